# Optimizing an MI355X kernel written in HIP

```python
import math
import jax, jax.numpy as jnp
from jax import lax
import numpy as np

D_MODEL = 1024
BATCH = 32
SEQ = 256
DEPTH = 4
DEC_BATCH = 8
DEC_SEQ = 4096
PAST_LEN = 256

GRID_W = 64
N_EVEN = (DEPTH + 1) // 2
N_ODD = DEPTH // 2
A_WIDTH = D_MODEL // 2
A_GROUPS = 4
A_CH = A_WIDTH // A_GROUPS
CHUNK = 128
B_WIDTH = D_MODEL // 2
HYENA_ORDER = 2
FILTER_BANDS = 16
FILTER_EMB = 2 * FILTER_BANDS + 1
FILTER_HIDDEN = 64
IN_EVEN = 2 * A_WIDTH + (HYENA_ORDER + 1) * B_WIDTH
MIX_EVEN = A_WIDTH + B_WIDTH
MLA_HEADS = 8
Q_RANK = D_MODEL // 2
KV_RANK = D_MODEL // 4
NOPE_DIM = 128
ROPE_DIM = 64
V_DIM = 128
QK_DIM = NOPE_DIM + ROPE_DIM
ROPE_BASE = 10000.0
Q_BLOCK = 128
D_FF = ((8 * D_MODEL // 3 + 127) // 128) * 128
EPS = 1e-6

kernel_name = 'hybrid_diffusion_chunkmlp_hyena_mla_step'


def rmsnorm(x, g):
    xf = x.astype(jnp.float32)
    y = xf * lax.rsqrt(jnp.mean(xf * xf, axis=-1, keepdims=True) + EPS)
    return (y * g.astype(jnp.float32)).astype(x.dtype)


def dwconv3(x, w, b):
    xp = jnp.pad(x, ((0, 0), (1, 1), (0, 0)))
    return xp[:, :-2] * w[0] + xp[:, 1:-1] * w[1] + xp[:, 2:] * w[2] + b


def adaln(cond, w, b):
    m = jax.nn.silu(cond) @ w + b
    return jnp.split(m[:, None, :], 6, axis=-1)


def axial_rope(x, seq_len):
    rows = seq_len // GRID_W
    row = jnp.repeat(jnp.arange(rows), GRID_W)
    col = jnp.tile(jnp.arange(GRID_W), rows)
    half = ROPE_DIM // 2
    inv = 1.0 / (ROPE_BASE ** (jnp.arange(0, half, 2, dtype=jnp.float32) / half))

    def rot(xa, pos):
        ang = pos.astype(jnp.float32)[:, None] * inv[None]
        cos = jnp.cos(ang)[None, :, None, :]
        sin = jnp.sin(ang)[None, :, None, :]
        x1, x2 = jnp.split(xa.astype(jnp.float32), 2, axis=-1)
        return jnp.concatenate([x1 * cos - x2 * sin, x2 * cos + x1 * sin], axis=-1)

    xr, xc = jnp.split(x, 2, axis=-1)
    return jnp.concatenate([rot(xr, row), rot(xc, col)], axis=-1).astype(x.dtype)


def rope_heads(x, seq_len):
    return jnp.concatenate([x[..., :NOPE_DIM], axial_rope(x[..., NOPE_DIM:], seq_len)], axis=-1)


def hyena_filters(L, w1, b1, w2, b2, w3, freq, decay):
    f32 = jnp.float32
    t = jnp.arange(L, dtype=f32)
    tn = t / L
    bands = jnp.arange(1, FILTER_BANDS + 1, dtype=f32)
    ang = (2.0 * math.pi) * tn[:, None] * bands[None]
    z = jnp.concatenate([tn[:, None], jnp.sin(ang), jnp.cos(ang)], axis=-1)
    fr = freq.astype(f32)
    h = jnp.sin(fr * (z @ w1.astype(f32) + b1.astype(f32)))
    h = jnp.sin(fr * (h @ w2.astype(f32) + b2.astype(f32)))
    h = (h @ w3.astype(f32)).reshape(L, HYENA_ORDER, B_WIDTH)
    dist = jnp.abs(t - L // 2) / L
    h = h * jnp.exp(-jnp.abs(decay.astype(f32))[None] * dist[:, None, None])
    return h / (jnp.sum(jnp.abs(h), axis=0, keepdims=True) + EPS)


def long_conv(u, h, d):
    L = u.shape[1]
    n = 2 * L
    y = jnp.fft.irfft(jnp.fft.rfft(u, n=n, axis=1) * jnp.fft.rfft(h, n=n, axis=0)[None], n=n, axis=1)
    return y[:, L // 2: L // 2 + L] + u * d.astype(jnp.float32)


def even_mixer(h, P, i):
    B, L, _ = h.shape
    p = h @ P['mix_w_in'][i]
    u, v = jnp.split(jax.nn.gelu(p[..., :2 * A_WIDTH]), 2, axis=-1)
    v = v.reshape(B, L // CHUNK, CHUNK, A_GROUPS, A_CH)
    s = jnp.einsum('gpq,bnqgc->bnpgc', P['sgu_w'][i], v) + P['sgu_b'][i].T[None, None, :, :, None]
    a_out = u * s.reshape(B, L, A_WIDTH)
    xb = dwconv3(p[..., 2 * A_WIDTH:], P['hy_conv_w'][i], P['hy_conv_b'][i]).astype(jnp.float32)
    vb, x1, x2 = jnp.split(xb, 3, axis=-1)
    filt = hyena_filters(L, P['hy_f_w1'][i], P['hy_f_b1'][i], P['hy_f_w2'][i], P['hy_f_b2'][i],
                         P['hy_f_w3'][i], P['hy_f_freq'][i], P['hy_decay'][i])
    d = P['hy_d'][i]
    z = x1 * long_conv(vb, filt[:, 0], d[0])
    z = x2 * long_conv(z, filt[:, 1], d[1])
    return jnp.concatenate([a_out, z.astype(h.dtype)], axis=-1) @ P['mix_w_out'][i]


def mla_queries(h, P, j):
    B, L, _ = h.shape
    q = (rmsnorm(h @ P['mla_w_dq'][j], P['mla_q_norm'][j]) @ P['mla_w_uq'][j]).reshape(B, L, MLA_HEADS, QK_DIM)
    return rmsnorm(q, P['mla_q_head_norm'][j])


def mla_compress(h, P, j):
    dkv = h @ P['mla_w_dkv'][j]
    return rmsnorm(dkv[..., :KV_RANK], P['mla_kv_norm'][j]), dkv[..., KV_RANK:]


def mla_expand(ckv, krope, P, j):
    B, L, _ = ckv.shape
    kv = (ckv @ P['mla_w_ukv'][j]).reshape(B, L, MLA_HEADS, NOPE_DIM + V_DIM)
    k = jnp.concatenate([kv[..., :NOPE_DIM],
                         jnp.broadcast_to(krope[:, :, None, :], (B, L, MLA_HEADS, ROPE_DIM))], axis=-1)
    return rmsnorm(k, P['mla_k_head_norm'][j]), kv[..., NOPE_DIM:]


def block_attention(q, k, v):
    B, Lq, H, Dk = q.shape
    nb = Lq // Q_BLOCK
    scale = 1.0 / math.sqrt(Dk)
    qb = q.reshape(B, nb, Q_BLOCK, H, Dk).transpose(1, 0, 2, 3, 4)

    def one(qblk):
        s = jnp.einsum('bqhd,bkhd->bhqk', qblk, k).astype(jnp.float32) * scale
        pr = jax.nn.softmax(s, axis=-1)
        return jnp.einsum('bhqk,bkhd->bqhd', pr.astype(v.dtype), v)

    out = lax.map(one, qb)
    return out.transpose(1, 0, 2, 3, 4).reshape(B, Lq, H * v.shape[-1])


def conv_ffn(h, P, l):
    up = dwconv3(h @ P['ffn_w_up'][l], P['ffn_conv_w'][l], P['ffn_conv_b'][l])
    g, u = jnp.split(up, 2, axis=-1)
    return (jax.nn.silu(g) * u) @ P['ffn_w_down'][l]


def trunk(x, cond, P, ctx_cache):
    B, L, _ = x.shape
    latent = ctx_cache is not None
    new_ckv = []
    new_kr = []
    for l in range(DEPTH):
        sh1, sc1, g1, sh2, sc2, g2 = adaln(cond, P['ada_w'][l], P['ada_b'][l])
        h = rmsnorm(x, P['norm_g'][l, 0]) * (1.0 + sc1) + sh1
        if l % 2 == 0:
            out = even_mixer(h, P, l // 2)
        else:
            j = l // 2
            q = mla_queries(h, P, j)
            ckv, kr = mla_compress(h, P, j)
            k, v = mla_expand(ckv, kr, P, j)
            if latent:
                q = rope_heads(q, L)
                k = rope_heads(k, L)
                kc, vc = mla_expand(ctx_cache[0][:, j], ctx_cache[1][:, j], P, j)
                k = jnp.concatenate([k, kc], axis=1)
                v = jnp.concatenate([v, vc], axis=1)
            else:
                new_ckv.append(ckv)
                new_kr.append(kr)
            out = block_attention(q, k, v) @ P['mla_w_o'][j]
        x = x + g1 * out
        h = rmsnorm(x, P['norm_g'][l, 1]) * (1.0 + sc2) + sh2
        x = x + g2 * conv_ffn(h, P, l)
    return x, new_ckv, new_kr


def setup_inputs(seed: int = 0) -> dict:
    key = jax.random.key(seed)
    ks = iter(jax.random.split(key, 64))

    def nrm(shape, scale):
        return jax.random.normal(next(ks), shape, jnp.float32) * scale

    def gain(shape):
        return 1.0 + nrm(shape, 0.05)

    D = D_MODEL
    return {
        'x_prompt': nrm((BATCH, SEQ, D), 1.0),
        'x_sample': nrm((DEC_BATCH, DEC_SEQ, D), 1.0),
        'cache_ckv': nrm((DEC_BATCH, N_ODD, PAST_LEN, KV_RANK), 1.0),
        'cache_krope': nrm((DEC_BATCH, N_ODD, PAST_LEN, ROPE_DIM), 1.0),
        'c': nrm((DEC_BATCH, D), 1.0),
        'c_ctx': nrm((D,), 1.0),
        'ada_w': nrm((DEPTH, D, 6 * D), 0.5 * D ** -0.5),
        'ada_b': nrm((DEPTH, 6 * D), 0.02),
        'norm_g': gain((DEPTH, 2, D)),
        'mix_w_in': nrm((N_EVEN, D, IN_EVEN), D ** -0.5),
        'sgu_w': nrm((N_EVEN, A_GROUPS, CHUNK, CHUNK), CHUNK ** -0.5),
        'sgu_b': nrm((N_EVEN, A_GROUPS, CHUNK), 0.02),
        'hy_conv_w': nrm((N_EVEN, 3, (HYENA_ORDER + 1) * B_WIDTH), 3 ** -0.5),
        'hy_conv_b': nrm((N_EVEN, (HYENA_ORDER + 1) * B_WIDTH), 0.02),
        'hy_f_w1': nrm((N_EVEN, FILTER_EMB, FILTER_HIDDEN), FILTER_EMB ** -0.5),
        'hy_f_b1': nrm((N_EVEN, FILTER_HIDDEN), 0.02),
        'hy_f_w2': nrm((N_EVEN, FILTER_HIDDEN, FILTER_HIDDEN), FILTER_HIDDEN ** -0.5),
        'hy_f_b2': nrm((N_EVEN, FILTER_HIDDEN), 0.02),
        'hy_f_w3': nrm((N_EVEN, FILTER_HIDDEN, HYENA_ORDER * B_WIDTH), FILTER_HIDDEN ** -0.5),
        'hy_f_freq': 1.0 + nrm((N_EVEN, FILTER_HIDDEN), 0.1),
        'hy_decay': jax.random.uniform(next(ks), (N_EVEN, HYENA_ORDER, B_WIDTH), jnp.float32, 3.0, 15.0),
        'hy_d': nrm((N_EVEN, HYENA_ORDER, B_WIDTH), 0.1),
        'mix_w_out': nrm((N_EVEN, MIX_EVEN, D), MIX_EVEN ** -0.5),
        'mla_w_dq': nrm((N_ODD, D, Q_RANK), D ** -0.5),
        'mla_q_norm': gain((N_ODD, Q_RANK)),
        'mla_w_uq': nrm((N_ODD, Q_RANK, MLA_HEADS * QK_DIM), Q_RANK ** -0.5),
        'mla_w_dkv': nrm((N_ODD, D, KV_RANK + ROPE_DIM), D ** -0.5),
        'mla_kv_norm': gain((N_ODD, KV_RANK)),
        'mla_w_ukv': nrm((N_ODD, KV_RANK, MLA_HEADS * (NOPE_DIM + V_DIM)), KV_RANK ** -0.5),
        'mla_q_head_norm': gain((N_ODD, QK_DIM)),
        'mla_k_head_norm': gain((N_ODD, QK_DIM)),
        'mla_w_o': nrm((N_ODD, MLA_HEADS * V_DIM, D), (MLA_HEADS * V_DIM) ** -0.5),
        'ffn_w_up': nrm((DEPTH, D, 2 * D_FF), D ** -0.5),
        'ffn_conv_w': nrm((DEPTH, 3, 2 * D_FF), 3 ** -0.5),
        'ffn_conv_b': nrm((DEPTH, 2 * D_FF), 0.02),
        'ffn_w_down': nrm((DEPTH, D_FF, D), D_FF ** -0.5),
    }


def reference(x_prompt, x_sample, cache_ckv, cache_krope, c, c_ctx,
              ada_w, ada_b, norm_g,
              mix_w_in, sgu_w, sgu_b, hy_conv_w, hy_conv_b,
              hy_f_w1, hy_f_b1, hy_f_w2, hy_f_b2, hy_f_w3, hy_f_freq, hy_decay, hy_d, mix_w_out,
              mla_w_dq, mla_q_norm, mla_w_uq, mla_w_dkv, mla_kv_norm, mla_w_ukv,
              mla_q_head_norm, mla_k_head_norm, mla_w_o,
              ffn_w_up, ffn_conv_w, ffn_conv_b, ffn_w_down):
    P = {
        'ada_w': ada_w, 'ada_b': ada_b, 'norm_g': norm_g,
        'mix_w_in': mix_w_in, 'sgu_w': sgu_w, 'sgu_b': sgu_b,
        'hy_conv_w': hy_conv_w, 'hy_conv_b': hy_conv_b,
        'hy_f_w1': hy_f_w1, 'hy_f_b1': hy_f_b1, 'hy_f_w2': hy_f_w2, 'hy_f_b2': hy_f_b2,
        'hy_f_w3': hy_f_w3, 'hy_f_freq': hy_f_freq, 'hy_decay': hy_decay, 'hy_d': hy_d,
        'mix_w_out': mix_w_out,
        'mla_w_dq': mla_w_dq, 'mla_q_norm': mla_q_norm, 'mla_w_uq': mla_w_uq,
        'mla_w_dkv': mla_w_dkv, 'mla_kv_norm': mla_kv_norm, 'mla_w_ukv': mla_w_ukv,
        'mla_q_head_norm': mla_q_head_norm, 'mla_k_head_norm': mla_k_head_norm, 'mla_w_o': mla_w_o,
        'ffn_w_up': ffn_w_up, 'ffn_conv_w': ffn_conv_w, 'ffn_conv_b': ffn_conv_b, 'ffn_w_down': ffn_w_down,
    }
    y_prompt, ckv_list, kr_list = trunk(x_prompt, c_ctx[None, :], P, None)
    new_cache_ckv = jnp.stack(ckv_list, axis=1)
    new_cache_krope = jnp.stack(kr_list, axis=1)
    y_sample, _, _ = trunk(x_sample, c, P, (cache_ckv, cache_krope))
    return (y_prompt, y_sample, new_cache_ckv, new_cache_krope)
```

```cpp
#include <hip/hip_runtime.h>
#include <hip/hip_cooperative_groups.h>
#include <cstdio>
namespace cg = cooperative_groups;

typedef unsigned short u16;
using bf16x8 = __attribute__((ext_vector_type(8))) short;
using f32x4 = __attribute__((ext_vector_type(4))) float;
using f32x16 = __attribute__((ext_vector_type(16))) float;
#define DI __device__ __forceinline__

constexpr int T = 40960;
constexpr int TP = 8192;
constexpr int TK = 43008;
constexpr float EPS = 1e-6f;
constexpr size_t LDS_BYTES = 139264;

constexpr size_t OFF_WMIXIN = 0;
constexpr size_t OFF_WMIXOUT = OFF_WMIXIN + (size_t)2 * 2560 * 1024 * 2;
constexpr size_t OFF_WDQKV = OFF_WMIXOUT + (size_t)2 * 1024 * 1024 * 2;
constexpr size_t OFF_WUQ = OFF_WDQKV + (size_t)2 * 896 * 1024 * 2;
constexpr size_t OFF_WUKV = OFF_WUQ + (size_t)2 * 1536 * 512 * 2;
constexpr size_t OFF_WO = OFF_WUKV + (size_t)2 * 2048 * 256 * 2;
constexpr size_t OFF_WSGU = OFF_WO + (size_t)2 * 1024 * 1024 * 2;
constexpr size_t OFF_WUP = OFF_WSGU + (size_t)2 * 4 * 128 * 128 * 2;
constexpr size_t OFF_WDOWN = OFF_WUP + (size_t)5632 * 1024 * 2;
constexpr size_t OFF_MOD = OFF_WDOWN + (size_t)1024 * 2816 * 2;
constexpr size_t OFF_FILT = OFF_MOD + (size_t)4 * 9 * 6144 * 4;
constexpr size_t OFF_H2 = OFF_FILT + (size_t)2 * 2 * 512 * 4352 * 2;
constexpr size_t OFF_EDGE = OFF_H2 + (size_t)2 * 4352 * 64 * 4;
constexpr size_t OFF_KR = OFF_EDGE + (size_t)160 * 4 * 5632 * 4;
constexpr size_t OFF_A = OFF_KR + (size_t)TK * 64 * 2;
constexpr size_t OFF_B = OFF_A + (size_t)T * 1024 * 2;
constexpr size_t WS_NEED = OFF_B + (size_t)346030080;
constexpr size_t A_H = 0, A_Z1 = 0, A_Z2 = (size_t)T * 512 * 2, A_QN = 0, A_CKV = (size_t)T * 512 * 2, A_O = 0;
constexpr size_t B_VT = 0, B_PRT = (size_t)T * 512 * 2, B_MIX = B_PRT + (size_t)T * 1536 * 2;
constexpr size_t B_DQKV = 0, B_Q = 0, B_K = (size_t)T * 1536 * 2, B_V = B_K + (size_t)TK * 1536 * 2;
constexpr size_t B_ACT = 0;
constexpr size_t VT_SAMPLE_OFF = (size_t)32 * 8 * 128 * 256;

struct Params {
  const float* in[36];
  float* out;
  char* ws;
};

DI int TIDX() { int t = (int)__builtin_amdgcn_workitem_id_x(); asm volatile("" : "+v"(t)); return t; }
DI u16 f2bf(float x) { unsigned u = __float_as_uint(x); u += 0x7fffu + ((u >> 16) & 1u); return (u16)(u >> 16); }
DI float bf2f(u16 h) { return __uint_as_float(((unsigned)h) << 16); }
DI unsigned pack2(float a, float b) { return (unsigned)f2bf(a) | ((unsigned)f2bf(b) << 16); }
DI uint2 pack4(float a, float b, float c, float d) { uint2 r; r.x = pack2(a, b); r.y = pack2(c, d); return r; }
DI float lo16(unsigned w) { return __uint_as_float(w << 16); }
DI float hi16(unsigned w) { return __uint_as_float(w & 0xffff0000u); }
DI float gelu_tanh(float x) { float y = 0.7978845608f * (x + 0.044715f * x * x * x); return x / (1.f + __expf(-2.f * y)); }
DI float silu(float x) { return x / (1.f + __expf(-x)); }
DI int condrow(int m) { return m < TP ? 0 : 1 + ((m - TP) >> 12); }
DI float wave_sum(float v) {
  v += __shfl_xor(v, 32); v += __shfl_xor(v, 16); v += __shfl_xor(v, 8);
  v += __shfl_xor(v, 4); v += __shfl_xor(v, 2); v += __shfl_xor(v, 1); return v;
}
DI int first_unit(int base) { int G = gridDim.x; int r = (int)blockIdx.x - (base % G); if (r < 0) r += G; return r; }
DI const float* xin_row(const Params& p, int l, int m) {
  if (l == 0) return m < TP ? p.in[0] + (size_t)m * 1024 : p.in[1] + (size_t)(m - TP) * 1024;
  return p.out + (size_t)m * 1024;
}

template <int MODE>
DI int rowmap(int n, int row0) {
  if (MODE == 0) return n + row0;
  return n < 2816 ? (n >> 6) * 128 + (n & 63) : ((n - 2816) >> 6) * 128 + 64 + ((n - 2816) & 63);
}
template <int MODE>
DI void convT(const float* __restrict__ src, u16* __restrict__ dst, int K, int N, int row0, char* smem, int& base) {
  u16* tl = (u16*)smem;
  const int tid = TIDX();
  const int nN = N >> 6, nunits = (K >> 6) * nN;
  for (int u = first_unit(base); u < nunits; u += gridDim.x) {
    const int k0 = (u / nN) << 6, n0 = (u % nN) << 6;
#pragma unroll
    for (int i = 0; i < 2; ++i) {
      const int r = (tid >> 4) + 32 * i, c4 = (tid & 15) * 4;
      const float4 v = *(const float4*)(src + (size_t)(k0 + r) * N + n0 + c4);
      tl[(c4 + 0) * 72 + r] = f2bf(v.x); tl[(c4 + 1) * 72 + r] = f2bf(v.y);
      tl[(c4 + 2) * 72 + r] = f2bf(v.z); tl[(c4 + 3) * 72 + r] = f2bf(v.w);
    }
    __syncthreads();
    {
      const int n = tid >> 3, kc = (tid & 7) * 8;
      const uint4 v = *(const uint4*)(tl + n * 72 + kc);
      *(uint4*)(dst + (size_t)rowmap<MODE>(n0 + n, row0) * K + k0 + kc) = v;
    }
    __syncthreads();
  }
  base += nunits;
}

DI void convert_ffn_weights(const Params& p, int l, char* smem, int& base) {
  convT<1>(p.in[32] + (size_t)l * 1024 * 5632, (u16*)(p.ws + OFF_WUP), 1024, 5632, 0, smem, base);
  convT<0>(p.in[35] + (size_t)l * 2816 * 1024, (u16*)(p.ws + OFF_WDOWN), 2816, 1024, 0, smem, base);
}

DI void phase_prep(const Params& p, char* smem) {
  const int tid = TIDX();
  int base = 0;
  char* ws = p.ws;
  for (int i = 0; i < 2; ++i) {
    convT<0>(p.in[9] + (size_t)i * 1024 * 2560, (u16*)(ws + OFF_WMIXIN) + (size_t)i * 2560 * 1024, 1024, 2560, 0, smem, base);
    convT<0>(p.in[22] + (size_t)i * 1024 * 1024, (u16*)(ws + OFF_WMIXOUT) + (size_t)i * 1024 * 1024, 1024, 1024, 0, smem, base);
    convT<0>(p.in[23] + (size_t)i * 1024 * 512, (u16*)(ws + OFF_WDQKV) + (size_t)i * 896 * 1024, 1024, 512, 0, smem, base);
    convT<0>(p.in[26] + (size_t)i * 1024 * 320, (u16*)(ws + OFF_WDQKV) + (size_t)i * 896 * 1024, 1024, 320, 512, smem, base);
    convT<0>(p.in[25] + (size_t)i * 512 * 1536, (u16*)(ws + OFF_WUQ) + (size_t)i * 1536 * 512, 512, 1536, 0, smem, base);
    convT<0>(p.in[28] + (size_t)i * 256 * 2048, (u16*)(ws + OFF_WUKV) + (size_t)i * 2048 * 256, 256, 2048, 0, smem, base);
    convT<0>(p.in[31] + (size_t)i * 1024 * 1024, (u16*)(ws + OFF_WO) + (size_t)i * 1024 * 1024, 1024, 1024, 0, smem, base);
  }
  convert_ffn_weights(p, 0, smem, base);
  {
    const long gtid = (long)blockIdx.x * blockDim.x + tid, gsz = (long)gridDim.x * blockDim.x;
    for (long i = gtid; i < 2 * 64 * 1024; i += gsz) {
      const int j = (int)(i >> 16), r = (int)(i & 65535);
      ((u16*)(ws + OFF_WDQKV))[(size_t)j * 896 * 1024 + (size_t)832 * 1024 + r] = 0;
    }
    for (long i = gtid; i < 2 * 4 * 128 * 128; i += gsz) ((u16*)(ws + OFF_WSGU))[i] = f2bf(p.in[10][i]);
  }
  {
    float* sc = (float*)smem;
    float* part = sc + 9 * 1024;
    __syncthreads();
    for (int i = tid; i < 9 * 1024; i += 512) {
      const int r = i >> 10, k = i & 1023;
      const float c = r == 0 ? p.in[5][k] : p.in[4][(r - 1) * 1024 + k];
      sc[i] = silu(c);
    }
    __syncthreads();
    float* MOD = (float*)(ws + OFF_MOD);
    const int nunits = 4 * 96;
    for (int u = first_unit(base); u < nunits; u += gridDim.x) {
      const int l = u / 96, n0 = (u % 96) * 64;
      const int col = n0 + (tid & 63), kg = tid >> 6;
      float acc[9];
#pragma unroll
      for (int r = 0; r < 9; ++r) acc[r] = 0.f;
      const float* w = p.in[6] + (size_t)l * 1024 * 6144 + col;
#pragma unroll 4
      for (int k = kg * 128; k < kg * 128 + 128; ++k) {
        const float wv = w[(size_t)k * 6144];
#pragma unroll
        for (int r = 0; r < 9; ++r) acc[r] += sc[r * 1024 + k] * wv;
      }
#pragma unroll
      for (int r = 0; r < 9; ++r) part[(kg * 9 + r) * 64 + (tid & 63)] = acc[r];
      __syncthreads();
      for (int i = tid; i < 576; i += 512) {
        const int r = i >> 6, cc = i & 63;
        float s = p.in[7][l * 6144 + n0 + cc];
#pragma unroll
        for (int g = 0; g < 8; ++g) s += part[(g * 9 + r) * 64 + cc];
        MOD[(size_t)(l * 9 + r) * 6144 + n0 + cc] = s;
      }
      __syncthreads();
    }
    base += nunits;
  }
  {
    float* zf = (float*)smem;
    float* h1 = zf + 8 * 36;
    float* H2 = (float*)(ws + OFF_H2);
    const int nunits = 2 * 544;
    for (int u = first_unit(base); u < nunits; u += gridDim.x) {
      const int i = u / 544, tg0 = (u % 544) * 8;
      __syncthreads();
      if (tid < 8 * 33) {
        const int tt = tid / 33, e = tid % 33;
        const int tg = tg0 + tt;
        const float L = tg < 256 ? 256.f : 4096.f;
        const float t = tg < 256 ? (float)tg : (float)(tg - 256);
        const float tn = t / L;
        float v;
        if (e == 0) v = tn;
        else if (e <= 16) v = sinf((6.283185307179586f * tn) * (float)e);
        else v = cosf((6.283185307179586f * tn) * (float)(e - 16));
        zf[tt * 36 + e] = v;
      }
      __syncthreads();
      const int tt = tid >> 6, jj = tid & 63;
      const float fr = p.in[19][i * 64 + jj];
      {
        float a = p.in[15][i * 64 + jj];
        const float* w1 = p.in[14] + (size_t)i * 33 * 64 + jj;
        for (int e = 0; e < 33; ++e) a += zf[tt * 36 + e] * w1[e * 64];
        h1[tt * 64 + jj] = sinf(fr * a);
      }
      __syncthreads();
      {
        float a = p.in[17][i * 64 + jj];
        const float* w2 = p.in[16] + (size_t)i * 64 * 64 + jj;
        for (int e = 0; e < 64; ++e) a += h1[tt * 64 + e] * w2[e * 64];
        H2[((size_t)i * 4352 + tg0 + tt) * 64 + jj] = sinf(fr * a);
      }
    }
    base += nunits;
    __syncthreads();
  }
}

DI void phase_filters(const Params& p, char* smem) {
  const int tid = TIDX();
  float* w3s = (float*)smem;
  float* red = w3s + 512;
  float* nrm = red + 512;
  float* hbuf = nrm + 8;
  const float* H2 = (const float*)(p.ws + OFF_H2);
  u16* FILT = (u16*)(p.ws + OFF_FILT);
  for (int u = blockIdx.x; u < 512; u += gridDim.x) {
    const int kind = (u >> 7) & 1, i = u >> 8, cg8 = (u & 127) * 8;
    const int L = kind ? 4096 : 256, tbase = kind ? 256 : 0;
    __syncthreads();
    { const int j = tid >> 3, cc = tid & 7; w3s[j * 8 + cc] = p.in[18][((size_t)i * 64 + j) * 1024 + cg8 + cc]; }
    __syncthreads();
    const int cc = tid & 7, tq = tid >> 3;
    const int col = cg8 + cc, o = col >> 9, c = col & 511;
    const float dec = fabsf(p.in[20][(i * 2 + o) * 512 + c]);
    float asum = 0.f;
    for (int t = tq; t < L; t += 64) {
      const float4* hr = (const float4*)(H2 + ((size_t)i * 4352 + tbase + t) * 64);
      float a = 0.f;
#pragma unroll
      for (int j4 = 0; j4 < 16; ++j4) {
        const float4 hv = hr[j4];
        a += hv.x * w3s[(j4 * 4 + 0) * 8 + cc]; a += hv.y * w3s[(j4 * 4 + 1) * 8 + cc];
        a += hv.z * w3s[(j4 * 4 + 2) * 8 + cc]; a += hv.w * w3s[(j4 * 4 + 3) * 8 + cc];
      }
      const float dist = fabsf((float)(t - L / 2)) / (float)L;
      a *= expf(-dec * dist);
      hbuf[cc * L + t] = a;
      asum += fabsf(a);
    }
    red[tid] = asum;
    __syncthreads();
    if (tid < 8) { float s = 0.f; for (int q = 0; q < 64; ++q) s += red[q * 8 + tid]; nrm[tid] = 1.f / (s + EPS); }
    __syncthreads();
    for (int idx = tid; idx < 8 * L; idx += 512) {
      const int c2 = idx / L, t = idx - c2 * L;
      const int col2 = cg8 + c2, o2 = col2 >> 9, cch = col2 & 511;
      FILT[((size_t)(i * 2 + o2) * 512 + cch) * 4352 + tbase + t] = f2bf(hbuf[c2 * L + t] * nrm[c2]);
    }
  }
  __syncthreads();
}

DI void phase_norm(const Params& p, int l, int part, int lx) {
  const int tid_ = TIDX(); const int lane = tid_ & 63, wid = tid_ >> 6;
  const float* MOD = (const float*)(p.ws + OFF_MOD);
  const float* g = p.in[8] + (size_t)(l * 2 + part) * 1024;
  u16* H = (u16*)(p.ws + OFF_A + A_H);
  for (int row = blockIdx.x * 8 + wid; row < T; row += gridDim.x * 8) {
    const float* xr = xin_row(p, lx, row);
    float4 v[4];
    float ss = 0.f;
#pragma unroll
    for (int i = 0; i < 4; ++i) {
      v[i] = *(const float4*)(xr + (i * 64 + lane) * 4);
      ss += v[i].x * v[i].x + v[i].y * v[i].y + v[i].z * v[i].z + v[i].w * v[i].w;
    }
    ss = wave_sum(ss);
    const float r = rsqrtf(ss * (1.f / 1024.f) + EPS);
    const float* mr = MOD + (size_t)(l * 9 + condrow(row)) * 6144 + part * 3072;
#pragma unroll
    for (int i = 0; i < 4; ++i) {
      const int k = (i * 64 + lane) * 4;
      const float4 gv = *(const float4*)(g + k), sh = *(const float4*)(mr + k), sc = *(const float4*)(mr + 1024 + k);
      const float a = v[i].x * r * gv.x * (1.f + sc.x) + sh.x;
      const float b = v[i].y * r * gv.y * (1.f + sc.y) + sh.y;
      const float c = v[i].z * r * gv.z * (1.f + sc.z) + sh.z;
      const float d = v[i].w * r * gv.w * (1.f + sc.w) + sh.w;
      *(uint2*)(H + (size_t)row * 1024 + k) = pack4(a, b, c, d);
    }
  }
}

template <bool SWAP, class Epi>
DI void gemm_tile(const u16* A, int lda, const u16* Bt, int ldb, int K, int m0, int n0, char* smem, Epi epi) {
  const int tid = TIDX(), lane = tid & 63, wid = tid >> 6;
  const int wm = wid >> 1, wn = wid & 1, fr = lane & 15, fq = lane >> 4;
  const int lrow = tid >> 3, kc = tid & 7;
  const u16* ga = A + (size_t)(m0 + lrow) * lda + kc * 8;
  const u16* gb = Bt + (size_t)(n0 + lrow) * ldb + kc * 8;
  const int soff = lrow * 128 + ((kc ^ (lrow & 7)) << 4);
  uint4 ra[4], rb[2];
  f32x4 acc[4][4];
#pragma unroll
  for (int i = 0; i < 4; ++i)
#pragma unroll
    for (int j = 0; j < 4; ++j) acc[i][j] = f32x4{0.f, 0.f, 0.f, 0.f};
  const int nk = K >> 6;
#pragma unroll
  for (int i = 0; i < 4; ++i) ra[i] = *(const uint4*)(ga + (size_t)(64 * i) * lda);
#pragma unroll
  for (int i = 0; i < 2; ++i) rb[i] = *(const uint4*)(gb + (size_t)(64 * i) * ldb);
#pragma unroll
  for (int i = 0; i < 4; ++i) *(uint4*)(smem + soff + i * 8192) = ra[i];
#pragma unroll
  for (int i = 0; i < 2; ++i) *(uint4*)(smem + 32768 + soff + i * 8192) = rb[i];
  __syncthreads();
  for (int kt = 0; kt < nk; ++kt) {
    const bool more = kt + 1 < nk;
    if (more) {
      const int k0 = (kt + 1) << 6;
#pragma unroll
      for (int i = 0; i < 4; ++i) ra[i] = *(const uint4*)(ga + (size_t)(64 * i) * lda + k0);
#pragma unroll
      for (int i = 0; i < 2; ++i) rb[i] = *(const uint4*)(gb + (size_t)(64 * i) * ldb + k0);
    }
    const char* sa = smem + (kt & 1) * 49152;
    const char* sb = sa + 32768;
#pragma unroll
    for (int ks = 0; ks < 2; ++ks) {
      bf16x8 af[4], bfv[4];
      const int co = ((ks * 4 + fq) ^ (fr & 7)) << 4;
#pragma unroll
      for (int mi = 0; mi < 4; ++mi) af[mi] = *(const bf16x8*)(sa + (wm * 64 + mi * 16 + fr) * 128 + co);
#pragma unroll
      for (int ni = 0; ni < 4; ++ni) bfv[ni] = *(const bf16x8*)(sb + (wn * 64 + ni * 16 + fr) * 128 + co);
#pragma unroll
      for (int mi = 0; mi < 4; ++mi)
#pragma unroll
        for (int ni = 0; ni < 4; ++ni)
          acc[mi][ni] = SWAP ? __builtin_amdgcn_mfma_f32_16x16x32_bf16(bfv[ni], af[mi], acc[mi][ni], 0, 0, 0)
                             : __builtin_amdgcn_mfma_f32_16x16x32_bf16(af[mi], bfv[ni], acc[mi][ni], 0, 0, 0);
    }
    if (more) {
      char* da = smem + ((kt + 1) & 1) * 49152;
#pragma unroll
      for (int i = 0; i < 4; ++i) *(uint4*)(da + soff + i * 8192) = ra[i];
#pragma unroll
      for (int i = 0; i < 2; ++i) *(uint4*)(da + 32768 + soff + i * 8192) = rb[i];
    }
    __syncthreads();
  }
#pragma unroll
  for (int mi = 0; mi < 4; ++mi)
#pragma unroll
    for (int ni = 0; ni < 4; ++ni) {
      if (SWAP) epi(m0 + wm * 64 + mi * 16 + fr, n0 + wn * 64 + ni * 16 + fq * 4, acc[mi][ni]);
      else epi(m0 + wm * 64 + mi * 16 + fq * 4, n0 + wn * 64 + ni * 16 + fr, acc[mi][ni]);
    }
}

template <class F>
DI void for_tiles(int nM, int nN, int sm, int sn, F f) {
  if (gridDim.x == 256) {
    const int xcd = blockIdx.x & 7, slot = blockIdx.x >> 3;
    const int am = slot % sm, bn = slot / sm;
    const int nSN = (nN + sn - 1) / sn, nS = (nM / sm) * nSN;
    for (int st = xcd; st < nS; st += 8) {
      const int tm = (st / nSN) * sm + am, tn = (st % nSN) * sn + bn;
      if (tn < nN) f(tm, tn);
    }
  } else {
    for (int t = blockIdx.x; t < nM * nN; t += gridDim.x) f(t / nN, t % nN);
  }
}

DI void phase_mix_in(const Params& p, int i, char* smem) {
  const u16* H = (const u16*)(p.ws + OFF_A + A_H);
  const u16* W = (const u16*)(p.ws + OFF_WMIXIN) + (size_t)i * 2560 * 1024;
  u16* MIX = (u16*)(p.ws + OFF_B + B_MIX);
  u16* VT = (u16*)(p.ws + OFF_B + B_VT);
  u16* PRT = (u16*)(p.ws + OFF_B + B_PRT);
  auto epi = [=](int m, int n, f32x4 v) {
    if (n < 512) {
      *(uint2*)(MIX + (size_t)m * 1024 + n) = pack4(gelu_tanh(v[0]), gelu_tanh(v[1]), gelu_tanh(v[2]), gelu_tanh(v[3]));
    } else if (n < 1024) {
      const int nn = n - 512, g = nn >> 7, c = nn & 127, chunk = m >> 7, q = m & 127;
      u16* b = VT + ((size_t)(g * 320 + chunk) * 128 + c) * 128 + q;
#pragma unroll
      for (int j = 0; j < 4; ++j) b[j * 128] = f2bf(gelu_tanh(v[j]));
    } else {
      const int cp = n - 1024;
      size_t off; int stride;
      if (m < TP) { off = (size_t)(m & ~255) * 1536 + (size_t)cp * 256 + (m & 255); stride = 256; }
      else { const int mm = m - TP; off = (size_t)(TP + (mm & ~4095)) * 1536 + (size_t)cp * 4096 + (mm & 4095); stride = 4096; }
#pragma unroll
      for (int j = 0; j < 4; ++j) PRT[off + (size_t)j * stride] = f2bf(v[j]);
    }
  };
  for_tiles(160, 20, 8, 4, [=](int tm, int tn) { gemm_tile<true>(H, 1024, W, 1024, 1024, tm * 256, tn * 128, smem, epi); });
}

DI void phase_sgu(const Params& p, int i, char* smem) {
  const u16* VT = (const u16*)(p.ws + OFF_B + B_VT);
  const u16* W = (const u16*)(p.ws + OFF_WSGU) + (size_t)i * 4 * 16384;
  u16* MIX = (u16*)(p.ws + OFF_B + B_MIX);
  const float* sb = p.in[11] + i * 512;
  for (int u = blockIdx.x; u < 640; u += gridDim.x) {
    const int g = u / 160, tm = u % 160;
    auto epi = [=](int m, int n, f32x4 v) {
      const int chunk = m >> 7, c = m & 127;
      const int t = chunk * 128 + n;
      const float bias = sb[g * 128 + n];
      u16* dst = MIX + (size_t)t * 1024 + g * 128 + c;
      const uint2 uu = *(const uint2*)dst;
      *(uint2*)dst = pack4(lo16(uu.x) * (v[0] + bias), hi16(uu.x) * (v[1] + bias), lo16(uu.y) * (v[2] + bias), hi16(uu.y) * (v[3] + bias));
    };
    gemm_tile<false>(VT + (size_t)g * 320 * 128 * 128, 128, W + (size_t)g * 16384, 128, 128, tm * 256, 0, smem, epi);
  }
}

DI size_t prt_off(int kind, int b, int cp) {
  return kind ? (size_t)(TP + b * 4096) * 1536 + (size_t)cp * 4096 : (size_t)(b * 256) * 1536 + (size_t)cp * 256;
}
DI size_t zt_off(int kind, int b, int c) {
  return kind ? (size_t)(TP + b * 4096) * 512 + (size_t)c * 4096 : (size_t)(b * 256) * 512 + (size_t)c * 256;
}
DI void phase_conv(const Params& p, int i, int ord, char* smem) {
  const int tid = TIDX(), lane = tid & 63, wid = tid >> 6;
  const u16* PRT = (const u16*)(p.ws + OFF_B + B_PRT);
  const u16* FILT = (const u16*)(p.ws + OFF_FILT);
  const u16* Z1 = (const u16*)(p.ws + OFF_A + A_Z1);
  u16* ZO = (u16*)(p.ws + OFF_A + (ord ? A_Z2 : A_Z1));
  const float* cw = p.in[12] + (size_t)i * 3 * 1536;
  const float* cb = p.in[13] + (size_t)i * 1536;
  u16* hc = (u16*)smem;
  char* Ub = smem + 68096;
  for (int u = blockIdx.x; u < 1024; u += gridDim.x) {
    const int kind = u < 512 ? 1 : 0, c = u & 511;
    const int L = kind ? 4096 : 256, NB = kind ? 8 : 32, LB = L >> 6, DD = L >> 7;
    const int US = (L + 8) * 2;
    const size_t fbase = ((size_t)(i * 2 + ord) * 512 + c) * 4352 + (kind ? 256 : 0);
    __syncthreads();
    for (int idx = tid; idx < 8 * (L + 136); idx += 512) {
      const int cpy = idx / (L + 136), m = idx - cpy * (L + 136);
      const int x = L + 63 - m - cpy;
      hc[cpy * 4256 + m] = (x >= 0 && x < L) ? FILT[fbase + x] : (u16)0;
    }
    {
      const int ncr = L >> 3, total = NB * ncr;
      const float w0 = cw[c], w1 = cw[1536 + c], w2 = cw[3072 + c], bb = cb[c];
      for (int id = tid; id < total; id += 512) {
        const int b = id / ncr, t = (id - b * ncr) * 8;
        uint4 o;
        if (ord == 0) {
          const u16* src = PRT + prt_off(kind, b, c) + t;
          const uint4 raw = *(const uint4*)src;
          float e[10];
          e[0] = t > 0 ? bf2f(src[-1]) : 0.f;
          e[9] = t + 8 < L ? bf2f(src[8]) : 0.f;
          e[1] = lo16(raw.x); e[2] = hi16(raw.x); e[3] = lo16(raw.y); e[4] = hi16(raw.y);
          e[5] = lo16(raw.z); e[6] = hi16(raw.z); e[7] = lo16(raw.w); e[8] = hi16(raw.w);
          float r[8];
#pragma unroll
          for (int k = 0; k < 8; ++k) r[k] = w0 * e[k] + w1 * e[k + 1] + w2 * e[k + 2] + bb;
          o.x = pack2(r[0], r[1]); o.y = pack2(r[2], r[3]); o.z = pack2(r[4], r[5]); o.w = pack2(r[6], r[7]);
        } else {
          o = *(const uint4*)(Z1 + zt_off(kind, b, c) + t);
        }
        *(uint4*)(Ub + b * US + t * 2) = o;
      }
    }
    __syncthreads();
    const int ncols = LB * NB;
    if (wid * 64 < ncols) {
      const int il = lane & 31, q = lane >> 5;
      int t1c[2], bc[2];
#pragma unroll
      for (int nt = 0; nt < 2; ++nt) { const int col = wid * 64 + nt * 32 + il; t1c[nt] = col / NB; bc[nt] = col % NB; }
      const int t1lo = (wid * 64) / NB, t1hi = (wid * 64 + 63) / NB;
      const int dlo = max(-DD, t1lo - (LB - 1)), dhi = min(DD, t1hi);
      const int cpy = 7 - (il & 7);
      const char* abase = (const char*)hc + cpy * 8512 + 2 * (L / 2 + 63 - il - cpy + 8 * q);
      f32x16 acc[2][2];
#pragma unroll
      for (int a = 0; a < 2; ++a)
#pragma unroll
        for (int b = 0; b < 2; ++b)
#pragma unroll
          for (int r = 0; r < 16; ++r) acc[a][b][r] = 0.f;
      for (int d = dlo; d <= dhi; ++d) {
        bf16x8 bfr[2][4];
#pragma unroll
        for (int nt = 0; nt < 2; ++nt) {
          const int s1 = t1c[nt] - d;
          const bool valid = s1 >= 0 && s1 < LB;
          const char* bp = Ub + bc[nt] * US + ((valid ? s1 : 0) * 64 + 8 * q) * 2;
#pragma unroll
          for (int ks = 0; ks < 4; ++ks) {
            bf16x8 v = *(const bf16x8*)(bp + ks * 32);
            if (!valid) v = bf16x8{0, 0, 0, 0, 0, 0, 0, 0};
            bfr[nt][ks] = v;
          }
        }
#pragma unroll
        for (int mt = 0; mt < 2; ++mt)
#pragma unroll
          for (int ks = 0; ks < 4; ++ks) {
            const bf16x8 af = *(const bf16x8*)(abase + 2 * (-64 * d - 32 * mt + 16 * ks));
#pragma unroll
            for (int nt = 0; nt < 2; ++nt) acc[mt][nt] = __builtin_amdgcn_mfma_f32_32x32x16_bf16(af, bfr[nt][ks], acc[mt][nt], 0, 0, 0);
          }
      }
      const float dsk = p.in[21][(i * 2 + ord) * 512 + c];
      const int gc = 512 * (ord + 1) + c;
      const float w0 = cw[gc], w1 = cw[1536 + gc], w2 = cw[3072 + gc], bb = cb[gc];
#pragma unroll
      for (int nt = 0; nt < 2; ++nt) {
        const int b = bc[nt];
        const u16* xrow = PRT + prt_off(kind, b, gc);
        u16* orow = ZO + zt_off(kind, b, c);
#pragma unroll
        for (int mt = 0; mt < 2; ++mt)
#pragma unroll
          for (int g = 0; g < 4; ++g) {
            const int t = 64 * t1c[nt] + mt * 32 + 8 * g + 4 * q;
            const uint2 uu = *(const uint2*)(Ub + b * US + t * 2);
            const uint2 xx = *(const uint2*)(xrow + t);
            const float em = t > 0 ? bf2f(xrow[t - 1]) : 0.f;
            const float ep = t + 4 < L ? bf2f(xrow[t + 4]) : 0.f;
            const float e0 = lo16(xx.x), e1 = hi16(xx.x), e2 = lo16(xx.y), e3 = hi16(xx.y);
            const float x0 = w0 * em + w1 * e0 + w2 * e1 + bb;
            const float x1 = w0 * e0 + w1 * e1 + w2 * e2 + bb;
            const float x2 = w0 * e1 + w1 * e2 + w2 * e3 + bb;
            const float x3 = w0 * e2 + w1 * e3 + w2 * ep + bb;
            const float y0 = acc[mt][nt][4 * g + 0] + lo16(uu.x) * dsk;
            const float y1 = acc[mt][nt][4 * g + 1] + hi16(uu.x) * dsk;
            const float y2 = acc[mt][nt][4 * g + 2] + lo16(uu.y) * dsk;
            const float y3 = acc[mt][nt][4 * g + 3] + hi16(uu.y) * dsk;
            *(uint2*)(orow + t) = pack4(x0 * y0, x1 * y1, x2 * y2, x3 * y3);
          }
      }
    }
  }
  __syncthreads();
}

DI void phase_ztrans(const Params& p, char* smem) {
  const int tid = TIDX();
  const u16* Z2 = (const u16*)(p.ws + OFF_A + A_Z2);
  u16* MIX = (u16*)(p.ws + OFF_B + B_MIX);
  u16* tl = (u16*)smem;
  for (int u = blockIdx.x; u < 640 * 8; u += gridDim.x) {
    const int tt0 = (u >> 3) * 64, c0 = (u & 7) * 64;
    const int kind = tt0 >= TP ? 1 : 0;
    const int b = kind ? (tt0 - TP) >> 12 : tt0 >> 8;
    const int tl0 = kind ? (tt0 - TP) & 4095 : tt0 & 255;
    __syncthreads();
    { const int c = tid >> 3, ch = tid & 7;
      *(uint4*)(tl + c * 72 + ch * 8) = *(const uint4*)(Z2 + zt_off(kind, b, c0 + c) + tl0 + ch * 8); }
    __syncthreads();
    { const int tr = tid >> 3, cc = (tid & 7) * 8;
      uint4 o;
      o.x = (unsigned)tl[(cc + 0) * 72 + tr] | ((unsigned)tl[(cc + 1) * 72 + tr] << 16);
      o.y = (unsigned)tl[(cc + 2) * 72 + tr] | ((unsigned)tl[(cc + 3) * 72 + tr] << 16);
      o.z = (unsigned)tl[(cc + 4) * 72 + tr] | ((unsigned)tl[(cc + 5) * 72 + tr] << 16);
      o.w = (unsigned)tl[(cc + 6) * 72 + tr] | ((unsigned)tl[(cc + 7) * 72 + tr] << 16);
      *(uint4*)(MIX + (size_t)(tt0 + tr) * 1024 + 512 + c0 + cc) = o; }
  }
  __syncthreads();
}

DI void phase_resid_gemm(const Params& p, int l, int lx, const u16* A, int K, const u16* W, int goff, char* smem) {
  const float* MOD = (const float*)(p.ws + OFF_MOD);
  float* X = p.out;
  const float* x0 = p.in[0];
  const float* x1 = p.in[1];
  auto epi = [=](int m, int n, f32x4 v) {
    const float* xr = lx == 0 ? (m < TP ? x0 + (size_t)m * 1024 : x1 + (size_t)(m - TP) * 1024) : X + (size_t)m * 1024;
    const float4 xo = *(const float4*)(xr + n);
    const float4 g = *(const float4*)(MOD + (size_t)(l * 9 + condrow(m)) * 6144 + goff + n);
    float4 o; o.x = xo.x + g.x * v[0]; o.y = xo.y + g.y * v[1]; o.z = xo.z + g.z * v[2]; o.w = xo.w + g.w * v[3];
    *(float4*)(X + (size_t)m * 1024 + n) = o;
  };
  for_tiles(160, 8, 4, 8, [=](int tm, int tn) { gemm_tile<true>(A, K, W, K, K, tm * 256, tn * 128, smem, epi); });
}

DI void phase_dqkv(const Params& p, int j, char* smem) {
  const u16* H = (const u16*)(p.ws + OFF_A + A_H);
  const u16* W = (const u16*)(p.ws + OFF_WDQKV) + (size_t)j * 896 * 1024;
  u16* DQKV = (u16*)(p.ws + OFF_B + B_DQKV);
  u16* KR = (u16*)(p.ws + OFF_KR);
  float* okr = p.out + 46137344;
  auto epi = [=](int m, int n, f32x4 v) {
    if (n < 832) {
      const uint2 pk = pack4(v[0], v[1], v[2], v[3]);
      *(uint2*)(DQKV + (size_t)m * 896 + n) = pk;
      if (n >= 768) {
        const int e = n - 768;
        *(uint2*)(KR + (size_t)m * 64 + e) = pk;
        if (m < TP) {
          float4 o; o.x = v[0]; o.y = v[1]; o.z = v[2]; o.w = v[3];
          *(float4*)(okr + ((size_t)((m >> 8) * 2 + j) * 256 + (m & 255)) * 64 + e) = o;
        }
      }
    }
  };
  for_tiles(160, 7, 4, 8, [=](int tm, int tn) { gemm_tile<true>(H, 1024, W, 1024, 1024, tm * 256, tn * 128, smem, epi); });
}

DI void phase_mla_norms(const Params& p, int j) {
  const int tid_ = TIDX(); const int lane = tid_ & 63, wid = tid_ >> 6;
  const u16* DQKV = (const u16*)(p.ws + OFF_B + B_DQKV);
  u16* QN = (u16*)(p.ws + OFF_A + A_QN);
  u16* CKV = (u16*)(p.ws + OFF_A + A_CKV);
  u16* KR = (u16*)(p.ws + OFF_KR);
  float* ockv = p.out + 41943040;
  const float* qn = p.in[24] + j * 512;
  const float* kvn = p.in[27] + j * 256;
  for (int t = blockIdx.x * 8 + wid; t < TK; t += gridDim.x * 8) {
    if (t < T) {
      const u16* row = DQKV + (size_t)t * 896;
      const uint4 a = *(const uint4*)(row + lane * 8);
      float q[8] = {lo16(a.x), hi16(a.x), lo16(a.y), hi16(a.y), lo16(a.z), hi16(a.z), lo16(a.w), hi16(a.w)};
      float ss = 0.f;
#pragma unroll
      for (int k = 0; k < 8; ++k) ss += q[k] * q[k];
      ss = wave_sum(ss);
      const float r = rsqrtf(ss * (1.f / 512.f) + EPS);
      const float4 g0 = *(const float4*)(qn + lane * 8), g1 = *(const float4*)(qn + lane * 8 + 4);
      uint4 o;
      o.x = pack2(q[0] * r * g0.x, q[1] * r * g0.y); o.y = pack2(q[2] * r * g0.z, q[3] * r * g0.w);
      o.z = pack2(q[4] * r * g1.x, q[5] * r * g1.y); o.w = pack2(q[6] * r * g1.z, q[7] * r * g1.w);
      *(uint4*)(QN + (size_t)t * 512 + lane * 8) = o;
      const uint2 b = *(const uint2*)(row + 512 + lane * 4);
      float kv[4] = {lo16(b.x), hi16(b.x), lo16(b.y), hi16(b.y)};
      float s2 = kv[0] * kv[0] + kv[1] * kv[1] + kv[2] * kv[2] + kv[3] * kv[3];
      s2 = wave_sum(s2);
      const float r2 = rsqrtf(s2 * (1.f / 256.f) + EPS);
      const float4 g2 = *(const float4*)(kvn + lane * 4);
      float4 o2; o2.x = kv[0] * r2 * g2.x; o2.y = kv[1] * r2 * g2.y; o2.z = kv[2] * r2 * g2.z; o2.w = kv[3] * r2 * g2.w;
      *(uint2*)(CKV + (size_t)t * 256 + lane * 4) = pack4(o2.x, o2.y, o2.z, o2.w);
      if (t < TP) *(float4*)(ockv + ((size_t)((t >> 8) * 2 + j) * 256 + (t & 255)) * 256 + lane * 4) = o2;
    } else {
      const int pp = t - T, b = pp >> 8, s = pp & 255;
      const float4 v = *(const float4*)(p.in[2] + ((size_t)(b * 2 + j) * 256 + s) * 256 + lane * 4);
      *(uint2*)(CKV + (size_t)t * 256 + lane * 4) = pack4(v.x, v.y, v.z, v.w);
      if (lane < 16) {
        const float4 w = *(const float4*)(p.in[3] + ((size_t)(b * 2 + j) * 256 + s) * 64 + lane * 4);
        *(uint2*)(KR + (size_t)t * 64 + lane * 4) = pack4(w.x, w.y, w.z, w.w);
      }
    }
  }
}

DI size_t vt_off(int m, int h, int d) {
  if (m < TP) return ((size_t)((m >> 8) * 8 + h) * 128 + d) * 256 + (m & 255);
  if (m < T) { const int mm = m - TP; return VT_SAMPLE_OFF + ((size_t)((mm >> 12) * 8 + h) * 128 + d) * 4352 + (mm & 4095); }
  const int mm = m - T;
  return VT_SAMPLE_OFF + ((size_t)((mm >> 8) * 8 + h) * 128 + d) * 4352 + 4096 + (mm & 255);
}
DI void phase_uq_ukv(const Params& p, int j, char* smem) {
  const u16* QN = (const u16*)(p.ws + OFF_A + A_QN);
  const u16* CKV = (const u16*)(p.ws + OFF_A + A_CKV);
  const u16* WQ = (const u16*)(p.ws + OFF_WUQ) + (size_t)j * 1536 * 512;
  const u16* WKV = (const u16*)(p.ws + OFF_WUKV) + (size_t)j * 2048 * 256;
  u16* Q = (u16*)(p.ws + OFF_B + B_Q);
  u16* Kb = (u16*)(p.ws + OFF_B + B_K);
  u16* Vt = (u16*)(p.ws + OFF_B + B_V);
  auto epiq = [=](int m, int n, f32x4 v) { *(uint2*)(Q + (size_t)m * 1536 + n) = pack4(v[0], v[1], v[2], v[3]); };
  for_tiles(160, 12, 8, 4, [=](int tm, int tn) { gemm_tile<true>(QN, 512, WQ, 512, 512, tm * 256, tn * 128, smem, epiq); });
  auto epik = [=](int m, int n, f32x4 v) {
    const int h = n >> 8, r = n & 255;
    *(uint2*)(Kb + ((size_t)m * 8 + h) * 192 + r) = pack4(v[0], v[1], v[2], v[3]);
  };
  auto epiv = [=](int m, int n, f32x4 v) {
    const int h = n >> 8, d = (n & 255) - 128;
    *(uint2*)(Vt + vt_off(m, h, d)) = pack4(v[0], v[1], v[2], v[3]);
  };
  for_tiles(168, 16, 4, 8, [=](int tm, int tn) {
    if (tn & 1) gemm_tile<false>(CKV, 256, WKV, 256, 256, tm * 256, tn * 128, smem, epiv);
    else gemm_tile<true>(CKV, 256, WKV, 256, 256, tm * 256, tn * 128, smem, epik);
  });
}

DI void phase_finalize(const Params& p, int j) {
  const int tid_ = TIDX(); const int lane = tid_ & 63, wid = tid_ >> 6;
  const int h = lane >> 3, l8 = lane & 7;
  u16* Q = (u16*)(p.ws + OFF_B + B_Q);
  u16* Kb = (u16*)(p.ws + OFF_B + B_K);
  const u16* KR = (const u16*)(p.ws + OFF_KR);
  const float QSCALE = 1.4426950408889634f * 0.07216878364870322f;
  for (int u = blockIdx.x * 8 + wid; u < T + TK; u += gridDim.x * 8) {
    const bool isq = u < T;
    const int t = isq ? u : u - T;
    u16* base = isq ? Q + (size_t)t * 1536 + h * 192 : Kb + ((size_t)t * 8 + h) * 192;
    const float* hn = (isq ? p.in[29] : p.in[30]) + j * 192;
    float v[3][8];
#pragma unroll
    for (int k = 0; k < 3; ++k) {
      const u16* src = (!isq && k == 2) ? KR + (size_t)t * 64 + 8 * l8 : base + 8 * (l8 + 8 * k);
      const uint4 a = *(const uint4*)src;
      v[k][0] = lo16(a.x); v[k][1] = hi16(a.x); v[k][2] = lo16(a.y); v[k][3] = hi16(a.y);
      v[k][4] = lo16(a.z); v[k][5] = hi16(a.z); v[k][6] = lo16(a.w); v[k][7] = hi16(a.w);
    }
    float ss = 0.f;
#pragma unroll
    for (int k = 0; k < 3; ++k)
#pragma unroll
      for (int e = 0; e < 8; ++e) ss += v[k][e] * v[k][e];
    ss += __shfl_xor(ss, 1); ss += __shfl_xor(ss, 2); ss += __shfl_xor(ss, 4);
    const float r = rsqrtf(ss * (1.f / 192.f) + EPS);
#pragma unroll
    for (int k = 0; k < 3; ++k) {
      const float4 g0 = *(const float4*)(hn + 8 * (l8 + 8 * k)), g1 = *(const float4*)(hn + 8 * (l8 + 8 * k) + 4);
      v[k][0] *= r * g0.x; v[k][1] *= r * g0.y; v[k][2] *= r * g0.z; v[k][3] *= r * g0.w;
      v[k][4] *= r * g1.x; v[k][5] *= r * g1.y; v[k][6] *= r * g1.z; v[k][7] *= r * g1.w;
    }
    const bool rope = t >= TP && t < T;
    {
      const int tl = (t - TP) & 4095;
      const float pos = (float)(l8 < 4 ? (tl >> 6) : (tl & 63));
#pragma unroll
      for (int e = 0; e < 8; ++e) {
        const float x = v[2][e];
        const float partner = __shfl_xor(x, 2);
        const int f = (l8 & 1) * 8 + e;
        const float inv = exp2f(-(float)f * (13.287712379549449f / 16.f));
        float sn, cs;
        sincosf(pos * inv, &sn, &cs);
        const float rot = (l8 & 2) ? x * cs + partner * sn : x * cs - partner * sn;
        v[2][e] = rope ? rot : x;
      }
    }
    const float sc = isq ? QSCALE : 1.f;
#pragma unroll
    for (int k = 0; k < 3; ++k) {
      uint4 o;
      o.x = pack2(v[k][0] * sc, v[k][1] * sc); o.y = pack2(v[k][2] * sc, v[k][3] * sc);
      o.z = pack2(v[k][4] * sc, v[k][5] * sc); o.w = pack2(v[k][6] * sc, v[k][7] * sc);
      *(uint4*)(base + 8 * (l8 + 8 * k)) = o;
    }
  }
}

DI void attn_item(const Params& p, int kind, int seq, int h, int q0, char* smem) {
  const int tid = TIDX(), lane = tid & 63, wid = tid >> 6;
  const int il = lane & 31, hh = lane >> 5;
  const u16* Q = (const u16*)(p.ws + OFF_B + B_Q);
  const u16* Kb = (const u16*)(p.ws + OFF_B + B_K);
  const u16* Vt = (const u16*)(p.ws + OFF_B + B_V);
  u16* O = (u16*)(p.ws + OFF_A + A_O);
  const int Lk = kind ? 4352 : 256, nkt = Lk >> 6;
  const u16* vbase = Vt + (kind ? VT_SAMPLE_OFF + (size_t)(seq * 8 + h) * 128 * 4352 : (size_t)(seq * 8 + h) * 128 * 256);
  const int tq = q0 + wid * 32 + il;
  bf16x8 qf[12];
#pragma unroll
  for (int ks = 0; ks < 12; ++ks) qf[ks] = *(const bf16x8*)(Q + ((size_t)tq * 8 + h) * 192 + 16 * ks + 8 * hh);
  f32x16 oacc[4];
#pragma unroll
  for (int a = 0; a < 4; ++a)
#pragma unroll
    for (int r = 0; r < 16; ++r) oacc[a][r] = 0.f;
  float mrun = -INFINITY, lrun = 0.f;
  const int sw = (il >> 1) & 7;
  int ko[4], vo[8];
#pragma unroll
  for (int a = 0; a < 4; ++a) ko[a] = il * 384 + (((2 * a + hh) ^ sw) << 4);
#pragma unroll
  for (int c = 0; c < 8; ++c) vo[c] = il * 128 + 8 * hh + ((c ^ sw) << 4);
  uint4 rk[3], rv[2];
  auto gload = [&](int kt) {
    const int k0 = kt * 64;
    const int rowbase = kind ? (k0 < 4096 ? TP + seq * 4096 + k0 : T + seq * 256 + (k0 - 4096)) : seq * 256 + k0;
#pragma unroll
    for (int i = 0; i < 3; ++i) {
      const int id = tid + 512 * i, r = id / 24, ch = id - r * 24;
      rk[i] = *(const uint4*)(Kb + ((size_t)(rowbase + r) * 8 + h) * 192 + ch * 8);
    }
#pragma unroll
    for (int i = 0; i < 2; ++i) {
      const int id = tid + 512 * i, dd = id >> 3, ch = id & 7;
      rv[i] = *(const uint4*)(vbase + (size_t)dd * Lk + k0 + ch * 8);
    }
  };
  auto sstore = [&](int s) {
    char* ks_ = smem + s * 40960;
#pragma unroll
    for (int i = 0; i < 3; ++i) {
      const int id = tid + 512 * i, r = id / 24, ch = id - r * 24;
      *(uint4*)(ks_ + r * 384 + (((ch & ~7) | ((ch & 7) ^ ((r >> 1) & 7))) << 4)) = rk[i];
    }
#pragma unroll
    for (int i = 0; i < 2; ++i) {
      const int id = tid + 512 * i, dd = id >> 3, ch = id & 7;
      *(uint4*)(ks_ + 24576 + dd * 128 + ((ch ^ ((dd >> 1) & 7)) << 4)) = rv[i];
    }
  };
  __syncthreads();
  gload(0); sstore(0);
  __syncthreads();
  for (int kt = 0; kt < nkt; ++kt) {
    const bool more = kt + 1 < nkt;
    if (more) gload(kt + 1);
    const char* Ks = smem + (kt & 1) * 40960;
    const char* Vs = Ks + 24576;
#pragma unroll
    for (int st = 0; st < 2; ++st) {
      f32x16 s;
#pragma unroll
      for (int r = 0; r < 16; ++r) s[r] = 0.f;
#pragma unroll
      for (int ks = 0; ks < 12; ++ks) {
        const bf16x8 kf = *(const bf16x8*)(Ks + ko[ks & 3] + st * 12288 + (ks >> 2) * 128);
        s = __builtin_amdgcn_mfma_f32_32x32x16_bf16(kf, qf[ks], s, 0, 0, 0);
      }
      float mx = s[0];
#pragma unroll
      for (int r = 1; r < 16; ++r) mx = fmaxf(mx, s[r]);
      mx = fmaxf(mx, __shfl_xor(mx, 32));
      const float mnew = fmaxf(mrun, mx);
      const float alpha = __builtin_amdgcn_exp2f(mrun - mnew);
      mrun = mnew;
      float psum = 0.f;
#pragma unroll
      for (int r = 0; r < 16; ++r) { const float pv = __builtin_amdgcn_exp2f(s[r] - mnew); s[r] = pv; psum += pv; }
      lrun = lrun * alpha + psum;
#pragma unroll
      for (int a = 0; a < 4; ++a)
#pragma unroll
        for (int r = 0; r < 16; ++r) oacc[a][r] *= alpha;
#pragma unroll
      for (int sb = 0; sb < 2; ++sb) {
        union { bf16x8 v; unsigned w[4]; } pb;
#pragma unroll
        for (int w = 0; w < 4; ++w) pb.w[w] = pack2(s[8 * sb + 2 * w], s[8 * sb + 2 * w + 1]);
        const int c1 = 4 * st + 2 * sb;
#pragma unroll
        for (int dt = 0; dt < 4; ++dt) {
          union { bf16x8 v; uint2 h2[2]; } vf;
          vf.h2[0] = *(const uint2*)(Vs + vo[c1] + dt * 4096);
          vf.h2[1] = *(const uint2*)(Vs + vo[c1 + 1] + dt * 4096);
          oacc[dt] = __builtin_amdgcn_mfma_f32_32x32x16_bf16(vf.v, pb.v, oacc[dt], 0, 0, 0);
        }
      }
    }
    if (more) sstore((kt + 1) & 1);
    __syncthreads();
  }
  const float ltot = lrun + __shfl_xor(lrun, 32);
  const float inv = 1.f / ltot;
#pragma unroll
  for (int dt = 0; dt < 4; ++dt)
#pragma unroll
    for (int g = 0; g < 4; ++g) {
      const int d = dt * 32 + 8 * g + 4 * hh;
      *(uint2*)(O + (size_t)tq * 1024 + h * 128 + d) =
          pack4(oacc[dt][4 * g] * inv, oacc[dt][4 * g + 1] * inv, oacc[dt][4 * g + 2] * inv, oacc[dt][4 * g + 3] * inv);
    }
}
DI void phase_attention(const Params& p, char* smem) {
  const bool xmap = gridDim.x == 256;
  const int nit = xmap ? 5 : (1280 + (int)gridDim.x - 1) / (int)gridDim.x;
#pragma unroll 1
  for (int r = 0; r < nit; ++r) {
    int kind, seq, h, q0;
    if (xmap) {
      if (r < 4) {
        const int xcd = blockIdx.x & 7, slot = blockIdx.x >> 3;
        const int pair = xcd + 8 * (2 * r + (slot >> 4)), qb = slot & 15;
        kind = 1; seq = pair >> 3; h = pair & 7; q0 = TP + seq * 4096 + qb * 256;
      } else {
        kind = 0; seq = blockIdx.x >> 3; h = blockIdx.x & 7; q0 = seq * 256;
      }
    } else {
      const int it = blockIdx.x + r * gridDim.x;
      if (it >= 1280) break;
      if (it < 1024) { const int pair = it >> 4, qb = it & 15; kind = 1; seq = pair >> 3; h = pair & 7; q0 = TP + seq * 4096 + qb * 256; }
      else { const int i2 = it - 1024; kind = 0; seq = i2 >> 3; h = i2 & 7; q0 = seq * 256; }
    }
    attn_item(p, kind, seq, h, q0, smem);
  }
  __syncthreads();
}

DI void phase_ffn_up(const Params& p, int l, char* smem) {
  const int tid = TIDX();
  const u16* H = (const u16*)(p.ws + OFF_A + A_H);
  const u16* W = (const u16*)(p.ws + OFF_WUP);
  u16* ACT = (u16*)(p.ws + OFF_B + B_ACT);
  float* EDGE = (float*)(p.ws + OFF_EDGE);
  const float* cw = p.in[33] + (size_t)l * 3 * 5632;
  const float* cb = p.in[34] + (size_t)l * 5632;
  float* E = (float*)smem;
  for_tiles(160, 44, 8, 4, [=](int tm, int tn) {
    const int m0 = tm * 256, n0 = tn * 128;
    auto epi = [=](int m, int n, f32x4 v) { *(f32x4*)(E + (m - m0) * 132 + (n - n0)) = v; };
    gemm_tile<true>(H, 1024, W, 1024, 1024, m0, n0, smem, epi);
    __syncthreads();
    {
      const int ri = tid >> 7, c = tid & 127;
      const int r = ri == 0 ? 0 : ri == 1 ? 1 : ri == 2 ? 254 : 255;
      EDGE[((size_t)tm * 4 + ri) * 5632 + n0 + c] = E[r * 132 + c];
    }
    const bool seq_start = m0 < TP || ((m0 - TP) & 4095) == 0;
    const bool seq_end = m0 < TP || ((m0 - TP) & 4095) == 4096 - 256;
    const int c4 = (tid & 15) * 4, a = tn * 64 + c4;
    const float4 wg0 = *(const float4*)(cw + a), wg1 = *(const float4*)(cw + 5632 + a), wg2 = *(const float4*)(cw + 11264 + a), bg = *(const float4*)(cb + a);
    const float4 wu0 = *(const float4*)(cw + 2816 + a), wu1 = *(const float4*)(cw + 5632 + 2816 + a), wu2 = *(const float4*)(cw + 11264 + 2816 + a), bu = *(const float4*)(cb + 2816 + a);
#pragma unroll 2
    for (int i = 0; i < 8; ++i) {
      const int r = (tid >> 4) + 32 * i;
      if ((r == 0 && !seq_start) || (r == 255 && !seq_end)) continue;
      const float4 z4 = make_float4(0.f, 0.f, 0.f, 0.f);
      const float4 gm = r > 0 ? *(const float4*)(E + (r - 1) * 132 + c4) : z4;
      const float4 gc = *(const float4*)(E + r * 132 + c4);
      const float4 gp = r < 255 ? *(const float4*)(E + (r + 1) * 132 + c4) : z4;
      const float4 um = r > 0 ? *(const float4*)(E + (r - 1) * 132 + 64 + c4) : z4;
      const float4 uc = *(const float4*)(E + r * 132 + 64 + c4);
      const float4 up = r < 255 ? *(const float4*)(E + (r + 1) * 132 + 64 + c4) : z4;
      const float g0 = wg0.x * gm.x + wg1.x * gc.x + wg2.x * gp.x + bg.x, u0 = wu0.x * um.x + wu1.x * uc.x + wu2.x * up.x + bu.x;
      const float g1 = wg0.y * gm.y + wg1.y * gc.y + wg2.y * gp.y + bg.y, u1 = wu0.y * um.y + wu1.y * uc.y + wu2.y * up.y + bu.y;
      const float g2 = wg0.z * gm.z + wg1.z * gc.z + wg2.z * gp.z + bg.z, u2 = wu0.z * um.z + wu1.z * uc.z + wu2.z * up.z + bu.z;
      const float g3 = wg0.w * gm.w + wg1.w * gc.w + wg2.w * gp.w + bg.w, u3 = wu0.w * um.w + wu1.w * uc.w + wu2.w * up.w + bu.w;
      *(uint2*)(ACT + (size_t)(m0 + r) * 2816 + a) = pack4(silu(g0) * u0, silu(g1) * u1, silu(g2) * u2, silu(g3) * u3);
    }
    __syncthreads();
  });
}
DI void phase_ffn_fix(const Params& p, int l) {
  const float* EDGE = (const float*)(p.ws + OFF_EDGE);
  u16* ACT = (u16*)(p.ws + OFF_B + B_ACT);
  const float* cw = p.in[33] + (size_t)l * 3 * 5632;
  const float* cb = p.in[34] + (size_t)l * 5632;
  const long gtid = (long)blockIdx.x * blockDim.x + TIDX(), gsz = (long)gridDim.x * blockDim.x;
  for (long idx = gtid; idx < (long)128 * 2 * 2816; idx += gsz) {
    const int a = (int)(idx % 2816), rr = (int)(idx / 2816), which = rr & 1, tm = 32 + (rr >> 1);
    const int pos = (tm - 32) & 15;
    if ((which == 0 && pos == 0) || (which == 1 && pos == 15)) continue;
    const int pc = (a >> 6) * 128 + (a & 63);
    const float *pr, *cu, *nx;
    if (which == 0) { pr = EDGE + ((size_t)(tm - 1) * 4 + 3) * 5632; cu = EDGE + ((size_t)tm * 4 + 0) * 5632; nx = EDGE + ((size_t)tm * 4 + 1) * 5632; }
    else { pr = EDGE + ((size_t)tm * 4 + 2) * 5632; cu = EDGE + ((size_t)tm * 4 + 3) * 5632; nx = EDGE + ((size_t)(tm + 1) * 4 + 0) * 5632; }
    const float g = cw[a] * pr[pc] + cw[5632 + a] * cu[pc] + cw[11264 + a] * nx[pc] + cb[a];
    const float uu = cw[2816 + a] * pr[pc + 64] + cw[5632 + 2816 + a] * cu[pc + 64] + cw[11264 + 2816 + a] * nx[pc + 64] + cb[2816 + a];
    const int t = tm * 256 + (which ? 255 : 0);
    ACT[(size_t)t * 2816 + a] = f2bf(silu(g) * uu);
  }
}

#ifndef PH
#define RUN(k, ...) __VA_ARGS__
#else
#define RUN(k, ...) if (PH == k) { __VA_ARGS__ }
#endif
extern "C" __global__ void __launch_bounds__(512) fwd_megakernel(Params p) {
  extern __shared__ __attribute__((aligned(16))) char smem[];
  cg::grid_group grid = cg::this_grid();
  RUN(0, phase_prep(p, smem);)
  grid.sync();
  RUN(1, phase_filters(p, smem);)
  for (int l = 0; l < 4; ++l) {
    const int i = l >> 1;
    RUN(2, phase_norm(p, l, 0, l);)
    RUN(0, if (l > 0) { int base = 0; convert_ffn_weights(p, l, smem, base); })
    grid.sync();
    if ((l & 1) == 0) {
      RUN(3, phase_mix_in(p, i, smem);)
      grid.sync();
      RUN(4, phase_sgu(p, i, smem);)
      RUN(5, phase_conv(p, i, 0, smem);)
      grid.sync();
      RUN(5, phase_conv(p, i, 1, smem);)
      grid.sync();
      RUN(6, phase_ztrans(p, smem);)
      grid.sync();
      RUN(7, phase_resid_gemm(p, l, l, (const u16*)(p.ws + OFF_B + B_MIX), 1024, (const u16*)(p.ws + OFF_WMIXOUT) + (size_t)i * 1024 * 1024, 2048, smem);)
      grid.sync();
    } else {
      RUN(8, phase_dqkv(p, i, smem);)
      grid.sync();
      RUN(9, phase_mla_norms(p, i);)
      grid.sync();
      RUN(10, phase_uq_ukv(p, i, smem);)
      grid.sync();
      RUN(11, phase_finalize(p, i);)
      grid.sync();
      RUN(12, phase_attention(p, smem);)
      grid.sync();
      RUN(7, phase_resid_gemm(p, l, l, (const u16*)(p.ws + OFF_A + A_O), 1024, (const u16*)(p.ws + OFF_WO) + (size_t)i * 1024 * 1024, 2048, smem);)
      grid.sync();
    }
    RUN(2, phase_norm(p, l, 1, 1);)
    grid.sync();
    RUN(13, phase_ffn_up(p, l, smem);)
    grid.sync();
    RUN(14, phase_ffn_fix(p, l);)
    grid.sync();
    RUN(7, phase_resid_gemm(p, l, 1, (const u16*)(p.ws + OFF_B + B_ACT), 2816, (const u16*)(p.ws + OFF_WDOWN), 5120, smem);)
    grid.sync();
  }
}

extern "C" void kernel_launch(void* const* d_in, const int* in_sizes, int n_in,
                              void* d_out, int out_size, void* d_ws, size_t ws_size,
                              hipStream_t stream) {
  static int grid_blocks = 0;
  if (!grid_blocks) {
    int dev = 0, cus = 0, per_cu = 0;
    (void)hipGetDevice(&dev);
    (void)hipDeviceGetAttribute(&cus, hipDeviceAttributeMultiprocessorCount, dev);
    (void)hipFuncSetAttribute((const void*)fwd_megakernel, hipFuncAttributeMaxDynamicSharedMemorySize, (int)LDS_BYTES);
    (void)hipOccupancyMaxActiveBlocksPerMultiprocessor(&per_cu, fwd_megakernel, 512, LDS_BYTES);
    if (per_cu < 1) per_cu = 1;
    if (per_cu > 1) per_cu = 1;
    grid_blocks = cus * per_cu;
  }
  if (ws_size < WS_NEED) fprintf(stderr, "workspace too small: %zu < %zu\n", ws_size, (size_t)WS_NEED);
  Params p{};
  for (int i = 0; i < 36; ++i) p.in[i] = (const float*)d_in[i];
  p.out = (float*)d_out;
  p.ws = (char*)d_ws;
  void* args[] = {&p};
  hipError_t e = hipLaunchCooperativeKernel((void*)fwd_megakernel, dim3(grid_blocks), dim3(512), args, LDS_BYTES, stream);
  if (e != hipSuccess) fprintf(stderr, "cooperative launch failed: %s (grid %d)\n", hipGetErrorString(e), grid_blocks);
}
```

```cpp
#include <hip/hip_runtime.h>
#include <hip/hip_cooperative_groups.h>
#include <cstdio>
namespace cg = cooperative_groups;

typedef unsigned short u16;
using bf16x8 = __attribute__((ext_vector_type(8))) short;
using f32x4 = __attribute__((ext_vector_type(4))) float;
using f32x16 = __attribute__((ext_vector_type(16))) float;
#define DI __device__ __forceinline__

constexpr int T = 40960;
constexpr int TP = 8192;
constexpr int TK = 43008;
constexpr float EPS = 1e-6f;
constexpr size_t LDS_BYTES = 139264;

constexpr size_t OFF_WMIXIN = 0;
constexpr size_t OFF_WMIXOUT = OFF_WMIXIN + (size_t)2 * 2560 * 1024 * 2;
constexpr size_t OFF_WDQKV = OFF_WMIXOUT + (size_t)2 * 1024 * 1024 * 2;
constexpr size_t OFF_WUQ = OFF_WDQKV + (size_t)2 * 1024 * 1024 * 2;
constexpr size_t OFF_WUKV = OFF_WUQ + (size_t)2 * 1536 * 512 * 2;
constexpr size_t OFF_WO = OFF_WUKV + (size_t)2 * 2048 * 256 * 2;
constexpr size_t OFF_WSGU = OFF_WO + (size_t)2 * 1024 * 1024 * 2;
constexpr size_t OFF_WUP = OFF_WSGU + (size_t)2 * 4 * 128 * 128 * 2;
constexpr size_t OFF_WDOWN = OFF_WUP + (size_t)5632 * 1024 * 2;
constexpr size_t OFF_MOD = OFF_WDOWN + (size_t)1024 * 2816 * 2;
constexpr size_t OFF_FILT = OFF_MOD + (size_t)4 * 9 * 6144 * 4;
constexpr size_t OFF_H2 = OFF_FILT + (size_t)2 * 2 * 512 * 4352 * 2;
constexpr size_t OFF_EDGE = OFF_H2 + (size_t)2 * 4352 * 64 * 4;
constexpr size_t OFF_KR = OFF_EDGE + (size_t)640 * 4 * 5632 * 2;
constexpr size_t OFF_A = OFF_KR + (size_t)TK * 64 * 2;
constexpr size_t OFF_B = OFF_A + (size_t)T * 1024 * 2;
constexpr size_t OFF_BAR = OFF_B + (size_t)346030080;
constexpr size_t WS_NEED = OFF_BAR + 256;
constexpr size_t A_H = 0, A_Z1 = 0, A_Z2 = (size_t)T * 512 * 2, A_QN = 0, A_CKV = (size_t)T * 512 * 2, A_O = 0;
constexpr size_t B_VT = 0, B_PRT = (size_t)T * 512 * 2, B_MIX = B_PRT + (size_t)T * 1536 * 2;
constexpr size_t B_DQKV = 0, B_Q = 0, B_K = (size_t)T * 1536 * 2, B_V = B_K + (size_t)TK * 1536 * 2;
constexpr size_t B_ACT = 0;
constexpr size_t VT_SAMPLE_OFF = (size_t)32 * 8 * 128 * 256;

struct Params {
  const float* in[36];
  float* out;
  char* ws;
};


constexpr int PARM_OFF = 138240;
struct PV {
  char* smem;
  DI unsigned long long ld(int k) const {
    int off = PARM_OFF + 8 * k;
    asm volatile("" : "+v"(off));
    const unsigned long long v = *(const unsigned long long*)(smem + off);
    const unsigned lo = __builtin_amdgcn_readfirstlane((unsigned)v), hi = __builtin_amdgcn_readfirstlane((unsigned)(v >> 32));
    return ((unsigned long long)hi << 32) | lo;
  }
  DI const float* in(int k) const { return (const float*)(const __attribute__((address_space(1))) float*)ld(k); }
  DI float* out() const { return (float*)(__attribute__((address_space(1))) float*)ld(36); }
  DI char* ws() const { return (char*)(__attribute__((address_space(1))) char*)ld(37); }
};

DI int TIDX() { int t = (int)__builtin_amdgcn_workitem_id_x(); asm volatile("" : "+v"(t)); return t; }
DI u16 f2bf(float x) { unsigned u = __float_as_uint(x); u += 0x7fffu + ((u >> 16) & 1u); return (u16)(u >> 16); }
DI float bf2f(u16 h) { return __uint_as_float(((unsigned)h) << 16); }
DI unsigned pack2(float a, float b) { return (unsigned)f2bf(a) | ((unsigned)f2bf(b) << 16); }
DI uint2 pack4(float a, float b, float c, float d) { uint2 r; r.x = pack2(a, b); r.y = pack2(c, d); return r; }
DI float lo16(unsigned w) { return __uint_as_float(w << 16); }
DI float hi16(unsigned w) { return __uint_as_float(w & 0xffff0000u); }
DI float gelu_tanh(float x) { float y = 0.7978845608f * (x + 0.044715f * x * x * x); return x / (1.f + __expf(-2.f * y)); }
DI float silu(float x) { return x / (1.f + __expf(-x)); }
DI int condrow(int m) { return m < TP ? 0 : 1 + ((m - TP) >> 12); }
template <int MASK> DI float shx(float v, int lane) {
  if (MASK == 32) return __int_as_float(__builtin_amdgcn_ds_bpermute((lane ^ 32) << 2, __float_as_int(v)));
  return __int_as_float(__builtin_amdgcn_ds_swizzle(__float_as_int(v), (MASK << 10) | 0x1f));
}
DI float wave_sum(float v, int lane) {
  v += shx<32>(v, lane); v += shx<16>(v, lane); v += shx<8>(v, lane);
  v += shx<4>(v, lane); v += shx<2>(v, lane); v += shx<1>(v, lane); return v;
}
DI int opaque_i(int x) { asm volatile("" : "+s"(x)); return x; }
DI int first_unit(int base) { const int G = opaque_i((int)gridDim.x); int r = (int)blockIdx.x - (base % G); if (r < 0) r += G; return r; }
DI const float* xin_row(const PV& p, int l, int m) {
  if (l == 0) return m < TP ? p.in(0) + (size_t)m * 1024 : p.in(1) + (size_t)(m - TP) * 1024;
  return p.out() + (size_t)m * 1024;
}


DI void grid_barrier(unsigned* bar, unsigned& bar_no) {
  asm volatile("s_waitcnt vmcnt(0)" ::: "memory");
  __syncthreads();
  ++bar_no;
  if (TIDX() == 0) {
    __builtin_amdgcn_fence(__ATOMIC_RELEASE, "agent");
    asm volatile("s_waitcnt vmcnt(0)" ::: "memory");
    const unsigned target = bar_no * gridDim.x;
    __hip_atomic_fetch_add(bar, 1u, __ATOMIC_RELAXED, __HIP_MEMORY_SCOPE_AGENT);
    while (__hip_atomic_load(bar, __ATOMIC_RELAXED, __HIP_MEMORY_SCOPE_AGENT) < target) __builtin_amdgcn_s_sleep(1);
    __builtin_amdgcn_fence(__ATOMIC_ACQUIRE, "agent");
    asm volatile("s_waitcnt vmcnt(0)" ::: "memory");
  }
  __syncthreads();
}

template <int MODE>
DI int rowmap(int n, int row0) {
  if (MODE == 0) return n + row0;
  return n < 2816 ? (n >> 7) * 256 + (n & 127) : ((n - 2816) >> 7) * 256 + 128 + ((n - 2816) & 127);
}
template <int MODE>
DI void convT(const float* __restrict__ src, u16* __restrict__ dst, int K, int N, int row0, char* smem, int& base) {
  u16* tl = (u16*)smem;
  const int tid = TIDX();
  const int nN = N >> 6, nunits = (K >> 6) * nN;
  for (int u = first_unit(base); u < nunits; u += gridDim.x) {
    const int k0 = (u / nN) << 6, n0 = (u % nN) << 6;
#pragma unroll
    for (int i = 0; i < 2; ++i) {
      const int r = (tid >> 4) + 32 * i, c4 = (tid & 15) * 4;
      const float4 v = *(const float4*)(src + (size_t)(k0 + r) * N + n0 + c4);
      tl[(c4 + 0) * 72 + r] = f2bf(v.x); tl[(c4 + 1) * 72 + r] = f2bf(v.y);
      tl[(c4 + 2) * 72 + r] = f2bf(v.z); tl[(c4 + 3) * 72 + r] = f2bf(v.w);
    }
    __syncthreads();
    {
      const int n = tid >> 3, kc = (tid & 7) * 8;
      const uint4 v = *(const uint4*)(tl + n * 72 + kc);
      *(uint4*)(dst + (size_t)rowmap<MODE>(n0 + n, row0) * K + k0 + kc) = v;
    }
    __syncthreads();
  }
  base += nunits;
}

DI void convert_ffn_weights(const PV& p, int l, char* smem, int& base) {
  convT<1>(p.in(32) + (size_t)l * 1024 * 5632, (u16*)(p.ws() + OFF_WUP), 1024, 5632, 0, smem, base);
  convT<0>(p.in(35) + (size_t)l * 2816 * 1024, (u16*)(p.ws() + OFF_WDOWN), 2816, 1024, 0, smem, base);
}

DI void phase_prep(const PV& p, char* smem) {
  const int tid = TIDX();
  int base = 0;
  char* ws = p.ws();
  for (int i = 0; i < 2; ++i) {
    convT<0>(p.in(9) + (size_t)i * 1024 * 2560, (u16*)(ws + OFF_WMIXIN) + (size_t)i * 2560 * 1024, 1024, 2560, 0, smem, base);
    convT<0>(p.in(22) + (size_t)i * 1024 * 1024, (u16*)(ws + OFF_WMIXOUT) + (size_t)i * 1024 * 1024, 1024, 1024, 0, smem, base);
    convT<0>(p.in(23) + (size_t)i * 1024 * 512, (u16*)(ws + OFF_WDQKV) + (size_t)i * 1024 * 1024, 1024, 512, 0, smem, base);
    convT<0>(p.in(26) + (size_t)i * 1024 * 320, (u16*)(ws + OFF_WDQKV) + (size_t)i * 1024 * 1024, 1024, 320, 512, smem, base);
    convT<0>(p.in(25) + (size_t)i * 512 * 1536, (u16*)(ws + OFF_WUQ) + (size_t)i * 1536 * 512, 512, 1536, 0, smem, base);
    convT<0>(p.in(28) + (size_t)i * 256 * 2048, (u16*)(ws + OFF_WUKV) + (size_t)i * 2048 * 256, 256, 2048, 0, smem, base);
    convT<0>(p.in(31) + (size_t)i * 1024 * 1024, (u16*)(ws + OFF_WO) + (size_t)i * 1024 * 1024, 1024, 1024, 0, smem, base);
  }
  convert_ffn_weights(p, 0, smem, base);
  {
    const long gtid = (long)blockIdx.x * blockDim.x + tid, gsz = (long)gridDim.x * blockDim.x;
    for (long i = gtid; i < 2 * 192 * 1024; i += gsz) {
      const int j = (int)(i / (192 * 1024)), r = (int)(i % (192 * 1024));
      ((u16*)(ws + OFF_WDQKV))[(size_t)j * 1024 * 1024 + (size_t)832 * 1024 + r] = 0;
    }
    for (long i = gtid; i < 2 * 4 * 128 * 128; i += gsz) ((u16*)(ws + OFF_WSGU))[i] = f2bf(p.in(10)[i]);
  }
  {
    float* sc = (float*)smem;
    float* part = sc + 9 * 1024;
    __syncthreads();
    for (int i = tid; i < 9 * 1024; i += 512) {
      const int r = i >> 10, k = i & 1023;
      const float c = r == 0 ? p.in(5)[k] : p.in(4)[(r - 1) * 1024 + k];
      sc[i] = silu(c);
    }
    __syncthreads();
    float* MOD = (float*)(ws + OFF_MOD);
    const int nunits = 4 * 96;
    for (int u = first_unit(base); u < nunits; u += gridDim.x) {
      const int l = u / 96, n0 = (u % 96) * 64;
      const int col = n0 + (tid & 63), kg = tid >> 6;
      float acc[9];
#pragma unroll
      for (int r = 0; r < 9; ++r) acc[r] = 0.f;
      const float* w = p.in(6) + (size_t)l * 1024 * 6144 + col;
#pragma unroll 4
      for (int k = kg * 128; k < kg * 128 + 128; ++k) {
        const float wv = w[(size_t)k * 6144];
#pragma unroll
        for (int r = 0; r < 9; ++r) acc[r] += sc[r * 1024 + k] * wv;
      }
#pragma unroll
      for (int r = 0; r < 9; ++r) part[(kg * 9 + r) * 64 + (tid & 63)] = acc[r];
      __syncthreads();
      for (int i = tid; i < 576; i += 512) {
        const int r = i >> 6, cc = i & 63;
        float s = p.in(7)[l * 6144 + n0 + cc];
#pragma unroll
        for (int g = 0; g < 8; ++g) s += part[(g * 9 + r) * 64 + cc];
        MOD[(size_t)(l * 9 + r) * 6144 + n0 + cc] = s;
      }
      __syncthreads();
    }
    base += nunits;
  }
  {
    float* zf = (float*)smem;
    float* h1 = zf + 8 * 36;
    float* H2 = (float*)(ws + OFF_H2);
    const int nunits = 2 * 544;
    for (int u = first_unit(base); u < nunits; u += gridDim.x) {
      const int i = u / 544, tg0 = (u % 544) * 8;
      __syncthreads();
      if (tid < 8 * 33) {
        const int tt = tid / 33, e = tid % 33;
        const int tg = tg0 + tt;
        const float L = tg < 256 ? 256.f : 4096.f;
        const float t = tg < 256 ? (float)tg : (float)(tg - 256);
        const float tn = t / L;
        float v;
        if (e == 0) v = tn;
        else if (e <= 16) v = sinf((6.283185307179586f * tn) * (float)e);
        else v = cosf((6.283185307179586f * tn) * (float)(e - 16));
        zf[tt * 36 + e] = v;
      }
      __syncthreads();
      const int tt = tid >> 6, jj = tid & 63;
      const float fr = p.in(19)[i * 64 + jj];
      {
        float a = p.in(15)[i * 64 + jj];
        const float* w1 = p.in(14) + (size_t)i * 33 * 64 + jj;
        for (int e = 0; e < 33; ++e) a += zf[tt * 36 + e] * w1[e * 64];
        h1[tt * 64 + jj] = sinf(fr * a);
      }
      __syncthreads();
      {
        float a = p.in(17)[i * 64 + jj];
        const float* w2 = p.in(16) + (size_t)i * 64 * 64 + jj;
        for (int e = 0; e < 64; ++e) a += h1[tt * 64 + e] * w2[e * 64];
        H2[((size_t)i * 4352 + tg0 + tt) * 64 + jj] = sinf(fr * a);
      }
    }
    base += nunits;
    __syncthreads();
  }
}

DI void phase_filters(const PV& p, char* smem) {
  const int tid = TIDX();
  float* w3s = (float*)smem;
  float* red = w3s + 512;
  float* nrm = red + 512;
  float* hbuf = nrm + 8;
  const float* H2 = (const float*)(p.ws() + OFF_H2);
  u16* FILT = (u16*)(p.ws() + OFF_FILT);
  for (int u = blockIdx.x; u < 512; u += gridDim.x) {
    const int kind = (u >> 7) & 1, i = u >> 8, cg8 = (u & 127) * 8;
    const int L = kind ? 4096 : 256, tbase = kind ? 256 : 0;
    __syncthreads();
    { const int j = tid >> 3, cc = tid & 7; w3s[j * 8 + cc] = p.in(18)[((size_t)i * 64 + j) * 1024 + cg8 + cc]; }
    __syncthreads();
    const int cc = tid & 7, tq = tid >> 3;
    const int col = cg8 + cc, o = col >> 9, c = col & 511;
    const float dec = fabsf(p.in(20)[(i * 2 + o) * 512 + c]);
    float asum = 0.f;
    for (int t = tq; t < L; t += 64) {
      const float4* hr = (const float4*)(H2 + ((size_t)i * 4352 + tbase + t) * 64);
      float a = 0.f;
#pragma unroll
      for (int j4 = 0; j4 < 16; ++j4) {
        const float4 hv = hr[j4];
        a += hv.x * w3s[(j4 * 4 + 0) * 8 + cc]; a += hv.y * w3s[(j4 * 4 + 1) * 8 + cc];
        a += hv.z * w3s[(j4 * 4 + 2) * 8 + cc]; a += hv.w * w3s[(j4 * 4 + 3) * 8 + cc];
      }
      const float dist = fabsf((float)(t - L / 2)) / (float)L;
      a *= expf(-dec * dist);
      hbuf[cc * L + t] = a;
      asum += fabsf(a);
    }
    red[tid] = asum;
    __syncthreads();
    if (tid < 8) { float s = 0.f; for (int q = 0; q < 64; ++q) s += red[q * 8 + tid]; nrm[tid] = 1.f / (s + EPS); }
    __syncthreads();
    for (int idx = tid; idx < 8 * L; idx += 512) {
      const int c2 = idx / L, t = idx - c2 * L;
      const int col2 = cg8 + c2, o2 = col2 >> 9, cch = col2 & 511;
      FILT[((size_t)(i * 2 + o2) * 512 + cch) * 4352 + tbase + t] = f2bf(hbuf[c2 * L + t] * nrm[c2]);
    }
  }
  __syncthreads();
}

DI void phase_norm(const PV& p, int l, int part, int lx) {
  const int tid_ = TIDX(); const int lane = tid_ & 63, wid = tid_ >> 6;
  const float* MOD = (const float*)(p.ws() + OFF_MOD);
  const float* g = p.in(8) + (size_t)(l * 2 + part) * 1024;
  u16* H = (u16*)(p.ws() + OFF_A + A_H);
  for (int row = blockIdx.x * 8 + wid; row < T; row += gridDim.x * 8) {
    const float* xr = xin_row(p, lx, row);
    float4 v[4];
    float ss = 0.f;
#pragma unroll
    for (int i = 0; i < 4; ++i) {
      v[i] = *(const float4*)(xr + (i * 64 + lane) * 4);
      ss += v[i].x * v[i].x + v[i].y * v[i].y + v[i].z * v[i].z + v[i].w * v[i].w;
    }
    ss = wave_sum(ss, lane);
    const float r = rsqrtf(ss * (1.f / 1024.f) + EPS);
    const float* mr = MOD + (size_t)(l * 9 + condrow(row)) * 6144 + part * 3072;
#pragma unroll
    for (int i = 0; i < 4; ++i) {
      const int k = (i * 64 + lane) * 4;
      const float4 gv = *(const float4*)(g + k), sh = *(const float4*)(mr + k), sc = *(const float4*)(mr + 1024 + k);
      const float a = v[i].x * r * gv.x * (1.f + sc.x) + sh.x;
      const float b = v[i].y * r * gv.y * (1.f + sc.y) + sh.y;
      const float c = v[i].z * r * gv.z * (1.f + sc.z) + sh.z;
      const float d = v[i].w * r * gv.w * (1.f + sc.w) + sh.w;
      *(uint2*)(H + (size_t)row * 1024 + k) = pack4(a, b, c, d);
    }
  }
}

template <bool SWAP, class Epi>
DI void gemm_tile(const u16* A, int lda, const u16* Bt, int ldb, int K, int m0, int n0, char* smem, Epi epi) {
  const int tid = TIDX(), lane = tid & 63, wid = tid >> 6;
  const int wm = wid >> 1, wn = wid & 1, fr = lane & 15, fq = lane >> 4;
  const int lrow = tid >> 3, kc = tid & 7;
  const u16* ga = A + (size_t)(m0 + lrow) * lda + kc * 8;
  const u16* gb = Bt + (size_t)(n0 + lrow) * ldb + kc * 8;
  const int soff = lrow * 128 + ((kc ^ (lrow & 7)) << 4);
  uint4 ra[4], rb[2];
  f32x4 acc[4][4];
#pragma unroll
  for (int i = 0; i < 4; ++i)
#pragma unroll
    for (int j = 0; j < 4; ++j) acc[i][j] = f32x4{0.f, 0.f, 0.f, 0.f};
  const int nk = K >> 6;
#pragma unroll
  for (int i = 0; i < 4; ++i) ra[i] = *(const uint4*)(ga + (size_t)(64 * i) * lda);
#pragma unroll
  for (int i = 0; i < 2; ++i) rb[i] = *(const uint4*)(gb + (size_t)(64 * i) * ldb);
#pragma unroll
  for (int i = 0; i < 4; ++i) *(uint4*)(smem + soff + i * 8192) = ra[i];
#pragma unroll
  for (int i = 0; i < 2; ++i) *(uint4*)(smem + 32768 + soff + i * 8192) = rb[i];
  __syncthreads();
  for (int kt = 0; kt < nk; ++kt) {
    const bool more = kt + 1 < nk;
    if (more) {
      const int k0 = (kt + 1) << 6;
#pragma unroll
      for (int i = 0; i < 4; ++i) ra[i] = *(const uint4*)(ga + (size_t)(64 * i) * lda + k0);
#pragma unroll
      for (int i = 0; i < 2; ++i) rb[i] = *(const uint4*)(gb + (size_t)(64 * i) * ldb + k0);
    }
    const char* sa = smem + (kt & 1) * 49152;
    const char* sb = sa + 32768;
#pragma unroll
    for (int ks = 0; ks < 2; ++ks) {
      bf16x8 af[4], bfv[4];
      const int co = ((ks * 4 + fq) ^ (fr & 7)) << 4;
#pragma unroll
      for (int mi = 0; mi < 4; ++mi) af[mi] = *(const bf16x8*)(sa + (wm * 64 + mi * 16 + fr) * 128 + co);
#pragma unroll
      for (int ni = 0; ni < 4; ++ni) bfv[ni] = *(const bf16x8*)(sb + (wn * 64 + ni * 16 + fr) * 128 + co);
#pragma unroll
      for (int mi = 0; mi < 4; ++mi)
#pragma unroll
        for (int ni = 0; ni < 4; ++ni)
          acc[mi][ni] = SWAP ? __builtin_amdgcn_mfma_f32_16x16x32_bf16(bfv[ni], af[mi], acc[mi][ni], 0, 0, 0)
                             : __builtin_amdgcn_mfma_f32_16x16x32_bf16(af[mi], bfv[ni], acc[mi][ni], 0, 0, 0);
    }
    if (more) {
      char* da = smem + ((kt + 1) & 1) * 49152;
#pragma unroll
      for (int i = 0; i < 4; ++i) *(uint4*)(da + soff + i * 8192) = ra[i];
#pragma unroll
      for (int i = 0; i < 2; ++i) *(uint4*)(da + 32768 + soff + i * 8192) = rb[i];
    }
    __syncthreads();
  }
#pragma unroll
  for (int mi = 0; mi < 4; ++mi)
#pragma unroll
    for (int ni = 0; ni < 4; ++ni) {
      if (SWAP) epi(m0 + wm * 64 + mi * 16 + fr, n0 + wn * 64 + ni * 16 + fq * 4, acc[mi][ni]);
      else epi(m0 + wm * 64 + mi * 16 + fq * 4, n0 + wn * 64 + ni * 16 + fr, acc[mi][ni]);
    }
}

template <class F>
DI void for_tiles(int nM, int nN, int sm, int sn, F f) {
  if (gridDim.x == 256) {
    const int xcd = blockIdx.x & 7, slot = blockIdx.x >> 3;
    const int am = slot % sm, bn = slot / sm;
    const int nSN = (nN + sn - 1) / sn, nS = (nM / sm) * nSN;
    for (int st = xcd; st < nS; st += 8) {
      const int tm = (st / nSN) * sm + am, tn = (st % nSN) * sn + bn;
      if (tn < nN) f(tm, tn);
    }
  } else {
    for (int t = blockIdx.x; t < nM * nN; t += gridDim.x) f(t / nN, t % nN);
  }
}


#define LAS __attribute__((address_space(3)))
constexpr int G8_HTB = 128 * 64 * 2;
DI int g8_lds_byte(int r, int c) { const int st = (r >> 4) * 2 + (c >> 5), rr = r & 15, cc = c & 31, ob = rr * 64 + cc * 2; return st * 1024 + (ob ^ (((ob >> 9) & 1) << 5)); }
DI void g8_stage_rc(int b, int& R, int& C) { const int st = b / 1024, sb = b % 1024, swz = sb ^ (((sb >> 9) & 1) << 5); R = (st >> 1) * 16 + swz / 64; C = (st & 1) * 32 + (swz % 64) / 2; }
struct TileSched {
  int nN, nSN, nS, sm, sn, am, bn, xcd, G, c, nT;
  DI void init(int nM, int nN_, int sm_, int sn_) {
    nN = nN_; sm = sm_; sn = sn_; nSN = nN_ / sn_; nS = (nM / sm_) * nSN; nT = nM * nN_;
    G = gridDim.x; c = blockIdx.x; xcd = c & 7; const int slot = c >> 3; am = slot % sm_; bn = slot / sm_;
  }
  DI bool next(int i, int& pm, int& pn) const {
    if (G == 256) { const int st = xcd + 8 * i; if (st >= nS) return false; pm = (st / nSN) * sm + am; pn = (st % nSN) * sn + bn; return true; }
    const int L = i * G + c; if (L >= nT) return false; pm = L / nN; pn = L % nN; return true;
  }
};
template <class Epi>
DI void gemm8(char* smem, const u16* A, const u16* Bt, int K, const TileSched& S, const Epi& E) {
  LAS unsigned char* lds = (LAS unsigned char*)smem;
  const int tid = TIDX(), wid = __builtin_amdgcn_readfirstlane(tid >> 6), lane = tid & 63, wr = wid >> 2, wc = wid & 3, fr = lane & 15, fq = lane >> 4;
  const int nt = K / 64;
  unsigned voff[2];
#pragma unroll
  for (int i = 0; i < 2; ++i) { int R, C; g8_stage_rc(tid * 16 + i * 8192, R, C); voff[i] = (unsigned)(R * K + C) * 2u; }
  const size_t kstep = 128, hstep = (size_t)128 * K * 2, tstep = 2 * hstep;
  const unsigned ldsw = (unsigned)wid * 1024u;
  const int aoff = g8_lds_byte(wr * 64 + fr, fq * 8), boff = g8_lds_byte(wc * 32 + fr, fq * 8);
#define G8_SA(b, h) (((b) * 2 + (h)) * G8_HTB)
#define G8_SB(b, h) ((4 + (b) * 2 + (h)) * G8_HTB)
#define G8_STAGE(bufoff, gbase) do { _Pragma("unroll") for (int _i = 0; _i < 2; ++_i) \
    __builtin_amdgcn_global_load_lds((const unsigned*)((const char*)(gbase) + voff[_i]), (LAS unsigned*)(lds + (bufoff) + ldsw + _i * 8192), 16, 0, 0); } while (0)
#define G8_LDA(dst, b, h) do { _Pragma("unroll") for (int m = 0; m < 4; ++m) _Pragma("unroll") for (int k = 0; k < 2; ++k) dst[m][k] = *(const LAS bf16x8*)(lds + G8_SA(b, h) + aoff + m * 2048 + k * 1024); } while (0)
#define G8_LDB(dst, b, h) do { _Pragma("unroll") for (int n = 0; n < 2; ++n) _Pragma("unroll") for (int k = 0; k < 2; ++k) dst[n][k] = *(const LAS bf16x8*)(lds + G8_SB(b, h) + boff + n * 2048 + k * 1024); } while (0)
#define G8_MMA(ai, bj, At_, Bt_) do { __builtin_amdgcn_s_setprio(1); _Pragma("unroll") for (int m = 0; m < 4; ++m) _Pragma("unroll") for (int n = 0; n < 2; ++n) _Pragma("unroll") for (int k = 0; k < 2; ++k) \
    acc[ai][bj][m][n] = __builtin_amdgcn_mfma_f32_16x16x32_bf16(Bt_[n][k], At_[m][k], acc[ai][bj][m][n], 0, 0, 0); __builtin_amdgcn_s_setprio(0); } while (0)
#define G8_WAIT_V(n) asm volatile("s_waitcnt vmcnt(" #n ")" ::: "memory")
#define G8_WAIT_L(n) asm volatile("s_waitcnt lgkmcnt(" #n ")" ::: "memory")
#define G8_BAR __builtin_amdgcn_s_barrier()
#define G8_SCHED __builtin_amdgcn_sched_barrier(0)
  int cpm, cpn, npm = 0, npn = 0, ui = 0;
  if (!S.next(0, cpm, cpn)) return;
  f32x4 acc[2][2][4][2];
#pragma unroll
  for (int a = 0; a < 2; ++a)
#pragma unroll
    for (int b = 0; b < 2; ++b)
#pragma unroll
      for (int m = 0; m < 4; ++m)
#pragma unroll
        for (int n = 0; n < 2; ++n) acc[a][b][m][n] = f32x4{0.f, 0.f, 0.f, 0.f};
  bf16x8 At[4][2], B0[2][2], B1[2][2];
  const char* cA = (const char*)A + (size_t)cpm * tstep; const char* cB = (const char*)Bt + (size_t)cpn * tstep;
  G8_STAGE(G8_SB(0, 0), cB); G8_STAGE(G8_SA(0, 0), cA); G8_STAGE(G8_SB(0, 1), cB + hstep); G8_STAGE(G8_SA(0, 1), cA + hstep);
  if (wr == 1) G8_BAR;
  G8_WAIT_V(4); G8_BAR;
  G8_STAGE(G8_SB(1, 0), cB + kstep); G8_STAGE(G8_SA(1, 0), cA + kstep); G8_STAGE(G8_SB(1, 1), cB + hstep + kstep);
  G8_WAIT_V(6); G8_BAR;
  for (;;) {
    const bool has_next = S.next(ui + 1, npm, npn);
    const char* nA = has_next ? (const char*)A + (size_t)npm * tstep : cA; const char* nB = has_next ? (const char*)Bt + (size_t)npn * tstep : cB;
    for (int t = 0; t < nt; t += 2) {
      const bool last = (t == nt - 2);
      const char* a1 = cA + (size_t)(t + 1) * kstep;
      const char* a2 = last ? nA : cA + (size_t)(t + 2) * kstep; const char* b2 = last ? nB : cB + (size_t)(t + 2) * kstep;
      const char* a3 = a2 + kstep; const char* b3 = b2 + kstep;
      G8_LDB(B0, 0, 0); G8_SCHED; G8_LDA(At, 0, 0); G8_STAGE(G8_SA(1, 1), a1 + hstep);
      G8_WAIT_L(8); G8_BAR; G8_WAIT_L(0); G8_MMA(0, 0, At, B0); G8_BAR; G8_SCHED;
      G8_LDB(B1, 0, 1); G8_STAGE(G8_SB(0, 0), b2);
      G8_BAR; G8_WAIT_L(0); G8_MMA(0, 1, At, B1); G8_BAR;
      G8_LDA(At, 0, 1); G8_STAGE(G8_SA(0, 0), a2);
      G8_BAR; G8_WAIT_L(0); G8_MMA(1, 0, At, B0); G8_BAR; G8_SCHED;
      G8_STAGE(G8_SB(0, 1), b2 + hstep);
      G8_WAIT_V(6); G8_BAR; G8_MMA(1, 1, At, B1); G8_BAR;
      G8_LDB(B0, 1, 0); G8_SCHED; G8_LDA(At, 1, 0); G8_STAGE(G8_SA(0, 1), a2 + hstep);
      G8_WAIT_L(8); G8_BAR; G8_WAIT_L(0); G8_MMA(0, 0, At, B0); G8_BAR; G8_SCHED;
      G8_LDB(B1, 1, 1); G8_STAGE(G8_SB(1, 0), b3);
      G8_BAR; G8_WAIT_L(0); G8_MMA(0, 1, At, B1); G8_BAR;
      G8_LDA(At, 1, 1); G8_STAGE(G8_SA(1, 0), a3);
      G8_BAR; G8_WAIT_L(0); G8_MMA(1, 0, At, B0); G8_BAR; G8_SCHED;
      G8_STAGE(G8_SB(1, 1), b3 + hstep);
      G8_WAIT_V(6); G8_BAR; G8_MMA(1, 1, At, B1); G8_BAR;
    }
    { const int t2 = TIDX(), w2 = __builtin_amdgcn_readfirstlane(t2 >> 6), l2 = t2 & 63; E(acc, cpm, cpn, w2 >> 2, w2 & 3, l2 & 15, l2 >> 4); }
    if (!has_next) break;
#pragma unroll
    for (int a = 0; a < 2; ++a)
#pragma unroll
      for (int b = 0; b < 2; ++b)
#pragma unroll
        for (int m = 0; m < 4; ++m)
#pragma unroll
          for (int n = 0; n < 2; ++n) acc[a][b][m][n] = f32x4{0.f, 0.f, 0.f, 0.f};
    cpm = npm; cpn = npn; cA = nA; cB = nB; ++ui;
  }
  G8_WAIT_V(0);
  if (wr == 0) G8_BAR;
  G8_BAR;
#undef G8_SA
#undef G8_SB
#undef G8_STAGE
#undef G8_LDA
#undef G8_LDB
#undef G8_MMA
#undef G8_WAIT_V
#undef G8_WAIT_L
#undef G8_BAR
#undef G8_SCHED
}
template <class F> struct ElemEpi {
  F f;
  DI void operator()(const f32x4 (&acc)[2][2][4][2], int pm, int pn, int wr, int wc, int fr, int fq) const {
    const int row0 = pm * 256 + wr * 64 + fr, col0 = pn * 256 + wc * 32 + 4 * fq;
#pragma unroll
    for (int ai = 0; ai < 2; ++ai)
#pragma unroll
      for (int m = 0; m < 4; ++m)
#pragma unroll
        for (int bj = 0; bj < 2; ++bj)
#pragma unroll
          for (int n = 0; n < 2; ++n) f(row0 + ai * 128 + m * 16, col0 + bj * 128 + n * 16, acc[ai][bj][m][n]);
  }
};
template <class F> DI ElemEpi<F> make_epi(F f) { return ElemEpi<F>{f}; }
template <class F>
DI void gemm8_job(char* smem, const u16* A, const u16* Bt, int K, int nM, int nN, int sm, int sn, F f) {
  TileSched S; S.init(nM, nN, sm, sn);
  gemm8(smem, A, Bt, K, S, make_epi(f));
}

DI void phase_mix_in(const PV& p, int i, char* smem) {
  const u16* H = (const u16*)(p.ws() + OFF_A + A_H);
  const u16* W = (const u16*)(p.ws() + OFF_WMIXIN) + (size_t)i * 2560 * 1024;
  u16* MIX = (u16*)(p.ws() + OFF_B + B_MIX);
  u16* VT = (u16*)(p.ws() + OFF_B + B_VT);
  u16* PRT = (u16*)(p.ws() + OFF_B + B_PRT);
  auto epi = [=](int m, int n, f32x4 v) {
    if (n < 512) {
      *(uint2*)(MIX + (size_t)m * 1024 + n) = pack4(gelu_tanh(v[0]), gelu_tanh(v[1]), gelu_tanh(v[2]), gelu_tanh(v[3]));
    } else if (n < 1024) {
      const int nn = n - 512, g = nn >> 7, c = nn & 127, chunk = m >> 7, q = m & 127;
      u16* b = VT + ((size_t)(g * 320 + chunk) * 128 + c) * 128 + q;
#pragma unroll
      for (int j = 0; j < 4; ++j) b[j * 128] = f2bf(gelu_tanh(v[j]));
    } else {
      const int cp = n - 1024;
      size_t off; int stride;
      if (m < TP) { off = (size_t)(m & ~255) * 1536 + (size_t)cp * 256 + (m & 255); stride = 256; }
      else { const int mm = m - TP; off = (size_t)(TP + (mm & ~4095)) * 1536 + (size_t)cp * 4096 + (mm & 4095); stride = 4096; }
#pragma unroll
      for (int j = 0; j < 4; ++j) PRT[off + (size_t)j * stride] = f2bf(v[j]);
    }
  };
  gemm8_job(smem, H, W, 1024, 160, 10, 16, 2, epi);
}

DI void phase_sgu(const PV& p, int i, char* smem) {
  const u16* VT = (const u16*)(p.ws() + OFF_B + B_VT);
  const u16* W = (const u16*)(p.ws() + OFF_WSGU) + (size_t)i * 4 * 16384;
  u16* MIX = (u16*)(p.ws() + OFF_B + B_MIX);
  const float* sb = p.in(11) + i * 512;
  for (int u = blockIdx.x; u < 640; u += gridDim.x) {
    const int g = u / 160, tm = u % 160;
    auto epi = [=](int m, int n, f32x4 v) {
      const int chunk = m >> 7, c = m & 127;
      const int t = chunk * 128 + n;
      const float bias = sb[g * 128 + n];
      u16* dst = MIX + (size_t)t * 1024 + g * 128 + c;
      const uint2 uu = *(const uint2*)dst;
      *(uint2*)dst = pack4(lo16(uu.x) * (v[0] + bias), hi16(uu.x) * (v[1] + bias), lo16(uu.y) * (v[2] + bias), hi16(uu.y) * (v[3] + bias));
    };
    gemm_tile<false>(VT + (size_t)g * 320 * 128 * 128, 128, W + (size_t)g * 16384, 128, 128, tm * 256, 0, smem, epi);
  }
}

DI size_t prt_off(int kind, int b, int cp) {
  return kind ? (size_t)(TP + b * 4096) * 1536 + (size_t)cp * 4096 : (size_t)(b * 256) * 1536 + (size_t)cp * 256;
}
DI size_t zt_off(int kind, int b, int c) {
  return kind ? (size_t)(TP + b * 4096) * 512 + (size_t)c * 4096 : (size_t)(b * 256) * 512 + (size_t)c * 256;
}
DI void phase_conv(const PV& p, int i, int ord, char* smem) {
  const int tid = TIDX(), lane = tid & 63, wid = tid >> 6;
  const u16* PRT = (const u16*)(p.ws() + OFF_B + B_PRT);
  const u16* FILT = (const u16*)(p.ws() + OFF_FILT);
  const u16* Z1 = (const u16*)(p.ws() + OFF_A + A_Z1);
  u16* ZO = (u16*)(p.ws() + OFF_A + (ord ? A_Z2 : A_Z1));
  const float* cw = p.in(12) + (size_t)i * 3 * 1536;
  const float* cb = p.in(13) + (size_t)i * 1536;
  u16* hc = (u16*)smem;
  char* Ub = smem + 68096;
  for (int u = blockIdx.x; u < 1024; u += gridDim.x) {
    const int kind = u < 512 ? 1 : 0, c = u & 511;
    const int L = kind ? 4096 : 256, NB = kind ? 8 : 32, LB = L >> 6, DD = L >> 7;
    const int US = (L + 8) * 2;
    const size_t fbase = ((size_t)(i * 2 + ord) * 512 + c) * 4352 + (kind ? 256 : 0);
    __syncthreads();
    for (int idx = tid; idx < 8 * (L + 136); idx += 512) {
      const int cpy = idx / (L + 136), m = idx - cpy * (L + 136);
      const int x = L + 63 - m - cpy;
      hc[cpy * 4256 + m] = (x >= 0 && x < L) ? FILT[fbase + x] : (u16)0;
    }
    {
      const int ncr = L >> 3, total = NB * ncr;
      const float w0 = cw[c], w1 = cw[1536 + c], w2 = cw[3072 + c], bb = cb[c];
      for (int id = tid; id < total; id += 512) {
        const int b = id / ncr, t = (id - b * ncr) * 8;
        uint4 o;
        if (ord == 0) {
          const u16* src = PRT + prt_off(kind, b, c) + t;
          const uint4 raw = *(const uint4*)src;
          float e[10];
          e[0] = t > 0 ? bf2f(src[-1]) : 0.f;
          e[9] = t + 8 < L ? bf2f(src[8]) : 0.f;
          e[1] = lo16(raw.x); e[2] = hi16(raw.x); e[3] = lo16(raw.y); e[4] = hi16(raw.y);
          e[5] = lo16(raw.z); e[6] = hi16(raw.z); e[7] = lo16(raw.w); e[8] = hi16(raw.w);
          float r[8];
#pragma unroll
          for (int k = 0; k < 8; ++k) r[k] = w0 * e[k] + w1 * e[k + 1] + w2 * e[k + 2] + bb;
          o.x = pack2(r[0], r[1]); o.y = pack2(r[2], r[3]); o.z = pack2(r[4], r[5]); o.w = pack2(r[6], r[7]);
        } else {
          o = *(const uint4*)(Z1 + zt_off(kind, b, c) + t);
        }
        *(uint4*)(Ub + b * US + t * 2) = o;
      }
    }
    __syncthreads();
    const int ncols = LB * NB;
    if (wid * 64 < ncols) {
      const int il = lane & 31, q = lane >> 5;
      int t1c[2], bc[2];
#pragma unroll
      for (int nt = 0; nt < 2; ++nt) { const int col = wid * 64 + nt * 32 + il; t1c[nt] = col / NB; bc[nt] = col % NB; }
      const int t1lo = (wid * 64) / NB, t1hi = (wid * 64 + 63) / NB;
      const int dlo = max(-DD, t1lo - (LB - 1)), dhi = min(DD, t1hi);
      const int cpy = 7 - (il & 7);
      const char* abase = (const char*)hc + cpy * 8512 + 2 * (L / 2 + 63 - il - cpy + 8 * q);
      f32x16 acc[2][2];
#pragma unroll
      for (int a = 0; a < 2; ++a)
#pragma unroll
        for (int b = 0; b < 2; ++b)
#pragma unroll
          for (int r = 0; r < 16; ++r) acc[a][b][r] = 0.f;
      for (int d = dlo; d <= dhi; ++d) {
        bf16x8 bfr[2][4];
#pragma unroll
        for (int nt = 0; nt < 2; ++nt) {
          const int s1 = t1c[nt] - d;
          const bool valid = s1 >= 0 && s1 < LB;
          const char* bp = Ub + bc[nt] * US + ((valid ? s1 : 0) * 64 + 8 * q) * 2;
#pragma unroll
          for (int ks = 0; ks < 4; ++ks) {
            bf16x8 v = *(const bf16x8*)(bp + ks * 32);
            if (!valid) v = bf16x8{0, 0, 0, 0, 0, 0, 0, 0};
            bfr[nt][ks] = v;
          }
        }
#pragma unroll
        for (int mt = 0; mt < 2; ++mt)
#pragma unroll
          for (int ks = 0; ks < 4; ++ks) {
            const bf16x8 af = *(const bf16x8*)(abase + 2 * (-64 * d - 32 * mt + 16 * ks));
#pragma unroll
            for (int nt = 0; nt < 2; ++nt) acc[mt][nt] = __builtin_amdgcn_mfma_f32_32x32x16_bf16(af, bfr[nt][ks], acc[mt][nt], 0, 0, 0);
          }
      }
      const float dsk = p.in(21)[(i * 2 + ord) * 512 + c];
      const int gc = 512 * (ord + 1) + c;
      const float w0 = cw[gc], w1 = cw[1536 + gc], w2 = cw[3072 + gc], bb = cb[gc];
#pragma unroll
      for (int nt = 0; nt < 2; ++nt) {
        const int b = bc[nt];
        const u16* xrow = PRT + prt_off(kind, b, gc);
        u16* orow = ZO + zt_off(kind, b, c);
#pragma unroll
        for (int mt = 0; mt < 2; ++mt)
#pragma unroll
          for (int g = 0; g < 4; ++g) {
            const int t = 64 * t1c[nt] + mt * 32 + 8 * g + 4 * q;
            const uint2 uu = *(const uint2*)(Ub + b * US + t * 2);
            const uint2 xx = *(const uint2*)(xrow + t);
            const float em = t > 0 ? bf2f(xrow[t - 1]) : 0.f;
            const float ep = t + 4 < L ? bf2f(xrow[t + 4]) : 0.f;
            const float e0 = lo16(xx.x), e1 = hi16(xx.x), e2 = lo16(xx.y), e3 = hi16(xx.y);
            const float x0 = w0 * em + w1 * e0 + w2 * e1 + bb;
            const float x1 = w0 * e0 + w1 * e1 + w2 * e2 + bb;
            const float x2 = w0 * e1 + w1 * e2 + w2 * e3 + bb;
            const float x3 = w0 * e2 + w1 * e3 + w2 * ep + bb;
            const float y0 = acc[mt][nt][4 * g + 0] + lo16(uu.x) * dsk;
            const float y1 = acc[mt][nt][4 * g + 1] + hi16(uu.x) * dsk;
            const float y2 = acc[mt][nt][4 * g + 2] + lo16(uu.y) * dsk;
            const float y3 = acc[mt][nt][4 * g + 3] + hi16(uu.y) * dsk;
            *(uint2*)(orow + t) = pack4(x0 * y0, x1 * y1, x2 * y2, x3 * y3);
          }
      }
    }
  }
  __syncthreads();
}

DI void phase_ztrans(const PV& p, char* smem) {
  const int tid = TIDX();
  const u16* Z2 = (const u16*)(p.ws() + OFF_A + A_Z2);
  u16* MIX = (u16*)(p.ws() + OFF_B + B_MIX);
  u16* tl = (u16*)smem;
  for (int u = blockIdx.x; u < 640 * 8; u += gridDim.x) {
    const int tt0 = (u >> 3) * 64, c0 = (u & 7) * 64;
    const int kind = tt0 >= TP ? 1 : 0;
    const int b = kind ? (tt0 - TP) >> 12 : tt0 >> 8;
    const int tl0 = kind ? (tt0 - TP) & 4095 : tt0 & 255;
    __syncthreads();
    { const int c = tid >> 3, ch = tid & 7;
      *(uint4*)(tl + c * 72 + ch * 8) = *(const uint4*)(Z2 + zt_off(kind, b, c0 + c) + tl0 + ch * 8); }
    __syncthreads();
    { const int tr = tid >> 3, cc = (tid & 7) * 8;
      uint4 o;
      o.x = (unsigned)tl[(cc + 0) * 72 + tr] | ((unsigned)tl[(cc + 1) * 72 + tr] << 16);
      o.y = (unsigned)tl[(cc + 2) * 72 + tr] | ((unsigned)tl[(cc + 3) * 72 + tr] << 16);
      o.z = (unsigned)tl[(cc + 4) * 72 + tr] | ((unsigned)tl[(cc + 5) * 72 + tr] << 16);
      o.w = (unsigned)tl[(cc + 6) * 72 + tr] | ((unsigned)tl[(cc + 7) * 72 + tr] << 16);
      *(uint4*)(MIX + (size_t)(tt0 + tr) * 1024 + 512 + c0 + cc) = o; }
  }
  __syncthreads();
}

DI void phase_resid_gemm(const PV& p, int l, int lx, const u16* A, int K, const u16* W, int goff, char* smem) {
  const float* MOD = (const float*)(p.ws() + OFF_MOD);
  float* X = p.out();
  const float* x0 = p.in(0);
  const float* x1 = p.in(1);
  auto epi = [=](int m, int n, f32x4 v) {
    const float* xr = lx == 0 ? (m < TP ? x0 + (size_t)m * 1024 : x1 + (size_t)(m - TP) * 1024) : X + (size_t)m * 1024;
    const float4 xo = *(const float4*)(xr + n);
    const float4 g = *(const float4*)(MOD + (size_t)(l * 9 + condrow(m)) * 6144 + goff + n);
    float4 o; o.x = xo.x + g.x * v[0]; o.y = xo.y + g.y * v[1]; o.z = xo.z + g.z * v[2]; o.w = xo.w + g.w * v[3];
    *(float4*)(X + (size_t)m * 1024 + n) = o;
  };
  gemm8_job(smem, A, W, K, 160, 4, 8, 4, epi);
}

DI void phase_dqkv(const PV& p, int j, char* smem) {
  const u16* H = (const u16*)(p.ws() + OFF_A + A_H);
  const u16* W = (const u16*)(p.ws() + OFF_WDQKV) + (size_t)j * 1024 * 1024;
  u16* DQKV = (u16*)(p.ws() + OFF_B + B_DQKV);
  u16* KR = (u16*)(p.ws() + OFF_KR);
  float* okr = p.out() + 46137344;
  auto epi = [=](int m, int n, f32x4 v) {
    if (n < 832) {
      const uint2 pk = pack4(v[0], v[1], v[2], v[3]);
      *(uint2*)(DQKV + (size_t)m * 896 + n) = pk;
      if (n >= 768) {
        const int e = n - 768;
        *(uint2*)(KR + (size_t)m * 64 + e) = pk;
        if (m < TP) {
          float4 o; o.x = v[0]; o.y = v[1]; o.z = v[2]; o.w = v[3];
          *(float4*)(okr + ((size_t)((m >> 8) * 2 + j) * 256 + (m & 255)) * 64 + e) = o;
        }
      }
    }
  };
  gemm8_job(smem, H, W, 1024, 160, 4, 8, 4, epi);
}

DI void phase_mla_norms(const PV& p, int j) {
  const int tid_ = TIDX(); const int lane = tid_ & 63, wid = tid_ >> 6;
  const u16* DQKV = (const u16*)(p.ws() + OFF_B + B_DQKV);
  u16* QN = (u16*)(p.ws() + OFF_A + A_QN);
  u16* CKV = (u16*)(p.ws() + OFF_A + A_CKV);
  u16* KR = (u16*)(p.ws() + OFF_KR);
  float* ockv = p.out() + 41943040;
  const float* qn = p.in(24) + j * 512;
  const float* kvn = p.in(27) + j * 256;
  for (int t = blockIdx.x * 8 + wid; t < TK; t += gridDim.x * 8) {
    if (t < T) {
      const u16* row = DQKV + (size_t)t * 896;
      const uint4 a = *(const uint4*)(row + lane * 8);
      float q[8] = {lo16(a.x), hi16(a.x), lo16(a.y), hi16(a.y), lo16(a.z), hi16(a.z), lo16(a.w), hi16(a.w)};
      float ss = 0.f;
#pragma unroll
      for (int k = 0; k < 8; ++k) ss += q[k] * q[k];
      ss = wave_sum(ss, lane);
      const float r = rsqrtf(ss * (1.f / 512.f) + EPS);
      const float4 g0 = *(const float4*)(qn + lane * 8), g1 = *(const float4*)(qn + lane * 8 + 4);
      uint4 o;
      o.x = pack2(q[0] * r * g0.x, q[1] * r * g0.y); o.y = pack2(q[2] * r * g0.z, q[3] * r * g0.w);
      o.z = pack2(q[4] * r * g1.x, q[5] * r * g1.y); o.w = pack2(q[6] * r * g1.z, q[7] * r * g1.w);
      *(uint4*)(QN + (size_t)t * 512 + lane * 8) = o;
      const uint2 b = *(const uint2*)(row + 512 + lane * 4);
      float kv[4] = {lo16(b.x), hi16(b.x), lo16(b.y), hi16(b.y)};
      float s2 = kv[0] * kv[0] + kv[1] * kv[1] + kv[2] * kv[2] + kv[3] * kv[3];
      s2 = wave_sum(s2, lane);
      const float r2 = rsqrtf(s2 * (1.f / 256.f) + EPS);
      const float4 g2 = *(const float4*)(kvn + lane * 4);
      float4 o2; o2.x = kv[0] * r2 * g2.x; o2.y = kv[1] * r2 * g2.y; o2.z = kv[2] * r2 * g2.z; o2.w = kv[3] * r2 * g2.w;
      *(uint2*)(CKV + (size_t)t * 256 + lane * 4) = pack4(o2.x, o2.y, o2.z, o2.w);
      if (t < TP) *(float4*)(ockv + ((size_t)((t >> 8) * 2 + j) * 256 + (t & 255)) * 256 + lane * 4) = o2;
    } else {
      const int pp = t - T, b = pp >> 8, s = pp & 255;
      const float4 v = *(const float4*)(p.in(2) + ((size_t)(b * 2 + j) * 256 + s) * 256 + lane * 4);
      *(uint2*)(CKV + (size_t)t * 256 + lane * 4) = pack4(v.x, v.y, v.z, v.w);
      if (lane < 16) {
        const float4 w = *(const float4*)(p.in(3) + ((size_t)(b * 2 + j) * 256 + s) * 64 + lane * 4);
        *(uint2*)(KR + (size_t)t * 64 + lane * 4) = pack4(w.x, w.y, w.z, w.w);
      }
    }
  }
}

DI size_t vt_off(int m, int h, int d) {
  if (m < TP) return ((size_t)((m >> 8) * 8 + h) * 128 + d) * 256 + (m & 255);
  if (m < T) { const int mm = m - TP; return VT_SAMPLE_OFF + ((size_t)((mm >> 12) * 8 + h) * 128 + d) * 4352 + (mm & 4095); }
  const int mm = m - T;
  return VT_SAMPLE_OFF + ((size_t)((mm >> 8) * 8 + h) * 128 + d) * 4352 + 4096 + (mm & 255);
}
DI void phase_uq_ukv(const PV& p, int j, char* smem) {
  const u16* QN = (const u16*)(p.ws() + OFF_A + A_QN);
  const u16* CKV = (const u16*)(p.ws() + OFF_A + A_CKV);
  const u16* WQ = (const u16*)(p.ws() + OFF_WUQ) + (size_t)j * 1536 * 512;
  const u16* WKV = (const u16*)(p.ws() + OFF_WUKV) + (size_t)j * 2048 * 256;
  u16* Q = (u16*)(p.ws() + OFF_B + B_Q);
  u16* Kb = (u16*)(p.ws() + OFF_B + B_K);
  u16* Vt = (u16*)(p.ws() + OFF_B + B_V);
  auto epiq = [=](int m, int n, f32x4 v) { *(uint2*)(Q + (size_t)m * 1536 + n) = pack4(v[0], v[1], v[2], v[3]); };
  gemm8_job(smem, QN, WQ, 512, 160, 6, 16, 2, epiq);
  auto epikv = [=](int m, int n, f32x4 v) {
    const int h = n >> 8, r = n & 255;
    if (r < 128) {
      *(uint2*)(Kb + ((size_t)m * 8 + h) * 192 + r) = pack4(v[0], v[1], v[2], v[3]);
    } else {
      u16* dst = Vt + vt_off(m, h, r - 128);
      const size_t ls = m < TP ? 256 : 4352;
#pragma unroll
      for (int j = 0; j < 4; ++j) dst[(size_t)j * ls] = f2bf(v[j]);
    }
  };
  gemm8_job(smem, CKV, WKV, 256, 168, 8, 4, 8, epikv);
}

DI void phase_finalize(const PV& p, int j) {
  const int tid_ = TIDX(); const int lane = tid_ & 63, wid = tid_ >> 6;
  const int h = lane >> 3, l8 = lane & 7;
  u16* Q = (u16*)(p.ws() + OFF_B + B_Q);
  u16* Kb = (u16*)(p.ws() + OFF_B + B_K);
  const u16* KR = (const u16*)(p.ws() + OFF_KR);
  const float QSCALE = 1.4426950408889634f * 0.07216878364870322f;
  for (int u = blockIdx.x * 8 + wid; u < T + TK; u += gridDim.x * 8) {
    const bool isq = u < T;
    const int t = isq ? u : u - T;
    u16* base = isq ? Q + (size_t)t * 1536 + h * 192 : Kb + ((size_t)t * 8 + h) * 192;
    const float* hn = (isq ? p.in(29) : p.in(30)) + j * 192;
    float v[3][8];
#pragma unroll
    for (int k = 0; k < 3; ++k) {
      const u16* src = (!isq && k == 2) ? KR + (size_t)t * 64 + 8 * l8 : base + 8 * (l8 + 8 * k);
      const uint4 a = *(const uint4*)src;
      v[k][0] = lo16(a.x); v[k][1] = hi16(a.x); v[k][2] = lo16(a.y); v[k][3] = hi16(a.y);
      v[k][4] = lo16(a.z); v[k][5] = hi16(a.z); v[k][6] = lo16(a.w); v[k][7] = hi16(a.w);
    }
    float ss = 0.f;
#pragma unroll
    for (int k = 0; k < 3; ++k)
#pragma unroll
      for (int e = 0; e < 8; ++e) ss += v[k][e] * v[k][e];
    ss += shx<1>(ss, lane); ss += shx<2>(ss, lane); ss += shx<4>(ss, lane);
    const float r = rsqrtf(ss * (1.f / 192.f) + EPS);
#pragma unroll
    for (int k = 0; k < 3; ++k) {
      const float4 g0 = *(const float4*)(hn + 8 * (l8 + 8 * k)), g1 = *(const float4*)(hn + 8 * (l8 + 8 * k) + 4);
      v[k][0] *= r * g0.x; v[k][1] *= r * g0.y; v[k][2] *= r * g0.z; v[k][3] *= r * g0.w;
      v[k][4] *= r * g1.x; v[k][5] *= r * g1.y; v[k][6] *= r * g1.z; v[k][7] *= r * g1.w;
    }
    const bool rope = t >= TP && t < T;
    {
      const int tl = (t - TP) & 4095;
      const float pos = (float)(l8 < 4 ? (tl >> 6) : (tl & 63));
#pragma unroll
      for (int e = 0; e < 8; ++e) {
        const float x = v[2][e];
        const float partner = shx<2>(x, lane);
        const int f = (l8 & 1) * 8 + e;
        const float inv = exp2f(-(float)f * (13.287712379549449f / 16.f));
        float sn, cs;
        sincosf(pos * inv, &sn, &cs);
        const float rot = (l8 & 2) ? x * cs + partner * sn : x * cs - partner * sn;
        v[2][e] = rope ? rot : x;
      }
    }
    const float sc = isq ? QSCALE : 1.f;
#pragma unroll
    for (int k = 0; k < 3; ++k) {
      uint4 o;
      o.x = pack2(v[k][0] * sc, v[k][1] * sc); o.y = pack2(v[k][2] * sc, v[k][3] * sc);
      o.z = pack2(v[k][4] * sc, v[k][5] * sc); o.w = pack2(v[k][6] * sc, v[k][7] * sc);
      *(uint4*)(base + 8 * (l8 + 8 * k)) = o;
    }
  }
}

DI void attn_item(const PV& p, int kind, int seq, int h, int q0, char* smem) {
  const int tid = TIDX(), lane = tid & 63, wid = tid >> 6;
  const int il = lane & 31, hh = lane >> 5;
  const u16* Q = (const u16*)(p.ws() + OFF_B + B_Q);
  const u16* Kb = (const u16*)(p.ws() + OFF_B + B_K);
  const u16* Vt = (const u16*)(p.ws() + OFF_B + B_V);
  u16* O = (u16*)(p.ws() + OFF_A + A_O);
  const int Lk = kind ? 4352 : 256, nkt = Lk >> 6;
  const u16* vbase = Vt + (kind ? VT_SAMPLE_OFF + (size_t)(seq * 8 + h) * 128 * 4352 : (size_t)(seq * 8 + h) * 128 * 256);
  const int tq = q0 + wid * 32 + il;
  bf16x8 qf[12];
#pragma unroll
  for (int ks = 0; ks < 12; ++ks) qf[ks] = *(const bf16x8*)(Q + ((size_t)tq * 8 + h) * 192 + 16 * ks + 8 * hh);
  f32x16 oacc[4];
#pragma unroll
  for (int a = 0; a < 4; ++a)
#pragma unroll
    for (int r = 0; r < 16; ++r) oacc[a][r] = 0.f;
  float mrun = -INFINITY, lrun = 0.f;
  const int sw = (il >> 1) & 7;
  int ko[4], vo[8];
#pragma unroll
  for (int a = 0; a < 4; ++a) ko[a] = il * 384 + (((2 * a + hh) ^ sw) << 4);
#pragma unroll
  for (int c = 0; c < 8; ++c) vo[c] = il * 128 + 8 * hh + ((c ^ sw) << 4);
  uint4 rk0, rk1, rk2, rv0, rv1;
#define ATT_GLOAD(kt_)                                                                                         \
  {                                                                                                            \
    const int k0_ = (kt_) * 64;                                                                                \
    const int rowbase_ = kind ? (k0_ < 4096 ? TP + seq * 4096 + k0_ : T + seq * 256 + (k0_ - 4096)) : seq * 256 + k0_; \
    { const int id = tid, r = id / 24, ch = id - r * 24; rk0 = *(const uint4*)(Kb + ((size_t)(rowbase_ + r) * 8 + h) * 192 + ch * 8); }        \
    { const int id = tid + 512, r = id / 24, ch = id - r * 24; rk1 = *(const uint4*)(Kb + ((size_t)(rowbase_ + r) * 8 + h) * 192 + ch * 8); }  \
    { const int id = tid + 1024, r = id / 24, ch = id - r * 24; rk2 = *(const uint4*)(Kb + ((size_t)(rowbase_ + r) * 8 + h) * 192 + ch * 8); } \
    { const int id = tid, dd = id >> 3, ch = id & 7; rv0 = *(const uint4*)(vbase + (size_t)dd * Lk + k0_ + ch * 8); }                          \
    { const int id = tid + 512, dd = id >> 3, ch = id & 7; rv1 = *(const uint4*)(vbase + (size_t)dd * Lk + k0_ + ch * 8); }                    \
  }
#define ATT_SSTORE(s_)                                                                                         \
  {                                                                                                            \
    char* ks_ = smem + (s_) * 40960;                                                                           \
    { const int id = tid, r = id / 24, ch = id - r * 24; *(uint4*)(ks_ + r * 384 + (((ch & ~7) | ((ch & 7) ^ ((r >> 1) & 7))) << 4)) = rk0; }        \
    { const int id = tid + 512, r = id / 24, ch = id - r * 24; *(uint4*)(ks_ + r * 384 + (((ch & ~7) | ((ch & 7) ^ ((r >> 1) & 7))) << 4)) = rk1; }  \
    { const int id = tid + 1024, r = id / 24, ch = id - r * 24; *(uint4*)(ks_ + r * 384 + (((ch & ~7) | ((ch & 7) ^ ((r >> 1) & 7))) << 4)) = rk2; } \
    { const int id = tid, dd = id >> 3, ch = id & 7; *(uint4*)(ks_ + 24576 + dd * 128 + ((ch ^ ((dd >> 1) & 7)) << 4)) = rv0; }                      \
    { const int id = tid + 512, dd = id >> 3, ch = id & 7; *(uint4*)(ks_ + 24576 + dd * 128 + ((ch ^ ((dd >> 1) & 7)) << 4)) = rv1; }                \
  }
  __syncthreads();
  ATT_GLOAD(0) ATT_SSTORE(0)
  __syncthreads();
  for (int kt = 0; kt < nkt; ++kt) {
    const bool more = kt + 1 < nkt;
    if (more) ATT_GLOAD(kt + 1)
    const char* Ks = smem + (kt & 1) * 40960;
    const char* Vs = Ks + 24576;
#pragma unroll
    for (int st = 0; st < 2; ++st) {
      f32x16 s;
#pragma unroll
      for (int r = 0; r < 16; ++r) s[r] = 0.f;
#pragma unroll
      for (int ks = 0; ks < 12; ++ks) {
        const bf16x8 kf = *(const bf16x8*)(Ks + ko[ks & 3] + st * 12288 + (ks >> 2) * 128);
        s = __builtin_amdgcn_mfma_f32_32x32x16_bf16(kf, qf[ks], s, 0, 0, 0);
      }
      float mx = s[0];
#pragma unroll
      for (int r = 1; r < 16; ++r) mx = fmaxf(mx, s[r]);
      mx = fmaxf(mx, shx<32>(mx, lane));
      const float mnew = fmaxf(mrun, mx);
      const float alpha = __builtin_amdgcn_exp2f(mrun - mnew);
      mrun = mnew;
      float psum = 0.f;
#pragma unroll
      for (int r = 0; r < 16; ++r) { const float pv = __builtin_amdgcn_exp2f(s[r] - mnew); s[r] = pv; psum += pv; }
      lrun = lrun * alpha + psum;
#pragma unroll
      for (int a = 0; a < 4; ++a)
#pragma unroll
        for (int r = 0; r < 16; ++r) oacc[a][r] *= alpha;
#pragma unroll
      for (int sb = 0; sb < 2; ++sb) {
        union { bf16x8 v; unsigned w[4]; } pb;
#pragma unroll
        for (int w = 0; w < 4; ++w) pb.w[w] = pack2(s[8 * sb + 2 * w], s[8 * sb + 2 * w + 1]);
        const int c1 = 4 * st + 2 * sb;
#pragma unroll
        for (int dt = 0; dt < 4; ++dt) {
          union { bf16x8 v; uint2 h2[2]; } vf;
          vf.h2[0] = *(const uint2*)(Vs + vo[c1] + dt * 4096);
          vf.h2[1] = *(const uint2*)(Vs + vo[c1 + 1] + dt * 4096);
          oacc[dt] = __builtin_amdgcn_mfma_f32_32x32x16_bf16(vf.v, pb.v, oacc[dt], 0, 0, 0);
        }
      }
    }
    if (more) ATT_SSTORE((kt + 1) & 1)
    __syncthreads();
  }
  const float ltot = lrun + shx<32>(lrun, lane);
  const float inv = 1.f / ltot;
#pragma unroll
  for (int dt = 0; dt < 4; ++dt)
#pragma unroll
    for (int g = 0; g < 4; ++g) {
      const int d = dt * 32 + 8 * g + 4 * hh;
      *(uint2*)(O + (size_t)tq * 1024 + h * 128 + d) =
          pack4(oacc[dt][4 * g] * inv, oacc[dt][4 * g + 1] * inv, oacc[dt][4 * g + 2] * inv, oacc[dt][4 * g + 3] * inv);
    }
}
DI void phase_attention(const PV& p, char* smem) {
  const bool xmap = gridDim.x == 256;
  const int Gq = opaque_i((int)gridDim.x);
  const int nit = xmap ? 5 : (1280 + Gq - 1) / Gq;
#pragma unroll 1
  for (int r = 0; r < nit; ++r) {
    int kind, seq, h, q0;
    if (xmap) {
      if (r < 4) {
        const int xcd = blockIdx.x & 7, slot = blockIdx.x >> 3;
        const int pair = xcd + 8 * (2 * r + (slot >> 4)), qb = slot & 15;
        kind = 1; seq = pair >> 3; h = pair & 7; q0 = TP + seq * 4096 + qb * 256;
      } else {
        kind = 0; seq = blockIdx.x >> 3; h = blockIdx.x & 7; q0 = seq * 256;
      }
    } else {
      const int it = blockIdx.x + r * gridDim.x;
      if (it >= 1280) break;
      if (it < 1024) { const int pair = it >> 4, qb = it & 15; kind = 1; seq = pair >> 3; h = pair & 7; q0 = TP + seq * 4096 + qb * 256; }
      else { const int i2 = it - 1024; kind = 0; seq = i2 >> 3; h = i2 & 7; q0 = seq * 256; }
    }
    attn_item(p, kind, seq, h, q0, smem);
  }
  __syncthreads();
}

DI float dpp_ror1(float x) { return __int_as_float(__builtin_amdgcn_update_dpp(0, __float_as_int(x), 0x121, 0xf, 0xf, false)); }
DI float dpp_ror15(float x) { return __int_as_float(__builtin_amdgcn_update_dpp(0, __float_as_int(x), 0x12F, 0xf, 0xf, false)); }
struct EpiFFN {
  u16* ACT; u16* EDGE; const float* cw; const float* cb;
  DI void operator()(const f32x4 (&acc)[2][2][4][2], int pm, int pn, int wr, int wc, int fr, int fq) const {
#pragma unroll
    for (int n = 0; n < 2; ++n) {
      const int a = pn * 128 + wc * 32 + n * 16 + fq * 4;
      const float4 w0g = *(const float4*)(cw + a), w1g = *(const float4*)(cw + 5632 + a), w2g = *(const float4*)(cw + 11264 + a), bg = *(const float4*)(cb + a);
      const float4 w0u = *(const float4*)(cw + 2816 + a), w1u = *(const float4*)(cw + 5632 + 2816 + a), w2u = *(const float4*)(cw + 11264 + 2816 + a), bu = *(const float4*)(cb + 2816 + a);
#pragma unroll
      for (int ai = 0; ai < 2; ++ai) {
        const int rbase = pm * 256 + ai * 128 + wr * 64;
        const size_t erow = (size_t)(rbase >> 6) * 4;
#pragma unroll
        for (int m = 0; m < 4; ++m) {
          const int mp = m > 0 ? m - 1 : 0, mn = m < 3 ? m + 1 : 3;
          float o[4];
#define FFN_ONE(J, C)                                                                                         \
          {                                                                                                   \
            const float g = acc[ai][0][m][n][J], u = acc[ai][1][m][n][J];                                     \
            const float gpv = m > 0 ? acc[ai][0][mp][n][J] : 0.f, gnx = m < 3 ? acc[ai][0][mn][n][J] : 0.f;   \
            const float upv = m > 0 ? acc[ai][1][mp][n][J] : 0.f, unx = m < 3 ? acc[ai][1][mn][n][J] : 0.f;   \
            const float gp = dpp_ror1(fr == 15 ? gpv : g), gn = dpp_ror15(fr == 0 ? gnx : g);                \
            const float up = dpp_ror1(fr == 15 ? upv : u), un = dpp_ror15(fr == 0 ? unx : u);                \
            const float cg = w0g.C * gp + w1g.C * g + w2g.C * gn + bg.C;                                      \
            const float cu = w0u.C * up + w1u.C * u + w2u.C * un + bu.C;                                      \
            o[J] = silu(cg) * cu;                                                                             \
          }
          FFN_ONE(0, x) FFN_ONE(1, y) FFN_ONE(2, z) FFN_ONE(3, w)
#undef FFN_ONE
          *(uint2*)(ACT + (size_t)(rbase + m * 16 + fr) * 2816 + a) = pack4(o[0], o[1], o[2], o[3]);
          if ((m == 0 && fr < 2) || (m == 3 && fr >= 14)) {
            const int ri = m == 0 ? fr : fr - 12;
            u16* e = EDGE + (erow + ri) * 5632 + pn * 256 + wc * 32 + n * 16 + fq * 4;
            *(uint2*)e = pack4(acc[ai][0][m][n][0], acc[ai][0][m][n][1], acc[ai][0][m][n][2], acc[ai][0][m][n][3]);
            *(uint2*)(e + 128) = pack4(acc[ai][1][m][n][0], acc[ai][1][m][n][1], acc[ai][1][m][n][2], acc[ai][1][m][n][3]);
          }
        }
      }
    }
  }
};
DI void phase_ffn_up(const PV& p, int l, char* smem) {
  EpiFFN E;
  E.ACT = (u16*)(p.ws() + OFF_B + B_ACT); E.EDGE = (u16*)(p.ws() + OFF_EDGE);
  E.cw = p.in(33) + (size_t)l * 3 * 5632; E.cb = p.in(34) + (size_t)l * 5632;
  TileSched S; S.init(160, 22, 16, 2);
  gemm8(smem, (const u16*)(p.ws() + OFF_A + A_H), (const u16*)(p.ws() + OFF_WUP), 1024, S, E);
}
DI void phase_ffn_fix(const PV& p, int l) {
  const u16* EDGE = (const u16*)(p.ws() + OFF_EDGE);
  u16* ACT = (u16*)(p.ws() + OFF_B + B_ACT);
  const float* cw = p.in(33) + (size_t)l * 3 * 5632;
  const float* cb = p.in(34) + (size_t)l * 5632;
  const long gtid = (long)blockIdx.x * blockDim.x + TIDX(), gsz = (long)gridDim.x * blockDim.x;
  for (long idx = gtid; idx < (long)640 * 2 * 2816; idx += gsz) {
    const int a = (int)(idx % 2816), rr = (int)(idx / 2816), which = rr & 1, sidx = rr >> 1;
    const int t = sidx * 64 + (which ? 63 : 0);
    const int tb = which ? t + 1 : t;
    const bool seqb = tb < TP ? (tb & 255) == 0 : ((tb - TP) & 4095) == 0;
    if (seqb) continue;
    const int pc = (a >> 7) * 256 + (a & 127);
    const u16 *pr, *cu, *nx;
    if (which == 0) { pr = EDGE + ((size_t)(sidx - 1) * 4 + 3) * 5632; cu = EDGE + ((size_t)sidx * 4 + 0) * 5632; nx = EDGE + ((size_t)sidx * 4 + 1) * 5632; }
    else { pr = EDGE + ((size_t)sidx * 4 + 2) * 5632; cu = EDGE + ((size_t)sidx * 4 + 3) * 5632; nx = EDGE + ((size_t)(sidx + 1) * 4 + 0) * 5632; }
    const float g = cw[a] * bf2f(pr[pc]) + cw[5632 + a] * bf2f(cu[pc]) + cw[11264 + a] * bf2f(nx[pc]) + cb[a];
    const float uu = cw[2816 + a] * bf2f(pr[pc + 128]) + cw[5632 + 2816 + a] * bf2f(cu[pc + 128]) + cw[11264 + 2816 + a] * bf2f(nx[pc + 128]) + cb[2816 + a];
    ACT[(size_t)t * 2816 + a] = f2bf(silu(g) * uu);
  }
}

#ifndef PH
#define RUN(k, ...) __VA_ARGS__
#else
#define RUN(k, ...) if (PH == k) { __VA_ARGS__ }
#endif
extern "C" __global__ void __launch_bounds__(512) fwd_megakernel(Params kp) {
  extern __shared__ __attribute__((aligned(16))) char smem[];
  cg::grid_group grid = cg::this_grid();
  if (TIDX() == 0) {
    unsigned long long* t = (unsigned long long*)(smem + PARM_OFF);
#pragma unroll
    for (int k = 0; k < 36; ++k) t[k] = (unsigned long long)kp.in[k];
    t[36] = (unsigned long long)kp.out; t[37] = (unsigned long long)kp.ws;
  }
  __syncthreads();
  PV p; p.smem = smem;
  unsigned* bar = (unsigned*)(p.ws() + OFF_BAR);
  unsigned bar_no = 0;
  RUN(0, phase_prep(p, smem);)
  grid.sync();
  RUN(1, phase_filters(p, smem);)
  for (int l = 0; l < 4; ++l) {
    const int i = l >> 1;
    RUN(2, phase_norm(p, l, 0, l);)
    RUN(0, if (l > 0) { int base = 0; convert_ffn_weights(p, l, smem, base); })
    grid_barrier(bar, bar_no);
    if ((l & 1) == 0) {
      RUN(3, phase_mix_in(p, i, smem);)
      grid_barrier(bar, bar_no);
      RUN(4, phase_sgu(p, i, smem);)
      RUN(5, phase_conv(p, i, 0, smem);)
      grid_barrier(bar, bar_no);
      RUN(5, phase_conv(p, i, 1, smem);)
      grid_barrier(bar, bar_no);
      RUN(6, phase_ztrans(p, smem);)
      grid_barrier(bar, bar_no);
      RUN(7, phase_resid_gemm(p, l, l, (const u16*)(p.ws() + OFF_B + B_MIX), 1024, (const u16*)(p.ws() + OFF_WMIXOUT) + (size_t)i * 1024 * 1024, 2048, smem);)
      grid_barrier(bar, bar_no);
    } else {
      RUN(8, phase_dqkv(p, i, smem);)
      grid_barrier(bar, bar_no);
      RUN(9, phase_mla_norms(p, i);)
      grid_barrier(bar, bar_no);
      RUN(10, phase_uq_ukv(p, i, smem);)
      grid_barrier(bar, bar_no);
      RUN(11, phase_finalize(p, i);)
      grid_barrier(bar, bar_no);
      RUN(12, phase_attention(p, smem);)
      grid_barrier(bar, bar_no);
      RUN(7, phase_resid_gemm(p, l, l, (const u16*)(p.ws() + OFF_A + A_O), 1024, (const u16*)(p.ws() + OFF_WO) + (size_t)i * 1024 * 1024, 2048, smem);)
      grid_barrier(bar, bar_no);
    }
    RUN(2, phase_norm(p, l, 1, 1);)
    grid_barrier(bar, bar_no);
    RUN(13, phase_ffn_up(p, l, smem);)
    grid_barrier(bar, bar_no);
    RUN(14, phase_ffn_fix(p, l);)
    grid_barrier(bar, bar_no);
    RUN(7, phase_resid_gemm(p, l, 1, (const u16*)(p.ws() + OFF_B + B_ACT), 2816, (const u16*)(p.ws() + OFF_WDOWN), 5120, smem);)
    grid_barrier(bar, bar_no);
  }
}

extern "C" void kernel_launch(void* const* d_in, const int* in_sizes, int n_in,
                              void* d_out, int out_size, void* d_ws, size_t ws_size,
                              hipStream_t stream) {
  static int grid_blocks = 0;
  if (!grid_blocks) {
    int dev = 0, cus = 0, per_cu = 0;
    (void)hipGetDevice(&dev);
    (void)hipDeviceGetAttribute(&cus, hipDeviceAttributeMultiprocessorCount, dev);
    (void)hipFuncSetAttribute((const void*)fwd_megakernel, hipFuncAttributeMaxDynamicSharedMemorySize, (int)LDS_BYTES);
    (void)hipOccupancyMaxActiveBlocksPerMultiprocessor(&per_cu, fwd_megakernel, 512, LDS_BYTES);
    if (per_cu < 1) per_cu = 1;
    if (per_cu > 1) per_cu = 1;
    grid_blocks = cus * per_cu;
  }
  if (ws_size < WS_NEED) fprintf(stderr, "workspace too small: %zu < %zu\n", ws_size, (size_t)WS_NEED);
  Params p{};
  for (int i = 0; i < 36; ++i) p.in[i] = (const float*)d_in[i];
  p.out = (float*)d_out;
  p.ws = (char*)d_ws;
  (void)hipMemsetAsync((char*)d_ws + OFF_BAR, 0, 256, stream);
  void* args[] = {&p};
  hipError_t e = hipLaunchCooperativeKernel((void*)fwd_megakernel, dim3(grid_blocks), dim3(512), args, LDS_BYTES, stream);
  if (e != hipSuccess) fprintf(stderr, "cooperative launch failed: %s (grid %d)\n", hipGetErrorString(e), grid_blocks);
}
```

```cpp
#include <hip/hip_runtime.h>
#include <hip/hip_cooperative_groups.h>
#include <cstdio>
namespace cg = cooperative_groups;

typedef unsigned short u16;
using bf16x8 = __attribute__((ext_vector_type(8))) short;
using f32x4 = __attribute__((ext_vector_type(4))) float;
using f32x16 = __attribute__((ext_vector_type(16))) float;
#define DI __device__ __forceinline__

constexpr int T = 40960;
constexpr int TP = 8192;
constexpr int TK = 43008;
constexpr float EPS = 1e-6f;
constexpr size_t LDS_BYTES = 139264;

constexpr size_t OFF_WMIXIN = 0;
constexpr size_t OFF_WMIXOUT = OFF_WMIXIN + (size_t)2 * 2560 * 1024 * 2;
constexpr size_t OFF_WDQKV = OFF_WMIXOUT + (size_t)2 * 1024 * 1024 * 2;
constexpr size_t OFF_WUQ = OFF_WDQKV + (size_t)2 * 1024 * 1024 * 2;
constexpr size_t OFF_WUKV = OFF_WUQ + (size_t)2 * 1536 * 512 * 2;
constexpr size_t OFF_WO = OFF_WUKV + (size_t)2 * 2048 * 256 * 2;
constexpr size_t OFF_WSGU = OFF_WO + (size_t)2 * 1024 * 1024 * 2;
constexpr size_t OFF_WUP = OFF_WSGU + (size_t)2 * 4 * 128 * 128 * 2;
constexpr size_t OFF_WDOWN = OFF_WUP + (size_t)5632 * 1024 * 2;
constexpr size_t OFF_MOD = OFF_WDOWN + (size_t)1024 * 2816 * 2;
constexpr size_t OFF_FILT = OFF_MOD + (size_t)4 * 9 * 6144 * 4;
constexpr size_t OFF_H2 = OFF_FILT + (size_t)2 * 2 * 512 * 4352 * 2;
constexpr size_t OFF_EDGE = OFF_H2 + (size_t)2 * 4352 * 64 * 4;
constexpr size_t OFF_KR = OFF_EDGE + (size_t)640 * 4 * 5632 * 2;
constexpr size_t OFF_A = OFF_KR + (size_t)TK * 64 * 2;
constexpr size_t OFF_B = OFF_A + (size_t)T * 1024 * 2;
constexpr size_t OFF_BAR = OFF_B + (size_t)346030080;
constexpr size_t WS_NEED = OFF_BAR + 256;
constexpr size_t A_H = 0, A_Z1 = 0, A_Z2 = (size_t)T * 512 * 2, A_QN = 0, A_CKV = (size_t)T * 512 * 2, A_O = 0;
constexpr size_t B_VT = 0, B_PRT = (size_t)T * 512 * 2, B_MIX = B_PRT + (size_t)T * 1536 * 2;
constexpr size_t B_DQKV = 0, B_Q = 0, B_K = (size_t)T * 1536 * 2, B_V = B_K + (size_t)TK * 1536 * 2;
constexpr size_t B_ACT = 0;
constexpr size_t VT_SAMPLE_OFF = (size_t)32 * 8 * 128 * 256;

struct Params {
  const float* in[36];
  float* out;
  char* ws;
};


constexpr int PARM_OFF = 138240;
struct PV {
  char* smem;
  DI unsigned long long ld(int k) const {
    int off = PARM_OFF + 8 * k;
    asm volatile("" : "+v"(off));
    const unsigned long long v = *(const unsigned long long*)(smem + off);
    const unsigned lo = __builtin_amdgcn_readfirstlane((unsigned)v), hi = __builtin_amdgcn_readfirstlane((unsigned)(v >> 32));
    return ((unsigned long long)hi << 32) | lo;
  }
  DI const float* in(int k) const { return (const float*)(const __attribute__((address_space(1))) float*)ld(k); }
  DI float* out() const { return (float*)(__attribute__((address_space(1))) float*)ld(36); }
  DI char* ws() const { return (char*)(__attribute__((address_space(1))) char*)ld(37); }
};

DI int TIDX() { int t = (int)__builtin_amdgcn_workitem_id_x(); asm volatile("" : "+v"(t)); return t; }
DI u16 f2bf(float x) { unsigned u = __float_as_uint(x); u += 0x7fffu + ((u >> 16) & 1u); return (u16)(u >> 16); }
DI float bf2f(u16 h) { return __uint_as_float(((unsigned)h) << 16); }
DI unsigned pack2(float a, float b) { unsigned r; asm("v_cvt_pk_bf16_f32 %0, %1, %2" : "=v"(r) : "v"(a), "v"(b)); return r; }
DI uint2 pack4(float a, float b, float c, float d) { uint2 r; r.x = pack2(a, b); r.y = pack2(c, d); return r; }
DI float lo16(unsigned w) { return __uint_as_float(w << 16); }
DI float hi16(unsigned w) { return __uint_as_float(w & 0xffff0000u); }
DI float gelu_tanh(float x) { const float y = x * (1.f + 0.044715f * x * x); return x * __builtin_amdgcn_rcpf(1.f + __builtin_amdgcn_exp2f(-2.302208198f * y)); }
DI float silu(float x) { return x * __builtin_amdgcn_rcpf(1.f + __builtin_amdgcn_exp2f(-1.4426950409f * x)); }
DI int condrow(int m) { return m < TP ? 0 : 1 + ((m - TP) >> 12); }
template <int MASK> DI float shx(float v, int lane) {
  if (MASK == 32) return __int_as_float(__builtin_amdgcn_ds_bpermute((lane ^ 32) << 2, __float_as_int(v)));
  return __int_as_float(__builtin_amdgcn_ds_swizzle(__float_as_int(v), (MASK << 10) | 0x1f));
}
DI float wave_sum(float v, int lane) {
  v += shx<32>(v, lane); v += shx<16>(v, lane); v += shx<8>(v, lane);
  v += shx<4>(v, lane); v += shx<2>(v, lane); v += shx<1>(v, lane); return v;
}
DI int opaque_i(int x) { asm volatile("" : "+s"(x)); return x; }
DI int first_unit(int base) { const int G = opaque_i((int)gridDim.x); int r = (int)blockIdx.x - (base % G); if (r < 0) r += G; return r; }
DI const float* xin_row(const PV& p, int l, int m) {
  if (l == 0) return m < TP ? p.in(0) + (size_t)m * 1024 : p.in(1) + (size_t)(m - TP) * 1024;
  return p.out() + (size_t)m * 1024;
}


DI void grid_barrier(unsigned* bar, unsigned& bar_no) {
  asm volatile("s_waitcnt vmcnt(0)" ::: "memory");
  __syncthreads();
  ++bar_no;
  if (TIDX() == 0) {
    __builtin_amdgcn_fence(__ATOMIC_RELEASE, "agent");
    asm volatile("s_waitcnt vmcnt(0)" ::: "memory");
    const unsigned target = bar_no * gridDim.x;
    __hip_atomic_fetch_add(bar, 1u, __ATOMIC_RELAXED, __HIP_MEMORY_SCOPE_AGENT);
    while (__hip_atomic_load(bar, __ATOMIC_RELAXED, __HIP_MEMORY_SCOPE_AGENT) < target) __builtin_amdgcn_s_sleep(1);
    __builtin_amdgcn_fence(__ATOMIC_ACQUIRE, "agent");
    asm volatile("s_waitcnt vmcnt(0)" ::: "memory");
  }
  __syncthreads();
}

template <int MODE>
DI int rowmap(int n, int row0) {
  if (MODE == 0) return n + row0;
  return n < 2816 ? (n >> 7) * 256 + (n & 127) : ((n - 2816) >> 7) * 256 + 128 + ((n - 2816) & 127);
}
template <int MODE>
DI void convT(const float* __restrict__ src, u16* __restrict__ dst, int K, int N, int row0, char* smem, int& base) {
  u16* tl = (u16*)smem;
  const int tid = TIDX();
  const int nN = N >> 6, nunits = (K >> 6) * nN;
  for (int u = first_unit(base); u < nunits; u += gridDim.x) {
    const int k0 = (u / nN) << 6, n0 = (u % nN) << 6;
#pragma unroll
    for (int i = 0; i < 2; ++i) {
      const int r = (tid >> 4) + 32 * i, c4 = (tid & 15) * 4;
      const float4 v = *(const float4*)(src + (size_t)(k0 + r) * N + n0 + c4);
      tl[(c4 + 0) * 72 + r] = f2bf(v.x); tl[(c4 + 1) * 72 + r] = f2bf(v.y);
      tl[(c4 + 2) * 72 + r] = f2bf(v.z); tl[(c4 + 3) * 72 + r] = f2bf(v.w);
    }
    __syncthreads();
    {
      const int n = tid >> 3, kc = (tid & 7) * 8;
      const uint4 v = *(const uint4*)(tl + n * 72 + kc);
      *(uint4*)(dst + (size_t)rowmap<MODE>(n0 + n, row0) * K + k0 + kc) = v;
    }
    __syncthreads();
  }
  base += nunits;
}

DI void convert_ffn_weights(const PV& p, int l, char* smem, int& base) {
  convT<1>(p.in(32) + (size_t)l * 1024 * 5632, (u16*)(p.ws() + OFF_WUP), 1024, 5632, 0, smem, base);
  convT<0>(p.in(35) + (size_t)l * 2816 * 1024, (u16*)(p.ws() + OFF_WDOWN), 2816, 1024, 0, smem, base);
}

DI void phase_prep(const PV& p, char* smem) {
  const int tid = TIDX();
  int base = 0;
  char* ws = p.ws();
  for (int i = 0; i < 2; ++i) {
    convT<0>(p.in(9) + (size_t)i * 1024 * 2560, (u16*)(ws + OFF_WMIXIN) + (size_t)i * 2560 * 1024, 1024, 2560, 0, smem, base);
    convT<0>(p.in(22) + (size_t)i * 1024 * 1024, (u16*)(ws + OFF_WMIXOUT) + (size_t)i * 1024 * 1024, 1024, 1024, 0, smem, base);
    convT<0>(p.in(23) + (size_t)i * 1024 * 512, (u16*)(ws + OFF_WDQKV) + (size_t)i * 1024 * 1024, 1024, 512, 0, smem, base);
    convT<0>(p.in(26) + (size_t)i * 1024 * 320, (u16*)(ws + OFF_WDQKV) + (size_t)i * 1024 * 1024, 1024, 320, 512, smem, base);
    convT<0>(p.in(25) + (size_t)i * 512 * 1536, (u16*)(ws + OFF_WUQ) + (size_t)i * 1536 * 512, 512, 1536, 0, smem, base);
    convT<0>(p.in(28) + (size_t)i * 256 * 2048, (u16*)(ws + OFF_WUKV) + (size_t)i * 2048 * 256, 256, 2048, 0, smem, base);
    convT<0>(p.in(31) + (size_t)i * 1024 * 1024, (u16*)(ws + OFF_WO) + (size_t)i * 1024 * 1024, 1024, 1024, 0, smem, base);
  }
  convert_ffn_weights(p, 0, smem, base);
  {
    const long gtid = (long)blockIdx.x * blockDim.x + tid, gsz = (long)gridDim.x * blockDim.x;
    for (long i = gtid; i < 2 * 192 * 1024; i += gsz) {
      const int j = (int)(i / (192 * 1024)), r = (int)(i % (192 * 1024));
      ((u16*)(ws + OFF_WDQKV))[(size_t)j * 1024 * 1024 + (size_t)832 * 1024 + r] = 0;
    }
    for (long i = gtid; i < 2 * 4 * 128 * 128; i += gsz) ((u16*)(ws + OFF_WSGU))[i] = f2bf(p.in(10)[i]);
  }
  {
    float* sc = (float*)smem;
    float* part = sc + 9 * 1024;
    __syncthreads();
    for (int i = tid; i < 9 * 1024; i += 512) {
      const int r = i >> 10, k = i & 1023;
      const float c = r == 0 ? p.in(5)[k] : p.in(4)[(r - 1) * 1024 + k];
      sc[i] = silu(c);
    }
    __syncthreads();
    float* MOD = (float*)(ws + OFF_MOD);
    const int nunits = 4 * 96;
    for (int u = first_unit(base); u < nunits; u += gridDim.x) {
      const int l = u / 96, n0 = (u % 96) * 64;
      const int col = n0 + (tid & 63), kg = tid >> 6;
      float acc[9];
#pragma unroll
      for (int r = 0; r < 9; ++r) acc[r] = 0.f;
      const float* w = p.in(6) + (size_t)l * 1024 * 6144 + col;
#pragma unroll 4
      for (int k = kg * 128; k < kg * 128 + 128; ++k) {
        const float wv = w[(size_t)k * 6144];
#pragma unroll
        for (int r = 0; r < 9; ++r) acc[r] += sc[r * 1024 + k] * wv;
      }
#pragma unroll
      for (int r = 0; r < 9; ++r) part[(kg * 9 + r) * 64 + (tid & 63)] = acc[r];
      __syncthreads();
      for (int i = tid; i < 576; i += 512) {
        const int r = i >> 6, cc = i & 63;
        float s = p.in(7)[l * 6144 + n0 + cc];
#pragma unroll
        for (int g = 0; g < 8; ++g) s += part[(g * 9 + r) * 64 + cc];
        MOD[(size_t)(l * 9 + r) * 6144 + n0 + cc] = s;
      }
      __syncthreads();
    }
    base += nunits;
  }
  {
    float* zf = (float*)smem;
    float* h1 = zf + 8 * 36;
    float* H2 = (float*)(ws + OFF_H2);
    const int nunits = 2 * 544;
    for (int u = first_unit(base); u < nunits; u += gridDim.x) {
      const int i = u / 544, tg0 = (u % 544) * 8;
      __syncthreads();
      if (tid < 8 * 33) {
        const int tt = tid / 33, e = tid % 33;
        const int tg = tg0 + tt;
        const float L = tg < 256 ? 256.f : 4096.f;
        const float t = tg < 256 ? (float)tg : (float)(tg - 256);
        const float tn = t / L;
        float v;
        if (e == 0) v = tn;
        else if (e <= 16) v = sinf((6.283185307179586f * tn) * (float)e);
        else v = cosf((6.283185307179586f * tn) * (float)(e - 16));
        zf[tt * 36 + e] = v;
      }
      __syncthreads();
      const int tt = tid >> 6, jj = tid & 63;
      const float fr = p.in(19)[i * 64 + jj];
      {
        float a = p.in(15)[i * 64 + jj];
        const float* w1 = p.in(14) + (size_t)i * 33 * 64 + jj;
        for (int e = 0; e < 33; ++e) a += zf[tt * 36 + e] * w1[e * 64];
        h1[tt * 64 + jj] = sinf(fr * a);
      }
      __syncthreads();
      {
        float a = p.in(17)[i * 64 + jj];
        const float* w2 = p.in(16) + (size_t)i * 64 * 64 + jj;
        for (int e = 0; e < 64; ++e) a += h1[tt * 64 + e] * w2[e * 64];
        H2[((size_t)i * 4352 + tg0 + tt) * 64 + jj] = sinf(fr * a);
      }
    }
    base += nunits;
    __syncthreads();
  }
}

DI void phase_filters(const PV& p, char* smem) {
  const int tid = TIDX();
  float* w3s = (float*)smem;
  float* red = w3s + 512;
  float* nrm = red + 512;
  float* hbuf = nrm + 8;
  const float* H2 = (const float*)(p.ws() + OFF_H2);
  u16* FILT = (u16*)(p.ws() + OFF_FILT);
  for (int u = blockIdx.x; u < 512; u += gridDim.x) {
    const int kind = (u >> 7) & 1, i = u >> 8, cg8 = (u & 127) * 8;
    const int L = kind ? 4096 : 256, tbase = kind ? 256 : 0;
    __syncthreads();
    { const int j = tid >> 3, cc = tid & 7; w3s[j * 8 + cc] = p.in(18)[((size_t)i * 64 + j) * 1024 + cg8 + cc]; }
    __syncthreads();
    const int cc = tid & 7, tq = tid >> 3;
    const int col = cg8 + cc, o = col >> 9, c = col & 511;
    const float dec = fabsf(p.in(20)[(i * 2 + o) * 512 + c]);
    float asum = 0.f;
    for (int t = tq; t < L; t += 64) {
      const float4* hr = (const float4*)(H2 + ((size_t)i * 4352 + tbase + t) * 64);
      float a = 0.f;
#pragma unroll
      for (int j4 = 0; j4 < 16; ++j4) {
        const float4 hv = hr[j4];
        a += hv.x * w3s[(j4 * 4 + 0) * 8 + cc]; a += hv.y * w3s[(j4 * 4 + 1) * 8 + cc];
        a += hv.z * w3s[(j4 * 4 + 2) * 8 + cc]; a += hv.w * w3s[(j4 * 4 + 3) * 8 + cc];
      }
      const float dist = fabsf((float)(t - L / 2)) / (float)L;
      a *= expf(-dec * dist);
      hbuf[cc * L + t] = a;
      asum += fabsf(a);
    }
    red[tid] = asum;
    __syncthreads();
    if (tid < 8) { float s = 0.f; for (int q = 0; q < 64; ++q) s += red[q * 8 + tid]; nrm[tid] = 1.f / (s + EPS); }
    __syncthreads();
    for (int idx = tid; idx < 8 * L; idx += 512) {
      const int c2 = idx / L, t = idx - c2 * L;
      const int col2 = cg8 + c2, o2 = col2 >> 9, cch = col2 & 511;
      FILT[((size_t)(i * 2 + o2) * 512 + cch) * 4352 + tbase + t] = f2bf(hbuf[c2 * L + t] * nrm[c2]);
    }
  }
  __syncthreads();
}

DI void phase_norm(const PV& p, int l, int part, int lx) {
  const int tid_ = TIDX(); const int lane = tid_ & 63, wid = tid_ >> 6;
  const float* MOD = (const float*)(p.ws() + OFF_MOD);
  const float* g = p.in(8) + (size_t)(l * 2 + part) * 1024;
  u16* H = (u16*)(p.ws() + OFF_A + A_H);
  for (int row = blockIdx.x * 8 + wid; row < T; row += gridDim.x * 8) {
    const float* xr = xin_row(p, lx, row);
    float4 v[4];
    float ss = 0.f;
#pragma unroll
    for (int i = 0; i < 4; ++i) {
      v[i] = *(const float4*)(xr + (i * 64 + lane) * 4);
      ss += v[i].x * v[i].x + v[i].y * v[i].y + v[i].z * v[i].z + v[i].w * v[i].w;
    }
    ss = wave_sum(ss, lane);
    const float r = rsqrtf(ss * (1.f / 1024.f) + EPS);
    const float* mr = MOD + (size_t)(l * 9 + condrow(row)) * 6144 + part * 3072;
#pragma unroll
    for (int i = 0; i < 4; ++i) {
      const int k = (i * 64 + lane) * 4;
      const float4 gv = *(const float4*)(g + k), sh = *(const float4*)(mr + k), sc = *(const float4*)(mr + 1024 + k);
      const float a = v[i].x * r * gv.x * (1.f + sc.x) + sh.x;
      const float b = v[i].y * r * gv.y * (1.f + sc.y) + sh.y;
      const float c = v[i].z * r * gv.z * (1.f + sc.z) + sh.z;
      const float d = v[i].w * r * gv.w * (1.f + sc.w) + sh.w;
      *(uint2*)(H + (size_t)row * 1024 + k) = pack4(a, b, c, d);
    }
  }
}

template <bool SWAP, class Epi, class Pre>
DI void gemm_tile(const u16* A, int lda, const u16* Bt, int ldb, int K, int m0, int n0, char* smem, Epi epi, Pre pre) {
  const int tid = TIDX(), lane = tid & 63, wid = tid >> 6;
  const int wm = wid >> 1, wn = wid & 1, fr = lane & 15, fq = lane >> 4;
  const int lrow = tid >> 3, kc = tid & 7;
  const u16* ga = A + (size_t)(m0 + lrow) * lda + kc * 8;
  const u16* gb = Bt + (size_t)(n0 + lrow) * ldb + kc * 8;
  const int soff = lrow * 128 + ((kc ^ (lrow & 7)) << 4);
  uint4 ra[4], rb[2];
  f32x4 acc[4][4];
#pragma unroll
  for (int i = 0; i < 4; ++i)
#pragma unroll
    for (int j = 0; j < 4; ++j) acc[i][j] = f32x4{0.f, 0.f, 0.f, 0.f};
  const int nk = K >> 6;
#pragma unroll
  for (int i = 0; i < 4; ++i) ra[i] = *(const uint4*)(ga + (size_t)(64 * i) * lda);
#pragma unroll
  for (int i = 0; i < 2; ++i) rb[i] = *(const uint4*)(gb + (size_t)(64 * i) * ldb);
#pragma unroll
  for (int i = 0; i < 4; ++i) *(uint4*)(smem + soff + i * 8192) = ra[i];
#pragma unroll
  for (int i = 0; i < 2; ++i) *(uint4*)(smem + 32768 + soff + i * 8192) = rb[i];
  __syncthreads();
  for (int kt = 0; kt < nk; ++kt) {
    const bool more = kt + 1 < nk;
    if (more) {
      const int k0 = (kt + 1) << 6;
#pragma unroll
      for (int i = 0; i < 4; ++i) ra[i] = *(const uint4*)(ga + (size_t)(64 * i) * lda + k0);
#pragma unroll
      for (int i = 0; i < 2; ++i) rb[i] = *(const uint4*)(gb + (size_t)(64 * i) * ldb + k0);
    }
    const char* sa = smem + (kt & 1) * 49152;
    const char* sb = sa + 32768;
#pragma unroll
    for (int ks = 0; ks < 2; ++ks) {
      bf16x8 af[4], bfv[4];
      const int co = ((ks * 4 + fq) ^ (fr & 7)) << 4;
#pragma unroll
      for (int mi = 0; mi < 4; ++mi) af[mi] = *(const bf16x8*)(sa + (wm * 64 + mi * 16 + fr) * 128 + co);
#pragma unroll
      for (int ni = 0; ni < 4; ++ni) bfv[ni] = *(const bf16x8*)(sb + (wn * 64 + ni * 16 + fr) * 128 + co);
#pragma unroll
      for (int mi = 0; mi < 4; ++mi)
#pragma unroll
        for (int ni = 0; ni < 4; ++ni)
          acc[mi][ni] = SWAP ? __builtin_amdgcn_mfma_f32_16x16x32_bf16(bfv[ni], af[mi], acc[mi][ni], 0, 0, 0)
                             : __builtin_amdgcn_mfma_f32_16x16x32_bf16(af[mi], bfv[ni], acc[mi][ni], 0, 0, 0);
    }
    if (more) {
      char* da = smem + ((kt + 1) & 1) * 49152;
#pragma unroll
      for (int i = 0; i < 4; ++i) *(uint4*)(da + soff + i * 8192) = ra[i];
#pragma unroll
      for (int i = 0; i < 2; ++i) *(uint4*)(da + 32768 + soff + i * 8192) = rb[i];
    }
    __syncthreads();
  }
  uint2 pv[4][4];
#pragma unroll
  for (int mi = 0; mi < 4; ++mi)
#pragma unroll
    for (int ni = 0; ni < 4; ++ni) {
      if (SWAP) pv[mi][ni] = pre(m0 + wm * 64 + mi * 16 + fr, n0 + wn * 64 + ni * 16 + fq * 4);
      else pv[mi][ni] = pre(m0 + wm * 64 + mi * 16 + fq * 4, n0 + wn * 64 + ni * 16 + fr);
    }
#pragma unroll
  for (int mi = 0; mi < 4; ++mi)
#pragma unroll
    for (int ni = 0; ni < 4; ++ni) {
      if (SWAP) epi(m0 + wm * 64 + mi * 16 + fr, n0 + wn * 64 + ni * 16 + fq * 4, acc[mi][ni], pv[mi][ni]);
      else epi(m0 + wm * 64 + mi * 16 + fq * 4, n0 + wn * 64 + ni * 16 + fr, acc[mi][ni], pv[mi][ni]);
    }
}

template <class F>
DI void for_tiles(int nM, int nN, int sm, int sn, F f) {
  if (gridDim.x == 256) {
    const int xcd = blockIdx.x & 7, slot = blockIdx.x >> 3;
    const int am = slot % sm, bn = slot / sm;
    const int nSN = (nN + sn - 1) / sn, nS = (nM / sm) * nSN;
    for (int st = xcd; st < nS; st += 8) {
      const int tm = (st / nSN) * sm + am, tn = (st % nSN) * sn + bn;
      if (tn < nN) f(tm, tn);
    }
  } else {
    for (int t = blockIdx.x; t < nM * nN; t += gridDim.x) f(t / nN, t % nN);
  }
}


#define LAS __attribute__((address_space(3)))
constexpr int G8_HTB = 128 * 64 * 2;
DI int g8_lds_byte(int r, int c) { const int st = (r >> 4) * 2 + (c >> 5), rr = r & 15, cc = c & 31, ob = rr * 64 + cc * 2; return st * 1024 + (ob ^ (((ob >> 9) & 1) << 5)); }
DI void g8_stage_rc(int b, int& R, int& C) { const int st = b / 1024, sb = b % 1024, swz = sb ^ (((sb >> 9) & 1) << 5); R = (st >> 1) * 16 + swz / 64; C = (st & 1) * 32 + (swz % 64) / 2; }
template <int NM, int NN, int NN1, int SM1, int SN1, int SM2, int SN2>
struct TileSched {
  static constexpr int nSN1 = NN1 / SN1, nS1 = (NM / SM1) * nSN1, nSN2 = (NN - NN1) / SN2, nS2 = (NM / SM2) * nSN2, nT = NM * NN;
  int c;
  DI void init() { c = blockIdx.x; }
  DI bool next(int i, int& pm, int& pn) const {
    if (gridDim.x == 256) {
      const int xcd = c & 7, slot = c >> 3;
      int st = xcd + 8 * i;
      if (st < nS1) { pm = (st / nSN1) * SM1 + slot % SM1; pn = (st % nSN1) * SN1 + slot / SM1; return true; }
      st -= nS1;
      if (nS2 == 0 || st >= nS2) return false;
      pm = (st / (nSN2 > 0 ? nSN2 : 1)) * SM2 + slot % SM2; pn = NN1 + (st % (nSN2 > 0 ? nSN2 : 1)) * SN2 + slot / SM2; return true;
    }
    const int L = i * (int)gridDim.x + c; if (L >= nT) return false; pm = L / NN; pn = L % NN; return true;
  }
};
template <class Sched, class Epi>
DI void gemm8(char* smem, const u16* A, const u16* Bt, int K, const Sched& S, const Epi& E) {
  LAS unsigned char* lds = (LAS unsigned char*)smem;
  const int tid = TIDX(), wid = __builtin_amdgcn_readfirstlane(tid >> 6), lane = tid & 63, wr = wid >> 2, wc = wid & 3, fr = lane & 15, fq = lane >> 4;
  const int nt = K / 64;
  unsigned voff[2];
#pragma unroll
  for (int i = 0; i < 2; ++i) { int R, C; g8_stage_rc(tid * 16 + i * 8192, R, C); voff[i] = (unsigned)(R * K + C) * 2u; }
  const size_t kstep = 128, hstep = (size_t)128 * K * 2, tstep = 2 * hstep;
  const unsigned ldsw = (unsigned)wid * 1024u;
  const int aoff = g8_lds_byte(wr * 64 + fr, fq * 8), boff = g8_lds_byte(wc * 32 + fr, fq * 8);
#define G8_SA(b, h) (((b) * 2 + (h)) * G8_HTB)
#define G8_SB(b, h) ((4 + (b) * 2 + (h)) * G8_HTB)
#define G8_STAGE(bufoff, gbase) do { _Pragma("unroll") for (int _i = 0; _i < 2; ++_i) \
    __builtin_amdgcn_global_load_lds((const unsigned*)((const char*)(gbase) + voff[_i]), (LAS unsigned*)(lds + (bufoff) + ldsw + _i * 8192), 16, 0, 0); } while (0)
#define G8_LDA(dst, b, h) do { _Pragma("unroll") for (int m = 0; m < 4; ++m) _Pragma("unroll") for (int k = 0; k < 2; ++k) dst[m][k] = *(const LAS bf16x8*)(lds + G8_SA(b, h) + aoff + m * 2048 + k * 1024); } while (0)
#define G8_LDB(dst, b, h) do { _Pragma("unroll") for (int n = 0; n < 2; ++n) _Pragma("unroll") for (int k = 0; k < 2; ++k) dst[n][k] = *(const LAS bf16x8*)(lds + G8_SB(b, h) + boff + n * 2048 + k * 1024); } while (0)
#define G8_MMA(ai, bj, At_, Bt_) do { __builtin_amdgcn_s_setprio(1); _Pragma("unroll") for (int m = 0; m < 4; ++m) _Pragma("unroll") for (int n = 0; n < 2; ++n) _Pragma("unroll") for (int k = 0; k < 2; ++k) \
    acc[ai][bj][m][n] = __builtin_amdgcn_mfma_f32_16x16x32_bf16(Bt_[n][k], At_[m][k], acc[ai][bj][m][n], 0, 0, 0); __builtin_amdgcn_s_setprio(0); } while (0)
#define G8_WAIT_V(n) asm volatile("s_waitcnt vmcnt(" #n ")" ::: "memory")
#define G8_WAIT_L(n) asm volatile("s_waitcnt lgkmcnt(" #n ")" ::: "memory")
#define G8_BAR __builtin_amdgcn_s_barrier()
#define G8_SCHED __builtin_amdgcn_sched_barrier(0)
  int cpm, cpn, npm = 0, npn = 0, ui = 0;
  if (!S.next(0, cpm, cpn)) return;
  f32x4 acc[2][2][4][2];
#pragma unroll
  for (int a = 0; a < 2; ++a)
#pragma unroll
    for (int b = 0; b < 2; ++b)
#pragma unroll
      for (int m = 0; m < 4; ++m)
#pragma unroll
        for (int n = 0; n < 2; ++n) acc[a][b][m][n] = f32x4{0.f, 0.f, 0.f, 0.f};
  bf16x8 At[4][2], B0[2][2], B1[2][2];
  const char* cA = (const char*)A + (size_t)cpm * tstep; const char* cB = (const char*)Bt + (size_t)cpn * tstep;
  G8_STAGE(G8_SB(0, 0), cB); G8_STAGE(G8_SA(0, 0), cA); G8_STAGE(G8_SB(0, 1), cB + hstep); G8_STAGE(G8_SA(0, 1), cA + hstep);
  if (wr == 1) G8_BAR;
  G8_WAIT_V(4); G8_BAR;
  G8_STAGE(G8_SB(1, 0), cB + kstep); G8_STAGE(G8_SA(1, 0), cA + kstep); G8_STAGE(G8_SB(1, 1), cB + hstep + kstep);
  G8_WAIT_V(6); G8_BAR;
  for (;;) {
    const bool has_next = S.next(ui + 1, npm, npn);
    const char* nA = has_next ? (const char*)A + (size_t)npm * tstep : cA; const char* nB = has_next ? (const char*)Bt + (size_t)npn * tstep : cB;
    for (int t = 0; t < nt; t += 2) {
      const bool last = (t == nt - 2);
      const char* a1 = cA + (size_t)(t + 1) * kstep;
      const char* a2 = last ? nA : cA + (size_t)(t + 2) * kstep; const char* b2 = last ? nB : cB + (size_t)(t + 2) * kstep;
      const char* a3 = a2 + kstep; const char* b3 = b2 + kstep;
      G8_LDB(B0, 0, 0); G8_SCHED; G8_LDA(At, 0, 0); G8_STAGE(G8_SA(1, 1), a1 + hstep);
      G8_WAIT_L(8); G8_BAR; G8_WAIT_L(0); G8_MMA(0, 0, At, B0); G8_BAR; G8_SCHED;
      G8_LDB(B1, 0, 1); G8_STAGE(G8_SB(0, 0), b2);
      G8_BAR; G8_WAIT_L(0); G8_MMA(0, 1, At, B1); G8_BAR;
      G8_LDA(At, 0, 1); G8_STAGE(G8_SA(0, 0), a2);
      G8_BAR; G8_WAIT_L(0); G8_MMA(1, 0, At, B0); G8_BAR; G8_SCHED;
      G8_STAGE(G8_SB(0, 1), b2 + hstep);
      G8_WAIT_V(6); G8_BAR; G8_MMA(1, 1, At, B1); G8_BAR;
      G8_LDB(B0, 1, 0); G8_SCHED; G8_LDA(At, 1, 0); G8_STAGE(G8_SA(0, 1), a2 + hstep);
      G8_WAIT_L(8); G8_BAR; G8_WAIT_L(0); G8_MMA(0, 0, At, B0); G8_BAR; G8_SCHED;
      G8_LDB(B1, 1, 1); G8_STAGE(G8_SB(1, 0), b3);
      G8_BAR; G8_WAIT_L(0); G8_MMA(0, 1, At, B1); G8_BAR;
      G8_LDA(At, 1, 1); G8_STAGE(G8_SA(1, 0), a3);
      G8_BAR; G8_WAIT_L(0); G8_MMA(1, 0, At, B0); G8_BAR; G8_SCHED;
      G8_STAGE(G8_SB(1, 1), b3 + hstep);
      G8_WAIT_V(6); G8_BAR; G8_MMA(1, 1, At, B1); G8_BAR;
    }
    { const int t2 = TIDX(), w2 = __builtin_amdgcn_readfirstlane(t2 >> 6), l2 = t2 & 63; E(acc, cpm, cpn, w2 >> 2, w2 & 3, l2 & 15, l2 >> 4); }
    if (!has_next) break;
#pragma unroll
    for (int a = 0; a < 2; ++a)
#pragma unroll
      for (int b = 0; b < 2; ++b)
#pragma unroll
        for (int m = 0; m < 4; ++m)
#pragma unroll
          for (int n = 0; n < 2; ++n) acc[a][b][m][n] = f32x4{0.f, 0.f, 0.f, 0.f};
    cpm = npm; cpn = npn; cA = nA; cB = nB; ++ui;
  }
  G8_WAIT_V(0);
  if (wr == 0) G8_BAR;
  G8_BAR;
#undef G8_SA
#undef G8_SB
#undef G8_STAGE
#undef G8_LDA
#undef G8_LDB
#undef G8_MMA
#undef G8_WAIT_V
#undef G8_WAIT_L
#undef G8_BAR
#undef G8_SCHED
}
template <class F> struct ElemEpi {
  F f;
  DI void operator()(const f32x4 (&acc)[2][2][4][2], int pm, int pn, int wr, int wc, int fr, int fq) const {
    const int row0 = pm * 256 + wr * 64 + fr, col0 = pn * 256 + wc * 32 + 4 * fq;
#pragma unroll
    for (int ai = 0; ai < 2; ++ai)
#pragma unroll
      for (int m = 0; m < 4; ++m)
#pragma unroll
        for (int bj = 0; bj < 2; ++bj)
#pragma unroll
          for (int n = 0; n < 2; ++n) f(row0 + ai * 128 + m * 16, col0 + bj * 128 + n * 16, acc[ai][bj][m][n]);
  }
};
template <class F> DI ElemEpi<F> make_epi(F f) { return ElemEpi<F>{f}; }
template <int NM, int NN, int NN1, int SM1, int SN1, int SM2, int SN2, class F>
DI void gemm8_job(char* smem, const u16* A, const u16* Bt, int K, F f) {
  TileSched<NM, NN, NN1, SM1, SN1, SM2, SN2> S; S.init();
  gemm8(smem, A, Bt, K, S, make_epi(f));
}

DI void phase_mix_in(const PV& p, int i, char* smem) {
  const u16* H = (const u16*)(p.ws() + OFF_A + A_H);
  const u16* W = (const u16*)(p.ws() + OFF_WMIXIN) + (size_t)i * 2560 * 1024;
  u16* MIX = (u16*)(p.ws() + OFF_B + B_MIX);
  u16* VT = (u16*)(p.ws() + OFF_B + B_VT);
  u16* PRT = (u16*)(p.ws() + OFF_B + B_PRT);
  auto epi = [=](int m, int n, f32x4 v) {
    if (n < 512) {
      *(uint2*)(MIX + (size_t)m * 1024 + n) = pack4(gelu_tanh(v[0]), gelu_tanh(v[1]), gelu_tanh(v[2]), gelu_tanh(v[3]));
    } else if (n < 1024) {
      const int nn = n - 512, g = nn >> 7, c = nn & 127, chunk = m >> 7, q = m & 127;
      u16* b = VT + ((size_t)(g * 320 + chunk) * 128 + c) * 128 + q;
#pragma unroll
      for (int j = 0; j < 4; ++j) b[j * 128] = f2bf(gelu_tanh(v[j]));
    } else {
      const int cp = n - 1024;
      size_t off; int stride;
      if (m < TP) { off = (size_t)(m & ~255) * 1536 + (size_t)cp * 256 + (m & 255); stride = 256; }
      else { const int mm = m - TP; off = (size_t)(TP + (mm & ~4095)) * 1536 + (size_t)cp * 4096 + (mm & 4095); stride = 4096; }
#pragma unroll
      for (int j = 0; j < 4; ++j) PRT[off + (size_t)j * stride] = f2bf(v[j]);
    }
  };
  gemm8_job<160, 10, 8, 8, 4, 16, 2>(smem, H, W, 1024, epi);
}

DI void phase_sgu(const PV& p, int i, char* smem) {
  const u16* VT = (const u16*)(p.ws() + OFF_B + B_VT);
  const u16* W = (const u16*)(p.ws() + OFF_WSGU) + (size_t)i * 4 * 16384;
  u16* MIX = (u16*)(p.ws() + OFF_B + B_MIX);
  const float* sb = p.in(11) + i * 512;
  for (int u = blockIdx.x; u < 640; u += gridDim.x) {
    const int g = u / 160, tm = u % 160;
    auto epi = [=](int m, int n, f32x4 v, uint2 uu) {
      const int chunk = m >> 7, c = m & 127;
      const int t = chunk * 128 + n;
      const float bias = sb[g * 128 + n];
      u16* dst = MIX + (size_t)t * 1024 + g * 128 + c;
      *(uint2*)dst = pack4(lo16(uu.x) * (v[0] + bias), hi16(uu.x) * (v[1] + bias), lo16(uu.y) * (v[2] + bias), hi16(uu.y) * (v[3] + bias));
    };
    auto pre = [=](int m, int n) { return *(const uint2*)(MIX + (size_t)((m >> 7) * 128 + n) * 1024 + g * 128 + (m & 127)); };
    gemm_tile<false>(VT + (size_t)g * 320 * 128 * 128, 128, W + (size_t)g * 16384, 128, 128, tm * 256, 0, smem, epi, pre);
  }
}

DI size_t prt_off(int kind, int b, int cp) {
  return kind ? (size_t)(TP + b * 4096) * 1536 + (size_t)cp * 4096 : (size_t)(b * 256) * 1536 + (size_t)cp * 256;
}
DI size_t zt_off(int kind, int b, int c) {
  return kind ? (size_t)(TP + b * 4096) * 512 + (size_t)c * 4096 : (size_t)(b * 256) * 512 + (size_t)c * 256;
}
DI void phase_conv(const PV& p, int i, int ord, char* smem) {
  const int tid = TIDX(), lane = tid & 63, wid = tid >> 6;
  const u16* PRT = (const u16*)(p.ws() + OFF_B + B_PRT);
  const u16* FILT = (const u16*)(p.ws() + OFF_FILT);
  const u16* Z1 = (const u16*)(p.ws() + OFF_A + A_Z1);
  u16* ZO = (u16*)(p.ws() + OFF_A + (ord ? A_Z2 : A_Z1));
  const float* cw = p.in(12) + (size_t)i * 3 * 1536;
  const float* cb = p.in(13) + (size_t)i * 1536;
  u16* hc = (u16*)smem;
  char* Ub = smem + 68096;
  for (int u = blockIdx.x; u < 1024; u += gridDim.x) {
    const int kind = u < 512 ? 1 : 0, c = u & 511;
    const int L = kind ? 4096 : 256, NB = kind ? 8 : 32, LB = L >> 6, DD = L >> 7;
    const int US = (L + 8) * 2;
    const size_t fbase = ((size_t)(i * 2 + ord) * 512 + c) * 4352 + (kind ? 256 : 0);
    __syncthreads();
    for (int idx = tid; idx < 8 * (L + 136); idx += 512) {
      const int cpy = idx / (L + 136), m = idx - cpy * (L + 136);
      const int x = L + 63 - m - cpy;
      hc[cpy * 4256 + m] = (x >= 0 && x < L) ? FILT[fbase + x] : (u16)0;
    }
    {
      const int ncr = L >> 3, total = NB * ncr;
      const float w0 = cw[c], w1 = cw[1536 + c], w2 = cw[3072 + c], bb = cb[c];
      for (int id = tid; id < total; id += 512) {
        const int b = id / ncr, t = (id - b * ncr) * 8;
        uint4 o;
        if (ord == 0) {
          const u16* src = PRT + prt_off(kind, b, c) + t;
          const uint4 raw = *(const uint4*)src;
          float e[10];
          e[0] = t > 0 ? bf2f(src[-1]) : 0.f;
          e[9] = t + 8 < L ? bf2f(src[8]) : 0.f;
          e[1] = lo16(raw.x); e[2] = hi16(raw.x); e[3] = lo16(raw.y); e[4] = hi16(raw.y);
          e[5] = lo16(raw.z); e[6] = hi16(raw.z); e[7] = lo16(raw.w); e[8] = hi16(raw.w);
          float r[8];
#pragma unroll
          for (int k = 0; k < 8; ++k) r[k] = w0 * e[k] + w1 * e[k + 1] + w2 * e[k + 2] + bb;
          o.x = pack2(r[0], r[1]); o.y = pack2(r[2], r[3]); o.z = pack2(r[4], r[5]); o.w = pack2(r[6], r[7]);
        } else {
          o = *(const uint4*)(Z1 + zt_off(kind, b, c) + t);
        }
        *(uint4*)(Ub + b * US + t * 2) = o;
      }
    }
    __syncthreads();
    const int ncols = LB * NB;
    if (wid * 64 < ncols) {
      const int il = lane & 31, q = lane >> 5;
      int t1c[2], bc[2];
#pragma unroll
      for (int nt = 0; nt < 2; ++nt) { const int col = wid * 64 + nt * 32 + il; t1c[nt] = col / NB; bc[nt] = col % NB; }
      const int t1lo = (wid * 64) / NB, t1hi = (wid * 64 + 63) / NB;
      const int dlo = max(-DD, t1lo - (LB - 1)), dhi = min(DD, t1hi);
      const int cpy = 7 - (il & 7);
      const char* abase = (const char*)hc + cpy * 8512 + 2 * (L / 2 + 63 - il - cpy + 8 * q);
      f32x16 acc[2][2];
#pragma unroll
      for (int a = 0; a < 2; ++a)
#pragma unroll
        for (int b = 0; b < 2; ++b)
#pragma unroll
          for (int r = 0; r < 16; ++r) acc[a][b][r] = 0.f;
      for (int d = dlo; d <= dhi; ++d) {
        bf16x8 bfr[2][4];
#pragma unroll
        for (int nt = 0; nt < 2; ++nt) {
          const int s1 = t1c[nt] - d;
          const bool valid = s1 >= 0 && s1 < LB;
          const char* bp = Ub + bc[nt] * US + ((valid ? s1 : 0) * 64 + 8 * q) * 2;
#pragma unroll
          for (int ks = 0; ks < 4; ++ks) {
            bf16x8 v = *(const bf16x8*)(bp + ks * 32);
            if (!valid) v = bf16x8{0, 0, 0, 0, 0, 0, 0, 0};
            bfr[nt][ks] = v;
          }
        }
#pragma unroll
        for (int mt = 0; mt < 2; ++mt)
#pragma unroll
          for (int ks = 0; ks < 4; ++ks) {
            const bf16x8 af = *(const bf16x8*)(abase + 2 * (-64 * d - 32 * mt + 16 * ks));
#pragma unroll
            for (int nt = 0; nt < 2; ++nt) acc[mt][nt] = __builtin_amdgcn_mfma_f32_32x32x16_bf16(af, bfr[nt][ks], acc[mt][nt], 0, 0, 0);
          }
      }
      const float dsk = p.in(21)[(i * 2 + ord) * 512 + c];
      const int gc = 512 * (ord + 1) + c;
      const float w0 = cw[gc], w1 = cw[1536 + gc], w2 = cw[3072 + gc], bb = cb[gc];
#pragma unroll
      for (int nt = 0; nt < 2; ++nt) {
        const int b = bc[nt];
        const u16* xrow = PRT + prt_off(kind, b, gc);
        u16* orow = ZO + zt_off(kind, b, c);
#pragma unroll
        for (int mt = 0; mt < 2; ++mt)
#pragma unroll
          for (int g = 0; g < 4; ++g) {
            const int t = 64 * t1c[nt] + mt * 32 + 8 * g + 4 * q;
            const uint2 uu = *(const uint2*)(Ub + b * US + t * 2);
            const uint2 xx = *(const uint2*)(xrow + t);
            const float em = t > 0 ? bf2f(xrow[t - 1]) : 0.f;
            const float ep = t + 4 < L ? bf2f(xrow[t + 4]) : 0.f;
            const float e0 = lo16(xx.x), e1 = hi16(xx.x), e2 = lo16(xx.y), e3 = hi16(xx.y);
            const float x0 = w0 * em + w1 * e0 + w2 * e1 + bb;
            const float x1 = w0 * e0 + w1 * e1 + w2 * e2 + bb;
            const float x2 = w0 * e1 + w1 * e2 + w2 * e3 + bb;
            const float x3 = w0 * e2 + w1 * e3 + w2 * ep + bb;
            const float y0 = acc[mt][nt][4 * g + 0] + lo16(uu.x) * dsk;
            const float y1 = acc[mt][nt][4 * g + 1] + hi16(uu.x) * dsk;
            const float y2 = acc[mt][nt][4 * g + 2] + lo16(uu.y) * dsk;
            const float y3 = acc[mt][nt][4 * g + 3] + hi16(uu.y) * dsk;
            *(uint2*)(orow + t) = pack4(x0 * y0, x1 * y1, x2 * y2, x3 * y3);
          }
      }
    }
  }
  __syncthreads();
}

DI void phase_ztrans(const PV& p, char* smem) {
  const int tid = TIDX();
  const u16* Z2 = (const u16*)(p.ws() + OFF_A + A_Z2);
  u16* MIX = (u16*)(p.ws() + OFF_B + B_MIX);
  u16* tl = (u16*)smem;
  for (int u = blockIdx.x; u < 640 * 8; u += gridDim.x) {
    const int tt0 = (u >> 3) * 64, c0 = (u & 7) * 64;
    const int kind = tt0 >= TP ? 1 : 0;
    const int b = kind ? (tt0 - TP) >> 12 : tt0 >> 8;
    const int tl0 = kind ? (tt0 - TP) & 4095 : tt0 & 255;
    __syncthreads();
    { const int c = tid >> 3, ch = tid & 7;
      *(uint4*)(tl + c * 72 + ch * 8) = *(const uint4*)(Z2 + zt_off(kind, b, c0 + c) + tl0 + ch * 8); }
    __syncthreads();
    { const int tr = tid >> 3, cc = (tid & 7) * 8;
      uint4 o;
      o.x = (unsigned)tl[(cc + 0) * 72 + tr] | ((unsigned)tl[(cc + 1) * 72 + tr] << 16);
      o.y = (unsigned)tl[(cc + 2) * 72 + tr] | ((unsigned)tl[(cc + 3) * 72 + tr] << 16);
      o.z = (unsigned)tl[(cc + 4) * 72 + tr] | ((unsigned)tl[(cc + 5) * 72 + tr] << 16);
      o.w = (unsigned)tl[(cc + 6) * 72 + tr] | ((unsigned)tl[(cc + 7) * 72 + tr] << 16);
      *(uint4*)(MIX + (size_t)(tt0 + tr) * 1024 + 512 + c0 + cc) = o; }
  }
  __syncthreads();
}

struct EpiResid {
  float* X; const float* x0; const float* x1; const float* gate; int lx;
  DI void operator()(const f32x4 (&acc)[2][2][4][2], int pm, int pn, int wr, int wc, int fr, int fq) const {
    const int rowt = pm * 256, col0 = pn * 256 + wc * 32 + 4 * fq;
    const float* gr = gate + (size_t)condrow(rowt) * 6144 + col0;
    const float* xb = lx == 0 ? (rowt < TP ? x0 + (size_t)rowt * 1024 : x1 + (size_t)(rowt - TP) * 1024) : X + (size_t)rowt * 1024;
    float4 g[2][2];
#pragma unroll
    for (int bj = 0; bj < 2; ++bj)
#pragma unroll
      for (int n = 0; n < 2; ++n) g[bj][n] = *(const float4*)(gr + bj * 128 + n * 16);
#pragma unroll
    for (int ai = 0; ai < 2; ++ai)
#pragma unroll
      for (int mh = 0; mh < 2; ++mh) {
        float4 xo[2][2][2];
#pragma unroll
        for (int mm = 0; mm < 2; ++mm)
#pragma unroll
          for (int bj = 0; bj < 2; ++bj)
#pragma unroll
            for (int n = 0; n < 2; ++n)
              xo[mm][bj][n] = *(const float4*)(xb + (size_t)(wr * 64 + fr + ai * 128 + (2 * mh + mm) * 16) * 1024 + col0 + bj * 128 + n * 16);
#pragma unroll
        for (int mm = 0; mm < 2; ++mm)
#pragma unroll
          for (int bj = 0; bj < 2; ++bj)
#pragma unroll
            for (int n = 0; n < 2; ++n) {
              const f32x4 v = acc[ai][bj][2 * mh + mm][n];
              const float4 x = xo[mm][bj][n], gg = g[bj][n];
              float4 o; o.x = x.x + gg.x * v[0]; o.y = x.y + gg.y * v[1]; o.z = x.z + gg.z * v[2]; o.w = x.w + gg.w * v[3];
              *(float4*)(X + (size_t)(rowt + wr * 64 + fr + ai * 128 + (2 * mh + mm) * 16) * 1024 + col0 + bj * 128 + n * 16) = o;
            }
      }
  }
};
DI void phase_resid_gemm(const PV& p, int l, int lx, const u16* A, int K, const u16* W, int goff, char* smem) {
  EpiResid E;
  E.X = p.out(); E.x0 = p.in(0); E.x1 = p.in(1); E.gate = (const float*)(p.ws() + OFF_MOD) + (size_t)l * 9 * 6144 + goff; E.lx = lx;
  TileSched<160, 4, 4, 8, 4, 32, 1> S; S.init();
  gemm8(smem, A, W, K, S, E);
}

DI void phase_dqkv(const PV& p, int j, char* smem) {
  const u16* H = (const u16*)(p.ws() + OFF_A + A_H);
  const u16* W = (const u16*)(p.ws() + OFF_WDQKV) + (size_t)j * 1024 * 1024;
  u16* DQKV = (u16*)(p.ws() + OFF_B + B_DQKV);
  u16* KR = (u16*)(p.ws() + OFF_KR);
  float* okr = p.out() + 46137344;
  auto epi = [=](int m, int n, f32x4 v) {
    if (n < 832) {
      const uint2 pk = pack4(v[0], v[1], v[2], v[3]);
      *(uint2*)(DQKV + (size_t)m * 896 + n) = pk;
      if (n >= 768) {
        const int e = n - 768;
        *(uint2*)(KR + (size_t)m * 64 + e) = pk;
        if (m < TP) {
          float4 o; o.x = v[0]; o.y = v[1]; o.z = v[2]; o.w = v[3];
          *(float4*)(okr + ((size_t)((m >> 8) * 2 + j) * 256 + (m & 255)) * 64 + e) = o;
        }
      }
    }
  };
  gemm8_job<160, 4, 4, 8, 4, 32, 1>(smem, H, W, 1024, epi);
}

DI void phase_mla_norms(const PV& p, int j) {
  const int tid_ = TIDX(); const int lane = tid_ & 63, wid = tid_ >> 6;
  const u16* DQKV = (const u16*)(p.ws() + OFF_B + B_DQKV);
  u16* QN = (u16*)(p.ws() + OFF_A + A_QN);
  u16* CKV = (u16*)(p.ws() + OFF_A + A_CKV);
  u16* KR = (u16*)(p.ws() + OFF_KR);
  float* ockv = p.out() + 41943040;
  const float* qn = p.in(24) + j * 512;
  const float* kvn = p.in(27) + j * 256;
  for (int t = blockIdx.x * 8 + wid; t < TK; t += gridDim.x * 8) {
    if (t < T) {
      const u16* row = DQKV + (size_t)t * 896;
      const uint4 a = *(const uint4*)(row + lane * 8);
      float q[8] = {lo16(a.x), hi16(a.x), lo16(a.y), hi16(a.y), lo16(a.z), hi16(a.z), lo16(a.w), hi16(a.w)};
      float ss = 0.f;
#pragma unroll
      for (int k = 0; k < 8; ++k) ss += q[k] * q[k];
      ss = wave_sum(ss, lane);
      const float r = rsqrtf(ss * (1.f / 512.f) + EPS);
      const float4 g0 = *(const float4*)(qn + lane * 8), g1 = *(const float4*)(qn + lane * 8 + 4);
      uint4 o;
      o.x = pack2(q[0] * r * g0.x, q[1] * r * g0.y); o.y = pack2(q[2] * r * g0.z, q[3] * r * g0.w);
      o.z = pack2(q[4] * r * g1.x, q[5] * r * g1.y); o.w = pack2(q[6] * r * g1.z, q[7] * r * g1.w);
      *(uint4*)(QN + (size_t)t * 512 + lane * 8) = o;
      const uint2 b = *(const uint2*)(row + 512 + lane * 4);
      float kv[4] = {lo16(b.x), hi16(b.x), lo16(b.y), hi16(b.y)};
      float s2 = kv[0] * kv[0] + kv[1] * kv[1] + kv[2] * kv[2] + kv[3] * kv[3];
      s2 = wave_sum(s2, lane);
      const float r2 = rsqrtf(s2 * (1.f / 256.f) + EPS);
      const float4 g2 = *(const float4*)(kvn + lane * 4);
      float4 o2; o2.x = kv[0] * r2 * g2.x; o2.y = kv[1] * r2 * g2.y; o2.z = kv[2] * r2 * g2.z; o2.w = kv[3] * r2 * g2.w;
      *(uint2*)(CKV + (size_t)t * 256 + lane * 4) = pack4(o2.x, o2.y, o2.z, o2.w);
      if (t < TP) *(float4*)(ockv + ((size_t)((t >> 8) * 2 + j) * 256 + (t & 255)) * 256 + lane * 4) = o2;
    } else {
      const int pp = t - T, b = pp >> 8, s = pp & 255;
      const float4 v = *(const float4*)(p.in(2) + ((size_t)(b * 2 + j) * 256 + s) * 256 + lane * 4);
      *(uint2*)(CKV + (size_t)t * 256 + lane * 4) = pack4(v.x, v.y, v.z, v.w);
      if (lane < 16) {
        const float4 w = *(const float4*)(p.in(3) + ((size_t)(b * 2 + j) * 256 + s) * 64 + lane * 4);
        *(uint2*)(KR + (size_t)t * 64 + lane * 4) = pack4(w.x, w.y, w.z, w.w);
      }
    }
  }
}

DI size_t vt_off(int m, int h, int d) {
  if (m < TP) return ((size_t)((m >> 8) * 8 + h) * 128 + d) * 256 + (m & 255);
  if (m < T) { const int mm = m - TP; return VT_SAMPLE_OFF + ((size_t)((mm >> 12) * 8 + h) * 128 + d) * 4352 + (mm & 4095); }
  const int mm = m - T;
  return VT_SAMPLE_OFF + ((size_t)((mm >> 8) * 8 + h) * 128 + d) * 4352 + 4096 + (mm & 255);
}
struct EpiKV {
  u16* Kb; u16* Vt;
  DI void operator()(const f32x4 (&acc)[2][2][4][2], int pm, int pn, int wr, int wc, int fr, int fq) const {
    const int h = pn;
#pragma unroll
    for (int ai = 0; ai < 2; ++ai)
#pragma unroll
      for (int m = 0; m < 4; ++m) {
        const int row = pm * 256 + ai * 128 + wr * 64 + m * 16 + fr;
        u16* kd = Kb + ((size_t)row * 8 + h) * 192 + wc * 32 + 4 * fq;
        const size_t ls = row < TP ? 256 : 4352;
        u16* vd = Vt + vt_off(row, h, 0) + (size_t)(wc * 32 + 4 * fq) * ls;
#pragma unroll
        for (int n = 0; n < 2; ++n) {
          const f32x4 k = acc[ai][0][m][n], v = acc[ai][1][m][n];
          *(uint2*)(kd + n * 16) = pack4(k[0], k[1], k[2], k[3]);
          const unsigned p01 = pack2(v[0], v[1]), p23 = pack2(v[2], v[3]);
          u16* vv = vd + (size_t)(n * 16) * ls;
          vv[0] = (u16)p01; vv[ls] = (u16)(p01 >> 16); vv[2 * ls] = (u16)p23; vv[3 * ls] = (u16)(p23 >> 16);
        }
      }
  }
};
DI void phase_uq_ukv(const PV& p, int j, char* smem) {
  const u16* QN = (const u16*)(p.ws() + OFF_A + A_QN);
  const u16* CKV = (const u16*)(p.ws() + OFF_A + A_CKV);
  const u16* WQ = (const u16*)(p.ws() + OFF_WUQ) + (size_t)j * 1536 * 512;
  const u16* WKV = (const u16*)(p.ws() + OFF_WUKV) + (size_t)j * 2048 * 256;
  u16* Q = (u16*)(p.ws() + OFF_B + B_Q);
  u16* Kb = (u16*)(p.ws() + OFF_B + B_K);
  u16* Vt = (u16*)(p.ws() + OFF_B + B_V);
  auto epiq = [=](int m, int n, f32x4 v) { *(uint2*)(Q + (size_t)m * 1536 + n) = pack4(v[0], v[1], v[2], v[3]); };
  gemm8_job<160, 6, 4, 8, 4, 16, 2>(smem, QN, WQ, 512, epiq);
  EpiKV E; E.Kb = Kb; E.Vt = Vt;
  TileSched<168, 8, 8, 8, 4, 32, 1> S; S.init();
  gemm8(smem, CKV, WKV, 256, S, E);
}

DI void phase_finalize(const PV& p, int j) {
  const int tid_ = TIDX(); const int lane = tid_ & 63, wid = tid_ >> 6;
  const int h = lane >> 3, l8 = lane & 7;
  u16* Q = (u16*)(p.ws() + OFF_B + B_Q);
  u16* Kb = (u16*)(p.ws() + OFF_B + B_K);
  const u16* KR = (const u16*)(p.ws() + OFF_KR);
  const float QSCALE = 1.4426950408889634f * 0.07216878364870322f;
  for (int u = blockIdx.x * 8 + wid; u < T + TK; u += gridDim.x * 8) {
    const bool isq = u < T;
    const int t = isq ? u : u - T;
    u16* base = isq ? Q + (size_t)t * 1536 + h * 192 : Kb + ((size_t)t * 8 + h) * 192;
    const float* hn = (isq ? p.in(29) : p.in(30)) + j * 192;
    float v[3][8];
#pragma unroll
    for (int k = 0; k < 3; ++k) {
      const u16* src = (!isq && k == 2) ? KR + (size_t)t * 64 + 8 * l8 : base + 8 * (l8 + 8 * k);
      const uint4 a = *(const uint4*)src;
      v[k][0] = lo16(a.x); v[k][1] = hi16(a.x); v[k][2] = lo16(a.y); v[k][3] = hi16(a.y);
      v[k][4] = lo16(a.z); v[k][5] = hi16(a.z); v[k][6] = lo16(a.w); v[k][7] = hi16(a.w);
    }
    float ss = 0.f;
#pragma unroll
    for (int k = 0; k < 3; ++k)
#pragma unroll
      for (int e = 0; e < 8; ++e) ss += v[k][e] * v[k][e];
    ss += shx<1>(ss, lane); ss += shx<2>(ss, lane); ss += shx<4>(ss, lane);
    const float r = rsqrtf(ss * (1.f / 192.f) + EPS);
#pragma unroll
    for (int k = 0; k < 3; ++k) {
      const float4 g0 = *(const float4*)(hn + 8 * (l8 + 8 * k)), g1 = *(const float4*)(hn + 8 * (l8 + 8 * k) + 4);
      v[k][0] *= r * g0.x; v[k][1] *= r * g0.y; v[k][2] *= r * g0.z; v[k][3] *= r * g0.w;
      v[k][4] *= r * g1.x; v[k][5] *= r * g1.y; v[k][6] *= r * g1.z; v[k][7] *= r * g1.w;
    }
    const bool rope = t >= TP && t < T;
    {
      const int tl = (t - TP) & 4095;
      const float pos = (float)(l8 < 4 ? (tl >> 6) : (tl & 63));
#pragma unroll
      for (int e = 0; e < 8; ++e) {
        const float x = v[2][e];
        const float partner = shx<2>(x, lane);
        const int f = (l8 & 1) * 8 + e;
        const float inv = exp2f(-(float)f * (13.287712379549449f / 16.f));
        float sn, cs;
        sincosf(pos * inv, &sn, &cs);
        const float rot = (l8 & 2) ? x * cs + partner * sn : x * cs - partner * sn;
        v[2][e] = rope ? rot : x;
      }
    }
    const float sc = isq ? QSCALE : 1.f;
#pragma unroll
    for (int k = 0; k < 3; ++k) {
      uint4 o;
      o.x = pack2(v[k][0] * sc, v[k][1] * sc); o.y = pack2(v[k][2] * sc, v[k][3] * sc);
      o.z = pack2(v[k][4] * sc, v[k][5] * sc); o.w = pack2(v[k][6] * sc, v[k][7] * sc);
      *(uint4*)(base + 8 * (l8 + 8 * k)) = o;
    }
  }
}

DI void attn_item(const PV& p, int kind, int seq, int h, int q0, char* smem) {
  const int tid = TIDX(), lane = tid & 63, wid = tid >> 6;
  const int il = lane & 31, hh = lane >> 5;
  const u16* Q = (const u16*)(p.ws() + OFF_B + B_Q);
  const u16* Kb = (const u16*)(p.ws() + OFF_B + B_K);
  const u16* Vt = (const u16*)(p.ws() + OFF_B + B_V);
  u16* O = (u16*)(p.ws() + OFF_A + A_O);
  const int Lk = kind ? 4352 : 256, nkt = Lk >> 6;
  const u16* vbase = Vt + (kind ? VT_SAMPLE_OFF + (size_t)(seq * 8 + h) * 128 * 4352 : (size_t)(seq * 8 + h) * 128 * 256);
  const int tq = q0 + wid * 32 + il;
  bf16x8 qf[12];
#pragma unroll
  for (int ks = 0; ks < 12; ++ks) qf[ks] = *(const bf16x8*)(Q + ((size_t)tq * 8 + h) * 192 + 16 * ks + 8 * hh);
  f32x16 oacc[4];
#pragma unroll
  for (int a = 0; a < 4; ++a)
#pragma unroll
    for (int r = 0; r < 16; ++r) oacc[a][r] = 0.f;
  float mrun = -INFINITY, lrun = 0.f;
  const int sw = (il >> 1) & 7;
  int ko[4], vo[8];
#pragma unroll
  for (int a = 0; a < 4; ++a) ko[a] = il * 384 + (((2 * a + hh) ^ sw) << 4);
#pragma unroll
  for (int c = 0; c < 8; ++c) vo[c] = il * 128 + 8 * hh + ((c ^ sw) << 4);
  LAS unsigned char* lds = (LAS unsigned char*)smem;
  unsigned kso[3], vso[2];
#pragma unroll
  for (int i = 0; i < 3; ++i) {
    const int id = tid + 512 * i, r = id / 24, pc = id - r * 24;
    const int ch = (pc & ~7) | ((pc & 7) ^ ((r >> 1) & 7));
    kso[i] = (unsigned)(r * 3072 + ch * 16);
  }
#pragma unroll
  for (int i = 0; i < 2; ++i) {
    const int id = tid + 512 * i, dd = id >> 3, pc = id & 7;
    const int ch = pc ^ ((dd >> 1) & 7);
    vso[i] = (unsigned)(dd * Lk * 2 + ch * 16);
  }
  const unsigned ldst = (unsigned)(tid >> 6) * 1024u;
#define ATT_STAGE(kt_, s_)                                                                                      \
  {                                                                                                            \
    const int k0_ = (kt_) * 64;                                                                                \
    const int rowbase_ = kind ? (k0_ < 4096 ? TP + seq * 4096 + k0_ : T + seq * 256 + (k0_ - 4096)) : seq * 256 + k0_; \
    const char* kg_ = (const char*)(Kb + ((size_t)rowbase_ * 8 + h) * 192);                                     \
    const char* vg_ = (const char*)(vbase + k0_);                                                              \
    _Pragma("unroll") for (int i_ = 0; i_ < 3; ++i_)                                                           \
      __builtin_amdgcn_global_load_lds((const unsigned*)(kg_ + kso[i_]), (LAS unsigned*)(lds + (s_) * 40960 + ldst + i_ * 8192), 16, 0, 0); \
    _Pragma("unroll") for (int i_ = 0; i_ < 2; ++i_)                                                           \
      __builtin_amdgcn_global_load_lds((const unsigned*)(vg_ + vso[i_]), (LAS unsigned*)(lds + (s_) * 40960 + 24576 + ldst + i_ * 8192), 16, 0, 0); \
  }
  __syncthreads();
  ATT_STAGE(0, 0)
  asm volatile("s_waitcnt vmcnt(0)" ::: "memory");
  __syncthreads();
  for (int kt = 0; kt < nkt; ++kt) {
    const bool more = kt + 1 < nkt;
    if (more) ATT_STAGE(kt + 1, (kt + 1) & 1)
    const char* Ks = smem + (kt & 1) * 40960;
    const char* Vs = Ks + 24576;
    f32x16 s2[2];
    __builtin_amdgcn_s_setprio(1);
#pragma unroll
    for (int st = 0; st < 2; ++st) {
#pragma unroll
      for (int r = 0; r < 16; ++r) s2[st][r] = 0.f;
#pragma unroll
      for (int ks = 0; ks < 12; ++ks) {
        const bf16x8 kf = *(const bf16x8*)(Ks + ko[ks & 3] + st * 12288 + (ks >> 2) * 128);
        s2[st] = __builtin_amdgcn_mfma_f32_32x32x16_bf16(kf, qf[ks], s2[st], 0, 0, 0);
      }
    }
    __builtin_amdgcn_s_setprio(0);
#pragma unroll
    for (int st = 0; st < 2; ++st) {
      float mx = s2[st][0];
#pragma unroll
      for (int r = 1; r < 16; ++r) mx = fmaxf(mx, s2[st][r]);
      mx = fmaxf(mx, shx<32>(mx, lane));
      const float mnew = fmaxf(mrun, mx);
      const float alpha = __builtin_amdgcn_exp2f(mrun - mnew);
      const bool changed = mnew != mrun;
      mrun = mnew;
      float psum = 0.f;
#pragma unroll
      for (int r = 0; r < 16; ++r) { const float pv = __builtin_amdgcn_exp2f(s2[st][r] - mnew); s2[st][r] = pv; psum += pv; }
      lrun = lrun * alpha + psum;
      if (__builtin_amdgcn_ballot_w64(changed) != 0ull) {
#pragma unroll
        for (int a = 0; a < 4; ++a)
#pragma unroll
          for (int r = 0; r < 16; ++r) oacc[a][r] *= alpha;
      }
      __builtin_amdgcn_s_setprio(1);
#pragma unroll
      for (int sb = 0; sb < 2; ++sb) {
        union { bf16x8 v; unsigned w[4]; } pb;
#pragma unroll
        for (int w = 0; w < 4; ++w) pb.w[w] = pack2(s2[st][8 * sb + 2 * w], s2[st][8 * sb + 2 * w + 1]);
        const int c1 = 4 * st + 2 * sb;
#pragma unroll
        for (int dt = 0; dt < 4; ++dt) {
          union { bf16x8 v; uint2 h2[2]; } vf;
          vf.h2[0] = *(const uint2*)(Vs + vo[c1] + dt * 4096);
          vf.h2[1] = *(const uint2*)(Vs + vo[c1 + 1] + dt * 4096);
          oacc[dt] = __builtin_amdgcn_mfma_f32_32x32x16_bf16(vf.v, pb.v, oacc[dt], 0, 0, 0);
        }
      }
      __builtin_amdgcn_s_setprio(0);
    }
    asm volatile("s_waitcnt vmcnt(0)" ::: "memory");
    __syncthreads();
  }
#undef ATT_STAGE
  const float ltot = lrun + shx<32>(lrun, lane);
  const float inv = 1.f / ltot;
#pragma unroll
  for (int dt = 0; dt < 4; ++dt)
#pragma unroll
    for (int g = 0; g < 4; ++g) {
      const int d = dt * 32 + 8 * g + 4 * hh;
      *(uint2*)(O + (size_t)tq * 1024 + h * 128 + d) =
          pack4(oacc[dt][4 * g] * inv, oacc[dt][4 * g + 1] * inv, oacc[dt][4 * g + 2] * inv, oacc[dt][4 * g + 3] * inv);
    }
}
DI void phase_attention(const PV& p, char* smem) {
  const bool xmap = gridDim.x == 256;
  const int Gq = opaque_i((int)gridDim.x);
  const int nit = xmap ? 5 : (1280 + Gq - 1) / Gq;
#pragma unroll 1
  for (int r = 0; r < nit; ++r) {
    int kind, seq, h, q0;
    if (xmap) {
      if (r < 4) {
        const int xcd = blockIdx.x & 7, slot = blockIdx.x >> 3;
        const int pair = xcd + 8 * (2 * r + (slot >> 4)), qb = slot & 15;
        kind = 1; seq = pair >> 3; h = pair & 7; q0 = TP + seq * 4096 + qb * 256;
      } else {
        kind = 0; seq = blockIdx.x >> 3; h = blockIdx.x & 7; q0 = seq * 256;
      }
    } else {
      const int it = blockIdx.x + r * gridDim.x;
      if (it >= 1280) break;
      if (it < 1024) { const int pair = it >> 4, qb = it & 15; kind = 1; seq = pair >> 3; h = pair & 7; q0 = TP + seq * 4096 + qb * 256; }
      else { const int i2 = it - 1024; kind = 0; seq = i2 >> 3; h = i2 & 7; q0 = seq * 256; }
    }
    attn_item(p, kind, seq, h, q0, smem);
  }
  __syncthreads();
}

DI float dpp_ror1(float x) { return __int_as_float(__builtin_amdgcn_update_dpp(0, __float_as_int(x), 0x121, 0xf, 0xf, false)); }
DI float dpp_ror15(float x) { return __int_as_float(__builtin_amdgcn_update_dpp(0, __float_as_int(x), 0x12F, 0xf, 0xf, false)); }
struct EpiFFN {
  u16* ACT; u16* EDGE; const float* cw; const float* cb;
  DI void operator()(const f32x4 (&acc)[2][2][4][2], int pm, int pn, int wr, int wc, int fr, int fq) const {
#pragma unroll
    for (int n = 0; n < 2; ++n) {
      const int a = pn * 128 + wc * 32 + n * 16 + fq * 4;
      const float4 w0g = *(const float4*)(cw + a), w1g = *(const float4*)(cw + 5632 + a), w2g = *(const float4*)(cw + 11264 + a), bg = *(const float4*)(cb + a);
      const float4 w0u = *(const float4*)(cw + 2816 + a), w1u = *(const float4*)(cw + 5632 + 2816 + a), w2u = *(const float4*)(cw + 11264 + 2816 + a), bu = *(const float4*)(cb + 2816 + a);
#pragma unroll
      for (int ai = 0; ai < 2; ++ai) {
        const int rbase = pm * 256 + ai * 128 + wr * 64;
        const size_t erow = (size_t)(rbase >> 6) * 4;
#pragma unroll
        for (int m = 0; m < 4; ++m) {
          const int mp = m > 0 ? m - 1 : 0, mn = m < 3 ? m + 1 : 3;
          float o[4];
#define FFN_ONE(J, C)                                                                                         \
          {                                                                                                   \
            const float g = acc[ai][0][m][n][J], u = acc[ai][1][m][n][J];                                     \
            const float gpv = m > 0 ? acc[ai][0][mp][n][J] : 0.f, gnx = m < 3 ? acc[ai][0][mn][n][J] : 0.f;   \
            const float upv = m > 0 ? acc[ai][1][mp][n][J] : 0.f, unx = m < 3 ? acc[ai][1][mn][n][J] : 0.f;   \
            const float gp = dpp_ror1(fr == 15 ? gpv : g), gn = dpp_ror15(fr == 0 ? gnx : g);                \
            const float up = dpp_ror1(fr == 15 ? upv : u), un = dpp_ror15(fr == 0 ? unx : u);                \
            const float cg = w0g.C * gp + w1g.C * g + w2g.C * gn + bg.C;                                      \
            const float cu = w0u.C * up + w1u.C * u + w2u.C * un + bu.C;                                      \
            o[J] = silu(cg) * cu;                                                                             \
          }
          FFN_ONE(0, x) FFN_ONE(1, y) FFN_ONE(2, z) FFN_ONE(3, w)
#undef FFN_ONE
          *(uint2*)(ACT + (size_t)(rbase + m * 16 + fr) * 2816 + a) = pack4(o[0], o[1], o[2], o[3]);
          if ((m == 0 && fr < 2) || (m == 3 && fr >= 14)) {
            const int ri = m == 0 ? fr : fr - 12;
            u16* e = EDGE + (erow + ri) * 5632 + pn * 256 + wc * 32 + n * 16 + fq * 4;
            *(uint2*)e = pack4(acc[ai][0][m][n][0], acc[ai][0][m][n][1], acc[ai][0][m][n][2], acc[ai][0][m][n][3]);
            *(uint2*)(e + 128) = pack4(acc[ai][1][m][n][0], acc[ai][1][m][n][1], acc[ai][1][m][n][2], acc[ai][1][m][n][3]);
          }
        }
      }
    }
  }
};
DI void phase_ffn_up(const PV& p, int l, char* smem) {
  EpiFFN E;
  E.ACT = (u16*)(p.ws() + OFF_B + B_ACT); E.EDGE = (u16*)(p.ws() + OFF_EDGE);
  E.cw = p.in(33) + (size_t)l * 3 * 5632; E.cb = p.in(34) + (size_t)l * 5632;
  TileSched<160, 22, 16, 8, 4, 16, 2> S; S.init();
  gemm8(smem, (const u16*)(p.ws() + OFF_A + A_H), (const u16*)(p.ws() + OFF_WUP), 1024, S, E);
}
DI void phase_ffn_fix(const PV& p, int l) {
  const u16* EDGE = (const u16*)(p.ws() + OFF_EDGE);
  u16* ACT = (u16*)(p.ws() + OFF_B + B_ACT);
  const float* cw = p.in(33) + (size_t)l * 3 * 5632;
  const float* cb = p.in(34) + (size_t)l * 5632;
  const long gtid = (long)blockIdx.x * blockDim.x + TIDX(), gsz = (long)gridDim.x * blockDim.x;
  for (long idx = gtid; idx < (long)640 * 2 * 2816; idx += gsz) {
    const int a = (int)(idx % 2816), rr = (int)(idx / 2816), which = rr & 1, sidx = rr >> 1;
    const int t = sidx * 64 + (which ? 63 : 0);
    const int tb = which ? t + 1 : t;
    const bool seqb = tb < TP ? (tb & 255) == 0 : ((tb - TP) & 4095) == 0;
    if (seqb) continue;
    const int pc = (a >> 7) * 256 + (a & 127);
    const u16 *pr, *cu, *nx;
    if (which == 0) { pr = EDGE + ((size_t)(sidx - 1) * 4 + 3) * 5632; cu = EDGE + ((size_t)sidx * 4 + 0) * 5632; nx = EDGE + ((size_t)sidx * 4 + 1) * 5632; }
    else { pr = EDGE + ((size_t)sidx * 4 + 2) * 5632; cu = EDGE + ((size_t)sidx * 4 + 3) * 5632; nx = EDGE + ((size_t)(sidx + 1) * 4 + 0) * 5632; }
    const float g = cw[a] * bf2f(pr[pc]) + cw[5632 + a] * bf2f(cu[pc]) + cw[11264 + a] * bf2f(nx[pc]) + cb[a];
    const float uu = cw[2816 + a] * bf2f(pr[pc + 128]) + cw[5632 + 2816 + a] * bf2f(cu[pc + 128]) + cw[11264 + 2816 + a] * bf2f(nx[pc + 128]) + cb[2816 + a];
    ACT[(size_t)t * 2816 + a] = f2bf(silu(g) * uu);
  }
}

#ifndef PH
#define RUN(k, ...) __VA_ARGS__
#else
#define RUN(k, ...) if (PH == k) { __VA_ARGS__ }
#endif
extern "C" __global__ void __launch_bounds__(512) fwd_megakernel(Params kp) {
  extern __shared__ __attribute__((aligned(16))) char smem[];
  cg::grid_group grid = cg::this_grid();
  if (TIDX() == 0) {
    unsigned long long* t = (unsigned long long*)(smem + PARM_OFF);
#pragma unroll
    for (int k = 0; k < 36; ++k) t[k] = (unsigned long long)kp.in[k];
    t[36] = (unsigned long long)kp.out; t[37] = (unsigned long long)kp.ws;
  }
  __syncthreads();
  PV p; p.smem = smem;
  unsigned* bar = (unsigned*)(p.ws() + OFF_BAR);
  unsigned bar_no = 0;
  RUN(0, phase_prep(p, smem);)
  grid.sync();
  RUN(1, phase_filters(p, smem);)
  for (int l = 0; l < 4; ++l) {
    const int i = l >> 1;
    RUN(2, phase_norm(p, l, 0, l);)
    RUN(0, if (l > 0) { int base = 0; convert_ffn_weights(p, l, smem, base); })
    grid_barrier(bar, bar_no);
    if ((l & 1) == 0) {
      RUN(3, phase_mix_in(p, i, smem);)
      grid_barrier(bar, bar_no);
      RUN(4, phase_sgu(p, i, smem);)
      RUN(5, phase_conv(p, i, 0, smem);)
      grid_barrier(bar, bar_no);
      RUN(5, phase_conv(p, i, 1, smem);)
      grid_barrier(bar, bar_no);
      RUN(6, phase_ztrans(p, smem);)
      grid_barrier(bar, bar_no);
      RUN(7, phase_resid_gemm(p, l, l, (const u16*)(p.ws() + OFF_B + B_MIX), 1024, (const u16*)(p.ws() + OFF_WMIXOUT) + (size_t)i * 1024 * 1024, 2048, smem);)
      grid_barrier(bar, bar_no);
    } else {
      RUN(8, phase_dqkv(p, i, smem);)
      grid_barrier(bar, bar_no);
      RUN(9, phase_mla_norms(p, i);)
      grid_barrier(bar, bar_no);
      RUN(10, phase_uq_ukv(p, i, smem);)
      grid_barrier(bar, bar_no);
      RUN(11, phase_finalize(p, i);)
      grid_barrier(bar, bar_no);
      RUN(12, phase_attention(p, smem);)
      grid_barrier(bar, bar_no);
      RUN(7, phase_resid_gemm(p, l, l, (const u16*)(p.ws() + OFF_A + A_O), 1024, (const u16*)(p.ws() + OFF_WO) + (size_t)i * 1024 * 1024, 2048, smem);)
      grid_barrier(bar, bar_no);
    }
    RUN(2, phase_norm(p, l, 1, 1);)
    grid_barrier(bar, bar_no);
    RUN(13, phase_ffn_up(p, l, smem);)
    grid_barrier(bar, bar_no);
    RUN(14, phase_ffn_fix(p, l);)
    grid_barrier(bar, bar_no);
    RUN(7, phase_resid_gemm(p, l, 1, (const u16*)(p.ws() + OFF_B + B_ACT), 2816, (const u16*)(p.ws() + OFF_WDOWN), 5120, smem);)
    grid_barrier(bar, bar_no);
  }
}

extern "C" void kernel_launch(void* const* d_in, const int* in_sizes, int n_in,
                              void* d_out, int out_size, void* d_ws, size_t ws_size,
                              hipStream_t stream) {
  static int grid_blocks = 0;
  if (!grid_blocks) {
    int dev = 0, cus = 0, per_cu = 0;
    (void)hipGetDevice(&dev);
    (void)hipDeviceGetAttribute(&cus, hipDeviceAttributeMultiprocessorCount, dev);
    (void)hipFuncSetAttribute((const void*)fwd_megakernel, hipFuncAttributeMaxDynamicSharedMemorySize, (int)LDS_BYTES);
    (void)hipOccupancyMaxActiveBlocksPerMultiprocessor(&per_cu, fwd_megakernel, 512, LDS_BYTES);
    if (per_cu < 1) per_cu = 1;
    if (per_cu > 1) per_cu = 1;
    grid_blocks = cus * per_cu;
  }
  if (ws_size < WS_NEED) fprintf(stderr, "workspace too small: %zu < %zu\n", ws_size, (size_t)WS_NEED);
  Params p{};
  for (int i = 0; i < 36; ++i) p.in[i] = (const float*)d_in[i];
  p.out = (float*)d_out;
  p.ws = (char*)d_ws;
  (void)hipMemsetAsync((char*)d_ws + OFF_BAR, 0, 256, stream);
  void* args[] = {&p};
  hipError_t e = hipLaunchCooperativeKernel((void*)fwd_megakernel, dim3(grid_blocks), dim3(512), args, LDS_BYTES, stream);
  if (e != hipSuccess) fprintf(stderr, "cooperative launch failed: %s (grid %d)\n", hipGetErrorString(e), grid_blocks);
}
```

```cpp
#include <hip/hip_runtime.h>
#include <hip/hip_cooperative_groups.h>
#include <cstdio>
namespace cg = cooperative_groups;

typedef unsigned short u16;
using bf16x8 = __attribute__((ext_vector_type(8))) short;
using f32x4 = __attribute__((ext_vector_type(4))) float;
using f32x16 = __attribute__((ext_vector_type(16))) float;
#define DI __device__ __forceinline__

constexpr int T = 40960;
constexpr int TP = 8192;
constexpr int TK = 43008;
constexpr float EPS = 1e-6f;
constexpr size_t LDS_BYTES = 139264;

constexpr size_t OFF_WMIXIN = 0;
constexpr size_t OFF_WMIXOUT = OFF_WMIXIN + (size_t)2 * 2560 * 1024 * 2;
constexpr size_t OFF_WDQKV = OFF_WMIXOUT + (size_t)2 * 1024 * 1024 * 2;
constexpr size_t OFF_WUQ = OFF_WDQKV + (size_t)2 * 1024 * 1024 * 2;
constexpr size_t OFF_WUKV = OFF_WUQ + (size_t)2 * 1536 * 512 * 2;
constexpr size_t OFF_WO = OFF_WUKV + (size_t)2 * 2048 * 256 * 2;
constexpr size_t OFF_WSGU = OFF_WO + (size_t)2 * 1024 * 1024 * 2;
constexpr size_t OFF_WUP = OFF_WSGU + (size_t)2 * 4 * 128 * 128 * 2;
constexpr size_t OFF_WDOWN = OFF_WUP + (size_t)5632 * 1024 * 2;
constexpr size_t OFF_MOD = OFF_WDOWN + (size_t)1024 * 2816 * 2;
constexpr size_t OFF_FILT = OFF_MOD + (size_t)4 * 9 * 6144 * 4;
constexpr size_t OFF_H2 = OFF_FILT + (size_t)2 * 2 * 512 * 4352 * 2;
constexpr size_t OFF_EDGE = OFF_H2 + (size_t)2 * 4352 * 64 * 4;
constexpr size_t OFF_KR = OFF_EDGE + (size_t)640 * 4 * 5632 * 2;
constexpr size_t OFF_A = OFF_KR + (size_t)TK * 64 * 2;
constexpr size_t OFF_B = OFF_A + (size_t)T * 1024 * 2;
constexpr size_t OFF_BAR = OFF_B + (size_t)346030080;
constexpr size_t OFF_ROPE = OFF_BAR + 256;
constexpr size_t WS_NEED = OFF_ROPE + 64 * 16 * 8;
constexpr size_t A_H = 0, A_Z1 = 0, A_Z2 = (size_t)T * 512 * 2, A_QN = 0, A_CKV = (size_t)T * 512 * 2, A_O = 0;
constexpr size_t B_VT = 0, B_PRT = (size_t)T * 512 * 2, B_MIX = B_PRT + (size_t)T * 1536 * 2;
constexpr size_t B_DQKV = 0, B_Q = 0, B_K = (size_t)T * 1536 * 2, B_V = B_K + (size_t)TK * 1536 * 2;
constexpr size_t B_ACT = 0;
constexpr size_t VT_SAMPLE_OFF = (size_t)32 * 8 * 128 * 256;

struct Params {
  const float* in[36];
  float* out;
  char* ws;
};


constexpr int PARM_OFF = 138240;
struct PV {
  char* smem;
  DI unsigned long long ld(int k) const {
    int off = PARM_OFF + 8 * k;
    asm volatile("" : "+v"(off));
    const unsigned long long v = *(const unsigned long long*)(smem + off);
    const unsigned lo = __builtin_amdgcn_readfirstlane((unsigned)v), hi = __builtin_amdgcn_readfirstlane((unsigned)(v >> 32));
    return ((unsigned long long)hi << 32) | lo;
  }
  DI const float* in(int k) const { return (const float*)(const __attribute__((address_space(1))) float*)ld(k); }
  DI float* out() const { return (float*)(__attribute__((address_space(1))) float*)ld(36); }
  DI char* ws() const { return (char*)(__attribute__((address_space(1))) char*)ld(37); }
};

DI int TIDX() { int t = (int)__builtin_amdgcn_workitem_id_x(); asm volatile("" : "+v"(t)); return t; }
DI u16 f2bf(float x) { unsigned u = __float_as_uint(x); u += 0x7fffu + ((u >> 16) & 1u); return (u16)(u >> 16); }
DI float bf2f(u16 h) { return __uint_as_float(((unsigned)h) << 16); }
DI unsigned pack2(float a, float b) { unsigned r; asm("v_cvt_pk_bf16_f32 %0, %1, %2" : "=v"(r) : "v"(a), "v"(b)); return r; }
DI uint2 pack4(float a, float b, float c, float d) { uint2 r; r.x = pack2(a, b); r.y = pack2(c, d); return r; }
DI float lo16(unsigned w) { return __uint_as_float(w << 16); }
DI float hi16(unsigned w) { return __uint_as_float(w & 0xffff0000u); }
DI float gelu_tanh(float x) { const float y = x * (1.f + 0.044715f * x * x); return x * __builtin_amdgcn_rcpf(1.f + __builtin_amdgcn_exp2f(-2.302208198f * y)); }
DI float silu(float x) { return x * __builtin_amdgcn_rcpf(1.f + __builtin_amdgcn_exp2f(-1.4426950409f * x)); }
DI int condrow(int m) { return m < TP ? 0 : 1 + ((m - TP) >> 12); }
template <int MASK> DI float shx(float v, int lane) {
  if (MASK == 32) return __int_as_float(__builtin_amdgcn_ds_bpermute((lane ^ 32) << 2, __float_as_int(v)));
  return __int_as_float(__builtin_amdgcn_ds_swizzle(__float_as_int(v), (MASK << 10) | 0x1f));
}
DI float wave_sum(float v, int lane) {
  v += shx<32>(v, lane); v += shx<16>(v, lane); v += shx<8>(v, lane);
  v += shx<4>(v, lane); v += shx<2>(v, lane); v += shx<1>(v, lane); return v;
}
DI int opaque_i(int x) { asm volatile("" : "+s"(x)); return x; }
DI int first_unit(int base) { const int G = opaque_i((int)gridDim.x); int r = (int)blockIdx.x - (base % G); if (r < 0) r += G; return r; }
DI const float* xin_row(const PV& p, int l, int m) {
  if (l == 0) return m < TP ? p.in(0) + (size_t)m * 1024 : p.in(1) + (size_t)(m - TP) * 1024;
  return p.out() + (size_t)m * 1024;
}


DI void grid_barrier(unsigned* bar, unsigned& bar_no) {
  asm volatile("s_waitcnt vmcnt(0)" ::: "memory");
  __syncthreads();
  ++bar_no;
  if (TIDX() == 0) {
    __builtin_amdgcn_fence(__ATOMIC_RELEASE, "agent");
    asm volatile("s_waitcnt vmcnt(0)" ::: "memory");
    const unsigned target = bar_no * gridDim.x;
    __hip_atomic_fetch_add(bar, 1u, __ATOMIC_RELAXED, __HIP_MEMORY_SCOPE_AGENT);
    while (__hip_atomic_load(bar, __ATOMIC_RELAXED, __HIP_MEMORY_SCOPE_AGENT) < target) __builtin_amdgcn_s_sleep(1);
    __builtin_amdgcn_fence(__ATOMIC_ACQUIRE, "agent");
    asm volatile("s_waitcnt vmcnt(0)" ::: "memory");
  }
  __syncthreads();
}

template <int MODE>
DI int rowmap(int n, int row0) {
  if (MODE == 0) return n + row0;
  return n < 2816 ? (n >> 7) * 256 + (n & 127) : ((n - 2816) >> 7) * 256 + 128 + ((n - 2816) & 127);
}
template <int MODE>
DI void convT(const float* __restrict__ src, u16* __restrict__ dst, int K, int N, int row0, char* smem, int& base) {
  u16* tl = (u16*)smem;
  const int tid = TIDX();
  const int nN = N >> 6, nunits = (K >> 6) * nN;
  for (int u = first_unit(base); u < nunits; u += gridDim.x) {
    const int k0 = (u / nN) << 6, n0 = (u % nN) << 6;
#pragma unroll
    for (int i = 0; i < 2; ++i) {
      const int r = (tid >> 4) + 32 * i, c4 = (tid & 15) * 4;
      const float4 v = *(const float4*)(src + (size_t)(k0 + r) * N + n0 + c4);
      tl[(c4 + 0) * 72 + r] = f2bf(v.x); tl[(c4 + 1) * 72 + r] = f2bf(v.y);
      tl[(c4 + 2) * 72 + r] = f2bf(v.z); tl[(c4 + 3) * 72 + r] = f2bf(v.w);
    }
    __syncthreads();
    {
      const int n = tid >> 3, kc = (tid & 7) * 8;
      const uint4 v = *(const uint4*)(tl + n * 72 + kc);
      *(uint4*)(dst + (size_t)rowmap<MODE>(n0 + n, row0) * K + k0 + kc) = v;
    }
    __syncthreads();
  }
  base += nunits;
}

DI void convert_ffn_weights(const PV& p, int l, char* smem, int& base) {
  convT<1>(p.in(32) + (size_t)l * 1024 * 5632, (u16*)(p.ws() + OFF_WUP), 1024, 5632, 0, smem, base);
  convT<0>(p.in(35) + (size_t)l * 2816 * 1024, (u16*)(p.ws() + OFF_WDOWN), 2816, 1024, 0, smem, base);
}

DI void phase_prep(const PV& p, char* smem) {
  const int tid = TIDX();
  int base = 0;
  char* ws = p.ws();
  for (int i = 0; i < 2; ++i) {
    convT<0>(p.in(9) + (size_t)i * 1024 * 2560, (u16*)(ws + OFF_WMIXIN) + (size_t)i * 2560 * 1024, 1024, 2560, 0, smem, base);
    convT<0>(p.in(22) + (size_t)i * 1024 * 1024, (u16*)(ws + OFF_WMIXOUT) + (size_t)i * 1024 * 1024, 1024, 1024, 0, smem, base);
    convT<0>(p.in(23) + (size_t)i * 1024 * 512, (u16*)(ws + OFF_WDQKV) + (size_t)i * 1024 * 1024, 1024, 512, 0, smem, base);
    convT<0>(p.in(26) + (size_t)i * 1024 * 320, (u16*)(ws + OFF_WDQKV) + (size_t)i * 1024 * 1024, 1024, 320, 512, smem, base);
    convT<0>(p.in(25) + (size_t)i * 512 * 1536, (u16*)(ws + OFF_WUQ) + (size_t)i * 1536 * 512, 512, 1536, 0, smem, base);
    convT<0>(p.in(28) + (size_t)i * 256 * 2048, (u16*)(ws + OFF_WUKV) + (size_t)i * 2048 * 256, 256, 2048, 0, smem, base);
    convT<0>(p.in(31) + (size_t)i * 1024 * 1024, (u16*)(ws + OFF_WO) + (size_t)i * 1024 * 1024, 1024, 1024, 0, smem, base);
  }
  convert_ffn_weights(p, 0, smem, base);
  {
    const long gtid = (long)blockIdx.x * blockDim.x + tid, gsz = (long)gridDim.x * blockDim.x;
    for (long i = gtid; i < 2 * 192 * 1024; i += gsz) {
      const int j = (int)(i / (192 * 1024)), r = (int)(i % (192 * 1024));
      ((u16*)(ws + OFF_WDQKV))[(size_t)j * 1024 * 1024 + (size_t)832 * 1024 + r] = 0;
    }
    for (long i = gtid; i < 2 * 4 * 128 * 128; i += gsz) ((u16*)(ws + OFF_WSGU))[i] = f2bf(p.in(10)[i]);
    for (long i = gtid; i < 64 * 16; i += gsz) {
      const int pos = (int)(i >> 4), f = (int)(i & 15);
      const float inv = exp2f(-(float)f * (13.287712379549449f / 16.f));
      float sn, cs;
      sincosf((float)pos * inv, &sn, &cs);
      ((float2*)(ws + OFF_ROPE))[i] = make_float2(cs, sn);
    }
  }
  {
    float* sc = (float*)smem;
    float* part = sc + 9 * 1024;
    __syncthreads();
    for (int i = tid; i < 9 * 1024; i += 512) {
      const int r = i >> 10, k = i & 1023;
      const float c = r == 0 ? p.in(5)[k] : p.in(4)[(r - 1) * 1024 + k];
      sc[i] = silu(c);
    }
    __syncthreads();
    float* MOD = (float*)(ws + OFF_MOD);
    const int nunits = 4 * 96;
    for (int u = first_unit(base); u < nunits; u += gridDim.x) {
      const int l = u / 96, n0 = (u % 96) * 64;
      const int col = n0 + (tid & 63), kg = tid >> 6;
      float acc[9];
#pragma unroll
      for (int r = 0; r < 9; ++r) acc[r] = 0.f;
      const float* w = p.in(6) + (size_t)l * 1024 * 6144 + col;
#pragma unroll 4
      for (int k = kg * 128; k < kg * 128 + 128; ++k) {
        const float wv = w[(size_t)k * 6144];
#pragma unroll
        for (int r = 0; r < 9; ++r) acc[r] += sc[r * 1024 + k] * wv;
      }
#pragma unroll
      for (int r = 0; r < 9; ++r) part[(kg * 9 + r) * 64 + (tid & 63)] = acc[r];
      __syncthreads();
      for (int i = tid; i < 576; i += 512) {
        const int r = i >> 6, cc = i & 63;
        float s = p.in(7)[l * 6144 + n0 + cc];
#pragma unroll
        for (int g = 0; g < 8; ++g) s += part[(g * 9 + r) * 64 + cc];
        MOD[(size_t)(l * 9 + r) * 6144 + n0 + cc] = s;
      }
      __syncthreads();
    }
    base += nunits;
  }
  {
    float* zf = (float*)smem;
    float* h1 = zf + 8 * 36;
    float* H2 = (float*)(ws + OFF_H2);
    const int nunits = 2 * 544;
    for (int u = first_unit(base); u < nunits; u += gridDim.x) {
      const int i = u / 544, tg0 = (u % 544) * 8;
      __syncthreads();
      if (tid < 8 * 33) {
        const int tt = tid / 33, e = tid % 33;
        const int tg = tg0 + tt;
        const float L = tg < 256 ? 256.f : 4096.f;
        const float t = tg < 256 ? (float)tg : (float)(tg - 256);
        const float tn = t / L;
        float v;
        if (e == 0) v = tn;
        else if (e <= 16) v = sinf((6.283185307179586f * tn) * (float)e);
        else v = cosf((6.283185307179586f * tn) * (float)(e - 16));
        zf[tt * 36 + e] = v;
      }
      __syncthreads();
      const int tt = tid >> 6, jj = tid & 63;
      const float fr = p.in(19)[i * 64 + jj];
      {
        float a = p.in(15)[i * 64 + jj];
        const float* w1 = p.in(14) + (size_t)i * 33 * 64 + jj;
        for (int e = 0; e < 33; ++e) a += zf[tt * 36 + e] * w1[e * 64];
        h1[tt * 64 + jj] = sinf(fr * a);
      }
      __syncthreads();
      {
        float a = p.in(17)[i * 64 + jj];
        const float* w2 = p.in(16) + (size_t)i * 64 * 64 + jj;
        for (int e = 0; e < 64; ++e) a += h1[tt * 64 + e] * w2[e * 64];
        H2[((size_t)i * 4352 + tg0 + tt) * 64 + jj] = sinf(fr * a);
      }
    }
    base += nunits;
    __syncthreads();
  }
}

DI void phase_filters(const PV& p, char* smem) {
  const int tid = TIDX();
  float* w3s = (float*)smem;
  float* red = w3s + 512;
  float* nrm = red + 512;
  float* hbuf = nrm + 8;
  const float* H2 = (const float*)(p.ws() + OFF_H2);
  u16* FILT = (u16*)(p.ws() + OFF_FILT);
  for (int u = blockIdx.x; u < 512; u += gridDim.x) {
    const int kind = (u >> 7) & 1, i = u >> 8, cg8 = (u & 127) * 8;
    const int L = kind ? 4096 : 256, tbase = kind ? 256 : 0;
    __syncthreads();
    { const int j = tid >> 3, cc = tid & 7; w3s[j * 8 + cc] = p.in(18)[((size_t)i * 64 + j) * 1024 + cg8 + cc]; }
    __syncthreads();
    const int cc = tid & 7, tq = tid >> 3;
    const int col = cg8 + cc, o = col >> 9, c = col & 511;
    const float dec = fabsf(p.in(20)[(i * 2 + o) * 512 + c]);
    float asum = 0.f;
    for (int t = tq; t < L; t += 64) {
      const float4* hr = (const float4*)(H2 + ((size_t)i * 4352 + tbase + t) * 64);
      float a = 0.f;
#pragma unroll
      for (int j4 = 0; j4 < 16; ++j4) {
        const float4 hv = hr[j4];
        a += hv.x * w3s[(j4 * 4 + 0) * 8 + cc]; a += hv.y * w3s[(j4 * 4 + 1) * 8 + cc];
        a += hv.z * w3s[(j4 * 4 + 2) * 8 + cc]; a += hv.w * w3s[(j4 * 4 + 3) * 8 + cc];
      }
      const float dist = fabsf((float)(t - L / 2)) / (float)L;
      a *= expf(-dec * dist);
      hbuf[cc * L + t] = a;
      asum += fabsf(a);
    }
    red[tid] = asum;
    __syncthreads();
    if (tid < 8) { float s = 0.f; for (int q = 0; q < 64; ++q) s += red[q * 8 + tid]; nrm[tid] = 1.f / (s + EPS); }
    __syncthreads();
    for (int idx = tid; idx < 8 * L; idx += 512) {
      const int c2 = idx / L, t = idx - c2 * L;
      const int col2 = cg8 + c2, o2 = col2 >> 9, cch = col2 & 511;
      FILT[((size_t)(i * 2 + o2) * 512 + cch) * 4352 + tbase + t] = f2bf(hbuf[c2 * L + t] * nrm[c2]);
    }
  }
  __syncthreads();
}

DI void phase_norm(const PV& p, int l, int part, int lx) {
  const int tid_ = TIDX(); const int lane = tid_ & 63, wid = tid_ >> 6;
  const float* MOD = (const float*)(p.ws() + OFF_MOD);
  const float* g = p.in(8) + (size_t)(l * 2 + part) * 1024;
  u16* H = (u16*)(p.ws() + OFF_A + A_H);
  const int stride = gridDim.x * 8;
  for (int row0 = blockIdx.x * 8 + wid; row0 < T; row0 += 2 * stride) {
    float4 v[2][4];
#pragma unroll
    for (int w = 0; w < 2; ++w) {
      const int row = row0 + w * stride;
      if (row < T) {
        const float* xr = xin_row(p, lx, row);
#pragma unroll
        for (int i = 0; i < 4; ++i) v[w][i] = *(const float4*)(xr + (i * 64 + lane) * 4);
      }
    }
#pragma unroll
    for (int w = 0; w < 2; ++w) {
      const int row = row0 + w * stride;
      if (row < T) {
        float ss = 0.f;
#pragma unroll
        for (int i = 0; i < 4; ++i) ss += v[w][i].x * v[w][i].x + v[w][i].y * v[w][i].y + v[w][i].z * v[w][i].z + v[w][i].w * v[w][i].w;
        ss = wave_sum(ss, lane);
        const float r = rsqrtf(ss * (1.f / 1024.f) + EPS);
        const float* mr = MOD + (size_t)(l * 9 + condrow(row)) * 6144 + part * 3072;
#pragma unroll
        for (int i = 0; i < 4; ++i) {
          const int k = (i * 64 + lane) * 4;
          const float4 gv = *(const float4*)(g + k), sh = *(const float4*)(mr + k), sc = *(const float4*)(mr + 1024 + k);
          const float a = v[w][i].x * r * gv.x * (1.f + sc.x) + sh.x;
          const float b = v[w][i].y * r * gv.y * (1.f + sc.y) + sh.y;
          const float c = v[w][i].z * r * gv.z * (1.f + sc.z) + sh.z;
          const float d = v[w][i].w * r * gv.w * (1.f + sc.w) + sh.w;
          *(uint2*)(H + (size_t)row * 1024 + k) = pack4(a, b, c, d);
        }
      }
    }
  }
}

template <bool SWAP, class Epi, class Pre>
DI void gemm_tile(const u16* A, int lda, const u16* Bt, int ldb, int K, int m0, int n0, char* smem, Epi epi, Pre pre) {
  const int tid = TIDX(), lane = tid & 63, wid = tid >> 6;
  const int wm = wid >> 1, wn = wid & 1, fr = lane & 15, fq = lane >> 4;
  const int lrow = tid >> 3, kc = tid & 7;
  const u16* ga = A + (size_t)(m0 + lrow) * lda + kc * 8;
  const u16* gb = Bt + (size_t)(n0 + lrow) * ldb + kc * 8;
  const int soff = lrow * 128 + ((kc ^ (lrow & 7)) << 4);
  uint4 ra[4], rb[2];
  f32x4 acc[4][4];
#pragma unroll
  for (int i = 0; i < 4; ++i)
#pragma unroll
    for (int j = 0; j < 4; ++j) acc[i][j] = f32x4{0.f, 0.f, 0.f, 0.f};
  const int nk = K >> 6;
#pragma unroll
  for (int i = 0; i < 4; ++i) ra[i] = *(const uint4*)(ga + (size_t)(64 * i) * lda);
#pragma unroll
  for (int i = 0; i < 2; ++i) rb[i] = *(const uint4*)(gb + (size_t)(64 * i) * ldb);
#pragma unroll
  for (int i = 0; i < 4; ++i) *(uint4*)(smem + soff + i * 8192) = ra[i];
#pragma unroll
  for (int i = 0; i < 2; ++i) *(uint4*)(smem + 32768 + soff + i * 8192) = rb[i];
  __syncthreads();
  for (int kt = 0; kt < nk; ++kt) {
    const bool more = kt + 1 < nk;
    if (more) {
      const int k0 = (kt + 1) << 6;
#pragma unroll
      for (int i = 0; i < 4; ++i) ra[i] = *(const uint4*)(ga + (size_t)(64 * i) * lda + k0);
#pragma unroll
      for (int i = 0; i < 2; ++i) rb[i] = *(const uint4*)(gb + (size_t)(64 * i) * ldb + k0);
    }
    const char* sa = smem + (kt & 1) * 49152;
    const char* sb = sa + 32768;
#pragma unroll
    for (int ks = 0; ks < 2; ++ks) {
      bf16x8 af[4], bfv[4];
      const int co = ((ks * 4 + fq) ^ (fr & 7)) << 4;
#pragma unroll
      for (int mi = 0; mi < 4; ++mi) af[mi] = *(const bf16x8*)(sa + (wm * 64 + mi * 16 + fr) * 128 + co);
#pragma unroll
      for (int ni = 0; ni < 4; ++ni) bfv[ni] = *(const bf16x8*)(sb + (wn * 64 + ni * 16 + fr) * 128 + co);
#pragma unroll
      for (int mi = 0; mi < 4; ++mi)
#pragma unroll
        for (int ni = 0; ni < 4; ++ni)
          acc[mi][ni] = SWAP ? __builtin_amdgcn_mfma_f32_16x16x32_bf16(bfv[ni], af[mi], acc[mi][ni], 0, 0, 0)
                             : __builtin_amdgcn_mfma_f32_16x16x32_bf16(af[mi], bfv[ni], acc[mi][ni], 0, 0, 0);
    }
    if (more) {
      char* da = smem + ((kt + 1) & 1) * 49152;
#pragma unroll
      for (int i = 0; i < 4; ++i) *(uint4*)(da + soff + i * 8192) = ra[i];
#pragma unroll
      for (int i = 0; i < 2; ++i) *(uint4*)(da + 32768 + soff + i * 8192) = rb[i];
    }
    __syncthreads();
  }
  uint2 pv[4][4];
#pragma unroll
  for (int mi = 0; mi < 4; ++mi)
#pragma unroll
    for (int ni = 0; ni < 4; ++ni) {
      if (SWAP) pv[mi][ni] = pre(m0 + wm * 64 + mi * 16 + fr, n0 + wn * 64 + ni * 16 + fq * 4);
      else pv[mi][ni] = pre(m0 + wm * 64 + mi * 16 + fq * 4, n0 + wn * 64 + ni * 16 + fr);
    }
#pragma unroll
  for (int mi = 0; mi < 4; ++mi)
#pragma unroll
    for (int ni = 0; ni < 4; ++ni) {
      if (SWAP) epi(m0 + wm * 64 + mi * 16 + fr, n0 + wn * 64 + ni * 16 + fq * 4, acc[mi][ni], pv[mi][ni]);
      else epi(m0 + wm * 64 + mi * 16 + fq * 4, n0 + wn * 64 + ni * 16 + fr, acc[mi][ni], pv[mi][ni]);
    }
}

template <class F>
DI void for_tiles(int nM, int nN, int sm, int sn, F f) {
  if (gridDim.x == 256) {
    const int xcd = blockIdx.x & 7, slot = blockIdx.x >> 3;
    const int am = slot % sm, bn = slot / sm;
    const int nSN = (nN + sn - 1) / sn, nS = (nM / sm) * nSN;
    for (int st = xcd; st < nS; st += 8) {
      const int tm = (st / nSN) * sm + am, tn = (st % nSN) * sn + bn;
      if (tn < nN) f(tm, tn);
    }
  } else {
    for (int t = blockIdx.x; t < nM * nN; t += gridDim.x) f(t / nN, t % nN);
  }
}


#define LAS __attribute__((address_space(3)))
constexpr int G8_HTB = 128 * 64 * 2;
DI int g8_lds_byte(int r, int c) { const int st = (r >> 4) * 2 + (c >> 5), rr = r & 15, cc = c & 31, ob = rr * 64 + cc * 2; return st * 1024 + (ob ^ (((ob >> 9) & 1) << 5)); }
DI void g8_stage_rc(int b, int& R, int& C) { const int st = b / 1024, sb = b % 1024, swz = sb ^ (((sb >> 9) & 1) << 5); R = (st >> 1) * 16 + swz / 64; C = (st & 1) * 32 + (swz % 64) / 2; }
template <int NM, int NN, int NN1, int SM1, int SN1, int SM2, int SN2>
struct TileSched {
  static constexpr int nSN1 = NN1 / SN1, nS1 = (NM / SM1) * nSN1, nSN2 = (NN - NN1) / SN2, nS2 = (NM / SM2) * nSN2, nT = NM * NN;
  int c;
  DI void init() { c = blockIdx.x; }
  DI bool next(int i, int& pm, int& pn) const {
    if (gridDim.x == 256) {
      const int xcd = c & 7, slot = c >> 3;
      int st = xcd + 8 * i;
      if (st < nS1) { pm = (st / nSN1) * SM1 + slot % SM1; pn = (st % nSN1) * SN1 + slot / SM1; return true; }
      st -= nS1;
      if (nS2 == 0 || st >= nS2) return false;
      pm = (st / (nSN2 > 0 ? nSN2 : 1)) * SM2 + slot % SM2; pn = NN1 + (st % (nSN2 > 0 ? nSN2 : 1)) * SN2 + slot / SM2; return true;
    }
    const int L = i * (int)gridDim.x + c; if (L >= nT) return false; pm = L / NN; pn = L % NN; return true;
  }
};
template <bool ABLK = false, class Sched, class Epi>
DI void gemm8(char* smem, const u16* A, const u16* Bt, int K, const Sched& S, const Epi& E) {
  LAS unsigned char* lds = (LAS unsigned char*)smem;
  const int tid = TIDX(), wid = __builtin_amdgcn_readfirstlane(tid >> 6), lane = tid & 63, wr = wid >> 2, wc = wid & 3, fr = lane & 15, fq = lane >> 4;
  const int nt = K / 64;
  unsigned voff[2], voffA[2];
#pragma unroll
  for (int i = 0; i < 2; ++i) { int R, C; g8_stage_rc(tid * 16 + i * 8192, R, C); voff[i] = (unsigned)(R * K + C) * 2u; voffA[i] = ABLK ? (unsigned)(R * 64 + C) * 2u : voff[i]; }
  const size_t kstep = 128, hstep = (size_t)128 * K * 2, tstep = 2 * hstep;
  const size_t kstepA = ABLK ? 32768 : kstep, hstepA = ABLK ? 16384 : hstep;
  const unsigned ldsw = (unsigned)wid * 1024u;
  const int aoff = g8_lds_byte(wr * 64 + fr, fq * 8), boff = g8_lds_byte(wc * 32 + fr, fq * 8);
#define G8_SA(b, h) (((b) * 2 + (h)) * G8_HTB)
#define G8_SB(b, h) ((4 + (b) * 2 + (h)) * G8_HTB)
#define G8_STAGE(bufoff, gbase) do { _Pragma("unroll") for (int _i = 0; _i < 2; ++_i) \
    __builtin_amdgcn_global_load_lds((const unsigned*)((const char*)(gbase) + voff[_i]), (LAS unsigned*)(lds + (bufoff) + ldsw + _i * 8192), 16, 0, 0); } while (0)
#define G8_STAGEA(bufoff, gbase) do { _Pragma("unroll") for (int _i = 0; _i < 2; ++_i) \
    __builtin_amdgcn_global_load_lds((const unsigned*)((const char*)(gbase) + voffA[_i]), (LAS unsigned*)(lds + (bufoff) + ldsw + _i * 8192), 16, 0, 0); } while (0)
#define G8_LDA(dst, b, h) do { _Pragma("unroll") for (int m = 0; m < 4; ++m) _Pragma("unroll") for (int k = 0; k < 2; ++k) dst[m][k] = *(const LAS bf16x8*)(lds + G8_SA(b, h) + aoff + m * 2048 + k * 1024); } while (0)
#define G8_LDB(dst, b, h) do { _Pragma("unroll") for (int n = 0; n < 2; ++n) _Pragma("unroll") for (int k = 0; k < 2; ++k) dst[n][k] = *(const LAS bf16x8*)(lds + G8_SB(b, h) + boff + n * 2048 + k * 1024); } while (0)
#define G8_MMA(ai, bj, At_, Bt_) do { __builtin_amdgcn_s_setprio(1); _Pragma("unroll") for (int m = 0; m < 4; ++m) _Pragma("unroll") for (int n = 0; n < 2; ++n) _Pragma("unroll") for (int k = 0; k < 2; ++k) \
    acc[ai][bj][m][n] = __builtin_amdgcn_mfma_f32_16x16x32_bf16(Bt_[n][k], At_[m][k], acc[ai][bj][m][n], 0, 0, 0); __builtin_amdgcn_s_setprio(0); } while (0)
#define G8_WAIT_V(n) asm volatile("s_waitcnt vmcnt(" #n ")" ::: "memory")
#define G8_WAIT_L(n) asm volatile("s_waitcnt lgkmcnt(" #n ")" ::: "memory")
#define G8_BAR __builtin_amdgcn_s_barrier()
#define G8_SCHED __builtin_amdgcn_sched_barrier(0)
  int cpm, cpn, npm = 0, npn = 0, ui = 0;
  if (!S.next(0, cpm, cpn)) return;
  f32x4 acc[2][2][4][2];
#pragma unroll
  for (int a = 0; a < 2; ++a)
#pragma unroll
    for (int b = 0; b < 2; ++b)
#pragma unroll
      for (int m = 0; m < 4; ++m)
#pragma unroll
        for (int n = 0; n < 2; ++n) acc[a][b][m][n] = f32x4{0.f, 0.f, 0.f, 0.f};
  bf16x8 At[4][2], B0[2][2], B1[2][2];
  const char* cA = (const char*)A + (size_t)cpm * tstep; const char* cB = (const char*)Bt + (size_t)cpn * tstep;
  G8_STAGE(G8_SB(0, 0), cB); G8_STAGEA(G8_SA(0, 0), cA); G8_STAGE(G8_SB(0, 1), cB + hstep); G8_STAGEA(G8_SA(0, 1), cA + hstepA);
  if (wr == 1) G8_BAR;
  G8_WAIT_V(4); G8_BAR;
  G8_STAGE(G8_SB(1, 0), cB + kstep); G8_STAGEA(G8_SA(1, 0), cA + kstepA); G8_STAGE(G8_SB(1, 1), cB + hstep + kstep);
  G8_WAIT_V(6); G8_BAR;
  for (;;) {
    const bool has_next = S.next(ui + 1, npm, npn);
    const char* nA = has_next ? (const char*)A + (size_t)npm * tstep : cA; const char* nB = has_next ? (const char*)Bt + (size_t)npn * tstep : cB;
#pragma unroll 1
    for (int t = 0; t < nt; t += 2) {
      const bool last = (t == nt - 2);
      const char* a1 = cA + (size_t)(t + 1) * kstepA;
      const char* a2 = last ? nA : cA + (size_t)(t + 2) * kstepA; const char* b2 = last ? nB : cB + (size_t)(t + 2) * kstep;
      const char* a3 = a2 + kstepA; const char* b3 = b2 + kstep;
      G8_LDB(B0, 0, 0); G8_SCHED; G8_LDA(At, 0, 0); G8_STAGEA(G8_SA(1, 1), a1 + hstepA);
      G8_WAIT_L(8); G8_BAR; G8_WAIT_L(0); G8_MMA(0, 0, At, B0); G8_BAR; G8_SCHED;
      G8_LDB(B1, 0, 1); G8_STAGE(G8_SB(0, 0), b2);
      G8_BAR; G8_WAIT_L(0); G8_MMA(0, 1, At, B1); G8_BAR;
      G8_LDA(At, 0, 1); G8_STAGEA(G8_SA(0, 0), a2);
      G8_BAR; G8_WAIT_L(0); G8_MMA(1, 0, At, B0); G8_BAR; G8_SCHED;
      G8_STAGE(G8_SB(0, 1), b2 + hstep);
      G8_WAIT_V(6); G8_BAR; G8_MMA(1, 1, At, B1); G8_BAR;
      G8_LDB(B0, 1, 0); G8_SCHED; G8_LDA(At, 1, 0); G8_STAGEA(G8_SA(0, 1), a2 + hstepA);
      G8_WAIT_L(8); G8_BAR; G8_WAIT_L(0); G8_MMA(0, 0, At, B0); G8_BAR; G8_SCHED;
      G8_LDB(B1, 1, 1); G8_STAGE(G8_SB(1, 0), b3);
      G8_BAR; G8_WAIT_L(0); G8_MMA(0, 1, At, B1); G8_BAR;
      G8_LDA(At, 1, 1); G8_STAGEA(G8_SA(1, 0), a3);
      G8_BAR; G8_WAIT_L(0); G8_MMA(1, 0, At, B0); G8_BAR; G8_SCHED;
      G8_STAGE(G8_SB(1, 1), b3 + hstep);
      G8_WAIT_V(6); G8_BAR; G8_MMA(1, 1, At, B1); G8_BAR;
    }
    { const int t2 = TIDX(), w2 = __builtin_amdgcn_readfirstlane(t2 >> 6), l2 = t2 & 63; E(acc, cpm, cpn, w2 >> 2, w2 & 3, l2 & 15, l2 >> 4); }
    if (!has_next) break;
#pragma unroll
    for (int a = 0; a < 2; ++a)
#pragma unroll
      for (int b = 0; b < 2; ++b)
#pragma unroll
        for (int m = 0; m < 4; ++m)
#pragma unroll
          for (int n = 0; n < 2; ++n) acc[a][b][m][n] = f32x4{0.f, 0.f, 0.f, 0.f};
    cpm = npm; cpn = npn; cA = nA; cB = nB; ++ui;
  }
  G8_WAIT_V(0);
  if (wr == 0) G8_BAR;
  G8_BAR;
#undef G8_SA
#undef G8_SB
#undef G8_STAGE
#undef G8_STAGEA
#undef G8_LDA
#undef G8_LDB
#undef G8_MMA
#undef G8_WAIT_V
#undef G8_WAIT_L
#undef G8_BAR
#undef G8_SCHED
}
template <class F> struct ElemEpi {
  F f;
  DI void operator()(const f32x4 (&acc)[2][2][4][2], int pm, int pn, int wr, int wc, int fr, int fq) const {
    const int row0 = pm * 256 + wr * 64 + fr, col0 = pn * 256 + wc * 32 + 4 * fq;
#pragma unroll
    for (int ai = 0; ai < 2; ++ai)
#pragma unroll
      for (int m = 0; m < 4; ++m)
#pragma unroll
        for (int bj = 0; bj < 2; ++bj)
#pragma unroll
          for (int n = 0; n < 2; ++n) f(row0 + ai * 128 + m * 16, col0 + bj * 128 + n * 16, acc[ai][bj][m][n]);
  }
};
template <class F> DI ElemEpi<F> make_epi(F f) { return ElemEpi<F>{f}; }
template <int NM, int NN, int NN1, int SM1, int SN1, int SM2, int SN2, class F>
DI void gemm8_job(char* smem, const u16* A, const u16* Bt, int K, F f) {
  TileSched<NM, NN, NN1, SM1, SN1, SM2, SN2> S; S.init();
  gemm8(smem, A, Bt, K, S, make_epi(f));
}

DI void phase_mix_in(const PV& p, int i, char* smem) {
  const u16* H = (const u16*)(p.ws() + OFF_A + A_H);
  const u16* W = (const u16*)(p.ws() + OFF_WMIXIN) + (size_t)i * 2560 * 1024;
  u16* MIX = (u16*)(p.ws() + OFF_B + B_MIX);
  u16* VT = (u16*)(p.ws() + OFF_B + B_VT);
  u16* PRT = (u16*)(p.ws() + OFF_B + B_PRT);
  auto epi = [=](int m, int n, f32x4 v) {
    if (n < 512) {
      *(uint2*)(MIX + (size_t)m * 1024 + n) = pack4(gelu_tanh(v[0]), gelu_tanh(v[1]), gelu_tanh(v[2]), gelu_tanh(v[3]));
    } else if (n < 1024) {
      const int nn = n - 512, g = nn >> 7, c = nn & 127, chunk = m >> 7, q = m & 127;
      u16* b = VT + ((size_t)(g * 320 + chunk) * 128 + c) * 128 + q;
#pragma unroll
      for (int j = 0; j < 4; ++j) b[j * 128] = f2bf(gelu_tanh(v[j]));
    } else {
      const int cp = n - 1024;
      size_t off; int stride;
      if (m < TP) { off = (size_t)(m & ~255) * 1536 + (size_t)cp * 256 + (m & 255); stride = 256; }
      else { const int mm = m - TP; off = (size_t)(TP + (mm & ~4095)) * 1536 + (size_t)cp * 4096 + (mm & 4095); stride = 4096; }
#pragma unroll
      for (int j = 0; j < 4; ++j) PRT[off + (size_t)j * stride] = f2bf(v[j]);
    }
  };
  gemm8_job<160, 10, 8, 8, 4, 16, 2>(smem, H, W, 1024, epi);
}

DI void phase_sgu(const PV& p, int i, char* smem) {
  const u16* VT = (const u16*)(p.ws() + OFF_B + B_VT);
  const u16* W = (const u16*)(p.ws() + OFF_WSGU) + (size_t)i * 4 * 16384;
  u16* MIX = (u16*)(p.ws() + OFF_B + B_MIX);
  const float* sb = p.in(11) + i * 512;
  for (int u = blockIdx.x; u < 640; u += gridDim.x) {
    const int g = u / 160, tm = u % 160;
    auto epi = [=](int m, int n, f32x4 v, uint2 uu) {
      const int chunk = m >> 7, c = m & 127;
      const int t = chunk * 128 + n;
      const float bias = sb[g * 128 + n];
      u16* dst = MIX + (size_t)t * 1024 + g * 128 + c;
      *(uint2*)dst = pack4(lo16(uu.x) * (v[0] + bias), hi16(uu.x) * (v[1] + bias), lo16(uu.y) * (v[2] + bias), hi16(uu.y) * (v[3] + bias));
    };
    auto pre = [=](int m, int n) { return *(const uint2*)(MIX + (size_t)((m >> 7) * 128 + n) * 1024 + g * 128 + (m & 127)); };
    gemm_tile<false>(VT + (size_t)g * 320 * 128 * 128, 128, W + (size_t)g * 16384, 128, 128, tm * 256, 0, smem, epi, pre);
  }
}

DI size_t prt_off(int kind, int b, int cp) {
  return kind ? (size_t)(TP + b * 4096) * 1536 + (size_t)cp * 4096 : (size_t)(b * 256) * 1536 + (size_t)cp * 256;
}
DI size_t zt_off(int kind, int b, int c) {
  return kind ? (size_t)(TP + b * 4096) * 512 + (size_t)c * 4096 : (size_t)(b * 256) * 512 + (size_t)c * 256;
}
DI void phase_conv(const PV& p, int i, int ord, char* smem) {
  const int tid = TIDX(), lane = tid & 63, wid = tid >> 6;
  const u16* PRT = (const u16*)(p.ws() + OFF_B + B_PRT);
  const u16* FILT = (const u16*)(p.ws() + OFF_FILT);
  const u16* Z1 = (const u16*)(p.ws() + OFF_A + A_Z1);
  u16* ZO = (u16*)(p.ws() + OFF_A + (ord ? A_Z2 : A_Z1));
  const float* cw = p.in(12) + (size_t)i * 3 * 1536;
  const float* cb = p.in(13) + (size_t)i * 1536;
  u16* hc = (u16*)smem;
  char* Ub = smem + 68096;
  for (int u = blockIdx.x; u < 1024; u += gridDim.x) {
    const int kind = u < 512 ? 1 : 0, c = u & 511;
    const int L = kind ? 4096 : 256, NB = kind ? 8 : 32, LB = L >> 6, DD = L >> 7;
    const int US = (L + 8) * 2;
    const size_t fbase = ((size_t)(i * 2 + ord) * 512 + c) * 4352 + (kind ? 256 : 0);
    __syncthreads();
    {
      u16* tmp = (u16*)Ub;
      for (int idx = tid; idx < (L >> 3); idx += 512) *(uint4*)(tmp + idx * 8) = *(const uint4*)(FILT + fbase + idx * 8);
      __syncthreads();
      for (int idx = tid; idx < 8 * (L + 136); idx += 512) {
        const int cpy = idx / (L + 136), m = idx - cpy * (L + 136);
        const int x = L + 63 - m - cpy;
        hc[cpy * 4256 + m] = (x >= 0 && x < L) ? tmp[x] : (u16)0;
      }
      __syncthreads();
    }
    {
      const int ncr = L >> 3, total = NB * ncr;
      const float w0 = cw[c], w1 = cw[1536 + c], w2 = cw[3072 + c], bb = cb[c];
      for (int id = tid; id < total; id += 512) {
        const int b = id / ncr, t = (id - b * ncr) * 8;
        uint4 o;
        if (ord == 0) {
          const u16* src = PRT + prt_off(kind, b, c) + t;
          const uint4 raw = *(const uint4*)src;
          float e[10];
          e[0] = t > 0 ? bf2f(src[-1]) : 0.f;
          e[9] = t + 8 < L ? bf2f(src[8]) : 0.f;
          e[1] = lo16(raw.x); e[2] = hi16(raw.x); e[3] = lo16(raw.y); e[4] = hi16(raw.y);
          e[5] = lo16(raw.z); e[6] = hi16(raw.z); e[7] = lo16(raw.w); e[8] = hi16(raw.w);
          float r[8];
#pragma unroll
          for (int k = 0; k < 8; ++k) r[k] = w0 * e[k] + w1 * e[k + 1] + w2 * e[k + 2] + bb;
          o.x = pack2(r[0], r[1]); o.y = pack2(r[2], r[3]); o.z = pack2(r[4], r[5]); o.w = pack2(r[6], r[7]);
        } else {
          o = *(const uint4*)(Z1 + zt_off(kind, b, c) + t);
        }
        *(uint4*)(Ub + b * US + t * 2) = o;
      }
    }
    __syncthreads();
    const int ncols = LB * NB;
    if (wid * 64 < ncols) {
      const int il = lane & 31, q = lane >> 5;
      int t1c[2], bc[2];
#pragma unroll
      for (int nt = 0; nt < 2; ++nt) { const int col = wid * 64 + nt * 32 + il; t1c[nt] = col / NB; bc[nt] = col % NB; }
      const int t1lo = (wid * 64) / NB, t1hi = (wid * 64 + 63) / NB;
      const int dlo = max(-DD, t1lo - (LB - 1)), dhi = min(DD, t1hi);
      const int cpy = 7 - (il & 7);
      const char* abase = (const char*)hc + cpy * 8512 + 2 * (L / 2 + 63 - il - cpy + 8 * q);
      f32x16 acc[2][2];
#pragma unroll
      for (int a = 0; a < 2; ++a)
#pragma unroll
        for (int b = 0; b < 2; ++b)
#pragma unroll
          for (int r = 0; r < 16; ++r) acc[a][b][r] = 0.f;
      for (int d = dlo; d <= dhi; ++d) {
        bf16x8 bfr[2][4];
#pragma unroll
        for (int nt = 0; nt < 2; ++nt) {
          const int s1 = t1c[nt] - d;
          const bool valid = s1 >= 0 && s1 < LB;
          const char* bp = Ub + bc[nt] * US + ((valid ? s1 : 0) * 64 + 8 * q) * 2;
#pragma unroll
          for (int ks = 0; ks < 4; ++ks) {
            bf16x8 v = *(const bf16x8*)(bp + ks * 32);
            if (!valid) v = bf16x8{0, 0, 0, 0, 0, 0, 0, 0};
            bfr[nt][ks] = v;
          }
        }
#pragma unroll
        for (int mt = 0; mt < 2; ++mt)
#pragma unroll
          for (int ks = 0; ks < 4; ++ks) {
            const bf16x8 af = *(const bf16x8*)(abase + 2 * (-64 * d - 32 * mt + 16 * ks));
#pragma unroll
            for (int nt = 0; nt < 2; ++nt) acc[mt][nt] = __builtin_amdgcn_mfma_f32_32x32x16_bf16(af, bfr[nt][ks], acc[mt][nt], 0, 0, 0);
          }
      }
      const float dsk = p.in(21)[(i * 2 + ord) * 512 + c];
      const int gc = 512 * (ord + 1) + c;
      const float w0 = cw[gc], w1 = cw[1536 + gc], w2 = cw[3072 + gc], bb = cb[gc];
#pragma unroll
      for (int nt = 0; nt < 2; ++nt) {
        const int b = bc[nt];
        const u16* xrow = PRT + prt_off(kind, b, gc);
        u16* orow = ZO + zt_off(kind, b, c);
#pragma unroll
        for (int mt = 0; mt < 2; ++mt)
#pragma unroll
          for (int g = 0; g < 4; ++g) {
            const int t = 64 * t1c[nt] + mt * 32 + 8 * g + 4 * q;
            const uint2 uu = *(const uint2*)(Ub + b * US + t * 2);
            const uint2 xx = *(const uint2*)(xrow + t);
            const float em = t > 0 ? bf2f(xrow[t - 1]) : 0.f;
            const float ep = t + 4 < L ? bf2f(xrow[t + 4]) : 0.f;
            const float e0 = lo16(xx.x), e1 = hi16(xx.x), e2 = lo16(xx.y), e3 = hi16(xx.y);
            const float x0 = w0 * em + w1 * e0 + w2 * e1 + bb;
            const float x1 = w0 * e0 + w1 * e1 + w2 * e2 + bb;
            const float x2 = w0 * e1 + w1 * e2 + w2 * e3 + bb;
            const float x3 = w0 * e2 + w1 * e3 + w2 * ep + bb;
            const float y0 = acc[mt][nt][4 * g + 0] + lo16(uu.x) * dsk;
            const float y1 = acc[mt][nt][4 * g + 1] + hi16(uu.x) * dsk;
            const float y2 = acc[mt][nt][4 * g + 2] + lo16(uu.y) * dsk;
            const float y3 = acc[mt][nt][4 * g + 3] + hi16(uu.y) * dsk;
            *(uint2*)(orow + t) = pack4(x0 * y0, x1 * y1, x2 * y2, x3 * y3);
          }
      }
    }
  }
  __syncthreads();
}

DI void phase_ztrans(const PV& p, char* smem) {
  const int tid = TIDX();
  const u16* Z2 = (const u16*)(p.ws() + OFF_A + A_Z2);
  u16* MIX = (u16*)(p.ws() + OFF_B + B_MIX);
  u16* tl = (u16*)smem;
  for (int u = blockIdx.x; u < 640 * 8; u += gridDim.x) {
    const int tt0 = (u >> 3) * 64, c0 = (u & 7) * 64;
    const int kind = tt0 >= TP ? 1 : 0;
    const int b = kind ? (tt0 - TP) >> 12 : tt0 >> 8;
    const int tl0 = kind ? (tt0 - TP) & 4095 : tt0 & 255;
    __syncthreads();
    { const int c = tid >> 3, ch = tid & 7;
      *(uint4*)(tl + c * 72 + ch * 8) = *(const uint4*)(Z2 + zt_off(kind, b, c0 + c) + tl0 + ch * 8); }
    __syncthreads();
    { const int tr = tid >> 3, cc = (tid & 7) * 8;
      uint4 o;
      o.x = (unsigned)tl[(cc + 0) * 72 + tr] | ((unsigned)tl[(cc + 1) * 72 + tr] << 16);
      o.y = (unsigned)tl[(cc + 2) * 72 + tr] | ((unsigned)tl[(cc + 3) * 72 + tr] << 16);
      o.z = (unsigned)tl[(cc + 4) * 72 + tr] | ((unsigned)tl[(cc + 5) * 72 + tr] << 16);
      o.w = (unsigned)tl[(cc + 6) * 72 + tr] | ((unsigned)tl[(cc + 7) * 72 + tr] << 16);
      *(uint4*)(MIX + (size_t)(tt0 + tr) * 1024 + 512 + c0 + cc) = o; }
  }
  __syncthreads();
}

struct EpiResid {
  float* X; const float* x0; const float* x1; const float* gate; int lx;
  DI void operator()(const f32x4 (&acc)[2][2][4][2], int pm, int pn, int wr, int wc, int fr, int fq) const {
    const int rowt = pm * 256, col0 = pn * 256 + wc * 32 + 4 * fq;
    const float* gr = gate + (size_t)condrow(rowt) * 6144 + col0;
    const float* xb = lx == 0 ? (rowt < TP ? x0 + (size_t)rowt * 1024 : x1 + (size_t)(rowt - TP) * 1024) : X + (size_t)rowt * 1024;
    float4 g[2][2];
#pragma unroll
    for (int bj = 0; bj < 2; ++bj)
#pragma unroll
      for (int n = 0; n < 2; ++n) g[bj][n] = *(const float4*)(gr + bj * 128 + n * 16);
#pragma unroll
    for (int ai = 0; ai < 2; ++ai)
#pragma unroll
      for (int mh = 0; mh < 2; ++mh) {
        float4 xo[2][2][2];
#pragma unroll
        for (int mm = 0; mm < 2; ++mm)
#pragma unroll
          for (int bj = 0; bj < 2; ++bj)
#pragma unroll
            for (int n = 0; n < 2; ++n)
              xo[mm][bj][n] = *(const float4*)(xb + (size_t)(wr * 64 + fr + ai * 128 + (2 * mh + mm) * 16) * 1024 + col0 + bj * 128 + n * 16);
#pragma unroll
        for (int mm = 0; mm < 2; ++mm)
#pragma unroll
          for (int bj = 0; bj < 2; ++bj)
#pragma unroll
            for (int n = 0; n < 2; ++n) {
              const f32x4 v = acc[ai][bj][2 * mh + mm][n];
              const float4 x = xo[mm][bj][n], gg = g[bj][n];
              float4 o; o.x = x.x + gg.x * v[0]; o.y = x.y + gg.y * v[1]; o.z = x.z + gg.z * v[2]; o.w = x.w + gg.w * v[3];
              *(float4*)(X + (size_t)(rowt + wr * 64 + fr + ai * 128 + (2 * mh + mm) * 16) * 1024 + col0 + bj * 128 + n * 16) = o;
            }
      }
  }
};
DI void phase_resid_gemm(const PV& p, int l, int lx, const u16* A, int K, const u16* W, int goff, char* smem) {
  EpiResid E;
  E.X = p.out(); E.x0 = p.in(0); E.x1 = p.in(1); E.gate = (const float*)(p.ws() + OFF_MOD) + (size_t)l * 9 * 6144 + goff; E.lx = lx;
  TileSched<160, 4, 4, 8, 4, 32, 1> S; S.init();
  if (K == 2816) gemm8<true>(smem, A, W, K, S, E);
  else gemm8<false>(smem, A, W, K, S, E);
}

DI void phase_dqkv(const PV& p, int j, char* smem) {
  const u16* H = (const u16*)(p.ws() + OFF_A + A_H);
  const u16* W = (const u16*)(p.ws() + OFF_WDQKV) + (size_t)j * 1024 * 1024;
  u16* DQKV = (u16*)(p.ws() + OFF_B + B_DQKV);
  u16* KR = (u16*)(p.ws() + OFF_KR);
  float* okr = p.out() + 46137344;
  auto epi = [=](int m, int n, f32x4 v) {
    if (n < 832) {
      const uint2 pk = pack4(v[0], v[1], v[2], v[3]);
      *(uint2*)(DQKV + (size_t)m * 896 + n) = pk;
      if (n >= 768) {
        const int e = n - 768;
        *(uint2*)(KR + (size_t)m * 64 + e) = pk;
        if (m < TP) {
          float4 o; o.x = v[0]; o.y = v[1]; o.z = v[2]; o.w = v[3];
          *(float4*)(okr + ((size_t)((m >> 8) * 2 + j) * 256 + (m & 255)) * 64 + e) = o;
        }
      }
    }
  };
  gemm8_job<160, 4, 4, 8, 4, 32, 1>(smem, H, W, 1024, epi);
}

DI void phase_mla_norms(const PV& p, int j) {
  const int tid_ = TIDX(); const int lane = tid_ & 63, wid = tid_ >> 6;
  const u16* DQKV = (const u16*)(p.ws() + OFF_B + B_DQKV);
  u16* QN = (u16*)(p.ws() + OFF_A + A_QN);
  u16* CKV = (u16*)(p.ws() + OFF_A + A_CKV);
  u16* KR = (u16*)(p.ws() + OFF_KR);
  float* ockv = p.out() + 41943040;
  const float* qn = p.in(24) + j * 512;
  const float* kvn = p.in(27) + j * 256;
  for (int t = blockIdx.x * 8 + wid; t < TK; t += gridDim.x * 8) {
    if (t < T) {
      const u16* row = DQKV + (size_t)t * 896;
      const uint4 a = *(const uint4*)(row + lane * 8);
      float q[8] = {lo16(a.x), hi16(a.x), lo16(a.y), hi16(a.y), lo16(a.z), hi16(a.z), lo16(a.w), hi16(a.w)};
      float ss = 0.f;
#pragma unroll
      for (int k = 0; k < 8; ++k) ss += q[k] * q[k];
      ss = wave_sum(ss, lane);
      const float r = rsqrtf(ss * (1.f / 512.f) + EPS);
      const float4 g0 = *(const float4*)(qn + lane * 8), g1 = *(const float4*)(qn + lane * 8 + 4);
      uint4 o;
      o.x = pack2(q[0] * r * g0.x, q[1] * r * g0.y); o.y = pack2(q[2] * r * g0.z, q[3] * r * g0.w);
      o.z = pack2(q[4] * r * g1.x, q[5] * r * g1.y); o.w = pack2(q[6] * r * g1.z, q[7] * r * g1.w);
      *(uint4*)(QN + (size_t)t * 512 + lane * 8) = o;
      const uint2 b = *(const uint2*)(row + 512 + lane * 4);
      float kv[4] = {lo16(b.x), hi16(b.x), lo16(b.y), hi16(b.y)};
      float s2 = kv[0] * kv[0] + kv[1] * kv[1] + kv[2] * kv[2] + kv[3] * kv[3];
      s2 = wave_sum(s2, lane);
      const float r2 = rsqrtf(s2 * (1.f / 256.f) + EPS);
      const float4 g2 = *(const float4*)(kvn + lane * 4);
      float4 o2; o2.x = kv[0] * r2 * g2.x; o2.y = kv[1] * r2 * g2.y; o2.z = kv[2] * r2 * g2.z; o2.w = kv[3] * r2 * g2.w;
      *(uint2*)(CKV + (size_t)t * 256 + lane * 4) = pack4(o2.x, o2.y, o2.z, o2.w);
      if (t < TP) *(float4*)(ockv + ((size_t)((t >> 8) * 2 + j) * 256 + (t & 255)) * 256 + lane * 4) = o2;
    } else {
      const int pp = t - T, b = pp >> 8, s = pp & 255;
      const float4 v = *(const float4*)(p.in(2) + ((size_t)(b * 2 + j) * 256 + s) * 256 + lane * 4);
      *(uint2*)(CKV + (size_t)t * 256 + lane * 4) = pack4(v.x, v.y, v.z, v.w);
      if (lane < 16) {
        const float4 w = *(const float4*)(p.in(3) + ((size_t)(b * 2 + j) * 256 + s) * 64 + lane * 4);
        *(uint2*)(KR + (size_t)t * 64 + lane * 4) = pack4(w.x, w.y, w.z, w.w);
      }
    }
  }
}

DI size_t vt_off(int m, int h, int d) {
  if (m < TP) return ((size_t)((m >> 8) * 8 + h) * 128 + d) * 256 + (m & 255);
  if (m < T) { const int mm = m - TP; return VT_SAMPLE_OFF + ((size_t)((mm >> 12) * 8 + h) * 128 + d) * 4352 + (mm & 4095); }
  const int mm = m - T;
  return VT_SAMPLE_OFF + ((size_t)((mm >> 8) * 8 + h) * 128 + d) * 4352 + 4096 + (mm & 255);
}
struct EpiKV {
  u16* Kb; u16* Vt;
  DI void operator()(const f32x4 (&acc)[2][2][4][2], int pm, int pn, int wr, int wc, int fr, int fq) const {
    const int h = pn;
    const int rowt = pm * 256;
    const unsigned ls = rowt < TP ? 256u : 4352u;
    unsigned vbase;
    if (rowt < TP) vbase = (unsigned)(((rowt >> 8) * 8 + h) * 128) * 256u;
    else if (rowt < T) { const int mm = rowt - TP; vbase = (unsigned)VT_SAMPLE_OFF + (unsigned)(((mm >> 12) * 8 + h) * 128) * 4352u + (unsigned)(mm & 4095); }
    else { const int mm = rowt - T; vbase = (unsigned)VT_SAMPLE_OFF + (unsigned)(((mm >> 8) * 8 + h) * 128) * 4352u + 4096u + (unsigned)(mm & 255); }
    const unsigned dcol = (unsigned)(wc * 32 + 4 * fq);
#pragma unroll
    for (int ai = 0; ai < 2; ++ai)
#pragma unroll
      for (int m = 0; m < 4; ++m) {
        const int rl = ai * 128 + wr * 64 + m * 16 + fr;
        const unsigned ko = (unsigned)((rowt + rl) * 8 + h) * 192u + dcol;
        const unsigned frp = (unsigned)((fr & 3) | ((fr & 4) << 1) | ((fr & 8) >> 1));
        const unsigned vo = vbase + (unsigned)(rl & ~15) + frp + dcol * ls;
#pragma unroll
        for (int n = 0; n < 2; ++n) {
          const f32x4 k = acc[ai][0][m][n], v = acc[ai][1][m][n];
          *(uint2*)(Kb + (ko + n * 16)) = pack4(k[0], k[1], k[2], k[3]);
          const unsigned p01 = pack2(v[0], v[1]), p23 = pack2(v[2], v[3]);
          const unsigned vq = vo + (unsigned)(n * 16) * ls;
          Vt[vq] = (u16)p01; Vt[vq + ls] = (u16)(p01 >> 16); Vt[vq + 2 * ls] = (u16)p23; Vt[vq + 3 * ls] = (u16)(p23 >> 16);
        }
      }
  }
};
DI void phase_uq_ukv(const PV& p, int j, char* smem) {
  const u16* QN = (const u16*)(p.ws() + OFF_A + A_QN);
  const u16* CKV = (const u16*)(p.ws() + OFF_A + A_CKV);
  const u16* WQ = (const u16*)(p.ws() + OFF_WUQ) + (size_t)j * 1536 * 512;
  const u16* WKV = (const u16*)(p.ws() + OFF_WUKV) + (size_t)j * 2048 * 256;
  u16* Q = (u16*)(p.ws() + OFF_B + B_Q);
  u16* Kb = (u16*)(p.ws() + OFF_B + B_K);
  u16* Vt = (u16*)(p.ws() + OFF_B + B_V);
  auto epiq = [=](int m, int n, f32x4 v) { *(uint2*)(Q + (size_t)m * 1536 + n) = pack4(v[0], v[1], v[2], v[3]); };
  gemm8_job<160, 6, 4, 8, 4, 16, 2>(smem, QN, WQ, 512, epiq);
  EpiKV E; E.Kb = Kb; E.Vt = Vt;
  TileSched<168, 8, 8, 8, 4, 32, 1> S; S.init();
  gemm8(smem, CKV, WKV, 256, S, E);
}

DI void phase_finalize(const PV& p, int j) {
  const int tid_ = TIDX(); const int lane = tid_ & 63, wid = tid_ >> 6;
  const int h = lane >> 3, l8 = lane & 7;
  u16* Q = (u16*)(p.ws() + OFF_B + B_Q);
  u16* Kb = (u16*)(p.ws() + OFF_B + B_K);
  const u16* KR = (const u16*)(p.ws() + OFF_KR);
  const float2* ROPE = (const float2*)(p.ws() + OFF_ROPE);
  const float* qhn = p.in(29) + j * 192;
  const float* khn = p.in(30) + j * 192;
  const float QSCALE = 1.4426950408889634f * 0.07216878364870322f;
  const int stride = gridDim.x * 8;
  for (int u0 = blockIdx.x * 8 + wid; u0 < T + TK; u0 += 2 * stride) {
    uint4 raw[2][3];
    u16* basep[2];
#pragma unroll
    for (int w = 0; w < 2; ++w) {
      const int u = u0 + w * stride;
      if (u < T + TK) {
        const bool isq = u < T;
        const int t = isq ? u : u - T;
        u16* base = isq ? Q + (size_t)t * 1536 + h * 192 : Kb + ((size_t)t * 8 + h) * 192;
        basep[w] = base;
#pragma unroll
        for (int k = 0; k < 3; ++k) {
          const u16* src = (!isq && k == 2) ? KR + (size_t)t * 64 + 8 * l8 : base + 8 * (l8 + 8 * k);
          raw[w][k] = *(const uint4*)src;
        }
      }
    }
#pragma unroll
    for (int w = 0; w < 2; ++w) {
      const int u = u0 + w * stride;
      if (u < T + TK) {
        const bool isq = u < T;
        const int t = isq ? u : u - T;
        const float* hn = isq ? qhn : khn;
        float v[3][8];
#pragma unroll
        for (int k = 0; k < 3; ++k) {
          const uint4 a = raw[w][k];
          v[k][0] = lo16(a.x); v[k][1] = hi16(a.x); v[k][2] = lo16(a.y); v[k][3] = hi16(a.y);
          v[k][4] = lo16(a.z); v[k][5] = hi16(a.z); v[k][6] = lo16(a.w); v[k][7] = hi16(a.w);
        }
        float ss = 0.f;
#pragma unroll
        for (int k = 0; k < 3; ++k)
#pragma unroll
          for (int e = 0; e < 8; ++e) ss += v[k][e] * v[k][e];
        ss += shx<1>(ss, lane); ss += shx<2>(ss, lane); ss += shx<4>(ss, lane);
        const float r = rsqrtf(ss * (1.f / 192.f) + EPS);
#pragma unroll
        for (int k = 0; k < 3; ++k) {
          const float4 g0 = *(const float4*)(hn + 8 * (l8 + 8 * k)), g1 = *(const float4*)(hn + 8 * (l8 + 8 * k) + 4);
          v[k][0] *= r * g0.x; v[k][1] *= r * g0.y; v[k][2] *= r * g0.z; v[k][3] *= r * g0.w;
          v[k][4] *= r * g1.x; v[k][5] *= r * g1.y; v[k][6] *= r * g1.z; v[k][7] *= r * g1.w;
        }
        if (t >= TP && t < T) {
          const int tl = (t - TP) & 4095;
          const int pos = l8 < 4 ? (tl >> 6) : (tl & 63);
          const float4* rp = (const float4*)(ROPE + pos * 16 + (l8 & 1) * 8);
          const float4 c01 = rp[0], c23 = rp[1], c45 = rp[2], c67 = rp[3];
          const float cs[8] = {c01.x, c01.z, c23.x, c23.z, c45.x, c45.z, c67.x, c67.z};
          const float sn[8] = {c01.y, c01.w, c23.y, c23.w, c45.y, c45.w, c67.y, c67.w};
#pragma unroll
          for (int e = 0; e < 8; ++e) {
            const float x = v[2][e];
            const float partner = shx<2>(x, lane);
            v[2][e] = (l8 & 2) ? x * cs[e] + partner * sn[e] : x * cs[e] - partner * sn[e];
          }
        }
        const float sc = isq ? QSCALE : 1.f;
#pragma unroll
        for (int k = 0; k < 3; ++k) {
          uint4 o;
          o.x = pack2(v[k][0] * sc, v[k][1] * sc); o.y = pack2(v[k][2] * sc, v[k][3] * sc);
          o.z = pack2(v[k][4] * sc, v[k][5] * sc); o.w = pack2(v[k][6] * sc, v[k][7] * sc);
          *(uint4*)(basep[w] + 8 * (l8 + 8 * k)) = o;
        }
      }
    }
  }
}

DI void attn_item(const PV& p, int kind, int seq, int h, int q0, char* smem) {
  const int tid = TIDX(), lane = tid & 63, wid = tid >> 6;
  const int il = lane & 31, hh = lane >> 5;
  const u16* Q = (const u16*)(p.ws() + OFF_B + B_Q);
  const u16* Kb = (const u16*)(p.ws() + OFF_B + B_K);
  const u16* Vt = (const u16*)(p.ws() + OFF_B + B_V);
  u16* O = (u16*)(p.ws() + OFF_A + A_O);
  const int Lk = kind ? 4352 : 256, nkt = Lk >> 6;
  const u16* vbase = Vt + (kind ? VT_SAMPLE_OFF + (size_t)(seq * 8 + h) * 128 * 4352 : (size_t)(seq * 8 + h) * 128 * 256);
  const int tq = q0 + wid * 32 + il;
  bf16x8 qf[12];
#pragma unroll
  for (int ks = 0; ks < 12; ++ks) qf[ks] = *(const bf16x8*)(Q + ((size_t)tq * 8 + h) * 192 + 16 * ks + 8 * hh);
  f32x16 oacc[4];
#pragma unroll
  for (int a = 0; a < 4; ++a)
#pragma unroll
    for (int r = 0; r < 16; ++r) oacc[a][r] = 0.f;
  float mrun = -INFINITY, lrun = 0.f;
  const int sw = (il >> 1) & 7;
  int ko[4], vob[4];
#pragma unroll
  for (int a = 0; a < 4; ++a) ko[a] = il * 384 + (((2 * a + hh) ^ sw) << 4);
#pragma unroll
  for (int c = 0; c < 4; ++c) vob[c] = il * 128 + (((2 * c + hh) ^ sw) << 4);
  LAS unsigned char* lds = (LAS unsigned char*)smem;
  unsigned kso[3], vso[2];
#pragma unroll
  for (int i = 0; i < 3; ++i) {
    const int id = tid + 512 * i, r = id / 24, pc = id - r * 24;
    const int ch = (pc & ~7) | ((pc & 7) ^ ((r >> 1) & 7));
    kso[i] = (unsigned)(r * 3072 + ch * 16);
  }
#pragma unroll
  for (int i = 0; i < 2; ++i) {
    const int id = tid + 512 * i, dd = id >> 3, pc = id & 7;
    const int ch = pc ^ ((dd >> 1) & 7);
    vso[i] = (unsigned)(dd * Lk * 2 + ch * 16);
  }
  const unsigned ldst = (unsigned)(tid >> 6) * 1024u;
#define ATT_STAGE(kt_, s_)                                                                                      \
  {                                                                                                            \
    const int k0_ = (kt_) * 64;                                                                                \
    const int rowbase_ = kind ? (k0_ < 4096 ? TP + seq * 4096 + k0_ : T + seq * 256 + (k0_ - 4096)) : seq * 256 + k0_; \
    const char* kg_ = (const char*)(Kb + ((size_t)rowbase_ * 8 + h) * 192);                                     \
    const char* vg_ = (const char*)(vbase + k0_);                                                              \
    _Pragma("unroll") for (int i_ = 0; i_ < 3; ++i_)                                                           \
      __builtin_amdgcn_global_load_lds((const unsigned*)(kg_ + kso[i_]), (LAS unsigned*)(lds + (s_) * 40960 + ldst + i_ * 8192), 16, 0, 0); \
    _Pragma("unroll") for (int i_ = 0; i_ < 2; ++i_)                                                           \
      __builtin_amdgcn_global_load_lds((const unsigned*)(vg_ + vso[i_]), (LAS unsigned*)(lds + (s_) * 40960 + 24576 + ldst + i_ * 8192), 16, 0, 0); \
  }
  __syncthreads();
  ATT_STAGE(0, 0)
  asm volatile("s_waitcnt vmcnt(0)" ::: "memory");
  __syncthreads();
  for (int kt = 0; kt < nkt; ++kt) {
    const bool more = kt + 1 < nkt;
    if (more) ATT_STAGE(kt + 1, (kt + 1) & 1)
    const char* Ks = smem + (kt & 1) * 40960;
    const char* Vs = Ks + 24576;
    f32x16 s2[2];
    __builtin_amdgcn_s_setprio(1);
#pragma unroll
    for (int st = 0; st < 2; ++st) {
#pragma unroll
      for (int r = 0; r < 16; ++r) s2[st][r] = 0.f;
#pragma unroll
      for (int ks = 0; ks < 12; ++ks) {
        const bf16x8 kf = *(const bf16x8*)(Ks + ko[ks & 3] + st * 12288 + (ks >> 2) * 128);
        s2[st] = __builtin_amdgcn_mfma_f32_32x32x16_bf16(kf, qf[ks], s2[st], 0, 0, 0);
      }
    }
    __builtin_amdgcn_s_setprio(0);
    {
      float pmax = s2[0][0];
#pragma unroll
      for (int r = 1; r < 16; ++r) pmax = fmaxf(pmax, s2[0][r]);
#pragma unroll
      for (int r = 0; r < 16; ++r) pmax = fmaxf(pmax, s2[1][r]);
      { auto rr = __builtin_amdgcn_permlane32_swap(__float_as_uint(pmax), __float_as_uint(pmax), false, false);
        pmax = fmaxf(__uint_as_float(rr[0]), __uint_as_float(rr[1])); }
      if (!__all(pmax - mrun <= 11.541560327f)) {
        const float mn = fmaxf(mrun, pmax);
        const float alpha = __builtin_amdgcn_exp2f(mrun - mn);
        mrun = mn;
        lrun *= alpha;
#pragma unroll
        for (int a = 0; a < 4; ++a)
#pragma unroll
          for (int r = 0; r < 16; ++r) oacc[a][r] *= alpha;
      }
      float psum = 0.f;
#pragma unroll
      for (int st = 0; st < 2; ++st)
#pragma unroll
        for (int r = 0; r < 16; ++r) { const float pv = __builtin_amdgcn_exp2f(s2[st][r] - mrun); s2[st][r] = pv; psum += pv; }
      lrun += psum;
    }
    __builtin_amdgcn_s_setprio(1);
#pragma unroll
    for (int st = 0; st < 2; ++st)
#pragma unroll
      for (int sb = 0; sb < 2; ++sb) {
        union { bf16x8 v; unsigned w[4]; } pb;
#pragma unroll
        for (int w = 0; w < 4; ++w) pb.w[w] = pack2(s2[st][8 * sb + 2 * w], s2[st][8 * sb + 2 * w + 1]);
#pragma unroll
        for (int dt = 0; dt < 4; ++dt) {
          const bf16x8 vf = *(const bf16x8*)(Vs + vob[2 * st + sb] + dt * 4096);
          oacc[dt] = __builtin_amdgcn_mfma_f32_32x32x16_bf16(vf, pb.v, oacc[dt], 0, 0, 0);
        }
      }
    __builtin_amdgcn_s_setprio(0);
    asm volatile("s_waitcnt vmcnt(0)" ::: "memory");
    __syncthreads();
  }
#undef ATT_STAGE
  float ltot;
  { auto rr = __builtin_amdgcn_permlane32_swap(__float_as_uint(lrun), __float_as_uint(lrun), false, false); ltot = __uint_as_float(rr[0]) + __uint_as_float(rr[1]); }
  const float inv = 1.f / ltot;
#pragma unroll
  for (int dt = 0; dt < 4; ++dt)
#pragma unroll
    for (int g = 0; g < 4; ++g) {
      const int d = dt * 32 + 8 * g + 4 * hh;
      *(uint2*)(O + (size_t)tq * 1024 + h * 128 + d) =
          pack4(oacc[dt][4 * g] * inv, oacc[dt][4 * g + 1] * inv, oacc[dt][4 * g + 2] * inv, oacc[dt][4 * g + 3] * inv);
    }
}
DI void phase_attention(const PV& p, char* smem) {
  const bool xmap = gridDim.x == 256;
  const int Gq = opaque_i((int)gridDim.x);
  const int nit = xmap ? 5 : (1280 + Gq - 1) / Gq;
#pragma unroll 1
  for (int r = 0; r < nit; ++r) {
    int kind, seq, h, q0;
    if (xmap) {
      if (r < 4) {
        const int xcd = blockIdx.x & 7, slot = blockIdx.x >> 3;
        const int pair = xcd + 8 * (2 * r + (slot >> 4)), qb = slot & 15;
        kind = 1; seq = pair >> 3; h = pair & 7; q0 = TP + seq * 4096 + qb * 256;
      } else {
        kind = 0; seq = blockIdx.x >> 3; h = blockIdx.x & 7; q0 = seq * 256;
      }
    } else {
      const int it = blockIdx.x + r * gridDim.x;
      if (it >= 1280) break;
      if (it < 1024) { const int pair = it >> 4, qb = it & 15; kind = 1; seq = pair >> 3; h = pair & 7; q0 = TP + seq * 4096 + qb * 256; }
      else { const int i2 = it - 1024; kind = 0; seq = i2 >> 3; h = i2 & 7; q0 = seq * 256; }
    }
    attn_item(p, kind, seq, h, q0, smem);
  }
  __syncthreads();
}

DI size_t act_blk(int t, int a) { return (size_t)(t >> 8) * (256 * 2816) + (size_t)(a >> 6) * (256 * 64) + (size_t)((t & 255) * 64 + (a & 63)); }
DI float dpp_ror1(float x) { return __int_as_float(__builtin_amdgcn_update_dpp(0, __float_as_int(x), 0x121, 0xf, 0xf, false)); }
DI float dpp_ror15(float x) { return __int_as_float(__builtin_amdgcn_update_dpp(0, __float_as_int(x), 0x12F, 0xf, 0xf, false)); }
struct EpiFFN {
  u16* ACT; u16* EDGE; const float* cw; const float* cb;
  DI void operator()(const f32x4 (&acc)[2][2][4][2], int pm, int pn, int wr, int wc, int fr, int fq) const {
#pragma unroll
    for (int n = 0; n < 2; ++n) {
      const int a = pn * 128 + wc * 32 + n * 16 + fq * 4;
      const float4 w0g = *(const float4*)(cw + a), w1g = *(const float4*)(cw + 5632 + a), w2g = *(const float4*)(cw + 11264 + a), bg = *(const float4*)(cb + a);
      const float4 w0u = *(const float4*)(cw + 2816 + a), w1u = *(const float4*)(cw + 5632 + 2816 + a), w2u = *(const float4*)(cw + 11264 + 2816 + a), bu = *(const float4*)(cb + 2816 + a);
#pragma unroll
      for (int ai = 0; ai < 2; ++ai) {
        const int rbase = pm * 256 + ai * 128 + wr * 64;
        const size_t erow = (size_t)(rbase >> 6) * 4;
#pragma unroll
        for (int m = 0; m < 4; ++m) {
          const int mp = m > 0 ? m - 1 : 0, mn = m < 3 ? m + 1 : 3;
          float o[4];
#define FFN_ONE(J, C)                                                                                         \
          {                                                                                                   \
            const float g = acc[ai][0][m][n][J], u = acc[ai][1][m][n][J];                                     \
            const float gpv = m > 0 ? acc[ai][0][mp][n][J] : 0.f, gnx = m < 3 ? acc[ai][0][mn][n][J] : 0.f;   \
            const float upv = m > 0 ? acc[ai][1][mp][n][J] : 0.f, unx = m < 3 ? acc[ai][1][mn][n][J] : 0.f;   \
            const float gp = dpp_ror1(fr == 15 ? gpv : g), gn = dpp_ror15(fr == 0 ? gnx : g);                \
            const float up = dpp_ror1(fr == 15 ? upv : u), un = dpp_ror15(fr == 0 ? unx : u);                \
            const float cg = w0g.C * gp + w1g.C * g + w2g.C * gn + bg.C;                                      \
            const float cu = w0u.C * up + w1u.C * u + w2u.C * un + bu.C;                                      \
            o[J] = silu(cg) * cu;                                                                             \
          }
          FFN_ONE(0, x) FFN_ONE(1, y) FFN_ONE(2, z) FFN_ONE(3, w)
#undef FFN_ONE
          *(uint2*)(ACT + act_blk(rbase + m * 16 + fr, a)) = pack4(o[0], o[1], o[2], o[3]);
          if ((m == 0 && fr < 2) || (m == 3 && fr >= 14)) {
            const int ri = m == 0 ? fr : fr - 12;
            u16* e = EDGE + (erow + ri) * 5632 + pn * 256 + wc * 32 + n * 16 + fq * 4;
            *(uint2*)e = pack4(acc[ai][0][m][n][0], acc[ai][0][m][n][1], acc[ai][0][m][n][2], acc[ai][0][m][n][3]);
            *(uint2*)(e + 128) = pack4(acc[ai][1][m][n][0], acc[ai][1][m][n][1], acc[ai][1][m][n][2], acc[ai][1][m][n][3]);
          }
        }
      }
    }
  }
};
DI void phase_ffn_up(const PV& p, int l, char* smem) {
  EpiFFN E;
  E.ACT = (u16*)(p.ws() + OFF_B + B_ACT); E.EDGE = (u16*)(p.ws() + OFF_EDGE);
  E.cw = p.in(33) + (size_t)l * 3 * 5632; E.cb = p.in(34) + (size_t)l * 5632;
  TileSched<160, 22, 16, 8, 4, 16, 2> S; S.init();
  gemm8(smem, (const u16*)(p.ws() + OFF_A + A_H), (const u16*)(p.ws() + OFF_WUP), 1024, S, E);
}
DI void phase_ffn_fix(const PV& p, int l) {
  const u16* EDGE = (const u16*)(p.ws() + OFF_EDGE);
  u16* ACT = (u16*)(p.ws() + OFF_B + B_ACT);
  const float* cw = p.in(33) + (size_t)l * 3 * 5632;
  const float* cb = p.in(34) + (size_t)l * 5632;
  const long gtid = (long)blockIdx.x * blockDim.x + TIDX(), gsz = (long)gridDim.x * blockDim.x;
  for (long idx = gtid; idx < (long)640 * 2 * 2816; idx += gsz) {
    const int a = (int)(idx % 2816), rr = (int)(idx / 2816), which = rr & 1, sidx = rr >> 1;
    const int t = sidx * 64 + (which ? 63 : 0);
    const int tb = which ? t + 1 : t;
    const bool seqb = tb < TP ? (tb & 255) == 0 : ((tb - TP) & 4095) == 0;
    if (seqb) continue;
    const int pc = (a >> 7) * 256 + (a & 127);
    const u16 *pr, *cu, *nx;
    if (which == 0) { pr = EDGE + ((size_t)(sidx - 1) * 4 + 3) * 5632; cu = EDGE + ((size_t)sidx * 4 + 0) * 5632; nx = EDGE + ((size_t)sidx * 4 + 1) * 5632; }
    else { pr = EDGE + ((size_t)sidx * 4 + 2) * 5632; cu = EDGE + ((size_t)sidx * 4 + 3) * 5632; nx = EDGE + ((size_t)(sidx + 1) * 4 + 0) * 5632; }
    const float g = cw[a] * bf2f(pr[pc]) + cw[5632 + a] * bf2f(cu[pc]) + cw[11264 + a] * bf2f(nx[pc]) + cb[a];
    const float uu = cw[2816 + a] * bf2f(pr[pc + 128]) + cw[5632 + 2816 + a] * bf2f(cu[pc + 128]) + cw[11264 + 2816 + a] * bf2f(nx[pc + 128]) + cb[2816 + a];
    ACT[act_blk(t, a)] = f2bf(silu(g) * uu);
  }
}

#ifndef PH
#define RUN(k, ...) __VA_ARGS__
#else
#define RUN(k, ...) if (PH == k) { __VA_ARGS__ }
#endif
extern "C" __global__ void __launch_bounds__(512) fwd_megakernel(Params kp) {
  extern __shared__ __attribute__((aligned(16))) char smem[];
  cg::grid_group grid = cg::this_grid();
  if (TIDX() == 0) {
    unsigned long long* t = (unsigned long long*)(smem + PARM_OFF);
#pragma unroll
    for (int k = 0; k < 36; ++k) t[k] = (unsigned long long)kp.in[k];
    t[36] = (unsigned long long)kp.out; t[37] = (unsigned long long)kp.ws;
  }
  __syncthreads();
  PV p; p.smem = smem;
  unsigned* bar = (unsigned*)(p.ws() + OFF_BAR);
  unsigned bar_no = 0;
  RUN(0, phase_prep(p, smem);)
  grid.sync();
  RUN(1, phase_filters(p, smem);)
  for (int l = 0; l < 4; ++l) {
    const int i = l >> 1;
    RUN(2, phase_norm(p, l, 0, l);)
    RUN(0, if (l > 0) { int base = 0; convert_ffn_weights(p, l, smem, base); })
    grid_barrier(bar, bar_no);
    if ((l & 1) == 0) {
      RUN(3, phase_mix_in(p, i, smem);)
      grid_barrier(bar, bar_no);
      RUN(4, phase_sgu(p, i, smem);)
      RUN(5, phase_conv(p, i, 0, smem);)
      grid_barrier(bar, bar_no);
      RUN(5, phase_conv(p, i, 1, smem);)
      grid_barrier(bar, bar_no);
      RUN(6, phase_ztrans(p, smem);)
      grid_barrier(bar, bar_no);
      RUN(7, phase_resid_gemm(p, l, l, (const u16*)(p.ws() + OFF_B + B_MIX), 1024, (const u16*)(p.ws() + OFF_WMIXOUT) + (size_t)i * 1024 * 1024, 2048, smem);)
      grid_barrier(bar, bar_no);
    } else {
      RUN(8, phase_dqkv(p, i, smem);)
      grid_barrier(bar, bar_no);
      RUN(9, phase_mla_norms(p, i);)
      grid_barrier(bar, bar_no);
      RUN(10, phase_uq_ukv(p, i, smem);)
      grid_barrier(bar, bar_no);
      RUN(11, phase_finalize(p, i);)
      grid_barrier(bar, bar_no);
      RUN(12, phase_attention(p, smem);)
      grid_barrier(bar, bar_no);
      RUN(7, phase_resid_gemm(p, l, l, (const u16*)(p.ws() + OFF_A + A_O), 1024, (const u16*)(p.ws() + OFF_WO) + (size_t)i * 1024 * 1024, 2048, smem);)
      grid_barrier(bar, bar_no);
    }
    RUN(2, phase_norm(p, l, 1, 1);)
    grid_barrier(bar, bar_no);
    RUN(13, phase_ffn_up(p, l, smem);)
    grid_barrier(bar, bar_no);
    RUN(14, phase_ffn_fix(p, l);)
    grid_barrier(bar, bar_no);
    RUN(7, phase_resid_gemm(p, l, 1, (const u16*)(p.ws() + OFF_B + B_ACT), 2816, (const u16*)(p.ws() + OFF_WDOWN), 5120, smem);)
    grid_barrier(bar, bar_no);
  }
}

extern "C" void kernel_launch(void* const* d_in, const int* in_sizes, int n_in,
                              void* d_out, int out_size, void* d_ws, size_t ws_size,
                              hipStream_t stream) {
  static int grid_blocks = 0;
  if (!grid_blocks) {
    int dev = 0, cus = 0, per_cu = 0;
    (void)hipGetDevice(&dev);
    (void)hipDeviceGetAttribute(&cus, hipDeviceAttributeMultiprocessorCount, dev);
    (void)hipFuncSetAttribute((const void*)fwd_megakernel, hipFuncAttributeMaxDynamicSharedMemorySize, (int)LDS_BYTES);
    (void)hipOccupancyMaxActiveBlocksPerMultiprocessor(&per_cu, fwd_megakernel, 512, LDS_BYTES);
    if (per_cu < 1) per_cu = 1;
    if (per_cu > 1) per_cu = 1;
    grid_blocks = cus * per_cu;
  }
  if (ws_size < WS_NEED) fprintf(stderr, "workspace too small: %zu < %zu\n", ws_size, (size_t)WS_NEED);
  Params p{};
  for (int i = 0; i < 36; ++i) p.in[i] = (const float*)d_in[i];
  p.out = (float*)d_out;
  p.ws = (char*)d_ws;
  (void)hipMemsetAsync((char*)d_ws + OFF_BAR, 0, 256, stream);
  void* args[] = {&p};
  hipError_t e = hipLaunchCooperativeKernel((void*)fwd_megakernel, dim3(grid_blocks), dim3(512), args, LDS_BYTES, stream);
  if (e != hipSuccess) fprintf(stderr, "cooperative launch failed: %s (grid %d)\n", hipGetErrorString(e), grid_blocks);
}
```

```cpp
#include <hip/hip_runtime.h>
#include <hip/hip_cooperative_groups.h>
#include <cstdio>
namespace cg = cooperative_groups;

typedef unsigned short u16;
using bf16x8 = __attribute__((ext_vector_type(8))) short;
using f32x4 = __attribute__((ext_vector_type(4))) float;
using f32x16 = __attribute__((ext_vector_type(16))) float;
#define DI __device__ __forceinline__

constexpr int T = 40960;
constexpr int TP = 8192;
constexpr int TK = 43008;
constexpr float EPS = 1e-6f;
constexpr size_t LDS_BYTES = 139264;

constexpr size_t OFF_WMIXIN = 0;
constexpr size_t OFF_WMIXOUT = OFF_WMIXIN + (size_t)2 * 2560 * 1024 * 2;
constexpr size_t OFF_WDQKV = OFF_WMIXOUT + (size_t)2 * 1024 * 1024 * 2;
constexpr size_t OFF_WUQ = OFF_WDQKV + (size_t)2 * 1024 * 1024 * 2;
constexpr size_t OFF_WUKV = OFF_WUQ + (size_t)2 * 1536 * 512 * 2;
constexpr size_t OFF_WO = OFF_WUKV + (size_t)2 * 2048 * 256 * 2;
constexpr size_t OFF_WSGU = OFF_WO + (size_t)2 * 1024 * 1024 * 2;
constexpr size_t OFF_WUP = OFF_WSGU + (size_t)2 * 4 * 128 * 128 * 2;
constexpr size_t OFF_WDOWN = OFF_WUP + (size_t)5632 * 1024 * 2;
constexpr size_t OFF_MOD = OFF_WDOWN + (size_t)1024 * 2816 * 2;
constexpr size_t OFF_FILT = OFF_MOD + (size_t)4 * 9 * 6144 * 4;
constexpr size_t OFF_H2 = OFF_FILT + (size_t)2 * 2 * 512 * 4352 * 2;
constexpr size_t OFF_EDGE = OFF_H2 + (size_t)2 * 4352 * 64 * 4;
constexpr size_t OFF_KR = OFF_EDGE + (size_t)640 * 4 * 5632 * 2;
constexpr size_t OFF_A = OFF_KR + (size_t)TK * 64 * 2;
constexpr size_t OFF_B = OFF_A + (size_t)T * 1024 * 2;
constexpr size_t OFF_BAR = OFF_B + (size_t)346030080;
constexpr size_t OFF_ROPE = OFF_BAR + 16384;
constexpr size_t WS_NEED = OFF_ROPE + 64 * 16 * 8;
constexpr size_t A_H = 0, A_Z1 = 0, A_Z2 = (size_t)T * 512 * 2, A_QN = 0, A_CKV = (size_t)T * 512 * 2, A_O = 0;
constexpr size_t B_VT = 0, B_PRT = (size_t)T * 512 * 2, B_MIX = B_PRT + (size_t)T * 1536 * 2;
constexpr size_t B_DQKV = 0, B_Q = 0, B_K = (size_t)T * 1536 * 2, B_V = B_K + (size_t)TK * 1536 * 2;
constexpr size_t B_ACT = 0;
constexpr size_t VT_SAMPLE_OFF = (size_t)32 * 8 * 128 * 256;

struct Params {
  const float* in[36];
  float* out;
  char* ws;
};


constexpr int PARM_OFF = 138240;
struct PV {
  char* smem;
  DI unsigned long long ld(int k) const {
    int off = PARM_OFF + 8 * k;
    asm volatile("" : "+v"(off));
    const unsigned long long v = *(const unsigned long long*)(smem + off);
    const unsigned lo = __builtin_amdgcn_readfirstlane((unsigned)v), hi = __builtin_amdgcn_readfirstlane((unsigned)(v >> 32));
    return ((unsigned long long)hi << 32) | lo;
  }
  DI const float* in(int k) const { return (const float*)(const __attribute__((address_space(1))) float*)ld(k); }
  DI float* out() const { return (float*)(__attribute__((address_space(1))) float*)ld(36); }
  DI char* ws() const { return (char*)(__attribute__((address_space(1))) char*)ld(37); }
};

DI int TIDX() { int t = (int)__builtin_amdgcn_workitem_id_x(); asm volatile("" : "+v"(t)); return t; }
DI u16 f2bf(float x) { unsigned u = __float_as_uint(x); u += 0x7fffu + ((u >> 16) & 1u); return (u16)(u >> 16); }
DI float bf2f(u16 h) { return __uint_as_float(((unsigned)h) << 16); }
DI unsigned pack2(float a, float b) { unsigned r; asm("v_cvt_pk_bf16_f32 %0, %1, %2" : "=v"(r) : "v"(a), "v"(b)); return r; }
DI uint2 pack4(float a, float b, float c, float d) { uint2 r; r.x = pack2(a, b); r.y = pack2(c, d); return r; }
DI float lo16(unsigned w) { return __uint_as_float(w << 16); }
DI float hi16(unsigned w) { return __uint_as_float(w & 0xffff0000u); }
DI float gelu_tanh(float x) { const float y = x * (1.f + 0.044715f * x * x); return x * __builtin_amdgcn_rcpf(1.f + __builtin_amdgcn_exp2f(-2.302208198f * y)); }
DI float silu(float x) { return x * __builtin_amdgcn_rcpf(1.f + __builtin_amdgcn_exp2f(-1.4426950409f * x)); }
DI int condrow(int m) { return m < TP ? 0 : 1 + ((m - TP) >> 12); }
template <int MASK> DI float shx(float v, int lane) {
  if (MASK == 32) return __int_as_float(__builtin_amdgcn_ds_bpermute((lane ^ 32) << 2, __float_as_int(v)));
  return __int_as_float(__builtin_amdgcn_ds_swizzle(__float_as_int(v), (MASK << 10) | 0x1f));
}
DI float wave_sum(float v, int lane) {
  v += shx<32>(v, lane); v += shx<16>(v, lane); v += shx<8>(v, lane);
  v += shx<4>(v, lane); v += shx<2>(v, lane); v += shx<1>(v, lane); return v;
}
DI int opaque_i(int x) { asm volatile("" : "+s"(x)); return x; }
DI int first_unit(int base) { const int G = opaque_i((int)gridDim.x); int r = (int)blockIdx.x - (base % G); if (r < 0) r += G; return r; }
DI const float* xin_row(const PV& p, int l, int m) {
  if (l == 0) return m < TP ? p.in(0) + (size_t)m * 1024 : p.in(1) + (size_t)(m - TP) * 1024;
  return p.out() + (size_t)m * 1024;
}


#define XB_TMO      128
#define XB_XCNT(j)  (256  + 64 * (j))
#define XB_XSUB(j)  (1280 + 64 * (j))
#define XB_XGEN(j)  (2304 + 64 * (j))
#define XB_TOP      3328
#define XB_TOPGEN   3392
#define XB_SPIN_CAP (1u << 22)
#define LASB __attribute__((address_space(3)))
DI unsigned xb_ld(unsigned* p) { return __hip_atomic_load(p, __ATOMIC_RELAXED, __HIP_MEMORY_SCOPE_AGENT); }
DI unsigned xb_add(unsigned* p, unsigned v) { return __hip_atomic_fetch_add(p, v, __ATOMIC_RELAXED, __HIP_MEMORY_SCOPE_AGENT); }
DI unsigned xb_xcc_id() { return (unsigned)__builtin_amdgcn_s_getreg((3 << 11) | 20) & 0xFu; }
#define XB_SPIN(cond, bar) do { unsigned _sp = 0; while (cond) { __builtin_amdgcn_s_sleep(1); \
    if ((++_sp & 255u) == 0u) { if (xb_ld(&(bar)[XB_TMO])) break; if (_sp > XB_SPIN_CAP) { atomicAdd(&(bar)[XB_TMO], 1u); break; } } } } while (0)
struct XcdBarrier { unsigned* bar; unsigned x; volatile LASB unsigned* st; };
DI XcdBarrier xcd_barrier_post(unsigned* bar, volatile LASB unsigned* st) {
  XcdBarrier b; b.bar = bar; b.x = xb_xcc_id(); b.st = st;
  if (TIDX() == 0) (void)xb_add(&bar[XB_XCNT(b.x)], 1u);
  return b;
}
DI void xcd_barrier_complete(unsigned* bar, unsigned x, unsigned& nloc, unsigned& nx) {
  const unsigned G = gridDim.x;
  unsigned sum, cnt, mine, sp = 0u;
  for (;;) {
    sum = 0u; cnt = 0u; mine = 0u;
#pragma unroll
    for (unsigned j = 0; j < 16; ++j) { const unsigned c = xb_ld(&bar[XB_XCNT(j)]); sum += c; cnt += (c > 0u) ? 1u : 0u; mine = (j == x) ? c : mine; }
    if (sum == G) break;
    __builtin_amdgcn_s_sleep(1);
    if ((++sp & 255u) == 0u) { if (xb_ld(&bar[XB_TMO])) break; if (sp > XB_SPIN_CAP) { atomicAdd(&bar[XB_TMO], 1u); break; } }
  }
  nloc = mine > 0u ? mine : 1u; nx = cnt > 0u ? cnt : 1u;
}
DI void xcd_barrier(const XcdBarrier& b) {
  asm volatile("s_waitcnt vmcnt(0)" ::: "memory");
  __syncthreads();
  if (TIDX() == 0) {
    unsigned* bar = b.bar;
    __builtin_amdgcn_s_waitcnt(0);
    unsigned nloc = b.st[0], nx = b.st[1];
    if (nloc == 0u) { xcd_barrier_complete(bar, b.x, nloc, nx); b.st[0] = nloc; b.st[1] = nx; }
    const unsigned old = xb_add(&bar[XB_XSUB(b.x)], 1u);
    const unsigned gen = old / nloc;
    if (old + 1u == (gen + 1u) * nloc) {
      __builtin_amdgcn_fence(__ATOMIC_RELEASE, "agent");
      asm volatile("s_waitcnt vmcnt(0)" ::: "memory");
      const unsigned og = xb_add(&bar[XB_TOP], 1u);
      const unsigned tg = og / nx;
      if (og + 1u == (tg + 1u) * nx) xb_add(&bar[XB_TOPGEN], 1u);
      else XB_SPIN(xb_ld(&bar[XB_TOPGEN]) == tg, bar);
      __builtin_amdgcn_fence(__ATOMIC_ACQUIRE, "agent");
      xb_add(&bar[XB_XGEN(b.x)], 1u);
      asm volatile("s_waitcnt vmcnt(0)" ::: "memory");
    } else {
      XB_SPIN(xb_ld(&bar[XB_XGEN(b.x)]) == gen, bar);
      __builtin_amdgcn_fence(__ATOMIC_ACQUIRE, "agent");
      asm volatile("s_waitcnt vmcnt(0)" ::: "memory");
    }
  }
  __syncthreads();
}

template <int MODE>
DI int rowmap(int n, int row0) {
  if (MODE == 0) return n + row0;
  return n < 2816 ? (n >> 7) * 256 + (n & 127) : ((n - 2816) >> 7) * 256 + 128 + ((n - 2816) & 127);
}
template <int MODE>
DI void convT(const float* __restrict__ src, u16* __restrict__ dst, int K, int N, int row0, char* smem, int& base) {
  u16* tl = (u16*)smem;
  const int tid = TIDX();
  const int nN = N >> 6, nunits = (K >> 6) * nN;
  for (int u = first_unit(base); u < nunits; u += gridDim.x) {
    const int k0 = (u / nN) << 6, n0 = (u % nN) << 6;
#pragma unroll
    for (int i = 0; i < 2; ++i) {
      const int r = (tid >> 4) + 32 * i, c4 = (tid & 15) * 4;
      const float4 v = *(const float4*)(src + (size_t)(k0 + r) * N + n0 + c4);
      tl[(c4 + 0) * 72 + r] = f2bf(v.x); tl[(c4 + 1) * 72 + r] = f2bf(v.y);
      tl[(c4 + 2) * 72 + r] = f2bf(v.z); tl[(c4 + 3) * 72 + r] = f2bf(v.w);
    }
    __syncthreads();
    {
      const int n = tid >> 3, kc = (tid & 7) * 8;
      const uint4 v = *(const uint4*)(tl + n * 72 + kc);
      *(uint4*)(dst + (size_t)rowmap<MODE>(n0 + n, row0) * K + k0 + kc) = v;
    }
    __syncthreads();
  }
  base += nunits;
}

DI void convert_ffn_weights(const PV& p, int l, char* smem, int& base) {
  convT<1>(p.in(32) + (size_t)l * 1024 * 5632, (u16*)(p.ws() + OFF_WUP), 1024, 5632, 0, smem, base);
  convT<0>(p.in(35) + (size_t)l * 2816 * 1024, (u16*)(p.ws() + OFF_WDOWN), 2816, 1024, 0, smem, base);
}

DI void phase_prep(const PV& p, char* smem) {
  const int tid = TIDX();
  int base = 0;
  char* ws = p.ws();
  for (int i = 0; i < 2; ++i) {
    convT<0>(p.in(9) + (size_t)i * 1024 * 2560, (u16*)(ws + OFF_WMIXIN) + (size_t)i * 2560 * 1024, 1024, 2560, 0, smem, base);
    convT<0>(p.in(22) + (size_t)i * 1024 * 1024, (u16*)(ws + OFF_WMIXOUT) + (size_t)i * 1024 * 1024, 1024, 1024, 0, smem, base);
    convT<0>(p.in(23) + (size_t)i * 1024 * 512, (u16*)(ws + OFF_WDQKV) + (size_t)i * 1024 * 1024, 1024, 512, 0, smem, base);
    convT<0>(p.in(26) + (size_t)i * 1024 * 320, (u16*)(ws + OFF_WDQKV) + (size_t)i * 1024 * 1024, 1024, 320, 512, smem, base);
    convT<0>(p.in(25) + (size_t)i * 512 * 1536, (u16*)(ws + OFF_WUQ) + (size_t)i * 1536 * 512, 512, 1536, 0, smem, base);
    convT<0>(p.in(28) + (size_t)i * 256 * 2048, (u16*)(ws + OFF_WUKV) + (size_t)i * 2048 * 256, 256, 2048, 0, smem, base);
    convT<0>(p.in(31) + (size_t)i * 1024 * 1024, (u16*)(ws + OFF_WO) + (size_t)i * 1024 * 1024, 1024, 1024, 0, smem, base);
  }
  convert_ffn_weights(p, 0, smem, base);
  {
    const long gtid = (long)blockIdx.x * blockDim.x + tid, gsz = (long)gridDim.x * blockDim.x;
    for (long i = gtid; i < 2 * 192 * 1024; i += gsz) {
      const int j = (int)(i / (192 * 1024)), r = (int)(i % (192 * 1024));
      ((u16*)(ws + OFF_WDQKV))[(size_t)j * 1024 * 1024 + (size_t)832 * 1024 + r] = 0;
    }
    for (long i = gtid; i < 2 * 4 * 128 * 128; i += gsz) ((u16*)(ws + OFF_WSGU))[i] = f2bf(p.in(10)[i]);
    for (long i = gtid; i < 64 * 16; i += gsz) {
      const int pos = (int)(i >> 4), f = (int)(i & 15);
      const float inv = exp2f(-(float)f * (13.287712379549449f / 16.f));
      float sn, cs;
      sincosf((float)pos * inv, &sn, &cs);
      ((float2*)(ws + OFF_ROPE))[i] = make_float2(cs, sn);
    }
  }
  {
    float* sc = (float*)smem;
    float* part = sc + 9 * 1024;
    __syncthreads();
    for (int i = tid; i < 9 * 1024; i += 512) {
      const int r = i >> 10, k = i & 1023;
      const float c = r == 0 ? p.in(5)[k] : p.in(4)[(r - 1) * 1024 + k];
      sc[i] = silu(c);
    }
    __syncthreads();
    float* MOD = (float*)(ws + OFF_MOD);
    const int nunits = 4 * 96;
    for (int u = first_unit(base); u < nunits; u += gridDim.x) {
      const int l = u / 96, n0 = (u % 96) * 64;
      const int col = n0 + (tid & 63), kg = tid >> 6;
      float acc[9];
#pragma unroll
      for (int r = 0; r < 9; ++r) acc[r] = 0.f;
      const float* w = p.in(6) + (size_t)l * 1024 * 6144 + col;
#pragma unroll 4
      for (int k = kg * 128; k < kg * 128 + 128; ++k) {
        const float wv = w[(size_t)k * 6144];
#pragma unroll
        for (int r = 0; r < 9; ++r) acc[r] += sc[r * 1024 + k] * wv;
      }
#pragma unroll
      for (int r = 0; r < 9; ++r) part[(kg * 9 + r) * 64 + (tid & 63)] = acc[r];
      __syncthreads();
      for (int i = tid; i < 576; i += 512) {
        const int r = i >> 6, cc = i & 63;
        float s = p.in(7)[l * 6144 + n0 + cc];
#pragma unroll
        for (int g = 0; g < 8; ++g) s += part[(g * 9 + r) * 64 + cc];
        MOD[(size_t)(l * 9 + r) * 6144 + n0 + cc] = s;
      }
      __syncthreads();
    }
    base += nunits;
  }
  {
    float* zf = (float*)smem;
    float* h1 = zf + 8 * 36;
    float* H2 = (float*)(ws + OFF_H2);
    const int nunits = 2 * 544;
    for (int u = first_unit(base); u < nunits; u += gridDim.x) {
      const int i = u / 544, tg0 = (u % 544) * 8;
      __syncthreads();
      if (tid < 8 * 33) {
        const int tt = tid / 33, e = tid % 33;
        const int tg = tg0 + tt;
        const float L = tg < 256 ? 256.f : 4096.f;
        const float t = tg < 256 ? (float)tg : (float)(tg - 256);
        const float tn = t / L;
        float v;
        if (e == 0) v = tn;
        else if (e <= 16) v = sinf((6.283185307179586f * tn) * (float)e);
        else v = cosf((6.283185307179586f * tn) * (float)(e - 16));
        zf[tt * 36 + e] = v;
      }
      __syncthreads();
      const int tt = tid >> 6, jj = tid & 63;
      const float fr = p.in(19)[i * 64 + jj];
      {
        float a = p.in(15)[i * 64 + jj];
        const float* w1 = p.in(14) + (size_t)i * 33 * 64 + jj;
        for (int e = 0; e < 33; ++e) a += zf[tt * 36 + e] * w1[e * 64];
        h1[tt * 64 + jj] = sinf(fr * a);
      }
      __syncthreads();
      {
        float a = p.in(17)[i * 64 + jj];
        const float* w2 = p.in(16) + (size_t)i * 64 * 64 + jj;
        for (int e = 0; e < 64; ++e) a += h1[tt * 64 + e] * w2[e * 64];
        H2[((size_t)i * 4352 + tg0 + tt) * 64 + jj] = sinf(fr * a);
      }
    }
    base += nunits;
    __syncthreads();
  }
}

DI void phase_filters(const PV& p, char* smem) {
  const int tid = TIDX();
  float* w3s = (float*)smem;
  float* red = w3s + 512;
  float* nrm = red + 512;
  float* hbuf = nrm + 8;
  const float* H2 = (const float*)(p.ws() + OFF_H2);
  u16* FILT = (u16*)(p.ws() + OFF_FILT);
  for (int u = blockIdx.x; u < 512; u += gridDim.x) {
    const int kind = (u >> 7) & 1, i = u >> 8, cg8 = (u & 127) * 8;
    const int L = kind ? 4096 : 256, tbase = kind ? 256 : 0;
    __syncthreads();
    { const int j = tid >> 3, cc = tid & 7; w3s[j * 8 + cc] = p.in(18)[((size_t)i * 64 + j) * 1024 + cg8 + cc]; }
    __syncthreads();
    const int cc = tid & 7, tq = tid >> 3;
    const int col = cg8 + cc, o = col >> 9, c = col & 511;
    const float dec = fabsf(p.in(20)[(i * 2 + o) * 512 + c]);
    float asum = 0.f;
    for (int t = tq; t < L; t += 64) {
      const float4* hr = (const float4*)(H2 + ((size_t)i * 4352 + tbase + t) * 64);
      float a = 0.f;
#pragma unroll
      for (int j4 = 0; j4 < 16; ++j4) {
        const float4 hv = hr[j4];
        a += hv.x * w3s[(j4 * 4 + 0) * 8 + cc]; a += hv.y * w3s[(j4 * 4 + 1) * 8 + cc];
        a += hv.z * w3s[(j4 * 4 + 2) * 8 + cc]; a += hv.w * w3s[(j4 * 4 + 3) * 8 + cc];
      }
      const float dist = fabsf((float)(t - L / 2)) / (float)L;
      a *= expf(-dec * dist);
      hbuf[cc * L + t] = a;
      asum += fabsf(a);
    }
    red[tid] = asum;
    __syncthreads();
    if (tid < 8) { float s = 0.f; for (int q = 0; q < 64; ++q) s += red[q * 8 + tid]; nrm[tid] = 1.f / (s + EPS); }
    __syncthreads();
    for (int idx = tid; idx < 8 * L; idx += 512) {
      const int c2 = idx / L, t = idx - c2 * L;
      const int col2 = cg8 + c2, o2 = col2 >> 9, cch = col2 & 511;
      FILT[((size_t)(i * 2 + o2) * 512 + cch) * 4352 + tbase + t] = f2bf(hbuf[c2 * L + t] * nrm[c2]);
    }
  }
  __syncthreads();
}

DI void phase_norm(const PV& p, int l, int part, int lx) {
  const int tid_ = TIDX(); const int lane = tid_ & 63, wid = tid_ >> 6;
  const float* MOD = (const float*)(p.ws() + OFF_MOD);
  const float* g = p.in(8) + (size_t)(l * 2 + part) * 1024;
  u16* H = (u16*)(p.ws() + OFF_A + A_H);
  const int stride = gridDim.x * 8;
  for (int row0 = blockIdx.x * 8 + wid; row0 < T; row0 += 2 * stride) {
    float4 v[2][4];
#pragma unroll
    for (int w = 0; w < 2; ++w) {
      const int row = row0 + w * stride;
      if (row < T) {
        const float* xr = xin_row(p, lx, row);
#pragma unroll
        for (int i = 0; i < 4; ++i) v[w][i] = *(const float4*)(xr + (i * 64 + lane) * 4);
      }
    }
#pragma unroll
    for (int w = 0; w < 2; ++w) {
      const int row = row0 + w * stride;
      if (row < T) {
        float ss = 0.f;
#pragma unroll
        for (int i = 0; i < 4; ++i) ss += v[w][i].x * v[w][i].x + v[w][i].y * v[w][i].y + v[w][i].z * v[w][i].z + v[w][i].w * v[w][i].w;
        ss = wave_sum(ss, lane);
        const float r = rsqrtf(ss * (1.f / 1024.f) + EPS);
        const float* mr = MOD + (size_t)(l * 9 + condrow(row)) * 6144 + part * 3072;
#pragma unroll
        for (int i = 0; i < 4; ++i) {
          const int k = (i * 64 + lane) * 4;
          const float4 gv = *(const float4*)(g + k), sh = *(const float4*)(mr + k), sc = *(const float4*)(mr + 1024 + k);
          const float a = v[w][i].x * r * gv.x * (1.f + sc.x) + sh.x;
          const float b = v[w][i].y * r * gv.y * (1.f + sc.y) + sh.y;
          const float c = v[w][i].z * r * gv.z * (1.f + sc.z) + sh.z;
          const float d = v[w][i].w * r * gv.w * (1.f + sc.w) + sh.w;
          *(uint2*)(H + (size_t)row * 1024 + k) = pack4(a, b, c, d);
        }
      }
    }
  }
}

template <bool SWAP, class Epi, class Pre>
DI void gemm_tile(const u16* A, int lda, const u16* Bt, int ldb, int K, int m0, int n0, char* smem, Epi epi, Pre pre) {
  const int tid = TIDX(), lane = tid & 63, wid = tid >> 6;
  const int wm = wid >> 1, wn = wid & 1, fr = lane & 15, fq = lane >> 4;
  const int lrow = tid >> 3, kc = tid & 7;
  const u16* ga = A + (size_t)(m0 + lrow) * lda + kc * 8;
  const u16* gb = Bt + (size_t)(n0 + lrow) * ldb + kc * 8;
  const int soff = lrow * 128 + ((kc ^ (lrow & 7)) << 4);
  uint4 ra[4], rb[2];
  f32x4 acc[4][4];
#pragma unroll
  for (int i = 0; i < 4; ++i)
#pragma unroll
    for (int j = 0; j < 4; ++j) acc[i][j] = f32x4{0.f, 0.f, 0.f, 0.f};
  const int nk = K >> 6;
#pragma unroll
  for (int i = 0; i < 4; ++i) ra[i] = *(const uint4*)(ga + (size_t)(64 * i) * lda);
#pragma unroll
  for (int i = 0; i < 2; ++i) rb[i] = *(const uint4*)(gb + (size_t)(64 * i) * ldb);
#pragma unroll
  for (int i = 0; i < 4; ++i) *(uint4*)(smem + soff + i * 8192) = ra[i];
#pragma unroll
  for (int i = 0; i < 2; ++i) *(uint4*)(smem + 32768 + soff + i * 8192) = rb[i];
  __syncthreads();
  for (int kt = 0; kt < nk; ++kt) {
    const bool more = kt + 1 < nk;
    if (more) {
      const int k0 = (kt + 1) << 6;
#pragma unroll
      for (int i = 0; i < 4; ++i) ra[i] = *(const uint4*)(ga + (size_t)(64 * i) * lda + k0);
#pragma unroll
      for (int i = 0; i < 2; ++i) rb[i] = *(const uint4*)(gb + (size_t)(64 * i) * ldb + k0);
    }
    const char* sa = smem + (kt & 1) * 49152;
    const char* sb = sa + 32768;
#pragma unroll
    for (int ks = 0; ks < 2; ++ks) {
      bf16x8 af[4], bfv[4];
      const int co = ((ks * 4 + fq) ^ (fr & 7)) << 4;
#pragma unroll
      for (int mi = 0; mi < 4; ++mi) af[mi] = *(const bf16x8*)(sa + (wm * 64 + mi * 16 + fr) * 128 + co);
#pragma unroll
      for (int ni = 0; ni < 4; ++ni) bfv[ni] = *(const bf16x8*)(sb + (wn * 64 + ni * 16 + fr) * 128 + co);
#pragma unroll
      for (int mi = 0; mi < 4; ++mi)
#pragma unroll
        for (int ni = 0; ni < 4; ++ni)
          acc[mi][ni] = SWAP ? __builtin_amdgcn_mfma_f32_16x16x32_bf16(bfv[ni], af[mi], acc[mi][ni], 0, 0, 0)
                             : __builtin_amdgcn_mfma_f32_16x16x32_bf16(af[mi], bfv[ni], acc[mi][ni], 0, 0, 0);
    }
    if (more) {
      char* da = smem + ((kt + 1) & 1) * 49152;
#pragma unroll
      for (int i = 0; i < 4; ++i) *(uint4*)(da + soff + i * 8192) = ra[i];
#pragma unroll
      for (int i = 0; i < 2; ++i) *(uint4*)(da + 32768 + soff + i * 8192) = rb[i];
    }
    __syncthreads();
  }
  uint2 pv[4][4];
#pragma unroll
  for (int mi = 0; mi < 4; ++mi)
#pragma unroll
    for (int ni = 0; ni < 4; ++ni) {
      if (SWAP) pv[mi][ni] = pre(m0 + wm * 64 + mi * 16 + fr, n0 + wn * 64 + ni * 16 + fq * 4);
      else pv[mi][ni] = pre(m0 + wm * 64 + mi * 16 + fq * 4, n0 + wn * 64 + ni * 16 + fr);
    }
#pragma unroll
  for (int mi = 0; mi < 4; ++mi)
#pragma unroll
    for (int ni = 0; ni < 4; ++ni) {
      if (SWAP) epi(m0 + wm * 64 + mi * 16 + fr, n0 + wn * 64 + ni * 16 + fq * 4, acc[mi][ni], pv[mi][ni]);
      else epi(m0 + wm * 64 + mi * 16 + fq * 4, n0 + wn * 64 + ni * 16 + fr, acc[mi][ni], pv[mi][ni]);
    }
}

template <class F>
DI void for_tiles(int nM, int nN, int sm, int sn, F f) {
  if (gridDim.x == 256) {
    const int xcd = blockIdx.x & 7, slot = blockIdx.x >> 3;
    const int am = slot % sm, bn = slot / sm;
    const int nSN = (nN + sn - 1) / sn, nS = (nM / sm) * nSN;
    for (int st = xcd; st < nS; st += 8) {
      const int tm = (st / nSN) * sm + am, tn = (st % nSN) * sn + bn;
      if (tn < nN) f(tm, tn);
    }
  } else {
    for (int t = blockIdx.x; t < nM * nN; t += gridDim.x) f(t / nN, t % nN);
  }
}


#define LAS __attribute__((address_space(3)))
constexpr int G8_HTB = 128 * 64 * 2;
DI int g8_lds_byte(int r, int c) { const int st = (r >> 4) * 2 + (c >> 5), rr = r & 15, cc = c & 31, ob = rr * 64 + cc * 2; return st * 1024 + (ob ^ (((ob >> 9) & 1) << 5)); }
DI void g8_stage_rc(int b, int& R, int& C) { const int st = b / 1024, sb = b % 1024, swz = sb ^ (((sb >> 9) & 1) << 5); R = (st >> 1) * 16 + swz / 64; C = (st & 1) * 32 + (swz % 64) / 2; }
template <int NM, int NN, int NN1, int SM1, int SN1, int SM2, int SN2>
struct TileSched {
  static constexpr int nSN1 = NN1 / SN1, nS1 = (NM / SM1) * nSN1, nSN2 = (NN - NN1) / SN2, nS2 = (NM / SM2) * nSN2, nT = NM * NN;
  int c;
  DI void init() { c = blockIdx.x; }
  DI bool next(int i, int& pm, int& pn) const {
    if (gridDim.x == 256) {
      const int xcd = c & 7, slot = c >> 3;
      int st = xcd + 8 * i;
      if (st < nS1) { pm = (st / nSN1) * SM1 + slot % SM1; pn = (st % nSN1) * SN1 + slot / SM1; return true; }
      st -= nS1;
      if (nS2 == 0 || st >= nS2) return false;
      pm = (st / (nSN2 > 0 ? nSN2 : 1)) * SM2 + slot % SM2; pn = NN1 + (st % (nSN2 > 0 ? nSN2 : 1)) * SN2 + slot / SM2; return true;
    }
    const int L = i * (int)gridDim.x + c; if (L >= nT) return false; pm = L / NN; pn = L % NN; return true;
  }
};
template <bool ABLK = false, class Sched, class Epi>
DI void gemm8(char* smem, const u16* A, const u16* Bt, int K, const Sched& S, const Epi& E) {
  LAS unsigned char* lds = (LAS unsigned char*)smem;
  const int tid = TIDX(), wid = __builtin_amdgcn_readfirstlane(tid >> 6), lane = tid & 63, wr = wid >> 2, wc = wid & 3, fr = lane & 15, fq = lane >> 4;
  const int nt = K / 64;
  unsigned voff[2], voffA[2];
#pragma unroll
  for (int i = 0; i < 2; ++i) { int R, C; g8_stage_rc(tid * 16 + i * 8192, R, C); voff[i] = (unsigned)(R * K + C) * 2u; voffA[i] = ABLK ? (unsigned)(R * 64 + C) * 2u : voff[i]; }
  const size_t kstep = 128, hstep = (size_t)128 * K * 2, tstep = 2 * hstep;
  const size_t kstepA = ABLK ? 32768 : kstep, hstepA = ABLK ? 16384 : hstep;
  const unsigned ldsw = (unsigned)wid * 1024u;
  const int aoff = g8_lds_byte(wr * 64 + fr, fq * 8), boff = g8_lds_byte(wc * 32 + fr, fq * 8);
#define G8_SA(b, h) (((b) * 2 + (h)) * G8_HTB)
#define G8_SB(b, h) ((4 + (b) * 2 + (h)) * G8_HTB)
#define G8_STAGE(bufoff, gbase) do { _Pragma("unroll") for (int _i = 0; _i < 2; ++_i) \
    __builtin_amdgcn_global_load_lds((const unsigned*)((const char*)(gbase) + voff[_i]), (LAS unsigned*)(lds + (bufoff) + ldsw + _i * 8192), 16, 0, 0); } while (0)
#define G8_STAGEA(bufoff, gbase) do { _Pragma("unroll") for (int _i = 0; _i < 2; ++_i) \
    __builtin_amdgcn_global_load_lds((const unsigned*)((const char*)(gbase) + voffA[_i]), (LAS unsigned*)(lds + (bufoff) + ldsw + _i * 8192), 16, 0, 0); } while (0)
#define G8_LDA(dst, b, h) do { _Pragma("unroll") for (int m = 0; m < 4; ++m) _Pragma("unroll") for (int k = 0; k < 2; ++k) dst[m][k] = *(const LAS bf16x8*)(lds + G8_SA(b, h) + aoff + m * 2048 + k * 1024); } while (0)
#define G8_LDB(dst, b, h) do { _Pragma("unroll") for (int n = 0; n < 2; ++n) _Pragma("unroll") for (int k = 0; k < 2; ++k) dst[n][k] = *(const LAS bf16x8*)(lds + G8_SB(b, h) + boff + n * 2048 + k * 1024); } while (0)
#define G8_MMA(ai, bj, At_, Bt_) do { __builtin_amdgcn_s_setprio(1); _Pragma("unroll") for (int m = 0; m < 4; ++m) _Pragma("unroll") for (int n = 0; n < 2; ++n) _Pragma("unroll") for (int k = 0; k < 2; ++k) \
    acc[ai][bj][m][n] = __builtin_amdgcn_mfma_f32_16x16x32_bf16(Bt_[n][k], At_[m][k], acc[ai][bj][m][n], 0, 0, 0); __builtin_amdgcn_s_setprio(0); } while (0)
#define G8_WAIT_V(n) asm volatile("s_waitcnt vmcnt(" #n ")" ::: "memory")
#define G8_WAIT_L(n) asm volatile("s_waitcnt lgkmcnt(" #n ")" ::: "memory")
#define G8_BAR __builtin_amdgcn_s_barrier()
#define G8_SCHED __builtin_amdgcn_sched_barrier(0)
  int cpm, cpn, npm = 0, npn = 0, ui = 0;
  if (!S.next(0, cpm, cpn)) return;
  f32x4 acc[2][2][4][2];
#pragma unroll
  for (int a = 0; a < 2; ++a)
#pragma unroll
    for (int b = 0; b < 2; ++b)
#pragma unroll
      for (int m = 0; m < 4; ++m)
#pragma unroll
        for (int n = 0; n < 2; ++n) acc[a][b][m][n] = f32x4{0.f, 0.f, 0.f, 0.f};
  bf16x8 At[4][2], B0[2][2], B1[2][2];
  const char* cA = (const char*)A + (size_t)cpm * tstep; const char* cB = (const char*)Bt + (size_t)cpn * tstep;
  G8_STAGE(G8_SB(0, 0), cB); G8_STAGEA(G8_SA(0, 0), cA); G8_STAGE(G8_SB(0, 1), cB + hstep); G8_STAGEA(G8_SA(0, 1), cA + hstepA);
  if (wr == 1) G8_BAR;
  G8_WAIT_V(4); G8_BAR;
  G8_STAGE(G8_SB(1, 0), cB + kstep); G8_STAGEA(G8_SA(1, 0), cA + kstepA); G8_STAGE(G8_SB(1, 1), cB + hstep + kstep);
  G8_WAIT_V(6); G8_BAR;
  for (;;) {
    const bool has_next = S.next(ui + 1, npm, npn);
    const char* nA = has_next ? (const char*)A + (size_t)npm * tstep : cA; const char* nB = has_next ? (const char*)Bt + (size_t)npn * tstep : cB;
#pragma unroll 1
    for (int t = 0; t < nt; t += 2) {
      const bool last = (t == nt - 2);
      const char* a1 = cA + (size_t)(t + 1) * kstepA;
      const char* a2 = last ? nA : cA + (size_t)(t + 2) * kstepA; const char* b2 = last ? nB : cB + (size_t)(t + 2) * kstep;
      const char* a3 = a2 + kstepA; const char* b3 = b2 + kstep;
      G8_LDB(B0, 0, 0); G8_SCHED; G8_LDA(At, 0, 0); G8_STAGEA(G8_SA(1, 1), a1 + hstepA);
      G8_WAIT_L(8); G8_BAR; G8_WAIT_L(0); G8_MMA(0, 0, At, B0); G8_BAR; G8_SCHED;
      G8_LDB(B1, 0, 1); G8_STAGE(G8_SB(0, 0), b2);
      G8_BAR; G8_WAIT_L(0); G8_MMA(0, 1, At, B1); G8_BAR;
      G8_LDA(At, 0, 1); G8_STAGEA(G8_SA(0, 0), a2);
      G8_BAR; G8_WAIT_L(0); G8_MMA(1, 0, At, B0); G8_BAR; G8_SCHED;
      G8_STAGE(G8_SB(0, 1), b2 + hstep);
      G8_WAIT_V(6); G8_BAR; G8_MMA(1, 1, At, B1); G8_BAR;
      G8_LDB(B0, 1, 0); G8_SCHED; G8_LDA(At, 1, 0); G8_STAGEA(G8_SA(0, 1), a2 + hstepA);
      G8_WAIT_L(8); G8_BAR; G8_WAIT_L(0); G8_MMA(0, 0, At, B0); G8_BAR; G8_SCHED;
      G8_LDB(B1, 1, 1); G8_STAGE(G8_SB(1, 0), b3);
      G8_BAR; G8_WAIT_L(0); G8_MMA(0, 1, At, B1); G8_BAR;
      G8_LDA(At, 1, 1); G8_STAGEA(G8_SA(1, 0), a3);
      G8_BAR; G8_WAIT_L(0); G8_MMA(1, 0, At, B0); G8_BAR; G8_SCHED;
      G8_STAGE(G8_SB(1, 1), b3 + hstep);
      G8_WAIT_V(6); G8_BAR; G8_MMA(1, 1, At, B1); G8_BAR;
    }
    { const int t2 = TIDX(), w2 = __builtin_amdgcn_readfirstlane(t2 >> 6), l2 = t2 & 63; E(acc, cpm, cpn, w2 >> 2, w2 & 3, l2 & 15, l2 >> 4); }
    if (!has_next) break;
#pragma unroll
    for (int a = 0; a < 2; ++a)
#pragma unroll
      for (int b = 0; b < 2; ++b)
#pragma unroll
        for (int m = 0; m < 4; ++m)
#pragma unroll
          for (int n = 0; n < 2; ++n) acc[a][b][m][n] = f32x4{0.f, 0.f, 0.f, 0.f};
    cpm = npm; cpn = npn; cA = nA; cB = nB; ++ui;
  }
  G8_WAIT_V(0);
  if (wr == 0) G8_BAR;
  G8_BAR;
#undef G8_SA
#undef G8_SB
#undef G8_STAGE
#undef G8_STAGEA
#undef G8_LDA
#undef G8_LDB
#undef G8_MMA
#undef G8_WAIT_V
#undef G8_WAIT_L
#undef G8_BAR
#undef G8_SCHED
}
template <class F> struct ElemEpi {
  F f;
  DI void operator()(const f32x4 (&acc)[2][2][4][2], int pm, int pn, int wr, int wc, int fr, int fq) const {
    const int row0 = pm * 256 + wr * 64 + fr, col0 = pn * 256 + wc * 32 + 4 * fq;
#pragma unroll
    for (int ai = 0; ai < 2; ++ai)
#pragma unroll
      for (int m = 0; m < 4; ++m)
#pragma unroll
        for (int bj = 0; bj < 2; ++bj)
#pragma unroll
          for (int n = 0; n < 2; ++n) f(row0 + ai * 128 + m * 16, col0 + bj * 128 + n * 16, acc[ai][bj][m][n]);
  }
};
template <class F> DI ElemEpi<F> make_epi(F f) { return ElemEpi<F>{f}; }
template <int NM, int NN, int NN1, int SM1, int SN1, int SM2, int SN2, class F>
DI void gemm8_job(char* smem, const u16* A, const u16* Bt, int K, F f) {
  TileSched<NM, NN, NN1, SM1, SN1, SM2, SN2> S; S.init();
  gemm8(smem, A, Bt, K, S, make_epi(f));
}

DI void phase_mix_in(const PV& p, int i, char* smem) {
  const u16* H = (const u16*)(p.ws() + OFF_A + A_H);
  const u16* W = (const u16*)(p.ws() + OFF_WMIXIN) + (size_t)i * 2560 * 1024;
  u16* MIX = (u16*)(p.ws() + OFF_B + B_MIX);
  u16* VT = (u16*)(p.ws() + OFF_B + B_VT);
  u16* PRT = (u16*)(p.ws() + OFF_B + B_PRT);
  auto epi = [=](int m, int n, f32x4 v) {
    if (n < 512) {
      *(uint2*)(MIX + (size_t)m * 1024 + n) = pack4(gelu_tanh(v[0]), gelu_tanh(v[1]), gelu_tanh(v[2]), gelu_tanh(v[3]));
    } else if (n < 1024) {
      const int nn = n - 512, g = nn >> 7, c = nn & 127, chunk = m >> 7, q = m & 127;
      u16* b = VT + ((size_t)(g * 320 + chunk) * 128 + c) * 128 + q;
#pragma unroll
      for (int j = 0; j < 4; ++j) b[j * 128] = f2bf(gelu_tanh(v[j]));
    } else {
      const int cp = n - 1024;
      size_t off; int stride;
      if (m < TP) { off = (size_t)(m & ~255) * 1536 + (size_t)cp * 256 + (m & 255); stride = 256; }
      else { const int mm = m - TP; off = (size_t)(TP + (mm & ~4095)) * 1536 + (size_t)cp * 4096 + (mm & 4095); stride = 4096; }
#pragma unroll
      for (int j = 0; j < 4; ++j) PRT[off + (size_t)j * stride] = f2bf(v[j]);
    }
  };
  gemm8_job<160, 10, 8, 8, 4, 16, 2>(smem, H, W, 1024, epi);
}

DI void phase_sgu(const PV& p, int i, char* smem) {
  const u16* VT = (const u16*)(p.ws() + OFF_B + B_VT);
  const u16* W = (const u16*)(p.ws() + OFF_WSGU) + (size_t)i * 4 * 16384;
  u16* MIX = (u16*)(p.ws() + OFF_B + B_MIX);
  const float* sb = p.in(11) + i * 512;
  for (int u = blockIdx.x; u < 640; u += gridDim.x) {
    const int g = u / 160, tm = u % 160;
    auto epi = [=](int m, int n, f32x4 v, uint2 uu) {
      const int chunk = m >> 7, c = m & 127;
      const int t = chunk * 128 + n;
      const float bias = sb[g * 128 + n];
      u16* dst = MIX + (size_t)t * 1024 + g * 128 + c;
      *(uint2*)dst = pack4(lo16(uu.x) * (v[0] + bias), hi16(uu.x) * (v[1] + bias), lo16(uu.y) * (v[2] + bias), hi16(uu.y) * (v[3] + bias));
    };
    auto pre = [=](int m, int n) { return *(const uint2*)(MIX + (size_t)((m >> 7) * 128 + n) * 1024 + g * 128 + (m & 127)); };
    gemm_tile<false>(VT + (size_t)g * 320 * 128 * 128, 128, W + (size_t)g * 16384, 128, 128, tm * 256, 0, smem, epi, pre);
  }
}

DI size_t prt_off(int kind, int b, int cp) {
  return kind ? (size_t)(TP + b * 4096) * 1536 + (size_t)cp * 4096 : (size_t)(b * 256) * 1536 + (size_t)cp * 256;
}
DI size_t zt_off(int kind, int b, int c) {
  return kind ? (size_t)(TP + b * 4096) * 512 + (size_t)c * 4096 : (size_t)(b * 256) * 512 + (size_t)c * 256;
}
DI void phase_conv(const PV& p, int i, int ord, char* smem) {
  const int tid = TIDX(), lane = tid & 63, wid = tid >> 6;
  const u16* PRT = (const u16*)(p.ws() + OFF_B + B_PRT);
  const u16* FILT = (const u16*)(p.ws() + OFF_FILT);
  const u16* Z1 = (const u16*)(p.ws() + OFF_A + A_Z1);
  u16* ZO = (u16*)(p.ws() + OFF_A + (ord ? A_Z2 : A_Z1));
  const float* cw = p.in(12) + (size_t)i * 3 * 1536;
  const float* cb = p.in(13) + (size_t)i * 1536;
  u16* hc = (u16*)smem;
  char* Ub = smem + 68096;
  for (int u = blockIdx.x; u < 1024; u += gridDim.x) {
    const int kind = u < 512 ? 1 : 0, c = u & 511;
    const int L = kind ? 4096 : 256, NB = kind ? 8 : 32, LB = L >> 6, DD = L >> 7;
    const int US = (L + 8) * 2;
    const size_t fbase = ((size_t)(i * 2 + ord) * 512 + c) * 4352 + (kind ? 256 : 0);
    __syncthreads();
    {
      u16* tmp = (u16*)Ub;
      for (int idx = tid; idx < (L >> 3); idx += 512) *(uint4*)(tmp + idx * 8) = *(const uint4*)(FILT + fbase + idx * 8);
      __syncthreads();
      for (int idx = tid; idx < 8 * (L + 136); idx += 512) {
        const int cpy = idx / (L + 136), m = idx - cpy * (L + 136);
        const int x = L + 63 - m - cpy;
        hc[cpy * 4256 + m] = (x >= 0 && x < L) ? tmp[x] : (u16)0;
      }
      __syncthreads();
    }
    {
      const int ncr = L >> 3, total = NB * ncr;
      const float w0 = cw[c], w1 = cw[1536 + c], w2 = cw[3072 + c], bb = cb[c];
      for (int id = tid; id < total; id += 512) {
        const int b = id / ncr, t = (id - b * ncr) * 8;
        uint4 o;
        if (ord == 0) {
          const u16* src = PRT + prt_off(kind, b, c) + t;
          const uint4 raw = *(const uint4*)src;
          float e[10];
          e[0] = t > 0 ? bf2f(src[-1]) : 0.f;
          e[9] = t + 8 < L ? bf2f(src[8]) : 0.f;
          e[1] = lo16(raw.x); e[2] = hi16(raw.x); e[3] = lo16(raw.y); e[4] = hi16(raw.y);
          e[5] = lo16(raw.z); e[6] = hi16(raw.z); e[7] = lo16(raw.w); e[8] = hi16(raw.w);
          float r[8];
#pragma unroll
          for (int k = 0; k < 8; ++k) r[k] = w0 * e[k] + w1 * e[k + 1] + w2 * e[k + 2] + bb;
          o.x = pack2(r[0], r[1]); o.y = pack2(r[2], r[3]); o.z = pack2(r[4], r[5]); o.w = pack2(r[6], r[7]);
        } else {
          o = *(const uint4*)(Z1 + zt_off(kind, b, c) + t);
        }
        *(uint4*)(Ub + b * US + t * 2) = o;
      }
    }
    __syncthreads();
    const int ncols = LB * NB;
    if (wid * 64 < ncols) {
      const int il = lane & 31, q = lane >> 5;
      int t1c[2], bc[2];
#pragma unroll
      for (int nt = 0; nt < 2; ++nt) { const int col = wid * 64 + nt * 32 + il; t1c[nt] = col / NB; bc[nt] = col % NB; }
      const int t1lo = (wid * 64) / NB, t1hi = (wid * 64 + 63) / NB;
      const int dlo = max(-DD, t1lo - (LB - 1)), dhi = min(DD, t1hi);
      const int cpy = 7 - (il & 7);
      const char* abase = (const char*)hc + cpy * 8512 + 2 * (L / 2 + 63 - il - cpy + 8 * q);
      f32x16 acc[2][2];
#pragma unroll
      for (int a = 0; a < 2; ++a)
#pragma unroll
        for (int b = 0; b < 2; ++b)
#pragma unroll
          for (int r = 0; r < 16; ++r) acc[a][b][r] = 0.f;
      for (int d = dlo; d <= dhi; ++d) {
        bf16x8 bfr[2][4];
#pragma unroll
        for (int nt = 0; nt < 2; ++nt) {
          const int s1 = t1c[nt] - d;
          const bool valid = s1 >= 0 && s1 < LB;
          const char* bp = Ub + bc[nt] * US + ((valid ? s1 : 0) * 64 + 8 * q) * 2;
#pragma unroll
          for (int ks = 0; ks < 4; ++ks) {
            bf16x8 v = *(const bf16x8*)(bp + ks * 32);
            if (!valid) v = bf16x8{0, 0, 0, 0, 0, 0, 0, 0};
            bfr[nt][ks] = v;
          }
        }
#pragma unroll
        for (int mt = 0; mt < 2; ++mt)
#pragma unroll
          for (int ks = 0; ks < 4; ++ks) {
            const bf16x8 af = *(const bf16x8*)(abase + 2 * (-64 * d - 32 * mt + 16 * ks));
#pragma unroll
            for (int nt = 0; nt < 2; ++nt) acc[mt][nt] = __builtin_amdgcn_mfma_f32_32x32x16_bf16(af, bfr[nt][ks], acc[mt][nt], 0, 0, 0);
          }
      }
      const float dsk = p.in(21)[(i * 2 + ord) * 512 + c];
      const int gc = 512 * (ord + 1) + c;
      const float w0 = cw[gc], w1 = cw[1536 + gc], w2 = cw[3072 + gc], bb = cb[gc];
#pragma unroll
      for (int nt = 0; nt < 2; ++nt) {
        const int b = bc[nt];
        const u16* xrow = PRT + prt_off(kind, b, gc);
        u16* orow = ZO + zt_off(kind, b, c);
#pragma unroll
        for (int mt = 0; mt < 2; ++mt)
#pragma unroll
          for (int g = 0; g < 4; ++g) {
            const int t = 64 * t1c[nt] + mt * 32 + 8 * g + 4 * q;
            const uint2 uu = *(const uint2*)(Ub + b * US + t * 2);
            const uint2 xx = *(const uint2*)(xrow + t);
            const float em = t > 0 ? bf2f(xrow[t - 1]) : 0.f;
            const float ep = t + 4 < L ? bf2f(xrow[t + 4]) : 0.f;
            const float e0 = lo16(xx.x), e1 = hi16(xx.x), e2 = lo16(xx.y), e3 = hi16(xx.y);
            const float x0 = w0 * em + w1 * e0 + w2 * e1 + bb;
            const float x1 = w0 * e0 + w1 * e1 + w2 * e2 + bb;
            const float x2 = w0 * e1 + w1 * e2 + w2 * e3 + bb;
            const float x3 = w0 * e2 + w1 * e3 + w2 * ep + bb;
            const float y0 = acc[mt][nt][4 * g + 0] + lo16(uu.x) * dsk;
            const float y1 = acc[mt][nt][4 * g + 1] + hi16(uu.x) * dsk;
            const float y2 = acc[mt][nt][4 * g + 2] + lo16(uu.y) * dsk;
            const float y3 = acc[mt][nt][4 * g + 3] + hi16(uu.y) * dsk;
            *(uint2*)(orow + t) = pack4(x0 * y0, x1 * y1, x2 * y2, x3 * y3);
          }
      }
    }
  }
  __syncthreads();
}

DI void phase_ztrans(const PV& p, char* smem) {
  const int tid = TIDX();
  const u16* Z2 = (const u16*)(p.ws() + OFF_A + A_Z2);
  u16* MIX = (u16*)(p.ws() + OFF_B + B_MIX);
  u16* tl = (u16*)smem;
  for (int u = blockIdx.x; u < 640 * 8; u += gridDim.x) {
    const int tt0 = (u >> 3) * 64, c0 = (u & 7) * 64;
    const int kind = tt0 >= TP ? 1 : 0;
    const int b = kind ? (tt0 - TP) >> 12 : tt0 >> 8;
    const int tl0 = kind ? (tt0 - TP) & 4095 : tt0 & 255;
    __syncthreads();
    { const int c = tid >> 3, ch = tid & 7;
      *(uint4*)(tl + c * 72 + ch * 8) = *(const uint4*)(Z2 + zt_off(kind, b, c0 + c) + tl0 + ch * 8); }
    __syncthreads();
    { const int tr = tid >> 3, cc = (tid & 7) * 8;
      uint4 o;
      o.x = (unsigned)tl[(cc + 0) * 72 + tr] | ((unsigned)tl[(cc + 1) * 72 + tr] << 16);
      o.y = (unsigned)tl[(cc + 2) * 72 + tr] | ((unsigned)tl[(cc + 3) * 72 + tr] << 16);
      o.z = (unsigned)tl[(cc + 4) * 72 + tr] | ((unsigned)tl[(cc + 5) * 72 + tr] << 16);
      o.w = (unsigned)tl[(cc + 6) * 72 + tr] | ((unsigned)tl[(cc + 7) * 72 + tr] << 16);
      *(uint4*)(MIX + (size_t)(tt0 + tr) * 1024 + 512 + c0 + cc) = o; }
  }
  __syncthreads();
}

struct EpiResid {
  float* X; const float* x0; const float* x1; const float* gate; int lx;
  DI void operator()(const f32x4 (&acc)[2][2][4][2], int pm, int pn, int wr, int wc, int fr, int fq) const {
    const int rowt = pm * 256, col0 = pn * 256 + wc * 32 + 4 * fq;
    const float* gr = gate + (size_t)condrow(rowt) * 6144 + col0;
    const float* xb = lx == 0 ? (rowt < TP ? x0 + (size_t)rowt * 1024 : x1 + (size_t)(rowt - TP) * 1024) : X + (size_t)rowt * 1024;
    float4 g[2][2];
#pragma unroll
    for (int bj = 0; bj < 2; ++bj)
#pragma unroll
      for (int n = 0; n < 2; ++n) g[bj][n] = *(const float4*)(gr + bj * 128 + n * 16);
#pragma unroll
    for (int ai = 0; ai < 2; ++ai)
#pragma unroll
      for (int mh = 0; mh < 2; ++mh) {
        float4 xo[2][2][2];
#pragma unroll
        for (int mm = 0; mm < 2; ++mm)
#pragma unroll
          for (int bj = 0; bj < 2; ++bj)
#pragma unroll
            for (int n = 0; n < 2; ++n)
              xo[mm][bj][n] = *(const float4*)(xb + (size_t)(wr * 64 + fr + ai * 128 + (2 * mh + mm) * 16) * 1024 + col0 + bj * 128 + n * 16);
#pragma unroll
        for (int mm = 0; mm < 2; ++mm)
#pragma unroll
          for (int bj = 0; bj < 2; ++bj)
#pragma unroll
            for (int n = 0; n < 2; ++n) {
              const f32x4 v = acc[ai][bj][2 * mh + mm][n];
              const float4 x = xo[mm][bj][n], gg = g[bj][n];
              float4 o; o.x = x.x + gg.x * v[0]; o.y = x.y + gg.y * v[1]; o.z = x.z + gg.z * v[2]; o.w = x.w + gg.w * v[3];
              *(float4*)(X + (size_t)(rowt + wr * 64 + fr + ai * 128 + (2 * mh + mm) * 16) * 1024 + col0 + bj * 128 + n * 16) = o;
            }
      }
  }
};
DI void phase_resid_gemm(const PV& p, int l, int lx, const u16* A, int K, const u16* W, int goff, char* smem) {
  EpiResid E;
  E.X = p.out(); E.x0 = p.in(0); E.x1 = p.in(1); E.gate = (const float*)(p.ws() + OFF_MOD) + (size_t)l * 9 * 6144 + goff; E.lx = lx;
  TileSched<160, 4, 4, 8, 4, 32, 1> S; S.init();
  if (K == 2816) gemm8<true>(smem, A, W, K, S, E);
  else gemm8<false>(smem, A, W, K, S, E);
}

DI void phase_dqkv(const PV& p, int j, char* smem) {
  const u16* H = (const u16*)(p.ws() + OFF_A + A_H);
  const u16* W = (const u16*)(p.ws() + OFF_WDQKV) + (size_t)j * 1024 * 1024;
  u16* DQKV = (u16*)(p.ws() + OFF_B + B_DQKV);
  u16* KR = (u16*)(p.ws() + OFF_KR);
  float* okr = p.out() + 46137344;
  auto epi = [=](int m, int n, f32x4 v) {
    if (n < 832) {
      const uint2 pk = pack4(v[0], v[1], v[2], v[3]);
      *(uint2*)(DQKV + (size_t)m * 896 + n) = pk;
      if (n >= 768) {
        const int e = n - 768;
        *(uint2*)(KR + (size_t)m * 64 + e) = pk;
        if (m < TP) {
          float4 o; o.x = v[0]; o.y = v[1]; o.z = v[2]; o.w = v[3];
          *(float4*)(okr + ((size_t)((m >> 8) * 2 + j) * 256 + (m & 255)) * 64 + e) = o;
        }
      }
    }
  };
  gemm8_job<160, 4, 4, 8, 4, 32, 1>(smem, H, W, 1024, epi);
}

DI void phase_mla_norms(const PV& p, int j) {
  const int tid_ = TIDX(); const int lane = tid_ & 63, wid = tid_ >> 6;
  const u16* DQKV = (const u16*)(p.ws() + OFF_B + B_DQKV);
  u16* QN = (u16*)(p.ws() + OFF_A + A_QN);
  u16* CKV = (u16*)(p.ws() + OFF_A + A_CKV);
  u16* KR = (u16*)(p.ws() + OFF_KR);
  float* ockv = p.out() + 41943040;
  const float* qn = p.in(24) + j * 512;
  const float* kvn = p.in(27) + j * 256;
  for (int t = blockIdx.x * 8 + wid; t < TK; t += gridDim.x * 8) {
    if (t < T) {
      const u16* row = DQKV + (size_t)t * 896;
      const uint4 a = *(const uint4*)(row + lane * 8);
      float q[8] = {lo16(a.x), hi16(a.x), lo16(a.y), hi16(a.y), lo16(a.z), hi16(a.z), lo16(a.w), hi16(a.w)};
      float ss = 0.f;
#pragma unroll
      for (int k = 0; k < 8; ++k) ss += q[k] * q[k];
      ss = wave_sum(ss, lane);
      const float r = rsqrtf(ss * (1.f / 512.f) + EPS);
      const float4 g0 = *(const float4*)(qn + lane * 8), g1 = *(const float4*)(qn + lane * 8 + 4);
      uint4 o;
      o.x = pack2(q[0] * r * g0.x, q[1] * r * g0.y); o.y = pack2(q[2] * r * g0.z, q[3] * r * g0.w);
      o.z = pack2(q[4] * r * g1.x, q[5] * r * g1.y); o.w = pack2(q[6] * r * g1.z, q[7] * r * g1.w);
      *(uint4*)(QN + (size_t)t * 512 + lane * 8) = o;
      const uint2 b = *(const uint2*)(row + 512 + lane * 4);
      float kv[4] = {lo16(b.x), hi16(b.x), lo16(b.y), hi16(b.y)};
      float s2 = kv[0] * kv[0] + kv[1] * kv[1] + kv[2] * kv[2] + kv[3] * kv[3];
      s2 = wave_sum(s2, lane);
      const float r2 = rsqrtf(s2 * (1.f / 256.f) + EPS);
      const float4 g2 = *(const float4*)(kvn + lane * 4);
      float4 o2; o2.x = kv[0] * r2 * g2.x; o2.y = kv[1] * r2 * g2.y; o2.z = kv[2] * r2 * g2.z; o2.w = kv[3] * r2 * g2.w;
      *(uint2*)(CKV + (size_t)t * 256 + lane * 4) = pack4(o2.x, o2.y, o2.z, o2.w);
      if (t < TP) *(float4*)(ockv + ((size_t)((t >> 8) * 2 + j) * 256 + (t & 255)) * 256 + lane * 4) = o2;
    } else {
      const int pp = t - T, b = pp >> 8, s = pp & 255;
      const float4 v = *(const float4*)(p.in(2) + ((size_t)(b * 2 + j) * 256 + s) * 256 + lane * 4);
      *(uint2*)(CKV + (size_t)t * 256 + lane * 4) = pack4(v.x, v.y, v.z, v.w);
      if (lane < 16) {
        const float4 w = *(const float4*)(p.in(3) + ((size_t)(b * 2 + j) * 256 + s) * 64 + lane * 4);
        *(uint2*)(KR + (size_t)t * 64 + lane * 4) = pack4(w.x, w.y, w.z, w.w);
      }
    }
  }
}

DI size_t vt_off(int m, int h, int d) {
  if (m < TP) return ((size_t)((m >> 8) * 8 + h) * 128 + d) * 256 + (m & 255);
  if (m < T) { const int mm = m - TP; return VT_SAMPLE_OFF + ((size_t)((mm >> 12) * 8 + h) * 128 + d) * 4352 + (mm & 4095); }
  const int mm = m - T;
  return VT_SAMPLE_OFF + ((size_t)((mm >> 8) * 8 + h) * 128 + d) * 4352 + 4096 + (mm & 255);
}
struct EpiKV {
  u16* Kb; u16* Vt;
  DI void operator()(const f32x4 (&acc)[2][2][4][2], int pm, int pn, int wr, int wc, int fr, int fq) const {
    const int h = pn;
    const int rowt = pm * 256;
    const unsigned ls = rowt < TP ? 256u : 4352u;
    unsigned vbase;
    if (rowt < TP) vbase = (unsigned)(((rowt >> 8) * 8 + h) * 128) * 256u;
    else if (rowt < T) { const int mm = rowt - TP; vbase = (unsigned)VT_SAMPLE_OFF + (unsigned)(((mm >> 12) * 8 + h) * 128) * 4352u + (unsigned)(mm & 4095); }
    else { const int mm = rowt - T; vbase = (unsigned)VT_SAMPLE_OFF + (unsigned)(((mm >> 8) * 8 + h) * 128) * 4352u + 4096u + (unsigned)(mm & 255); }
    const unsigned dcol = (unsigned)(wc * 32 + 4 * fq);
#pragma unroll
    for (int ai = 0; ai < 2; ++ai)
#pragma unroll
      for (int m = 0; m < 4; ++m) {
        const int rl = ai * 128 + wr * 64 + m * 16 + fr;
        const unsigned ko = (unsigned)((rowt + rl) * 8 + h) * 192u + dcol;
        const unsigned frp = (unsigned)((fr & 3) | ((fr & 4) << 1) | ((fr & 8) >> 1));
        const unsigned vo = vbase + (unsigned)(rl & ~15) + frp + dcol * ls;
#pragma unroll
        for (int n = 0; n < 2; ++n) {
          const f32x4 k = acc[ai][0][m][n], v = acc[ai][1][m][n];
          *(uint2*)(Kb + (ko + n * 16)) = pack4(k[0], k[1], k[2], k[3]);
          const unsigned p01 = pack2(v[0], v[1]), p23 = pack2(v[2], v[3]);
          const unsigned vq = vo + (unsigned)(n * 16) * ls;
          Vt[vq] = (u16)p01; Vt[vq + ls] = (u16)(p01 >> 16); Vt[vq + 2 * ls] = (u16)p23; Vt[vq + 3 * ls] = (u16)(p23 >> 16);
        }
      }
  }
};
DI void phase_uq_ukv(const PV& p, int j, char* smem) {
  const u16* QN = (const u16*)(p.ws() + OFF_A + A_QN);
  const u16* CKV = (const u16*)(p.ws() + OFF_A + A_CKV);
  const u16* WQ = (const u16*)(p.ws() + OFF_WUQ) + (size_t)j * 1536 * 512;
  const u16* WKV = (const u16*)(p.ws() + OFF_WUKV) + (size_t)j * 2048 * 256;
  u16* Q = (u16*)(p.ws() + OFF_B + B_Q);
  u16* Kb = (u16*)(p.ws() + OFF_B + B_K);
  u16* Vt = (u16*)(p.ws() + OFF_B + B_V);
  auto epiq = [=](int m, int n, f32x4 v) { *(uint2*)(Q + (size_t)m * 1536 + n) = pack4(v[0], v[1], v[2], v[3]); };
  gemm8_job<160, 6, 4, 8, 4, 16, 2>(smem, QN, WQ, 512, epiq);
  EpiKV E; E.Kb = Kb; E.Vt = Vt;
  TileSched<168, 8, 8, 8, 4, 32, 1> S; S.init();
  gemm8(smem, CKV, WKV, 256, S, E);
}

DI void phase_finalize(const PV& p, int j) {
  const int tid_ = TIDX(); const int lane = tid_ & 63, wid = tid_ >> 6;
  const int h = lane >> 3, l8 = lane & 7;
  u16* Q = (u16*)(p.ws() + OFF_B + B_Q);
  u16* Kb = (u16*)(p.ws() + OFF_B + B_K);
  const u16* KR = (const u16*)(p.ws() + OFF_KR);
  const float2* ROPE = (const float2*)(p.ws() + OFF_ROPE);
  const float* qhn = p.in(29) + j * 192;
  const float* khn = p.in(30) + j * 192;
  const float QSCALE = 1.4426950408889634f * 0.07216878364870322f;
  const int stride = gridDim.x * 8;
  for (int u0 = blockIdx.x * 8 + wid; u0 < T + TK; u0 += 2 * stride) {
    uint4 raw[2][3];
    u16* basep[2];
#pragma unroll
    for (int w = 0; w < 2; ++w) {
      const int u = u0 + w * stride;
      if (u < T + TK) {
        const bool isq = u < T;
        const int t = isq ? u : u - T;
        u16* base = isq ? Q + (size_t)t * 1536 + h * 192 : Kb + ((size_t)t * 8 + h) * 192;
        basep[w] = base;
#pragma unroll
        for (int k = 0; k < 3; ++k) {
          const u16* src = (!isq && k == 2) ? KR + (size_t)t * 64 + 8 * l8 : base + 8 * (l8 + 8 * k);
          raw[w][k] = *(const uint4*)src;
        }
      }
    }
#pragma unroll
    for (int w = 0; w < 2; ++w) {
      const int u = u0 + w * stride;
      if (u < T + TK) {
        const bool isq = u < T;
        const int t = isq ? u : u - T;
        const float* hn = isq ? qhn : khn;
        float v[3][8];
#pragma unroll
        for (int k = 0; k < 3; ++k) {
          const uint4 a = raw[w][k];
          v[k][0] = lo16(a.x); v[k][1] = hi16(a.x); v[k][2] = lo16(a.y); v[k][3] = hi16(a.y);
          v[k][4] = lo16(a.z); v[k][5] = hi16(a.z); v[k][6] = lo16(a.w); v[k][7] = hi16(a.w);
        }
        float ss = 0.f;
#pragma unroll
        for (int k = 0; k < 3; ++k)
#pragma unroll
          for (int e = 0; e < 8; ++e) ss += v[k][e] * v[k][e];
        ss += shx<1>(ss, lane); ss += shx<2>(ss, lane); ss += shx<4>(ss, lane);
        const float r = rsqrtf(ss * (1.f / 192.f) + EPS);
#pragma unroll
        for (int k = 0; k < 3; ++k) {
          const float4 g0 = *(const float4*)(hn + 8 * (l8 + 8 * k)), g1 = *(const float4*)(hn + 8 * (l8 + 8 * k) + 4);
          v[k][0] *= r * g0.x; v[k][1] *= r * g0.y; v[k][2] *= r * g0.z; v[k][3] *= r * g0.w;
          v[k][4] *= r * g1.x; v[k][5] *= r * g1.y; v[k][6] *= r * g1.z; v[k][7] *= r * g1.w;
        }
        if (t >= TP && t < T) {
          const int tl = (t - TP) & 4095;
          const int pos = l8 < 4 ? (tl >> 6) : (tl & 63);
          const float4* rp = (const float4*)(ROPE + pos * 16 + (l8 & 1) * 8);
          const float4 c01 = rp[0], c23 = rp[1], c45 = rp[2], c67 = rp[3];
          const float cs[8] = {c01.x, c01.z, c23.x, c23.z, c45.x, c45.z, c67.x, c67.z};
          const float sn[8] = {c01.y, c01.w, c23.y, c23.w, c45.y, c45.w, c67.y, c67.w};
#pragma unroll
          for (int e = 0; e < 8; ++e) {
            const float x = v[2][e];
            const float partner = shx<2>(x, lane);
            v[2][e] = (l8 & 2) ? x * cs[e] + partner * sn[e] : x * cs[e] - partner * sn[e];
          }
        }
        const float sc = isq ? QSCALE : 1.f;
#pragma unroll
        for (int k = 0; k < 3; ++k) {
          uint4 o;
          o.x = pack2(v[k][0] * sc, v[k][1] * sc); o.y = pack2(v[k][2] * sc, v[k][3] * sc);
          o.z = pack2(v[k][4] * sc, v[k][5] * sc); o.w = pack2(v[k][6] * sc, v[k][7] * sc);
          *(uint4*)(basep[w] + 8 * (l8 + 8 * k)) = o;
        }
      }
    }
  }
}

DI void attn_item(const PV& p, int kind, int seq, int h, int q0, char* smem) {
  const int tid = TIDX(), lane = tid & 63, wid = tid >> 6;
  const int il = lane & 31, hh = lane >> 5;
  const u16* Q = (const u16*)(p.ws() + OFF_B + B_Q);
  const u16* Kb = (const u16*)(p.ws() + OFF_B + B_K);
  const u16* Vt = (const u16*)(p.ws() + OFF_B + B_V);
  u16* O = (u16*)(p.ws() + OFF_A + A_O);
  const int Lk = kind ? 4352 : 256, nkt = Lk >> 6;
  const u16* vbase = Vt + (kind ? VT_SAMPLE_OFF + (size_t)(seq * 8 + h) * 128 * 4352 : (size_t)(seq * 8 + h) * 128 * 256);
  const int tq = q0 + wid * 32 + il;
  bf16x8 qf[12];
#pragma unroll
  for (int ks = 0; ks < 12; ++ks) qf[ks] = *(const bf16x8*)(Q + ((size_t)tq * 8 + h) * 192 + 16 * ks + 8 * hh);
  f32x16 oacc[4];
#pragma unroll
  for (int a = 0; a < 4; ++a)
#pragma unroll
    for (int r = 0; r < 16; ++r) oacc[a][r] = 0.f;
  float mrun = -INFINITY, lrun = 0.f;
  const int sw = (il >> 1) & 7;
  int ko[4], vob[4];
#pragma unroll
  for (int a = 0; a < 4; ++a) ko[a] = il * 384 + (((2 * a + hh) ^ sw) << 4);
#pragma unroll
  for (int c = 0; c < 4; ++c) vob[c] = il * 128 + (((2 * c + hh) ^ sw) << 4);
  LAS unsigned char* lds = (LAS unsigned char*)smem;
  unsigned kso[3], vso[2];
#pragma unroll
  for (int i = 0; i < 3; ++i) {
    const int id = tid + 512 * i, r = id / 24, pc = id - r * 24;
    const int ch = (pc & ~7) | ((pc & 7) ^ ((r >> 1) & 7));
    kso[i] = (unsigned)(r * 3072 + ch * 16);
  }
#pragma unroll
  for (int i = 0; i < 2; ++i) {
    const int id = tid + 512 * i, dd = id >> 3, pc = id & 7;
    const int ch = pc ^ ((dd >> 1) & 7);
    vso[i] = (unsigned)(dd * Lk * 2 + ch * 16);
  }
  const unsigned ldst = (unsigned)(tid >> 6) * 1024u;
#define ATT_STAGE(kt_, s_)                                                                                      \
  {                                                                                                            \
    const int k0_ = (kt_) * 64;                                                                                \
    const int rowbase_ = kind ? (k0_ < 4096 ? TP + seq * 4096 + k0_ : T + seq * 256 + (k0_ - 4096)) : seq * 256 + k0_; \
    const char* kg_ = (const char*)(Kb + ((size_t)rowbase_ * 8 + h) * 192);                                     \
    const char* vg_ = (const char*)(vbase + k0_);                                                              \
    _Pragma("unroll") for (int i_ = 0; i_ < 3; ++i_)                                                           \
      __builtin_amdgcn_global_load_lds((const unsigned*)(kg_ + kso[i_]), (LAS unsigned*)(lds + (s_) * 40960 + ldst + i_ * 8192), 16, 0, 0); \
    _Pragma("unroll") for (int i_ = 0; i_ < 2; ++i_)                                                           \
      __builtin_amdgcn_global_load_lds((const unsigned*)(vg_ + vso[i_]), (LAS unsigned*)(lds + (s_) * 40960 + 24576 + ldst + i_ * 8192), 16, 0, 0); \
  }
  __syncthreads();
  ATT_STAGE(0, 0)
  asm volatile("s_waitcnt vmcnt(0)" ::: "memory");
  __syncthreads();
  for (int kt = 0; kt < nkt; ++kt) {
    const bool more = kt + 1 < nkt;
    if (more) ATT_STAGE(kt + 1, (kt + 1) & 1)
    const char* Ks = smem + (kt & 1) * 40960;
    const char* Vs = Ks + 24576;
    f32x16 s2[2];
    __builtin_amdgcn_s_setprio(1);
#pragma unroll
    for (int st = 0; st < 2; ++st) {
#pragma unroll
      for (int r = 0; r < 16; ++r) s2[st][r] = 0.f;
#pragma unroll
      for (int ks = 0; ks < 12; ++ks) {
        const bf16x8 kf = *(const bf16x8*)(Ks + ko[ks & 3] + st * 12288 + (ks >> 2) * 128);
        s2[st] = __builtin_amdgcn_mfma_f32_32x32x16_bf16(kf, qf[ks], s2[st], 0, 0, 0);
      }
    }
    __builtin_amdgcn_s_setprio(0);
    {
      float pmax = s2[0][0];
#pragma unroll
      for (int r = 1; r < 16; ++r) pmax = fmaxf(pmax, s2[0][r]);
#pragma unroll
      for (int r = 0; r < 16; ++r) pmax = fmaxf(pmax, s2[1][r]);
      { auto rr = __builtin_amdgcn_permlane32_swap(__float_as_uint(pmax), __float_as_uint(pmax), false, false);
        pmax = fmaxf(__uint_as_float(rr[0]), __uint_as_float(rr[1])); }
      if (!__all(pmax - mrun <= 11.541560327f)) {
        const float mn = fmaxf(mrun, pmax);
        const float alpha = __builtin_amdgcn_exp2f(mrun - mn);
        mrun = mn;
        lrun *= alpha;
#pragma unroll
        for (int a = 0; a < 4; ++a)
#pragma unroll
          for (int r = 0; r < 16; ++r) oacc[a][r] *= alpha;
      }
      float psum = 0.f;
#pragma unroll
      for (int st = 0; st < 2; ++st)
#pragma unroll
        for (int r = 0; r < 16; ++r) { const float pv = __builtin_amdgcn_exp2f(s2[st][r] - mrun); s2[st][r] = pv; psum += pv; }
      lrun += psum;
    }
    __builtin_amdgcn_s_setprio(1);
#pragma unroll
    for (int st = 0; st < 2; ++st)
#pragma unroll
      for (int sb = 0; sb < 2; ++sb) {
        union { bf16x8 v; unsigned w[4]; } pb;
#pragma unroll
        for (int w = 0; w < 4; ++w) pb.w[w] = pack2(s2[st][8 * sb + 2 * w], s2[st][8 * sb + 2 * w + 1]);
#pragma unroll
        for (int dt = 0; dt < 4; ++dt) {
          const bf16x8 vf = *(const bf16x8*)(Vs + vob[2 * st + sb] + dt * 4096);
          oacc[dt] = __builtin_amdgcn_mfma_f32_32x32x16_bf16(vf, pb.v, oacc[dt], 0, 0, 0);
        }
      }
    __builtin_amdgcn_s_setprio(0);
    asm volatile("s_waitcnt vmcnt(0)" ::: "memory");
    __syncthreads();
  }
#undef ATT_STAGE
  float ltot;
  { auto rr = __builtin_amdgcn_permlane32_swap(__float_as_uint(lrun), __float_as_uint(lrun), false, false); ltot = __uint_as_float(rr[0]) + __uint_as_float(rr[1]); }
  const float inv = 1.f / ltot;
#pragma unroll
  for (int dt = 0; dt < 4; ++dt)
#pragma unroll
    for (int g = 0; g < 4; ++g) {
      const int d = dt * 32 + 8 * g + 4 * hh;
      *(uint2*)(O + (size_t)tq * 1024 + h * 128 + d) =
          pack4(oacc[dt][4 * g] * inv, oacc[dt][4 * g + 1] * inv, oacc[dt][4 * g + 2] * inv, oacc[dt][4 * g + 3] * inv);
    }
}
DI void phase_attention(const PV& p, char* smem) {
  const bool xmap = gridDim.x == 256;
  const int Gq = opaque_i((int)gridDim.x);
  const int nit = xmap ? 5 : (1280 + Gq - 1) / Gq;
#pragma unroll 1
  for (int r = 0; r < nit; ++r) {
    int kind, seq, h, q0;
    if (xmap) {
      if (r < 4) {
        const int xcd = blockIdx.x & 7, slot = blockIdx.x >> 3;
        const int pair = xcd + 8 * (2 * r + (slot >> 4)), qb = slot & 15;
        kind = 1; seq = pair >> 3; h = pair & 7; q0 = TP + seq * 4096 + qb * 256;
      } else {
        kind = 0; seq = blockIdx.x >> 3; h = blockIdx.x & 7; q0 = seq * 256;
      }
    } else {
      const int it = blockIdx.x + r * gridDim.x;
      if (it >= 1280) break;
      if (it < 1024) { const int pair = it >> 4, qb = it & 15; kind = 1; seq = pair >> 3; h = pair & 7; q0 = TP + seq * 4096 + qb * 256; }
      else { const int i2 = it - 1024; kind = 0; seq = i2 >> 3; h = i2 & 7; q0 = seq * 256; }
    }
    attn_item(p, kind, seq, h, q0, smem);
  }
  __syncthreads();
}

DI size_t act_blk(int t, int a) { return (size_t)(t >> 8) * (256 * 2816) + (size_t)(a >> 6) * (256 * 64) + (size_t)((t & 255) * 64 + (a & 63)); }
DI float dpp_ror1(float x) { return __int_as_float(__builtin_amdgcn_update_dpp(0, __float_as_int(x), 0x121, 0xf, 0xf, false)); }
DI float dpp_ror15(float x) { return __int_as_float(__builtin_amdgcn_update_dpp(0, __float_as_int(x), 0x12F, 0xf, 0xf, false)); }
struct EpiFFN {
  u16* ACT; u16* EDGE; const float* cw; const float* cb;
  DI void operator()(const f32x4 (&acc)[2][2][4][2], int pm, int pn, int wr, int wc, int fr, int fq) const {
#pragma unroll
    for (int n = 0; n < 2; ++n) {
      const int a = pn * 128 + wc * 32 + n * 16 + fq * 4;
      const float4 w0g = *(const float4*)(cw + a), w1g = *(const float4*)(cw + 5632 + a), w2g = *(const float4*)(cw + 11264 + a), bg = *(const float4*)(cb + a);
      const float4 w0u = *(const float4*)(cw + 2816 + a), w1u = *(const float4*)(cw + 5632 + 2816 + a), w2u = *(const float4*)(cw + 11264 + 2816 + a), bu = *(const float4*)(cb + 2816 + a);
#pragma unroll
      for (int ai = 0; ai < 2; ++ai) {
        const int rbase = pm * 256 + ai * 128 + wr * 64;
        const size_t erow = (size_t)(rbase >> 6) * 4;
#pragma unroll
        for (int m = 0; m < 4; ++m) {
          const int mp = m > 0 ? m - 1 : 0, mn = m < 3 ? m + 1 : 3;
          float o[4];
#define FFN_ONE(J, C)                                                                                         \
          {                                                                                                   \
            const float g = acc[ai][0][m][n][J], u = acc[ai][1][m][n][J];                                     \
            const float gpv = m > 0 ? acc[ai][0][mp][n][J] : 0.f, gnx = m < 3 ? acc[ai][0][mn][n][J] : 0.f;   \
            const float upv = m > 0 ? acc[ai][1][mp][n][J] : 0.f, unx = m < 3 ? acc[ai][1][mn][n][J] : 0.f;   \
            const float gp = dpp_ror1(fr == 15 ? gpv : g), gn = dpp_ror15(fr == 0 ? gnx : g);                \
            const float up = dpp_ror1(fr == 15 ? upv : u), un = dpp_ror15(fr == 0 ? unx : u);                \
            const float cg = w0g.C * gp + w1g.C * g + w2g.C * gn + bg.C;                                      \
            const float cu = w0u.C * up + w1u.C * u + w2u.C * un + bu.C;                                      \
            o[J] = silu(cg) * cu;                                                                             \
          }
          FFN_ONE(0, x) FFN_ONE(1, y) FFN_ONE(2, z) FFN_ONE(3, w)
#undef FFN_ONE
          *(uint2*)(ACT + act_blk(rbase + m * 16 + fr, a)) = pack4(o[0], o[1], o[2], o[3]);
          if ((m == 0 && fr < 2) || (m == 3 && fr >= 14)) {
            const int ri = m == 0 ? fr : fr - 12;
            u16* e = EDGE + (erow + ri) * 5632 + pn * 256 + wc * 32 + n * 16 + fq * 4;
            *(uint2*)e = pack4(acc[ai][0][m][n][0], acc[ai][0][m][n][1], acc[ai][0][m][n][2], acc[ai][0][m][n][3]);
            *(uint2*)(e + 128) = pack4(acc[ai][1][m][n][0], acc[ai][1][m][n][1], acc[ai][1][m][n][2], acc[ai][1][m][n][3]);
          }
        }
      }
    }
  }
};
DI void phase_ffn_up(const PV& p, int l, char* smem) {
  EpiFFN E;
  E.ACT = (u16*)(p.ws() + OFF_B + B_ACT); E.EDGE = (u16*)(p.ws() + OFF_EDGE);
  E.cw = p.in(33) + (size_t)l * 3 * 5632; E.cb = p.in(34) + (size_t)l * 5632;
  TileSched<160, 22, 16, 8, 4, 16, 2> S; S.init();
  gemm8(smem, (const u16*)(p.ws() + OFF_A + A_H), (const u16*)(p.ws() + OFF_WUP), 1024, S, E);
}
DI void phase_ffn_fix(const PV& p, int l) {
  const u16* EDGE = (const u16*)(p.ws() + OFF_EDGE);
  u16* ACT = (u16*)(p.ws() + OFF_B + B_ACT);
  const float* cw = p.in(33) + (size_t)l * 3 * 5632;
  const float* cb = p.in(34) + (size_t)l * 5632;
  const long gtid = (long)blockIdx.x * blockDim.x + TIDX(), gsz = (long)gridDim.x * blockDim.x;
  for (long idx = gtid; idx < (long)640 * 2 * 2816; idx += gsz) {
    const int a = (int)(idx % 2816), rr = (int)(idx / 2816), which = rr & 1, sidx = rr >> 1;
    const int t = sidx * 64 + (which ? 63 : 0);
    const int tb = which ? t + 1 : t;
    const bool seqb = tb < TP ? (tb & 255) == 0 : ((tb - TP) & 4095) == 0;
    if (seqb) continue;
    const int pc = (a >> 7) * 256 + (a & 127);
    const u16 *pr, *cu, *nx;
    if (which == 0) { pr = EDGE + ((size_t)(sidx - 1) * 4 + 3) * 5632; cu = EDGE + ((size_t)sidx * 4 + 0) * 5632; nx = EDGE + ((size_t)sidx * 4 + 1) * 5632; }
    else { pr = EDGE + ((size_t)sidx * 4 + 2) * 5632; cu = EDGE + ((size_t)sidx * 4 + 3) * 5632; nx = EDGE + ((size_t)(sidx + 1) * 4 + 0) * 5632; }
    const float g = cw[a] * bf2f(pr[pc]) + cw[5632 + a] * bf2f(cu[pc]) + cw[11264 + a] * bf2f(nx[pc]) + cb[a];
    const float uu = cw[2816 + a] * bf2f(pr[pc + 128]) + cw[5632 + 2816 + a] * bf2f(cu[pc + 128]) + cw[11264 + 2816 + a] * bf2f(nx[pc + 128]) + cb[2816 + a];
    ACT[act_blk(t, a)] = f2bf(silu(g) * uu);
  }
}

#ifndef PH
#define RUN(k, ...) __VA_ARGS__
#else
#define RUN(k, ...) if (PH == k) { __VA_ARGS__ }
#endif
extern "C" __global__ void __launch_bounds__(512) fwd_megakernel(Params kp) {
  extern __shared__ __attribute__((aligned(16))) char smem[];
  cg::grid_group grid = cg::this_grid();
  if (TIDX() == 0) {
    unsigned long long* t = (unsigned long long*)(smem + PARM_OFF);
#pragma unroll
    for (int k = 0; k < 36; ++k) t[k] = (unsigned long long)kp.in[k];
    t[36] = (unsigned long long)kp.out; t[37] = (unsigned long long)kp.ws;
  }
  __syncthreads();
  PV p; p.smem = smem;
  unsigned* bar = (unsigned*)(p.ws() + OFF_BAR);
  if (TIDX() == 0) { *(unsigned*)(smem + PARM_OFF + 512) = 0u; *(unsigned*)(smem + PARM_OFF + 516) = 0u; }
  __syncthreads();
  const XcdBarrier xb = xcd_barrier_post(bar, (volatile LASB unsigned*)(smem + PARM_OFF + 512));
  RUN(0, phase_prep(p, smem);)
  grid.sync();
  RUN(1, phase_filters(p, smem);)
  for (int l = 0; l < 4; ++l) {
    const int i = l >> 1;
    RUN(2, phase_norm(p, l, 0, l);)
    RUN(0, if (l > 0) { int base = 0; convert_ffn_weights(p, l, smem, base); })
    xcd_barrier(xb);
    if ((l & 1) == 0) {
      RUN(3, phase_mix_in(p, i, smem);)
      xcd_barrier(xb);
      RUN(4, phase_sgu(p, i, smem);)
      RUN(5, phase_conv(p, i, 0, smem);)
      xcd_barrier(xb);
      RUN(5, phase_conv(p, i, 1, smem);)
      xcd_barrier(xb);
      RUN(6, phase_ztrans(p, smem);)
      xcd_barrier(xb);
      RUN(7, phase_resid_gemm(p, l, l, (const u16*)(p.ws() + OFF_B + B_MIX), 1024, (const u16*)(p.ws() + OFF_WMIXOUT) + (size_t)i * 1024 * 1024, 2048, smem);)
      xcd_barrier(xb);
    } else {
      RUN(8, phase_dqkv(p, i, smem);)
      xcd_barrier(xb);
      RUN(9, phase_mla_norms(p, i);)
      xcd_barrier(xb);
      RUN(10, phase_uq_ukv(p, i, smem);)
      xcd_barrier(xb);
      RUN(11, phase_finalize(p, i);)
      xcd_barrier(xb);
      RUN(12, phase_attention(p, smem);)
      xcd_barrier(xb);
      RUN(7, phase_resid_gemm(p, l, l, (const u16*)(p.ws() + OFF_A + A_O), 1024, (const u16*)(p.ws() + OFF_WO) + (size_t)i * 1024 * 1024, 2048, smem);)
      xcd_barrier(xb);
    }
    RUN(2, phase_norm(p, l, 1, 1);)
    xcd_barrier(xb);
    RUN(13, phase_ffn_up(p, l, smem);)
    xcd_barrier(xb);
    RUN(14, phase_ffn_fix(p, l);)
    xcd_barrier(xb);
    RUN(7, phase_resid_gemm(p, l, 1, (const u16*)(p.ws() + OFF_B + B_ACT), 2816, (const u16*)(p.ws() + OFF_WDOWN), 5120, smem);)
    xcd_barrier(xb);
  }
}

extern "C" void kernel_launch(void* const* d_in, const int* in_sizes, int n_in,
                              void* d_out, int out_size, void* d_ws, size_t ws_size,
                              hipStream_t stream) {
  static int grid_blocks = 0;
  if (!grid_blocks) {
    int dev = 0, cus = 0, per_cu = 0;
    (void)hipGetDevice(&dev);
    (void)hipDeviceGetAttribute(&cus, hipDeviceAttributeMultiprocessorCount, dev);
    (void)hipFuncSetAttribute((const void*)fwd_megakernel, hipFuncAttributeMaxDynamicSharedMemorySize, (int)LDS_BYTES);
    (void)hipOccupancyMaxActiveBlocksPerMultiprocessor(&per_cu, fwd_megakernel, 512, LDS_BYTES);
    if (per_cu < 1) per_cu = 1;
    if (per_cu > 1) per_cu = 1;
    grid_blocks = cus * per_cu;
  }
  if (ws_size < WS_NEED) fprintf(stderr, "workspace too small: %zu < %zu\n", ws_size, (size_t)WS_NEED);
  Params p{};
  for (int i = 0; i < 36; ++i) p.in[i] = (const float*)d_in[i];
  p.out = (float*)d_out;
  p.ws = (char*)d_ws;
  (void)hipMemsetAsync((char*)d_ws + OFF_BAR, 0, 16384, stream);
  void* args[] = {&p};
  hipError_t e = hipLaunchCooperativeKernel((void*)fwd_megakernel, dim3(grid_blocks), dim3(512), args, LDS_BYTES, stream);
  if (e != hipSuccess) fprintf(stderr, "cooperative launch failed: %s (grid %d)\n", hipGetErrorString(e), grid_blocks);
}
```

```cpp
#include <hip/hip_runtime.h>
#include <hip/hip_cooperative_groups.h>
#include <cstdio>
namespace cg = cooperative_groups;

typedef unsigned short u16;
using bf16x8 = __attribute__((ext_vector_type(8))) short;
using f32x4 = __attribute__((ext_vector_type(4))) float;
using f32x16 = __attribute__((ext_vector_type(16))) float;
#define DI __device__ __forceinline__

constexpr int T = 40960;
constexpr int TP = 8192;
constexpr int TK = 43008;
constexpr float EPS = 1e-6f;
constexpr size_t LDS_BYTES = 139264;

constexpr size_t OFF_WMIXIN = 0;
constexpr size_t OFF_WMIXOUT = OFF_WMIXIN + (size_t)2 * 2560 * 1024 * 2;
constexpr size_t OFF_WDQKV = OFF_WMIXOUT + (size_t)2 * 1024 * 1024 * 2;
constexpr size_t OFF_WUQ = OFF_WDQKV + (size_t)2 * 1024 * 1024 * 2;
constexpr size_t OFF_WUKV = OFF_WUQ + (size_t)2 * 1536 * 512 * 2;
constexpr size_t OFF_WO = OFF_WUKV + (size_t)2 * 2048 * 256 * 2;
constexpr size_t OFF_WSGU = OFF_WO + (size_t)2 * 1024 * 1024 * 2;
constexpr size_t OFF_WUP = OFF_WSGU + (size_t)2 * 4 * 128 * 128 * 2;
constexpr size_t OFF_WDOWN = OFF_WUP + (size_t)5632 * 1024 * 2;
constexpr size_t OFF_MOD = OFF_WDOWN + (size_t)1024 * 2816 * 2;
constexpr size_t OFF_FILT = OFF_MOD + (size_t)4 * 9 * 6144 * 4;
constexpr size_t OFF_H2 = OFF_FILT + (size_t)2 * 2 * 512 * 4352 * 2;
constexpr size_t OFF_EDGE = OFF_H2 + (size_t)2 * 4352 * 64 * 4;
constexpr size_t OFF_KR = OFF_EDGE + (size_t)640 * 4 * 5632 * 2;
constexpr size_t OFF_A = OFF_KR + (size_t)TK * 64 * 2;
constexpr size_t OFF_B = OFF_A + (size_t)T * 1024 * 2;
constexpr size_t OFF_BAR = OFF_B + (size_t)346030080;
constexpr size_t OFF_ROPE = OFF_BAR + 16384;
constexpr size_t WS_NEED = OFF_ROPE + 64 * 16 * 8;
constexpr size_t A_H = 0, A_Z1 = 0, A_Z2 = (size_t)T * 512 * 2, A_QN = 0, A_CKV = (size_t)T * 512 * 2, A_O = 0;
constexpr size_t B_VT = 0, B_PRT = (size_t)T * 512 * 2, B_MIX = B_PRT + (size_t)T * 1536 * 2;
constexpr size_t B_DQKV = 0, B_Q = 0, B_K = (size_t)T * 1536 * 2, B_V = B_K + (size_t)TK * 1536 * 2;
constexpr size_t B_ACT = 0;
constexpr size_t VT_SAMPLE_OFF = (size_t)32 * 8 * 128 * 256;

struct Params {
  const float* in[36];
  float* out;
  char* ws;
};


constexpr int PARM_OFF = 138240;
struct PV {
  char* smem;
  DI unsigned long long ld(int k) const {
    int off = PARM_OFF + 8 * k;
    asm volatile("" : "+v"(off));
    const unsigned long long v = *(const unsigned long long*)(smem + off);
    const unsigned lo = __builtin_amdgcn_readfirstlane((unsigned)v), hi = __builtin_amdgcn_readfirstlane((unsigned)(v >> 32));
    return ((unsigned long long)hi << 32) | lo;
  }
  DI const float* in(int k) const { return (const float*)(const __attribute__((address_space(1))) float*)ld(k); }
  DI float* out() const { return (float*)(__attribute__((address_space(1))) float*)ld(36); }
  DI char* ws() const { return (char*)(__attribute__((address_space(1))) char*)ld(37); }
};

DI int TIDX() { int t = (int)__builtin_amdgcn_workitem_id_x(); asm volatile("" : "+v"(t)); return t; }
DI u16 f2bf(float x) { unsigned u = __float_as_uint(x); u += 0x7fffu + ((u >> 16) & 1u); return (u16)(u >> 16); }
DI float bf2f(u16 h) { return __uint_as_float(((unsigned)h) << 16); }
DI unsigned pack2(float a, float b) { unsigned r; asm("v_cvt_pk_bf16_f32 %0, %1, %2" : "=v"(r) : "v"(a), "v"(b)); return r; }
DI uint2 pack4(float a, float b, float c, float d) { uint2 r; r.x = pack2(a, b); r.y = pack2(c, d); return r; }
DI float lo16(unsigned w) { return __uint_as_float(w << 16); }
DI float hi16(unsigned w) { return __uint_as_float(w & 0xffff0000u); }
DI float gelu_tanh(float x) { const float y = x * (1.f + 0.044715f * x * x); return x * __builtin_amdgcn_rcpf(1.f + __builtin_amdgcn_exp2f(-2.302208198f * y)); }
DI float silu(float x) { return x * __builtin_amdgcn_rcpf(1.f + __builtin_amdgcn_exp2f(-1.4426950409f * x)); }
DI int condrow(int m) { return m < TP ? 0 : 1 + ((m - TP) >> 12); }
template <int MASK> DI float shx(float v, int lane) {
  if (MASK == 32) return __int_as_float(__builtin_amdgcn_ds_bpermute((lane ^ 32) << 2, __float_as_int(v)));
  return __int_as_float(__builtin_amdgcn_ds_swizzle(__float_as_int(v), (MASK << 10) | 0x1f));
}
DI float wave_sum(float v, int lane) {
  v += shx<32>(v, lane); v += shx<16>(v, lane); v += shx<8>(v, lane);
  v += shx<4>(v, lane); v += shx<2>(v, lane); v += shx<1>(v, lane); return v;
}
DI int opaque_i(int x) { asm volatile("" : "+s"(x)); return x; }
DI int first_unit(int base) { const int G = opaque_i((int)gridDim.x); int r = (int)blockIdx.x - (base % G); if (r < 0) r += G; return r; }
DI const float* xin_row(const PV& p, int l, int m) {
  if (l == 0) return m < TP ? p.in(0) + (size_t)m * 1024 : p.in(1) + (size_t)(m - TP) * 1024;
  return p.out() + (size_t)m * 1024;
}


#define XB_TMO      128
#define XB_XCNT(j)  (256  + 64 * (j))
#define XB_XSUB(j)  (1280 + 64 * (j))
#define XB_XGEN(j)  (2304 + 64 * (j))
#define XB_TOP      3328
#define XB_TOPGEN   3392
#define XB_SPIN_CAP (1u << 22)
#define LASB __attribute__((address_space(3)))
DI unsigned xb_ld(unsigned* p) { return __hip_atomic_load(p, __ATOMIC_RELAXED, __HIP_MEMORY_SCOPE_AGENT); }
DI unsigned xb_add(unsigned* p, unsigned v) { return __hip_atomic_fetch_add(p, v, __ATOMIC_RELAXED, __HIP_MEMORY_SCOPE_AGENT); }
DI unsigned xb_xcc_id() { return (unsigned)__builtin_amdgcn_s_getreg((3 << 11) | 20) & 0xFu; }
#define XB_SPIN(cond, bar) do { unsigned _sp = 0; while (cond) { __builtin_amdgcn_s_sleep(1); \
    if ((++_sp & 255u) == 0u) { if (xb_ld(&(bar)[XB_TMO])) break; if (_sp > XB_SPIN_CAP) { atomicAdd(&(bar)[XB_TMO], 1u); break; } } } } while (0)
struct XcdBarrier { unsigned* bar; unsigned x; volatile LASB unsigned* st; };
DI XcdBarrier xcd_barrier_post(unsigned* bar, volatile LASB unsigned* st) {
  XcdBarrier b; b.bar = bar; b.x = xb_xcc_id(); b.st = st;
  if (TIDX() == 0) (void)xb_add(&bar[XB_XCNT(b.x)], 1u);
  return b;
}
DI void xcd_barrier_complete(unsigned* bar, unsigned x, unsigned& nloc, unsigned& nx) {
  const unsigned G = gridDim.x;
  unsigned sum, cnt, mine, sp = 0u;
  for (;;) {
    sum = 0u; cnt = 0u; mine = 0u;
#pragma unroll
    for (unsigned j = 0; j < 16; ++j) { const unsigned c = xb_ld(&bar[XB_XCNT(j)]); sum += c; cnt += (c > 0u) ? 1u : 0u; mine = (j == x) ? c : mine; }
    if (sum == G) break;
    __builtin_amdgcn_s_sleep(1);
    if ((++sp & 255u) == 0u) { if (xb_ld(&bar[XB_TMO])) break; if (sp > XB_SPIN_CAP) { atomicAdd(&bar[XB_TMO], 1u); break; } }
  }
  nloc = mine > 0u ? mine : 1u; nx = cnt > 0u ? cnt : 1u;
}
DI void xcd_barrier(const XcdBarrier& b) {
  asm volatile("s_waitcnt vmcnt(0)" ::: "memory");
  __syncthreads();
  if (TIDX() == 0) {
    unsigned* bar = b.bar;
    __builtin_amdgcn_s_waitcnt(0);
    unsigned nloc = b.st[0], nx = b.st[1];
    if (nloc == 0u) { xcd_barrier_complete(bar, b.x, nloc, nx); b.st[0] = nloc; b.st[1] = nx; }
    const unsigned old = xb_add(&bar[XB_XSUB(b.x)], 1u);
    const unsigned gen = old / nloc;
    if (old + 1u == (gen + 1u) * nloc) {
      __builtin_amdgcn_fence(__ATOMIC_RELEASE, "agent");
      asm volatile("s_waitcnt vmcnt(0)" ::: "memory");
      const unsigned og = xb_add(&bar[XB_TOP], 1u);
      const unsigned tg = og / nx;
      if (og + 1u == (tg + 1u) * nx) xb_add(&bar[XB_TOPGEN], 1u);
      else XB_SPIN(xb_ld(&bar[XB_TOPGEN]) == tg, bar);
      __builtin_amdgcn_fence(__ATOMIC_ACQUIRE, "agent");
      xb_add(&bar[XB_XGEN(b.x)], 1u);
      asm volatile("s_waitcnt vmcnt(0)" ::: "memory");
    } else {
      XB_SPIN(xb_ld(&bar[XB_XGEN(b.x)]) == gen, bar);
      __builtin_amdgcn_fence(__ATOMIC_ACQUIRE, "agent");
      asm volatile("s_waitcnt vmcnt(0)" ::: "memory");
    }
  }
  __syncthreads();
}

template <int MODE>
DI int rowmap(int n, int row0) {
  if (MODE == 0) return n + row0;
  return n < 2816 ? (n >> 7) * 256 + (n & 127) : ((n - 2816) >> 7) * 256 + 128 + ((n - 2816) & 127);
}
template <int MODE, int NJ = 4>
DI void convT(const float* __restrict__ src, u16* __restrict__ dst, int K, int N, int row0, char* smem, int& base) {
  u16* tl = (u16*)smem;
  const int tid = TIDX();
  const int nN = N / (64 * NJ), nunits = (K >> 6) * nN;
  for (int u = first_unit(base); u < nunits; u += gridDim.x) {
    const int k0 = (u / nN) << 6, n0 = (u % nN) * (64 * NJ);
    float4 v[2][NJ];
#pragma unroll
    for (int i = 0; i < 2; ++i)
#pragma unroll
      for (int j = 0; j < NJ; ++j)
        v[i][j] = *(const float4*)(src + (size_t)(k0 + (tid >> 4) + 32 * i) * N + n0 + (tid & 15) * 4 + 64 * j);
#pragma unroll
    for (int i = 0; i < 2; ++i)
#pragma unroll
      for (int j = 0; j < NJ; ++j) {
        const int r = (tid >> 4) + 32 * i, c4 = (tid & 15) * 4 + 64 * j;
        tl[(c4 + 0) * 72 + r] = f2bf(v[i][j].x); tl[(c4 + 1) * 72 + r] = f2bf(v[i][j].y);
        tl[(c4 + 2) * 72 + r] = f2bf(v[i][j].z); tl[(c4 + 3) * 72 + r] = f2bf(v[i][j].w);
      }
    __syncthreads();
#pragma unroll
    for (int j = 0; j < NJ; ++j) {
      const int n = (tid >> 3) + 64 * j, kc = (tid & 7) * 8;
      const uint4 o = *(const uint4*)(tl + n * 72 + kc);
      *(uint4*)(dst + (size_t)rowmap<MODE>(n0 + n, row0) * K + k0 + kc) = o;
    }
    __syncthreads();
  }
  base += nunits;
}

DI void convert_ffn_weights(const PV& p, int l, char* smem, int& base) {
  convT<1>(p.in(32) + (size_t)l * 1024 * 5632, (u16*)(p.ws() + OFF_WUP), 1024, 5632, 0, smem, base);
  convT<0>(p.in(35) + (size_t)l * 2816 * 1024, (u16*)(p.ws() + OFF_WDOWN), 2816, 1024, 0, smem, base);
}

DI void phase_prep(const PV& p, char* smem) {
  const int tid = TIDX();
  int base = 0;
  char* ws = p.ws();
  for (int i = 0; i < 2; ++i) {
    convT<0>(p.in(9) + (size_t)i * 1024 * 2560, (u16*)(ws + OFF_WMIXIN) + (size_t)i * 2560 * 1024, 1024, 2560, 0, smem, base);
    convT<0>(p.in(22) + (size_t)i * 1024 * 1024, (u16*)(ws + OFF_WMIXOUT) + (size_t)i * 1024 * 1024, 1024, 1024, 0, smem, base);
    convT<0>(p.in(23) + (size_t)i * 1024 * 512, (u16*)(ws + OFF_WDQKV) + (size_t)i * 1024 * 1024, 1024, 512, 0, smem, base);
    convT<0, 1>(p.in(26) + (size_t)i * 1024 * 320, (u16*)(ws + OFF_WDQKV) + (size_t)i * 1024 * 1024, 1024, 320, 512, smem, base);
    convT<0>(p.in(25) + (size_t)i * 512 * 1536, (u16*)(ws + OFF_WUQ) + (size_t)i * 1536 * 512, 512, 1536, 0, smem, base);
    convT<0>(p.in(28) + (size_t)i * 256 * 2048, (u16*)(ws + OFF_WUKV) + (size_t)i * 2048 * 256, 256, 2048, 0, smem, base);
    convT<0>(p.in(31) + (size_t)i * 1024 * 1024, (u16*)(ws + OFF_WO) + (size_t)i * 1024 * 1024, 1024, 1024, 0, smem, base);
  }
  convert_ffn_weights(p, 0, smem, base);
  {
    const long gtid = (long)blockIdx.x * blockDim.x + tid, gsz = (long)gridDim.x * blockDim.x;
    for (long i = gtid; i < 2 * 192 * 1024; i += gsz) {
      const int j = (int)(i / (192 * 1024)), r = (int)(i % (192 * 1024));
      ((u16*)(ws + OFF_WDQKV))[(size_t)j * 1024 * 1024 + (size_t)832 * 1024 + r] = 0;
    }
    for (long i = gtid; i < 2 * 4 * 128 * 128; i += gsz) ((u16*)(ws + OFF_WSGU))[i] = f2bf(p.in(10)[i]);
    for (long i = gtid; i < 64 * 16; i += gsz) {
      const int pos = (int)(i >> 4), f = (int)(i & 15);
      const float inv = exp2f(-(float)f * (13.287712379549449f / 16.f));
      float sn, cs;
      sincosf((float)pos * inv, &sn, &cs);
      ((float2*)(ws + OFF_ROPE))[i] = make_float2(cs, sn);
    }
  }
  {
    float* sc = (float*)smem;
    float* part = sc + 9 * 1024;
    __syncthreads();
    for (int i = tid; i < 9 * 1024; i += 512) {
      const int r = i >> 10, k = i & 1023;
      const float c = r == 0 ? p.in(5)[k] : p.in(4)[(r - 1) * 1024 + k];
      sc[i] = silu(c);
    }
    __syncthreads();
    float* MOD = (float*)(ws + OFF_MOD);
    const int nunits = 4 * 96;
    for (int u = first_unit(base); u < nunits; u += gridDim.x) {
      const int l = u / 96, n0 = (u % 96) * 64;
      const int col = n0 + (tid & 63), kg = tid >> 6;
      float acc[9];
#pragma unroll
      for (int r = 0; r < 9; ++r) acc[r] = 0.f;
      const float* w = p.in(6) + (size_t)l * 1024 * 6144 + col;
#pragma unroll 16
      for (int k = kg * 128; k < kg * 128 + 128; ++k) {
        const float wv = w[(size_t)k * 6144];
#pragma unroll
        for (int r = 0; r < 9; ++r) acc[r] += sc[r * 1024 + k] * wv;
      }
#pragma unroll
      for (int r = 0; r < 9; ++r) part[(kg * 9 + r) * 64 + (tid & 63)] = acc[r];
      __syncthreads();
      for (int i = tid; i < 576; i += 512) {
        const int r = i >> 6, cc = i & 63;
        float s = p.in(7)[l * 6144 + n0 + cc];
#pragma unroll
        for (int g = 0; g < 8; ++g) s += part[(g * 9 + r) * 64 + cc];
        MOD[(size_t)(l * 9 + r) * 6144 + n0 + cc] = s;
      }
      __syncthreads();
    }
    base += nunits;
  }
  {
    float* zf = (float*)smem;
    float* h1 = zf + 8 * 36;
    float* H2 = (float*)(ws + OFF_H2);
    const int nunits = 2 * 544;
    for (int u = first_unit(base); u < nunits; u += gridDim.x) {
      const int i = u / 544, tg0 = (u % 544) * 8;
      __syncthreads();
      if (tid < 8 * 33) {
        const int tt = tid / 33, e = tid % 33;
        const int tg = tg0 + tt;
        const float L = tg < 256 ? 256.f : 4096.f;
        const float t = tg < 256 ? (float)tg : (float)(tg - 256);
        const float tn = t / L;
        float v;
        if (e == 0) v = tn;
        else if (e <= 16) v = sinf((6.283185307179586f * tn) * (float)e);
        else v = cosf((6.283185307179586f * tn) * (float)(e - 16));
        zf[tt * 36 + e] = v;
      }
      __syncthreads();
      const int tt = tid >> 6, jj = tid & 63;
      const float fr = p.in(19)[i * 64 + jj];
      {
        float a = p.in(15)[i * 64 + jj];
        const float* w1 = p.in(14) + (size_t)i * 33 * 64 + jj;
        for (int e = 0; e < 33; ++e) a += zf[tt * 36 + e] * w1[e * 64];
        h1[tt * 64 + jj] = sinf(fr * a);
      }
      __syncthreads();
      {
        float a = p.in(17)[i * 64 + jj];
        const float* w2 = p.in(16) + (size_t)i * 64 * 64 + jj;
        for (int e = 0; e < 64; ++e) a += h1[tt * 64 + e] * w2[e * 64];
        H2[((size_t)i * 4352 + tg0 + tt) * 64 + jj] = sinf(fr * a);
      }
    }
    base += nunits;
    __syncthreads();
  }
}

DI void phase_filters(const PV& p, char* smem) {
  const int tid = TIDX();
  float* w3s = (float*)smem;
  float* red = w3s + 512;
  float* nrm = red + 512;
  float* hbuf = nrm + 8;
  const float* H2 = (const float*)(p.ws() + OFF_H2);
  u16* FILT = (u16*)(p.ws() + OFF_FILT);
  for (int u = blockIdx.x; u < 512; u += gridDim.x) {
    const int kind = (u >> 7) & 1, i = u >> 8, cg8 = (u & 127) * 8;
    const int L = kind ? 4096 : 256, tbase = kind ? 256 : 0;
    __syncthreads();
    { const int j = tid >> 3, cc = tid & 7; w3s[j * 8 + cc] = p.in(18)[((size_t)i * 64 + j) * 1024 + cg8 + cc]; }
    __syncthreads();
    const int cc = tid & 7, tq = tid >> 3;
    const int col = cg8 + cc, o = col >> 9, c = col & 511;
    const float dec = fabsf(p.in(20)[(i * 2 + o) * 512 + c]);
    float asum = 0.f;
    for (int t = tq; t < L; t += 64) {
      const float4* hr = (const float4*)(H2 + ((size_t)i * 4352 + tbase + t) * 64);
      float a = 0.f;
#pragma unroll
      for (int j4 = 0; j4 < 16; ++j4) {
        const float4 hv = hr[j4];
        a += hv.x * w3s[(j4 * 4 + 0) * 8 + cc]; a += hv.y * w3s[(j4 * 4 + 1) * 8 + cc];
        a += hv.z * w3s[(j4 * 4 + 2) * 8 + cc]; a += hv.w * w3s[(j4 * 4 + 3) * 8 + cc];
      }
      const float dist = fabsf((float)(t - L / 2)) / (float)L;
      a *= expf(-dec * dist);
      hbuf[cc * L + t] = a;
      asum += fabsf(a);
    }
    red[tid] = asum;
    __syncthreads();
    if (tid < 8) { float s = 0.f; for (int q = 0; q < 64; ++q) s += red[q * 8 + tid]; nrm[tid] = 1.f / (s + EPS); }
    __syncthreads();
    for (int idx = tid; idx < 8 * L; idx += 512) {
      const int c2 = idx / L, t = idx - c2 * L;
      const int col2 = cg8 + c2, o2 = col2 >> 9, cch = col2 & 511;
      FILT[((size_t)(i * 2 + o2) * 512 + cch) * 4352 + tbase + t] = f2bf(hbuf[c2 * L + t] * nrm[c2]);
    }
  }
  __syncthreads();
}

DI void phase_norm(const PV& p, int l, int part, int lx) {
  const int tid_ = TIDX(); const int lane = tid_ & 63, wid = tid_ >> 6;
  const float* MOD = (const float*)(p.ws() + OFF_MOD);
  const float* g = p.in(8) + (size_t)(l * 2 + part) * 1024;
  u16* H = (u16*)(p.ws() + OFF_A + A_H);
  const int stride = gridDim.x * 8;
  for (int row0 = blockIdx.x * 8 + wid; row0 < T; row0 += 2 * stride) {
    float4 v[2][4];
#pragma unroll
    for (int w = 0; w < 2; ++w) {
      const int row = row0 + w * stride;
      if (row < T) {
        const float* xr = xin_row(p, lx, row);
#pragma unroll
        for (int i = 0; i < 4; ++i) v[w][i] = *(const float4*)(xr + (i * 64 + lane) * 4);
      }
    }
#pragma unroll
    for (int w = 0; w < 2; ++w) {
      const int row = row0 + w * stride;
      if (row < T) {
        float ss = 0.f;
#pragma unroll
        for (int i = 0; i < 4; ++i) ss += v[w][i].x * v[w][i].x + v[w][i].y * v[w][i].y + v[w][i].z * v[w][i].z + v[w][i].w * v[w][i].w;
        ss = wave_sum(ss, lane);
        const float r = rsqrtf(ss * (1.f / 1024.f) + EPS);
        const float* mr = MOD + (size_t)(l * 9 + condrow(row)) * 6144 + part * 3072;
#pragma unroll
        for (int i = 0; i < 4; ++i) {
          const int k = (i * 64 + lane) * 4;
          const float4 gv = *(const float4*)(g + k), sh = *(const float4*)(mr + k), sc = *(const float4*)(mr + 1024 + k);
          const float a = v[w][i].x * r * gv.x * (1.f + sc.x) + sh.x;
          const float b = v[w][i].y * r * gv.y * (1.f + sc.y) + sh.y;
          const float c = v[w][i].z * r * gv.z * (1.f + sc.z) + sh.z;
          const float d = v[w][i].w * r * gv.w * (1.f + sc.w) + sh.w;
          *(uint2*)(H + (size_t)row * 1024 + k) = pack4(a, b, c, d);
        }
      }
    }
  }
}

template <bool SWAP, class Epi, class Pre>
DI void gemm_tile(const u16* A, int lda, const u16* Bt, int ldb, int K, int m0, int n0, char* smem, Epi epi, Pre pre) {
  const int tid = TIDX(), lane = tid & 63, wid = tid >> 6;
  const int wm = wid >> 1, wn = wid & 1, fr = lane & 15, fq = lane >> 4;
  const int lrow = tid >> 3, kc = tid & 7;
  const u16* ga = A + (size_t)(m0 + lrow) * lda + kc * 8;
  const u16* gb = Bt + (size_t)(n0 + lrow) * ldb + kc * 8;
  const int soff = lrow * 128 + ((kc ^ (lrow & 7)) << 4);
  uint4 ra[4], rb[2];
  f32x4 acc[4][4];
#pragma unroll
  for (int i = 0; i < 4; ++i)
#pragma unroll
    for (int j = 0; j < 4; ++j) acc[i][j] = f32x4{0.f, 0.f, 0.f, 0.f};
  const int nk = K >> 6;
#pragma unroll
  for (int i = 0; i < 4; ++i) ra[i] = *(const uint4*)(ga + (size_t)(64 * i) * lda);
#pragma unroll
  for (int i = 0; i < 2; ++i) rb[i] = *(const uint4*)(gb + (size_t)(64 * i) * ldb);
#pragma unroll
  for (int i = 0; i < 4; ++i) *(uint4*)(smem + soff + i * 8192) = ra[i];
#pragma unroll
  for (int i = 0; i < 2; ++i) *(uint4*)(smem + 32768 + soff + i * 8192) = rb[i];
  __syncthreads();
  for (int kt = 0; kt < nk; ++kt) {
    const bool more = kt + 1 < nk;
    if (more) {
      const int k0 = (kt + 1) << 6;
#pragma unroll
      for (int i = 0; i < 4; ++i) ra[i] = *(const uint4*)(ga + (size_t)(64 * i) * lda + k0);
#pragma unroll
      for (int i = 0; i < 2; ++i) rb[i] = *(const uint4*)(gb + (size_t)(64 * i) * ldb + k0);
    }
    const char* sa = smem + (kt & 1) * 49152;
    const char* sb = sa + 32768;
#pragma unroll
    for (int ks = 0; ks < 2; ++ks) {
      bf16x8 af[4], bfv[4];
      const int co = ((ks * 4 + fq) ^ (fr & 7)) << 4;
#pragma unroll
      for (int mi = 0; mi < 4; ++mi) af[mi] = *(const bf16x8*)(sa + (wm * 64 + mi * 16 + fr) * 128 + co);
#pragma unroll
      for (int ni = 0; ni < 4; ++ni) bfv[ni] = *(const bf16x8*)(sb + (wn * 64 + ni * 16 + fr) * 128 + co);
#pragma unroll
      for (int mi = 0; mi < 4; ++mi)
#pragma unroll
        for (int ni = 0; ni < 4; ++ni)
          acc[mi][ni] = SWAP ? __builtin_amdgcn_mfma_f32_16x16x32_bf16(bfv[ni], af[mi], acc[mi][ni], 0, 0, 0)
                             : __builtin_amdgcn_mfma_f32_16x16x32_bf16(af[mi], bfv[ni], acc[mi][ni], 0, 0, 0);
    }
    if (more) {
      char* da = smem + ((kt + 1) & 1) * 49152;
#pragma unroll
      for (int i = 0; i < 4; ++i) *(uint4*)(da + soff + i * 8192) = ra[i];
#pragma unroll
      for (int i = 0; i < 2; ++i) *(uint4*)(da + 32768 + soff + i * 8192) = rb[i];
    }
    __syncthreads();
  }
  uint2 pv[4][4];
#pragma unroll
  for (int mi = 0; mi < 4; ++mi)
#pragma unroll
    for (int ni = 0; ni < 4; ++ni) {
      if (SWAP) pv[mi][ni] = pre(m0 + wm * 64 + mi * 16 + fr, n0 + wn * 64 + ni * 16 + fq * 4);
      else pv[mi][ni] = pre(m0 + wm * 64 + mi * 16 + fq * 4, n0 + wn * 64 + ni * 16 + fr);
    }
#pragma unroll
  for (int mi = 0; mi < 4; ++mi)
#pragma unroll
    for (int ni = 0; ni < 4; ++ni) {
      if (SWAP) epi(m0 + wm * 64 + mi * 16 + fr, n0 + wn * 64 + ni * 16 + fq * 4, acc[mi][ni], pv[mi][ni]);
      else epi(m0 + wm * 64 + mi * 16 + fq * 4, n0 + wn * 64 + ni * 16 + fr, acc[mi][ni], pv[mi][ni]);
    }
}

template <class F>
DI void for_tiles(int nM, int nN, int sm, int sn, F f) {
  if (gridDim.x == 256) {
    const int xcd = blockIdx.x & 7, slot = blockIdx.x >> 3;
    const int am = slot % sm, bn = slot / sm;
    const int nSN = (nN + sn - 1) / sn, nS = (nM / sm) * nSN;
    for (int st = xcd; st < nS; st += 8) {
      const int tm = (st / nSN) * sm + am, tn = (st % nSN) * sn + bn;
      if (tn < nN) f(tm, tn);
    }
  } else {
    for (int t = blockIdx.x; t < nM * nN; t += gridDim.x) f(t / nN, t % nN);
  }
}


#define LAS __attribute__((address_space(3)))
constexpr int G8_HTB = 128 * 64 * 2;
DI int g8_lds_byte(int r, int c) { const int st = (r >> 4) * 2 + (c >> 5), rr = r & 15, cc = c & 31, ob = rr * 64 + cc * 2; return st * 1024 + (ob ^ (((ob >> 9) & 1) << 5)); }
DI void g8_stage_rc(int b, int& R, int& C) { const int st = b / 1024, sb = b % 1024, swz = sb ^ (((sb >> 9) & 1) << 5); R = (st >> 1) * 16 + swz / 64; C = (st & 1) * 32 + (swz % 64) / 2; }
template <int NM, int NN, int NN1, int SM1, int SN1, int SM2, int SN2>
struct TileSched {
  static constexpr int nSN1 = NN1 / SN1, nS1 = (NM / SM1) * nSN1, nSN2 = (NN - NN1) / SN2, nS2 = (NM / SM2) * nSN2, nT = NM * NN;
  int c;
  DI void init() { c = blockIdx.x; }
  DI bool next(int i, int& pm, int& pn) const {
    if (gridDim.x == 256) {
      const int xcd = c & 7, slot = c >> 3;
      int st = xcd + 8 * i;
      if (st < nS1) { pm = (st / nSN1) * SM1 + slot % SM1; pn = (st % nSN1) * SN1 + slot / SM1; return true; }
      st -= nS1;
      if (nS2 == 0 || st >= nS2) return false;
      pm = (st / (nSN2 > 0 ? nSN2 : 1)) * SM2 + slot % SM2; pn = NN1 + (st % (nSN2 > 0 ? nSN2 : 1)) * SN2 + slot / SM2; return true;
    }
    const int L = i * (int)gridDim.x + c; if (L >= nT) return false; pm = L / NN; pn = L % NN; return true;
  }
};
template <bool ABLK = false, class Sched, class Epi>
DI void gemm8(char* smem, const u16* A, const u16* Bt, int K, const Sched& S, const Epi& E) {
  LAS unsigned char* lds = (LAS unsigned char*)smem;
  const int tid = TIDX(), wid = __builtin_amdgcn_readfirstlane(tid >> 6), lane = tid & 63, wr = wid >> 2, wc = wid & 3, fr = lane & 15, fq = lane >> 4;
  const int nt = K / 64;
  unsigned voff[2], voffA[2];
#pragma unroll
  for (int i = 0; i < 2; ++i) { int R, C; g8_stage_rc(tid * 16 + i * 8192, R, C); voff[i] = (unsigned)(R * K + C) * 2u; voffA[i] = ABLK ? (unsigned)(R * 64 + C) * 2u : voff[i]; }
  const size_t kstep = 128, hstep = (size_t)128 * K * 2, tstep = 2 * hstep;
  const size_t kstepA = ABLK ? 32768 : kstep, hstepA = ABLK ? 16384 : hstep;
  const unsigned ldsw = (unsigned)wid * 1024u;
  const int aoff = g8_lds_byte(wr * 64 + fr, fq * 8), boff = g8_lds_byte(wc * 32 + fr, fq * 8);
#define G8_SA(b, h) (((b) * 2 + (h)) * G8_HTB)
#define G8_SB(b, h) ((4 + (b) * 2 + (h)) * G8_HTB)
#define G8_STAGE(bufoff, gbase) do { _Pragma("unroll") for (int _i = 0; _i < 2; ++_i) \
    __builtin_amdgcn_global_load_lds((const unsigned*)((const char*)(gbase) + voff[_i]), (LAS unsigned*)(lds + (bufoff) + ldsw + _i * 8192), 16, 0, 0); } while (0)
#define G8_STAGEA(bufoff, gbase) do { _Pragma("unroll") for (int _i = 0; _i < 2; ++_i) \
    __builtin_amdgcn_global_load_lds((const unsigned*)((const char*)(gbase) + voffA[_i]), (LAS unsigned*)(lds + (bufoff) + ldsw + _i * 8192), 16, 0, 0); } while (0)
#define G8_LDA(dst, b, h) do { _Pragma("unroll") for (int m = 0; m < 4; ++m) _Pragma("unroll") for (int k = 0; k < 2; ++k) dst[m][k] = *(const LAS bf16x8*)(lds + G8_SA(b, h) + aoff + m * 2048 + k * 1024); } while (0)
#define G8_LDB(dst, b, h) do { _Pragma("unroll") for (int n = 0; n < 2; ++n) _Pragma("unroll") for (int k = 0; k < 2; ++k) dst[n][k] = *(const LAS bf16x8*)(lds + G8_SB(b, h) + boff + n * 2048 + k * 1024); } while (0)
#define G8_MMA(ai, bj, At_, Bt_) do { __builtin_amdgcn_s_setprio(1); _Pragma("unroll") for (int m = 0; m < 4; ++m) _Pragma("unroll") for (int n = 0; n < 2; ++n) _Pragma("unroll") for (int k = 0; k < 2; ++k) \
    acc[ai][bj][m][n] = __builtin_amdgcn_mfma_f32_16x16x32_bf16(Bt_[n][k], At_[m][k], acc[ai][bj][m][n], 0, 0, 0); __builtin_amdgcn_s_setprio(0); } while (0)
#define G8_WAIT_V(n) asm volatile("s_waitcnt vmcnt(" #n ")" ::: "memory")
#define G8_WAIT_L(n) asm volatile("s_waitcnt lgkmcnt(" #n ")" ::: "memory")
#define G8_BAR __builtin_amdgcn_s_barrier()
#define G8_SCHED __builtin_amdgcn_sched_barrier(0)
  int cpm, cpn, npm = 0, npn = 0, ui = 0;
  if (!S.next(0, cpm, cpn)) return;
  f32x4 acc[2][2][4][2];
#pragma unroll
  for (int a = 0; a < 2; ++a)
#pragma unroll
    for (int b = 0; b < 2; ++b)
#pragma unroll
      for (int m = 0; m < 4; ++m)
#pragma unroll
        for (int n = 0; n < 2; ++n) acc[a][b][m][n] = f32x4{0.f, 0.f, 0.f, 0.f};
  bf16x8 At[4][2], B0[2][2], B1[2][2];
  const char* cA = (const char*)A + (size_t)cpm * tstep; const char* cB = (const char*)Bt + (size_t)cpn * tstep;
  G8_STAGE(G8_SB(0, 0), cB); G8_STAGEA(G8_SA(0, 0), cA); G8_STAGE(G8_SB(0, 1), cB + hstep); G8_STAGEA(G8_SA(0, 1), cA + hstepA);
  if (wr == 1) G8_BAR;
  G8_WAIT_V(4); G8_BAR;
  G8_STAGE(G8_SB(1, 0), cB + kstep); G8_STAGEA(G8_SA(1, 0), cA + kstepA); G8_STAGE(G8_SB(1, 1), cB + hstep + kstep);
  G8_WAIT_V(6); G8_BAR;
  for (;;) {
    const bool has_next = S.next(ui + 1, npm, npn);
    const char* nA = has_next ? (const char*)A + (size_t)npm * tstep : cA; const char* nB = has_next ? (const char*)Bt + (size_t)npn * tstep : cB;
#pragma unroll 1
    for (int t = 0; t < nt; t += 2) {
      const bool last = (t == nt - 2);
      const char* a1 = cA + (size_t)(t + 1) * kstepA;
      const char* a2 = last ? nA : cA + (size_t)(t + 2) * kstepA; const char* b2 = last ? nB : cB + (size_t)(t + 2) * kstep;
      const char* a3 = a2 + kstepA; const char* b3 = b2 + kstep;
      G8_LDB(B0, 0, 0); G8_SCHED; G8_LDA(At, 0, 0); G8_STAGEA(G8_SA(1, 1), a1 + hstepA);
      G8_WAIT_L(8); G8_BAR; G8_WAIT_L(0); G8_MMA(0, 0, At, B0); G8_BAR; G8_SCHED;
      G8_LDB(B1, 0, 1); G8_STAGE(G8_SB(0, 0), b2);
      G8_BAR; G8_WAIT_L(0); G8_MMA(0, 1, At, B1); G8_BAR;
      G8_LDA(At, 0, 1); G8_STAGEA(G8_SA(0, 0), a2);
      G8_BAR; G8_WAIT_L(0); G8_MMA(1, 0, At, B0); G8_BAR; G8_SCHED;
      G8_STAGE(G8_SB(0, 1), b2 + hstep);
      G8_WAIT_V(6); G8_BAR; G8_MMA(1, 1, At, B1); G8_BAR;
      G8_LDB(B0, 1, 0); G8_SCHED; G8_LDA(At, 1, 0); G8_STAGEA(G8_SA(0, 1), a2 + hstepA);
      G8_WAIT_L(8); G8_BAR; G8_WAIT_L(0); G8_MMA(0, 0, At, B0); G8_BAR; G8_SCHED;
      G8_LDB(B1, 1, 1); G8_STAGE(G8_SB(1, 0), b3);
      G8_BAR; G8_WAIT_L(0); G8_MMA(0, 1, At, B1); G8_BAR;
      G8_LDA(At, 1, 1); G8_STAGEA(G8_SA(1, 0), a3);
      G8_BAR; G8_WAIT_L(0); G8_MMA(1, 0, At, B0); G8_BAR; G8_SCHED;
      G8_STAGE(G8_SB(1, 1), b3 + hstep);
      G8_WAIT_V(6); G8_BAR; G8_MMA(1, 1, At, B1); G8_BAR;
    }
    { const int t2 = TIDX(), w2 = __builtin_amdgcn_readfirstlane(t2 >> 6), l2 = t2 & 63; E(acc, cpm, cpn, w2 >> 2, w2 & 3, l2 & 15, l2 >> 4); }
    if (!has_next) break;
#pragma unroll
    for (int a = 0; a < 2; ++a)
#pragma unroll
      for (int b = 0; b < 2; ++b)
#pragma unroll
        for (int m = 0; m < 4; ++m)
#pragma unroll
          for (int n = 0; n < 2; ++n) acc[a][b][m][n] = f32x4{0.f, 0.f, 0.f, 0.f};
    cpm = npm; cpn = npn; cA = nA; cB = nB; ++ui;
  }
  G8_WAIT_V(0);
  if (wr == 0) G8_BAR;
  G8_BAR;
#undef G8_SA
#undef G8_SB
#undef G8_STAGE
#undef G8_STAGEA
#undef G8_LDA
#undef G8_LDB
#undef G8_MMA
#undef G8_WAIT_V
#undef G8_WAIT_L
#undef G8_BAR
#undef G8_SCHED
}
template <bool ABLK, class Epi>
DI void gemm_half(char* smem, const u16* A, const u16* Bt, int K, int pm, int pn, int nh, const Epi& E) {
  LAS unsigned char* lds = (LAS unsigned char*)smem;
  const int tid = TIDX(), wid = __builtin_amdgcn_readfirstlane(tid >> 6), lane = tid & 63, wr = wid >> 2, wc = wid & 3, fr = lane & 15, fq = lane >> 4;
  const int nt = K / 64;
  unsigned voff[2], voffA[2];
#pragma unroll
  for (int i = 0; i < 2; ++i) { int R, C; g8_stage_rc(tid * 16 + i * 8192, R, C); voff[i] = (unsigned)(R * K + C) * 2u; voffA[i] = ABLK ? (unsigned)(R * 64 + C) * 2u : voff[i]; }
  const size_t kstep = 128, hstep = (size_t)128 * K * 2, tstep = 2 * hstep;
  const size_t kstepA = ABLK ? 32768 : kstep, hstepA = ABLK ? 16384 : hstep;
  const unsigned ldsw = (unsigned)wid * 1024u;
  const int aoff = g8_lds_byte(wr * 64 + fr, fq * 8), boff = g8_lds_byte(wc * 32 + fr, fq * 8);
  const char* cA = (const char*)A + (size_t)pm * tstep;
  const char* cB = (const char*)Bt + (size_t)pn * tstep + (size_t)nh * hstep;
#define GH_STAGE(s_, kt_) do { _Pragma("unroll") for (int _i = 0; _i < 2; ++_i) { \
    __builtin_amdgcn_global_load_lds((const unsigned*)(cB + (size_t)(kt_) * kstep + voff[_i]), (LAS unsigned*)(lds + (s_) * 49152 + ldsw + _i * 8192), 16, 0, 0); \
    __builtin_amdgcn_global_load_lds((const unsigned*)(cA + (size_t)(kt_) * kstepA + voffA[_i]), (LAS unsigned*)(lds + (s_) * 49152 + 16384 + ldsw + _i * 8192), 16, 0, 0); \
    __builtin_amdgcn_global_load_lds((const unsigned*)(cA + hstepA + (size_t)(kt_) * kstepA + voffA[_i]), (LAS unsigned*)(lds + (s_) * 49152 + 32768 + ldsw + _i * 8192), 16, 0, 0); } } while (0)
  f32x4 acc[2][4][2];
#pragma unroll
  for (int a = 0; a < 2; ++a)
#pragma unroll
    for (int m = 0; m < 4; ++m)
#pragma unroll
      for (int n = 0; n < 2; ++n) acc[a][m][n] = f32x4{0.f, 0.f, 0.f, 0.f};
  __syncthreads();
  GH_STAGE(0, 0);
  asm volatile("s_waitcnt vmcnt(0)" ::: "memory");
  __syncthreads();
#pragma unroll 1
  for (int kt = 0; kt < nt; ++kt) {
    if (kt + 1 < nt) GH_STAGE((kt + 1) & 1, kt + 1);
    const LAS unsigned char* base = lds + (kt & 1) * 49152;
    bf16x8 B0[2][2];
#pragma unroll
    for (int n = 0; n < 2; ++n)
#pragma unroll
      for (int k = 0; k < 2; ++k) B0[n][k] = *(const LAS bf16x8*)(base + boff + n * 2048 + k * 1024);
#pragma unroll
    for (int ai = 0; ai < 2; ++ai) {
      bf16x8 At[4][2];
#pragma unroll
      for (int m = 0; m < 4; ++m)
#pragma unroll
        for (int k = 0; k < 2; ++k) At[m][k] = *(const LAS bf16x8*)(base + 16384 + ai * 16384 + aoff + m * 2048 + k * 1024);
#pragma unroll
      for (int m = 0; m < 4; ++m)
#pragma unroll
        for (int n = 0; n < 2; ++n)
#pragma unroll
          for (int k = 0; k < 2; ++k) acc[ai][m][n] = __builtin_amdgcn_mfma_f32_16x16x32_bf16(B0[n][k], At[m][k], acc[ai][m][n], 0, 0, 0);
    }
    asm volatile("s_waitcnt vmcnt(0)" ::: "memory");
    __syncthreads();
  }
#undef GH_STAGE
  E(acc, pm, pn, nh, wr, wc, fr, fq);
}

template <class F> struct ElemEpi {
  F f;
  DI void operator()(const f32x4 (&acc)[2][2][4][2], int pm, int pn, int wr, int wc, int fr, int fq) const {
    const int row0 = pm * 256 + wr * 64 + fr, col0 = pn * 256 + wc * 32 + 4 * fq;
#pragma unroll
    for (int ai = 0; ai < 2; ++ai)
#pragma unroll
      for (int m = 0; m < 4; ++m)
#pragma unroll
        for (int bj = 0; bj < 2; ++bj)
#pragma unroll
          for (int n = 0; n < 2; ++n) f(row0 + ai * 128 + m * 16, col0 + bj * 128 + n * 16, acc[ai][bj][m][n]);
  }
};
template <class F> DI ElemEpi<F> make_epi(F f) { return ElemEpi<F>{f}; }
template <int NM, int NN, int NN1, int SM1, int SN1, int SM2, int SN2, class F>
DI void gemm8_job(char* smem, const u16* A, const u16* Bt, int K, F f) {
  TileSched<NM, NN, NN1, SM1, SN1, SM2, SN2> S; S.init();
  gemm8(smem, A, Bt, K, S, make_epi(f));
}

DI void phase_mix_in(const PV& p, int i, char* smem) {
  const u16* H = (const u16*)(p.ws() + OFF_A + A_H);
  const u16* W = (const u16*)(p.ws() + OFF_WMIXIN) + (size_t)i * 2560 * 1024;
  u16* MIX = (u16*)(p.ws() + OFF_B + B_MIX);
  u16* VT = (u16*)(p.ws() + OFF_B + B_VT);
  u16* PRT = (u16*)(p.ws() + OFF_B + B_PRT);
  auto epi = [=](int m, int n, f32x4 v) {
    if (n < 512) {
      *(uint2*)(MIX + (size_t)m * 1024 + n) = pack4(gelu_tanh(v[0]), gelu_tanh(v[1]), gelu_tanh(v[2]), gelu_tanh(v[3]));
    } else if (n < 1024) {
      const int nn = n - 512, g = nn >> 7, c = nn & 127, chunk = m >> 7, q = m & 127;
      u16* b = VT + ((size_t)(g * 320 + chunk) * 128 + c) * 128 + q;
#pragma unroll
      for (int j = 0; j < 4; ++j) b[j * 128] = f2bf(gelu_tanh(v[j]));
    } else {
      const int cp = n - 1024;
      size_t off; int stride;
      if (m < TP) { off = (size_t)(m & ~255) * 1536 + (size_t)cp * 256 + (m & 255); stride = 256; }
      else { const int mm = m - TP; off = (size_t)(TP + (mm & ~4095)) * 1536 + (size_t)cp * 4096 + (mm & 4095); stride = 4096; }
#pragma unroll
      for (int j = 0; j < 4; ++j) PRT[off + (size_t)j * stride] = f2bf(v[j]);
    }
  };
  gemm8_job<160, 10, 8, 8, 4, 16, 2>(smem, H, W, 1024, epi);
}

DI void phase_sgu(const PV& p, int i, char* smem) {
  const u16* VT = (const u16*)(p.ws() + OFF_B + B_VT);
  const u16* W = (const u16*)(p.ws() + OFF_WSGU) + (size_t)i * 4 * 16384;
  u16* MIX = (u16*)(p.ws() + OFF_B + B_MIX);
  const float* sb = p.in(11) + i * 512;
  for (int u = blockIdx.x; u < 640; u += gridDim.x) {
    const int g = u / 160, tm = u % 160;
    auto epi = [=](int m, int n, f32x4 v, uint2 uu) {
      const int chunk = m >> 7, c = m & 127;
      const int t = chunk * 128 + n;
      const float bias = sb[g * 128 + n];
      u16* dst = MIX + (size_t)t * 1024 + g * 128 + c;
      *(uint2*)dst = pack4(lo16(uu.x) * (v[0] + bias), hi16(uu.x) * (v[1] + bias), lo16(uu.y) * (v[2] + bias), hi16(uu.y) * (v[3] + bias));
    };
    auto pre = [=](int m, int n) { return *(const uint2*)(MIX + (size_t)((m >> 7) * 128 + n) * 1024 + g * 128 + (m & 127)); };
    gemm_tile<false>(VT + (size_t)g * 320 * 128 * 128, 128, W + (size_t)g * 16384, 128, 128, tm * 256, 0, smem, epi, pre);
  }
}

DI size_t prt_off(int kind, int b, int cp) {
  return kind ? (size_t)(TP + b * 4096) * 1536 + (size_t)cp * 4096 : (size_t)(b * 256) * 1536 + (size_t)cp * 256;
}
DI size_t zt_off(int kind, int b, int c) {
  return kind ? (size_t)(TP + b * 4096) * 512 + (size_t)c * 4096 : (size_t)(b * 256) * 512 + (size_t)c * 256;
}
DI void phase_conv(const PV& p, int i, int ord, char* smem) {
  const int tid = TIDX(), lane = tid & 63, wid = tid >> 6;
  const u16* PRT = (const u16*)(p.ws() + OFF_B + B_PRT);
  const u16* FILT = (const u16*)(p.ws() + OFF_FILT);
  const u16* Z1 = (const u16*)(p.ws() + OFF_A + A_Z1);
  u16* ZO = (u16*)(p.ws() + OFF_A + (ord ? A_Z2 : A_Z1));
  const float* cw = p.in(12) + (size_t)i * 3 * 1536;
  const float* cb = p.in(13) + (size_t)i * 1536;
  u16* hc = (u16*)smem;
  char* Ub = smem + 68096;
  for (int u = blockIdx.x; u < 1024; u += gridDim.x) {
    const int kind = u < 512 ? 1 : 0, c = u & 511;
    const int L = kind ? 4096 : 256, NB = kind ? 8 : 32, LB = L >> 6, DD = L >> 7;
    const int US = (L + 8) * 2;
    const size_t fbase = ((size_t)(i * 2 + ord) * 512 + c) * 4352 + (kind ? 256 : 0);
    __syncthreads();
    {
      u16* tmp = (u16*)Ub;
      for (int idx = tid; idx < (L >> 3); idx += 512) *(uint4*)(tmp + idx * 8) = *(const uint4*)(FILT + fbase + idx * 8);
      __syncthreads();
      for (int idx = tid; idx < 8 * (L + 136); idx += 512) {
        const int cpy = idx / (L + 136), m = idx - cpy * (L + 136);
        const int x = L + 63 - m - cpy;
        hc[cpy * 4256 + m] = (x >= 0 && x < L) ? tmp[x] : (u16)0;
      }
      __syncthreads();
    }
    {
      const int ncr = L >> 3, total = NB * ncr;
      const float w0 = cw[c], w1 = cw[1536 + c], w2 = cw[3072 + c], bb = cb[c];
      for (int id = tid; id < total; id += 512) {
        const int b = id / ncr, t = (id - b * ncr) * 8;
        uint4 o;
        if (ord == 0) {
          const u16* src = PRT + prt_off(kind, b, c) + t;
          const uint4 raw = *(const uint4*)src;
          float e[10];
          e[0] = t > 0 ? bf2f(src[-1]) : 0.f;
          e[9] = t + 8 < L ? bf2f(src[8]) : 0.f;
          e[1] = lo16(raw.x); e[2] = hi16(raw.x); e[3] = lo16(raw.y); e[4] = hi16(raw.y);
          e[5] = lo16(raw.z); e[6] = hi16(raw.z); e[7] = lo16(raw.w); e[8] = hi16(raw.w);
          float r[8];
#pragma unroll
          for (int k = 0; k < 8; ++k) r[k] = w0 * e[k] + w1 * e[k + 1] + w2 * e[k + 2] + bb;
          o.x = pack2(r[0], r[1]); o.y = pack2(r[2], r[3]); o.z = pack2(r[4], r[5]); o.w = pack2(r[6], r[7]);
        } else {
          o = *(const uint4*)(Z1 + zt_off(kind, b, c) + t);
        }
        *(uint4*)(Ub + b * US + t * 2) = o;
      }
    }
    __syncthreads();
    const int ncols = LB * NB;
    if (wid * 64 < ncols) {
      const int il = lane & 31, q = lane >> 5;
      int t1c[2], bc[2];
#pragma unroll
      for (int nt = 0; nt < 2; ++nt) { const int col = wid * 64 + nt * 32 + il; t1c[nt] = col / NB; bc[nt] = col % NB; }
      const int t1lo = (wid * 64) / NB, t1hi = (wid * 64 + 63) / NB;
      const int dlo = max(-DD, t1lo - (LB - 1)), dhi = min(DD, t1hi);
      const int cpy = 7 - (il & 7);
      const char* abase = (const char*)hc + cpy * 8512 + 2 * (L / 2 + 63 - il - cpy + 8 * q);
      f32x16 acc[2][2];
#pragma unroll
      for (int a = 0; a < 2; ++a)
#pragma unroll
        for (int b = 0; b < 2; ++b)
#pragma unroll
          for (int r = 0; r < 16; ++r) acc[a][b][r] = 0.f;
      for (int d = dlo; d <= dhi; ++d) {
        bf16x8 bfr[2][4];
#pragma unroll
        for (int nt = 0; nt < 2; ++nt) {
          const int s1 = t1c[nt] - d;
          const bool valid = s1 >= 0 && s1 < LB;
          const char* bp = Ub + bc[nt] * US + ((valid ? s1 : 0) * 64 + 8 * q) * 2;
#pragma unroll
          for (int ks = 0; ks < 4; ++ks) {
            bf16x8 v = *(const bf16x8*)(bp + ks * 32);
            if (!valid) v = bf16x8{0, 0, 0, 0, 0, 0, 0, 0};
            bfr[nt][ks] = v;
          }
        }
#pragma unroll
        for (int mt = 0; mt < 2; ++mt)
#pragma unroll
          for (int ks = 0; ks < 4; ++ks) {
            const bf16x8 af = *(const bf16x8*)(abase + 2 * (-64 * d - 32 * mt + 16 * ks));
#pragma unroll
            for (int nt = 0; nt < 2; ++nt) acc[mt][nt] = __builtin_amdgcn_mfma_f32_32x32x16_bf16(af, bfr[nt][ks], acc[mt][nt], 0, 0, 0);
          }
      }
      const float dsk = p.in(21)[(i * 2 + ord) * 512 + c];
      const int gc = 512 * (ord + 1) + c;
      const float w0 = cw[gc], w1 = cw[1536 + gc], w2 = cw[3072 + gc], bb = cb[gc];
#pragma unroll
      for (int nt = 0; nt < 2; ++nt) {
        const int b = bc[nt];
        const u16* xrow = PRT + prt_off(kind, b, gc);
        u16* orow = ZO + zt_off(kind, b, c);
#pragma unroll
        for (int mt = 0; mt < 2; ++mt)
#pragma unroll
          for (int g = 0; g < 4; ++g) {
            const int t = 64 * t1c[nt] + mt * 32 + 8 * g + 4 * q;
            const uint2 uu = *(const uint2*)(Ub + b * US + t * 2);
            const uint2 xx = *(const uint2*)(xrow + t);
            const float em = t > 0 ? bf2f(xrow[t - 1]) : 0.f;
            const float ep = t + 4 < L ? bf2f(xrow[t + 4]) : 0.f;
            const float e0 = lo16(xx.x), e1 = hi16(xx.x), e2 = lo16(xx.y), e3 = hi16(xx.y);
            const float x0 = w0 * em + w1 * e0 + w2 * e1 + bb;
            const float x1 = w0 * e0 + w1 * e1 + w2 * e2 + bb;
            const float x2 = w0 * e1 + w1 * e2 + w2 * e3 + bb;
            const float x3 = w0 * e2 + w1 * e3 + w2 * ep + bb;
            const float y0 = acc[mt][nt][4 * g + 0] + lo16(uu.x) * dsk;
            const float y1 = acc[mt][nt][4 * g + 1] + hi16(uu.x) * dsk;
            const float y2 = acc[mt][nt][4 * g + 2] + lo16(uu.y) * dsk;
            const float y3 = acc[mt][nt][4 * g + 3] + hi16(uu.y) * dsk;
            *(uint2*)(orow + t) = pack4(x0 * y0, x1 * y1, x2 * y2, x3 * y3);
          }
      }
    }
  }
  __syncthreads();
}

DI void phase_ztrans(const PV& p, char* smem) {
  const int tid = TIDX();
  const u16* Z2 = (const u16*)(p.ws() + OFF_A + A_Z2);
  u16* MIX = (u16*)(p.ws() + OFF_B + B_MIX);
  u16* tl = (u16*)smem;
  for (int u = blockIdx.x; u < 640 * 8; u += gridDim.x) {
    const int tt0 = (u >> 3) * 64, c0 = (u & 7) * 64;
    const int kind = tt0 >= TP ? 1 : 0;
    const int b = kind ? (tt0 - TP) >> 12 : tt0 >> 8;
    const int tl0 = kind ? (tt0 - TP) & 4095 : tt0 & 255;
    __syncthreads();
    { const int c = tid >> 3, ch = tid & 7;
      *(uint4*)(tl + c * 72 + ch * 8) = *(const uint4*)(Z2 + zt_off(kind, b, c0 + c) + tl0 + ch * 8); }
    __syncthreads();
    { const int tr = tid >> 3, cc = (tid & 7) * 8;
      uint4 o;
      o.x = (unsigned)tl[(cc + 0) * 72 + tr] | ((unsigned)tl[(cc + 1) * 72 + tr] << 16);
      o.y = (unsigned)tl[(cc + 2) * 72 + tr] | ((unsigned)tl[(cc + 3) * 72 + tr] << 16);
      o.z = (unsigned)tl[(cc + 4) * 72 + tr] | ((unsigned)tl[(cc + 5) * 72 + tr] << 16);
      o.w = (unsigned)tl[(cc + 6) * 72 + tr] | ((unsigned)tl[(cc + 7) * 72 + tr] << 16);
      *(uint4*)(MIX + (size_t)(tt0 + tr) * 1024 + 512 + c0 + cc) = o; }
  }
  __syncthreads();
}

struct EpiResid {
  float* X; const float* x0; const float* x1; const float* gate; int lx;
  DI void operator()(const f32x4 (&acc)[2][2][4][2], int pm, int pn, int wr, int wc, int fr, int fq) const {
    const int rowt = pm * 256, col0 = pn * 256 + wc * 32 + 4 * fq;
    const float* gr = gate + (size_t)condrow(rowt) * 6144 + col0;
    const float* xb = lx == 0 ? (rowt < TP ? x0 + (size_t)rowt * 1024 : x1 + (size_t)(rowt - TP) * 1024) : X + (size_t)rowt * 1024;
    float4 g[2][2];
#pragma unroll
    for (int bj = 0; bj < 2; ++bj)
#pragma unroll
      for (int n = 0; n < 2; ++n) g[bj][n] = *(const float4*)(gr + bj * 128 + n * 16);
#pragma unroll
    for (int ai = 0; ai < 2; ++ai)
#pragma unroll
      for (int mh = 0; mh < 2; ++mh) {
        float4 xo[2][2][2];
#pragma unroll
        for (int mm = 0; mm < 2; ++mm)
#pragma unroll
          for (int bj = 0; bj < 2; ++bj)
#pragma unroll
            for (int n = 0; n < 2; ++n)
              xo[mm][bj][n] = *(const float4*)(xb + (size_t)(wr * 64 + fr + ai * 128 + (2 * mh + mm) * 16) * 1024 + col0 + bj * 128 + n * 16);
#pragma unroll
        for (int mm = 0; mm < 2; ++mm)
#pragma unroll
          for (int bj = 0; bj < 2; ++bj)
#pragma unroll
            for (int n = 0; n < 2; ++n) {
              const f32x4 v = acc[ai][bj][2 * mh + mm][n];
              const float4 x = xo[mm][bj][n], gg = g[bj][n];
              float4 o; o.x = x.x + gg.x * v[0]; o.y = x.y + gg.y * v[1]; o.z = x.z + gg.z * v[2]; o.w = x.w + gg.w * v[3];
              *(float4*)(X + (size_t)(rowt + wr * 64 + fr + ai * 128 + (2 * mh + mm) * 16) * 1024 + col0 + bj * 128 + n * 16) = o;
            }
      }
  }
};
struct EpiResidHalf {
  float* X; const float* x0; const float* x1; const float* gate; int lx;
  DI void operator()(const f32x4 (&acc)[2][4][2], int pm, int pn, int nh, int wr, int wc, int fr, int fq) const {
    const int rowt = pm * 256, col0 = pn * 256 + nh * 128 + wc * 32 + 4 * fq;
    const float* gr = gate + (size_t)condrow(rowt) * 6144 + col0;
    const float* xb = lx == 0 ? (rowt < TP ? x0 + (size_t)rowt * 1024 : x1 + (size_t)(rowt - TP) * 1024) : X + (size_t)rowt * 1024;
    float4 g[2];
#pragma unroll
    for (int n = 0; n < 2; ++n) g[n] = *(const float4*)(gr + n * 16);
#pragma unroll
    for (int ai = 0; ai < 2; ++ai) {
      float4 xo[4][2];
#pragma unroll
      for (int m = 0; m < 4; ++m)
#pragma unroll
        for (int n = 0; n < 2; ++n) xo[m][n] = *(const float4*)(xb + (size_t)(wr * 64 + fr + ai * 128 + m * 16) * 1024 + col0 + n * 16);
#pragma unroll
      for (int m = 0; m < 4; ++m)
#pragma unroll
        for (int n = 0; n < 2; ++n) {
          const f32x4 v = acc[ai][m][n];
          const float4 x = xo[m][n], gg = g[n];
          float4 o; o.x = x.x + gg.x * v[0]; o.y = x.y + gg.y * v[1]; o.z = x.z + gg.z * v[2]; o.w = x.w + gg.w * v[3];
          *(float4*)(X + (size_t)(rowt + wr * 64 + fr + ai * 128 + m * 16) * 1024 + col0 + n * 16) = o;
        }
    }
  }
};
struct ResidSched2 {
  int c;
  DI void init() { c = blockIdx.x; }
  DI bool next(int i, int& pm, int& pn) const {
    if (gridDim.x == 256) {
      const int st = (c & 7) + 8 * i;
      if (st >= 16) return false;
      pm = st * 8 + ((c >> 3) & 7); pn = c >> 6; return true;
    }
    const int L = i * (int)gridDim.x + c; if (L >= 640) return false; pm = L >> 2; pn = L & 3; return true;
  }
};
DI void phase_resid_gemm(const PV& p, int l, int lx, const u16* A, int K, const u16* W, int goff, char* smem) {
  EpiResid E;
  E.X = p.out(); E.x0 = p.in(0); E.x1 = p.in(1); E.gate = (const float*)(p.ws() + OFF_MOD) + (size_t)l * 9 * 6144 + goff; E.lx = lx;
  ResidSched2 S; S.init();
  if (K == 2816) gemm8<true>(smem, A, W, K, S, E);
  else gemm8<false>(smem, A, W, K, S, E);
  if (gridDim.x == 256) {
    EpiResidHalf EH; EH.X = E.X; EH.x0 = E.x0; EH.x1 = E.x1; EH.gate = E.gate; EH.lx = lx;
    const int xcd = blockIdx.x & 7, slot = blockIdx.x >> 3;
    const int st = 16 + (xcd >> 1), ti = (xcd & 1) * 16 + (slot >> 1), nh = slot & 1;
    const int pm = st * 8 + (ti & 7), pn = ti >> 3;
    if (K == 2816) gemm_half<true>(smem, A, W, K, pm, pn, nh, EH);
    else gemm_half<false>(smem, A, W, K, pm, pn, nh, EH);
  }
}

DI void phase_dqkv(const PV& p, int j, char* smem) {
  const u16* H = (const u16*)(p.ws() + OFF_A + A_H);
  const u16* W = (const u16*)(p.ws() + OFF_WDQKV) + (size_t)j * 1024 * 1024;
  u16* DQKV = (u16*)(p.ws() + OFF_B + B_DQKV);
  u16* KR = (u16*)(p.ws() + OFF_KR);
  float* okr = p.out() + 46137344;
  auto epi = [=](int m, int n, f32x4 v) {
    if (n < 832) {
      const uint2 pk = pack4(v[0], v[1], v[2], v[3]);
      *(uint2*)(DQKV + (size_t)m * 896 + n) = pk;
      if (n >= 768) {
        const int e = n - 768;
        *(uint2*)(KR + (size_t)m * 64 + e) = pk;
        if (m < TP) {
          float4 o; o.x = v[0]; o.y = v[1]; o.z = v[2]; o.w = v[3];
          *(float4*)(okr + ((size_t)((m >> 8) * 2 + j) * 256 + (m & 255)) * 64 + e) = o;
        }
      }
    }
  };
  gemm8_job<160, 4, 4, 8, 4, 32, 1>(smem, H, W, 1024, epi);
}

DI void phase_mla_norms(const PV& p, int j) {
  const int tid_ = TIDX(); const int lane = tid_ & 63, wid = tid_ >> 6;
  const u16* DQKV = (const u16*)(p.ws() + OFF_B + B_DQKV);
  u16* QN = (u16*)(p.ws() + OFF_A + A_QN);
  u16* CKV = (u16*)(p.ws() + OFF_A + A_CKV);
  u16* KR = (u16*)(p.ws() + OFF_KR);
  float* ockv = p.out() + 41943040;
  const float* qn = p.in(24) + j * 512;
  const float* kvn = p.in(27) + j * 256;
  for (int t = blockIdx.x * 8 + wid; t < TK; t += gridDim.x * 8) {
    if (t < T) {
      const u16* row = DQKV + (size_t)t * 896;
      const uint4 a = *(const uint4*)(row + lane * 8);
      float q[8] = {lo16(a.x), hi16(a.x), lo16(a.y), hi16(a.y), lo16(a.z), hi16(a.z), lo16(a.w), hi16(a.w)};
      float ss = 0.f;
#pragma unroll
      for (int k = 0; k < 8; ++k) ss += q[k] * q[k];
      ss = wave_sum(ss, lane);
      const float r = rsqrtf(ss * (1.f / 512.f) + EPS);
      const float4 g0 = *(const float4*)(qn + lane * 8), g1 = *(const float4*)(qn + lane * 8 + 4);
      uint4 o;
      o.x = pack2(q[0] * r * g0.x, q[1] * r * g0.y); o.y = pack2(q[2] * r * g0.z, q[3] * r * g0.w);
      o.z = pack2(q[4] * r * g1.x, q[5] * r * g1.y); o.w = pack2(q[6] * r * g1.z, q[7] * r * g1.w);
      *(uint4*)(QN + (size_t)t * 512 + lane * 8) = o;
      const uint2 b = *(const uint2*)(row + 512 + lane * 4);
      float kv[4] = {lo16(b.x), hi16(b.x), lo16(b.y), hi16(b.y)};
      float s2 = kv[0] * kv[0] + kv[1] * kv[1] + kv[2] * kv[2] + kv[3] * kv[3];
      s2 = wave_sum(s2, lane);
      const float r2 = rsqrtf(s2 * (1.f / 256.f) + EPS);
      const float4 g2 = *(const float4*)(kvn + lane * 4);
      float4 o2; o2.x = kv[0] * r2 * g2.x; o2.y = kv[1] * r2 * g2.y; o2.z = kv[2] * r2 * g2.z; o2.w = kv[3] * r2 * g2.w;
      *(uint2*)(CKV + (size_t)t * 256 + lane * 4) = pack4(o2.x, o2.y, o2.z, o2.w);
      if (t < TP) *(float4*)(ockv + ((size_t)((t >> 8) * 2 + j) * 256 + (t & 255)) * 256 + lane * 4) = o2;
    } else {
      const int pp = t - T, b = pp >> 8, s = pp & 255;
      const float4 v = *(const float4*)(p.in(2) + ((size_t)(b * 2 + j) * 256 + s) * 256 + lane * 4);
      *(uint2*)(CKV + (size_t)t * 256 + lane * 4) = pack4(v.x, v.y, v.z, v.w);
      if (lane < 16) {
        const float4 w = *(const float4*)(p.in(3) + ((size_t)(b * 2 + j) * 256 + s) * 64 + lane * 4);
        *(uint2*)(KR + (size_t)t * 64 + lane * 4) = pack4(w.x, w.y, w.z, w.w);
      }
    }
  }
}

DI size_t vt_off(int m, int h, int d) {
  if (m < TP) return ((size_t)((m >> 8) * 8 + h) * 128 + d) * 256 + (m & 255);
  if (m < T) { const int mm = m - TP; return VT_SAMPLE_OFF + ((size_t)((mm >> 12) * 8 + h) * 128 + d) * 4352 + (mm & 4095); }
  const int mm = m - T;
  return VT_SAMPLE_OFF + ((size_t)((mm >> 8) * 8 + h) * 128 + d) * 4352 + 4096 + (mm & 255);
}
struct EpiKV {
  u16* Kb; u16* Vt;
  DI void operator()(const f32x4 (&acc)[2][2][4][2], int pm, int pn, int wr, int wc, int fr, int fq) const {
    const int h = pn;
    const int rowt = pm * 256;
    const unsigned ls = rowt < TP ? 256u : 4352u;
    unsigned vbase;
    if (rowt < TP) vbase = (unsigned)(((rowt >> 8) * 8 + h) * 128) * 256u;
    else if (rowt < T) { const int mm = rowt - TP; vbase = (unsigned)VT_SAMPLE_OFF + (unsigned)(((mm >> 12) * 8 + h) * 128) * 4352u + (unsigned)(mm & 4095); }
    else { const int mm = rowt - T; vbase = (unsigned)VT_SAMPLE_OFF + (unsigned)(((mm >> 8) * 8 + h) * 128) * 4352u + 4096u + (unsigned)(mm & 255); }
    const unsigned dcol = (unsigned)(wc * 32 + 4 * fq);
#pragma unroll
    for (int ai = 0; ai < 2; ++ai)
#pragma unroll
      for (int m = 0; m < 4; ++m) {
        const int rl = ai * 128 + wr * 64 + m * 16 + fr;
        const unsigned ko = (unsigned)((rowt + rl) * 8 + h) * 192u + dcol;
        const unsigned frp = (unsigned)((fr & 3) | ((fr & 4) << 1) | ((fr & 8) >> 1));
        const unsigned vo = vbase + (unsigned)(rl & ~15) + frp + dcol * ls;
#pragma unroll
        for (int n = 0; n < 2; ++n) {
          const f32x4 k = acc[ai][0][m][n], v = acc[ai][1][m][n];
          *(uint2*)(Kb + (ko + n * 16)) = pack4(k[0], k[1], k[2], k[3]);
          const unsigned p01 = pack2(v[0], v[1]), p23 = pack2(v[2], v[3]);
          const unsigned vq = vo + (unsigned)(n * 16) * ls;
          Vt[vq] = (u16)p01; Vt[vq + ls] = (u16)(p01 >> 16); Vt[vq + 2 * ls] = (u16)p23; Vt[vq + 3 * ls] = (u16)(p23 >> 16);
        }
      }
  }
};
DI void phase_uq_ukv(const PV& p, int j, char* smem) {
  const u16* QN = (const u16*)(p.ws() + OFF_A + A_QN);
  const u16* CKV = (const u16*)(p.ws() + OFF_A + A_CKV);
  const u16* WQ = (const u16*)(p.ws() + OFF_WUQ) + (size_t)j * 1536 * 512;
  const u16* WKV = (const u16*)(p.ws() + OFF_WUKV) + (size_t)j * 2048 * 256;
  u16* Q = (u16*)(p.ws() + OFF_B + B_Q);
  u16* Kb = (u16*)(p.ws() + OFF_B + B_K);
  u16* Vt = (u16*)(p.ws() + OFF_B + B_V);
  auto epiq = [=](int m, int n, f32x4 v) { *(uint2*)(Q + (size_t)m * 1536 + n) = pack4(v[0], v[1], v[2], v[3]); };
  gemm8_job<160, 6, 4, 8, 4, 16, 2>(smem, QN, WQ, 512, epiq);
  EpiKV E; E.Kb = Kb; E.Vt = Vt;
  TileSched<168, 8, 8, 8, 4, 32, 1> S; S.init();
  gemm8(smem, CKV, WKV, 256, S, E);
}

DI void phase_finalize(const PV& p, int j) {
  const int tid_ = TIDX(); const int lane = tid_ & 63, wid = tid_ >> 6;
  const int h = lane >> 3, l8 = lane & 7;
  u16* Q = (u16*)(p.ws() + OFF_B + B_Q);
  u16* Kb = (u16*)(p.ws() + OFF_B + B_K);
  const u16* KR = (const u16*)(p.ws() + OFF_KR);
  const float2* ROPE = (const float2*)(p.ws() + OFF_ROPE);
  const float* qhn = p.in(29) + j * 192;
  const float* khn = p.in(30) + j * 192;
  const float QSCALE = 1.4426950408889634f * 0.07216878364870322f;
  const int stride = gridDim.x * 8;
  for (int u0 = blockIdx.x * 8 + wid; u0 < T + TK; u0 += 2 * stride) {
    uint4 raw[2][3];
    u16* basep[2];
#pragma unroll
    for (int w = 0; w < 2; ++w) {
      const int u = u0 + w * stride;
      if (u < T + TK) {
        const bool isq = u < T;
        const int t = isq ? u : u - T;
        u16* base = isq ? Q + (size_t)t * 1536 + h * 192 : Kb + ((size_t)t * 8 + h) * 192;
        basep[w] = base;
#pragma unroll
        for (int k = 0; k < 3; ++k) {
          const u16* src = (!isq && k == 2) ? KR + (size_t)t * 64 + 8 * l8 : base + 8 * (l8 + 8 * k);
          raw[w][k] = *(const uint4*)src;
        }
      }
    }
#pragma unroll
    for (int w = 0; w < 2; ++w) {
      const int u = u0 + w * stride;
      if (u < T + TK) {
        const bool isq = u < T;
        const int t = isq ? u : u - T;
        const float* hn = isq ? qhn : khn;
        float v[3][8];
#pragma unroll
        for (int k = 0; k < 3; ++k) {
          const uint4 a = raw[w][k];
          v[k][0] = lo16(a.x); v[k][1] = hi16(a.x); v[k][2] = lo16(a.y); v[k][3] = hi16(a.y);
          v[k][4] = lo16(a.z); v[k][5] = hi16(a.z); v[k][6] = lo16(a.w); v[k][7] = hi16(a.w);
        }
        float ss = 0.f;
#pragma unroll
        for (int k = 0; k < 3; ++k)
#pragma unroll
          for (int e = 0; e < 8; ++e) ss += v[k][e] * v[k][e];
        ss += shx<1>(ss, lane); ss += shx<2>(ss, lane); ss += shx<4>(ss, lane);
        const float r = rsqrtf(ss * (1.f / 192.f) + EPS);
#pragma unroll
        for (int k = 0; k < 3; ++k) {
          const float4 g0 = *(const float4*)(hn + 8 * (l8 + 8 * k)), g1 = *(const float4*)(hn + 8 * (l8 + 8 * k) + 4);
          v[k][0] *= r * g0.x; v[k][1] *= r * g0.y; v[k][2] *= r * g0.z; v[k][3] *= r * g0.w;
          v[k][4] *= r * g1.x; v[k][5] *= r * g1.y; v[k][6] *= r * g1.z; v[k][7] *= r * g1.w;
        }
        if (t >= TP && t < T) {
          const int tl = (t - TP) & 4095;
          const int pos = l8 < 4 ? (tl >> 6) : (tl & 63);
          const float4* rp = (const float4*)(ROPE + pos * 16 + (l8 & 1) * 8);
          const float4 c01 = rp[0], c23 = rp[1], c45 = rp[2], c67 = rp[3];
          const float cs[8] = {c01.x, c01.z, c23.x, c23.z, c45.x, c45.z, c67.x, c67.z};
          const float sn[8] = {c01.y, c01.w, c23.y, c23.w, c45.y, c45.w, c67.y, c67.w};
#pragma unroll
          for (int e = 0; e < 8; ++e) {
            const float x = v[2][e];
            const float partner = shx<2>(x, lane);
            v[2][e] = (l8 & 2) ? x * cs[e] + partner * sn[e] : x * cs[e] - partner * sn[e];
          }
        }
        const float sc = isq ? QSCALE : 1.f;
#pragma unroll
        for (int k = 0; k < 3; ++k) {
          uint4 o;
          o.x = pack2(v[k][0] * sc, v[k][1] * sc); o.y = pack2(v[k][2] * sc, v[k][3] * sc);
          o.z = pack2(v[k][4] * sc, v[k][5] * sc); o.w = pack2(v[k][6] * sc, v[k][7] * sc);
          *(uint4*)(basep[w] + 8 * (l8 + 8 * k)) = o;
        }
      }
    }
  }
}

DI void attn_item(const PV& p, int kind, int seq, int h, int q0, char* smem) {
  const int tid = TIDX(), lane = tid & 63, wid = tid >> 6;
  const int il = lane & 31, hh = lane >> 5;
  const u16* Q = (const u16*)(p.ws() + OFF_B + B_Q);
  const u16* Kb = (const u16*)(p.ws() + OFF_B + B_K);
  const u16* Vt = (const u16*)(p.ws() + OFF_B + B_V);
  u16* O = (u16*)(p.ws() + OFF_A + A_O);
  const int Lk = kind ? 4352 : 256, nkt = Lk >> 6;
  const u16* vbase = Vt + (kind ? VT_SAMPLE_OFF + (size_t)(seq * 8 + h) * 128 * 4352 : (size_t)(seq * 8 + h) * 128 * 256);
  const int tq = q0 + wid * 32 + il;
  bf16x8 qf[12];
#pragma unroll
  for (int ks = 0; ks < 12; ++ks) qf[ks] = *(const bf16x8*)(Q + ((size_t)tq * 8 + h) * 192 + 16 * ks + 8 * hh);
  f32x16 oacc[4];
#pragma unroll
  for (int a = 0; a < 4; ++a)
#pragma unroll
    for (int r = 0; r < 16; ++r) oacc[a][r] = 0.f;
  float mrun = -INFINITY, lrun = 0.f;
  const int sw = (il >> 1) & 7;
  int ko[4], vob[4];
#pragma unroll
  for (int a = 0; a < 4; ++a) ko[a] = il * 384 + (((2 * a + hh) ^ sw) << 4);
#pragma unroll
  for (int c = 0; c < 4; ++c) vob[c] = il * 128 + (((2 * c + hh) ^ sw) << 4);
  LAS unsigned char* lds = (LAS unsigned char*)smem;
  unsigned kso[3], vso[2];
#pragma unroll
  for (int i = 0; i < 3; ++i) {
    const int id = tid + 512 * i, r = id / 24, pc = id - r * 24;
    const int ch = (pc & ~7) | ((pc & 7) ^ ((r >> 1) & 7));
    kso[i] = (unsigned)(r * 3072 + ch * 16);
  }
#pragma unroll
  for (int i = 0; i < 2; ++i) {
    const int id = tid + 512 * i, dd = id >> 3, pc = id & 7;
    const int ch = pc ^ ((dd >> 1) & 7);
    vso[i] = (unsigned)(dd * Lk * 2 + ch * 16);
  }
  const unsigned ldst = (unsigned)(tid >> 6) * 1024u;
#define ATT_STAGE(kt_, s_)                                                                                      \
  {                                                                                                            \
    const int k0_ = (kt_) * 64;                                                                                \
    const int rowbase_ = kind ? (k0_ < 4096 ? TP + seq * 4096 + k0_ : T + seq * 256 + (k0_ - 4096)) : seq * 256 + k0_; \
    const char* kg_ = (const char*)(Kb + ((size_t)rowbase_ * 8 + h) * 192);                                     \
    const char* vg_ = (const char*)(vbase + k0_);                                                              \
    _Pragma("unroll") for (int i_ = 0; i_ < 3; ++i_)                                                           \
      __builtin_amdgcn_global_load_lds((const unsigned*)(kg_ + kso[i_]), (LAS unsigned*)(lds + (s_) * 40960 + ldst + i_ * 8192), 16, 0, 0); \
    _Pragma("unroll") for (int i_ = 0; i_ < 2; ++i_)                                                           \
      __builtin_amdgcn_global_load_lds((const unsigned*)(vg_ + vso[i_]), (LAS unsigned*)(lds + (s_) * 40960 + 24576 + ldst + i_ * 8192), 16, 0, 0); \
  }
  __syncthreads();
  ATT_STAGE(0, 0)
  asm volatile("s_waitcnt vmcnt(0)" ::: "memory");
  __syncthreads();
  for (int kt = 0; kt < nkt; ++kt) {
    const bool more = kt + 1 < nkt;
    if (more) ATT_STAGE(kt + 1, (kt + 1) & 1)
    const char* Ks = smem + (kt & 1) * 40960;
    const char* Vs = Ks + 24576;
    f32x16 s2[2];
    __builtin_amdgcn_s_setprio(1);
#pragma unroll
    for (int st = 0; st < 2; ++st) {
#pragma unroll
      for (int r = 0; r < 16; ++r) s2[st][r] = 0.f;
#pragma unroll
      for (int ks = 0; ks < 12; ++ks) {
        const bf16x8 kf = *(const bf16x8*)(Ks + ko[ks & 3] + st * 12288 + (ks >> 2) * 128);
        s2[st] = __builtin_amdgcn_mfma_f32_32x32x16_bf16(kf, qf[ks], s2[st], 0, 0, 0);
      }
    }
    __builtin_amdgcn_s_setprio(0);
    {
      float pmax = s2[0][0];
#pragma unroll
      for (int r = 1; r < 16; ++r) pmax = fmaxf(pmax, s2[0][r]);
#pragma unroll
      for (int r = 0; r < 16; ++r) pmax = fmaxf(pmax, s2[1][r]);
      { auto rr = __builtin_amdgcn_permlane32_swap(__float_as_uint(pmax), __float_as_uint(pmax), false, false);
        pmax = fmaxf(__uint_as_float(rr[0]), __uint_as_float(rr[1])); }
      if (!__all(pmax - mrun <= 11.541560327f)) {
        const float mn = fmaxf(mrun, pmax);
        const float alpha = __builtin_amdgcn_exp2f(mrun - mn);
        mrun = mn;
        lrun *= alpha;
#pragma unroll
        for (int a = 0; a < 4; ++a)
#pragma unroll
          for (int r = 0; r < 16; ++r) oacc[a][r] *= alpha;
      }
      float psum = 0.f;
#pragma unroll
      for (int st = 0; st < 2; ++st)
#pragma unroll
        for (int r = 0; r < 16; ++r) { const float pv = __builtin_amdgcn_exp2f(s2[st][r] - mrun); s2[st][r] = pv; psum += pv; }
      lrun += psum;
    }
    __builtin_amdgcn_s_setprio(1);
#pragma unroll
    for (int st = 0; st < 2; ++st)
#pragma unroll
      for (int sb = 0; sb < 2; ++sb) {
        union { bf16x8 v; unsigned w[4]; } pb;
#pragma unroll
        for (int w = 0; w < 4; ++w) pb.w[w] = pack2(s2[st][8 * sb + 2 * w], s2[st][8 * sb + 2 * w + 1]);
#pragma unroll
        for (int dt = 0; dt < 4; ++dt) {
          const bf16x8 vf = *(const bf16x8*)(Vs + vob[2 * st + sb] + dt * 4096);
          oacc[dt] = __builtin_amdgcn_mfma_f32_32x32x16_bf16(vf, pb.v, oacc[dt], 0, 0, 0);
        }
      }
    __builtin_amdgcn_s_setprio(0);
    asm volatile("s_waitcnt vmcnt(0)" ::: "memory");
    __syncthreads();
  }
#undef ATT_STAGE
  float ltot;
  { auto rr = __builtin_amdgcn_permlane32_swap(__float_as_uint(lrun), __float_as_uint(lrun), false, false); ltot = __uint_as_float(rr[0]) + __uint_as_float(rr[1]); }
  const float inv = 1.f / ltot;
#pragma unroll
  for (int dt = 0; dt < 4; ++dt)
#pragma unroll
    for (int g = 0; g < 4; ++g) {
      const int d = dt * 32 + 8 * g + 4 * hh;
      *(uint2*)(O + (size_t)tq * 1024 + h * 128 + d) =
          pack4(oacc[dt][4 * g] * inv, oacc[dt][4 * g + 1] * inv, oacc[dt][4 * g + 2] * inv, oacc[dt][4 * g + 3] * inv);
    }
}
DI void phase_attention(const PV& p, char* smem) {
  const bool xmap = gridDim.x == 256;
  const int Gq = opaque_i((int)gridDim.x);
  const int nit = xmap ? 5 : (1280 + Gq - 1) / Gq;
#pragma unroll 1
  for (int r = 0; r < nit; ++r) {
    int kind, seq, h, q0;
    if (xmap) {
      if (r < 4) {
        const int xcd = blockIdx.x & 7, slot = blockIdx.x >> 3;
        const int pair = xcd + 8 * (2 * r + (slot >> 4)), qb = slot & 15;
        kind = 1; seq = pair >> 3; h = pair & 7; q0 = TP + seq * 4096 + qb * 256;
      } else {
        kind = 0; seq = blockIdx.x >> 3; h = blockIdx.x & 7; q0 = seq * 256;
      }
    } else {
      const int it = blockIdx.x + r * gridDim.x;
      if (it >= 1280) break;
      if (it < 1024) { const int pair = it >> 4, qb = it & 15; kind = 1; seq = pair >> 3; h = pair & 7; q0 = TP + seq * 4096 + qb * 256; }
      else { const int i2 = it - 1024; kind = 0; seq = i2 >> 3; h = i2 & 7; q0 = seq * 256; }
    }
    attn_item(p, kind, seq, h, q0, smem);
  }
  __syncthreads();
}

DI size_t act_blk(int t, int a) { return (size_t)(t >> 8) * (256 * 2816) + (size_t)(a >> 6) * (256 * 64) + (size_t)((t & 255) * 64 + (a & 63)); }
DI float dpp_ror1(float x) { return __int_as_float(__builtin_amdgcn_update_dpp(0, __float_as_int(x), 0x121, 0xf, 0xf, false)); }
DI float dpp_ror15(float x) { return __int_as_float(__builtin_amdgcn_update_dpp(0, __float_as_int(x), 0x12F, 0xf, 0xf, false)); }
struct EpiFFN {
  u16* ACT; u16* EDGE; const float* cw; const float* cb;
  DI void operator()(const f32x4 (&acc)[2][2][4][2], int pm, int pn, int wr, int wc, int fr, int fq) const {
#pragma unroll
    for (int n = 0; n < 2; ++n) {
      const int a = pn * 128 + wc * 32 + n * 16 + fq * 4;
      const float4 w0g = *(const float4*)(cw + a), w1g = *(const float4*)(cw + 5632 + a), w2g = *(const float4*)(cw + 11264 + a), bg = *(const float4*)(cb + a);
      const float4 w0u = *(const float4*)(cw + 2816 + a), w1u = *(const float4*)(cw + 5632 + 2816 + a), w2u = *(const float4*)(cw + 11264 + 2816 + a), bu = *(const float4*)(cb + 2816 + a);
#pragma unroll
      for (int ai = 0; ai < 2; ++ai) {
        const int rbase = pm * 256 + ai * 128 + wr * 64;
        const size_t erow = (size_t)(rbase >> 6) * 4;
#pragma unroll
        for (int m = 0; m < 4; ++m) {
          const int mp = m > 0 ? m - 1 : 0, mn = m < 3 ? m + 1 : 3;
          float o[4];
#define FFN_ONE(J, C)                                                                                         \
          {                                                                                                   \
            const float g = acc[ai][0][m][n][J], u = acc[ai][1][m][n][J];                                     \
            const float gpv = m > 0 ? acc[ai][0][mp][n][J] : 0.f, gnx = m < 3 ? acc[ai][0][mn][n][J] : 0.f;   \
            const float upv = m > 0 ? acc[ai][1][mp][n][J] : 0.f, unx = m < 3 ? acc[ai][1][mn][n][J] : 0.f;   \
            const float gp = dpp_ror1(fr == 15 ? gpv : g), gn = dpp_ror15(fr == 0 ? gnx : g);                \
            const float up = dpp_ror1(fr == 15 ? upv : u), un = dpp_ror15(fr == 0 ? unx : u);                \
            const float cg = w0g.C * gp + w1g.C * g + w2g.C * gn + bg.C;                                      \
            const float cu = w0u.C * up + w1u.C * u + w2u.C * un + bu.C;                                      \
            o[J] = silu(cg) * cu;                                                                             \
          }
          FFN_ONE(0, x) FFN_ONE(1, y) FFN_ONE(2, z) FFN_ONE(3, w)
#undef FFN_ONE
          *(uint2*)(ACT + act_blk(rbase + m * 16 + fr, a)) = pack4(o[0], o[1], o[2], o[3]);
          if ((m == 0 && fr < 2) || (m == 3 && fr >= 14)) {
            const int ri = m == 0 ? fr : fr - 12;
            u16* e = EDGE + (erow + ri) * 5632 + pn * 256 + wc * 32 + n * 16 + fq * 4;
            *(uint2*)e = pack4(acc[ai][0][m][n][0], acc[ai][0][m][n][1], acc[ai][0][m][n][2], acc[ai][0][m][n][3]);
            *(uint2*)(e + 128) = pack4(acc[ai][1][m][n][0], acc[ai][1][m][n][1], acc[ai][1][m][n][2], acc[ai][1][m][n][3]);
          }
        }
      }
    }
  }
};
DI void phase_ffn_up(const PV& p, int l, char* smem) {
  EpiFFN E;
  E.ACT = (u16*)(p.ws() + OFF_B + B_ACT); E.EDGE = (u16*)(p.ws() + OFF_EDGE);
  E.cw = p.in(33) + (size_t)l * 3 * 5632; E.cb = p.in(34) + (size_t)l * 5632;
  TileSched<160, 22, 16, 8, 4, 16, 2> S; S.init();
  gemm8(smem, (const u16*)(p.ws() + OFF_A + A_H), (const u16*)(p.ws() + OFF_WUP), 1024, S, E);
}
DI void phase_ffn_fix(const PV& p, int l) {
  const u16* EDGE = (const u16*)(p.ws() + OFF_EDGE);
  u16* ACT = (u16*)(p.ws() + OFF_B + B_ACT);
  const float* cw = p.in(33) + (size_t)l * 3 * 5632;
  const float* cb = p.in(34) + (size_t)l * 5632;
  const long gtid = (long)blockIdx.x * blockDim.x + TIDX(), gsz = (long)gridDim.x * blockDim.x;
  for (long idx = gtid; idx < (long)640 * 2 * 2816; idx += gsz) {
    const int a = (int)(idx % 2816), rr = (int)(idx / 2816), which = rr & 1, sidx = rr >> 1;
    const int t = sidx * 64 + (which ? 63 : 0);
    const int tb = which ? t + 1 : t;
    const bool seqb = tb < TP ? (tb & 255) == 0 : ((tb - TP) & 4095) == 0;
    if (seqb) continue;
    const int pc = (a >> 7) * 256 + (a & 127);
    const u16 *pr, *cu, *nx;
    if (which == 0) { pr = EDGE + ((size_t)(sidx - 1) * 4 + 3) * 5632; cu = EDGE + ((size_t)sidx * 4 + 0) * 5632; nx = EDGE + ((size_t)sidx * 4 + 1) * 5632; }
    else { pr = EDGE + ((size_t)sidx * 4 + 2) * 5632; cu = EDGE + ((size_t)sidx * 4 + 3) * 5632; nx = EDGE + ((size_t)(sidx + 1) * 4 + 0) * 5632; }
    const float g = cw[a] * bf2f(pr[pc]) + cw[5632 + a] * bf2f(cu[pc]) + cw[11264 + a] * bf2f(nx[pc]) + cb[a];
    const float uu = cw[2816 + a] * bf2f(pr[pc + 128]) + cw[5632 + 2816 + a] * bf2f(cu[pc + 128]) + cw[11264 + 2816 + a] * bf2f(nx[pc + 128]) + cb[2816 + a];
    ACT[act_blk(t, a)] = f2bf(silu(g) * uu);
  }
}

#ifndef PH
#define RUN(k, ...) __VA_ARGS__
#else
#define RUN(k, ...) if (PH == k) { __VA_ARGS__ }
#endif
extern "C" __global__ void __launch_bounds__(512) fwd_megakernel(Params kp) {
  extern __shared__ __attribute__((aligned(16))) char smem[];
  cg::grid_group grid = cg::this_grid();
  if (TIDX() == 0) {
    unsigned long long* t = (unsigned long long*)(smem + PARM_OFF);
#pragma unroll
    for (int k = 0; k < 36; ++k) t[k] = (unsigned long long)kp.in[k];
    t[36] = (unsigned long long)kp.out; t[37] = (unsigned long long)kp.ws;
  }
  __syncthreads();
  PV p; p.smem = smem;
  unsigned* bar = (unsigned*)(p.ws() + OFF_BAR);
  if (TIDX() == 0) { *(unsigned*)(smem + PARM_OFF + 512) = 0u; *(unsigned*)(smem + PARM_OFF + 516) = 0u; }
  __syncthreads();
  const XcdBarrier xb = xcd_barrier_post(bar, (volatile LASB unsigned*)(smem + PARM_OFF + 512));
  RUN(0, phase_prep(p, smem);)
  grid.sync();
  RUN(1, phase_filters(p, smem);)
  for (int l = 0; l < 4; ++l) {
    const int i = l >> 1;
    RUN(2, phase_norm(p, l, 0, l);)
    RUN(0, if (l > 0) { int base = 0; convert_ffn_weights(p, l, smem, base); })
    xcd_barrier(xb);
    if ((l & 1) == 0) {
      RUN(3, phase_mix_in(p, i, smem);)
      xcd_barrier(xb);
      RUN(4, phase_sgu(p, i, smem);)
      RUN(5, phase_conv(p, i, 0, smem);)
      xcd_barrier(xb);
      RUN(5, phase_conv(p, i, 1, smem);)
      xcd_barrier(xb);
      RUN(6, phase_ztrans(p, smem);)
      xcd_barrier(xb);
      RUN(7, phase_resid_gemm(p, l, l, (const u16*)(p.ws() + OFF_B + B_MIX), 1024, (const u16*)(p.ws() + OFF_WMIXOUT) + (size_t)i * 1024 * 1024, 2048, smem);)
      xcd_barrier(xb);
    } else {
      RUN(8, phase_dqkv(p, i, smem);)
      xcd_barrier(xb);
      RUN(9, phase_mla_norms(p, i);)
      xcd_barrier(xb);
      RUN(10, phase_uq_ukv(p, i, smem);)
      xcd_barrier(xb);
      RUN(11, phase_finalize(p, i);)
      xcd_barrier(xb);
      RUN(12, phase_attention(p, smem);)
      xcd_barrier(xb);
      RUN(7, phase_resid_gemm(p, l, l, (const u16*)(p.ws() + OFF_A + A_O), 1024, (const u16*)(p.ws() + OFF_WO) + (size_t)i * 1024 * 1024, 2048, smem);)
      xcd_barrier(xb);
    }
    RUN(2, phase_norm(p, l, 1, 1);)
    xcd_barrier(xb);
    RUN(13, phase_ffn_up(p, l, smem);)
    xcd_barrier(xb);
    RUN(14, phase_ffn_fix(p, l);)
    xcd_barrier(xb);
    RUN(7, phase_resid_gemm(p, l, 1, (const u16*)(p.ws() + OFF_B + B_ACT), 2816, (const u16*)(p.ws() + OFF_WDOWN), 5120, smem);)
    xcd_barrier(xb);
  }
}

extern "C" void kernel_launch(void* const* d_in, const int* in_sizes, int n_in,
                              void* d_out, int out_size, void* d_ws, size_t ws_size,
                              hipStream_t stream) {
  static int grid_blocks = 0;
  if (!grid_blocks) {
    int dev = 0, cus = 0, per_cu = 0;
    (void)hipGetDevice(&dev);
    (void)hipDeviceGetAttribute(&cus, hipDeviceAttributeMultiprocessorCount, dev);
    (void)hipFuncSetAttribute((const void*)fwd_megakernel, hipFuncAttributeMaxDynamicSharedMemorySize, (int)LDS_BYTES);
    (void)hipOccupancyMaxActiveBlocksPerMultiprocessor(&per_cu, fwd_megakernel, 512, LDS_BYTES);
    if (per_cu < 1) per_cu = 1;
    if (per_cu > 1) per_cu = 1;
    grid_blocks = cus * per_cu;
  }
  if (ws_size < WS_NEED) fprintf(stderr, "workspace too small: %zu < %zu\n", ws_size, (size_t)WS_NEED);
  Params p{};
  for (int i = 0; i < 36; ++i) p.in[i] = (const float*)d_in[i];
  p.out = (float*)d_out;
  p.ws = (char*)d_ws;
  (void)hipMemsetAsync((char*)d_ws + OFF_BAR, 0, 16384, stream);
  void* args[] = {&p};
  hipError_t e = hipLaunchCooperativeKernel((void*)fwd_megakernel, dim3(grid_blocks), dim3(512), args, LDS_BYTES, stream);
  if (e != hipSuccess) fprintf(stderr, "cooperative launch failed: %s (grid %d)\n", hipGetErrorString(e), grid_blocks);
}
```

```cpp
#include <hip/hip_runtime.h>
#include <hip/hip_cooperative_groups.h>
#include <cstdio>
namespace cg = cooperative_groups;

typedef unsigned short u16;
using bf16x8 = __attribute__((ext_vector_type(8))) short;
using f32x4 = __attribute__((ext_vector_type(4))) float;
using f32x16 = __attribute__((ext_vector_type(16))) float;
#define DI __device__ __forceinline__

constexpr int T = 40960;
constexpr int TP = 8192;
constexpr int TK = 43008;
constexpr float EPS = 1e-6f;
constexpr size_t LDS_BYTES = 139264;

constexpr size_t OFF_WMIXIN = 0;
constexpr size_t OFF_WMIXOUT = OFF_WMIXIN + (size_t)2 * 2560 * 1024 * 2;
constexpr size_t OFF_WDQKV = OFF_WMIXOUT + (size_t)2 * 1024 * 1024 * 2;
constexpr size_t OFF_WUQ = OFF_WDQKV + (size_t)2 * 1024 * 1024 * 2;
constexpr size_t OFF_WUKV = OFF_WUQ + (size_t)2 * 1536 * 512 * 2;
constexpr size_t OFF_WO = OFF_WUKV + (size_t)2 * 2048 * 256 * 2;
constexpr size_t OFF_WSGU = OFF_WO + (size_t)2 * 1024 * 1024 * 2;
constexpr size_t OFF_WUP = OFF_WSGU + (size_t)2 * 4 * 128 * 128 * 2;
constexpr size_t OFF_WDOWN = OFF_WUP + (size_t)5632 * 1024 * 2;
constexpr size_t OFF_MOD = OFF_WDOWN + (size_t)1024 * 2816 * 2;
constexpr size_t OFF_FILT = OFF_MOD + (size_t)4 * 9 * 6144 * 4;
constexpr size_t OFF_H2 = OFF_FILT + (size_t)2 * 2 * 512 * 4352 * 2;
constexpr size_t OFF_EDGE = OFF_H2 + (size_t)2 * 4352 * 64 * 4;
constexpr size_t OFF_KR = OFF_EDGE + (size_t)640 * 4 * 5632 * 2;
constexpr size_t OFF_A = OFF_KR + (size_t)TK * 64 * 2;
constexpr size_t OFF_B = OFF_A + (size_t)T * 1024 * 2;
constexpr size_t OFF_BAR = OFF_B + (size_t)346030080;
constexpr size_t OFF_ROPE = OFF_BAR + 16384;
constexpr size_t WS_NEED = OFF_ROPE + 64 * 16 * 8;
constexpr size_t A_H = 0, A_Z1 = 0, A_Z2 = (size_t)T * 512 * 2, A_QN = 0, A_CKV = (size_t)T * 512 * 2, A_O = 0;
constexpr size_t B_VT = 0, B_PRT = (size_t)T * 512 * 2, B_MIX = B_PRT + (size_t)T * 1536 * 2;
constexpr size_t B_DQKV = 0, B_Q = 0, B_K = (size_t)T * 1536 * 2, B_V = B_K + (size_t)TK * 1536 * 2;
constexpr size_t B_ACT = 0;
constexpr size_t VT_SAMPLE_OFF = (size_t)32 * 8 * 128 * 256;

struct Params {
  const float* in[36];
  float* out;
  char* ws;
};


constexpr int PARM_OFF = 138240;
struct PV {
  char* smem;
  DI unsigned long long ld(int k) const {
    int off = PARM_OFF + 8 * k;
    asm volatile("" : "+v"(off));
    const unsigned long long v = *(const unsigned long long*)(smem + off);
    const unsigned lo = __builtin_amdgcn_readfirstlane((unsigned)v), hi = __builtin_amdgcn_readfirstlane((unsigned)(v >> 32));
    return ((unsigned long long)hi << 32) | lo;
  }
  DI const float* in(int k) const { return (const float*)(const __attribute__((address_space(1))) float*)ld(k); }
  DI float* out() const { return (float*)(__attribute__((address_space(1))) float*)ld(36); }
  DI char* ws() const { return (char*)(__attribute__((address_space(1))) char*)ld(37); }
};

DI int TIDX() { int t = (int)__builtin_amdgcn_workitem_id_x(); asm volatile("" : "+v"(t)); return t; }
DI u16 f2bf(float x) { unsigned u = __float_as_uint(x); u += 0x7fffu + ((u >> 16) & 1u); return (u16)(u >> 16); }
DI float bf2f(u16 h) { return __uint_as_float(((unsigned)h) << 16); }
DI unsigned pack2(float a, float b) { unsigned r; asm("v_cvt_pk_bf16_f32 %0, %1, %2" : "=v"(r) : "v"(a), "v"(b)); return r; }
DI uint2 pack4(float a, float b, float c, float d) { uint2 r; r.x = pack2(a, b); r.y = pack2(c, d); return r; }
DI float lo16(unsigned w) { return __uint_as_float(w << 16); }
DI float hi16(unsigned w) { return __uint_as_float(w & 0xffff0000u); }
DI float gelu_tanh(float x) { const float y = x * (1.f + 0.044715f * x * x); return x * __builtin_amdgcn_rcpf(1.f + __builtin_amdgcn_exp2f(-2.302208198f * y)); }
DI float silu(float x) { return x * __builtin_amdgcn_rcpf(1.f + __builtin_amdgcn_exp2f(-1.4426950409f * x)); }
DI int condrow(int m) { return m < TP ? 0 : 1 + ((m - TP) >> 12); }
template <int MASK> DI float shx(float v, int lane) {
  if (MASK == 32) return __int_as_float(__builtin_amdgcn_ds_bpermute((lane ^ 32) << 2, __float_as_int(v)));
  return __int_as_float(__builtin_amdgcn_ds_swizzle(__float_as_int(v), (MASK << 10) | 0x1f));
}
DI float wave_sum(float v, int lane) {
  v += shx<32>(v, lane); v += shx<16>(v, lane); v += shx<8>(v, lane);
  v += shx<4>(v, lane); v += shx<2>(v, lane); v += shx<1>(v, lane); return v;
}
DI int opaque_i(int x) { asm volatile("" : "+s"(x)); return x; }
DI int first_unit(int base) { const int G = opaque_i((int)gridDim.x); int r = (int)blockIdx.x - (base % G); if (r < 0) r += G; return r; }
DI const float* xin_row(const PV& p, int l, int m) {
  if (l == 0) return m < TP ? p.in(0) + (size_t)m * 1024 : p.in(1) + (size_t)(m - TP) * 1024;
  return p.out() + (size_t)m * 1024;
}


#define XB_TMO      128
#define XB_XCNT(j)  (256  + 64 * (j))
#define XB_XSUB(j)  (1280 + 64 * (j))
#define XB_XGEN(j)  (2304 + 64 * (j))
#define XB_TOP      3328
#define XB_TOPGEN   3392
#define XB_SPIN_CAP (1u << 22)
#define LASB __attribute__((address_space(3)))
DI unsigned xb_ld(unsigned* p) { return __hip_atomic_load(p, __ATOMIC_RELAXED, __HIP_MEMORY_SCOPE_AGENT); }
DI unsigned xb_add(unsigned* p, unsigned v) { return __hip_atomic_fetch_add(p, v, __ATOMIC_RELAXED, __HIP_MEMORY_SCOPE_AGENT); }
DI unsigned xb_xcc_id() { return (unsigned)__builtin_amdgcn_s_getreg((3 << 11) | 20) & 0xFu; }
#define XB_SPIN(cond, bar) do { unsigned _sp = 0; while (cond) { __builtin_amdgcn_s_sleep(1); \
    if ((++_sp & 255u) == 0u) { if (xb_ld(&(bar)[XB_TMO])) break; if (_sp > XB_SPIN_CAP) { atomicAdd(&(bar)[XB_TMO], 1u); break; } } } } while (0)
struct XcdBarrier { unsigned* bar; unsigned x; volatile LASB unsigned* st; };
DI XcdBarrier xcd_barrier_post(unsigned* bar, volatile LASB unsigned* st) {
  XcdBarrier b; b.bar = bar; b.x = xb_xcc_id(); b.st = st;
  if (TIDX() == 0) (void)xb_add(&bar[XB_XCNT(b.x)], 1u);
  return b;
}
DI void xcd_barrier_complete(unsigned* bar, unsigned x, unsigned& nloc, unsigned& nx) {
  const unsigned G = gridDim.x;
  unsigned sum, cnt, mine, sp = 0u;
  for (;;) {
    sum = 0u; cnt = 0u; mine = 0u;
#pragma unroll
    for (unsigned j = 0; j < 16; ++j) { const unsigned c = xb_ld(&bar[XB_XCNT(j)]); sum += c; cnt += (c > 0u) ? 1u : 0u; mine = (j == x) ? c : mine; }
    if (sum == G) break;
    __builtin_amdgcn_s_sleep(1);
    if ((++sp & 255u) == 0u) { if (xb_ld(&bar[XB_TMO])) break; if (sp > XB_SPIN_CAP) { atomicAdd(&bar[XB_TMO], 1u); break; } }
  }
  nloc = mine > 0u ? mine : 1u; nx = cnt > 0u ? cnt : 1u;
}
DI void xcd_barrier(const XcdBarrier& b) {
  asm volatile("s_waitcnt vmcnt(0)" ::: "memory");
  __syncthreads();
  if (TIDX() == 0) {
    unsigned* bar = b.bar;
    __builtin_amdgcn_s_waitcnt(0);
    unsigned nloc = b.st[0], nx = b.st[1];
    if (nloc == 0u) { xcd_barrier_complete(bar, b.x, nloc, nx); b.st[0] = nloc; b.st[1] = nx; }
    const unsigned old = xb_add(&bar[XB_XSUB(b.x)], 1u);
    const unsigned gen = old / nloc;
    if (old + 1u == (gen + 1u) * nloc) {
      __builtin_amdgcn_fence(__ATOMIC_RELEASE, "agent");
      asm volatile("s_waitcnt vmcnt(0)" ::: "memory");
      const unsigned og = xb_add(&bar[XB_TOP], 1u);
      const unsigned tg = og / nx;
      if (og + 1u == (tg + 1u) * nx) xb_add(&bar[XB_TOPGEN], 1u);
      else XB_SPIN(xb_ld(&bar[XB_TOPGEN]) == tg, bar);
      __builtin_amdgcn_fence(__ATOMIC_ACQUIRE, "agent");
      xb_add(&bar[XB_XGEN(b.x)], 1u);
      asm volatile("s_waitcnt vmcnt(0)" ::: "memory");
    } else {
      XB_SPIN(xb_ld(&bar[XB_XGEN(b.x)]) == gen, bar);
      __builtin_amdgcn_fence(__ATOMIC_ACQUIRE, "agent");
      asm volatile("s_waitcnt vmcnt(0)" ::: "memory");
    }
  }
  __syncthreads();
}

template <int MODE>
DI int rowmap(int n, int row0) {
  if (MODE == 0) return n + row0;
  return n < 2816 ? (n >> 7) * 256 + (n & 127) : ((n - 2816) >> 7) * 256 + 128 + ((n - 2816) & 127);
}
template <int MODE, int NJ = 4>
DI void convT(const float* __restrict__ src, u16* __restrict__ dst, int K, int N, int row0, char* smem, int& base) {
  u16* tl = (u16*)smem;
  const int tid = TIDX();
  const int nN = N / (64 * NJ), nunits = (K >> 6) * nN;
  for (int u = first_unit(base); u < nunits; u += gridDim.x) {
    const int k0 = (u / nN) << 6, n0 = (u % nN) * (64 * NJ);
    float4 v[2][NJ];
#pragma unroll
    for (int i = 0; i < 2; ++i)
#pragma unroll
      for (int j = 0; j < NJ; ++j)
        v[i][j] = *(const float4*)(src + (size_t)(k0 + (tid >> 4) + 32 * i) * N + n0 + (tid & 15) * 4 + 64 * j);
#pragma unroll
    for (int i = 0; i < 2; ++i)
#pragma unroll
      for (int j = 0; j < NJ; ++j) {
        const int r = (tid >> 4) + 32 * i, c4 = (tid & 15) * 4 + 64 * j;
        tl[(c4 + 0) * 72 + r] = f2bf(v[i][j].x); tl[(c4 + 1) * 72 + r] = f2bf(v[i][j].y);
        tl[(c4 + 2) * 72 + r] = f2bf(v[i][j].z); tl[(c4 + 3) * 72 + r] = f2bf(v[i][j].w);
      }
    __syncthreads();
#pragma unroll
    for (int j = 0; j < NJ; ++j) {
      const int n = (tid >> 3) + 64 * j, kc = (tid & 7) * 8;
      const uint4 o = *(const uint4*)(tl + n * 72 + kc);
      *(uint4*)(dst + (size_t)rowmap<MODE>(n0 + n, row0) * K + k0 + kc) = o;
    }
    __syncthreads();
  }
  base += nunits;
}

DI void convert_ffn_weights(const PV& p, int l, char* smem, int& base) {
  convT<1>(p.in(32) + (size_t)l * 1024 * 5632, (u16*)(p.ws() + OFF_WUP), 1024, 5632, 0, smem, base);
  convT<0>(p.in(35) + (size_t)l * 2816 * 1024, (u16*)(p.ws() + OFF_WDOWN), 2816, 1024, 0, smem, base);
}

DI void phase_prep(const PV& p, char* smem) {
  const int tid = TIDX();
  int base = 0;
  char* ws = p.ws();
  for (int i = 0; i < 2; ++i) {
    convT<0>(p.in(9) + (size_t)i * 1024 * 2560, (u16*)(ws + OFF_WMIXIN) + (size_t)i * 2560 * 1024, 1024, 2560, 0, smem, base);
    convT<0>(p.in(22) + (size_t)i * 1024 * 1024, (u16*)(ws + OFF_WMIXOUT) + (size_t)i * 1024 * 1024, 1024, 1024, 0, smem, base);
    convT<0>(p.in(23) + (size_t)i * 1024 * 512, (u16*)(ws + OFF_WDQKV) + (size_t)i * 1024 * 1024, 1024, 512, 0, smem, base);
    convT<0, 1>(p.in(26) + (size_t)i * 1024 * 320, (u16*)(ws + OFF_WDQKV) + (size_t)i * 1024 * 1024, 1024, 320, 512, smem, base);
    convT<0>(p.in(25) + (size_t)i * 512 * 1536, (u16*)(ws + OFF_WUQ) + (size_t)i * 1536 * 512, 512, 1536, 0, smem, base);
    convT<0>(p.in(28) + (size_t)i * 256 * 2048, (u16*)(ws + OFF_WUKV) + (size_t)i * 2048 * 256, 256, 2048, 0, smem, base);
    convT<0>(p.in(31) + (size_t)i * 1024 * 1024, (u16*)(ws + OFF_WO) + (size_t)i * 1024 * 1024, 1024, 1024, 0, smem, base);
  }
  convert_ffn_weights(p, 0, smem, base);
  {
    const long gtid = (long)blockIdx.x * blockDim.x + tid, gsz = (long)gridDim.x * blockDim.x;
    for (long i = gtid; i < 2 * 192 * 1024; i += gsz) {
      const int j = (int)(i / (192 * 1024)), r = (int)(i % (192 * 1024));
      ((u16*)(ws + OFF_WDQKV))[(size_t)j * 1024 * 1024 + (size_t)832 * 1024 + r] = 0;
    }
    for (long i = gtid; i < 2 * 4 * 128 * 128; i += gsz) ((u16*)(ws + OFF_WSGU))[i] = f2bf(p.in(10)[i]);
    for (long i = gtid; i < 64 * 16; i += gsz) {
      const int pos = (int)(i >> 4), f = (int)(i & 15);
      const float inv = exp2f(-(float)f * (13.287712379549449f / 16.f));
      float sn, cs;
      sincosf((float)pos * inv, &sn, &cs);
      ((float2*)(ws + OFF_ROPE))[i] = make_float2(cs, sn);
    }
  }
  {
    float* sc = (float*)smem;
    float* part = sc + 9 * 1024;
    __syncthreads();
    for (int i = tid; i < 9 * 1024; i += 512) {
      const int r = i >> 10, k = i & 1023;
      const float c = r == 0 ? p.in(5)[k] : p.in(4)[(r - 1) * 1024 + k];
      sc[i] = silu(c);
    }
    __syncthreads();
    float* MOD = (float*)(ws + OFF_MOD);
    const int nunits = 4 * 96;
    for (int u = first_unit(base); u < nunits; u += gridDim.x) {
      const int l = u / 96, n0 = (u % 96) * 64;
      const int col = n0 + (tid & 63), kg = tid >> 6;
      float acc[9];
#pragma unroll
      for (int r = 0; r < 9; ++r) acc[r] = 0.f;
      const float* w = p.in(6) + (size_t)l * 1024 * 6144 + col;
#pragma unroll 16
      for (int k = kg * 128; k < kg * 128 + 128; ++k) {
        const float wv = w[(size_t)k * 6144];
#pragma unroll
        for (int r = 0; r < 9; ++r) acc[r] += sc[r * 1024 + k] * wv;
      }
#pragma unroll
      for (int r = 0; r < 9; ++r) part[(kg * 9 + r) * 64 + (tid & 63)] = acc[r];
      __syncthreads();
      for (int i = tid; i < 576; i += 512) {
        const int r = i >> 6, cc = i & 63;
        float s = p.in(7)[l * 6144 + n0 + cc];
#pragma unroll
        for (int g = 0; g < 8; ++g) s += part[(g * 9 + r) * 64 + cc];
        MOD[(size_t)(l * 9 + r) * 6144 + n0 + cc] = s;
      }
      __syncthreads();
    }
    base += nunits;
  }
  {
    float* zf = (float*)smem;
    float* h1 = zf + 8 * 36;
    float* H2 = (float*)(ws + OFF_H2);
    const int nunits = 2 * 544;
    for (int u = first_unit(base); u < nunits; u += gridDim.x) {
      const int i = u / 544, tg0 = (u % 544) * 8;
      __syncthreads();
      if (tid < 8 * 33) {
        const int tt = tid / 33, e = tid % 33;
        const int tg = tg0 + tt;
        const float L = tg < 256 ? 256.f : 4096.f;
        const float t = tg < 256 ? (float)tg : (float)(tg - 256);
        const float tn = t / L;
        float v;
        if (e == 0) v = tn;
        else if (e <= 16) v = sinf((6.283185307179586f * tn) * (float)e);
        else v = cosf((6.283185307179586f * tn) * (float)(e - 16));
        zf[tt * 36 + e] = v;
      }
      __syncthreads();
      const int tt = tid >> 6, jj = tid & 63;
      const float fr = p.in(19)[i * 64 + jj];
      {
        float a = p.in(15)[i * 64 + jj];
        const float* w1 = p.in(14) + (size_t)i * 33 * 64 + jj;
        for (int e = 0; e < 33; ++e) a += zf[tt * 36 + e] * w1[e * 64];
        h1[tt * 64 + jj] = sinf(fr * a);
      }
      __syncthreads();
      {
        float a = p.in(17)[i * 64 + jj];
        const float* w2 = p.in(16) + (size_t)i * 64 * 64 + jj;
        for (int e = 0; e < 64; ++e) a += h1[tt * 64 + e] * w2[e * 64];
        H2[((size_t)i * 4352 + tg0 + tt) * 64 + jj] = sinf(fr * a);
      }
    }
    base += nunits;
    __syncthreads();
  }
}

DI void phase_filters(const PV& p, char* smem) {
  const int tid = TIDX();
  float* w3s = (float*)smem;
  float* red = w3s + 512;
  float* nrm = red + 512;
  float* hbuf = nrm + 8;
  const float* H2 = (const float*)(p.ws() + OFF_H2);
  u16* FILT = (u16*)(p.ws() + OFF_FILT);
  for (int u = blockIdx.x; u < 512; u += gridDim.x) {
    const int kind = (u >> 7) & 1, i = u >> 8, cg8 = (u & 127) * 8;
    const int L = kind ? 4096 : 256, tbase = kind ? 256 : 0;
    __syncthreads();
    { const int j = tid >> 3, cc = tid & 7; w3s[j * 8 + cc] = p.in(18)[((size_t)i * 64 + j) * 1024 + cg8 + cc]; }
    __syncthreads();
    const int cc = tid & 7, tq = tid >> 3;
    const int col = cg8 + cc, o = col >> 9, c = col & 511;
    const float dec = fabsf(p.in(20)[(i * 2 + o) * 512 + c]);
    float asum = 0.f;
    for (int t = tq; t < L; t += 64) {
      const float4* hr = (const float4*)(H2 + ((size_t)i * 4352 + tbase + t) * 64);
      float a = 0.f;
#pragma unroll
      for (int j4 = 0; j4 < 16; ++j4) {
        const float4 hv = hr[j4];
        a += hv.x * w3s[(j4 * 4 + 0) * 8 + cc]; a += hv.y * w3s[(j4 * 4 + 1) * 8 + cc];
        a += hv.z * w3s[(j4 * 4 + 2) * 8 + cc]; a += hv.w * w3s[(j4 * 4 + 3) * 8 + cc];
      }
      const float dist = fabsf((float)(t - L / 2)) / (float)L;
      a *= expf(-dec * dist);
      hbuf[cc * L + t] = a;
      asum += fabsf(a);
    }
    red[tid] = asum;
    __syncthreads();
    if (tid < 8) { float s = 0.f; for (int q = 0; q < 64; ++q) s += red[q * 8 + tid]; nrm[tid] = 1.f / (s + EPS); }
    __syncthreads();
    for (int idx = tid; idx < 8 * L; idx += 512) {
      const int c2 = idx / L, t = idx - c2 * L;
      const int col2 = cg8 + c2, o2 = col2 >> 9, cch = col2 & 511;
      FILT[((size_t)(i * 2 + o2) * 512 + cch) * 4352 + tbase + t] = f2bf(hbuf[c2 * L + t] * nrm[c2]);
    }
  }
  __syncthreads();
}

DI void phase_norm(const PV& p, int l, int part, int lx) {
  const int tid_ = TIDX(); const int lane = tid_ & 63, wid = tid_ >> 6;
  const float* MOD = (const float*)(p.ws() + OFF_MOD);
  const float* g = p.in(8) + (size_t)(l * 2 + part) * 1024;
  u16* H = (u16*)(p.ws() + OFF_A + A_H);
  const int stride = gridDim.x * 8;
  for (int row0 = blockIdx.x * 8 + wid; row0 < T; row0 += 2 * stride) {
    float4 v[2][4];
#pragma unroll
    for (int w = 0; w < 2; ++w) {
      const int row = row0 + w * stride;
      if (row < T) {
        const float* xr = xin_row(p, lx, row);
#pragma unroll
        for (int i = 0; i < 4; ++i) v[w][i] = *(const float4*)(xr + (i * 64 + lane) * 4);
      }
    }
#pragma unroll
    for (int w = 0; w < 2; ++w) {
      const int row = row0 + w * stride;
      if (row < T) {
        float ss = 0.f;
#pragma unroll
        for (int i = 0; i < 4; ++i) ss += v[w][i].x * v[w][i].x + v[w][i].y * v[w][i].y + v[w][i].z * v[w][i].z + v[w][i].w * v[w][i].w;
        ss = wave_sum(ss, lane);
        const float r = rsqrtf(ss * (1.f / 1024.f) + EPS);
        const float* mr = MOD + (size_t)(l * 9 + condrow(row)) * 6144 + part * 3072;
#pragma unroll
        for (int i = 0; i < 4; ++i) {
          const int k = (i * 64 + lane) * 4;
          const float4 gv = *(const float4*)(g + k), sh = *(const float4*)(mr + k), sc = *(const float4*)(mr + 1024 + k);
          const float a = v[w][i].x * r * gv.x * (1.f + sc.x) + sh.x;
          const float b = v[w][i].y * r * gv.y * (1.f + sc.y) + sh.y;
          const float c = v[w][i].z * r * gv.z * (1.f + sc.z) + sh.z;
          const float d = v[w][i].w * r * gv.w * (1.f + sc.w) + sh.w;
          *(uint2*)(H + (size_t)row * 1024 + k) = pack4(a, b, c, d);
        }
      }
    }
  }
}

template <bool SWAP, class Epi, class Pre>
DI void gemm_tile(const u16* A, int lda, const u16* Bt, int ldb, int K, int m0, int n0, char* smem, Epi epi, Pre pre) {
  const int tid = TIDX(), lane = tid & 63, wid = tid >> 6;
  const int wm = wid >> 1, wn = wid & 1, fr = lane & 15, fq = lane >> 4;
  const int lrow = tid >> 3, kc = tid & 7;
  const u16* ga = A + (size_t)(m0 + lrow) * lda + kc * 8;
  const u16* gb = Bt + (size_t)(n0 + lrow) * ldb + kc * 8;
  const int soff = lrow * 128 + ((kc ^ (lrow & 7)) << 4);
  uint4 ra[4], rb[2];
  f32x4 acc[4][4];
#pragma unroll
  for (int i = 0; i < 4; ++i)
#pragma unroll
    for (int j = 0; j < 4; ++j) acc[i][j] = f32x4{0.f, 0.f, 0.f, 0.f};
  const int nk = K >> 6;
#pragma unroll
  for (int i = 0; i < 4; ++i) ra[i] = *(const uint4*)(ga + (size_t)(64 * i) * lda);
#pragma unroll
  for (int i = 0; i < 2; ++i) rb[i] = *(const uint4*)(gb + (size_t)(64 * i) * ldb);
#pragma unroll
  for (int i = 0; i < 4; ++i) *(uint4*)(smem + soff + i * 8192) = ra[i];
#pragma unroll
  for (int i = 0; i < 2; ++i) *(uint4*)(smem + 32768 + soff + i * 8192) = rb[i];
  __syncthreads();
  for (int kt = 0; kt < nk; ++kt) {
    const bool more = kt + 1 < nk;
    if (more) {
      const int k0 = (kt + 1) << 6;
#pragma unroll
      for (int i = 0; i < 4; ++i) ra[i] = *(const uint4*)(ga + (size_t)(64 * i) * lda + k0);
#pragma unroll
      for (int i = 0; i < 2; ++i) rb[i] = *(const uint4*)(gb + (size_t)(64 * i) * ldb + k0);
    }
    const char* sa = smem + (kt & 1) * 49152;
    const char* sb = sa + 32768;
#pragma unroll
    for (int ks = 0; ks < 2; ++ks) {
      bf16x8 af[4], bfv[4];
      const int co = ((ks * 4 + fq) ^ (fr & 7)) << 4;
#pragma unroll
      for (int mi = 0; mi < 4; ++mi) af[mi] = *(const bf16x8*)(sa + (wm * 64 + mi * 16 + fr) * 128 + co);
#pragma unroll
      for (int ni = 0; ni < 4; ++ni) bfv[ni] = *(const bf16x8*)(sb + (wn * 64 + ni * 16 + fr) * 128 + co);
#pragma unroll
      for (int mi = 0; mi < 4; ++mi)
#pragma unroll
        for (int ni = 0; ni < 4; ++ni)
          acc[mi][ni] = SWAP ? __builtin_amdgcn_mfma_f32_16x16x32_bf16(bfv[ni], af[mi], acc[mi][ni], 0, 0, 0)
                             : __builtin_amdgcn_mfma_f32_16x16x32_bf16(af[mi], bfv[ni], acc[mi][ni], 0, 0, 0);
    }
    if (more) {
      char* da = smem + ((kt + 1) & 1) * 49152;
#pragma unroll
      for (int i = 0; i < 4; ++i) *(uint4*)(da + soff + i * 8192) = ra[i];
#pragma unroll
      for (int i = 0; i < 2; ++i) *(uint4*)(da + 32768 + soff + i * 8192) = rb[i];
    }
    __syncthreads();
  }
  uint2 pv[4][4];
#pragma unroll
  for (int mi = 0; mi < 4; ++mi)
#pragma unroll
    for (int ni = 0; ni < 4; ++ni) {
      if (SWAP) pv[mi][ni] = pre(m0 + wm * 64 + mi * 16 + fr, n0 + wn * 64 + ni * 16 + fq * 4);
      else pv[mi][ni] = pre(m0 + wm * 64 + mi * 16 + fq * 4, n0 + wn * 64 + ni * 16 + fr);
    }
#pragma unroll
  for (int mi = 0; mi < 4; ++mi)
#pragma unroll
    for (int ni = 0; ni < 4; ++ni) {
      if (SWAP) epi(m0 + wm * 64 + mi * 16 + fr, n0 + wn * 64 + ni * 16 + fq * 4, acc[mi][ni], pv[mi][ni]);
      else epi(m0 + wm * 64 + mi * 16 + fq * 4, n0 + wn * 64 + ni * 16 + fr, acc[mi][ni], pv[mi][ni]);
    }
}

template <class F>
DI void for_tiles(int nM, int nN, int sm, int sn, F f) {
  if (gridDim.x == 256) {
    const int xcd = blockIdx.x & 7, slot = blockIdx.x >> 3;
    const int am = slot % sm, bn = slot / sm;
    const int nSN = (nN + sn - 1) / sn, nS = (nM / sm) * nSN;
    for (int st = xcd; st < nS; st += 8) {
      const int tm = (st / nSN) * sm + am, tn = (st % nSN) * sn + bn;
      if (tn < nN) f(tm, tn);
    }
  } else {
    for (int t = blockIdx.x; t < nM * nN; t += gridDim.x) f(t / nN, t % nN);
  }
}


#define LAS __attribute__((address_space(3)))
constexpr int G8_HTB = 128 * 64 * 2;
DI int g8_lds_byte(int r, int c) { const int st = (r >> 4) * 2 + (c >> 5), rr = r & 15, cc = c & 31, ob = rr * 64 + cc * 2; return st * 1024 + (ob ^ (((ob >> 9) & 1) << 5)); }
DI void g8_stage_rc(int b, int& R, int& C) { const int st = b / 1024, sb = b % 1024, swz = sb ^ (((sb >> 9) & 1) << 5); R = (st >> 1) * 16 + swz / 64; C = (st & 1) * 32 + (swz % 64) / 2; }
template <int NM, int NN, int NN1, int SM1, int SN1, int SM2, int SN2>
struct TileSched {
  static constexpr int nSN1 = NN1 / SN1, nS1 = (NM / SM1) * nSN1, nSN2 = (NN - NN1) / SN2, nS2 = (NM / SM2) * nSN2, nT = NM * NN;
  int c;
  DI void init() { c = blockIdx.x; }
  DI bool next(int i, int& pm, int& pn) const {
    if (gridDim.x == 256) {
      const int xcd = c & 7, slot = c >> 3;
      int st = xcd + 8 * i;
      if (st < nS1) { pm = (st / nSN1) * SM1 + slot % SM1; pn = (st % nSN1) * SN1 + slot / SM1; return true; }
      st -= nS1;
      if (nS2 == 0 || st >= nS2) return false;
      pm = (st / (nSN2 > 0 ? nSN2 : 1)) * SM2 + slot % SM2; pn = NN1 + (st % (nSN2 > 0 ? nSN2 : 1)) * SN2 + slot / SM2; return true;
    }
    const int L = i * (int)gridDim.x + c; if (L >= nT) return false; pm = L / NN; pn = L % NN; return true;
  }
};
template <bool ABLK = false, class Sched, class Epi>
DI void gemm8(char* smem, const u16* A, const u16* Bt, int K, const Sched& S, const Epi& E) {
  LAS unsigned char* lds = (LAS unsigned char*)smem;
  const int tid = TIDX(), wid = __builtin_amdgcn_readfirstlane(tid >> 6), lane = tid & 63, wr = wid >> 2, wc = wid & 3, fr = lane & 15, fq = lane >> 4;
  const int nt = K / 64;
  unsigned voff[2], voffA[2];
#pragma unroll
  for (int i = 0; i < 2; ++i) { int R, C; g8_stage_rc(tid * 16 + i * 8192, R, C); voff[i] = (unsigned)(R * K + C) * 2u; voffA[i] = ABLK ? (unsigned)(R * 64 + C) * 2u : voff[i]; }
  const size_t kstep = 128, hstep = (size_t)128 * K * 2, tstep = 2 * hstep;
  const size_t kstepA = ABLK ? 32768 : kstep, hstepA = ABLK ? 16384 : hstep;
  const unsigned ldsw = (unsigned)wid * 1024u;
  const int aoff = g8_lds_byte(wr * 64 + fr, fq * 8), boff = g8_lds_byte(wc * 32 + fr, fq * 8);
#define G8_SA(b, h) (((b) * 2 + (h)) * G8_HTB)
#define G8_SB(b, h) ((4 + (b) * 2 + (h)) * G8_HTB)
#define G8_STAGE(bufoff, gbase) do { _Pragma("unroll") for (int _i = 0; _i < 2; ++_i) \
    __builtin_amdgcn_global_load_lds((const unsigned*)((const char*)(gbase) + voff[_i]), (LAS unsigned*)(lds + (bufoff) + ldsw + _i * 8192), 16, 0, 0); } while (0)
#define G8_STAGEA(bufoff, gbase) do { _Pragma("unroll") for (int _i = 0; _i < 2; ++_i) \
    __builtin_amdgcn_global_load_lds((const unsigned*)((const char*)(gbase) + voffA[_i]), (LAS unsigned*)(lds + (bufoff) + ldsw + _i * 8192), 16, 0, 0); } while (0)
#define G8_LDA(dst, b, h) do { _Pragma("unroll") for (int m = 0; m < 4; ++m) _Pragma("unroll") for (int k = 0; k < 2; ++k) dst[m][k] = *(const LAS bf16x8*)(lds + G8_SA(b, h) + aoff + m * 2048 + k * 1024); } while (0)
#define G8_LDB(dst, b, h) do { _Pragma("unroll") for (int n = 0; n < 2; ++n) _Pragma("unroll") for (int k = 0; k < 2; ++k) dst[n][k] = *(const LAS bf16x8*)(lds + G8_SB(b, h) + boff + n * 2048 + k * 1024); } while (0)
#define G8_MMA(ai, bj, At_, Bt_) do { __builtin_amdgcn_s_setprio(1); _Pragma("unroll") for (int m = 0; m < 4; ++m) _Pragma("unroll") for (int n = 0; n < 2; ++n) _Pragma("unroll") for (int k = 0; k < 2; ++k) \
    acc[ai][bj][m][n] = __builtin_amdgcn_mfma_f32_16x16x32_bf16(Bt_[n][k], At_[m][k], acc[ai][bj][m][n], 0, 0, 0); __builtin_amdgcn_s_setprio(0); } while (0)
#define G8_WAIT_V(n) asm volatile("s_waitcnt vmcnt(" #n ")" ::: "memory")
#define G8_WAIT_L(n) asm volatile("s_waitcnt lgkmcnt(" #n ")" ::: "memory")
#define G8_BAR __builtin_amdgcn_s_barrier()
#define G8_SCHED __builtin_amdgcn_sched_barrier(0)
  int cpm, cpn, npm = 0, npn = 0, ui = 0;
  if (!S.next(0, cpm, cpn)) return;
  f32x4 acc[2][2][4][2];
#pragma unroll
  for (int a = 0; a < 2; ++a)
#pragma unroll
    for (int b = 0; b < 2; ++b)
#pragma unroll
      for (int m = 0; m < 4; ++m)
#pragma unroll
        for (int n = 0; n < 2; ++n) acc[a][b][m][n] = f32x4{0.f, 0.f, 0.f, 0.f};
  bf16x8 At[4][2], B0[2][2], B1[2][2];
  const char* cA = (const char*)A + (size_t)cpm * tstep; const char* cB = (const char*)Bt + (size_t)cpn * tstep;
  G8_STAGE(G8_SB(0, 0), cB); G8_STAGEA(G8_SA(0, 0), cA); G8_STAGE(G8_SB(0, 1), cB + hstep); G8_STAGEA(G8_SA(0, 1), cA + hstepA);
  if (wr == 1) G8_BAR;
  G8_WAIT_V(4); G8_BAR;
  G8_STAGE(G8_SB(1, 0), cB + kstep); G8_STAGEA(G8_SA(1, 0), cA + kstepA); G8_STAGE(G8_SB(1, 1), cB + hstep + kstep);
  G8_WAIT_V(6); G8_BAR;
  for (;;) {
    const bool has_next = S.next(ui + 1, npm, npn);
    const char* nA = has_next ? (const char*)A + (size_t)npm * tstep : cA; const char* nB = has_next ? (const char*)Bt + (size_t)npn * tstep : cB;
#pragma unroll 1
    for (int t = 0; t < nt; t += 2) {
      const bool last = (t == nt - 2);
      const char* a1 = cA + (size_t)(t + 1) * kstepA;
      const char* a2 = last ? nA : cA + (size_t)(t + 2) * kstepA; const char* b2 = last ? nB : cB + (size_t)(t + 2) * kstep;
      const char* a3 = a2 + kstepA; const char* b3 = b2 + kstep;
      G8_LDB(B0, 0, 0); G8_SCHED; G8_LDA(At, 0, 0); G8_STAGEA(G8_SA(1, 1), a1 + hstepA);
      G8_WAIT_L(8); G8_BAR; G8_WAIT_L(0); G8_MMA(0, 0, At, B0); G8_BAR; G8_SCHED;
      G8_LDB(B1, 0, 1); G8_STAGE(G8_SB(0, 0), b2);
      G8_BAR; G8_WAIT_L(0); G8_MMA(0, 1, At, B1); G8_BAR;
      G8_LDA(At, 0, 1); G8_STAGEA(G8_SA(0, 0), a2);
      G8_BAR; G8_WAIT_L(0); G8_MMA(1, 0, At, B0); G8_BAR; G8_SCHED;
      G8_STAGE(G8_SB(0, 1), b2 + hstep);
      G8_WAIT_V(6); G8_BAR; G8_MMA(1, 1, At, B1); G8_BAR;
      G8_LDB(B0, 1, 0); G8_SCHED; G8_LDA(At, 1, 0); G8_STAGEA(G8_SA(0, 1), a2 + hstepA);
      G8_WAIT_L(8); G8_BAR; G8_WAIT_L(0); G8_MMA(0, 0, At, B0); G8_BAR; G8_SCHED;
      G8_LDB(B1, 1, 1); G8_STAGE(G8_SB(1, 0), b3);
      G8_BAR; G8_WAIT_L(0); G8_MMA(0, 1, At, B1); G8_BAR;
      G8_LDA(At, 1, 1); G8_STAGEA(G8_SA(1, 0), a3);
      G8_BAR; G8_WAIT_L(0); G8_MMA(1, 0, At, B0); G8_BAR; G8_SCHED;
      G8_STAGE(G8_SB(1, 1), b3 + hstep);
      G8_WAIT_V(6); G8_BAR; G8_MMA(1, 1, At, B1); G8_BAR;
    }
    { const int t2 = TIDX(), w2 = __builtin_amdgcn_readfirstlane(t2 >> 6), l2 = t2 & 63; E(acc, cpm, cpn, w2 >> 2, w2 & 3, l2 & 15, l2 >> 4); }
    if (!has_next) break;
#pragma unroll
    for (int a = 0; a < 2; ++a)
#pragma unroll
      for (int b = 0; b < 2; ++b)
#pragma unroll
        for (int m = 0; m < 4; ++m)
#pragma unroll
          for (int n = 0; n < 2; ++n) acc[a][b][m][n] = f32x4{0.f, 0.f, 0.f, 0.f};
    cpm = npm; cpn = npn; cA = nA; cB = nB; ++ui;
  }
  G8_WAIT_V(0);
  if (wr == 0) G8_BAR;
  G8_BAR;
#undef G8_SA
#undef G8_SB
#undef G8_STAGE
#undef G8_STAGEA
#undef G8_LDA
#undef G8_LDB
#undef G8_MMA
#undef G8_WAIT_V
#undef G8_WAIT_L
#undef G8_BAR
#undef G8_SCHED
}
template <bool ABLK, class Epi>
DI void gemm_half(char* smem, const u16* A, const u16* Bt, int K, int pm, int pn, int nh, const Epi& E) {
  LAS unsigned char* lds = (LAS unsigned char*)smem;
  const int tid = TIDX(), wid = __builtin_amdgcn_readfirstlane(tid >> 6), lane = tid & 63, wr = wid >> 2, wc = wid & 3, fr = lane & 15, fq = lane >> 4;
  const int nt = K / 64;
  unsigned voff[2], voffA[2];
#pragma unroll
  for (int i = 0; i < 2; ++i) { int R, C; g8_stage_rc(tid * 16 + i * 8192, R, C); voff[i] = (unsigned)(R * K + C) * 2u; voffA[i] = ABLK ? (unsigned)(R * 64 + C) * 2u : voff[i]; }
  const size_t kstep = 128, hstep = (size_t)128 * K * 2, tstep = 2 * hstep;
  const size_t kstepA = ABLK ? 32768 : kstep, hstepA = ABLK ? 16384 : hstep;
  const unsigned ldsw = (unsigned)wid * 1024u;
  const int aoff = g8_lds_byte(wr * 64 + fr, fq * 8), boff = g8_lds_byte(wc * 32 + fr, fq * 8);
  const char* cA = (const char*)A + (size_t)pm * tstep;
  const char* cB = (const char*)Bt + (size_t)pn * tstep + (size_t)nh * hstep;
#define GH_STAGE(s_, kt_) do { _Pragma("unroll") for (int _i = 0; _i < 2; ++_i) { \
    __builtin_amdgcn_global_load_lds((const unsigned*)(cB + (size_t)(kt_) * kstep + voff[_i]), (LAS unsigned*)(lds + (s_) * 49152 + ldsw + _i * 8192), 16, 0, 0); \
    __builtin_amdgcn_global_load_lds((const unsigned*)(cA + (size_t)(kt_) * kstepA + voffA[_i]), (LAS unsigned*)(lds + (s_) * 49152 + 16384 + ldsw + _i * 8192), 16, 0, 0); \
    __builtin_amdgcn_global_load_lds((const unsigned*)(cA + hstepA + (size_t)(kt_) * kstepA + voffA[_i]), (LAS unsigned*)(lds + (s_) * 49152 + 32768 + ldsw + _i * 8192), 16, 0, 0); } } while (0)
  f32x4 acc[2][4][2];
#pragma unroll
  for (int a = 0; a < 2; ++a)
#pragma unroll
    for (int m = 0; m < 4; ++m)
#pragma unroll
      for (int n = 0; n < 2; ++n) acc[a][m][n] = f32x4{0.f, 0.f, 0.f, 0.f};
  __syncthreads();
  GH_STAGE(0, 0);
  asm volatile("s_waitcnt vmcnt(0)" ::: "memory");
  __syncthreads();
#pragma unroll 1
  for (int kt = 0; kt < nt; ++kt) {
    if (kt + 1 < nt) GH_STAGE((kt + 1) & 1, kt + 1);
    const LAS unsigned char* base = lds + (kt & 1) * 49152;
    bf16x8 B0[2][2];
#pragma unroll
    for (int n = 0; n < 2; ++n)
#pragma unroll
      for (int k = 0; k < 2; ++k) B0[n][k] = *(const LAS bf16x8*)(base + boff + n * 2048 + k * 1024);
#pragma unroll
    for (int ai = 0; ai < 2; ++ai) {
      bf16x8 At[4][2];
#pragma unroll
      for (int m = 0; m < 4; ++m)
#pragma unroll
        for (int k = 0; k < 2; ++k) At[m][k] = *(const LAS bf16x8*)(base + 16384 + ai * 16384 + aoff + m * 2048 + k * 1024);
#pragma unroll
      for (int m = 0; m < 4; ++m)
#pragma unroll
        for (int n = 0; n < 2; ++n)
#pragma unroll
          for (int k = 0; k < 2; ++k) acc[ai][m][n] = __builtin_amdgcn_mfma_f32_16x16x32_bf16(B0[n][k], At[m][k], acc[ai][m][n], 0, 0, 0);
    }
    asm volatile("s_waitcnt vmcnt(0)" ::: "memory");
    __syncthreads();
  }
#undef GH_STAGE
  E(acc, pm, pn, nh, wr, wc, fr, fq);
}

template <class F> struct ElemEpi {
  F f;
  DI void operator()(const f32x4 (&acc)[2][2][4][2], int pm, int pn, int wr, int wc, int fr, int fq) const {
    const int row0 = pm * 256 + wr * 64 + fr, col0 = pn * 256 + wc * 32 + 4 * fq;
#pragma unroll
    for (int ai = 0; ai < 2; ++ai)
#pragma unroll
      for (int m = 0; m < 4; ++m)
#pragma unroll
        for (int bj = 0; bj < 2; ++bj)
#pragma unroll
          for (int n = 0; n < 2; ++n) f(row0 + ai * 128 + m * 16, col0 + bj * 128 + n * 16, acc[ai][bj][m][n]);
  }
};
template <class F> DI ElemEpi<F> make_epi(F f) { return ElemEpi<F>{f}; }
template <int NM, int NN, int NN1, int SM1, int SN1, int SM2, int SN2, class F>
DI void gemm8_job(char* smem, const u16* A, const u16* Bt, int K, F f) {
  TileSched<NM, NN, NN1, SM1, SN1, SM2, SN2> S; S.init();
  gemm8(smem, A, Bt, K, S, make_epi(f));
}

DI void phase_mix_in(const PV& p, int i, char* smem) {
  const u16* H = (const u16*)(p.ws() + OFF_A + A_H);
  const u16* W = (const u16*)(p.ws() + OFF_WMIXIN) + (size_t)i * 2560 * 1024;
  u16* MIX = (u16*)(p.ws() + OFF_B + B_MIX);
  u16* VT = (u16*)(p.ws() + OFF_B + B_VT);
  u16* PRT = (u16*)(p.ws() + OFF_B + B_PRT);
  auto epi = [=](int m, int n, f32x4 v) {
    if (n < 512) {
      *(uint2*)(MIX + (size_t)m * 1024 + n) = pack4(gelu_tanh(v[0]), gelu_tanh(v[1]), gelu_tanh(v[2]), gelu_tanh(v[3]));
    } else if (n < 1024) {
      const int nn = n - 512, g = nn >> 7, c = nn & 127, chunk = m >> 7, q = m & 127;
      u16* b = VT + ((size_t)(g * 320 + chunk) * 128 + c) * 128 + q;
#pragma unroll
      for (int j = 0; j < 4; ++j) b[j * 128] = f2bf(gelu_tanh(v[j]));
    } else {
      const int cp = n - 1024;
      size_t off; int stride;
      if (m < TP) { off = (size_t)(m & ~255) * 1536 + (size_t)cp * 256 + (m & 255); stride = 256; }
      else { const int mm = m - TP; off = (size_t)(TP + (mm & ~4095)) * 1536 + (size_t)cp * 4096 + (mm & 4095); stride = 4096; }
#pragma unroll
      for (int j = 0; j < 4; ++j) PRT[off + (size_t)j * stride] = f2bf(v[j]);
    }
  };
  gemm8_job<160, 10, 8, 8, 4, 16, 2>(smem, H, W, 1024, epi);
}

DI void phase_sgu(const PV& p, int i, char* smem) {
  const u16* VT = (const u16*)(p.ws() + OFF_B + B_VT);
  const u16* W = (const u16*)(p.ws() + OFF_WSGU) + (size_t)i * 4 * 16384;
  u16* MIX = (u16*)(p.ws() + OFF_B + B_MIX);
  const float* sb = p.in(11) + i * 512;
  for (int u = blockIdx.x; u < 640; u += gridDim.x) {
    const int g = u / 160, tm = u % 160;
    auto epi = [=](int m, int n, f32x4 v, uint2 uu) {
      const int chunk = m >> 7, c = m & 127;
      const int t = chunk * 128 + n;
      const float bias = sb[g * 128 + n];
      u16* dst = MIX + (size_t)t * 1024 + g * 128 + c;
      *(uint2*)dst = pack4(lo16(uu.x) * (v[0] + bias), hi16(uu.x) * (v[1] + bias), lo16(uu.y) * (v[2] + bias), hi16(uu.y) * (v[3] + bias));
    };
    auto pre = [=](int m, int n) { return *(const uint2*)(MIX + (size_t)((m >> 7) * 128 + n) * 1024 + g * 128 + (m & 127)); };
    gemm_tile<false>(VT + (size_t)g * 320 * 128 * 128, 128, W + (size_t)g * 16384, 128, 128, tm * 256, 0, smem, epi, pre);
  }
}

DI size_t prt_off(int kind, int b, int cp) {
  return kind ? (size_t)(TP + b * 4096) * 1536 + (size_t)cp * 4096 : (size_t)(b * 256) * 1536 + (size_t)cp * 256;
}
DI size_t zt_off(int kind, int b, int c) {
  return kind ? (size_t)(TP + b * 4096) * 512 + (size_t)c * 4096 : (size_t)(b * 256) * 512 + (size_t)c * 256;
}
DI void phase_conv(const PV& p, int i, int ord, char* smem) {
  const int tid = TIDX(), lane = tid & 63, wid = tid >> 6;
  const u16* PRT = (const u16*)(p.ws() + OFF_B + B_PRT);
  const u16* FILT = (const u16*)(p.ws() + OFF_FILT);
  const u16* Z1 = (const u16*)(p.ws() + OFF_A + A_Z1);
  u16* ZO = (u16*)(p.ws() + OFF_A + (ord ? A_Z2 : A_Z1));
  const float* cw = p.in(12) + (size_t)i * 3 * 1536;
  const float* cb = p.in(13) + (size_t)i * 1536;
  u16* hc = (u16*)smem;
  char* Ub = smem + 68096;
  for (int u = blockIdx.x; u < 1024; u += gridDim.x) {
    const int kind = u < 512 ? 1 : 0, c = u & 511;
    const int L = kind ? 4096 : 256, NB = kind ? 8 : 32, LB = L >> 6, DD = L >> 7;
    const int US = (L + 8) * 2;
    const size_t fbase = ((size_t)(i * 2 + ord) * 512 + c) * 4352 + (kind ? 256 : 0);
    __syncthreads();
    {
      u16* tmp = (u16*)Ub;
      for (int idx = tid; idx < (L >> 3); idx += 512) *(uint4*)(tmp + idx * 8) = *(const uint4*)(FILT + fbase + idx * 8);
      __syncthreads();
      for (int idx = tid; idx < 8 * (L + 136); idx += 512) {
        const int cpy = idx / (L + 136), m = idx - cpy * (L + 136);
        const int x = L + 63 - m - cpy;
        hc[cpy * 4256 + m] = (x >= 0 && x < L) ? tmp[x] : (u16)0;
      }
      __syncthreads();
    }
    {
      const int ncr = L >> 3, total = NB * ncr;
      const float w0 = cw[c], w1 = cw[1536 + c], w2 = cw[3072 + c], bb = cb[c];
      for (int id = tid; id < total; id += 512) {
        const int b = id / ncr, t = (id - b * ncr) * 8;
        uint4 o;
        if (ord == 0) {
          const u16* src = PRT + prt_off(kind, b, c) + t;
          const uint4 raw = *(const uint4*)src;
          float e[10];
          e[0] = t > 0 ? bf2f(src[-1]) : 0.f;
          e[9] = t + 8 < L ? bf2f(src[8]) : 0.f;
          e[1] = lo16(raw.x); e[2] = hi16(raw.x); e[3] = lo16(raw.y); e[4] = hi16(raw.y);
          e[5] = lo16(raw.z); e[6] = hi16(raw.z); e[7] = lo16(raw.w); e[8] = hi16(raw.w);
          float r[8];
#pragma unroll
          for (int k = 0; k < 8; ++k) r[k] = w0 * e[k] + w1 * e[k + 1] + w2 * e[k + 2] + bb;
          o.x = pack2(r[0], r[1]); o.y = pack2(r[2], r[3]); o.z = pack2(r[4], r[5]); o.w = pack2(r[6], r[7]);
        } else {
          o = *(const uint4*)(Z1 + zt_off(kind, b, c) + t);
        }
        *(uint4*)(Ub + b * US + t * 2) = o;
      }
    }
    __syncthreads();
    const int ncols = LB * NB;
    if (wid * 64 < ncols) {
      const int il = lane & 31, q = lane >> 5;
      int t1c[2], bc[2];
#pragma unroll
      for (int nt = 0; nt < 2; ++nt) { const int col = wid * 64 + nt * 32 + il; t1c[nt] = col / NB; bc[nt] = col % NB; }
      const int t1lo = (wid * 64) / NB, t1hi = (wid * 64 + 63) / NB;
      const int dlo = max(-DD, t1lo - (LB - 1)), dhi = min(DD, t1hi);
      const int cpy = 7 - (il & 7);
      const char* abase = (const char*)hc + cpy * 8512 + 2 * (L / 2 + 63 - il - cpy + 8 * q);
      f32x16 acc[2][2];
#pragma unroll
      for (int a = 0; a < 2; ++a)
#pragma unroll
        for (int b = 0; b < 2; ++b)
#pragma unroll
          for (int r = 0; r < 16; ++r) acc[a][b][r] = 0.f;
      for (int d = dlo; d <= dhi; ++d) {
        bf16x8 bfr[2][4];
#pragma unroll
        for (int nt = 0; nt < 2; ++nt) {
          const int s1 = t1c[nt] - d;
          const bool valid = s1 >= 0 && s1 < LB;
          const char* bp = Ub + bc[nt] * US + ((valid ? s1 : 0) * 64 + 8 * q) * 2;
#pragma unroll
          for (int ks = 0; ks < 4; ++ks) {
            bf16x8 v = *(const bf16x8*)(bp + ks * 32);
            if (!valid) v = bf16x8{0, 0, 0, 0, 0, 0, 0, 0};
            bfr[nt][ks] = v;
          }
        }
#pragma unroll
        for (int mt = 0; mt < 2; ++mt)
#pragma unroll
          for (int ks = 0; ks < 4; ++ks) {
            const bf16x8 af = *(const bf16x8*)(abase + 2 * (-64 * d - 32 * mt + 16 * ks));
#pragma unroll
            for (int nt = 0; nt < 2; ++nt) acc[mt][nt] = __builtin_amdgcn_mfma_f32_32x32x16_bf16(af, bfr[nt][ks], acc[mt][nt], 0, 0, 0);
          }
      }
      const float dsk = p.in(21)[(i * 2 + ord) * 512 + c];
      const int gc = 512 * (ord + 1) + c;
      const float w0 = cw[gc], w1 = cw[1536 + gc], w2 = cw[3072 + gc], bb = cb[gc];
#pragma unroll
      for (int nt = 0; nt < 2; ++nt) {
        const int b = bc[nt];
        const u16* xrow = PRT + prt_off(kind, b, gc);
        u16* orow = ZO + zt_off(kind, b, c);
#pragma unroll
        for (int mt = 0; mt < 2; ++mt)
#pragma unroll
          for (int g = 0; g < 4; ++g) {
            const int t = 64 * t1c[nt] + mt * 32 + 8 * g + 4 * q;
            const uint2 uu = *(const uint2*)(Ub + b * US + t * 2);
            const uint2 xx = *(const uint2*)(xrow + t);
            const float em = t > 0 ? bf2f(xrow[t - 1]) : 0.f;
            const float ep = t + 4 < L ? bf2f(xrow[t + 4]) : 0.f;
            const float e0 = lo16(xx.x), e1 = hi16(xx.x), e2 = lo16(xx.y), e3 = hi16(xx.y);
            const float x0 = w0 * em + w1 * e0 + w2 * e1 + bb;
            const float x1 = w0 * e0 + w1 * e1 + w2 * e2 + bb;
            const float x2 = w0 * e1 + w1 * e2 + w2 * e3 + bb;
            const float x3 = w0 * e2 + w1 * e3 + w2 * ep + bb;
            const float y0 = acc[mt][nt][4 * g + 0] + lo16(uu.x) * dsk;
            const float y1 = acc[mt][nt][4 * g + 1] + hi16(uu.x) * dsk;
            const float y2 = acc[mt][nt][4 * g + 2] + lo16(uu.y) * dsk;
            const float y3 = acc[mt][nt][4 * g + 3] + hi16(uu.y) * dsk;
            *(uint2*)(orow + t) = pack4(x0 * y0, x1 * y1, x2 * y2, x3 * y3);
          }
      }
    }
  }
  __syncthreads();
}

DI void phase_ztrans(const PV& p, char* smem) {
  const int tid = TIDX();
  const u16* Z2 = (const u16*)(p.ws() + OFF_A + A_Z2);
  u16* MIX = (u16*)(p.ws() + OFF_B + B_MIX);
  u16* tl = (u16*)smem;
  for (int u4 = blockIdx.x * 4; u4 < 640 * 8; u4 += gridDim.x * 4) {
    const int tt0 = (u4 >> 3) * 64;
    const int kind = tt0 >= TP ? 1 : 0;
    const int b = kind ? (tt0 - TP) >> 12 : tt0 >> 8;
    const int tl0 = kind ? (tt0 - TP) & 4095 : tt0 & 255;
    __syncthreads();
    { const int c = tid >> 3, ch = tid & 7;
      uint4 v[4];
#pragma unroll
      for (int w = 0; w < 4; ++w) v[w] = *(const uint4*)(Z2 + zt_off(kind, b, ((u4 + w) & 7) * 64 + c) + tl0 + ch * 8);
#pragma unroll
      for (int w = 0; w < 4; ++w) *(uint4*)(tl + w * 4608 + c * 72 + ch * 8) = v[w]; }
    __syncthreads();
    { const int tr = tid >> 3, cc = (tid & 7) * 8;
#pragma unroll
      for (int w = 0; w < 4; ++w) {
        const u16* tw = tl + w * 4608;
        uint4 o;
        o.x = (unsigned)tw[(cc + 0) * 72 + tr] | ((unsigned)tw[(cc + 1) * 72 + tr] << 16);
        o.y = (unsigned)tw[(cc + 2) * 72 + tr] | ((unsigned)tw[(cc + 3) * 72 + tr] << 16);
        o.z = (unsigned)tw[(cc + 4) * 72 + tr] | ((unsigned)tw[(cc + 5) * 72 + tr] << 16);
        o.w = (unsigned)tw[(cc + 6) * 72 + tr] | ((unsigned)tw[(cc + 7) * 72 + tr] << 16);
        *(uint4*)(MIX + (size_t)(tt0 + tr) * 1024 + 512 + ((u4 + w) & 7) * 64 + cc) = o;
      } }
  }
  __syncthreads();
}

struct EpiResid {
  float* X; const float* x0; const float* x1; const float* gate; int lx;
  DI void operator()(const f32x4 (&acc)[2][2][4][2], int pm, int pn, int wr, int wc, int fr, int fq) const {
    const int rowt = pm * 256, col0 = pn * 256 + wc * 32 + 4 * fq;
    const float* gr = gate + (size_t)condrow(rowt) * 6144 + col0;
    const float* xb = lx == 0 ? (rowt < TP ? x0 + (size_t)rowt * 1024 : x1 + (size_t)(rowt - TP) * 1024) : X + (size_t)rowt * 1024;
    float4 g[2][2];
#pragma unroll
    for (int bj = 0; bj < 2; ++bj)
#pragma unroll
      for (int n = 0; n < 2; ++n) g[bj][n] = *(const float4*)(gr + bj * 128 + n * 16);
#pragma unroll
    for (int ai = 0; ai < 2; ++ai)
#pragma unroll
      for (int mh = 0; mh < 2; ++mh) {
        float4 xo[2][2][2];
#pragma unroll
        for (int mm = 0; mm < 2; ++mm)
#pragma unroll
          for (int bj = 0; bj < 2; ++bj)
#pragma unroll
            for (int n = 0; n < 2; ++n)
              xo[mm][bj][n] = *(const float4*)(xb + (size_t)(wr * 64 + fr + ai * 128 + (2 * mh + mm) * 16) * 1024 + col0 + bj * 128 + n * 16);
#pragma unroll
        for (int mm = 0; mm < 2; ++mm)
#pragma unroll
          for (int bj = 0; bj < 2; ++bj)
#pragma unroll
            for (int n = 0; n < 2; ++n) {
              const f32x4 v = acc[ai][bj][2 * mh + mm][n];
              const float4 x = xo[mm][bj][n], gg = g[bj][n];
              float4 o; o.x = x.x + gg.x * v[0]; o.y = x.y + gg.y * v[1]; o.z = x.z + gg.z * v[2]; o.w = x.w + gg.w * v[3];
              *(float4*)(X + (size_t)(rowt + wr * 64 + fr + ai * 128 + (2 * mh + mm) * 16) * 1024 + col0 + bj * 128 + n * 16) = o;
            }
      }
  }
};
struct EpiResidHalf {
  float* X; const float* x0; const float* x1; const float* gate; int lx;
  DI void operator()(const f32x4 (&acc)[2][4][2], int pm, int pn, int nh, int wr, int wc, int fr, int fq) const {
    const int rowt = pm * 256, col0 = pn * 256 + nh * 128 + wc * 32 + 4 * fq;
    const float* gr = gate + (size_t)condrow(rowt) * 6144 + col0;
    const float* xb = lx == 0 ? (rowt < TP ? x0 + (size_t)rowt * 1024 : x1 + (size_t)(rowt - TP) * 1024) : X + (size_t)rowt * 1024;
    float4 g[2];
#pragma unroll
    for (int n = 0; n < 2; ++n) g[n] = *(const float4*)(gr + n * 16);
#pragma unroll
    for (int ai = 0; ai < 2; ++ai) {
      float4 xo[4][2];
#pragma unroll
      for (int m = 0; m < 4; ++m)
#pragma unroll
        for (int n = 0; n < 2; ++n) xo[m][n] = *(const float4*)(xb + (size_t)(wr * 64 + fr + ai * 128 + m * 16) * 1024 + col0 + n * 16);
#pragma unroll
      for (int m = 0; m < 4; ++m)
#pragma unroll
        for (int n = 0; n < 2; ++n) {
          const f32x4 v = acc[ai][m][n];
          const float4 x = xo[m][n], gg = g[n];
          float4 o; o.x = x.x + gg.x * v[0]; o.y = x.y + gg.y * v[1]; o.z = x.z + gg.z * v[2]; o.w = x.w + gg.w * v[3];
          *(float4*)(X + (size_t)(rowt + wr * 64 + fr + ai * 128 + m * 16) * 1024 + col0 + n * 16) = o;
        }
    }
  }
};
struct ResidSched2 {
  int c;
  DI void init() { c = blockIdx.x; }
  DI bool next(int i, int& pm, int& pn) const {
    if (gridDim.x == 256) {
      const int st = (c & 7) + 8 * i;
      if (st >= 16) return false;
      pm = st * 8 + ((c >> 3) & 7); pn = c >> 6; return true;
    }
    const int L = i * (int)gridDim.x + c; if (L >= 640) return false; pm = L >> 2; pn = L & 3; return true;
  }
};
DI void phase_resid_gemm(const PV& p, int l, int lx, const u16* A, int K, const u16* W, int goff, char* smem) {
  EpiResid E;
  E.X = p.out(); E.x0 = p.in(0); E.x1 = p.in(1); E.gate = (const float*)(p.ws() + OFF_MOD) + (size_t)l * 9 * 6144 + goff; E.lx = lx;
  ResidSched2 S; S.init();
  if (K == 2816) gemm8<true>(smem, A, W, K, S, E);
  else gemm8<false>(smem, A, W, K, S, E);
  if (gridDim.x == 256) {
    EpiResidHalf EH; EH.X = E.X; EH.x0 = E.x0; EH.x1 = E.x1; EH.gate = E.gate; EH.lx = lx;
    const int xcd = blockIdx.x & 7, slot = blockIdx.x >> 3;
    const int st = 16 + (xcd >> 1), ti = (xcd & 1) * 16 + (slot >> 1), nh = slot & 1;
    const int pm = st * 8 + (ti & 7), pn = ti >> 3;
    if (K == 2816) gemm_half<true>(smem, A, W, K, pm, pn, nh, EH);
    else gemm_half<false>(smem, A, W, K, pm, pn, nh, EH);
  }
}

DI void phase_dqkv(const PV& p, int j, char* smem) {
  const u16* H = (const u16*)(p.ws() + OFF_A + A_H);
  const u16* W = (const u16*)(p.ws() + OFF_WDQKV) + (size_t)j * 1024 * 1024;
  u16* DQKV = (u16*)(p.ws() + OFF_B + B_DQKV);
  u16* KR = (u16*)(p.ws() + OFF_KR);
  float* okr = p.out() + 46137344;
  auto epi = [=](int m, int n, f32x4 v) {
    if (n < 832) {
      const uint2 pk = pack4(v[0], v[1], v[2], v[3]);
      *(uint2*)(DQKV + (size_t)m * 896 + n) = pk;
      if (n >= 768) {
        const int e = n - 768;
        *(uint2*)(KR + (size_t)m * 64 + e) = pk;
        if (m < TP) {
          float4 o; o.x = v[0]; o.y = v[1]; o.z = v[2]; o.w = v[3];
          *(float4*)(okr + ((size_t)((m >> 8) * 2 + j) * 256 + (m & 255)) * 64 + e) = o;
        }
      }
    }
  };
  gemm8_job<160, 4, 4, 8, 4, 32, 1>(smem, H, W, 1024, epi);
}

DI void phase_mla_norms(const PV& p, int j) {
  const int tid_ = TIDX(); const int lane = tid_ & 63, wid = tid_ >> 6;
  const u16* DQKV = (const u16*)(p.ws() + OFF_B + B_DQKV);
  u16* QN = (u16*)(p.ws() + OFF_A + A_QN);
  u16* CKV = (u16*)(p.ws() + OFF_A + A_CKV);
  u16* KR = (u16*)(p.ws() + OFF_KR);
  float* ockv = p.out() + 41943040;
  const float* qn = p.in(24) + j * 512;
  const float* kvn = p.in(27) + j * 256;
  for (int t = blockIdx.x * 8 + wid; t < TK; t += gridDim.x * 8) {
    if (t < T) {
      const u16* row = DQKV + (size_t)t * 896;
      const uint4 a = *(const uint4*)(row + lane * 8);
      float q[8] = {lo16(a.x), hi16(a.x), lo16(a.y), hi16(a.y), lo16(a.z), hi16(a.z), lo16(a.w), hi16(a.w)};
      float ss = 0.f;
#pragma unroll
      for (int k = 0; k < 8; ++k) ss += q[k] * q[k];
      ss = wave_sum(ss, lane);
      const float r = rsqrtf(ss * (1.f / 512.f) + EPS);
      const float4 g0 = *(const float4*)(qn + lane * 8), g1 = *(const float4*)(qn + lane * 8 + 4);
      uint4 o;
      o.x = pack2(q[0] * r * g0.x, q[1] * r * g0.y); o.y = pack2(q[2] * r * g0.z, q[3] * r * g0.w);
      o.z = pack2(q[4] * r * g1.x, q[5] * r * g1.y); o.w = pack2(q[6] * r * g1.z, q[7] * r * g1.w);
      *(uint4*)(QN + (size_t)t * 512 + lane * 8) = o;
      const uint2 b = *(const uint2*)(row + 512 + lane * 4);
      float kv[4] = {lo16(b.x), hi16(b.x), lo16(b.y), hi16(b.y)};
      float s2 = kv[0] * kv[0] + kv[1] * kv[1] + kv[2] * kv[2] + kv[3] * kv[3];
      s2 = wave_sum(s2, lane);
      const float r2 = rsqrtf(s2 * (1.f / 256.f) + EPS);
      const float4 g2 = *(const float4*)(kvn + lane * 4);
      float4 o2; o2.x = kv[0] * r2 * g2.x; o2.y = kv[1] * r2 * g2.y; o2.z = kv[2] * r2 * g2.z; o2.w = kv[3] * r2 * g2.w;
      *(uint2*)(CKV + (size_t)t * 256 + lane * 4) = pack4(o2.x, o2.y, o2.z, o2.w);
      if (t < TP) *(float4*)(ockv + ((size_t)((t >> 8) * 2 + j) * 256 + (t & 255)) * 256 + lane * 4) = o2;
    } else {
      const int pp = t - T, b = pp >> 8, s = pp & 255;
      const float4 v = *(const float4*)(p.in(2) + ((size_t)(b * 2 + j) * 256 + s) * 256 + lane * 4);
      *(uint2*)(CKV + (size_t)t * 256 + lane * 4) = pack4(v.x, v.y, v.z, v.w);
      if (lane < 16) {
        const float4 w = *(const float4*)(p.in(3) + ((size_t)(b * 2 + j) * 256 + s) * 64 + lane * 4);
        *(uint2*)(KR + (size_t)t * 64 + lane * 4) = pack4(w.x, w.y, w.z, w.w);
      }
    }
  }
}

DI size_t vt_off(int m, int h, int d) {
  if (m < TP) return ((size_t)((m >> 8) * 8 + h) * 128 + d) * 256 + (m & 255);
  if (m < T) { const int mm = m - TP; return VT_SAMPLE_OFF + ((size_t)((mm >> 12) * 8 + h) * 128 + d) * 4352 + (mm & 4095); }
  const int mm = m - T;
  return VT_SAMPLE_OFF + ((size_t)((mm >> 8) * 8 + h) * 128 + d) * 4352 + 4096 + (mm & 255);
}
struct EpiKV {
  u16* Kb; u16* Vt;
  DI void operator()(const f32x4 (&acc)[2][2][4][2], int pm, int pn, int wr, int wc, int fr, int fq) const {
    const int h = pn;
    const int rowt = pm * 256;
    const unsigned ls = rowt < TP ? 256u : 4352u;
    unsigned vbase;
    if (rowt < TP) vbase = (unsigned)(((rowt >> 8) * 8 + h) * 128) * 256u;
    else if (rowt < T) { const int mm = rowt - TP; vbase = (unsigned)VT_SAMPLE_OFF + (unsigned)(((mm >> 12) * 8 + h) * 128) * 4352u + (unsigned)(mm & 4095); }
    else { const int mm = rowt - T; vbase = (unsigned)VT_SAMPLE_OFF + (unsigned)(((mm >> 8) * 8 + h) * 128) * 4352u + 4096u + (unsigned)(mm & 255); }
    const unsigned dcol = (unsigned)(wc * 32 + 4 * fq);
#pragma unroll
    for (int ai = 0; ai < 2; ++ai)
#pragma unroll
      for (int m = 0; m < 4; ++m) {
        const int rl = ai * 128 + wr * 64 + m * 16 + fr;
        const unsigned ko = (unsigned)((rowt + rl) * 8 + h) * 192u + dcol;
        const unsigned frp = (unsigned)((fr & 3) | ((fr & 4) << 1) | ((fr & 8) >> 1));
        const unsigned vo = vbase + (unsigned)(rl & ~15) + frp + dcol * ls;
#pragma unroll
        for (int n = 0; n < 2; ++n) {
          const f32x4 k = acc[ai][0][m][n], v = acc[ai][1][m][n];
          *(uint2*)(Kb + (ko + n * 16)) = pack4(k[0], k[1], k[2], k[3]);
          const unsigned p01 = pack2(v[0], v[1]), p23 = pack2(v[2], v[3]);
          const unsigned vq = vo + (unsigned)(n * 16) * ls;
          Vt[vq] = (u16)p01; Vt[vq + ls] = (u16)(p01 >> 16); Vt[vq + 2 * ls] = (u16)p23; Vt[vq + 3 * ls] = (u16)(p23 >> 16);
        }
      }
  }
};
DI void phase_uq_ukv(const PV& p, int j, char* smem) {
  const u16* QN = (const u16*)(p.ws() + OFF_A + A_QN);
  const u16* CKV = (const u16*)(p.ws() + OFF_A + A_CKV);
  const u16* WQ = (const u16*)(p.ws() + OFF_WUQ) + (size_t)j * 1536 * 512;
  const u16* WKV = (const u16*)(p.ws() + OFF_WUKV) + (size_t)j * 2048 * 256;
  u16* Q = (u16*)(p.ws() + OFF_B + B_Q);
  u16* Kb = (u16*)(p.ws() + OFF_B + B_K);
  u16* Vt = (u16*)(p.ws() + OFF_B + B_V);
  auto epiq = [=](int m, int n, f32x4 v) { *(uint2*)(Q + (size_t)m * 1536 + n) = pack4(v[0], v[1], v[2], v[3]); };
  gemm8_job<160, 6, 4, 8, 4, 16, 2>(smem, QN, WQ, 512, epiq);
  EpiKV E; E.Kb = Kb; E.Vt = Vt;
  TileSched<168, 8, 8, 8, 4, 32, 1> S; S.init();
  gemm8(smem, CKV, WKV, 256, S, E);
}

DI void phase_finalize(const PV& p, int j) {
  const int tid_ = TIDX(); const int lane = tid_ & 63, wid = tid_ >> 6;
  const int h = lane >> 3, l8 = lane & 7;
  u16* Q = (u16*)(p.ws() + OFF_B + B_Q);
  u16* Kb = (u16*)(p.ws() + OFF_B + B_K);
  const u16* KR = (const u16*)(p.ws() + OFF_KR);
  const float2* ROPE = (const float2*)(p.ws() + OFF_ROPE);
  const float* qhn = p.in(29) + j * 192;
  const float* khn = p.in(30) + j * 192;
  const float QSCALE = 1.4426950408889634f * 0.07216878364870322f;
  const int stride = gridDim.x * 8;
  for (int u0 = blockIdx.x * 8 + wid; u0 < T + TK; u0 += 2 * stride) {
    uint4 raw[2][3];
    u16* basep[2];
#pragma unroll
    for (int w = 0; w < 2; ++w) {
      const int u = u0 + w * stride;
      if (u < T + TK) {
        const bool isq = u < T;
        const int t = isq ? u : u - T;
        u16* base = isq ? Q + (size_t)t * 1536 + h * 192 : Kb + ((size_t)t * 8 + h) * 192;
        basep[w] = base;
#pragma unroll
        for (int k = 0; k < 3; ++k) {
          const u16* src = (!isq && k == 2) ? KR + (size_t)t * 64 + 8 * l8 : base + 8 * (l8 + 8 * k);
          raw[w][k] = *(const uint4*)src;
        }
      }
    }
#pragma unroll
    for (int w = 0; w < 2; ++w) {
      const int u = u0 + w * stride;
      if (u < T + TK) {
        const bool isq = u < T;
        const int t = isq ? u : u - T;
        const float* hn = isq ? qhn : khn;
        float v[3][8];
#pragma unroll
        for (int k = 0; k < 3; ++k) {
          const uint4 a = raw[w][k];
          v[k][0] = lo16(a.x); v[k][1] = hi16(a.x); v[k][2] = lo16(a.y); v[k][3] = hi16(a.y);
          v[k][4] = lo16(a.z); v[k][5] = hi16(a.z); v[k][6] = lo16(a.w); v[k][7] = hi16(a.w);
        }
        float ss = 0.f;
#pragma unroll
        for (int k = 0; k < 3; ++k)
#pragma unroll
          for (int e = 0; e < 8; ++e) ss += v[k][e] * v[k][e];
        ss += shx<1>(ss, lane); ss += shx<2>(ss, lane); ss += shx<4>(ss, lane);
        const float r = rsqrtf(ss * (1.f / 192.f) + EPS);
#pragma unroll
        for (int k = 0; k < 3; ++k) {
          const float4 g0 = *(const float4*)(hn + 8 * (l8 + 8 * k)), g1 = *(const float4*)(hn + 8 * (l8 + 8 * k) + 4);
          v[k][0] *= r * g0.x; v[k][1] *= r * g0.y; v[k][2] *= r * g0.z; v[k][3] *= r * g0.w;
          v[k][4] *= r * g1.x; v[k][5] *= r * g1.y; v[k][6] *= r * g1.z; v[k][7] *= r * g1.w;
        }
        if (t >= TP && t < T) {
          const int tl = (t - TP) & 4095;
          const int pos = l8 < 4 ? (tl >> 6) : (tl & 63);
          const float4* rp = (const float4*)(ROPE + pos * 16 + (l8 & 1) * 8);
          const float4 c01 = rp[0], c23 = rp[1], c45 = rp[2], c67 = rp[3];
          const float cs[8] = {c01.x, c01.z, c23.x, c23.z, c45.x, c45.z, c67.x, c67.z};
          const float sn[8] = {c01.y, c01.w, c23.y, c23.w, c45.y, c45.w, c67.y, c67.w};
#pragma unroll
          for (int e = 0; e < 8; ++e) {
            const float x = v[2][e];
            const float partner = shx<2>(x, lane);
            v[2][e] = (l8 & 2) ? x * cs[e] + partner * sn[e] : x * cs[e] - partner * sn[e];
          }
        }
        const float sc = isq ? QSCALE : 1.f;
#pragma unroll
        for (int k = 0; k < 3; ++k) {
          uint4 o;
          o.x = pack2(v[k][0] * sc, v[k][1] * sc); o.y = pack2(v[k][2] * sc, v[k][3] * sc);
          o.z = pack2(v[k][4] * sc, v[k][5] * sc); o.w = pack2(v[k][6] * sc, v[k][7] * sc);
          *(uint4*)(basep[w] + 8 * (l8 + 8 * k)) = o;
        }
      }
    }
  }
}

DI void attn_item(const PV& p, int kind, int seq, int h, int q0, char* smem) {
  const int tid = TIDX(), lane = tid & 63, wid = tid >> 6;
  const int il = lane & 31, hh = lane >> 5;
  const u16* Q = (const u16*)(p.ws() + OFF_B + B_Q);
  const u16* Kb = (const u16*)(p.ws() + OFF_B + B_K);
  const u16* Vt = (const u16*)(p.ws() + OFF_B + B_V);
  u16* O = (u16*)(p.ws() + OFF_A + A_O);
  const int Lk = kind ? 4352 : 256, nkt = Lk >> 6;
  const u16* vbase = Vt + (kind ? VT_SAMPLE_OFF + (size_t)(seq * 8 + h) * 128 * 4352 : (size_t)(seq * 8 + h) * 128 * 256);
  const int tq = q0 + wid * 32 + il;
  bf16x8 qf[12];
#pragma unroll
  for (int ks = 0; ks < 12; ++ks) qf[ks] = *(const bf16x8*)(Q + ((size_t)tq * 8 + h) * 192 + 16 * ks + 8 * hh);
  f32x16 oacc[4];
#pragma unroll
  for (int a = 0; a < 4; ++a)
#pragma unroll
    for (int r = 0; r < 16; ++r) oacc[a][r] = 0.f;
  float mrun = -INFINITY, lrun = 0.f;
  const int sw = (il >> 1) & 7;
  int ko[4], vob[4];
#pragma unroll
  for (int a = 0; a < 4; ++a) ko[a] = il * 384 + (((2 * a + hh) ^ sw) << 4);
#pragma unroll
  for (int c = 0; c < 4; ++c) vob[c] = il * 128 + (((2 * c + hh) ^ sw) << 4);
  LAS unsigned char* lds = (LAS unsigned char*)smem;
  unsigned kso[3], vso[2];
#pragma unroll
  for (int i = 0; i < 3; ++i) {
    const int id = tid + 512 * i, r = id / 24, pc = id - r * 24;
    const int ch = (pc & ~7) | ((pc & 7) ^ ((r >> 1) & 7));
    kso[i] = (unsigned)(r * 3072 + ch * 16);
  }
#pragma unroll
  for (int i = 0; i < 2; ++i) {
    const int id = tid + 512 * i, dd = id >> 3, pc = id & 7;
    const int ch = pc ^ ((dd >> 1) & 7);
    vso[i] = (unsigned)(dd * Lk * 2 + ch * 16);
  }
  const unsigned ldst = (unsigned)(tid >> 6) * 1024u;
#define ATT_STAGE(kt_, s_)                                                                                      \
  {                                                                                                            \
    const int k0_ = (kt_) * 64;                                                                                \
    const int rowbase_ = kind ? (k0_ < 4096 ? TP + seq * 4096 + k0_ : T + seq * 256 + (k0_ - 4096)) : seq * 256 + k0_; \
    const char* kg_ = (const char*)(Kb + ((size_t)rowbase_ * 8 + h) * 192);                                     \
    const char* vg_ = (const char*)(vbase + k0_);                                                              \
    _Pragma("unroll") for (int i_ = 0; i_ < 3; ++i_)                                                           \
      __builtin_amdgcn_global_load_lds((const unsigned*)(kg_ + kso[i_]), (LAS unsigned*)(lds + (s_) * 40960 + ldst + i_ * 8192), 16, 0, 0); \
    _Pragma("unroll") for (int i_ = 0; i_ < 2; ++i_)                                                           \
      __builtin_amdgcn_global_load_lds((const unsigned*)(vg_ + vso[i_]), (LAS unsigned*)(lds + (s_) * 40960 + 24576 + ldst + i_ * 8192), 16, 0, 0); \
  }
  __syncthreads();
  ATT_STAGE(0, 0)
  asm volatile("s_waitcnt vmcnt(0)" ::: "memory");
  __syncthreads();
  for (int kt = 0; kt < nkt; ++kt) {
    const bool more = kt + 1 < nkt;
    if (more) ATT_STAGE(kt + 1, (kt + 1) & 1)
    const char* Ks = smem + (kt & 1) * 40960;
    const char* Vs = Ks + 24576;
    f32x16 s2[2];
    __builtin_amdgcn_s_setprio(1);
#pragma unroll
    for (int st = 0; st < 2; ++st)
#pragma unroll
      for (int r = 0; r < 16; ++r) s2[st][r] = 0.f;
#pragma unroll
    for (int ks = 0; ks < 12; ++ks)
#pragma unroll
      for (int st = 0; st < 2; ++st) {
        const bf16x8 kf = *(const bf16x8*)(Ks + ko[ks & 3] + st * 12288 + (ks >> 2) * 128);
        s2[st] = __builtin_amdgcn_mfma_f32_32x32x16_bf16(kf, qf[ks], s2[st], 0, 0, 0);
      }
    __builtin_amdgcn_s_setprio(0);
    {
      float pmax = s2[0][0];
#pragma unroll
      for (int r = 1; r < 16; ++r) pmax = fmaxf(pmax, s2[0][r]);
#pragma unroll
      for (int r = 0; r < 16; ++r) pmax = fmaxf(pmax, s2[1][r]);
      { auto rr = __builtin_amdgcn_permlane32_swap(__float_as_uint(pmax), __float_as_uint(pmax), false, false);
        pmax = fmaxf(__uint_as_float(rr[0]), __uint_as_float(rr[1])); }
      if (!__all(pmax - mrun <= 11.541560327f)) {
        const float mn = fmaxf(mrun, pmax);
        const float alpha = __builtin_amdgcn_exp2f(mrun - mn);
        mrun = mn;
        lrun *= alpha;
#pragma unroll
        for (int a = 0; a < 4; ++a)
#pragma unroll
          for (int r = 0; r < 16; ++r) oacc[a][r] *= alpha;
      }
      float psum = 0.f;
#pragma unroll
      for (int st = 0; st < 2; ++st)
#pragma unroll
        for (int r = 0; r < 16; ++r) { const float pv = __builtin_amdgcn_exp2f(s2[st][r] - mrun); s2[st][r] = pv; psum += pv; }
      lrun += psum;
    }
    __builtin_amdgcn_s_setprio(1);
#pragma unroll
    for (int st = 0; st < 2; ++st)
#pragma unroll
      for (int sb = 0; sb < 2; ++sb) {
        union { bf16x8 v; unsigned w[4]; } pb;
#pragma unroll
        for (int w = 0; w < 4; ++w) pb.w[w] = pack2(s2[st][8 * sb + 2 * w], s2[st][8 * sb + 2 * w + 1]);
#pragma unroll
        for (int dt = 0; dt < 4; ++dt) {
          const bf16x8 vf = *(const bf16x8*)(Vs + vob[2 * st + sb] + dt * 4096);
          oacc[dt] = __builtin_amdgcn_mfma_f32_32x32x16_bf16(vf, pb.v, oacc[dt], 0, 0, 0);
        }
      }
    __builtin_amdgcn_s_setprio(0);
    asm volatile("s_waitcnt vmcnt(0)" ::: "memory");
    __syncthreads();
  }
#undef ATT_STAGE
  float ltot;
  { auto rr = __builtin_amdgcn_permlane32_swap(__float_as_uint(lrun), __float_as_uint(lrun), false, false); ltot = __uint_as_float(rr[0]) + __uint_as_float(rr[1]); }
  const float inv = 1.f / ltot;
#pragma unroll
  for (int dt = 0; dt < 4; ++dt)
#pragma unroll
    for (int g = 0; g < 4; ++g) {
      const int d = dt * 32 + 8 * g + 4 * hh;
      *(uint2*)(O + (size_t)tq * 1024 + h * 128 + d) =
          pack4(oacc[dt][4 * g] * inv, oacc[dt][4 * g + 1] * inv, oacc[dt][4 * g + 2] * inv, oacc[dt][4 * g + 3] * inv);
    }
}
DI void phase_attention(const PV& p, char* smem) {
  const bool xmap = gridDim.x == 256;
  const int Gq = opaque_i((int)gridDim.x);
  const int nit = xmap ? 5 : (1280 + Gq - 1) / Gq;
#pragma unroll 1
  for (int r = 0; r < nit; ++r) {
    int kind, seq, h, q0;
    if (xmap) {
      if (r < 4) {
        const int xcd = blockIdx.x & 7, slot = blockIdx.x >> 3;
        const int pair = xcd + 8 * (2 * r + (slot >> 4)), qb = slot & 15;
        kind = 1; seq = pair >> 3; h = pair & 7; q0 = TP + seq * 4096 + qb * 256;
      } else {
        kind = 0; seq = blockIdx.x >> 3; h = blockIdx.x & 7; q0 = seq * 256;
      }
    } else {
      const int it = blockIdx.x + r * gridDim.x;
      if (it >= 1280) break;
      if (it < 1024) { const int pair = it >> 4, qb = it & 15; kind = 1; seq = pair >> 3; h = pair & 7; q0 = TP + seq * 4096 + qb * 256; }
      else { const int i2 = it - 1024; kind = 0; seq = i2 >> 3; h = i2 & 7; q0 = seq * 256; }
    }
    attn_item(p, kind, seq, h, q0, smem);
  }
  __syncthreads();
}

DI size_t act_blk(int t, int a) { return (size_t)(t >> 8) * (256 * 2816) + (size_t)(a >> 6) * (256 * 64) + (size_t)((t & 255) * 64 + (a & 63)); }
DI float dpp_ror1(float x) { return __int_as_float(__builtin_amdgcn_update_dpp(0, __float_as_int(x), 0x121, 0xf, 0xf, false)); }
DI float dpp_ror15(float x) { return __int_as_float(__builtin_amdgcn_update_dpp(0, __float_as_int(x), 0x12F, 0xf, 0xf, false)); }
struct EpiFFN {
  u16* ACT; u16* EDGE; const float* cw; const float* cb;
  DI void operator()(const f32x4 (&acc)[2][2][4][2], int pm, int pn, int wr, int wc, int fr, int fq) const {
#pragma unroll
    for (int n = 0; n < 2; ++n) {
      const int a = pn * 128 + wc * 32 + n * 16 + fq * 4;
      const float4 w0g = *(const float4*)(cw + a), w1g = *(const float4*)(cw + 5632 + a), w2g = *(const float4*)(cw + 11264 + a), bg = *(const float4*)(cb + a);
      const float4 w0u = *(const float4*)(cw + 2816 + a), w1u = *(const float4*)(cw + 5632 + 2816 + a), w2u = *(const float4*)(cw + 11264 + 2816 + a), bu = *(const float4*)(cb + 2816 + a);
#pragma unroll
      for (int ai = 0; ai < 2; ++ai) {
        const int rbase = pm * 256 + ai * 128 + wr * 64;
        const size_t erow = (size_t)(rbase >> 6) * 4;
#pragma unroll
        for (int m = 0; m < 4; ++m) {
          const int mp = m > 0 ? m - 1 : 0, mn = m < 3 ? m + 1 : 3;
          float o[4];
#define FFN_ONE(J, C)                                                                                         \
          {                                                                                                   \
            const float g = acc[ai][0][m][n][J], u = acc[ai][1][m][n][J];                                     \
            const float gpv = m > 0 ? acc[ai][0][mp][n][J] : 0.f, gnx = m < 3 ? acc[ai][0][mn][n][J] : 0.f;   \
            const float upv = m > 0 ? acc[ai][1][mp][n][J] : 0.f, unx = m < 3 ? acc[ai][1][mn][n][J] : 0.f;   \
            const float gp = dpp_ror1(fr == 15 ? gpv : g), gn = dpp_ror15(fr == 0 ? gnx : g);                \
            const float up = dpp_ror1(fr == 15 ? upv : u), un = dpp_ror15(fr == 0 ? unx : u);                \
            const float cg = w0g.C * gp + w1g.C * g + w2g.C * gn + bg.C;                                      \
            const float cu = w0u.C * up + w1u.C * u + w2u.C * un + bu.C;                                      \
            o[J] = silu(cg) * cu;                                                                             \
          }
          FFN_ONE(0, x) FFN_ONE(1, y) FFN_ONE(2, z) FFN_ONE(3, w)
#undef FFN_ONE
          *(uint2*)(ACT + act_blk(rbase + m * 16 + fr, a)) = pack4(o[0], o[1], o[2], o[3]);
          if ((m == 0 && fr < 2) || (m == 3 && fr >= 14)) {
            const int ri = m == 0 ? fr : fr - 12;
            u16* e = EDGE + (erow + ri) * 5632 + pn * 256 + wc * 32 + n * 16 + fq * 4;
            *(uint2*)e = pack4(acc[ai][0][m][n][0], acc[ai][0][m][n][1], acc[ai][0][m][n][2], acc[ai][0][m][n][3]);
            *(uint2*)(e + 128) = pack4(acc[ai][1][m][n][0], acc[ai][1][m][n][1], acc[ai][1][m][n][2], acc[ai][1][m][n][3]);
          }
        }
      }
    }
  }
};
DI void phase_ffn_up(const PV& p, int l, char* smem) {
  EpiFFN E;
  E.ACT = (u16*)(p.ws() + OFF_B + B_ACT); E.EDGE = (u16*)(p.ws() + OFF_EDGE);
  E.cw = p.in(33) + (size_t)l * 3 * 5632; E.cb = p.in(34) + (size_t)l * 5632;
  TileSched<160, 22, 16, 8, 4, 16, 2> S; S.init();
  gemm8(smem, (const u16*)(p.ws() + OFF_A + A_H), (const u16*)(p.ws() + OFF_WUP), 1024, S, E);
}
DI void phase_ffn_fix(const PV& p, int l) {
  const u16* EDGE = (const u16*)(p.ws() + OFF_EDGE);
  u16* ACT = (u16*)(p.ws() + OFF_B + B_ACT);
  const float* cw = p.in(33) + (size_t)l * 3 * 5632;
  const float* cb = p.in(34) + (size_t)l * 5632;
  const long gtid = (long)blockIdx.x * blockDim.x + TIDX(), gsz = (long)gridDim.x * blockDim.x;
  for (long idx = gtid; idx < (long)640 * 2 * 704; idx += gsz) {
    const int a = (int)(idx % 704) * 4, rr = (int)(idx / 704), which = rr & 1, sidx = rr >> 1;
    const int t = sidx * 64 + (which ? 63 : 0);
    const int tb = which ? t + 1 : t;
    const bool seqb = tb < TP ? (tb & 255) == 0 : ((tb - TP) & 4095) == 0;
    if (seqb) continue;
    const int pc = (a >> 7) * 256 + (a & 127);
    const u16 *pr, *cu, *nx;
    if (which == 0) { pr = EDGE + ((size_t)(sidx - 1) * 4 + 3) * 5632; cu = EDGE + ((size_t)sidx * 4 + 0) * 5632; nx = EDGE + ((size_t)sidx * 4 + 1) * 5632; }
    else { pr = EDGE + ((size_t)sidx * 4 + 2) * 5632; cu = EDGE + ((size_t)sidx * 4 + 3) * 5632; nx = EDGE + ((size_t)(sidx + 1) * 4 + 0) * 5632; }
    const uint2 gp = *(const uint2*)(pr + pc), gc = *(const uint2*)(cu + pc), gn = *(const uint2*)(nx + pc);
    const uint2 up = *(const uint2*)(pr + pc + 128), uc = *(const uint2*)(cu + pc + 128), un = *(const uint2*)(nx + pc + 128);
    const float4 w0g = *(const float4*)(cw + a), w1g = *(const float4*)(cw + 5632 + a), w2g = *(const float4*)(cw + 11264 + a), bg = *(const float4*)(cb + a);
    const float4 w0u = *(const float4*)(cw + 2816 + a), w1u = *(const float4*)(cw + 5632 + 2816 + a), w2u = *(const float4*)(cw + 11264 + 2816 + a), bu = *(const float4*)(cb + 2816 + a);
    const float g0 = w0g.x * lo16(gp.x) + w1g.x * lo16(gc.x) + w2g.x * lo16(gn.x) + bg.x, u0 = w0u.x * lo16(up.x) + w1u.x * lo16(uc.x) + w2u.x * lo16(un.x) + bu.x;
    const float g1 = w0g.y * hi16(gp.x) + w1g.y * hi16(gc.x) + w2g.y * hi16(gn.x) + bg.y, u1 = w0u.y * hi16(up.x) + w1u.y * hi16(uc.x) + w2u.y * hi16(un.x) + bu.y;
    const float g2 = w0g.z * lo16(gp.y) + w1g.z * lo16(gc.y) + w2g.z * lo16(gn.y) + bg.z, u2 = w0u.z * lo16(up.y) + w1u.z * lo16(uc.y) + w2u.z * lo16(un.y) + bu.z;
    const float g3 = w0g.w * hi16(gp.y) + w1g.w * hi16(gc.y) + w2g.w * hi16(gn.y) + bg.w, u3 = w0u.w * hi16(up.y) + w1u.w * hi16(uc.y) + w2u.w * hi16(un.y) + bu.w;
    *(uint2*)(ACT + act_blk(t, a)) = pack4(silu(g0) * u0, silu(g1) * u1, silu(g2) * u2, silu(g3) * u3);
  }
}

#ifndef PH
#define RUN(k, ...) __VA_ARGS__
#else
#define RUN(k, ...) if (PH == k) { __VA_ARGS__ }
#endif
extern "C" __global__ void __launch_bounds__(512) fwd_megakernel(Params kp) {
  extern __shared__ __attribute__((aligned(16))) char smem[];
  cg::grid_group grid = cg::this_grid();
  if (TIDX() == 0) {
    unsigned long long* t = (unsigned long long*)(smem + PARM_OFF);
#pragma unroll
    for (int k = 0; k < 36; ++k) t[k] = (unsigned long long)kp.in[k];
    t[36] = (unsigned long long)kp.out; t[37] = (unsigned long long)kp.ws;
  }
  __syncthreads();
  PV p; p.smem = smem;
  unsigned* bar = (unsigned*)(p.ws() + OFF_BAR);
  if (TIDX() == 0) { *(unsigned*)(smem + PARM_OFF + 512) = 0u; *(unsigned*)(smem + PARM_OFF + 516) = 0u; }
  __syncthreads();
  const XcdBarrier xb = xcd_barrier_post(bar, (volatile LASB unsigned*)(smem + PARM_OFF + 512));
  RUN(0, phase_prep(p, smem);)
  grid.sync();
  RUN(1, phase_filters(p, smem);)
  for (int l = 0; l < 4; ++l) {
    const int i = l >> 1;
    RUN(2, phase_norm(p, l, 0, l);)
    RUN(0, if (l > 0) { int base = 0; convert_ffn_weights(p, l, smem, base); })
    xcd_barrier(xb);
    if ((l & 1) == 0) {
      RUN(3, phase_mix_in(p, i, smem);)
      xcd_barrier(xb);
      RUN(4, phase_sgu(p, i, smem);)
      RUN(5, phase_conv(p, i, 0, smem);)
      xcd_barrier(xb);
      RUN(5, phase_conv(p, i, 1, smem);)
      xcd_barrier(xb);
      RUN(6, phase_ztrans(p, smem);)
      xcd_barrier(xb);
      RUN(7, phase_resid_gemm(p, l, l, (const u16*)(p.ws() + OFF_B + B_MIX), 1024, (const u16*)(p.ws() + OFF_WMIXOUT) + (size_t)i * 1024 * 1024, 2048, smem);)
      xcd_barrier(xb);
    } else {
      RUN(8, phase_dqkv(p, i, smem);)
      xcd_barrier(xb);
      RUN(9, phase_mla_norms(p, i);)
      xcd_barrier(xb);
      RUN(10, phase_uq_ukv(p, i, smem);)
      xcd_barrier(xb);
      RUN(11, phase_finalize(p, i);)
      xcd_barrier(xb);
      RUN(12, phase_attention(p, smem);)
      xcd_barrier(xb);
      RUN(7, phase_resid_gemm(p, l, l, (const u16*)(p.ws() + OFF_A + A_O), 1024, (const u16*)(p.ws() + OFF_WO) + (size_t)i * 1024 * 1024, 2048, smem);)
      xcd_barrier(xb);
    }
    RUN(2, phase_norm(p, l, 1, 1);)
    xcd_barrier(xb);
    RUN(13, phase_ffn_up(p, l, smem);)
    xcd_barrier(xb);
    RUN(14, phase_ffn_fix(p, l);)
    xcd_barrier(xb);
    RUN(7, phase_resid_gemm(p, l, 1, (const u16*)(p.ws() + OFF_B + B_ACT), 2816, (const u16*)(p.ws() + OFF_WDOWN), 5120, smem);)
    xcd_barrier(xb);
  }
}

extern "C" void kernel_launch(void* const* d_in, const int* in_sizes, int n_in,
                              void* d_out, int out_size, void* d_ws, size_t ws_size,
                              hipStream_t stream) {
  static int grid_blocks = 0;
  if (!grid_blocks) {
    int dev = 0, cus = 0, per_cu = 0;
    (void)hipGetDevice(&dev);
    (void)hipDeviceGetAttribute(&cus, hipDeviceAttributeMultiprocessorCount, dev);
    (void)hipFuncSetAttribute((const void*)fwd_megakernel, hipFuncAttributeMaxDynamicSharedMemorySize, (int)LDS_BYTES);
    (void)hipOccupancyMaxActiveBlocksPerMultiprocessor(&per_cu, fwd_megakernel, 512, LDS_BYTES);
    if (per_cu < 1) per_cu = 1;
    if (per_cu > 1) per_cu = 1;
    grid_blocks = cus * per_cu;
  }
  if (ws_size < WS_NEED) fprintf(stderr, "workspace too small: %zu < %zu\n", ws_size, (size_t)WS_NEED);
  Params p{};
  for (int i = 0; i < 36; ++i) p.in[i] = (const float*)d_in[i];
  p.out = (float*)d_out;
  p.ws = (char*)d_ws;
  (void)hipMemsetAsync((char*)d_ws + OFF_BAR, 0, 16384, stream);
  void* args[] = {&p};
  hipError_t e = hipLaunchCooperativeKernel((void*)fwd_megakernel, dim3(grid_blocks), dim3(512), args, LDS_BYTES, stream);
  if (e != hipSuccess) fprintf(stderr, "cooperative launch failed: %s (grid %d)\n", hipGetErrorString(e), grid_blocks);
}
```

```cpp
#include <hip/hip_runtime.h>
#include <hip/hip_cooperative_groups.h>
#include <cstdio>
namespace cg = cooperative_groups;

typedef unsigned short u16;
using bf16x8 = __attribute__((ext_vector_type(8))) short;
using f32x4 = __attribute__((ext_vector_type(4))) float;
using f32x16 = __attribute__((ext_vector_type(16))) float;
#define DI __device__ __forceinline__

constexpr int T = 40960;
constexpr int TP = 8192;
constexpr int TK = 43008;
constexpr float EPS = 1e-6f;
constexpr size_t LDS_BYTES = 139264;

constexpr size_t OFF_WMIXIN = 0;
constexpr size_t OFF_WMIXOUT = OFF_WMIXIN + (size_t)2 * 2560 * 1024 * 2;
constexpr size_t OFF_WDQKV = OFF_WMIXOUT + (size_t)2 * 1024 * 1024 * 2;
constexpr size_t OFF_WUQ = OFF_WDQKV + (size_t)2 * 1024 * 1024 * 2;
constexpr size_t OFF_WUKV = OFF_WUQ + (size_t)2 * 1536 * 512 * 2;
constexpr size_t OFF_WO = OFF_WUKV + (size_t)2 * 2048 * 256 * 2;
constexpr size_t OFF_WSGU = OFF_WO + (size_t)2 * 1024 * 1024 * 2;
constexpr size_t OFF_WUP = OFF_WSGU + (size_t)2 * 4 * 128 * 128 * 2;
constexpr size_t OFF_WDOWN = OFF_WUP + (size_t)5632 * 1024 * 2;
constexpr size_t OFF_MOD = OFF_WDOWN + (size_t)1024 * 2816 * 2;
constexpr size_t OFF_FILT = OFF_MOD + (size_t)4 * 9 * 6144 * 4;
constexpr size_t OFF_H2 = OFF_FILT + (size_t)2 * 2 * 512 * 4352 * 2;
constexpr size_t OFF_EDGE = OFF_H2 + (size_t)2 * 4352 * 64 * 4;
constexpr size_t OFF_KR = OFF_EDGE + (size_t)640 * 4 * 5632 * 2;
constexpr size_t OFF_A = OFF_KR + (size_t)TK * 64 * 2;
constexpr size_t OFF_B = OFF_A + (size_t)T * 1024 * 2;
constexpr size_t OFF_BAR = OFF_B + (size_t)346030080;
constexpr size_t OFF_ROPE = OFF_BAR + 16384;
constexpr size_t WS_NEED = OFF_ROPE + 64 * 16 * 8;
constexpr size_t A_H = 0, A_Z1 = 0, A_Z2 = (size_t)T * 512 * 2, A_QN = 0, A_CKV = (size_t)T * 512 * 2, A_O = 0;
constexpr size_t B_VT = 0, B_PRT = (size_t)T * 512 * 2, B_MIX = B_PRT + (size_t)T * 1536 * 2;
constexpr size_t B_DQKV = 0, B_Q = 0, B_K = (size_t)T * 1536 * 2, B_V = B_K + (size_t)TK * 1536 * 2;
constexpr size_t B_ACT = 0;
constexpr size_t VT_SAMPLE_OFF = (size_t)32 * 8 * 128 * 256;

struct Params {
  const float* in[36];
  float* out;
  char* ws;
};


constexpr int PARM_OFF = 138240;
struct PV {
  char* smem;
  DI unsigned long long ld(int k) const {
    int off = PARM_OFF + 8 * k;
    asm volatile("" : "+v"(off));
    const unsigned long long v = *(const unsigned long long*)(smem + off);
    const unsigned lo = __builtin_amdgcn_readfirstlane((unsigned)v), hi = __builtin_amdgcn_readfirstlane((unsigned)(v >> 32));
    return ((unsigned long long)hi << 32) | lo;
  }
  DI const float* in(int k) const { return (const float*)(const __attribute__((address_space(1))) float*)ld(k); }
  DI float* out() const { return (float*)(__attribute__((address_space(1))) float*)ld(36); }
  DI char* ws() const { return (char*)(__attribute__((address_space(1))) char*)ld(37); }
};

DI int TIDX() { int t = (int)__builtin_amdgcn_workitem_id_x(); asm volatile("" : "+v"(t)); return t; }
DI u16 f2bf(float x) { unsigned u = __float_as_uint(x); u += 0x7fffu + ((u >> 16) & 1u); return (u16)(u >> 16); }
DI float bf2f(u16 h) { return __uint_as_float(((unsigned)h) << 16); }
DI unsigned pack2(float a, float b) { unsigned r; asm("v_cvt_pk_bf16_f32 %0, %1, %2" : "=v"(r) : "v"(a), "v"(b)); return r; }
DI uint2 pack4(float a, float b, float c, float d) { uint2 r; r.x = pack2(a, b); r.y = pack2(c, d); return r; }
DI float lo16(unsigned w) { return __uint_as_float(w << 16); }
DI float hi16(unsigned w) { return __uint_as_float(w & 0xffff0000u); }
DI float gelu_tanh(float x) { const float y = x * (1.f + 0.044715f * x * x); return x * __builtin_amdgcn_rcpf(1.f + __builtin_amdgcn_exp2f(-2.302208198f * y)); }
DI float silu(float x) { return x * __builtin_amdgcn_rcpf(1.f + __builtin_amdgcn_exp2f(-1.4426950409f * x)); }
DI int condrow(int m) { return m < TP ? 0 : 1 + ((m - TP) >> 12); }
template <int MASK> DI float shx(float v, int lane) {
  if (MASK == 32) return __int_as_float(__builtin_amdgcn_ds_bpermute((lane ^ 32) << 2, __float_as_int(v)));
  return __int_as_float(__builtin_amdgcn_ds_swizzle(__float_as_int(v), (MASK << 10) | 0x1f));
}
DI float wave_sum(float v, int lane) {
  v += shx<32>(v, lane); v += shx<16>(v, lane); v += shx<8>(v, lane);
  v += shx<4>(v, lane); v += shx<2>(v, lane); v += shx<1>(v, lane); return v;
}
DI int opaque_i(int x) { asm volatile("" : "+s"(x)); return x; }
DI int first_unit(int base) { const int G = opaque_i((int)gridDim.x); int r = (int)blockIdx.x - (base % G); if (r < 0) r += G; return r; }
DI const float* xin_row(const PV& p, int l, int m) {
  if (l == 0) return m < TP ? p.in(0) + (size_t)m * 1024 : p.in(1) + (size_t)(m - TP) * 1024;
  return p.out() + (size_t)m * 1024;
}


#define XB_TMO      128
#define XB_XCNT(j)  (256  + 64 * (j))
#define XB_XSUB(j)  (1280 + 64 * (j))
#define XB_XGEN(j)  (2304 + 64 * (j))
#define XB_TOP      3328
#define XB_TOPGEN   3392
#define XB_SPIN_CAP (1u << 22)
#define LASB __attribute__((address_space(3)))
DI unsigned xb_ld(unsigned* p) { return __hip_atomic_load(p, __ATOMIC_RELAXED, __HIP_MEMORY_SCOPE_AGENT); }
DI unsigned xb_add(unsigned* p, unsigned v) { return __hip_atomic_fetch_add(p, v, __ATOMIC_RELAXED, __HIP_MEMORY_SCOPE_AGENT); }
DI unsigned xb_xcc_id() { return (unsigned)__builtin_amdgcn_s_getreg((3 << 11) | 20) & 0xFu; }
#define XB_SPIN(cond, bar) do { unsigned _sp = 0; while (cond) { __builtin_amdgcn_s_sleep(1); \
    if ((++_sp & 255u) == 0u) { if (xb_ld(&(bar)[XB_TMO])) break; if (_sp > XB_SPIN_CAP) { atomicAdd(&(bar)[XB_TMO], 1u); break; } } } } while (0)
struct XcdBarrier { unsigned* bar; unsigned x; volatile LASB unsigned* st; };
DI XcdBarrier xcd_barrier_post(unsigned* bar, volatile LASB unsigned* st) {
  XcdBarrier b; b.bar = bar; b.x = xb_xcc_id(); b.st = st;
  if (TIDX() == 0) (void)xb_add(&bar[XB_XCNT(b.x)], 1u);
  return b;
}
DI void xcd_barrier_complete(unsigned* bar, unsigned x, unsigned& nloc, unsigned& nx) {
  const unsigned G = gridDim.x;
  unsigned sum, cnt, mine, sp = 0u;
  for (;;) {
    sum = 0u; cnt = 0u; mine = 0u;
#pragma unroll
    for (unsigned j = 0; j < 16; ++j) { const unsigned c = xb_ld(&bar[XB_XCNT(j)]); sum += c; cnt += (c > 0u) ? 1u : 0u; mine = (j == x) ? c : mine; }
    if (sum == G) break;
    __builtin_amdgcn_s_sleep(1);
    if ((++sp & 255u) == 0u) { if (xb_ld(&bar[XB_TMO])) break; if (sp > XB_SPIN_CAP) { atomicAdd(&bar[XB_TMO], 1u); break; } }
  }
  nloc = mine > 0u ? mine : 1u; nx = cnt > 0u ? cnt : 1u;
}
DI void xcd_barrier(const XcdBarrier& b) {
  asm volatile("s_waitcnt vmcnt(0)" ::: "memory");
  __syncthreads();
  if (TIDX() == 0) {
    unsigned* bar = b.bar;
    __builtin_amdgcn_s_waitcnt(0);
    unsigned nloc = b.st[0], nx = b.st[1];
    if (nloc == 0u) { xcd_barrier_complete(bar, b.x, nloc, nx); b.st[0] = nloc; b.st[1] = nx; }
    const unsigned old = xb_add(&bar[XB_XSUB(b.x)], 1u);
    const unsigned gen = old / nloc;
    if (old + 1u == (gen + 1u) * nloc) {
      __builtin_amdgcn_fence(__ATOMIC_RELEASE, "agent");
      asm volatile("s_waitcnt vmcnt(0)" ::: "memory");
      const unsigned og = xb_add(&bar[XB_TOP], 1u);
      const unsigned tg = og / nx;
      if (og + 1u == (tg + 1u) * nx) xb_add(&bar[XB_TOPGEN], 1u);
      else XB_SPIN(xb_ld(&bar[XB_TOPGEN]) == tg, bar);
      __builtin_amdgcn_fence(__ATOMIC_ACQUIRE, "agent");
      xb_add(&bar[XB_XGEN(b.x)], 1u);
      asm volatile("s_waitcnt vmcnt(0)" ::: "memory");
    } else {
      XB_SPIN(xb_ld(&bar[XB_XGEN(b.x)]) == gen, bar);
      __builtin_amdgcn_fence(__ATOMIC_ACQUIRE, "agent");
      asm volatile("s_waitcnt vmcnt(0)" ::: "memory");
    }
  }
  __syncthreads();
}

template <int MODE>
DI int rowmap(int n, int row0) {
  if (MODE == 0) return n + row0;
  return n < 2816 ? (n >> 7) * 256 + (n & 127) : ((n - 2816) >> 7) * 256 + 128 + ((n - 2816) & 127);
}
template <int MODE, int NJ = 4>
DI void convT(const float* __restrict__ src, u16* __restrict__ dst, int K, int N, int row0, char* smem, int& base) {
  u16* tl = (u16*)smem;
  const int tid = TIDX();
  const int nN = N / (64 * NJ), nunits = (K >> 6) * nN;
  for (int u = first_unit(base); u < nunits; u += gridDim.x) {
    const int k0 = (u / nN) << 6, n0 = (u % nN) * (64 * NJ);
    float4 v[2][NJ];
#pragma unroll
    for (int i = 0; i < 2; ++i)
#pragma unroll
      for (int j = 0; j < NJ; ++j)
        v[i][j] = *(const float4*)(src + (size_t)(k0 + (tid >> 4) + 32 * i) * N + n0 + (tid & 15) * 4 + 64 * j);
#pragma unroll
    for (int i = 0; i < 2; ++i)
#pragma unroll
      for (int j = 0; j < NJ; ++j) {
        const int r = (tid >> 4) + 32 * i, c4 = (tid & 15) * 4 + 64 * j;
        tl[(c4 + 0) * 72 + r] = f2bf(v[i][j].x); tl[(c4 + 1) * 72 + r] = f2bf(v[i][j].y);
        tl[(c4 + 2) * 72 + r] = f2bf(v[i][j].z); tl[(c4 + 3) * 72 + r] = f2bf(v[i][j].w);
      }
    __syncthreads();
#pragma unroll
    for (int j = 0; j < NJ; ++j) {
      const int n = (tid >> 3) + 64 * j, kc = (tid & 7) * 8;
      const uint4 o = *(const uint4*)(tl + n * 72 + kc);
      *(uint4*)(dst + (size_t)rowmap<MODE>(n0 + n, row0) * K + k0 + kc) = o;
    }
    __syncthreads();
  }
  base += nunits;
}

DI void convert_ffn_weights(const PV& p, int l, char* smem, int& base) {
  convT<1>(p.in(32) + (size_t)l * 1024 * 5632, (u16*)(p.ws() + OFF_WUP), 1024, 5632, 0, smem, base);
  convT<0>(p.in(35) + (size_t)l * 2816 * 1024, (u16*)(p.ws() + OFF_WDOWN), 2816, 1024, 0, smem, base);
}

DI void phase_prep(const PV& p, char* smem) {
  const int tid = TIDX();
  int base = 0;
  char* ws = p.ws();
  for (int i = 0; i < 2; ++i) {
    convT<0>(p.in(9) + (size_t)i * 1024 * 2560, (u16*)(ws + OFF_WMIXIN) + (size_t)i * 2560 * 1024, 1024, 2560, 0, smem, base);
    convT<0>(p.in(22) + (size_t)i * 1024 * 1024, (u16*)(ws + OFF_WMIXOUT) + (size_t)i * 1024 * 1024, 1024, 1024, 0, smem, base);
    convT<0>(p.in(23) + (size_t)i * 1024 * 512, (u16*)(ws + OFF_WDQKV) + (size_t)i * 1024 * 1024, 1024, 512, 0, smem, base);
    convT<0, 1>(p.in(26) + (size_t)i * 1024 * 320, (u16*)(ws + OFF_WDQKV) + (size_t)i * 1024 * 1024, 1024, 320, 512, smem, base);
    convT<0>(p.in(25) + (size_t)i * 512 * 1536, (u16*)(ws + OFF_WUQ) + (size_t)i * 1536 * 512, 512, 1536, 0, smem, base);
    convT<0>(p.in(28) + (size_t)i * 256 * 2048, (u16*)(ws + OFF_WUKV) + (size_t)i * 2048 * 256, 256, 2048, 0, smem, base);
    convT<0>(p.in(31) + (size_t)i * 1024 * 1024, (u16*)(ws + OFF_WO) + (size_t)i * 1024 * 1024, 1024, 1024, 0, smem, base);
  }
  convert_ffn_weights(p, 0, smem, base);
  {
    const long gtid = (long)blockIdx.x * blockDim.x + tid, gsz = (long)gridDim.x * blockDim.x;
    for (long i = gtid; i < 2 * 192 * 1024; i += gsz) {
      const int j = (int)(i / (192 * 1024)), r = (int)(i % (192 * 1024));
      ((u16*)(ws + OFF_WDQKV))[(size_t)j * 1024 * 1024 + (size_t)832 * 1024 + r] = 0;
    }
    for (long i = gtid; i < 2 * 4 * 128 * 128; i += gsz) ((u16*)(ws + OFF_WSGU))[i] = f2bf(p.in(10)[i]);
    for (long i = gtid; i < 64 * 16; i += gsz) {
      const int pos = (int)(i >> 4), f = (int)(i & 15);
      const float inv = exp2f(-(float)f * (13.287712379549449f / 16.f));
      float sn, cs;
      sincosf((float)pos * inv, &sn, &cs);
      ((float2*)(ws + OFF_ROPE))[i] = make_float2(cs, sn);
    }
  }
  {
    float* sc = (float*)smem;
    float* part = sc + 9 * 1024;
    __syncthreads();
    for (int i = tid; i < 9 * 1024; i += 512) {
      const int r = i >> 10, k = i & 1023;
      const float c = r == 0 ? p.in(5)[k] : p.in(4)[(r - 1) * 1024 + k];
      sc[i] = silu(c);
    }
    __syncthreads();
    float* MOD = (float*)(ws + OFF_MOD);
    const int nunits = 4 * 96;
    for (int u = first_unit(base); u < nunits; u += gridDim.x) {
      const int l = u / 96, n0 = (u % 96) * 64;
      const int col = n0 + (tid & 63), kg = tid >> 6;
      float acc[9];
#pragma unroll
      for (int r = 0; r < 9; ++r) acc[r] = 0.f;
      const float* w = p.in(6) + (size_t)l * 1024 * 6144 + col;
#pragma unroll 16
      for (int k = kg * 128; k < kg * 128 + 128; ++k) {
        const float wv = w[(size_t)k * 6144];
#pragma unroll
        for (int r = 0; r < 9; ++r) acc[r] += sc[r * 1024 + k] * wv;
      }
#pragma unroll
      for (int r = 0; r < 9; ++r) part[(kg * 9 + r) * 64 + (tid & 63)] = acc[r];
      __syncthreads();
      for (int i = tid; i < 576; i += 512) {
        const int r = i >> 6, cc = i & 63;
        float s = p.in(7)[l * 6144 + n0 + cc];
#pragma unroll
        for (int g = 0; g < 8; ++g) s += part[(g * 9 + r) * 64 + cc];
        MOD[(size_t)(l * 9 + r) * 6144 + n0 + cc] = s;
      }
      __syncthreads();
    }
    base += nunits;
  }
  {
    float* zf = (float*)smem;
    float* h1 = zf + 8 * 36;
    float* H2 = (float*)(ws + OFF_H2);
    const int nunits = 2 * 544;
    for (int u = first_unit(base); u < nunits; u += gridDim.x) {
      const int i = u / 544, tg0 = (u % 544) * 8;
      __syncthreads();
      if (tid < 8 * 33) {
        const int tt = tid / 33, e = tid % 33;
        const int tg = tg0 + tt;
        const float L = tg < 256 ? 256.f : 4096.f;
        const float t = tg < 256 ? (float)tg : (float)(tg - 256);
        const float tn = t / L;
        float v;
        if (e == 0) v = tn;
        else if (e <= 16) v = sinf((6.283185307179586f * tn) * (float)e);
        else v = cosf((6.283185307179586f * tn) * (float)(e - 16));
        zf[tt * 36 + e] = v;
      }
      __syncthreads();
      const int tt = tid >> 6, jj = tid & 63;
      const float fr = p.in(19)[i * 64 + jj];
      {
        float a = p.in(15)[i * 64 + jj];
        const float* w1 = p.in(14) + (size_t)i * 33 * 64 + jj;
        for (int e = 0; e < 33; ++e) a += zf[tt * 36 + e] * w1[e * 64];
        h1[tt * 64 + jj] = sinf(fr * a);
      }
      __syncthreads();
      {
        float a = p.in(17)[i * 64 + jj];
        const float* w2 = p.in(16) + (size_t)i * 64 * 64 + jj;
        for (int e = 0; e < 64; ++e) a += h1[tt * 64 + e] * w2[e * 64];
        H2[((size_t)i * 4352 + tg0 + tt) * 64 + jj] = sinf(fr * a);
      }
    }
    base += nunits;
    __syncthreads();
  }
}

DI void phase_filters(const PV& p, char* smem) {
  const int tid = TIDX();
  float* w3s = (float*)smem;
  float* red = w3s + 512;
  float* nrm = red + 512;
  float* hbuf = nrm + 8;
  const float* H2 = (const float*)(p.ws() + OFF_H2);
  u16* FILT = (u16*)(p.ws() + OFF_FILT);
  for (int u = blockIdx.x; u < 512; u += gridDim.x) {
    const int kind = (u >> 7) & 1, i = u >> 8, cg8 = (u & 127) * 8;
    const int L = kind ? 4096 : 256, tbase = kind ? 256 : 0;
    __syncthreads();
    { const int j = tid >> 3, cc = tid & 7; w3s[j * 8 + cc] = p.in(18)[((size_t)i * 64 + j) * 1024 + cg8 + cc]; }
    __syncthreads();
    const int cc = tid & 7, tq = tid >> 3;
    const int col = cg8 + cc, o = col >> 9, c = col & 511;
    const float dec = fabsf(p.in(20)[(i * 2 + o) * 512 + c]);
    float asum = 0.f;
    for (int t = tq; t < L; t += 64) {
      const float4* hr = (const float4*)(H2 + ((size_t)i * 4352 + tbase + t) * 64);
      float a = 0.f;
#pragma unroll
      for (int j4 = 0; j4 < 16; ++j4) {
        const float4 hv = hr[j4];
        a += hv.x * w3s[(j4 * 4 + 0) * 8 + cc]; a += hv.y * w3s[(j4 * 4 + 1) * 8 + cc];
        a += hv.z * w3s[(j4 * 4 + 2) * 8 + cc]; a += hv.w * w3s[(j4 * 4 + 3) * 8 + cc];
      }
      const float dist = fabsf((float)(t - L / 2)) / (float)L;
      a *= expf(-dec * dist);
      hbuf[cc * L + t] = a;
      asum += fabsf(a);
    }
    red[tid] = asum;
    __syncthreads();
    if (tid < 8) { float s = 0.f; for (int q = 0; q < 64; ++q) s += red[q * 8 + tid]; nrm[tid] = 1.f / (s + EPS); }
    __syncthreads();
    for (int idx = tid; idx < 8 * L; idx += 512) {
      const int c2 = idx / L, t = idx - c2 * L;
      const int col2 = cg8 + c2, o2 = col2 >> 9, cch = col2 & 511;
      FILT[((size_t)(i * 2 + o2) * 512 + cch) * 4352 + tbase + t] = f2bf(hbuf[c2 * L + t] * nrm[c2]);
    }
  }
  __syncthreads();
}

DI void phase_norm(const PV& p, int l, int part, int lx) {
  const int tid_ = TIDX(); const int lane = tid_ & 63, wid = tid_ >> 6;
  const float* MOD = (const float*)(p.ws() + OFF_MOD);
  const float* g = p.in(8) + (size_t)(l * 2 + part) * 1024;
  u16* H = (u16*)(p.ws() + OFF_A + A_H);
  const int stride = gridDim.x * 8;
  for (int row0 = blockIdx.x * 8 + wid; row0 < T; row0 += 2 * stride) {
    float4 v[2][4];
#pragma unroll
    for (int w = 0; w < 2; ++w) {
      const int row = row0 + w * stride;
      if (row < T) {
        const float* xr = xin_row(p, lx, row);
#pragma unroll
        for (int i = 0; i < 4; ++i) v[w][i] = *(const float4*)(xr + (i * 64 + lane) * 4);
      }
    }
#pragma unroll
    for (int w = 0; w < 2; ++w) {
      const int row = row0 + w * stride;
      if (row < T) {
        float ss = 0.f;
#pragma unroll
        for (int i = 0; i < 4; ++i) ss += v[w][i].x * v[w][i].x + v[w][i].y * v[w][i].y + v[w][i].z * v[w][i].z + v[w][i].w * v[w][i].w;
        ss = wave_sum(ss, lane);
        const float r = rsqrtf(ss * (1.f / 1024.f) + EPS);
        const float* mr = MOD + (size_t)(l * 9 + condrow(row)) * 6144 + part * 3072;
#pragma unroll
        for (int i = 0; i < 4; ++i) {
          const int k = (i * 64 + lane) * 4;
          const float4 gv = *(const float4*)(g + k), sh = *(const float4*)(mr + k), sc = *(const float4*)(mr + 1024 + k);
          const float a = v[w][i].x * r * gv.x * (1.f + sc.x) + sh.x;
          const float b = v[w][i].y * r * gv.y * (1.f + sc.y) + sh.y;
          const float c = v[w][i].z * r * gv.z * (1.f + sc.z) + sh.z;
          const float d = v[w][i].w * r * gv.w * (1.f + sc.w) + sh.w;
          *(uint2*)(H + (size_t)row * 1024 + k) = pack4(a, b, c, d);
        }
      }
    }
  }
}

template <bool SWAP, class Epi, class Pre>
DI void gemm_tile(const u16* A, int lda, const u16* Bt, int ldb, int K, int m0, int n0, char* smem, Epi epi, Pre pre) {
  const int tid = TIDX(), lane = tid & 63, wid = tid >> 6;
  const int wm = wid >> 1, wn = wid & 1, fr = lane & 15, fq = lane >> 4;
  const int lrow = tid >> 3, kc = tid & 7;
  const u16* ga = A + (size_t)(m0 + lrow) * lda + kc * 8;
  const u16* gb = Bt + (size_t)(n0 + lrow) * ldb + kc * 8;
  const int soff = lrow * 128 + ((kc ^ (lrow & 7)) << 4);
  uint4 ra[4], rb[2];
  f32x4 acc[4][4];
#pragma unroll
  for (int i = 0; i < 4; ++i)
#pragma unroll
    for (int j = 0; j < 4; ++j) acc[i][j] = f32x4{0.f, 0.f, 0.f, 0.f};
  const int nk = K >> 6;
#pragma unroll
  for (int i = 0; i < 4; ++i) ra[i] = *(const uint4*)(ga + (size_t)(64 * i) * lda);
#pragma unroll
  for (int i = 0; i < 2; ++i) rb[i] = *(const uint4*)(gb + (size_t)(64 * i) * ldb);
#pragma unroll
  for (int i = 0; i < 4; ++i) *(uint4*)(smem + soff + i * 8192) = ra[i];
#pragma unroll
  for (int i = 0; i < 2; ++i) *(uint4*)(smem + 32768 + soff + i * 8192) = rb[i];
  __syncthreads();
  for (int kt = 0; kt < nk; ++kt) {
    const bool more = kt + 1 < nk;
    if (more) {
      const int k0 = (kt + 1) << 6;
#pragma unroll
      for (int i = 0; i < 4; ++i) ra[i] = *(const uint4*)(ga + (size_t)(64 * i) * lda + k0);
#pragma unroll
      for (int i = 0; i < 2; ++i) rb[i] = *(const uint4*)(gb + (size_t)(64 * i) * ldb + k0);
    }
    const char* sa = smem + (kt & 1) * 49152;
    const char* sb = sa + 32768;
#pragma unroll
    for (int ks = 0; ks < 2; ++ks) {
      bf16x8 af[4], bfv[4];
      const int co = ((ks * 4 + fq) ^ (fr & 7)) << 4;
#pragma unroll
      for (int mi = 0; mi < 4; ++mi) af[mi] = *(const bf16x8*)(sa + (wm * 64 + mi * 16 + fr) * 128 + co);
#pragma unroll
      for (int ni = 0; ni < 4; ++ni) bfv[ni] = *(const bf16x8*)(sb + (wn * 64 + ni * 16 + fr) * 128 + co);
#pragma unroll
      for (int mi = 0; mi < 4; ++mi)
#pragma unroll
        for (int ni = 0; ni < 4; ++ni)
          acc[mi][ni] = SWAP ? __builtin_amdgcn_mfma_f32_16x16x32_bf16(bfv[ni], af[mi], acc[mi][ni], 0, 0, 0)
                             : __builtin_amdgcn_mfma_f32_16x16x32_bf16(af[mi], bfv[ni], acc[mi][ni], 0, 0, 0);
    }
    if (more) {
      char* da = smem + ((kt + 1) & 1) * 49152;
#pragma unroll
      for (int i = 0; i < 4; ++i) *(uint4*)(da + soff + i * 8192) = ra[i];
#pragma unroll
      for (int i = 0; i < 2; ++i) *(uint4*)(da + 32768 + soff + i * 8192) = rb[i];
    }
    __syncthreads();
  }
  uint2 pv[4][4];
#pragma unroll
  for (int mi = 0; mi < 4; ++mi)
#pragma unroll
    for (int ni = 0; ni < 4; ++ni) {
      if (SWAP) pv[mi][ni] = pre(m0 + wm * 64 + mi * 16 + fr, n0 + wn * 64 + ni * 16 + fq * 4);
      else pv[mi][ni] = pre(m0 + wm * 64 + mi * 16 + fq * 4, n0 + wn * 64 + ni * 16 + fr);
    }
#pragma unroll
  for (int mi = 0; mi < 4; ++mi)
#pragma unroll
    for (int ni = 0; ni < 4; ++ni) {
      if (SWAP) epi(m0 + wm * 64 + mi * 16 + fr, n0 + wn * 64 + ni * 16 + fq * 4, acc[mi][ni], pv[mi][ni]);
      else epi(m0 + wm * 64 + mi * 16 + fq * 4, n0 + wn * 64 + ni * 16 + fr, acc[mi][ni], pv[mi][ni]);
    }
}

template <class F>
DI void for_tiles(int nM, int nN, int sm, int sn, F f) {
  if (gridDim.x == 256) {
    const int xcd = blockIdx.x & 7, slot = blockIdx.x >> 3;
    const int am = slot % sm, bn = slot / sm;
    const int nSN = (nN + sn - 1) / sn, nS = (nM / sm) * nSN;
    for (int st = xcd; st < nS; st += 8) {
      const int tm = (st / nSN) * sm + am, tn = (st % nSN) * sn + bn;
      if (tn < nN) f(tm, tn);
    }
  } else {
    for (int t = blockIdx.x; t < nM * nN; t += gridDim.x) f(t / nN, t % nN);
  }
}


#define LAS __attribute__((address_space(3)))
constexpr int G8_HTB = 128 * 64 * 2;
DI int g8_lds_byte(int r, int c) { const int st = (r >> 4) * 2 + (c >> 5), rr = r & 15, cc = c & 31, ob = rr * 64 + cc * 2; return st * 1024 + (ob ^ (((ob >> 9) & 1) << 5)); }
DI void g8_stage_rc(int b, int& R, int& C) { const int st = b / 1024, sb = b % 1024, swz = sb ^ (((sb >> 9) & 1) << 5); R = (st >> 1) * 16 + swz / 64; C = (st & 1) * 32 + (swz % 64) / 2; }
template <int NM, int NN, int NN1, int SM1, int SN1, int SM2, int SN2>
struct TileSched {
  static constexpr int nSN1 = NN1 / SN1, nS1 = (NM / SM1) * nSN1, nSN2 = (NN - NN1) / SN2, nS2 = (NM / SM2) * nSN2, nT = NM * NN;
  int c;
  DI void init() { c = blockIdx.x; }
  DI bool next(int i, int& pm, int& pn) const {
    if (gridDim.x == 256) {
      const int xcd = c & 7, slot = c >> 3;
      int st = xcd + 8 * i;
      if (st < nS1) { pm = (st / nSN1) * SM1 + slot % SM1; pn = (st % nSN1) * SN1 + slot / SM1; return true; }
      st -= nS1;
      if (nS2 == 0 || st >= nS2) return false;
      pm = (st / (nSN2 > 0 ? nSN2 : 1)) * SM2 + slot % SM2; pn = NN1 + (st % (nSN2 > 0 ? nSN2 : 1)) * SN2 + slot / SM2; return true;
    }
    const int L = i * (int)gridDim.x + c; if (L >= nT) return false; pm = L / NN; pn = L % NN; return true;
  }
};
template <bool ABLK = false, class Sched, class Epi>
DI void gemm8(char* smem, const u16* A, const u16* Bt, int K, const Sched& S, const Epi& E) {
  LAS unsigned char* lds = (LAS unsigned char*)smem;
  const int tid = TIDX(), wid = __builtin_amdgcn_readfirstlane(tid >> 6), lane = tid & 63, wr = wid >> 2, wc = wid & 3, fr = lane & 15, fq = lane >> 4;
  const int nt = K / 64;
  unsigned voff[2], voffA[2];
#pragma unroll
  for (int i = 0; i < 2; ++i) { int R, C; g8_stage_rc(tid * 16 + i * 8192, R, C); voff[i] = (unsigned)(R * K + C) * 2u; voffA[i] = ABLK ? (unsigned)(R * 64 + C) * 2u : voff[i]; }
  const size_t kstep = 128, hstep = (size_t)128 * K * 2, tstep = 2 * hstep;
  const size_t kstepA = ABLK ? 32768 : kstep, hstepA = ABLK ? 16384 : hstep;
  const unsigned ldsw = (unsigned)wid * 1024u;
  const int aoff = g8_lds_byte(wr * 64 + fr, fq * 8), boff = g8_lds_byte(wc * 32 + fr, fq * 8);
#define G8_SA(b, h) (((b) * 2 + (h)) * G8_HTB)
#define G8_SB(b, h) ((4 + (b) * 2 + (h)) * G8_HTB)
#define G8_STAGE(bufoff, gbase) do { _Pragma("unroll") for (int _i = 0; _i < 2; ++_i) \
    __builtin_amdgcn_global_load_lds((const unsigned*)((const char*)(gbase) + voff[_i]), (LAS unsigned*)(lds + (bufoff) + ldsw + _i * 8192), 16, 0, 0); } while (0)
#define G8_STAGEA(bufoff, gbase) do { _Pragma("unroll") for (int _i = 0; _i < 2; ++_i) \
    __builtin_amdgcn_global_load_lds((const unsigned*)((const char*)(gbase) + voffA[_i]), (LAS unsigned*)(lds + (bufoff) + ldsw + _i * 8192), 16, 0, 0); } while (0)
#define G8_LDA(dst, b, h) do { _Pragma("unroll") for (int m = 0; m < 4; ++m) _Pragma("unroll") for (int k = 0; k < 2; ++k) dst[m][k] = *(const LAS bf16x8*)(lds + G8_SA(b, h) + aoff + m * 2048 + k * 1024); } while (0)
#define G8_LDB(dst, b, h) do { _Pragma("unroll") for (int n = 0; n < 2; ++n) _Pragma("unroll") for (int k = 0; k < 2; ++k) dst[n][k] = *(const LAS bf16x8*)(lds + G8_SB(b, h) + boff + n * 2048 + k * 1024); } while (0)
#define G8_MMA(ai, bj, At_, Bt_) do { __builtin_amdgcn_s_setprio(1); _Pragma("unroll") for (int m = 0; m < 4; ++m) _Pragma("unroll") for (int n = 0; n < 2; ++n) _Pragma("unroll") for (int k = 0; k < 2; ++k) \
    acc[ai][bj][m][n] = __builtin_amdgcn_mfma_f32_16x16x32_bf16(Bt_[n][k], At_[m][k], acc[ai][bj][m][n], 0, 0, 0); __builtin_amdgcn_s_setprio(0); } while (0)
#define G8_WAIT_V(n) asm volatile("s_waitcnt vmcnt(" #n ")" ::: "memory")
#define G8_WAIT_L(n) asm volatile("s_waitcnt lgkmcnt(" #n ")" ::: "memory")
#define G8_BAR __builtin_amdgcn_s_barrier()
#define G8_SCHED __builtin_amdgcn_sched_barrier(0)
  int cpm, cpn, npm = 0, npn = 0, ui = 0;
  if (!S.next(0, cpm, cpn)) return;
  f32x4 acc[2][2][4][2];
#pragma unroll
  for (int a = 0; a < 2; ++a)
#pragma unroll
    for (int b = 0; b < 2; ++b)
#pragma unroll
      for (int m = 0; m < 4; ++m)
#pragma unroll
        for (int n = 0; n < 2; ++n) acc[a][b][m][n] = f32x4{0.f, 0.f, 0.f, 0.f};
  bf16x8 At[4][2], B0[2][2], B1[2][2];
  const char* cA = (const char*)A + (size_t)cpm * tstep; const char* cB = (const char*)Bt + (size_t)cpn * tstep;
  G8_STAGE(G8_SB(0, 0), cB); G8_STAGEA(G8_SA(0, 0), cA); G8_STAGE(G8_SB(0, 1), cB + hstep); G8_STAGEA(G8_SA(0, 1), cA + hstepA);
  if (wr == 1) G8_BAR;
  G8_WAIT_V(4); G8_BAR;
  G8_STAGE(G8_SB(1, 0), cB + kstep); G8_STAGEA(G8_SA(1, 0), cA + kstepA); G8_STAGE(G8_SB(1, 1), cB + hstep + kstep);
  G8_WAIT_V(6); G8_BAR;
  for (;;) {
    const bool has_next = S.next(ui + 1, npm, npn);
    const char* nA = has_next ? (const char*)A + (size_t)npm * tstep : cA; const char* nB = has_next ? (const char*)Bt + (size_t)npn * tstep : cB;
#pragma unroll 1
    for (int t = 0; t < nt; t += 2) {
      const bool last = (t == nt - 2);
      const char* a1 = cA + (size_t)(t + 1) * kstepA;
      const char* a2 = last ? nA : cA + (size_t)(t + 2) * kstepA; const char* b2 = last ? nB : cB + (size_t)(t + 2) * kstep;
      const char* a3 = a2 + kstepA; const char* b3 = b2 + kstep;
      G8_LDB(B0, 0, 0); G8_SCHED; G8_LDA(At, 0, 0); G8_STAGEA(G8_SA(1, 1), a1 + hstepA);
      G8_WAIT_L(8); G8_BAR; G8_WAIT_L(0); G8_MMA(0, 0, At, B0); G8_BAR; G8_SCHED;
      G8_LDB(B1, 0, 1); G8_STAGE(G8_SB(0, 0), b2);
      G8_BAR; G8_WAIT_L(0); G8_MMA(0, 1, At, B1); G8_BAR;
      G8_LDA(At, 0, 1); G8_STAGEA(G8_SA(0, 0), a2);
      G8_BAR; G8_WAIT_L(0); G8_MMA(1, 0, At, B0); G8_BAR; G8_SCHED;
      G8_STAGE(G8_SB(0, 1), b2 + hstep);
      G8_WAIT_V(6); G8_BAR; G8_MMA(1, 1, At, B1); G8_BAR;
      G8_LDB(B0, 1, 0); G8_SCHED; G8_LDA(At, 1, 0); G8_STAGEA(G8_SA(0, 1), a2 + hstepA);
      G8_WAIT_L(8); G8_BAR; G8_WAIT_L(0); G8_MMA(0, 0, At, B0); G8_BAR; G8_SCHED;
      G8_LDB(B1, 1, 1); G8_STAGE(G8_SB(1, 0), b3);
      G8_BAR; G8_WAIT_L(0); G8_MMA(0, 1, At, B1); G8_BAR;
      G8_LDA(At, 1, 1); G8_STAGEA(G8_SA(1, 0), a3);
      G8_BAR; G8_WAIT_L(0); G8_MMA(1, 0, At, B0); G8_BAR; G8_SCHED;
      G8_STAGE(G8_SB(1, 1), b3 + hstep);
      G8_WAIT_V(6); G8_BAR; G8_MMA(1, 1, At, B1); G8_BAR;
    }
    { const int t2 = TIDX(), w2 = __builtin_amdgcn_readfirstlane(t2 >> 6), l2 = t2 & 63; E(acc, cpm, cpn, w2 >> 2, w2 & 3, l2 & 15, l2 >> 4); }
    if (!has_next) break;
#pragma unroll
    for (int a = 0; a < 2; ++a)
#pragma unroll
      for (int b = 0; b < 2; ++b)
#pragma unroll
        for (int m = 0; m < 4; ++m)
#pragma unroll
          for (int n = 0; n < 2; ++n) acc[a][b][m][n] = f32x4{0.f, 0.f, 0.f, 0.f};
    cpm = npm; cpn = npn; cA = nA; cB = nB; ++ui;
  }
  G8_WAIT_V(0);
  if (wr == 0) G8_BAR;
  G8_BAR;
#undef G8_SA
#undef G8_SB
#undef G8_STAGE
#undef G8_STAGEA
#undef G8_LDA
#undef G8_LDB
#undef G8_MMA
#undef G8_WAIT_V
#undef G8_WAIT_L
#undef G8_BAR
#undef G8_SCHED
}
template <bool ABLK, class Epi>
DI void gemm_half(char* smem, const u16* A, const u16* Bt, int K, int pm, int pn, int nh, const Epi& E) {
  LAS unsigned char* lds = (LAS unsigned char*)smem;
  const int tid = TIDX(), wid = __builtin_amdgcn_readfirstlane(tid >> 6), lane = tid & 63, wr = wid >> 2, wc = wid & 3, fr = lane & 15, fq = lane >> 4;
  const int nt = K / 64;
  unsigned voff[2], voffA[2];
#pragma unroll
  for (int i = 0; i < 2; ++i) { int R, C; g8_stage_rc(tid * 16 + i * 8192, R, C); voff[i] = (unsigned)(R * K + C) * 2u; voffA[i] = ABLK ? (unsigned)(R * 64 + C) * 2u : voff[i]; }
  const size_t kstep = 128, hstep = (size_t)128 * K * 2, tstep = 2 * hstep;
  const size_t kstepA = ABLK ? 32768 : kstep, hstepA = ABLK ? 16384 : hstep;
  const unsigned ldsw = (unsigned)wid * 1024u;
  const int aoff = g8_lds_byte(wr * 64 + fr, fq * 8), boff = g8_lds_byte(wc * 32 + fr, fq * 8);
  const char* cA = (const char*)A + (size_t)pm * tstep;
  const char* cB = (const char*)Bt + (size_t)pn * tstep + (size_t)nh * hstep;
#define GH_STAGE(s_, kt_) do { _Pragma("unroll") for (int _i = 0; _i < 2; ++_i) { \
    __builtin_amdgcn_global_load_lds((const unsigned*)(cB + (size_t)(kt_) * kstep + voff[_i]), (LAS unsigned*)(lds + (s_) * 49152 + ldsw + _i * 8192), 16, 0, 0); \
    __builtin_amdgcn_global_load_lds((const unsigned*)(cA + (size_t)(kt_) * kstepA + voffA[_i]), (LAS unsigned*)(lds + (s_) * 49152 + 16384 + ldsw + _i * 8192), 16, 0, 0); \
    __builtin_amdgcn_global_load_lds((const unsigned*)(cA + hstepA + (size_t)(kt_) * kstepA + voffA[_i]), (LAS unsigned*)(lds + (s_) * 49152 + 32768 + ldsw + _i * 8192), 16, 0, 0); } } while (0)
  f32x4 acc[2][4][2];
#pragma unroll
  for (int a = 0; a < 2; ++a)
#pragma unroll
    for (int m = 0; m < 4; ++m)
#pragma unroll
      for (int n = 0; n < 2; ++n) acc[a][m][n] = f32x4{0.f, 0.f, 0.f, 0.f};
  __syncthreads();
  GH_STAGE(0, 0);
  asm volatile("s_waitcnt vmcnt(0)" ::: "memory");
  __syncthreads();
#pragma unroll 1
  for (int kt = 0; kt < nt; ++kt) {
    if (kt + 1 < nt) GH_STAGE((kt + 1) & 1, kt + 1);
    const LAS unsigned char* base = lds + (kt & 1) * 49152;
    bf16x8 B0[2][2];
#pragma unroll
    for (int n = 0; n < 2; ++n)
#pragma unroll
      for (int k = 0; k < 2; ++k) B0[n][k] = *(const LAS bf16x8*)(base + boff + n * 2048 + k * 1024);
#pragma unroll
    for (int ai = 0; ai < 2; ++ai) {
      bf16x8 At[4][2];
#pragma unroll
      for (int m = 0; m < 4; ++m)
#pragma unroll
        for (int k = 0; k < 2; ++k) At[m][k] = *(const LAS bf16x8*)(base + 16384 + ai * 16384 + aoff + m * 2048 + k * 1024);
#pragma unroll
      for (int m = 0; m < 4; ++m)
#pragma unroll
        for (int n = 0; n < 2; ++n)
#pragma unroll
          for (int k = 0; k < 2; ++k) acc[ai][m][n] = __builtin_amdgcn_mfma_f32_16x16x32_bf16(B0[n][k], At[m][k], acc[ai][m][n], 0, 0, 0);
    }
    asm volatile("s_waitcnt vmcnt(0)" ::: "memory");
    __syncthreads();
  }
#undef GH_STAGE
  E(acc, pm, pn, nh, wr, wc, fr, fq);
}

template <class F> struct ElemEpi {
  F f;
  DI void operator()(const f32x4 (&acc)[2][2][4][2], int pm, int pn, int wr, int wc, int fr, int fq) const {
    const int row0 = pm * 256 + wr * 64 + fr, col0 = pn * 256 + wc * 32 + 4 * fq;
#pragma unroll
    for (int ai = 0; ai < 2; ++ai)
#pragma unroll
      for (int m = 0; m < 4; ++m)
#pragma unroll
        for (int bj = 0; bj < 2; ++bj)
#pragma unroll
          for (int n = 0; n < 2; ++n) f(row0 + ai * 128 + m * 16, col0 + bj * 128 + n * 16, acc[ai][bj][m][n]);
  }
};
template <class F> DI ElemEpi<F> make_epi(F f) { return ElemEpi<F>{f}; }
template <int NM, int NN, int NN1, int SM1, int SN1, int SM2, int SN2, class F>
DI void gemm8_job(char* smem, const u16* A, const u16* Bt, int K, F f) {
  TileSched<NM, NN, NN1, SM1, SN1, SM2, SN2> S; S.init();
  gemm8(smem, A, Bt, K, S, make_epi(f));
}

DI void phase_mix_in(const PV& p, int i, char* smem) {
  const u16* H = (const u16*)(p.ws() + OFF_A + A_H);
  const u16* W = (const u16*)(p.ws() + OFF_WMIXIN) + (size_t)i * 2560 * 1024;
  u16* MIX = (u16*)(p.ws() + OFF_B + B_MIX);
  u16* VT = (u16*)(p.ws() + OFF_B + B_VT);
  u16* PRT = (u16*)(p.ws() + OFF_B + B_PRT);
  auto epi = [=](int m, int n, f32x4 v) {
    if (n < 512) {
      *(uint2*)(MIX + (size_t)m * 1024 + n) = pack4(gelu_tanh(v[0]), gelu_tanh(v[1]), gelu_tanh(v[2]), gelu_tanh(v[3]));
    } else if (n < 1024) {
      const int nn = n - 512, g = nn >> 7, c = nn & 127, chunk = m >> 7, q = m & 127;
      u16* b = VT + ((size_t)(g * 320 + chunk) * 128 + c) * 128 + q;
#pragma unroll
      for (int j = 0; j < 4; ++j) b[j * 128] = f2bf(gelu_tanh(v[j]));
    } else {
      const int cp = n - 1024;
      size_t off; int stride;
      if (m < TP) { off = (size_t)(m & ~255) * 1536 + (size_t)cp * 256 + (m & 255); stride = 256; }
      else { const int mm = m - TP; off = (size_t)(TP + (mm & ~4095)) * 1536 + (size_t)cp * 4096 + (mm & 4095); stride = 4096; }
#pragma unroll
      for (int j = 0; j < 4; ++j) PRT[off + (size_t)j * stride] = f2bf(v[j]);
    }
  };
  gemm8_job<160, 10, 8, 8, 4, 16, 2>(smem, H, W, 1024, epi);
}

DI void phase_sgu(const PV& p, int i, char* smem) {
  const u16* VT = (const u16*)(p.ws() + OFF_B + B_VT);
  const u16* W = (const u16*)(p.ws() + OFF_WSGU) + (size_t)i * 4 * 16384;
  u16* MIX = (u16*)(p.ws() + OFF_B + B_MIX);
  const float* sb = p.in(11) + i * 512;
  for (int u = blockIdx.x; u < 640; u += gridDim.x) {
    const int g = u / 160, tm = u % 160;
    auto epi = [=](int m, int n, f32x4 v, uint2 uu) {
      const int chunk = m >> 7, c = m & 127;
      const int t = chunk * 128 + n;
      const float bias = sb[g * 128 + n];
      u16* dst = MIX + (size_t)t * 1024 + g * 128 + c;
      *(uint2*)dst = pack4(lo16(uu.x) * (v[0] + bias), hi16(uu.x) * (v[1] + bias), lo16(uu.y) * (v[2] + bias), hi16(uu.y) * (v[3] + bias));
    };
    auto pre = [=](int m, int n) { return *(const uint2*)(MIX + (size_t)((m >> 7) * 128 + n) * 1024 + g * 128 + (m & 127)); };
    gemm_tile<false>(VT + (size_t)g * 320 * 128 * 128, 128, W + (size_t)g * 16384, 128, 128, tm * 256, 0, smem, epi, pre);
  }
}

DI size_t prt_off(int kind, int b, int cp) {
  return kind ? (size_t)(TP + b * 4096) * 1536 + (size_t)cp * 4096 : (size_t)(b * 256) * 1536 + (size_t)cp * 256;
}
DI size_t zt_off(int kind, int b, int c) {
  return kind ? (size_t)(TP + b * 4096) * 512 + (size_t)c * 4096 : (size_t)(b * 256) * 512 + (size_t)c * 256;
}
DI void phase_conv(const PV& p, int i, int ord, char* smem) {
  const int tid = TIDX(), lane = tid & 63, wid = tid >> 6;
  const u16* PRT = (const u16*)(p.ws() + OFF_B + B_PRT);
  const u16* FILT = (const u16*)(p.ws() + OFF_FILT);
  const u16* Z1 = (const u16*)(p.ws() + OFF_A + A_Z1);
  u16* ZO = (u16*)(p.ws() + OFF_A + (ord ? A_Z2 : A_Z1));
  const float* cw = p.in(12) + (size_t)i * 3 * 1536;
  const float* cb = p.in(13) + (size_t)i * 1536;
  u16* hc = (u16*)smem;
  char* Ub = smem + 68096;
  for (int u = blockIdx.x; u < 1024; u += gridDim.x) {
    const int kind = u < 512 ? 1 : 0, c = u & 511;
    const int L = kind ? 4096 : 256, NB = kind ? 8 : 32, LB = L >> 6, DD = L >> 7;
    const int US = (L + 8) * 2;
    const size_t fbase = ((size_t)(i * 2 + ord) * 512 + c) * 4352 + (kind ? 256 : 0);
    __syncthreads();
    {
      u16* tmp = (u16*)Ub;
      for (int idx = tid; idx < (L >> 3); idx += 512) *(uint4*)(tmp + idx * 8) = *(const uint4*)(FILT + fbase + idx * 8);
      __syncthreads();
      for (int idx = tid; idx < 8 * (L + 136); idx += 512) {
        const int cpy = idx / (L + 136), m = idx - cpy * (L + 136);
        const int x = L + 63 - m - cpy;
        hc[cpy * 4256 + m] = (x >= 0 && x < L) ? tmp[x] : (u16)0;
      }
      __syncthreads();
    }
    {
      const int ncr = L >> 3, total = NB * ncr;
      const float w0 = cw[c], w1 = cw[1536 + c], w2 = cw[3072 + c], bb = cb[c];
      for (int id = tid; id < total; id += 512) {
        const int b = id / ncr, t = (id - b * ncr) * 8;
        uint4 o;
        if (ord == 0) {
          const u16* src = PRT + prt_off(kind, b, c) + t;
          const uint4 raw = *(const uint4*)src;
          float e[10];
          e[0] = t > 0 ? bf2f(src[-1]) : 0.f;
          e[9] = t + 8 < L ? bf2f(src[8]) : 0.f;
          e[1] = lo16(raw.x); e[2] = hi16(raw.x); e[3] = lo16(raw.y); e[4] = hi16(raw.y);
          e[5] = lo16(raw.z); e[6] = hi16(raw.z); e[7] = lo16(raw.w); e[8] = hi16(raw.w);
          float r[8];
#pragma unroll
          for (int k = 0; k < 8; ++k) r[k] = w0 * e[k] + w1 * e[k + 1] + w2 * e[k + 2] + bb;
          o.x = pack2(r[0], r[1]); o.y = pack2(r[2], r[3]); o.z = pack2(r[4], r[5]); o.w = pack2(r[6], r[7]);
        } else {
          o = *(const uint4*)(Z1 + zt_off(kind, b, c) + t);
        }
        *(uint4*)(Ub + b * US + t * 2) = o;
      }
    }
    __syncthreads();
    const int ncols = LB * NB;
    if (wid * 64 < ncols) {
      const int il = lane & 31, q = lane >> 5;
      int t1c[2], bc[2];
#pragma unroll
      for (int nt = 0; nt < 2; ++nt) { const int col = wid * 64 + nt * 32 + il; t1c[nt] = col / NB; bc[nt] = col % NB; }
      const int t1lo = (wid * 64) / NB, t1hi = (wid * 64 + 63) / NB;
      const int dlo = max(-DD, t1lo - (LB - 1)), dhi = min(DD, t1hi);
      const int cpy = 7 - (il & 7);
      const char* abase = (const char*)hc + cpy * 8512 + 2 * (L / 2 + 63 - il - cpy + 8 * q);
      f32x16 acc[2][2];
#pragma unroll
      for (int a = 0; a < 2; ++a)
#pragma unroll
        for (int b = 0; b < 2; ++b)
#pragma unroll
          for (int r = 0; r < 16; ++r) acc[a][b][r] = 0.f;
      for (int d = dlo; d <= dhi; ++d) {
        bf16x8 bfr[2][4];
#pragma unroll
        for (int nt = 0; nt < 2; ++nt) {
          const int s1 = t1c[nt] - d;
          const bool valid = s1 >= 0 && s1 < LB;
          const char* bp = Ub + bc[nt] * US + ((valid ? s1 : 0) * 64 + 8 * q) * 2;
#pragma unroll
          for (int ks = 0; ks < 4; ++ks) {
            bf16x8 v = *(const bf16x8*)(bp + ks * 32);
            if (!valid) v = bf16x8{0, 0, 0, 0, 0, 0, 0, 0};
            bfr[nt][ks] = v;
          }
        }
#pragma unroll
        for (int mt = 0; mt < 2; ++mt)
#pragma unroll
          for (int ks = 0; ks < 4; ++ks) {
            const bf16x8 af = *(const bf16x8*)(abase + 2 * (-64 * d - 32 * mt + 16 * ks));
#pragma unroll
            for (int nt = 0; nt < 2; ++nt) acc[mt][nt] = __builtin_amdgcn_mfma_f32_32x32x16_bf16(af, bfr[nt][ks], acc[mt][nt], 0, 0, 0);
          }
      }
      const float dsk = p.in(21)[(i * 2 + ord) * 512 + c];
      const int gc = 512 * (ord + 1) + c;
      const float w0 = cw[gc], w1 = cw[1536 + gc], w2 = cw[3072 + gc], bb = cb[gc];
#pragma unroll
      for (int nt = 0; nt < 2; ++nt) {
        const int b = bc[nt];
        const u16* xrow = PRT + prt_off(kind, b, gc);
        u16* orow = ZO + zt_off(kind, b, c);
#pragma unroll
        for (int mt = 0; mt < 2; ++mt)
#pragma unroll
          for (int g = 0; g < 4; ++g) {
            const int t = 64 * t1c[nt] + mt * 32 + 8 * g + 4 * q;
            const uint2 uu = *(const uint2*)(Ub + b * US + t * 2);
            const uint2 xx = *(const uint2*)(xrow + t);
            const float em = t > 0 ? bf2f(xrow[t - 1]) : 0.f;
            const float ep = t + 4 < L ? bf2f(xrow[t + 4]) : 0.f;
            const float e0 = lo16(xx.x), e1 = hi16(xx.x), e2 = lo16(xx.y), e3 = hi16(xx.y);
            const float x0 = w0 * em + w1 * e0 + w2 * e1 + bb;
            const float x1 = w0 * e0 + w1 * e1 + w2 * e2 + bb;
            const float x2 = w0 * e1 + w1 * e2 + w2 * e3 + bb;
            const float x3 = w0 * e2 + w1 * e3 + w2 * ep + bb;
            const float y0 = acc[mt][nt][4 * g + 0] + lo16(uu.x) * dsk;
            const float y1 = acc[mt][nt][4 * g + 1] + hi16(uu.x) * dsk;
            const float y2 = acc[mt][nt][4 * g + 2] + lo16(uu.y) * dsk;
            const float y3 = acc[mt][nt][4 * g + 3] + hi16(uu.y) * dsk;
            *(uint2*)(orow + t) = pack4(x0 * y0, x1 * y1, x2 * y2, x3 * y3);
          }
      }
    }
  }
  __syncthreads();
}

DI void phase_ztrans(const PV& p, char* smem) {
  const int tid = TIDX();
  const u16* Z2 = (const u16*)(p.ws() + OFF_A + A_Z2);
  u16* MIX = (u16*)(p.ws() + OFF_B + B_MIX);
  u16* tl = (u16*)smem;
  for (int u4 = blockIdx.x * 4; u4 < 640 * 8; u4 += gridDim.x * 4) {
    const int tt0 = (u4 >> 3) * 64;
    const int kind = tt0 >= TP ? 1 : 0;
    const int b = kind ? (tt0 - TP) >> 12 : tt0 >> 8;
    const int tl0 = kind ? (tt0 - TP) & 4095 : tt0 & 255;
    __syncthreads();
    { const int c = tid >> 3, ch = tid & 7;
      uint4 v[4];
#pragma unroll
      for (int w = 0; w < 4; ++w) v[w] = *(const uint4*)(Z2 + zt_off(kind, b, ((u4 + w) & 7) * 64 + c) + tl0 + ch * 8);
#pragma unroll
      for (int w = 0; w < 4; ++w) *(uint4*)(tl + w * 4608 + c * 72 + ch * 8) = v[w]; }
    __syncthreads();
    { const int tr = tid >> 3, cc = (tid & 7) * 8;
#pragma unroll
      for (int w = 0; w < 4; ++w) {
        const u16* tw = tl + w * 4608;
        uint4 o;
        o.x = (unsigned)tw[(cc + 0) * 72 + tr] | ((unsigned)tw[(cc + 1) * 72 + tr] << 16);
        o.y = (unsigned)tw[(cc + 2) * 72 + tr] | ((unsigned)tw[(cc + 3) * 72 + tr] << 16);
        o.z = (unsigned)tw[(cc + 4) * 72 + tr] | ((unsigned)tw[(cc + 5) * 72 + tr] << 16);
        o.w = (unsigned)tw[(cc + 6) * 72 + tr] | ((unsigned)tw[(cc + 7) * 72 + tr] << 16);
        *(uint4*)(MIX + (size_t)(tt0 + tr) * 1024 + 512 + ((u4 + w) & 7) * 64 + cc) = o;
      } }
  }
  __syncthreads();
}

struct EpiResid {
  float* X; const float* x0; const float* x1; const float* gate; int lx;
  DI void operator()(const f32x4 (&acc)[2][2][4][2], int pm, int pn, int wr, int wc, int fr, int fq) const {
    const int rowt = pm * 256, col0 = pn * 256 + wc * 32 + 4 * fq;
    const float* gr = gate + (size_t)condrow(rowt) * 6144 + col0;
    const float* xb = lx == 0 ? (rowt < TP ? x0 + (size_t)rowt * 1024 : x1 + (size_t)(rowt - TP) * 1024) : X + (size_t)rowt * 1024;
    float4 g[2][2];
#pragma unroll
    for (int bj = 0; bj < 2; ++bj)
#pragma unroll
      for (int n = 0; n < 2; ++n) g[bj][n] = *(const float4*)(gr + bj * 128 + n * 16);
#pragma unroll
    for (int ai = 0; ai < 2; ++ai)
#pragma unroll
      for (int mh = 0; mh < 2; ++mh) {
        float4 xo[2][2][2];
#pragma unroll
        for (int mm = 0; mm < 2; ++mm)
#pragma unroll
          for (int bj = 0; bj < 2; ++bj)
#pragma unroll
            for (int n = 0; n < 2; ++n)
              xo[mm][bj][n] = *(const float4*)(xb + (size_t)(wr * 64 + fr + ai * 128 + (2 * mh + mm) * 16) * 1024 + col0 + bj * 128 + n * 16);
#pragma unroll
        for (int mm = 0; mm < 2; ++mm)
#pragma unroll
          for (int bj = 0; bj < 2; ++bj)
#pragma unroll
            for (int n = 0; n < 2; ++n) {
              const f32x4 v = acc[ai][bj][2 * mh + mm][n];
              const float4 x = xo[mm][bj][n], gg = g[bj][n];
              float4 o; o.x = x.x + gg.x * v[0]; o.y = x.y + gg.y * v[1]; o.z = x.z + gg.z * v[2]; o.w = x.w + gg.w * v[3];
              *(float4*)(X + (size_t)(rowt + wr * 64 + fr + ai * 128 + (2 * mh + mm) * 16) * 1024 + col0 + bj * 128 + n * 16) = o;
            }
      }
  }
};
struct EpiResidHalf {
  float* X; const float* x0; const float* x1; const float* gate; int lx;
  DI void operator()(const f32x4 (&acc)[2][4][2], int pm, int pn, int nh, int wr, int wc, int fr, int fq) const {
    const int rowt = pm * 256, col0 = pn * 256 + nh * 128 + wc * 32 + 4 * fq;
    const float* gr = gate + (size_t)condrow(rowt) * 6144 + col0;
    const float* xb = lx == 0 ? (rowt < TP ? x0 + (size_t)rowt * 1024 : x1 + (size_t)(rowt - TP) * 1024) : X + (size_t)rowt * 1024;
    float4 g[2];
#pragma unroll
    for (int n = 0; n < 2; ++n) g[n] = *(const float4*)(gr + n * 16);
#pragma unroll
    for (int ai = 0; ai < 2; ++ai) {
      float4 xo[4][2];
#pragma unroll
      for (int m = 0; m < 4; ++m)
#pragma unroll
        for (int n = 0; n < 2; ++n) xo[m][n] = *(const float4*)(xb + (size_t)(wr * 64 + fr + ai * 128 + m * 16) * 1024 + col0 + n * 16);
#pragma unroll
      for (int m = 0; m < 4; ++m)
#pragma unroll
        for (int n = 0; n < 2; ++n) {
          const f32x4 v = acc[ai][m][n];
          const float4 x = xo[m][n], gg = g[n];
          float4 o; o.x = x.x + gg.x * v[0]; o.y = x.y + gg.y * v[1]; o.z = x.z + gg.z * v[2]; o.w = x.w + gg.w * v[3];
          *(float4*)(X + (size_t)(rowt + wr * 64 + fr + ai * 128 + m * 16) * 1024 + col0 + n * 16) = o;
        }
    }
  }
};
struct ResidSched2 {
  int c;
  DI void init() { c = blockIdx.x; }
  DI bool next(int i, int& pm, int& pn) const {
    if (gridDim.x == 256) {
      const int st = (c & 7) + 8 * i;
      if (st >= 16) return false;
      pm = st * 8 + ((c >> 3) & 7); pn = c >> 6; return true;
    }
    const int L = i * (int)gridDim.x + c; if (L >= 640) return false; pm = L >> 2; pn = L & 3; return true;
  }
};
DI void phase_resid_gemm(const PV& p, int l, int lx, const u16* A, int K, const u16* W, int goff, char* smem) {
  EpiResid E;
  E.X = p.out(); E.x0 = p.in(0); E.x1 = p.in(1); E.gate = (const float*)(p.ws() + OFF_MOD) + (size_t)l * 9 * 6144 + goff; E.lx = lx;
  ResidSched2 S; S.init();
  if (K == 2816) gemm8<true>(smem, A, W, K, S, E);
  else gemm8<false>(smem, A, W, K, S, E);
  if (gridDim.x == 256) {
    EpiResidHalf EH; EH.X = E.X; EH.x0 = E.x0; EH.x1 = E.x1; EH.gate = E.gate; EH.lx = lx;
    const int xcd = blockIdx.x & 7, slot = blockIdx.x >> 3;
    const int st = 16 + (xcd >> 1), ti = (xcd & 1) * 16 + (slot >> 1), nh = slot & 1;
    const int pm = st * 8 + (ti & 7), pn = ti >> 3;
    if (K == 2816) gemm_half<true>(smem, A, W, K, pm, pn, nh, EH);
    else gemm_half<false>(smem, A, W, K, pm, pn, nh, EH);
  }
}

DI void phase_dqkv(const PV& p, int j, char* smem) {
  const u16* H = (const u16*)(p.ws() + OFF_A + A_H);
  const u16* W = (const u16*)(p.ws() + OFF_WDQKV) + (size_t)j * 1024 * 1024;
  u16* DQKV = (u16*)(p.ws() + OFF_B + B_DQKV);
  u16* KR = (u16*)(p.ws() + OFF_KR);
  float* okr = p.out() + 46137344;
  auto epi = [=](int m, int n, f32x4 v) {
    if (n < 832) {
      const uint2 pk = pack4(v[0], v[1], v[2], v[3]);
      *(uint2*)(DQKV + (size_t)m * 896 + n) = pk;
      if (n >= 768) {
        const int e = n - 768;
        *(uint2*)(KR + (size_t)m * 64 + e) = pk;
        if (m < TP) {
          float4 o; o.x = v[0]; o.y = v[1]; o.z = v[2]; o.w = v[3];
          *(float4*)(okr + ((size_t)((m >> 8) * 2 + j) * 256 + (m & 255)) * 64 + e) = o;
        }
      }
    }
  };
  gemm8_job<160, 4, 4, 8, 4, 32, 1>(smem, H, W, 1024, epi);
}

DI void phase_mla_norms(const PV& p, int j) {
  const int tid_ = TIDX(); const int lane = tid_ & 63, wid = tid_ >> 6;
  const u16* DQKV = (const u16*)(p.ws() + OFF_B + B_DQKV);
  u16* QN = (u16*)(p.ws() + OFF_A + A_QN);
  u16* CKV = (u16*)(p.ws() + OFF_A + A_CKV);
  u16* KR = (u16*)(p.ws() + OFF_KR);
  float* ockv = p.out() + 41943040;
  const float* qn = p.in(24) + j * 512;
  const float* kvn = p.in(27) + j * 256;
  for (int t = blockIdx.x * 8 + wid; t < TK; t += gridDim.x * 8) {
    if (t < T) {
      const u16* row = DQKV + (size_t)t * 896;
      const uint4 a = *(const uint4*)(row + lane * 8);
      float q[8] = {lo16(a.x), hi16(a.x), lo16(a.y), hi16(a.y), lo16(a.z), hi16(a.z), lo16(a.w), hi16(a.w)};
      float ss = 0.f;
#pragma unroll
      for (int k = 0; k < 8; ++k) ss += q[k] * q[k];
      ss = wave_sum(ss, lane);
      const float r = rsqrtf(ss * (1.f / 512.f) + EPS);
      const float4 g0 = *(const float4*)(qn + lane * 8), g1 = *(const float4*)(qn + lane * 8 + 4);
      uint4 o;
      o.x = pack2(q[0] * r * g0.x, q[1] * r * g0.y); o.y = pack2(q[2] * r * g0.z, q[3] * r * g0.w);
      o.z = pack2(q[4] * r * g1.x, q[5] * r * g1.y); o.w = pack2(q[6] * r * g1.z, q[7] * r * g1.w);
      *(uint4*)(QN + (size_t)t * 512 + lane * 8) = o;
      const uint2 b = *(const uint2*)(row + 512 + lane * 4);
      float kv[4] = {lo16(b.x), hi16(b.x), lo16(b.y), hi16(b.y)};
      float s2 = kv[0] * kv[0] + kv[1] * kv[1] + kv[2] * kv[2] + kv[3] * kv[3];
      s2 = wave_sum(s2, lane);
      const float r2 = rsqrtf(s2 * (1.f / 256.f) + EPS);
      const float4 g2 = *(const float4*)(kvn + lane * 4);
      float4 o2; o2.x = kv[0] * r2 * g2.x; o2.y = kv[1] * r2 * g2.y; o2.z = kv[2] * r2 * g2.z; o2.w = kv[3] * r2 * g2.w;
      *(uint2*)(CKV + (size_t)t * 256 + lane * 4) = pack4(o2.x, o2.y, o2.z, o2.w);
      if (t < TP) *(float4*)(ockv + ((size_t)((t >> 8) * 2 + j) * 256 + (t & 255)) * 256 + lane * 4) = o2;
    } else {
      const int pp = t - T, b = pp >> 8, s = pp & 255;
      const float4 v = *(const float4*)(p.in(2) + ((size_t)(b * 2 + j) * 256 + s) * 256 + lane * 4);
      *(uint2*)(CKV + (size_t)t * 256 + lane * 4) = pack4(v.x, v.y, v.z, v.w);
      if (lane < 16) {
        const float4 w = *(const float4*)(p.in(3) + ((size_t)(b * 2 + j) * 256 + s) * 64 + lane * 4);
        *(uint2*)(KR + (size_t)t * 64 + lane * 4) = pack4(w.x, w.y, w.z, w.w);
      }
    }
  }
}

DI size_t vt_off(int m, int h, int d) {
  if (m < TP) return ((size_t)((m >> 8) * 8 + h) * 128 + d) * 256 + (m & 255);
  if (m < T) { const int mm = m - TP; return VT_SAMPLE_OFF + ((size_t)((mm >> 12) * 8 + h) * 128 + d) * 4352 + (mm & 4095); }
  const int mm = m - T;
  return VT_SAMPLE_OFF + ((size_t)((mm >> 8) * 8 + h) * 128 + d) * 4352 + 4096 + (mm & 255);
}
struct EpiKV {
  u16* Kb; u16* Vt;
  DI void operator()(const f32x4 (&acc)[2][2][4][2], int pm, int pn, int wr, int wc, int fr, int fq) const {
    const int h = pn;
    const int rowt = pm * 256;
    const unsigned ls = rowt < TP ? 256u : 4352u;
    unsigned vbase;
    if (rowt < TP) vbase = (unsigned)(((rowt >> 8) * 8 + h) * 128) * 256u;
    else if (rowt < T) { const int mm = rowt - TP; vbase = (unsigned)VT_SAMPLE_OFF + (unsigned)(((mm >> 12) * 8 + h) * 128) * 4352u + (unsigned)(mm & 4095); }
    else { const int mm = rowt - T; vbase = (unsigned)VT_SAMPLE_OFF + (unsigned)(((mm >> 8) * 8 + h) * 128) * 4352u + 4096u + (unsigned)(mm & 255); }
    const unsigned dcol = (unsigned)(wc * 32 + 4 * fq);
#pragma unroll
    for (int ai = 0; ai < 2; ++ai)
#pragma unroll
      for (int m = 0; m < 4; ++m) {
        const int rl = ai * 128 + wr * 64 + m * 16 + fr;
        const unsigned ko = (unsigned)((rowt + rl) * 8 + h) * 192u + dcol;
        const unsigned frp = (unsigned)((fr & 3) | ((fr & 4) << 1) | ((fr & 8) >> 1));
        const unsigned vo = vbase + (unsigned)(rl & ~15) + frp + dcol * ls;
#pragma unroll
        for (int n = 0; n < 2; ++n) {
          const f32x4 k = acc[ai][0][m][n], v = acc[ai][1][m][n];
          *(uint2*)(Kb + (ko + n * 16)) = pack4(k[0], k[1], k[2], k[3]);
          const unsigned p01 = pack2(v[0], v[1]), p23 = pack2(v[2], v[3]);
          const unsigned vq = vo + (unsigned)(n * 16) * ls;
          Vt[vq] = (u16)p01; Vt[vq + ls] = (u16)(p01 >> 16); Vt[vq + 2 * ls] = (u16)p23; Vt[vq + 3 * ls] = (u16)(p23 >> 16);
        }
      }
  }
};
DI void phase_uq_ukv(const PV& p, int j, char* smem) {
  const u16* QN = (const u16*)(p.ws() + OFF_A + A_QN);
  const u16* CKV = (const u16*)(p.ws() + OFF_A + A_CKV);
  const u16* WQ = (const u16*)(p.ws() + OFF_WUQ) + (size_t)j * 1536 * 512;
  const u16* WKV = (const u16*)(p.ws() + OFF_WUKV) + (size_t)j * 2048 * 256;
  u16* Q = (u16*)(p.ws() + OFF_B + B_Q);
  u16* Kb = (u16*)(p.ws() + OFF_B + B_K);
  u16* Vt = (u16*)(p.ws() + OFF_B + B_V);
  auto epiq = [=](int m, int n, f32x4 v) { *(uint2*)(Q + (size_t)m * 1536 + n) = pack4(v[0], v[1], v[2], v[3]); };
  gemm8_job<160, 6, 4, 8, 4, 16, 2>(smem, QN, WQ, 512, epiq);
  EpiKV E; E.Kb = Kb; E.Vt = Vt;
  TileSched<168, 8, 8, 8, 4, 32, 1> S; S.init();
  gemm8(smem, CKV, WKV, 256, S, E);
}

DI void phase_finalize(const PV& p, int j) {
  const int tid_ = TIDX(); const int lane = tid_ & 63, wid = tid_ >> 6;
  const int h = lane >> 3, l8 = lane & 7;
  u16* Q = (u16*)(p.ws() + OFF_B + B_Q);
  u16* Kb = (u16*)(p.ws() + OFF_B + B_K);
  const u16* KR = (const u16*)(p.ws() + OFF_KR);
  const float2* ROPE = (const float2*)(p.ws() + OFF_ROPE);
  const float* qhn = p.in(29) + j * 192;
  const float* khn = p.in(30) + j * 192;
  const float QSCALE = 1.4426950408889634f * 0.07216878364870322f;
  const int stride = gridDim.x * 8;
  for (int u0 = T + blockIdx.x * 8 + wid; u0 < T + TK; u0 += 2 * stride) {
    uint4 raw[2][3];
    u16* basep[2];
#pragma unroll
    for (int w = 0; w < 2; ++w) {
      const int u = u0 + w * stride;
      if (u < T + TK) {
        const bool isq = u < T;
        const int t = isq ? u : u - T;
        u16* base = isq ? Q + (size_t)t * 1536 + h * 192 : Kb + ((size_t)t * 8 + h) * 192;
        basep[w] = base;
#pragma unroll
        for (int k = 0; k < 3; ++k) {
          const u16* src = (!isq && k == 2) ? KR + (size_t)t * 64 + 8 * l8 : base + 8 * (l8 + 8 * k);
          raw[w][k] = *(const uint4*)src;
        }
      }
    }
#pragma unroll
    for (int w = 0; w < 2; ++w) {
      const int u = u0 + w * stride;
      if (u < T + TK) {
        const bool isq = u < T;
        const int t = isq ? u : u - T;
        const float* hn = isq ? qhn : khn;
        float v[3][8];
#pragma unroll
        for (int k = 0; k < 3; ++k) {
          const uint4 a = raw[w][k];
          v[k][0] = lo16(a.x); v[k][1] = hi16(a.x); v[k][2] = lo16(a.y); v[k][3] = hi16(a.y);
          v[k][4] = lo16(a.z); v[k][5] = hi16(a.z); v[k][6] = lo16(a.w); v[k][7] = hi16(a.w);
        }
        float ss = 0.f;
#pragma unroll
        for (int k = 0; k < 3; ++k)
#pragma unroll
          for (int e = 0; e < 8; ++e) ss += v[k][e] * v[k][e];
        ss += shx<1>(ss, lane); ss += shx<2>(ss, lane); ss += shx<4>(ss, lane);
        const float r = rsqrtf(ss * (1.f / 192.f) + EPS);
#pragma unroll
        for (int k = 0; k < 3; ++k) {
          const float4 g0 = *(const float4*)(hn + 8 * (l8 + 8 * k)), g1 = *(const float4*)(hn + 8 * (l8 + 8 * k) + 4);
          v[k][0] *= r * g0.x; v[k][1] *= r * g0.y; v[k][2] *= r * g0.z; v[k][3] *= r * g0.w;
          v[k][4] *= r * g1.x; v[k][5] *= r * g1.y; v[k][6] *= r * g1.z; v[k][7] *= r * g1.w;
        }
        if (t >= TP && t < T) {
          const int tl = (t - TP) & 4095;
          const int pos = l8 < 4 ? (tl >> 6) : (tl & 63);
          const float4* rp = (const float4*)(ROPE + pos * 16 + (l8 & 1) * 8);
          const float4 c01 = rp[0], c23 = rp[1], c45 = rp[2], c67 = rp[3];
          const float cs[8] = {c01.x, c01.z, c23.x, c23.z, c45.x, c45.z, c67.x, c67.z};
          const float sn[8] = {c01.y, c01.w, c23.y, c23.w, c45.y, c45.w, c67.y, c67.w};
#pragma unroll
          for (int e = 0; e < 8; ++e) {
            const float x = v[2][e];
            const float partner = shx<2>(x, lane);
            v[2][e] = (l8 & 2) ? x * cs[e] + partner * sn[e] : x * cs[e] - partner * sn[e];
          }
        }
        const float sc = isq ? QSCALE : 1.f;
#pragma unroll
        for (int k = 0; k < 3; ++k) {
          uint4 o;
          o.x = pack2(v[k][0] * sc, v[k][1] * sc); o.y = pack2(v[k][2] * sc, v[k][3] * sc);
          o.z = pack2(v[k][4] * sc, v[k][5] * sc); o.w = pack2(v[k][6] * sc, v[k][7] * sc);
          *(uint4*)(basep[w] + 8 * (l8 + 8 * k)) = o;
        }
      }
    }
  }
}

DI void attn_item(const PV& p, int j, int kind, int seq, int h, int q0, char* smem) {
  const int tid = TIDX(), lane = tid & 63, wid = tid >> 6;
  const int il = lane & 31, hh = lane >> 5;
  const u16* Q = (const u16*)(p.ws() + OFF_B + B_Q);
  const u16* Kb = (const u16*)(p.ws() + OFF_B + B_K);
  const u16* Vt = (const u16*)(p.ws() + OFF_B + B_V);
  u16* O = (u16*)(p.ws() + OFF_A + A_O);
  const float* qhn = p.in(29) + j * 192;
  const float2* ROPE = (const float2*)(p.ws() + OFF_ROPE);
  const int Lk = kind ? 4352 : 256, nkt = Lk >> 6;
  const u16* vbase = Vt + (kind ? VT_SAMPLE_OFF + (size_t)(seq * 8 + h) * 128 * 4352 : (size_t)(seq * 8 + h) * 128 * 256);
  const int tq = q0 + wid * 32 + il;
  bf16x8 qf[12];
  {
    float v[12][8];
    float ss = 0.f;
#pragma unroll
    for (int ks = 0; ks < 12; ++ks) {
      const uint4 a = *(const uint4*)(Q + ((size_t)tq * 8 + h) * 192 + 16 * ks + 8 * hh);
      v[ks][0] = lo16(a.x); v[ks][1] = hi16(a.x); v[ks][2] = lo16(a.y); v[ks][3] = hi16(a.y);
      v[ks][4] = lo16(a.z); v[ks][5] = hi16(a.z); v[ks][6] = lo16(a.w); v[ks][7] = hi16(a.w);
#pragma unroll
      for (int e = 0; e < 8; ++e) ss += v[ks][e] * v[ks][e];
    }
    { auto rr = __builtin_amdgcn_permlane32_swap(__float_as_uint(ss), __float_as_uint(ss), false, false); ss = __uint_as_float(rr[0]) + __uint_as_float(rr[1]); }
    const float rn = rsqrtf(ss * (1.f / 192.f) + EPS);
#pragma unroll
    for (int ks = 0; ks < 12; ++ks) {
      const float4 g0 = *(const float4*)(qhn + 16 * ks + 8 * hh), g1 = *(const float4*)(qhn + 16 * ks + 8 * hh + 4);
      v[ks][0] *= rn * g0.x; v[ks][1] *= rn * g0.y; v[ks][2] *= rn * g0.z; v[ks][3] *= rn * g0.w;
      v[ks][4] *= rn * g1.x; v[ks][5] *= rn * g1.y; v[ks][6] *= rn * g1.z; v[ks][7] *= rn * g1.w;
    }
    if (kind) {
      const int tl = (tq - TP) & 4095;
#pragma unroll
      for (int part = 0; part < 2; ++part) {
        const int pos = part == 0 ? (tl >> 6) : (tl & 63);
        const float4* rp = (const float4*)(ROPE + pos * 16 + 8 * hh);
        const float4 c01 = rp[0], c23 = rp[1], c45 = rp[2], c67 = rp[3];
        const float cs[8] = {c01.x, c01.z, c23.x, c23.z, c45.x, c45.z, c67.x, c67.z};
        const float sn[8] = {c01.y, c01.w, c23.y, c23.w, c45.y, c45.w, c67.y, c67.w};
#pragma unroll
        for (int e = 0; e < 8; ++e) {
          const float x1 = v[8 + 2 * part][e], x2 = v[9 + 2 * part][e];
          v[8 + 2 * part][e] = x1 * cs[e] - x2 * sn[e];
          v[9 + 2 * part][e] = x2 * cs[e] + x1 * sn[e];
        }
      }
    }
    const float QSCALE = 1.4426950408889634f * 0.07216878364870322f;
#pragma unroll
    for (int ks = 0; ks < 12; ++ks) {
      union { bf16x8 b; unsigned w[4]; } o;
#pragma unroll
      for (int w = 0; w < 4; ++w) o.w[w] = pack2(v[ks][2 * w] * QSCALE, v[ks][2 * w + 1] * QSCALE);
      qf[ks] = o.b;
    }
  }
  f32x16 oacc[4];
#pragma unroll
  for (int a = 0; a < 4; ++a)
#pragma unroll
    for (int r = 0; r < 16; ++r) oacc[a][r] = 0.f;
  float mrun = -INFINITY, lrun = 0.f;
  const int sw = (il >> 1) & 7;
  int ko[4], vob[4];
#pragma unroll
  for (int a = 0; a < 4; ++a) ko[a] = il * 384 + (((2 * a + hh) ^ sw) << 4);
#pragma unroll
  for (int c = 0; c < 4; ++c) vob[c] = il * 128 + (((2 * c + hh) ^ sw) << 4);
  LAS unsigned char* lds = (LAS unsigned char*)smem;
  unsigned kso[3], vso[2];
#pragma unroll
  for (int i = 0; i < 3; ++i) {
    const int id = tid + 512 * i, r = id / 24, pc = id - r * 24;
    const int ch = (pc & ~7) | ((pc & 7) ^ ((r >> 1) & 7));
    kso[i] = (unsigned)(r * 3072 + ch * 16);
  }
#pragma unroll
  for (int i = 0; i < 2; ++i) {
    const int id = tid + 512 * i, dd = id >> 3, pc = id & 7;
    const int ch = pc ^ ((dd >> 1) & 7);
    vso[i] = (unsigned)(dd * Lk * 2 + ch * 16);
  }
  const unsigned ldst = (unsigned)(tid >> 6) * 1024u;
#define ATT_STAGE(kt_, s_)                                                                                      \
  {                                                                                                            \
    const int k0_ = (kt_) * 64;                                                                                \
    const int rowbase_ = kind ? (k0_ < 4096 ? TP + seq * 4096 + k0_ : T + seq * 256 + (k0_ - 4096)) : seq * 256 + k0_; \
    const char* kg_ = (const char*)(Kb + ((size_t)rowbase_ * 8 + h) * 192);                                     \
    const char* vg_ = (const char*)(vbase + k0_);                                                              \
    _Pragma("unroll") for (int i_ = 0; i_ < 3; ++i_)                                                           \
      __builtin_amdgcn_global_load_lds((const unsigned*)(kg_ + kso[i_]), (LAS unsigned*)(lds + (s_) * 40960 + ldst + i_ * 8192), 16, 0, 0); \
    _Pragma("unroll") for (int i_ = 0; i_ < 2; ++i_)                                                           \
      __builtin_amdgcn_global_load_lds((const unsigned*)(vg_ + vso[i_]), (LAS unsigned*)(lds + (s_) * 40960 + 24576 + ldst + i_ * 8192), 16, 0, 0); \
  }
  __syncthreads();
  ATT_STAGE(0, 0)
  asm volatile("s_waitcnt vmcnt(0)" ::: "memory");
  __syncthreads();
  for (int kt = 0; kt < nkt; ++kt) {
    const bool more = kt + 1 < nkt;
    if (more) ATT_STAGE(kt + 1, (kt + 1) & 1)
    const char* Ks = smem + (kt & 1) * 40960;
    const char* Vs = Ks + 24576;
    f32x16 s2[2];
    __builtin_amdgcn_s_setprio(1);
#pragma unroll
    for (int st = 0; st < 2; ++st)
#pragma unroll
      for (int r = 0; r < 16; ++r) s2[st][r] = 0.f;
#pragma unroll
    for (int ks = 0; ks < 12; ++ks)
#pragma unroll
      for (int st = 0; st < 2; ++st) {
        const bf16x8 kf = *(const bf16x8*)(Ks + ko[ks & 3] + st * 12288 + (ks >> 2) * 128);
        s2[st] = __builtin_amdgcn_mfma_f32_32x32x16_bf16(kf, qf[ks], s2[st], 0, 0, 0);
      }
    __builtin_amdgcn_s_setprio(0);
    {
      float pmax = s2[0][0];
#pragma unroll
      for (int r = 1; r < 16; ++r) pmax = fmaxf(pmax, s2[0][r]);
#pragma unroll
      for (int r = 0; r < 16; ++r) pmax = fmaxf(pmax, s2[1][r]);
      { auto rr = __builtin_amdgcn_permlane32_swap(__float_as_uint(pmax), __float_as_uint(pmax), false, false);
        pmax = fmaxf(__uint_as_float(rr[0]), __uint_as_float(rr[1])); }
      if (!__all(pmax - mrun <= 11.541560327f)) {
        const float mn = fmaxf(mrun, pmax);
        const float alpha = __builtin_amdgcn_exp2f(mrun - mn);
        mrun = mn;
        lrun *= alpha;
#pragma unroll
        for (int a = 0; a < 4; ++a)
#pragma unroll
          for (int r = 0; r < 16; ++r) oacc[a][r] *= alpha;
      }
      float psum = 0.f;
#pragma unroll
      for (int st = 0; st < 2; ++st)
#pragma unroll
        for (int r = 0; r < 16; ++r) { const float pv = __builtin_amdgcn_exp2f(s2[st][r] - mrun); s2[st][r] = pv; psum += pv; }
      lrun += psum;
    }
    __builtin_amdgcn_s_setprio(1);
#pragma unroll
    for (int st = 0; st < 2; ++st)
#pragma unroll
      for (int sb = 0; sb < 2; ++sb) {
        union { bf16x8 v; unsigned w[4]; } pb;
#pragma unroll
        for (int w = 0; w < 4; ++w) pb.w[w] = pack2(s2[st][8 * sb + 2 * w], s2[st][8 * sb + 2 * w + 1]);
#pragma unroll
        for (int dt = 0; dt < 4; ++dt) {
          const bf16x8 vf = *(const bf16x8*)(Vs + vob[2 * st + sb] + dt * 4096);
          oacc[dt] = __builtin_amdgcn_mfma_f32_32x32x16_bf16(vf, pb.v, oacc[dt], 0, 0, 0);
        }
      }
    __builtin_amdgcn_s_setprio(0);
    asm volatile("s_waitcnt vmcnt(0)" ::: "memory");
    __syncthreads();
  }
#undef ATT_STAGE
  float ltot;
  { auto rr = __builtin_amdgcn_permlane32_swap(__float_as_uint(lrun), __float_as_uint(lrun), false, false); ltot = __uint_as_float(rr[0]) + __uint_as_float(rr[1]); }
  const float inv = 1.f / ltot;
#pragma unroll
  for (int dt = 0; dt < 4; ++dt)
#pragma unroll
    for (int g = 0; g < 4; ++g) {
      const int d = dt * 32 + 8 * g + 4 * hh;
      *(uint2*)(O + (size_t)tq * 1024 + h * 128 + d) =
          pack4(oacc[dt][4 * g] * inv, oacc[dt][4 * g + 1] * inv, oacc[dt][4 * g + 2] * inv, oacc[dt][4 * g + 3] * inv);
    }
}
DI void phase_attention(const PV& p, int j, char* smem) {
  const bool xmap = gridDim.x == 256;
  const int Gq = opaque_i((int)gridDim.x);
  const int nit = xmap ? 5 : (1280 + Gq - 1) / Gq;
#pragma unroll 1
  for (int r = 0; r < nit; ++r) {
    int kind, seq, h, q0;
    if (xmap) {
      if (r < 4) {
        const int xcd = blockIdx.x & 7, slot = blockIdx.x >> 3;
        const int pair = xcd + 8 * (2 * r + (slot >> 4)), qb = slot & 15;
        kind = 1; seq = pair >> 3; h = pair & 7; q0 = TP + seq * 4096 + qb * 256;
      } else {
        kind = 0; seq = blockIdx.x >> 3; h = blockIdx.x & 7; q0 = seq * 256;
      }
    } else {
      const int it = blockIdx.x + r * gridDim.x;
      if (it >= 1280) break;
      if (it < 1024) { const int pair = it >> 4, qb = it & 15; kind = 1; seq = pair >> 3; h = pair & 7; q0 = TP + seq * 4096 + qb * 256; }
      else { const int i2 = it - 1024; kind = 0; seq = i2 >> 3; h = i2 & 7; q0 = seq * 256; }
    }
    attn_item(p, j, kind, seq, h, q0, smem);
  }
  __syncthreads();
}

DI size_t act_blk(int t, int a) { return (size_t)(t >> 8) * (256 * 2816) + (size_t)(a >> 6) * (256 * 64) + (size_t)((t & 255) * 64 + (a & 63)); }
DI float dpp_ror1(float x) { return __int_as_float(__builtin_amdgcn_update_dpp(0, __float_as_int(x), 0x121, 0xf, 0xf, false)); }
DI float dpp_ror15(float x) { return __int_as_float(__builtin_amdgcn_update_dpp(0, __float_as_int(x), 0x12F, 0xf, 0xf, false)); }
struct EpiFFN {
  u16* ACT; u16* EDGE; const float* cw; const float* cb;
  DI void operator()(const f32x4 (&acc)[2][2][4][2], int pm, int pn, int wr, int wc, int fr, int fq) const {
#pragma unroll
    for (int n = 0; n < 2; ++n) {
      const int a = pn * 128 + wc * 32 + n * 16 + fq * 4;
      const float4 w0g = *(const float4*)(cw + a), w1g = *(const float4*)(cw + 5632 + a), w2g = *(const float4*)(cw + 11264 + a), bg = *(const float4*)(cb + a);
      const float4 w0u = *(const float4*)(cw + 2816 + a), w1u = *(const float4*)(cw + 5632 + 2816 + a), w2u = *(const float4*)(cw + 11264 + 2816 + a), bu = *(const float4*)(cb + 2816 + a);
#pragma unroll
      for (int ai = 0; ai < 2; ++ai) {
        const int rbase = pm * 256 + ai * 128 + wr * 64;
        const size_t erow = (size_t)(rbase >> 6) * 4;
#pragma unroll
        for (int m = 0; m < 4; ++m) {
          const int mp = m > 0 ? m - 1 : 0, mn = m < 3 ? m + 1 : 3;
          float o[4];
#define FFN_ONE(J, C)                                                                                         \
          {                                                                                                   \
            const float g = acc[ai][0][m][n][J], u = acc[ai][1][m][n][J];                                     \
            const float gpv = m > 0 ? acc[ai][0][mp][n][J] : 0.f, gnx = m < 3 ? acc[ai][0][mn][n][J] : 0.f;   \
            const float upv = m > 0 ? acc[ai][1][mp][n][J] : 0.f, unx = m < 3 ? acc[ai][1][mn][n][J] : 0.f;   \
            const float gp = dpp_ror1(fr == 15 ? gpv : g), gn = dpp_ror15(fr == 0 ? gnx : g);                \
            const float up = dpp_ror1(fr == 15 ? upv : u), un = dpp_ror15(fr == 0 ? unx : u);                \
            const float cg = w0g.C * gp + w1g.C * g + w2g.C * gn + bg.C;                                      \
            const float cu = w0u.C * up + w1u.C * u + w2u.C * un + bu.C;                                      \
            o[J] = silu(cg) * cu;                                                                             \
          }
          FFN_ONE(0, x) FFN_ONE(1, y) FFN_ONE(2, z) FFN_ONE(3, w)
#undef FFN_ONE
          *(uint2*)(ACT + act_blk(rbase + m * 16 + fr, a)) = pack4(o[0], o[1], o[2], o[3]);
          if ((m == 0 && fr < 2) || (m == 3 && fr >= 14)) {
            const int ri = m == 0 ? fr : fr - 12;
            u16* e = EDGE + (erow + ri) * 5632 + pn * 256 + wc * 32 + n * 16 + fq * 4;
            *(uint2*)e = pack4(acc[ai][0][m][n][0], acc[ai][0][m][n][1], acc[ai][0][m][n][2], acc[ai][0][m][n][3]);
            *(uint2*)(e + 128) = pack4(acc[ai][1][m][n][0], acc[ai][1][m][n][1], acc[ai][1][m][n][2], acc[ai][1][m][n][3]);
          }
        }
      }
    }
  }
};
DI void phase_ffn_up(const PV& p, int l, char* smem) {
  EpiFFN E;
  E.ACT = (u16*)(p.ws() + OFF_B + B_ACT); E.EDGE = (u16*)(p.ws() + OFF_EDGE);
  E.cw = p.in(33) + (size_t)l * 3 * 5632; E.cb = p.in(34) + (size_t)l * 5632;
  TileSched<160, 22, 16, 8, 4, 16, 2> S; S.init();
  gemm8(smem, (const u16*)(p.ws() + OFF_A + A_H), (const u16*)(p.ws() + OFF_WUP), 1024, S, E);
}
DI void phase_ffn_fix(const PV& p, int l) {
  const u16* EDGE = (const u16*)(p.ws() + OFF_EDGE);
  u16* ACT = (u16*)(p.ws() + OFF_B + B_ACT);
  const float* cw = p.in(33) + (size_t)l * 3 * 5632;
  const float* cb = p.in(34) + (size_t)l * 5632;
  const long gtid = (long)blockIdx.x * blockDim.x + TIDX(), gsz = (long)gridDim.x * blockDim.x;
  for (long idx = gtid; idx < (long)640 * 2 * 704; idx += gsz) {
    const int a = (int)(idx % 704) * 4, rr = (int)(idx / 704), which = rr & 1, sidx = rr >> 1;
    const int t = sidx * 64 + (which ? 63 : 0);
    const int tb = which ? t + 1 : t;
    const bool seqb = tb < TP ? (tb & 255) == 0 : ((tb - TP) & 4095) == 0;
    if (seqb) continue;
    const int pc = (a >> 7) * 256 + (a & 127);
    const u16 *pr, *cu, *nx;
    if (which == 0) { pr = EDGE + ((size_t)(sidx - 1) * 4 + 3) * 5632; cu = EDGE + ((size_t)sidx * 4 + 0) * 5632; nx = EDGE + ((size_t)sidx * 4 + 1) * 5632; }
    else { pr = EDGE + ((size_t)sidx * 4 + 2) * 5632; cu = EDGE + ((size_t)sidx * 4 + 3) * 5632; nx = EDGE + ((size_t)(sidx + 1) * 4 + 0) * 5632; }
    const uint2 gp = *(const uint2*)(pr + pc), gc = *(const uint2*)(cu + pc), gn = *(const uint2*)(nx + pc);
    const uint2 up = *(const uint2*)(pr + pc + 128), uc = *(const uint2*)(cu + pc + 128), un = *(const uint2*)(nx + pc + 128);
    const float4 w0g = *(const float4*)(cw + a), w1g = *(const float4*)(cw + 5632 + a), w2g = *(const float4*)(cw + 11264 + a), bg = *(const float4*)(cb + a);
    const float4 w0u = *(const float4*)(cw + 2816 + a), w1u = *(const float4*)(cw + 5632 + 2816 + a), w2u = *(const float4*)(cw + 11264 + 2816 + a), bu = *(const float4*)(cb + 2816 + a);
    const float g0 = w0g.x * lo16(gp.x) + w1g.x * lo16(gc.x) + w2g.x * lo16(gn.x) + bg.x, u0 = w0u.x * lo16(up.x) + w1u.x * lo16(uc.x) + w2u.x * lo16(un.x) + bu.x;
    const float g1 = w0g.y * hi16(gp.x) + w1g.y * hi16(gc.x) + w2g.y * hi16(gn.x) + bg.y, u1 = w0u.y * hi16(up.x) + w1u.y * hi16(uc.x) + w2u.y * hi16(un.x) + bu.y;
    const float g2 = w0g.z * lo16(gp.y) + w1g.z * lo16(gc.y) + w2g.z * lo16(gn.y) + bg.z, u2 = w0u.z * lo16(up.y) + w1u.z * lo16(uc.y) + w2u.z * lo16(un.y) + bu.z;
    const float g3 = w0g.w * hi16(gp.y) + w1g.w * hi16(gc.y) + w2g.w * hi16(gn.y) + bg.w, u3 = w0u.w * hi16(up.y) + w1u.w * hi16(uc.y) + w2u.w * hi16(un.y) + bu.w;
    *(uint2*)(ACT + act_blk(t, a)) = pack4(silu(g0) * u0, silu(g1) * u1, silu(g2) * u2, silu(g3) * u3);
  }
}

#ifndef PH
#define RUN(k, ...) __VA_ARGS__
#else
#define RUN(k, ...) if (PH == k) { __VA_ARGS__ }
#endif
extern "C" __global__ void __launch_bounds__(512) fwd_megakernel(Params kp) {
  extern __shared__ __attribute__((aligned(16))) char smem[];
  cg::grid_group grid = cg::this_grid();
  if (TIDX() == 0) {
    unsigned long long* t = (unsigned long long*)(smem + PARM_OFF);
#pragma unroll
    for (int k = 0; k < 36; ++k) t[k] = (unsigned long long)kp.in[k];
    t[36] = (unsigned long long)kp.out; t[37] = (unsigned long long)kp.ws;
  }
  __syncthreads();
  PV p; p.smem = smem;
  unsigned* bar = (unsigned*)(p.ws() + OFF_BAR);
  if (TIDX() == 0) { *(unsigned*)(smem + PARM_OFF + 512) = 0u; *(unsigned*)(smem + PARM_OFF + 516) = 0u; }
  __syncthreads();
  const XcdBarrier xb = xcd_barrier_post(bar, (volatile LASB unsigned*)(smem + PARM_OFF + 512));
  RUN(0, phase_prep(p, smem);)
  grid.sync();
  RUN(1, phase_filters(p, smem);)
  for (int l = 0; l < 4; ++l) {
    const int i = l >> 1;
    RUN(2, phase_norm(p, l, 0, l);)
    RUN(0, if (l > 0) { int base = 0; convert_ffn_weights(p, l, smem, base); })
    xcd_barrier(xb);
    if ((l & 1) == 0) {
      RUN(3, phase_mix_in(p, i, smem);)
      xcd_barrier(xb);
      RUN(4, phase_sgu(p, i, smem);)
      RUN(5, phase_conv(p, i, 0, smem);)
      xcd_barrier(xb);
      RUN(5, phase_conv(p, i, 1, smem);)
      xcd_barrier(xb);
      RUN(6, phase_ztrans(p, smem);)
      xcd_barrier(xb);
      RUN(7, phase_resid_gemm(p, l, l, (const u16*)(p.ws() + OFF_B + B_MIX), 1024, (const u16*)(p.ws() + OFF_WMIXOUT) + (size_t)i * 1024 * 1024, 2048, smem);)
      xcd_barrier(xb);
    } else {
      RUN(8, phase_dqkv(p, i, smem);)
      xcd_barrier(xb);
      RUN(9, phase_mla_norms(p, i);)
      xcd_barrier(xb);
      RUN(10, phase_uq_ukv(p, i, smem);)
      xcd_barrier(xb);
      RUN(11, phase_finalize(p, i);)
      xcd_barrier(xb);
      RUN(12, phase_attention(p, i, smem);)
      xcd_barrier(xb);
      RUN(7, phase_resid_gemm(p, l, l, (const u16*)(p.ws() + OFF_A + A_O), 1024, (const u16*)(p.ws() + OFF_WO) + (size_t)i * 1024 * 1024, 2048, smem);)
      xcd_barrier(xb);
    }
    RUN(2, phase_norm(p, l, 1, 1);)
    xcd_barrier(xb);
    RUN(13, phase_ffn_up(p, l, smem);)
    xcd_barrier(xb);
    RUN(14, phase_ffn_fix(p, l);)
    xcd_barrier(xb);
    RUN(7, phase_resid_gemm(p, l, 1, (const u16*)(p.ws() + OFF_B + B_ACT), 2816, (const u16*)(p.ws() + OFF_WDOWN), 5120, smem);)
    xcd_barrier(xb);
  }
}

extern "C" void kernel_launch(void* const* d_in, const int* in_sizes, int n_in,
                              void* d_out, int out_size, void* d_ws, size_t ws_size,
                              hipStream_t stream) {
  static int grid_blocks = 0;
  if (!grid_blocks) {
    int dev = 0, cus = 0, per_cu = 0;
    (void)hipGetDevice(&dev);
    (void)hipDeviceGetAttribute(&cus, hipDeviceAttributeMultiprocessorCount, dev);
    (void)hipFuncSetAttribute((const void*)fwd_megakernel, hipFuncAttributeMaxDynamicSharedMemorySize, (int)LDS_BYTES);
    (void)hipOccupancyMaxActiveBlocksPerMultiprocessor(&per_cu, fwd_megakernel, 512, LDS_BYTES);
    if (per_cu < 1) per_cu = 1;
    if (per_cu > 1) per_cu = 1;
    grid_blocks = cus * per_cu;
  }
  if (ws_size < WS_NEED) fprintf(stderr, "workspace too small: %zu < %zu\n", ws_size, (size_t)WS_NEED);
  Params p{};
  for (int i = 0; i < 36; ++i) p.in[i] = (const float*)d_in[i];
  p.out = (float*)d_out;
  p.ws = (char*)d_ws;
  (void)hipMemsetAsync((char*)d_ws + OFF_BAR, 0, 16384, stream);
  void* args[] = {&p};
  hipError_t e = hipLaunchCooperativeKernel((void*)fwd_megakernel, dim3(grid_blocks), dim3(512), args, LDS_BYTES, stream);
  if (e != hipSuccess) fprintf(stderr, "cooperative launch failed: %s (grid %d)\n", hipGetErrorString(e), grid_blocks);
}
```

```cpp
#include <hip/hip_runtime.h>
#include <hip/hip_cooperative_groups.h>
#include <cstdio>
namespace cg = cooperative_groups;

typedef unsigned short u16;
using bf16x8 = __attribute__((ext_vector_type(8))) short;
using f32x4 = __attribute__((ext_vector_type(4))) float;
using f32x16 = __attribute__((ext_vector_type(16))) float;
#define DI __device__ __forceinline__

constexpr int T = 40960;
constexpr int TP = 8192;
constexpr int TK = 43008;
constexpr float EPS = 1e-6f;
constexpr size_t LDS_BYTES = 139264;

constexpr size_t OFF_WMIXIN = 0;
constexpr size_t OFF_WMIXOUT = OFF_WMIXIN + (size_t)2 * 2560 * 1024 * 2;
constexpr size_t OFF_WDQKV = OFF_WMIXOUT + (size_t)2 * 1024 * 1024 * 2;
constexpr size_t OFF_WUQ = OFF_WDQKV + (size_t)2 * 1024 * 1024 * 2;
constexpr size_t OFF_WUKV = OFF_WUQ + (size_t)2 * 1536 * 512 * 2;
constexpr size_t OFF_WO = OFF_WUKV + (size_t)2 * 2048 * 256 * 2;
constexpr size_t OFF_WSGU = OFF_WO + (size_t)2 * 1024 * 1024 * 2;
constexpr size_t OFF_WUP = OFF_WSGU + (size_t)2 * 4 * 128 * 128 * 2;
constexpr size_t OFF_WDOWN = OFF_WUP + (size_t)5632 * 1024 * 2;
constexpr size_t OFF_MOD = OFF_WDOWN + (size_t)1024 * 2816 * 2;
constexpr size_t OFF_FILT = OFF_MOD + (size_t)4 * 9 * 6144 * 4;
constexpr size_t OFF_H2 = OFF_FILT + (size_t)2 * 2 * 512 * 4352 * 2;
constexpr size_t OFF_EDGE = OFF_H2 + (size_t)2 * 4352 * 64 * 4;
constexpr size_t OFF_KR = OFF_EDGE + (size_t)640 * 4 * 5632 * 2;
constexpr size_t OFF_A = OFF_KR + (size_t)TK * 64 * 2;
constexpr size_t OFF_B = OFF_A + (size_t)T * 1024 * 2;
constexpr size_t OFF_BAR = OFF_B + (size_t)346030080;
constexpr size_t OFF_ROPE = OFF_BAR + 16384;
constexpr size_t WS_NEED = OFF_ROPE + 64 * 16 * 8;
constexpr size_t A_H = 0, A_Z1 = 0, A_Z2 = (size_t)T * 512 * 2, A_QN = 0, A_CKV = (size_t)T * 512 * 2, A_O = 0;
constexpr size_t B_VT = 0, B_PRT = (size_t)T * 512 * 2, B_MIX = B_PRT + (size_t)T * 1536 * 2;
constexpr size_t B_DQKV = 0, B_Q = 0, B_K = (size_t)T * 1536 * 2, B_V = B_K + (size_t)TK * 1536 * 2;
constexpr size_t B_ACT = 0;
constexpr size_t VT_SAMPLE_OFF = (size_t)32 * 8 * 128 * 256;

struct Params {
  const float* in[36];
  float* out;
  char* ws;
};


constexpr int PARM_OFF = 138240;
struct PV {
  char* smem;
  DI unsigned long long ld(int k) const {
    int off = PARM_OFF + 8 * k;
    asm volatile("" : "+v"(off));
    const unsigned long long v = *(const unsigned long long*)(smem + off);
    const unsigned lo = __builtin_amdgcn_readfirstlane((unsigned)v), hi = __builtin_amdgcn_readfirstlane((unsigned)(v >> 32));
    return ((unsigned long long)hi << 32) | lo;
  }
  DI const float* in(int k) const { return (const float*)(const __attribute__((address_space(1))) float*)ld(k); }
  DI float* out() const { return (float*)(__attribute__((address_space(1))) float*)ld(36); }
  DI char* ws() const { return (char*)(__attribute__((address_space(1))) char*)ld(37); }
};

DI int TIDX() { int t = (int)__builtin_amdgcn_workitem_id_x(); asm volatile("" : "+v"(t)); return t; }
DI u16 f2bf(float x) { unsigned u = __float_as_uint(x); u += 0x7fffu + ((u >> 16) & 1u); return (u16)(u >> 16); }
DI float bf2f(u16 h) { return __uint_as_float(((unsigned)h) << 16); }
DI unsigned pack2(float a, float b) { unsigned r; asm("v_cvt_pk_bf16_f32 %0, %1, %2" : "=v"(r) : "v"(a), "v"(b)); return r; }
DI uint2 pack4(float a, float b, float c, float d) { uint2 r; r.x = pack2(a, b); r.y = pack2(c, d); return r; }
DI float lo16(unsigned w) { return __uint_as_float(w << 16); }
DI float hi16(unsigned w) { return __uint_as_float(w & 0xffff0000u); }
DI float gelu_tanh(float x) { const float y = x * (1.f + 0.044715f * x * x); return x * __builtin_amdgcn_rcpf(1.f + __builtin_amdgcn_exp2f(-2.302208198f * y)); }
DI float silu(float x) { return x * __builtin_amdgcn_rcpf(1.f + __builtin_amdgcn_exp2f(-1.4426950409f * x)); }
DI int condrow(int m) { return m < TP ? 0 : 1 + ((m - TP) >> 12); }
template <int MASK> DI float shx(float v, int lane) {
  if (MASK == 32) return __int_as_float(__builtin_amdgcn_ds_bpermute((lane ^ 32) << 2, __float_as_int(v)));
  return __int_as_float(__builtin_amdgcn_ds_swizzle(__float_as_int(v), (MASK << 10) | 0x1f));
}
DI float wave_sum(float v, int lane) {
  v += shx<32>(v, lane); v += shx<16>(v, lane); v += shx<8>(v, lane);
  v += shx<4>(v, lane); v += shx<2>(v, lane); v += shx<1>(v, lane); return v;
}
DI int opaque_i(int x) { asm volatile("" : "+s"(x)); return x; }
DI int first_unit(int base) { const int G = opaque_i((int)gridDim.x); int r = (int)blockIdx.x - (base % G); if (r < 0) r += G; return r; }
DI const float* xin_row(const PV& p, int l, int m) {
  if (l == 0) return m < TP ? p.in(0) + (size_t)m * 1024 : p.in(1) + (size_t)(m - TP) * 1024;
  return p.out() + (size_t)m * 1024;
}


#define XB_TMO      128
#define XB_XCNT(j)  (256  + 64 * (j))
#define XB_XSUB(j)  (1280 + 64 * (j))
#define XB_XGEN(j)  (2304 + 64 * (j))
#define XB_TOP      3328
#define XB_TOPGEN   3392
#define XB_SPIN_CAP (1u << 22)
#define LASB __attribute__((address_space(3)))
DI unsigned xb_ld(unsigned* p) { return __hip_atomic_load(p, __ATOMIC_RELAXED, __HIP_MEMORY_SCOPE_AGENT); }
DI unsigned xb_add(unsigned* p, unsigned v) { return __hip_atomic_fetch_add(p, v, __ATOMIC_RELAXED, __HIP_MEMORY_SCOPE_AGENT); }
DI unsigned xb_xcc_id() { return (unsigned)__builtin_amdgcn_s_getreg((3 << 11) | 20) & 0xFu; }
#define XB_SPIN(cond, bar) do { unsigned _sp = 0; while (cond) { __builtin_amdgcn_s_sleep(1); \
    if ((++_sp & 255u) == 0u) { if (xb_ld(&(bar)[XB_TMO])) break; if (_sp > XB_SPIN_CAP) { atomicAdd(&(bar)[XB_TMO], 1u); break; } } } } while (0)
struct XcdBarrier { unsigned* bar; unsigned x; volatile LASB unsigned* st; };
DI XcdBarrier xcd_barrier_post(unsigned* bar, volatile LASB unsigned* st) {
  XcdBarrier b; b.bar = bar; b.x = xb_xcc_id(); b.st = st;
  if (TIDX() == 0) (void)xb_add(&bar[XB_XCNT(b.x)], 1u);
  return b;
}
DI void xcd_barrier_complete(unsigned* bar, unsigned x, unsigned& nloc, unsigned& nx) {
  const unsigned G = gridDim.x;
  unsigned sum, cnt, mine, sp = 0u;
  for (;;) {
    sum = 0u; cnt = 0u; mine = 0u;
#pragma unroll
    for (unsigned j = 0; j < 16; ++j) { const unsigned c = xb_ld(&bar[XB_XCNT(j)]); sum += c; cnt += (c > 0u) ? 1u : 0u; mine = (j == x) ? c : mine; }
    if (sum == G) break;
    __builtin_amdgcn_s_sleep(1);
    if ((++sp & 255u) == 0u) { if (xb_ld(&bar[XB_TMO])) break; if (sp > XB_SPIN_CAP) { atomicAdd(&bar[XB_TMO], 1u); break; } }
  }
  nloc = mine > 0u ? mine : 1u; nx = cnt > 0u ? cnt : 1u;
}
DI void xcd_barrier(const XcdBarrier& b) {
  asm volatile("s_waitcnt vmcnt(0)" ::: "memory");
  __syncthreads();
  if (TIDX() == 0) {
    unsigned* bar = b.bar;
    __builtin_amdgcn_s_waitcnt(0);
    unsigned nloc = b.st[0], nx = b.st[1];
    if (nloc == 0u) { xcd_barrier_complete(bar, b.x, nloc, nx); b.st[0] = nloc; b.st[1] = nx; }
    const unsigned old = xb_add(&bar[XB_XSUB(b.x)], 1u);
    const unsigned gen = old / nloc;
    if (old + 1u == (gen + 1u) * nloc) {
      __builtin_amdgcn_fence(__ATOMIC_RELEASE, "agent");
      asm volatile("s_waitcnt vmcnt(0)" ::: "memory");
      const unsigned og = xb_add(&bar[XB_TOP], 1u);
      const unsigned tg = og / nx;
      if (og + 1u == (tg + 1u) * nx) xb_add(&bar[XB_TOPGEN], 1u);
      else XB_SPIN(xb_ld(&bar[XB_TOPGEN]) == tg, bar);
      __builtin_amdgcn_fence(__ATOMIC_ACQUIRE, "agent");
      xb_add(&bar[XB_XGEN(b.x)], 1u);
      asm volatile("s_waitcnt vmcnt(0)" ::: "memory");
    } else {
      XB_SPIN(xb_ld(&bar[XB_XGEN(b.x)]) == gen, bar);
      __builtin_amdgcn_fence(__ATOMIC_ACQUIRE, "agent");
      asm volatile("s_waitcnt vmcnt(0)" ::: "memory");
    }
  }
  __syncthreads();
}

template <int MODE>
DI int rowmap(int n, int row0) {
  if (MODE == 0) return n + row0;
  return n < 2816 ? (n >> 7) * 256 + (n & 127) : ((n - 2816) >> 7) * 256 + 128 + ((n - 2816) & 127);
}
template <int MODE, int NJ = 4>
DI void convT(const float* __restrict__ src, u16* __restrict__ dst, int K, int N, int row0, char* smem, int& base) {
  u16* tl = (u16*)smem;
  const int tid = TIDX();
  const int nN = N / (64 * NJ), nunits = (K >> 6) * nN;
  for (int u = first_unit(base); u < nunits; u += gridDim.x) {
    const int k0 = (u / nN) << 6, n0 = (u % nN) * (64 * NJ);
    float4 v[2][NJ];
#pragma unroll
    for (int i = 0; i < 2; ++i)
#pragma unroll
      for (int j = 0; j < NJ; ++j)
        v[i][j] = *(const float4*)(src + (size_t)(k0 + (tid >> 4) + 32 * i) * N + n0 + (tid & 15) * 4 + 64 * j);
#pragma unroll
    for (int i = 0; i < 2; ++i)
#pragma unroll
      for (int j = 0; j < NJ; ++j) {
        const int r = (tid >> 4) + 32 * i, c4 = (tid & 15) * 4 + 64 * j;
        tl[(c4 + 0) * 72 + r] = f2bf(v[i][j].x); tl[(c4 + 1) * 72 + r] = f2bf(v[i][j].y);
        tl[(c4 + 2) * 72 + r] = f2bf(v[i][j].z); tl[(c4 + 3) * 72 + r] = f2bf(v[i][j].w);
      }
    __syncthreads();
#pragma unroll
    for (int j = 0; j < NJ; ++j) {
      const int n = (tid >> 3) + 64 * j, kc = (tid & 7) * 8;
      const uint4 o = *(const uint4*)(tl + n * 72 + kc);
      *(uint4*)(dst + (size_t)rowmap<MODE>(n0 + n, row0) * K + k0 + kc) = o;
    }
    __syncthreads();
  }
  base += nunits;
}

DI void convert_ffn_weights(const PV& p, int l, char* smem, int& base) {
  convT<1>(p.in(32) + (size_t)l * 1024 * 5632, (u16*)(p.ws() + OFF_WUP), 1024, 5632, 0, smem, base);
  convT<0>(p.in(35) + (size_t)l * 2816 * 1024, (u16*)(p.ws() + OFF_WDOWN), 2816, 1024, 0, smem, base);
}

DI void phase_prep(const PV& p, char* smem) {
  const int tid = TIDX();
  int base = 0;
  char* ws = p.ws();
  for (int i = 0; i < 2; ++i) {
    convT<0>(p.in(9) + (size_t)i * 1024 * 2560, (u16*)(ws + OFF_WMIXIN) + (size_t)i * 2560 * 1024, 1024, 2560, 0, smem, base);
    convT<0>(p.in(22) + (size_t)i * 1024 * 1024, (u16*)(ws + OFF_WMIXOUT) + (size_t)i * 1024 * 1024, 1024, 1024, 0, smem, base);
    convT<0>(p.in(23) + (size_t)i * 1024 * 512, (u16*)(ws + OFF_WDQKV) + (size_t)i * 1024 * 1024, 1024, 512, 0, smem, base);
    convT<0, 1>(p.in(26) + (size_t)i * 1024 * 320, (u16*)(ws + OFF_WDQKV) + (size_t)i * 1024 * 1024, 1024, 320, 512, smem, base);
    convT<0>(p.in(25) + (size_t)i * 512 * 1536, (u16*)(ws + OFF_WUQ) + (size_t)i * 1536 * 512, 512, 1536, 0, smem, base);
    convT<0>(p.in(28) + (size_t)i * 256 * 2048, (u16*)(ws + OFF_WUKV) + (size_t)i * 2048 * 256, 256, 2048, 0, smem, base);
    convT<0>(p.in(31) + (size_t)i * 1024 * 1024, (u16*)(ws + OFF_WO) + (size_t)i * 1024 * 1024, 1024, 1024, 0, smem, base);
  }
  convert_ffn_weights(p, 0, smem, base);
  {
    const long gtid = (long)blockIdx.x * blockDim.x + tid, gsz = (long)gridDim.x * blockDim.x;
    for (long i = gtid; i < 2 * 192 * 1024; i += gsz) {
      const int j = (int)(i / (192 * 1024)), r = (int)(i % (192 * 1024));
      ((u16*)(ws + OFF_WDQKV))[(size_t)j * 1024 * 1024 + (size_t)832 * 1024 + r] = 0;
    }
    for (long i = gtid; i < 2 * 4 * 128 * 128; i += gsz) ((u16*)(ws + OFF_WSGU))[i] = f2bf(p.in(10)[i]);
    for (long i = gtid; i < 64 * 16; i += gsz) {
      const int pos = (int)(i >> 4), f = (int)(i & 15);
      const float inv = exp2f(-(float)f * (13.287712379549449f / 16.f));
      float sn, cs;
      sincosf((float)pos * inv, &sn, &cs);
      ((float2*)(ws + OFF_ROPE))[i] = make_float2(cs, sn);
    }
  }
  {
    float* sc = (float*)smem;
    float* part = sc + 9 * 1024;
    __syncthreads();
    for (int i = tid; i < 9 * 1024; i += 512) {
      const int r = i >> 10, k = i & 1023;
      const float c = r == 0 ? p.in(5)[k] : p.in(4)[(r - 1) * 1024 + k];
      sc[i] = silu(c);
    }
    __syncthreads();
    float* MOD = (float*)(ws + OFF_MOD);
    const int nunits = 4 * 96;
    for (int u = first_unit(base); u < nunits; u += gridDim.x) {
      const int l = u / 96, n0 = (u % 96) * 64;
      const int col = n0 + (tid & 63), kg = tid >> 6;
      float acc[9];
#pragma unroll
      for (int r = 0; r < 9; ++r) acc[r] = 0.f;
      const float* w = p.in(6) + (size_t)l * 1024 * 6144 + col;
#pragma unroll 16
      for (int k = kg * 128; k < kg * 128 + 128; ++k) {
        const float wv = w[(size_t)k * 6144];
#pragma unroll
        for (int r = 0; r < 9; ++r) acc[r] += sc[r * 1024 + k] * wv;
      }
#pragma unroll
      for (int r = 0; r < 9; ++r) part[(kg * 9 + r) * 64 + (tid & 63)] = acc[r];
      __syncthreads();
      for (int i = tid; i < 576; i += 512) {
        const int r = i >> 6, cc = i & 63;
        float s = p.in(7)[l * 6144 + n0 + cc];
#pragma unroll
        for (int g = 0; g < 8; ++g) s += part[(g * 9 + r) * 64 + cc];
        MOD[(size_t)(l * 9 + r) * 6144 + n0 + cc] = s;
      }
      __syncthreads();
    }
    base += nunits;
  }
  {
    float* zf = (float*)smem;
    float* h1 = zf + 8 * 36;
    float* H2 = (float*)(ws + OFF_H2);
    const int nunits = 2 * 544;
    for (int u = first_unit(base); u < nunits; u += gridDim.x) {
      const int i = u / 544, tg0 = (u % 544) * 8;
      __syncthreads();
      if (tid < 8 * 33) {
        const int tt = tid / 33, e = tid % 33;
        const int tg = tg0 + tt;
        const float L = tg < 256 ? 256.f : 4096.f;
        const float t = tg < 256 ? (float)tg : (float)(tg - 256);
        const float tn = t / L;
        float v;
        if (e == 0) v = tn;
        else if (e <= 16) v = sinf((6.283185307179586f * tn) * (float)e);
        else v = cosf((6.283185307179586f * tn) * (float)(e - 16));
        zf[tt * 36 + e] = v;
      }
      __syncthreads();
      const int tt = tid >> 6, jj = tid & 63;
      const float fr = p.in(19)[i * 64 + jj];
      {
        float a = p.in(15)[i * 64 + jj];
        const float* w1 = p.in(14) + (size_t)i * 33 * 64 + jj;
        for (int e = 0; e < 33; ++e) a += zf[tt * 36 + e] * w1[e * 64];
        h1[tt * 64 + jj] = sinf(fr * a);
      }
      __syncthreads();
      {
        float a = p.in(17)[i * 64 + jj];
        const float* w2 = p.in(16) + (size_t)i * 64 * 64 + jj;
        for (int e = 0; e < 64; ++e) a += h1[tt * 64 + e] * w2[e * 64];
        H2[((size_t)i * 4352 + tg0 + tt) * 64 + jj] = sinf(fr * a);
      }
    }
    base += nunits;
    __syncthreads();
  }
}

DI void phase_filters(const PV& p, char* smem) {
  const int tid = TIDX();
  float* w3s = (float*)smem;
  float* red = w3s + 512;
  float* nrm = red + 512;
  float* hbuf = nrm + 8;
  const float* H2 = (const float*)(p.ws() + OFF_H2);
  u16* FILT = (u16*)(p.ws() + OFF_FILT);
  for (int u = blockIdx.x; u < 512; u += gridDim.x) {
    const int kind = (u >> 7) & 1, i = u >> 8, cg8 = (u & 127) * 8;
    const int L = kind ? 4096 : 256, tbase = kind ? 256 : 0;
    __syncthreads();
    { const int j = tid >> 3, cc = tid & 7; w3s[j * 8 + cc] = p.in(18)[((size_t)i * 64 + j) * 1024 + cg8 + cc]; }
    __syncthreads();
    const int cc = tid & 7, tq = tid >> 3;
    const int col = cg8 + cc, o = col >> 9, c = col & 511;
    const float dec = fabsf(p.in(20)[(i * 2 + o) * 512 + c]);
    float asum = 0.f;
    for (int t = tq; t < L; t += 64) {
      const float4* hr = (const float4*)(H2 + ((size_t)i * 4352 + tbase + t) * 64);
      float a = 0.f;
#pragma unroll
      for (int j4 = 0; j4 < 16; ++j4) {
        const float4 hv = hr[j4];
        a += hv.x * w3s[(j4 * 4 + 0) * 8 + cc]; a += hv.y * w3s[(j4 * 4 + 1) * 8 + cc];
        a += hv.z * w3s[(j4 * 4 + 2) * 8 + cc]; a += hv.w * w3s[(j4 * 4 + 3) * 8 + cc];
      }
      const float dist = fabsf((float)(t - L / 2)) / (float)L;
      a *= expf(-dec * dist);
      hbuf[cc * L + t] = a;
      asum += fabsf(a);
    }
    red[tid] = asum;
    __syncthreads();
    if (tid < 8) { float s = 0.f; for (int q = 0; q < 64; ++q) s += red[q * 8 + tid]; nrm[tid] = 1.f / (s + EPS); }
    __syncthreads();
    const int lgL = kind ? 12 : 8;
    for (int idx = tid; idx < 8 * L; idx += 512) {
      const int c2 = idx >> lgL, t = idx & (L - 1);
      const int col2 = cg8 + c2, o2 = col2 >> 9, cch = col2 & 511;
      FILT[((size_t)(i * 2 + o2) * 512 + cch) * 4352 + tbase + t] = f2bf(hbuf[c2 * L + t] * nrm[c2]);
    }
  }
  __syncthreads();
}

DI void phase_norm(const PV& p, int l, int part, int lx) {
  const int tid_ = TIDX(); const int lane = tid_ & 63, wid = tid_ >> 6;
  const float* MOD = (const float*)(p.ws() + OFF_MOD);
  const float* g = p.in(8) + (size_t)(l * 2 + part) * 1024;
  u16* H = (u16*)(p.ws() + OFF_A + A_H);
  const int stride = gridDim.x * 8;
  for (int row0 = blockIdx.x * 8 + wid; row0 < T; row0 += 2 * stride) {
    float4 v[2][4];
#pragma unroll
    for (int w = 0; w < 2; ++w) {
      const int row = row0 + w * stride;
      if (row < T) {
        const float* xr = xin_row(p, lx, row);
#pragma unroll
        for (int i = 0; i < 4; ++i) v[w][i] = *(const float4*)(xr + (i * 64 + lane) * 4);
      }
    }
#pragma unroll
    for (int w = 0; w < 2; ++w) {
      const int row = row0 + w * stride;
      if (row < T) {
        float ss = 0.f;
#pragma unroll
        for (int i = 0; i < 4; ++i) ss += v[w][i].x * v[w][i].x + v[w][i].y * v[w][i].y + v[w][i].z * v[w][i].z + v[w][i].w * v[w][i].w;
        ss = wave_sum(ss, lane);
        const float r = rsqrtf(ss * (1.f / 1024.f) + EPS);
        const float* mr = MOD + (size_t)(l * 9 + condrow(row)) * 6144 + part * 3072;
#pragma unroll
        for (int i = 0; i < 4; ++i) {
          const int k = (i * 64 + lane) * 4;
          const float4 gv = *(const float4*)(g + k), sh = *(const float4*)(mr + k), sc = *(const float4*)(mr + 1024 + k);
          const float a = v[w][i].x * r * gv.x * (1.f + sc.x) + sh.x;
          const float b = v[w][i].y * r * gv.y * (1.f + sc.y) + sh.y;
          const float c = v[w][i].z * r * gv.z * (1.f + sc.z) + sh.z;
          const float d = v[w][i].w * r * gv.w * (1.f + sc.w) + sh.w;
          *(uint2*)(H + (size_t)row * 1024 + k) = pack4(a, b, c, d);
        }
      }
    }
  }
}

template <bool SWAP, class Epi, class Pre>
DI void gemm_tile(const u16* A, int lda, const u16* Bt, int ldb, int K, int m0, int n0, char* smem, Epi epi, Pre pre) {
  const int tid = TIDX(), lane = tid & 63, wid = tid >> 6;
  const int wm = wid >> 1, wn = wid & 1, fr = lane & 15, fq = lane >> 4;
  const int lrow = tid >> 3, kc = tid & 7;
  const u16* ga = A + (size_t)(m0 + lrow) * lda + kc * 8;
  const u16* gb = Bt + (size_t)(n0 + lrow) * ldb + kc * 8;
  const int soff = lrow * 128 + ((kc ^ (lrow & 7)) << 4);
  uint4 ra[4], rb[2];
  f32x4 acc[4][4];
#pragma unroll
  for (int i = 0; i < 4; ++i)
#pragma unroll
    for (int j = 0; j < 4; ++j) acc[i][j] = f32x4{0.f, 0.f, 0.f, 0.f};
  const int nk = K >> 6;
#pragma unroll
  for (int i = 0; i < 4; ++i) ra[i] = *(const uint4*)(ga + (size_t)(64 * i) * lda);
#pragma unroll
  for (int i = 0; i < 2; ++i) rb[i] = *(const uint4*)(gb + (size_t)(64 * i) * ldb);
#pragma unroll
  for (int i = 0; i < 4; ++i) *(uint4*)(smem + soff + i * 8192) = ra[i];
#pragma unroll
  for (int i = 0; i < 2; ++i) *(uint4*)(smem + 32768 + soff + i * 8192) = rb[i];
  __syncthreads();
  for (int kt = 0; kt < nk; ++kt) {
    const bool more = kt + 1 < nk;
    if (more) {
      const int k0 = (kt + 1) << 6;
#pragma unroll
      for (int i = 0; i < 4; ++i) ra[i] = *(const uint4*)(ga + (size_t)(64 * i) * lda + k0);
#pragma unroll
      for (int i = 0; i < 2; ++i) rb[i] = *(const uint4*)(gb + (size_t)(64 * i) * ldb + k0);
    }
    const char* sa = smem + (kt & 1) * 49152;
    const char* sb = sa + 32768;
#pragma unroll
    for (int ks = 0; ks < 2; ++ks) {
      bf16x8 af[4], bfv[4];
      const int co = ((ks * 4 + fq) ^ (fr & 7)) << 4;
#pragma unroll
      for (int mi = 0; mi < 4; ++mi) af[mi] = *(const bf16x8*)(sa + (wm * 64 + mi * 16 + fr) * 128 + co);
#pragma unroll
      for (int ni = 0; ni < 4; ++ni) bfv[ni] = *(const bf16x8*)(sb + (wn * 64 + ni * 16 + fr) * 128 + co);
#pragma unroll
      for (int mi = 0; mi < 4; ++mi)
#pragma unroll
        for (int ni = 0; ni < 4; ++ni)
          acc[mi][ni] = SWAP ? __builtin_amdgcn_mfma_f32_16x16x32_bf16(bfv[ni], af[mi], acc[mi][ni], 0, 0, 0)
                             : __builtin_amdgcn_mfma_f32_16x16x32_bf16(af[mi], bfv[ni], acc[mi][ni], 0, 0, 0);
    }
    if (more) {
      char* da = smem + ((kt + 1) & 1) * 49152;
#pragma unroll
      for (int i = 0; i < 4; ++i) *(uint4*)(da + soff + i * 8192) = ra[i];
#pragma unroll
      for (int i = 0; i < 2; ++i) *(uint4*)(da + 32768 + soff + i * 8192) = rb[i];
    }
    __syncthreads();
  }
  uint2 pv[4][4];
#pragma unroll
  for (int mi = 0; mi < 4; ++mi)
#pragma unroll
    for (int ni = 0; ni < 4; ++ni) {
      if (SWAP) pv[mi][ni] = pre(m0 + wm * 64 + mi * 16 + fr, n0 + wn * 64 + ni * 16 + fq * 4);
      else pv[mi][ni] = pre(m0 + wm * 64 + mi * 16 + fq * 4, n0 + wn * 64 + ni * 16 + fr);
    }
#pragma unroll
  for (int mi = 0; mi < 4; ++mi)
#pragma unroll
    for (int ni = 0; ni < 4; ++ni) {
      if (SWAP) epi(m0 + wm * 64 + mi * 16 + fr, n0 + wn * 64 + ni * 16 + fq * 4, acc[mi][ni], pv[mi][ni]);
      else epi(m0 + wm * 64 + mi * 16 + fq * 4, n0 + wn * 64 + ni * 16 + fr, acc[mi][ni], pv[mi][ni]);
    }
}

template <class F>
DI void for_tiles(int nM, int nN, int sm, int sn, F f) {
  if (gridDim.x == 256) {
    const int xcd = blockIdx.x & 7, slot = blockIdx.x >> 3;
    const int am = slot % sm, bn = slot / sm;
    const int nSN = (nN + sn - 1) / sn, nS = (nM / sm) * nSN;
    for (int st = xcd; st < nS; st += 8) {
      const int tm = (st / nSN) * sm + am, tn = (st % nSN) * sn + bn;
      if (tn < nN) f(tm, tn);
    }
  } else {
    for (int t = blockIdx.x; t < nM * nN; t += gridDim.x) f(t / nN, t % nN);
  }
}


#define LAS __attribute__((address_space(3)))
constexpr int G8_HTB = 128 * 64 * 2;
DI int g8_lds_byte(int r, int c) { const int st = (r >> 4) * 2 + (c >> 5), rr = r & 15, cc = c & 31, ob = rr * 64 + cc * 2; return st * 1024 + (ob ^ (((ob >> 9) & 1) << 5)); }
DI void g8_stage_rc(int b, int& R, int& C) { const int st = b / 1024, sb = b % 1024, swz = sb ^ (((sb >> 9) & 1) << 5); R = (st >> 1) * 16 + swz / 64; C = (st & 1) * 32 + (swz % 64) / 2; }
template <int NM, int NN, int NN1, int SM1, int SN1, int SM2, int SN2>
struct TileSched {
  static constexpr int nSN1 = NN1 / SN1, nS1 = (NM / SM1) * nSN1, nSN2 = (NN - NN1) / SN2, nS2 = (NM / SM2) * nSN2, nT = NM * NN;
  int c;
  DI void init() { c = blockIdx.x; }
  DI bool next(int i, int& pm, int& pn) const {
    if (gridDim.x == 256) {
      const int xcd = c & 7, slot = c >> 3;
      int st = xcd + 8 * i;
      if (st < nS1) { pm = (st / nSN1) * SM1 + slot % SM1; pn = (st % nSN1) * SN1 + slot / SM1; return true; }
      st -= nS1;
      if (nS2 == 0 || st >= nS2) return false;
      pm = (st / (nSN2 > 0 ? nSN2 : 1)) * SM2 + slot % SM2; pn = NN1 + (st % (nSN2 > 0 ? nSN2 : 1)) * SN2 + slot / SM2; return true;
    }
    const int L = i * (int)gridDim.x + c; if (L >= nT) return false; pm = L / NN; pn = L % NN; return true;
  }
};
template <bool ABLK = false, int SWM = 0, class Sched, class Epi>
DI void gemm8(char* smem, const u16* A, const u16* Bt, int K, const Sched& S, const Epi& E) {
  LAS unsigned char* lds = (LAS unsigned char*)smem;
  const int tid = TIDX(), wid = __builtin_amdgcn_readfirstlane(tid >> 6), lane = tid & 63, wr = wid >> 2, wc = wid & 3, fr = lane & 15, fq = lane >> 4;
  const int nt = K / 64;
  unsigned voff[2], voffA[2];
#pragma unroll
  for (int i = 0; i < 2; ++i) { int R, C; g8_stage_rc(tid * 16 + i * 8192, R, C); voff[i] = (unsigned)(R * K + C) * 2u; voffA[i] = ABLK ? (unsigned)(R * 64 + C) * 2u : voff[i]; }
  const size_t kstep = 128, hstep = (size_t)128 * K * 2, tstep = 2 * hstep;
  const size_t kstepA = ABLK ? 32768 : kstep, hstepA = ABLK ? 16384 : hstep;
  const unsigned ldsw = (unsigned)wid * 1024u;
  const int aoff = g8_lds_byte(wr * 64 + fr, fq * 8), boff = g8_lds_byte(wc * 32 + fr, fq * 8);
#define G8_SA(b, h) (((b) * 2 + (h)) * G8_HTB)
#define G8_SB(b, h) ((4 + (b) * 2 + (h)) * G8_HTB)
#define G8_STAGE(bufoff, gbase) do { _Pragma("unroll") for (int _i = 0; _i < 2; ++_i) \
    __builtin_amdgcn_global_load_lds((const unsigned*)((const char*)(gbase) + voff[_i]), (LAS unsigned*)(lds + (bufoff) + ldsw + _i * 8192), 16, 0, 0); } while (0)
#define G8_STAGEA(bufoff, gbase) do { _Pragma("unroll") for (int _i = 0; _i < 2; ++_i) \
    __builtin_amdgcn_global_load_lds((const unsigned*)((const char*)(gbase) + voffA[_i]), (LAS unsigned*)(lds + (bufoff) + ldsw + _i * 8192), 16, 0, 0); } while (0)
#define G8_LDA(dst, b, h) do { _Pragma("unroll") for (int m = 0; m < 4; ++m) _Pragma("unroll") for (int k = 0; k < 2; ++k) dst[m][k] = *(const LAS bf16x8*)(lds + G8_SA(b, h) + aoff + m * 2048 + k * 1024); } while (0)
#define G8_LDB(dst, b, h) do { _Pragma("unroll") for (int n = 0; n < 2; ++n) _Pragma("unroll") for (int k = 0; k < 2; ++k) dst[n][k] = *(const LAS bf16x8*)(lds + G8_SB(b, h) + boff + n * 2048 + k * 1024); } while (0)
#define G8_MMA(ai, bj, At_, Bt_) do { __builtin_amdgcn_s_setprio(1); _Pragma("unroll") for (int m = 0; m < 4; ++m) _Pragma("unroll") for (int n = 0; n < 2; ++n) _Pragma("unroll") for (int k = 0; k < 2; ++k) \
    acc[ai][bj][m][n] = SWM == 2 ? __builtin_amdgcn_mfma_f32_16x16x32_bf16(At_[m][k], Bt_[n][k], acc[ai][bj][m][n], 0, 0, 0) \
                                 : __builtin_amdgcn_mfma_f32_16x16x32_bf16(Bt_[n][k], At_[m][k], acc[ai][bj][m][n], 0, 0, 0); __builtin_amdgcn_s_setprio(0); } while (0)
#define G8_WAIT_V(n) asm volatile("s_waitcnt vmcnt(" #n ")" ::: "memory")
#define G8_WAIT_L(n) asm volatile("s_waitcnt lgkmcnt(" #n ")" ::: "memory")
#define G8_BAR __builtin_amdgcn_s_barrier()
#define G8_SCHED __builtin_amdgcn_sched_barrier(0)
  int cpm, cpn, npm = 0, npn = 0, ui = 0;
  if (!S.next(0, cpm, cpn)) return;
  f32x4 acc[2][2][4][2];
#pragma unroll
  for (int a = 0; a < 2; ++a)
#pragma unroll
    for (int b = 0; b < 2; ++b)
#pragma unroll
      for (int m = 0; m < 4; ++m)
#pragma unroll
        for (int n = 0; n < 2; ++n) acc[a][b][m][n] = f32x4{0.f, 0.f, 0.f, 0.f};
  bf16x8 At[4][2], B0[2][2], B1[2][2];
  const char* cA = (const char*)A + (size_t)cpm * tstep; const char* cB = (const char*)Bt + (size_t)cpn * tstep;
  G8_STAGE(G8_SB(0, 0), cB); G8_STAGEA(G8_SA(0, 0), cA); G8_STAGE(G8_SB(0, 1), cB + hstep); G8_STAGEA(G8_SA(0, 1), cA + hstepA);
  if (wr == 1) G8_BAR;
  G8_WAIT_V(4); G8_BAR;
  G8_STAGE(G8_SB(1, 0), cB + kstep); G8_STAGEA(G8_SA(1, 0), cA + kstepA); G8_STAGE(G8_SB(1, 1), cB + hstep + kstep);
  G8_WAIT_V(6); G8_BAR;
  for (;;) {
    const bool has_next = S.next(ui + 1, npm, npn);
    const char* nA = has_next ? (const char*)A + (size_t)npm * tstep : cA; const char* nB = has_next ? (const char*)Bt + (size_t)npn * tstep : cB;
#pragma unroll 1
    for (int t = 0; t < nt; t += 2) {
      const bool last = (t == nt - 2);
      const char* a1 = cA + (size_t)(t + 1) * kstepA;
      const char* a2 = last ? nA : cA + (size_t)(t + 2) * kstepA; const char* b2 = last ? nB : cB + (size_t)(t + 2) * kstep;
      const char* a3 = a2 + kstepA; const char* b3 = b2 + kstep;
      G8_LDB(B0, 0, 0); G8_SCHED; G8_LDA(At, 0, 0); G8_STAGEA(G8_SA(1, 1), a1 + hstepA);
      G8_WAIT_L(8); G8_BAR; G8_WAIT_L(0); G8_MMA(0, 0, At, B0); G8_BAR; G8_SCHED;
      G8_LDB(B1, 0, 1); G8_STAGE(G8_SB(0, 0), b2);
      G8_BAR; G8_WAIT_L(0); G8_MMA(0, 1, At, B1); G8_BAR;
      G8_LDA(At, 0, 1); G8_STAGEA(G8_SA(0, 0), a2);
      G8_BAR; G8_WAIT_L(0); G8_MMA(1, 0, At, B0); G8_BAR; G8_SCHED;
      G8_STAGE(G8_SB(0, 1), b2 + hstep);
      G8_WAIT_V(6); G8_BAR; G8_MMA(1, 1, At, B1); G8_BAR;
      G8_LDB(B0, 1, 0); G8_SCHED; G8_LDA(At, 1, 0); G8_STAGEA(G8_SA(0, 1), a2 + hstepA);
      G8_WAIT_L(8); G8_BAR; G8_WAIT_L(0); G8_MMA(0, 0, At, B0); G8_BAR; G8_SCHED;
      G8_LDB(B1, 1, 1); G8_STAGE(G8_SB(1, 0), b3);
      G8_BAR; G8_WAIT_L(0); G8_MMA(0, 1, At, B1); G8_BAR;
      G8_LDA(At, 1, 1); G8_STAGEA(G8_SA(1, 0), a3);
      G8_BAR; G8_WAIT_L(0); G8_MMA(1, 0, At, B0); G8_BAR; G8_SCHED;
      G8_STAGE(G8_SB(1, 1), b3 + hstep);
      G8_WAIT_V(6); G8_BAR; G8_MMA(1, 1, At, B1); G8_BAR;
    }
    { const int t2 = TIDX(), w2 = __builtin_amdgcn_readfirstlane(t2 >> 6), l2 = t2 & 63; E(acc, cpm, cpn, w2 >> 2, w2 & 3, l2 & 15, l2 >> 4); }
    if (!has_next) break;
#pragma unroll
    for (int a = 0; a < 2; ++a)
#pragma unroll
      for (int b = 0; b < 2; ++b)
#pragma unroll
        for (int m = 0; m < 4; ++m)
#pragma unroll
          for (int n = 0; n < 2; ++n) acc[a][b][m][n] = f32x4{0.f, 0.f, 0.f, 0.f};
    cpm = npm; cpn = npn; cA = nA; cB = nB; ++ui;
  }
  G8_WAIT_V(0);
  if (wr == 0) G8_BAR;
  G8_BAR;
#undef G8_SA
#undef G8_SB
#undef G8_STAGE
#undef G8_STAGEA
#undef G8_LDA
#undef G8_LDB
#undef G8_MMA
#undef G8_WAIT_V
#undef G8_WAIT_L
#undef G8_BAR
#undef G8_SCHED
}
template <bool ABLK, class Epi>
DI void gemm_half(char* smem, const u16* A, const u16* Bt, int K, int pm, int pn, int nh, const Epi& E) {
  LAS unsigned char* lds = (LAS unsigned char*)smem;
  const int tid = TIDX(), wid = __builtin_amdgcn_readfirstlane(tid >> 6), lane = tid & 63, wr = wid >> 2, wc = wid & 3, fr = lane & 15, fq = lane >> 4;
  const int nt = K / 64;
  unsigned voff[2], voffA[2];
#pragma unroll
  for (int i = 0; i < 2; ++i) { int R, C; g8_stage_rc(tid * 16 + i * 8192, R, C); voff[i] = (unsigned)(R * K + C) * 2u; voffA[i] = ABLK ? (unsigned)(R * 64 + C) * 2u : voff[i]; }
  const size_t kstep = 128, hstep = (size_t)128 * K * 2, tstep = 2 * hstep;
  const size_t kstepA = ABLK ? 32768 : kstep, hstepA = ABLK ? 16384 : hstep;
  const unsigned ldsw = (unsigned)wid * 1024u;
  const int aoff = g8_lds_byte(wr * 64 + fr, fq * 8), boff = g8_lds_byte(wc * 32 + fr, fq * 8);
  const char* cA = (const char*)A + (size_t)pm * tstep;
  const char* cB = (const char*)Bt + (size_t)pn * tstep + (size_t)nh * hstep;
#define GH_STAGE(s_, kt_) do { _Pragma("unroll") for (int _i = 0; _i < 2; ++_i) { \
    __builtin_amdgcn_global_load_lds((const unsigned*)(cB + (size_t)(kt_) * kstep + voff[_i]), (LAS unsigned*)(lds + (s_) * 49152 + ldsw + _i * 8192), 16, 0, 0); \
    __builtin_amdgcn_global_load_lds((const unsigned*)(cA + (size_t)(kt_) * kstepA + voffA[_i]), (LAS unsigned*)(lds + (s_) * 49152 + 16384 + ldsw + _i * 8192), 16, 0, 0); \
    __builtin_amdgcn_global_load_lds((const unsigned*)(cA + hstepA + (size_t)(kt_) * kstepA + voffA[_i]), (LAS unsigned*)(lds + (s_) * 49152 + 32768 + ldsw + _i * 8192), 16, 0, 0); } } while (0)
  f32x4 acc[2][4][2];
#pragma unroll
  for (int a = 0; a < 2; ++a)
#pragma unroll
    for (int m = 0; m < 4; ++m)
#pragma unroll
      for (int n = 0; n < 2; ++n) acc[a][m][n] = f32x4{0.f, 0.f, 0.f, 0.f};
  __syncthreads();
  GH_STAGE(0, 0);
  asm volatile("s_waitcnt vmcnt(0)" ::: "memory");
  __syncthreads();
#pragma unroll 1
  for (int kt = 0; kt < nt; ++kt) {
    if (kt + 1 < nt) GH_STAGE((kt + 1) & 1, kt + 1);
    const LAS unsigned char* base = lds + (kt & 1) * 49152;
    bf16x8 B0[2][2];
#pragma unroll
    for (int n = 0; n < 2; ++n)
#pragma unroll
      for (int k = 0; k < 2; ++k) B0[n][k] = *(const LAS bf16x8*)(base + boff + n * 2048 + k * 1024);
#pragma unroll
    for (int ai = 0; ai < 2; ++ai) {
      bf16x8 At[4][2];
#pragma unroll
      for (int m = 0; m < 4; ++m)
#pragma unroll
        for (int k = 0; k < 2; ++k) At[m][k] = *(const LAS bf16x8*)(base + 16384 + ai * 16384 + aoff + m * 2048 + k * 1024);
#pragma unroll
      for (int m = 0; m < 4; ++m)
#pragma unroll
        for (int n = 0; n < 2; ++n)
#pragma unroll
          for (int k = 0; k < 2; ++k) acc[ai][m][n] = __builtin_amdgcn_mfma_f32_16x16x32_bf16(B0[n][k], At[m][k], acc[ai][m][n], 0, 0, 0);
    }
    asm volatile("s_waitcnt vmcnt(0)" ::: "memory");
    __syncthreads();
  }
#undef GH_STAGE
  E(acc, pm, pn, nh, wr, wc, fr, fq);
}

template <class F> struct ElemEpi {
  F f;
  DI void operator()(const f32x4 (&acc)[2][2][4][2], int pm, int pn, int wr, int wc, int fr, int fq) const {
    const int row0 = pm * 256 + wr * 64 + fr, col0 = pn * 256 + wc * 32 + 4 * fq;
#pragma unroll
    for (int ai = 0; ai < 2; ++ai)
#pragma unroll
      for (int m = 0; m < 4; ++m)
#pragma unroll
        for (int bj = 0; bj < 2; ++bj)
#pragma unroll
          for (int n = 0; n < 2; ++n) f(row0 + ai * 128 + m * 16, col0 + bj * 128 + n * 16, acc[ai][bj][m][n]);
  }
};
template <class F> DI ElemEpi<F> make_epi(F f) { return ElemEpi<F>{f}; }
template <int NM, int NN, int NN1, int SM1, int SN1, int SM2, int SN2, class F>
DI void gemm8_job(char* smem, const u16* A, const u16* Bt, int K, F f) {
  TileSched<NM, NN, NN1, SM1, SN1, SM2, SN2> S; S.init();
  gemm8(smem, A, Bt, K, S, make_epi(f));
}

struct EpiMixU {
  u16* MIX;
  DI void operator()(const f32x4 (&acc)[2][2][4][2], int pm, int pn, int wr, int wc, int fr, int fq) const {
    const int row0 = pm * 256 + wr * 64 + fr, col0 = pn * 256 + wc * 32 + 4 * fq;
#pragma unroll
    for (int ai = 0; ai < 2; ++ai)
#pragma unroll
      for (int m = 0; m < 4; ++m)
#pragma unroll
        for (int bj = 0; bj < 2; ++bj)
#pragma unroll
          for (int n = 0; n < 2; ++n) {
            const f32x4 v = acc[ai][bj][m][n];
            *(uint2*)(MIX + (unsigned)((row0 + ai * 128 + m * 16) * 1024 + col0 + bj * 128 + n * 16)) = pack4(gelu_tanh(v[0]), gelu_tanh(v[1]), gelu_tanh(v[2]), gelu_tanh(v[3]));
          }
  }
  DI void operator()(const f32x4 (&acc)[2][4][2], int pm, int pn, int nh, int wr, int wc, int fr, int fq) const {
    const int row0 = pm * 256 + wr * 64 + fr, col0 = pn * 256 + nh * 128 + wc * 32 + 4 * fq;
#pragma unroll
    for (int ai = 0; ai < 2; ++ai)
#pragma unroll
      for (int m = 0; m < 4; ++m)
#pragma unroll
        for (int n = 0; n < 2; ++n) {
          const f32x4 v = acc[ai][m][n];
          *(uint2*)(MIX + (unsigned)((row0 + ai * 128 + m * 16) * 1024 + col0 + n * 16)) = pack4(gelu_tanh(v[0]), gelu_tanh(v[1]), gelu_tanh(v[2]), gelu_tanh(v[3]));
        }
  }
};
struct EpiMixV {
  u16* VT; u16* PRT;
  DI void operator()(const f32x4 (&acc)[2][2][4][2], int pm, int pn, int wr, int wc, int fr, int fq) const {
    const int rowt = pm * 256;
    if (pn < 2) {
#pragma unroll
      for (int ai = 0; ai < 2; ++ai)
#pragma unroll
        for (int bj = 0; bj < 2; ++bj) {
          const unsigned g = (unsigned)(pn * 2 + bj), chunk = (unsigned)(pm * 2 + ai);
          const unsigned base = ((g * 320u + chunk) * 128u) * 128u;
#pragma unroll
          for (int m = 0; m < 4; ++m)
#pragma unroll
            for (int n = 0; n < 2; ++n) {
              const f32x4 v = acc[ai][bj][m][n];
              const unsigned c = (unsigned)(wc * 32 + n * 16 + fr), q = (unsigned)(wr * 64 + m * 16 + 4 * fq);
              *(uint2*)(VT + (base + c * 128u + q)) = pack4(gelu_tanh(v[0]), gelu_tanh(v[1]), gelu_tanh(v[2]), gelu_tanh(v[3]));
            }
        }
    } else {
      unsigned sbase, L;
      if (rowt < TP) { sbase = (unsigned)rowt * 1536u; L = 256u; }
      else { const int mm = rowt - TP; sbase = (unsigned)(TP + (mm & ~4095)) * 1536u + (unsigned)(mm & 4095); L = 4096u; }
#pragma unroll
      for (int ai = 0; ai < 2; ++ai)
#pragma unroll
        for (int bj = 0; bj < 2; ++bj)
#pragma unroll
          for (int m = 0; m < 4; ++m)
#pragma unroll
            for (int n = 0; n < 2; ++n) {
              const f32x4 v = acc[ai][bj][m][n];
              const unsigned cp = (unsigned)((pn - 2) * 256 + bj * 128 + wc * 32 + n * 16 + fr), tl = (unsigned)(ai * 128 + wr * 64 + m * 16 + 4 * fq);
              *(uint2*)(PRT + (sbase + cp * L + tl)) = pack4(v[0], v[1], v[2], v[3]);
            }
    }
  }
};
struct OneRoundSched {
  int c;
  DI void init() { c = blockIdx.x; }
  DI bool next(int i, int& pm, int& pn) const {
    if (gridDim.x == 256) { if (i > 0) return false; const int slot = c >> 3; pm = (c & 7) * 16 + (slot & 15); pn = slot >> 4; return true; }
    const int L = i * (int)gridDim.x + c; if (L >= 320) return false; pm = L >> 1; pn = L & 1; return true;
  }
};
DI void phase_mix_in(const PV& p, int i, char* smem) {
  const u16* H = (const u16*)(p.ws() + OFF_A + A_H);
  const u16* W = (const u16*)(p.ws() + OFF_WMIXIN) + (size_t)i * 2560 * 1024;
  EpiMixV EV; EV.VT = (u16*)(p.ws() + OFF_B + B_VT); EV.PRT = (u16*)(p.ws() + OFF_B + B_PRT);
  EpiMixU EU; EU.MIX = (u16*)(p.ws() + OFF_B + B_MIX);
  {
    TileSched<160, 8, 8, 8, 4, 32, 1> S; S.init();
    gemm8<false, 2>(smem, H, W + (size_t)512 * 1024, 1024, S, EV);
  }
  {
    OneRoundSched S; S.init();
    gemm8<false, 0>(smem, H, W, 1024, S, EU);
    if (gridDim.x == 256 && blockIdx.x < 128) {
      const int tile = blockIdx.x >> 1, nh = blockIdx.x & 1;
      gemm_half<false>(smem, H, W, 1024, 128 + (tile & 31), tile >> 5, nh, EU);
    }
  }
}

DI void phase_sgu(const PV& p, int i, char* smem) {
  const u16* VT = (const u16*)(p.ws() + OFF_B + B_VT);
  const u16* W = (const u16*)(p.ws() + OFF_WSGU) + (size_t)i * 4 * 16384;
  u16* MIX = (u16*)(p.ws() + OFF_B + B_MIX);
  const float* sb = p.in(11) + i * 512;
  for (int u = blockIdx.x; u < 640; u += gridDim.x) {
    const int g = u / 160, tm = u % 160;
    auto epi = [=](int m, int n, f32x4 v, uint2 uu) {
      const int chunk = m >> 7, c = m & 127;
      const int t = chunk * 128 + n;
      const float bias = sb[g * 128 + n];
      u16* dst = MIX + (size_t)t * 1024 + g * 128 + c;
      *(uint2*)dst = pack4(lo16(uu.x) * (v[0] + bias), hi16(uu.x) * (v[1] + bias), lo16(uu.y) * (v[2] + bias), hi16(uu.y) * (v[3] + bias));
    };
    auto pre = [=](int m, int n) { return *(const uint2*)(MIX + (size_t)((m >> 7) * 128 + n) * 1024 + g * 128 + (m & 127)); };
    gemm_tile<false>(VT + (size_t)g * 320 * 128 * 128, 128, W + (size_t)g * 16384, 128, 128, tm * 256, 0, smem, epi, pre);
  }
}

DI size_t prt_off(int kind, int b, int cp) {
  return kind ? (size_t)(TP + b * 4096) * 1536 + (size_t)cp * 4096 : (size_t)(b * 256) * 1536 + (size_t)cp * 256;
}
DI size_t zt_off(int kind, int b, int c) {
  return kind ? (size_t)(TP + b * 4096) * 512 + (size_t)c * 4096 : (size_t)(b * 256) * 512 + (size_t)c * 256;
}
DI void phase_conv(const PV& p, int i, int ord, char* smem) {
  const int tid = TIDX(), lane = tid & 63, wid = tid >> 6;
  const u16* PRT = (const u16*)(p.ws() + OFF_B + B_PRT);
  const u16* FILT = (const u16*)(p.ws() + OFF_FILT);
  const u16* Z1 = (const u16*)(p.ws() + OFF_A + A_Z1);
  u16* ZO = (u16*)(p.ws() + OFF_A + (ord ? A_Z2 : A_Z1));
  const float* cw = p.in(12) + (size_t)i * 3 * 1536;
  const float* cb = p.in(13) + (size_t)i * 1536;
  u16* hc = (u16*)smem;
  char* Ub = smem + 68096;
  for (int u = blockIdx.x; u < 1024; u += gridDim.x) {
    const int kind = u < 512 ? 1 : 0, c = u & 511;
    const int L = kind ? 4096 : 256, NB = kind ? 8 : 32, LB = L >> 6, DD = L >> 7;
    const int US = (L + 8) * 2;
    const size_t fbase = ((size_t)(i * 2 + ord) * 512 + c) * 4352 + (kind ? 256 : 0);
    __syncthreads();
    {
      u16* tmp = (u16*)Ub;
      for (int idx = tid; idx < (L >> 3); idx += 512) *(uint4*)(tmp + idx * 8) = *(const uint4*)(FILT + fbase + idx * 8);
      __syncthreads();
#pragma unroll 1
      for (int cpy = 0; cpy < 8; ++cpy)
        for (int m = tid; m < L + 136; m += 512) {
          const int x = L + 63 - m - cpy;
          hc[cpy * 4256 + m] = (x >= 0 && x < L) ? tmp[x] : (u16)0;
        }
      __syncthreads();
    }
    {
      const int lgn = kind ? 9 : 5, ncr = 1 << lgn, total = NB * ncr;
      const float w0 = cw[c], w1 = cw[1536 + c], w2 = cw[3072 + c], bb = cb[c];
      for (int id = tid; id < total; id += 512) {
        const int b = id >> lgn, t = (id & (ncr - 1)) * 8;
        uint4 o;
        if (ord == 0) {
          const u16* src = PRT + prt_off(kind, b, c) + t;
          const uint4 raw = *(const uint4*)src;
          float e[10];
          e[0] = t > 0 ? bf2f(src[-1]) : 0.f;
          e[9] = t + 8 < L ? bf2f(src[8]) : 0.f;
          e[1] = lo16(raw.x); e[2] = hi16(raw.x); e[3] = lo16(raw.y); e[4] = hi16(raw.y);
          e[5] = lo16(raw.z); e[6] = hi16(raw.z); e[7] = lo16(raw.w); e[8] = hi16(raw.w);
          float r[8];
#pragma unroll
          for (int k = 0; k < 8; ++k) r[k] = w0 * e[k] + w1 * e[k + 1] + w2 * e[k + 2] + bb;
          o.x = pack2(r[0], r[1]); o.y = pack2(r[2], r[3]); o.z = pack2(r[4], r[5]); o.w = pack2(r[6], r[7]);
        } else {
          o = *(const uint4*)(Z1 + zt_off(kind, b, c) + t);
        }
        *(uint4*)(Ub + b * US + t * 2) = o;
      }
    }
    __syncthreads();
    const int ncols = LB * NB;
#pragma unroll 1
    for (int hf = 0; hf < 2; ++hf) {
      const int jt = wid + 8 * hf;
      if (jt * 32 >= ncols) break;
      const int il = lane & 31, q = lane >> 5;
      const int lgb = kind ? 3 : 5;
      const int col = jt * 32 + il, t1c = col >> lgb, bc = col & (NB - 1);
      const int t1lo = (jt * 32) >> lgb, t1hi = (jt * 32 + 31) >> lgb;
      const int dlo = max(-DD, t1lo - (LB - 1)), dhi = min(DD, t1hi);
      const int cpy = 7 - (il & 7);
      const char* abase = (const char*)hc + cpy * 8512 + 2 * (L / 2 + 63 - il - cpy + 8 * q);
      f32x16 acc[2];
#pragma unroll
      for (int a = 0; a < 2; ++a)
#pragma unroll
        for (int r = 0; r < 16; ++r) acc[a][r] = 0.f;
      for (int d = dlo; d <= dhi; ++d) {
        bf16x8 bfr[4];
        {
          const int s1 = t1c - d;
          const bool valid = s1 >= 0 && s1 < LB;
          const char* bp = Ub + bc * US + ((valid ? s1 : 0) * 64 + 8 * q) * 2;
#pragma unroll
          for (int ks = 0; ks < 4; ++ks) {
            bf16x8 v = *(const bf16x8*)(bp + ks * 32);
            if (!valid) v = bf16x8{0, 0, 0, 0, 0, 0, 0, 0};
            bfr[ks] = v;
          }
        }
#pragma unroll
        for (int mt = 0; mt < 2; ++mt)
#pragma unroll
          for (int ks = 0; ks < 4; ++ks) {
            const bf16x8 af = *(const bf16x8*)(abase + 2 * (-64 * d - 32 * mt + 16 * ks));
            acc[mt] = __builtin_amdgcn_mfma_f32_32x32x16_bf16(af, bfr[ks], acc[mt], 0, 0, 0);
          }
      }
      const float dsk = p.in(21)[(i * 2 + ord) * 512 + c];
      const int gc = 512 * (ord + 1) + c;
      const float w0 = cw[gc], w1 = cw[1536 + gc], w2 = cw[3072 + gc], bb = cb[gc];
      {
        const int b = bc;
        const u16* xrow = PRT + prt_off(kind, b, gc);
        u16* orow = ZO + zt_off(kind, b, c);
#pragma unroll
        for (int mt = 0; mt < 2; ++mt)
#pragma unroll
          for (int g = 0; g < 4; ++g) {
            const int t = 64 * t1c + mt * 32 + 8 * g + 4 * q;
            const uint2 uu = *(const uint2*)(Ub + b * US + t * 2);
            const uint2 xx = *(const uint2*)(xrow + t);
            const float em = t > 0 ? bf2f(xrow[t - 1]) : 0.f;
            const float ep = t + 4 < L ? bf2f(xrow[t + 4]) : 0.f;
            const float e0 = lo16(xx.x), e1 = hi16(xx.x), e2 = lo16(xx.y), e3 = hi16(xx.y);
            const float x0 = w0 * em + w1 * e0 + w2 * e1 + bb;
            const float x1 = w0 * e0 + w1 * e1 + w2 * e2 + bb;
            const float x2 = w0 * e1 + w1 * e2 + w2 * e3 + bb;
            const float x3 = w0 * e2 + w1 * e3 + w2 * ep + bb;
            const float y0 = acc[mt][4 * g + 0] + lo16(uu.x) * dsk;
            const float y1 = acc[mt][4 * g + 1] + hi16(uu.x) * dsk;
            const float y2 = acc[mt][4 * g + 2] + lo16(uu.y) * dsk;
            const float y3 = acc[mt][4 * g + 3] + hi16(uu.y) * dsk;
            *(uint2*)(orow + t) = pack4(x0 * y0, x1 * y1, x2 * y2, x3 * y3);
          }
      }
    }
  }
  __syncthreads();
}

DI void phase_ztrans(const PV& p, char* smem) {
  const int tid = TIDX();
  const u16* Z2 = (const u16*)(p.ws() + OFF_A + A_Z2);
  u16* MIX = (u16*)(p.ws() + OFF_B + B_MIX);
  u16* tl = (u16*)smem;
  for (int u4 = blockIdx.x * 4; u4 < 640 * 8; u4 += gridDim.x * 4) {
    const int tt0 = (u4 >> 3) * 64;
    const int kind = tt0 >= TP ? 1 : 0;
    const int b = kind ? (tt0 - TP) >> 12 : tt0 >> 8;
    const int tl0 = kind ? (tt0 - TP) & 4095 : tt0 & 255;
    __syncthreads();
    { const int c = tid >> 3, ch = tid & 7;
      uint4 v[4];
#pragma unroll
      for (int w = 0; w < 4; ++w) v[w] = *(const uint4*)(Z2 + zt_off(kind, b, ((u4 + w) & 7) * 64 + c) + tl0 + ch * 8);
#pragma unroll
      for (int w = 0; w < 4; ++w) *(uint4*)(tl + w * 4608 + c * 72 + ch * 8) = v[w]; }
    __syncthreads();
    { const int tr = tid >> 3, cc = (tid & 7) * 8;
#pragma unroll
      for (int w = 0; w < 4; ++w) {
        const u16* tw = tl + w * 4608;
        uint4 o;
        o.x = (unsigned)tw[(cc + 0) * 72 + tr] | ((unsigned)tw[(cc + 1) * 72 + tr] << 16);
        o.y = (unsigned)tw[(cc + 2) * 72 + tr] | ((unsigned)tw[(cc + 3) * 72 + tr] << 16);
        o.z = (unsigned)tw[(cc + 4) * 72 + tr] | ((unsigned)tw[(cc + 5) * 72 + tr] << 16);
        o.w = (unsigned)tw[(cc + 6) * 72 + tr] | ((unsigned)tw[(cc + 7) * 72 + tr] << 16);
        *(uint4*)(MIX + (size_t)(tt0 + tr) * 1024 + 512 + ((u4 + w) & 7) * 64 + cc) = o;
      } }
  }
  __syncthreads();
}

struct EpiResid {
  float* X; const float* x0; const float* x1; const float* gate; int lx;
  DI void operator()(const f32x4 (&acc)[2][2][4][2], int pm, int pn, int wr, int wc, int fr, int fq) const {
    const int rowt = pm * 256, col0 = pn * 256 + wc * 32 + 4 * fq;
    const float* gr = gate + (size_t)condrow(rowt) * 6144 + col0;
    const float* xb = lx == 0 ? (rowt < TP ? x0 + (size_t)rowt * 1024 : x1 + (size_t)(rowt - TP) * 1024) : X + (size_t)rowt * 1024;
    float4 g[2][2];
#pragma unroll
    for (int bj = 0; bj < 2; ++bj)
#pragma unroll
      for (int n = 0; n < 2; ++n) g[bj][n] = *(const float4*)(gr + bj * 128 + n * 16);
#pragma unroll
    for (int ai = 0; ai < 2; ++ai)
#pragma unroll
      for (int mh = 0; mh < 2; ++mh) {
        float4 xo[2][2][2];
#pragma unroll
        for (int mm = 0; mm < 2; ++mm)
#pragma unroll
          for (int bj = 0; bj < 2; ++bj)
#pragma unroll
            for (int n = 0; n < 2; ++n)
              xo[mm][bj][n] = *(const float4*)(xb + (size_t)(wr * 64 + fr + ai * 128 + (2 * mh + mm) * 16) * 1024 + col0 + bj * 128 + n * 16);
#pragma unroll
        for (int mm = 0; mm < 2; ++mm)
#pragma unroll
          for (int bj = 0; bj < 2; ++bj)
#pragma unroll
            for (int n = 0; n < 2; ++n) {
              const f32x4 v = acc[ai][bj][2 * mh + mm][n];
              const float4 x = xo[mm][bj][n], gg = g[bj][n];
              float4 o; o.x = x.x + gg.x * v[0]; o.y = x.y + gg.y * v[1]; o.z = x.z + gg.z * v[2]; o.w = x.w + gg.w * v[3];
              *(float4*)(X + (size_t)(rowt + wr * 64 + fr + ai * 128 + (2 * mh + mm) * 16) * 1024 + col0 + bj * 128 + n * 16) = o;
            }
      }
  }
};
struct EpiResidHalf {
  float* X; const float* x0; const float* x1; const float* gate; int lx;
  DI void operator()(const f32x4 (&acc)[2][4][2], int pm, int pn, int nh, int wr, int wc, int fr, int fq) const {
    const int rowt = pm * 256, col0 = pn * 256 + nh * 128 + wc * 32 + 4 * fq;
    const float* gr = gate + (size_t)condrow(rowt) * 6144 + col0;
    const float* xb = lx == 0 ? (rowt < TP ? x0 + (size_t)rowt * 1024 : x1 + (size_t)(rowt - TP) * 1024) : X + (size_t)rowt * 1024;
    float4 g[2];
#pragma unroll
    for (int n = 0; n < 2; ++n) g[n] = *(const float4*)(gr + n * 16);
#pragma unroll
    for (int ai = 0; ai < 2; ++ai) {
      float4 xo[4][2];
#pragma unroll
      for (int m = 0; m < 4; ++m)
#pragma unroll
        for (int n = 0; n < 2; ++n) xo[m][n] = *(const float4*)(xb + (size_t)(wr * 64 + fr + ai * 128 + m * 16) * 1024 + col0 + n * 16);
#pragma unroll
      for (int m = 0; m < 4; ++m)
#pragma unroll
        for (int n = 0; n < 2; ++n) {
          const f32x4 v = acc[ai][m][n];
          const float4 x = xo[m][n], gg = g[n];
          float4 o; o.x = x.x + gg.x * v[0]; o.y = x.y + gg.y * v[1]; o.z = x.z + gg.z * v[2]; o.w = x.w + gg.w * v[3];
          *(float4*)(X + (size_t)(rowt + wr * 64 + fr + ai * 128 + m * 16) * 1024 + col0 + n * 16) = o;
        }
    }
  }
};
struct ResidSched2 {
  int c;
  DI void init() { c = blockIdx.x; }
  DI bool next(int i, int& pm, int& pn) const {
    if (gridDim.x == 256) {
      const int st = (c & 7) + 8 * i;
      if (st >= 16) return false;
      pm = st * 8 + ((c >> 3) & 7); pn = c >> 6; return true;
    }
    const int L = i * (int)gridDim.x + c; if (L >= 640) return false; pm = L >> 2; pn = L & 3; return true;
  }
};
DI void phase_resid_gemm(const PV& p, int l, int lx, const u16* A, int K, const u16* W, int goff, char* smem) {
  EpiResid E;
  E.X = p.out(); E.x0 = p.in(0); E.x1 = p.in(1); E.gate = (const float*)(p.ws() + OFF_MOD) + (size_t)l * 9 * 6144 + goff; E.lx = lx;
  ResidSched2 S; S.init();
  if (K == 2816) gemm8<true>(smem, A, W, K, S, E);
  else gemm8<false>(smem, A, W, K, S, E);
  if (gridDim.x == 256) {
    EpiResidHalf EH; EH.X = E.X; EH.x0 = E.x0; EH.x1 = E.x1; EH.gate = E.gate; EH.lx = lx;
    const int xcd = blockIdx.x & 7, slot = blockIdx.x >> 3;
    const int st = 16 + (xcd >> 1), ti = (xcd & 1) * 16 + (slot >> 1), nh = slot & 1;
    const int pm = st * 8 + (ti & 7), pn = ti >> 3;
    if (K == 2816) gemm_half<true>(smem, A, W, K, pm, pn, nh, EH);
    else gemm_half<false>(smem, A, W, K, pm, pn, nh, EH);
  }
}

DI void phase_dqkv(const PV& p, int j, char* smem) {
  const u16* H = (const u16*)(p.ws() + OFF_A + A_H);
  const u16* W = (const u16*)(p.ws() + OFF_WDQKV) + (size_t)j * 1024 * 1024;
  u16* DQKV = (u16*)(p.ws() + OFF_B + B_DQKV);
  u16* KR = (u16*)(p.ws() + OFF_KR);
  float* okr = p.out() + 46137344;
  auto epi = [=](int m, int n, f32x4 v) {
    if (n < 832) {
      const uint2 pk = pack4(v[0], v[1], v[2], v[3]);
      *(uint2*)(DQKV + (size_t)m * 896 + n) = pk;
      if (n >= 768) {
        const int e = n - 768;
        *(uint2*)(KR + (size_t)m * 64 + e) = pk;
        if (m < TP) {
          float4 o; o.x = v[0]; o.y = v[1]; o.z = v[2]; o.w = v[3];
          *(float4*)(okr + ((size_t)((m >> 8) * 2 + j) * 256 + (m & 255)) * 64 + e) = o;
        }
      }
    }
  };
  gemm8_job<160, 4, 4, 8, 4, 32, 1>(smem, H, W, 1024, epi);
}

DI void phase_mla_norms(const PV& p, int j) {
  const int tid_ = TIDX(); const int lane = tid_ & 63, wid = tid_ >> 6;
  const u16* DQKV = (const u16*)(p.ws() + OFF_B + B_DQKV);
  u16* QN = (u16*)(p.ws() + OFF_A + A_QN);
  u16* CKV = (u16*)(p.ws() + OFF_A + A_CKV);
  u16* KR = (u16*)(p.ws() + OFF_KR);
  float* ockv = p.out() + 41943040;
  const float* qn = p.in(24) + j * 512;
  const float* kvn = p.in(27) + j * 256;
  for (int t = blockIdx.x * 8 + wid; t < TK; t += gridDim.x * 8) {
    if (t < T) {
      const u16* row = DQKV + (size_t)t * 896;
      const uint4 a = *(const uint4*)(row + lane * 8);
      float q[8] = {lo16(a.x), hi16(a.x), lo16(a.y), hi16(a.y), lo16(a.z), hi16(a.z), lo16(a.w), hi16(a.w)};
      float ss = 0.f;
#pragma unroll
      for (int k = 0; k < 8; ++k) ss += q[k] * q[k];
      ss = wave_sum(ss, lane);
      const float r = rsqrtf(ss * (1.f / 512.f) + EPS);
      const float4 g0 = *(const float4*)(qn + lane * 8), g1 = *(const float4*)(qn + lane * 8 + 4);
      uint4 o;
      o.x = pack2(q[0] * r * g0.x, q[1] * r * g0.y); o.y = pack2(q[2] * r * g0.z, q[3] * r * g0.w);
      o.z = pack2(q[4] * r * g1.x, q[5] * r * g1.y); o.w = pack2(q[6] * r * g1.z, q[7] * r * g1.w);
      *(uint4*)(QN + (size_t)t * 512 + lane * 8) = o;
      const uint2 b = *(const uint2*)(row + 512 + lane * 4);
      float kv[4] = {lo16(b.x), hi16(b.x), lo16(b.y), hi16(b.y)};
      float s2 = kv[0] * kv[0] + kv[1] * kv[1] + kv[2] * kv[2] + kv[3] * kv[3];
      s2 = wave_sum(s2, lane);
      const float r2 = rsqrtf(s2 * (1.f / 256.f) + EPS);
      const float4 g2 = *(const float4*)(kvn + lane * 4);
      float4 o2; o2.x = kv[0] * r2 * g2.x; o2.y = kv[1] * r2 * g2.y; o2.z = kv[2] * r2 * g2.z; o2.w = kv[3] * r2 * g2.w;
      *(uint2*)(CKV + (size_t)t * 256 + lane * 4) = pack4(o2.x, o2.y, o2.z, o2.w);
      if (t < TP) *(float4*)(ockv + ((size_t)((t >> 8) * 2 + j) * 256 + (t & 255)) * 256 + lane * 4) = o2;
    } else {
      const int pp = t - T, b = pp >> 8, s = pp & 255;
      const float4 v = *(const float4*)(p.in(2) + ((size_t)(b * 2 + j) * 256 + s) * 256 + lane * 4);
      *(uint2*)(CKV + (size_t)t * 256 + lane * 4) = pack4(v.x, v.y, v.z, v.w);
      if (lane < 16) {
        const float4 w = *(const float4*)(p.in(3) + ((size_t)(b * 2 + j) * 256 + s) * 64 + lane * 4);
        *(uint2*)(KR + (size_t)t * 64 + lane * 4) = pack4(w.x, w.y, w.z, w.w);
      }
    }
  }
}

DI size_t vt_off(int m, int h, int d) {
  if (m < TP) return ((size_t)((m >> 8) * 8 + h) * 128 + d) * 256 + (m & 255);
  if (m < T) { const int mm = m - TP; return VT_SAMPLE_OFF + ((size_t)((mm >> 12) * 8 + h) * 128 + d) * 4352 + (mm & 4095); }
  const int mm = m - T;
  return VT_SAMPLE_OFF + ((size_t)((mm >> 8) * 8 + h) * 128 + d) * 4352 + 4096 + (mm & 255);
}
struct EpiKV {
  u16* Kb; u16* Vt;
  DI void operator()(const f32x4 (&acc)[2][2][4][2], int pm, int pn, int wr, int wc, int fr, int fq) const {
    const int h = pn;
    const int rowt = pm * 256;
    const unsigned ls = rowt < TP ? 256u : 4352u;
    unsigned vbase;
    if (rowt < TP) vbase = (unsigned)(((rowt >> 8) * 8 + h) * 128) * 256u;
    else if (rowt < T) { const int mm = rowt - TP; vbase = (unsigned)VT_SAMPLE_OFF + (unsigned)(((mm >> 12) * 8 + h) * 128) * 4352u + (unsigned)(mm & 4095); }
    else { const int mm = rowt - T; vbase = (unsigned)VT_SAMPLE_OFF + (unsigned)(((mm >> 8) * 8 + h) * 128) * 4352u + 4096u + (unsigned)(mm & 255); }
    const unsigned dcol = (unsigned)(wc * 32 + 4 * fq);
#pragma unroll
    for (int ai = 0; ai < 2; ++ai)
#pragma unroll
      for (int m = 0; m < 4; ++m) {
        const int rl = ai * 128 + wr * 64 + m * 16 + fr;
        const unsigned ko = (unsigned)((rowt + rl) * 8 + h) * 192u + dcol;
        const unsigned frp = (unsigned)((fr & 3) | ((fr & 4) << 1) | ((fr & 8) >> 1));
        const unsigned vo = vbase + (unsigned)(rl & ~15) + frp + dcol * ls;
#pragma unroll
        for (int n = 0; n < 2; ++n) {
          const f32x4 k = acc[ai][0][m][n], v = acc[ai][1][m][n];
          *(uint2*)(Kb + (ko + n * 16)) = pack4(k[0], k[1], k[2], k[3]);
          const unsigned p01 = pack2(v[0], v[1]), p23 = pack2(v[2], v[3]);
          const unsigned vq = vo + (unsigned)(n * 16) * ls;
          Vt[vq] = (u16)p01; Vt[vq + ls] = (u16)(p01 >> 16); Vt[vq + 2 * ls] = (u16)p23; Vt[vq + 3 * ls] = (u16)(p23 >> 16);
        }
      }
  }
};
DI void phase_uq_ukv(const PV& p, int j, char* smem) {
  const u16* QN = (const u16*)(p.ws() + OFF_A + A_QN);
  const u16* CKV = (const u16*)(p.ws() + OFF_A + A_CKV);
  const u16* WQ = (const u16*)(p.ws() + OFF_WUQ) + (size_t)j * 1536 * 512;
  const u16* WKV = (const u16*)(p.ws() + OFF_WUKV) + (size_t)j * 2048 * 256;
  u16* Q = (u16*)(p.ws() + OFF_B + B_Q);
  u16* Kb = (u16*)(p.ws() + OFF_B + B_K);
  u16* Vt = (u16*)(p.ws() + OFF_B + B_V);
  auto epiq = [=](int m, int n, f32x4 v) { *(uint2*)(Q + (size_t)m * 1536 + n) = pack4(v[0], v[1], v[2], v[3]); };
  gemm8_job<160, 6, 4, 8, 4, 16, 2>(smem, QN, WQ, 512, epiq);
  EpiKV E; E.Kb = Kb; E.Vt = Vt;
  TileSched<168, 8, 8, 8, 4, 32, 1> S; S.init();
  gemm8(smem, CKV, WKV, 256, S, E);
}

DI void phase_finalize(const PV& p, int j) {
  const int tid_ = TIDX(); const int lane = tid_ & 63, wid = tid_ >> 6;
  const int h = lane >> 3, l8 = lane & 7;
  u16* Q = (u16*)(p.ws() + OFF_B + B_Q);
  u16* Kb = (u16*)(p.ws() + OFF_B + B_K);
  const u16* KR = (const u16*)(p.ws() + OFF_KR);
  const float2* ROPE = (const float2*)(p.ws() + OFF_ROPE);
  const float* qhn = p.in(29) + j * 192;
  const float* khn = p.in(30) + j * 192;
  const float QSCALE = 1.4426950408889634f * 0.07216878364870322f;
  const int stride = gridDim.x * 8;
  for (int u0 = T + blockIdx.x * 8 + wid; u0 < T + TK; u0 += 2 * stride) {
    uint4 raw[2][3];
    u16* basep[2];
#pragma unroll
    for (int w = 0; w < 2; ++w) {
      const int u = u0 + w * stride;
      if (u < T + TK) {
        const bool isq = u < T;
        const int t = isq ? u : u - T;
        u16* base = isq ? Q + (size_t)t * 1536 + h * 192 : Kb + ((size_t)t * 8 + h) * 192;
        basep[w] = base;
#pragma unroll
        for (int k = 0; k < 3; ++k) {
          const u16* src = (!isq && k == 2) ? KR + (size_t)t * 64 + 8 * l8 : base + 8 * (l8 + 8 * k);
          raw[w][k] = *(const uint4*)src;
        }
      }
    }
#pragma unroll
    for (int w = 0; w < 2; ++w) {
      const int u = u0 + w * stride;
      if (u < T + TK) {
        const bool isq = u < T;
        const int t = isq ? u : u - T;
        const float* hn = isq ? qhn : khn;
        float v[3][8];
#pragma unroll
        for (int k = 0; k < 3; ++k) {
          const uint4 a = raw[w][k];
          v[k][0] = lo16(a.x); v[k][1] = hi16(a.x); v[k][2] = lo16(a.y); v[k][3] = hi16(a.y);
          v[k][4] = lo16(a.z); v[k][5] = hi16(a.z); v[k][6] = lo16(a.w); v[k][7] = hi16(a.w);
        }
        float ss = 0.f;
#pragma unroll
        for (int k = 0; k < 3; ++k)
#pragma unroll
          for (int e = 0; e < 8; ++e) ss += v[k][e] * v[k][e];
        ss += shx<1>(ss, lane); ss += shx<2>(ss, lane); ss += shx<4>(ss, lane);
        const float r = rsqrtf(ss * (1.f / 192.f) + EPS);
#pragma unroll
        for (int k = 0; k < 3; ++k) {
          const float4 g0 = *(const float4*)(hn + 8 * (l8 + 8 * k)), g1 = *(const float4*)(hn + 8 * (l8 + 8 * k) + 4);
          v[k][0] *= r * g0.x; v[k][1] *= r * g0.y; v[k][2] *= r * g0.z; v[k][3] *= r * g0.w;
          v[k][4] *= r * g1.x; v[k][5] *= r * g1.y; v[k][6] *= r * g1.z; v[k][7] *= r * g1.w;
        }
        if (t >= TP && t < T) {
          const int tl = (t - TP) & 4095;
          const int pos = l8 < 4 ? (tl >> 6) : (tl & 63);
          const float4* rp = (const float4*)(ROPE + pos * 16 + (l8 & 1) * 8);
          const float4 c01 = rp[0], c23 = rp[1], c45 = rp[2], c67 = rp[3];
          const float cs[8] = {c01.x, c01.z, c23.x, c23.z, c45.x, c45.z, c67.x, c67.z};
          const float sn[8] = {c01.y, c01.w, c23.y, c23.w, c45.y, c45.w, c67.y, c67.w};
#pragma unroll
          for (int e = 0; e < 8; ++e) {
            const float x = v[2][e];
            const float partner = shx<2>(x, lane);
            v[2][e] = (l8 & 2) ? x * cs[e] + partner * sn[e] : x * cs[e] - partner * sn[e];
          }
        }
        const float sc = isq ? QSCALE : 1.f;
#pragma unroll
        for (int k = 0; k < 3; ++k) {
          uint4 o;
          o.x = pack2(v[k][0] * sc, v[k][1] * sc); o.y = pack2(v[k][2] * sc, v[k][3] * sc);
          o.z = pack2(v[k][4] * sc, v[k][5] * sc); o.w = pack2(v[k][6] * sc, v[k][7] * sc);
          *(uint4*)(basep[w] + 8 * (l8 + 8 * k)) = o;
        }
      }
    }
  }
}

DI void attn_item(const PV& p, int j, int kind, int seq, int h, int q0, char* smem) {
  const int tid = TIDX(), lane = tid & 63, wid = tid >> 6;
  const int il = lane & 31, hh = lane >> 5;
  const u16* Q = (const u16*)(p.ws() + OFF_B + B_Q);
  const u16* Kb = (const u16*)(p.ws() + OFF_B + B_K);
  const u16* Vt = (const u16*)(p.ws() + OFF_B + B_V);
  u16* O = (u16*)(p.ws() + OFF_A + A_O);
  const float* qhn = p.in(29) + j * 192;
  const float2* ROPE = (const float2*)(p.ws() + OFF_ROPE);
  const int Lk = kind ? 4352 : 256, nkt = Lk >> 6;
  const u16* vbase = Vt + (kind ? VT_SAMPLE_OFF + (size_t)(seq * 8 + h) * 128 * 4352 : (size_t)(seq * 8 + h) * 128 * 256);
  const int tq = q0 + wid * 32 + il;
  bf16x8 qf[12];
  {
    float v[12][8];
    float ss = 0.f;
#pragma unroll
    for (int ks = 0; ks < 12; ++ks) {
      const uint4 a = *(const uint4*)(Q + ((size_t)tq * 8 + h) * 192 + 16 * ks + 8 * hh);
      v[ks][0] = lo16(a.x); v[ks][1] = hi16(a.x); v[ks][2] = lo16(a.y); v[ks][3] = hi16(a.y);
      v[ks][4] = lo16(a.z); v[ks][5] = hi16(a.z); v[ks][6] = lo16(a.w); v[ks][7] = hi16(a.w);
#pragma unroll
      for (int e = 0; e < 8; ++e) ss += v[ks][e] * v[ks][e];
    }
    { auto rr = __builtin_amdgcn_permlane32_swap(__float_as_uint(ss), __float_as_uint(ss), false, false); ss = __uint_as_float(rr[0]) + __uint_as_float(rr[1]); }
    const float rn = rsqrtf(ss * (1.f / 192.f) + EPS);
#pragma unroll
    for (int ks = 0; ks < 12; ++ks) {
      const float4 g0 = *(const float4*)(qhn + 16 * ks + 8 * hh), g1 = *(const float4*)(qhn + 16 * ks + 8 * hh + 4);
      v[ks][0] *= rn * g0.x; v[ks][1] *= rn * g0.y; v[ks][2] *= rn * g0.z; v[ks][3] *= rn * g0.w;
      v[ks][4] *= rn * g1.x; v[ks][5] *= rn * g1.y; v[ks][6] *= rn * g1.z; v[ks][7] *= rn * g1.w;
    }
    if (kind) {
      const int tl = (tq - TP) & 4095;
#pragma unroll
      for (int part = 0; part < 2; ++part) {
        const int pos = part == 0 ? (tl >> 6) : (tl & 63);
        const float4* rp = (const float4*)(ROPE + pos * 16 + 8 * hh);
        const float4 c01 = rp[0], c23 = rp[1], c45 = rp[2], c67 = rp[3];
        const float cs[8] = {c01.x, c01.z, c23.x, c23.z, c45.x, c45.z, c67.x, c67.z};
        const float sn[8] = {c01.y, c01.w, c23.y, c23.w, c45.y, c45.w, c67.y, c67.w};
#pragma unroll
        for (int e = 0; e < 8; ++e) {
          const float x1 = v[8 + 2 * part][e], x2 = v[9 + 2 * part][e];
          v[8 + 2 * part][e] = x1 * cs[e] - x2 * sn[e];
          v[9 + 2 * part][e] = x2 * cs[e] + x1 * sn[e];
        }
      }
    }
    const float QSCALE = 1.4426950408889634f * 0.07216878364870322f;
#pragma unroll
    for (int ks = 0; ks < 12; ++ks) {
      union { bf16x8 b; unsigned w[4]; } o;
#pragma unroll
      for (int w = 0; w < 4; ++w) o.w[w] = pack2(v[ks][2 * w] * QSCALE, v[ks][2 * w + 1] * QSCALE);
      qf[ks] = o.b;
    }
  }
  f32x16 oacc[4];
#pragma unroll
  for (int a = 0; a < 4; ++a)
#pragma unroll
    for (int r = 0; r < 16; ++r) oacc[a][r] = 0.f;
  float mrun = -INFINITY, lrun = 0.f;
  const int sw = (il >> 1) & 7;
  int ko[4], vob[4];
#pragma unroll
  for (int a = 0; a < 4; ++a) ko[a] = il * 384 + (((2 * a + hh) ^ sw) << 4);
#pragma unroll
  for (int c = 0; c < 4; ++c) vob[c] = il * 128 + (((2 * c + hh) ^ sw) << 4);
  LAS unsigned char* lds = (LAS unsigned char*)smem;
  unsigned kso[3], vso[2];
#pragma unroll
  for (int i = 0; i < 3; ++i) {
    const int id = tid + 512 * i, r = id / 24, pc = id - r * 24;
    const int ch = (pc & ~7) | ((pc & 7) ^ ((r >> 1) & 7));
    kso[i] = (unsigned)(r * 3072 + ch * 16);
  }
#pragma unroll
  for (int i = 0; i < 2; ++i) {
    const int id = tid + 512 * i, dd = id >> 3, pc = id & 7;
    const int ch = pc ^ ((dd >> 1) & 7);
    vso[i] = (unsigned)(dd * Lk * 2 + ch * 16);
  }
  const unsigned ldst = (unsigned)(tid >> 6) * 1024u;
#define ATT_STAGE(kt_, s_)                                                                                      \
  {                                                                                                            \
    const int k0_ = (kt_) * 64;                                                                                \
    const int rowbase_ = kind ? (k0_ < 4096 ? TP + seq * 4096 + k0_ : T + seq * 256 + (k0_ - 4096)) : seq * 256 + k0_; \
    const char* kg_ = (const char*)(Kb + ((size_t)rowbase_ * 8 + h) * 192);                                     \
    const char* vg_ = (const char*)(vbase + k0_);                                                              \
    _Pragma("unroll") for (int i_ = 0; i_ < 3; ++i_)                                                           \
      __builtin_amdgcn_global_load_lds((const unsigned*)(kg_ + kso[i_]), (LAS unsigned*)(lds + (s_) * 40960 + ldst + i_ * 8192), 16, 0, 0); \
    _Pragma("unroll") for (int i_ = 0; i_ < 2; ++i_)                                                           \
      __builtin_amdgcn_global_load_lds((const unsigned*)(vg_ + vso[i_]), (LAS unsigned*)(lds + (s_) * 40960 + 24576 + ldst + i_ * 8192), 16, 0, 0); \
  }
  __syncthreads();
  ATT_STAGE(0, 0)
  asm volatile("s_waitcnt vmcnt(0)" ::: "memory");
  __syncthreads();
  for (int kt = 0; kt < nkt; ++kt) {
    const bool more = kt + 1 < nkt;
    if (more) ATT_STAGE(kt + 1, (kt + 1) & 1)
    const char* Ks = smem + (kt & 1) * 40960;
    const char* Vs = Ks + 24576;
    f32x16 s2[2];
    __builtin_amdgcn_s_setprio(1);
#pragma unroll
    for (int st = 0; st < 2; ++st)
#pragma unroll
      for (int r = 0; r < 16; ++r) s2[st][r] = 0.f;
#pragma unroll
    for (int ks = 0; ks < 12; ++ks)
#pragma unroll
      for (int st = 0; st < 2; ++st) {
        const bf16x8 kf = *(const bf16x8*)(Ks + ko[ks & 3] + st * 12288 + (ks >> 2) * 128);
        s2[st] = __builtin_amdgcn_mfma_f32_32x32x16_bf16(kf, qf[ks], s2[st], 0, 0, 0);
      }
    __builtin_amdgcn_s_setprio(0);
    {
      float pmax = s2[0][0];
#pragma unroll
      for (int r = 1; r < 16; ++r) pmax = fmaxf(pmax, s2[0][r]);
#pragma unroll
      for (int r = 0; r < 16; ++r) pmax = fmaxf(pmax, s2[1][r]);
      { auto rr = __builtin_amdgcn_permlane32_swap(__float_as_uint(pmax), __float_as_uint(pmax), false, false);
        pmax = fmaxf(__uint_as_float(rr[0]), __uint_as_float(rr[1])); }
      if (!__all(pmax - mrun <= 11.541560327f)) {
        const float mn = fmaxf(mrun, pmax);
        const float alpha = __builtin_amdgcn_exp2f(mrun - mn);
        mrun = mn;
        lrun *= alpha;
#pragma unroll
        for (int a = 0; a < 4; ++a)
#pragma unroll
          for (int r = 0; r < 16; ++r) oacc[a][r] *= alpha;
      }
      float psum = 0.f;
#pragma unroll
      for (int st = 0; st < 2; ++st)
#pragma unroll
        for (int r = 0; r < 16; ++r) { const float pv = __builtin_amdgcn_exp2f(s2[st][r] - mrun); s2[st][r] = pv; psum += pv; }
      lrun += psum;
    }
    __builtin_amdgcn_s_setprio(1);
#pragma unroll
    for (int st = 0; st < 2; ++st)
#pragma unroll
      for (int sb = 0; sb < 2; ++sb) {
        union { bf16x8 v; unsigned w[4]; } pb;
#pragma unroll
        for (int w = 0; w < 4; ++w) pb.w[w] = pack2(s2[st][8 * sb + 2 * w], s2[st][8 * sb + 2 * w + 1]);
#pragma unroll
        for (int dt = 0; dt < 4; ++dt) {
          const bf16x8 vf = *(const bf16x8*)(Vs + vob[2 * st + sb] + dt * 4096);
          oacc[dt] = __builtin_amdgcn_mfma_f32_32x32x16_bf16(vf, pb.v, oacc[dt], 0, 0, 0);
        }
      }
    __builtin_amdgcn_s_setprio(0);
    asm volatile("s_waitcnt vmcnt(0)" ::: "memory");
    __syncthreads();
  }
#undef ATT_STAGE
  float ltot;
  { auto rr = __builtin_amdgcn_permlane32_swap(__float_as_uint(lrun), __float_as_uint(lrun), false, false); ltot = __uint_as_float(rr[0]) + __uint_as_float(rr[1]); }
  const float inv = 1.f / ltot;
#pragma unroll
  for (int dt = 0; dt < 4; ++dt)
#pragma unroll
    for (int g = 0; g < 4; ++g) {
      const int d = dt * 32 + 8 * g + 4 * hh;
      *(uint2*)(O + (size_t)tq * 1024 + h * 128 + d) =
          pack4(oacc[dt][4 * g] * inv, oacc[dt][4 * g + 1] * inv, oacc[dt][4 * g + 2] * inv, oacc[dt][4 * g + 3] * inv);
    }
}
DI void phase_attention(const PV& p, int j, char* smem) {
  const bool xmap = gridDim.x == 256;
  const int Gq = opaque_i((int)gridDim.x);
  const int nit = xmap ? 5 : (1280 + Gq - 1) / Gq;
#pragma unroll 1
  for (int r = 0; r < nit; ++r) {
    int kind, seq, h, q0;
    if (xmap) {
      if (r < 4) {
        const int xcd = blockIdx.x & 7, slot = blockIdx.x >> 3;
        const int pair = xcd + 8 * (2 * r + (slot >> 4)), qb = slot & 15;
        kind = 1; seq = pair >> 3; h = pair & 7; q0 = TP + seq * 4096 + qb * 256;
      } else {
        kind = 0; seq = blockIdx.x >> 3; h = blockIdx.x & 7; q0 = seq * 256;
      }
    } else {
      const int it = blockIdx.x + r * gridDim.x;
      if (it >= 1280) break;
      if (it < 1024) { const int pair = it >> 4, qb = it & 15; kind = 1; seq = pair >> 3; h = pair & 7; q0 = TP + seq * 4096 + qb * 256; }
      else { const int i2 = it - 1024; kind = 0; seq = i2 >> 3; h = i2 & 7; q0 = seq * 256; }
    }
    attn_item(p, j, kind, seq, h, q0, smem);
  }
  __syncthreads();
}

DI size_t act_blk(int t, int a) { return (size_t)(t >> 8) * (256 * 2816) + (size_t)(a >> 6) * (256 * 64) + (size_t)((t & 255) * 64 + (a & 63)); }
DI float dpp_ror1(float x) { return __int_as_float(__builtin_amdgcn_update_dpp(0, __float_as_int(x), 0x121, 0xf, 0xf, false)); }
DI float dpp_ror15(float x) { return __int_as_float(__builtin_amdgcn_update_dpp(0, __float_as_int(x), 0x12F, 0xf, 0xf, false)); }
struct EpiFFN {
  u16* ACT; u16* EDGE; const float* cw; const float* cb;
  DI void operator()(const f32x4 (&acc)[2][2][4][2], int pm, int pn, int wr, int wc, int fr, int fq) const {
#pragma unroll
    for (int n = 0; n < 2; ++n) {
      const int a = pn * 128 + wc * 32 + n * 16 + fq * 4;
      const float4 w0g = *(const float4*)(cw + a), w1g = *(const float4*)(cw + 5632 + a), w2g = *(const float4*)(cw + 11264 + a), bg = *(const float4*)(cb + a);
      const float4 w0u = *(const float4*)(cw + 2816 + a), w1u = *(const float4*)(cw + 5632 + 2816 + a), w2u = *(const float4*)(cw + 11264 + 2816 + a), bu = *(const float4*)(cb + 2816 + a);
#pragma unroll
      for (int ai = 0; ai < 2; ++ai) {
        const int rbase = pm * 256 + ai * 128 + wr * 64;
        const size_t erow = (size_t)(rbase >> 6) * 4;
#pragma unroll
        for (int m = 0; m < 4; ++m) {
          const int mp = m > 0 ? m - 1 : 0, mn = m < 3 ? m + 1 : 3;
          float o[4];
#define FFN_ONE(J, C)                                                                                         \
          {                                                                                                   \
            const float g = acc[ai][0][m][n][J], u = acc[ai][1][m][n][J];                                     \
            const float gpv = m > 0 ? acc[ai][0][mp][n][J] : 0.f, gnx = m < 3 ? acc[ai][0][mn][n][J] : 0.f;   \
            const float upv = m > 0 ? acc[ai][1][mp][n][J] : 0.f, unx = m < 3 ? acc[ai][1][mn][n][J] : 0.f;   \
            const float gp = dpp_ror1(fr == 15 ? gpv : g), gn = dpp_ror15(fr == 0 ? gnx : g);                \
            const float up = dpp_ror1(fr == 15 ? upv : u), un = dpp_ror15(fr == 0 ? unx : u);                \
            const float cg = w0g.C * gp + w1g.C * g + w2g.C * gn + bg.C;                                      \
            const float cu = w0u.C * up + w1u.C * u + w2u.C * un + bu.C;                                      \
            o[J] = silu(cg) * cu;                                                                             \
          }
          FFN_ONE(0, x) FFN_ONE(1, y) FFN_ONE(2, z) FFN_ONE(3, w)
#undef FFN_ONE
          *(uint2*)(ACT + act_blk(rbase + m * 16 + fr, a)) = pack4(o[0], o[1], o[2], o[3]);
          if ((m == 0 && fr < 2) || (m == 3 && fr >= 14)) {
            const int ri = m == 0 ? fr : fr - 12;
            u16* e = EDGE + (erow + ri) * 5632 + pn * 256 + wc * 32 + n * 16 + fq * 4;
            *(uint2*)e = pack4(acc[ai][0][m][n][0], acc[ai][0][m][n][1], acc[ai][0][m][n][2], acc[ai][0][m][n][3]);
            *(uint2*)(e + 128) = pack4(acc[ai][1][m][n][0], acc[ai][1][m][n][1], acc[ai][1][m][n][2], acc[ai][1][m][n][3]);
          }
        }
      }
    }
  }
};
DI void phase_ffn_up(const PV& p, int l, char* smem) {
  EpiFFN E;
  E.ACT = (u16*)(p.ws() + OFF_B + B_ACT); E.EDGE = (u16*)(p.ws() + OFF_EDGE);
  E.cw = p.in(33) + (size_t)l * 3 * 5632; E.cb = p.in(34) + (size_t)l * 5632;
  TileSched<160, 22, 16, 8, 4, 16, 2> S; S.init();
  gemm8(smem, (const u16*)(p.ws() + OFF_A + A_H), (const u16*)(p.ws() + OFF_WUP), 1024, S, E);
}
DI void phase_ffn_fix(const PV& p, int l) {
  const u16* EDGE = (const u16*)(p.ws() + OFF_EDGE);
  u16* ACT = (u16*)(p.ws() + OFF_B + B_ACT);
  const float* cw = p.in(33) + (size_t)l * 3 * 5632;
  const float* cb = p.in(34) + (size_t)l * 5632;
  const unsigned gtid = blockIdx.x * blockDim.x + (unsigned)TIDX(), gsz = gridDim.x * blockDim.x;
  for (unsigned idx = gtid; idx < 640u * 2u * 704u; idx += gsz) {
    const unsigned rq = idx / 704u;
    const int a = (int)(idx - rq * 704u) * 4, rr = (int)rq, which = rr & 1, sidx = rr >> 1;
    const int t = sidx * 64 + (which ? 63 : 0);
    const int tb = which ? t + 1 : t;
    const bool seqb = tb < TP ? (tb & 255) == 0 : ((tb - TP) & 4095) == 0;
    if (seqb) continue;
    const int pc = (a >> 7) * 256 + (a & 127);
    const u16 *pr, *cu, *nx;
    if (which == 0) { pr = EDGE + ((size_t)(sidx - 1) * 4 + 3) * 5632; cu = EDGE + ((size_t)sidx * 4 + 0) * 5632; nx = EDGE + ((size_t)sidx * 4 + 1) * 5632; }
    else { pr = EDGE + ((size_t)sidx * 4 + 2) * 5632; cu = EDGE + ((size_t)sidx * 4 + 3) * 5632; nx = EDGE + ((size_t)(sidx + 1) * 4 + 0) * 5632; }
    const uint2 gp = *(const uint2*)(pr + pc), gc = *(const uint2*)(cu + pc), gn = *(const uint2*)(nx + pc);
    const uint2 up = *(const uint2*)(pr + pc + 128), uc = *(const uint2*)(cu + pc + 128), un = *(const uint2*)(nx + pc + 128);
    const float4 w0g = *(const float4*)(cw + a), w1g = *(const float4*)(cw + 5632 + a), w2g = *(const float4*)(cw + 11264 + a), bg = *(const float4*)(cb + a);
    const float4 w0u = *(const float4*)(cw + 2816 + a), w1u = *(const float4*)(cw + 5632 + 2816 + a), w2u = *(const float4*)(cw + 11264 + 2816 + a), bu = *(const float4*)(cb + 2816 + a);
    const float g0 = w0g.x * lo16(gp.x) + w1g.x * lo16(gc.x) + w2g.x * lo16(gn.x) + bg.x, u0 = w0u.x * lo16(up.x) + w1u.x * lo16(uc.x) + w2u.x * lo16(un.x) + bu.x;
    const float g1 = w0g.y * hi16(gp.x) + w1g.y * hi16(gc.x) + w2g.y * hi16(gn.x) + bg.y, u1 = w0u.y * hi16(up.x) + w1u.y * hi16(uc.x) + w2u.y * hi16(un.x) + bu.y;
    const float g2 = w0g.z * lo16(gp.y) + w1g.z * lo16(gc.y) + w2g.z * lo16(gn.y) + bg.z, u2 = w0u.z * lo16(up.y) + w1u.z * lo16(uc.y) + w2u.z * lo16(un.y) + bu.z;
    const float g3 = w0g.w * hi16(gp.y) + w1g.w * hi16(gc.y) + w2g.w * hi16(gn.y) + bg.w, u3 = w0u.w * hi16(up.y) + w1u.w * hi16(uc.y) + w2u.w * hi16(un.y) + bu.w;
    *(uint2*)(ACT + act_blk(t, a)) = pack4(silu(g0) * u0, silu(g1) * u1, silu(g2) * u2, silu(g3) * u3);
  }
}

#ifndef PH
#define RUN(k, ...) __VA_ARGS__
#else
#define RUN(k, ...) if (PH == k) { __VA_ARGS__ }
#endif
extern "C" __global__ void __launch_bounds__(512) fwd_megakernel(Params kp) {
  extern __shared__ __attribute__((aligned(16))) char smem[];
  cg::grid_group grid = cg::this_grid();
  if (TIDX() == 0) {
    unsigned long long* t = (unsigned long long*)(smem + PARM_OFF);
#pragma unroll
    for (int k = 0; k < 36; ++k) t[k] = (unsigned long long)kp.in[k];
    t[36] = (unsigned long long)kp.out; t[37] = (unsigned long long)kp.ws;
  }
  __syncthreads();
  PV p; p.smem = smem;
  unsigned* bar = (unsigned*)(p.ws() + OFF_BAR);
  if (TIDX() == 0) { *(unsigned*)(smem + PARM_OFF + 512) = 0u; *(unsigned*)(smem + PARM_OFF + 516) = 0u; }
  __syncthreads();
  const XcdBarrier xb = xcd_barrier_post(bar, (volatile LASB unsigned*)(smem + PARM_OFF + 512));
  RUN(0, phase_prep(p, smem);)
  grid.sync();
  RUN(1, phase_filters(p, smem);)
  for (int l = 0; l < 4; ++l) {
    const int i = l >> 1;
    RUN(2, phase_norm(p, l, 0, l);)
    RUN(0, if (l > 0) { int base = 0; convert_ffn_weights(p, l, smem, base); })
    xcd_barrier(xb);
    if ((l & 1) == 0) {
      RUN(3, phase_mix_in(p, i, smem);)
      xcd_barrier(xb);
      RUN(4, phase_sgu(p, i, smem);)
      RUN(5, phase_conv(p, i, 0, smem);)
      xcd_barrier(xb);
      RUN(5, phase_conv(p, i, 1, smem);)
      xcd_barrier(xb);
      RUN(6, phase_ztrans(p, smem);)
      xcd_barrier(xb);
      RUN(7, phase_resid_gemm(p, l, l, (const u16*)(p.ws() + OFF_B + B_MIX), 1024, (const u16*)(p.ws() + OFF_WMIXOUT) + (size_t)i * 1024 * 1024, 2048, smem);)
      xcd_barrier(xb);
    } else {
      RUN(8, phase_dqkv(p, i, smem);)
      xcd_barrier(xb);
      RUN(9, phase_mla_norms(p, i);)
      xcd_barrier(xb);
      RUN(10, phase_uq_ukv(p, i, smem);)
      xcd_barrier(xb);
      RUN(11, phase_finalize(p, i);)
      xcd_barrier(xb);
      RUN(12, phase_attention(p, i, smem);)
      xcd_barrier(xb);
      RUN(7, phase_resid_gemm(p, l, l, (const u16*)(p.ws() + OFF_A + A_O), 1024, (const u16*)(p.ws() + OFF_WO) + (size_t)i * 1024 * 1024, 2048, smem);)
      xcd_barrier(xb);
    }
    RUN(2, phase_norm(p, l, 1, 1);)
    xcd_barrier(xb);
    RUN(13, phase_ffn_up(p, l, smem);)
    xcd_barrier(xb);
    RUN(14, phase_ffn_fix(p, l);)
    xcd_barrier(xb);
    RUN(7, phase_resid_gemm(p, l, 1, (const u16*)(p.ws() + OFF_B + B_ACT), 2816, (const u16*)(p.ws() + OFF_WDOWN), 5120, smem);)
    xcd_barrier(xb);
  }
}

extern "C" void kernel_launch(void* const* d_in, const int* in_sizes, int n_in,
                              void* d_out, int out_size, void* d_ws, size_t ws_size,
                              hipStream_t stream) {
  static int grid_blocks = 0;
  if (!grid_blocks) {
    int dev = 0, cus = 0, per_cu = 0;
    (void)hipGetDevice(&dev);
    (void)hipDeviceGetAttribute(&cus, hipDeviceAttributeMultiprocessorCount, dev);
    (void)hipFuncSetAttribute((const void*)fwd_megakernel, hipFuncAttributeMaxDynamicSharedMemorySize, (int)LDS_BYTES);
    (void)hipOccupancyMaxActiveBlocksPerMultiprocessor(&per_cu, fwd_megakernel, 512, LDS_BYTES);
    if (per_cu < 1) per_cu = 1;
    if (per_cu > 1) per_cu = 1;
    grid_blocks = cus * per_cu;
  }
  if (ws_size < WS_NEED) fprintf(stderr, "workspace too small: %zu < %zu\n", ws_size, (size_t)WS_NEED);
  Params p{};
  for (int i = 0; i < 36; ++i) p.in[i] = (const float*)d_in[i];
  p.out = (float*)d_out;
  p.ws = (char*)d_ws;
  (void)hipMemsetAsync((char*)d_ws + OFF_BAR, 0, 16384, stream);
  void* args[] = {&p};
  hipError_t e = hipLaunchCooperativeKernel((void*)fwd_megakernel, dim3(grid_blocks), dim3(512), args, LDS_BYTES, stream);
  if (e != hipSuccess) fprintf(stderr, "cooperative launch failed: %s (grid %d)\n", hipGetErrorString(e), grid_blocks);
}
```

```cpp
#include <hip/hip_runtime.h>
#include <hip/hip_cooperative_groups.h>
#include <cstdio>
namespace cg = cooperative_groups;

typedef unsigned short u16;
using bf16x8 = __attribute__((ext_vector_type(8))) short;
using f32x4 = __attribute__((ext_vector_type(4))) float;
using f32x16 = __attribute__((ext_vector_type(16))) float;
#define DI __device__ __forceinline__

constexpr int T = 40960;
constexpr int TP = 8192;
constexpr int TK = 43008;
constexpr float EPS = 1e-6f;
constexpr size_t LDS_BYTES = 139264;

constexpr size_t OFF_WMIXIN = 0;
constexpr size_t OFF_WMIXOUT = OFF_WMIXIN + (size_t)2 * 2560 * 1024 * 2;
constexpr size_t OFF_WDQKV = OFF_WMIXOUT + (size_t)2 * 1024 * 1024 * 2;
constexpr size_t OFF_WUQ = OFF_WDQKV + (size_t)2 * 1024 * 1024 * 2;
constexpr size_t OFF_WUKV = OFF_WUQ + (size_t)2 * 1536 * 512 * 2;
constexpr size_t OFF_WO = OFF_WUKV + (size_t)2 * 2048 * 256 * 2;
constexpr size_t OFF_WSGU = OFF_WO + (size_t)2 * 1024 * 1024 * 2;
constexpr size_t OFF_WUP = OFF_WSGU + (size_t)2 * 4 * 128 * 128 * 2;
constexpr size_t OFF_WDOWN = OFF_WUP + (size_t)5632 * 1024 * 2;
constexpr size_t OFF_MOD = OFF_WDOWN + (size_t)1024 * 2816 * 2;
constexpr size_t OFF_FILT = OFF_MOD + (size_t)4 * 9 * 6144 * 4;
constexpr size_t OFF_H2 = OFF_FILT + (size_t)2 * 2 * 512 * 4352 * 2;
constexpr size_t OFF_EDGE = OFF_H2 + (size_t)2 * 4352 * 64 * 4;
constexpr size_t OFF_KR = OFF_EDGE + (size_t)640 * 4 * 5632 * 2;
constexpr size_t OFF_A = OFF_KR + (size_t)TK * 64 * 2;
constexpr size_t OFF_B = OFF_A + (size_t)T * 1024 * 2;
constexpr size_t OFF_BAR = OFF_B + (size_t)346030080;
constexpr size_t OFF_ROPE = OFF_BAR + 16384;
constexpr size_t WS_NEED = OFF_ROPE + 64 * 16 * 8;
constexpr size_t A_H = 0, A_Z1 = 0, A_Z2 = (size_t)T * 512 * 2, A_QN = 0, A_CKV = (size_t)T * 512 * 2, A_O = 0;
constexpr size_t B_VT = 0, B_PRT = (size_t)T * 512 * 2, B_MIX = B_PRT + (size_t)T * 1536 * 2;
constexpr size_t B_DQKV = 0, B_Q = 0, B_K = (size_t)T * 1536 * 2, B_V = B_K + (size_t)TK * 1536 * 2;
constexpr size_t B_ACT = 0;
constexpr size_t VT_SAMPLE_OFF = (size_t)32 * 8 * 128 * 256;

struct Params {
  const float* in[36];
  float* out;
  char* ws;
};


constexpr int PARM_OFF = 138240;
struct PV {
  char* smem;
  DI unsigned long long ld(int k) const {
    int off = PARM_OFF + 8 * k;
    asm volatile("" : "+v"(off));
    const unsigned long long v = *(const unsigned long long*)(smem + off);
    const unsigned lo = __builtin_amdgcn_readfirstlane((unsigned)v), hi = __builtin_amdgcn_readfirstlane((unsigned)(v >> 32));
    return ((unsigned long long)hi << 32) | lo;
  }
  DI const float* in(int k) const { return (const float*)(const __attribute__((address_space(1))) float*)ld(k); }
  DI float* out() const { return (float*)(__attribute__((address_space(1))) float*)ld(36); }
  DI char* ws() const { return (char*)(__attribute__((address_space(1))) char*)ld(37); }
};

DI int TIDX() { int t = (int)__builtin_amdgcn_workitem_id_x(); asm volatile("" : "+v"(t)); return t; }
DI u16 f2bf(float x) { unsigned u = __float_as_uint(x); u += 0x7fffu + ((u >> 16) & 1u); return (u16)(u >> 16); }
DI float bf2f(u16 h) { return __uint_as_float(((unsigned)h) << 16); }
DI unsigned pack2(float a, float b) { unsigned r; asm("v_cvt_pk_bf16_f32 %0, %1, %2" : "=v"(r) : "v"(a), "v"(b)); return r; }
DI uint2 pack4(float a, float b, float c, float d) { uint2 r; r.x = pack2(a, b); r.y = pack2(c, d); return r; }
DI float lo16(unsigned w) { return __uint_as_float(w << 16); }
DI float hi16(unsigned w) { return __uint_as_float(w & 0xffff0000u); }
DI float gelu_tanh(float x) { const float y = x * (1.f + 0.044715f * x * x); return x * __builtin_amdgcn_rcpf(1.f + __builtin_amdgcn_exp2f(-2.302208198f * y)); }
DI float silu(float x) { return x * __builtin_amdgcn_rcpf(1.f + __builtin_amdgcn_exp2f(-1.4426950409f * x)); }
DI int condrow(int m) { return m < TP ? 0 : 1 + ((m - TP) >> 12); }
template <int MASK> DI float shx(float v, int lane) {
  if (MASK == 32) return __int_as_float(__builtin_amdgcn_ds_bpermute((lane ^ 32) << 2, __float_as_int(v)));
  return __int_as_float(__builtin_amdgcn_ds_swizzle(__float_as_int(v), (MASK << 10) | 0x1f));
}
DI float wave_sum(float v, int lane) {
  v += shx<32>(v, lane); v += shx<16>(v, lane); v += shx<8>(v, lane);
  v += shx<4>(v, lane); v += shx<2>(v, lane); v += shx<1>(v, lane); return v;
}
DI int opaque_i(int x) { asm volatile("" : "+s"(x)); return x; }
DI int first_unit(int base) { const int G = opaque_i((int)gridDim.x); int r = (int)blockIdx.x - (base % G); if (r < 0) r += G; return r; }
DI const float* xin_row(const PV& p, int l, int m) {
  if (l == 0) return m < TP ? p.in(0) + (size_t)m * 1024 : p.in(1) + (size_t)(m - TP) * 1024;
  return p.out() + (size_t)m * 1024;
}


#define XB_TMO      128
#define XB_XCNT(j)  (256  + 64 * (j))
#define XB_XSUB(j)  (1280 + 64 * (j))
#define XB_XGEN(j)  (2304 + 64 * (j))
#define XB_TOP      3328
#define XB_TOPGEN   3392
#define XB_SPIN_CAP (1u << 22)
#define LASB __attribute__((address_space(3)))
DI unsigned xb_ld(unsigned* p) { return __hip_atomic_load(p, __ATOMIC_RELAXED, __HIP_MEMORY_SCOPE_AGENT); }
DI unsigned xb_add(unsigned* p, unsigned v) { return __hip_atomic_fetch_add(p, v, __ATOMIC_RELAXED, __HIP_MEMORY_SCOPE_AGENT); }
DI unsigned xb_xcc_id() { return (unsigned)__builtin_amdgcn_s_getreg((3 << 11) | 20) & 0xFu; }
#define XB_SPIN(cond, bar) do { unsigned _sp = 0; while (cond) { __builtin_amdgcn_s_sleep(1); \
    if ((++_sp & 255u) == 0u) { if (xb_ld(&(bar)[XB_TMO])) break; if (_sp > XB_SPIN_CAP) { atomicAdd(&(bar)[XB_TMO], 1u); break; } } } } while (0)
struct XcdBarrier { unsigned* bar; unsigned x; volatile LASB unsigned* st; };
DI XcdBarrier xcd_barrier_post(unsigned* bar, volatile LASB unsigned* st) {
  XcdBarrier b; b.bar = bar; b.x = xb_xcc_id(); b.st = st;
  if (TIDX() == 0) (void)xb_add(&bar[XB_XCNT(b.x)], 1u);
  return b;
}
DI void xcd_barrier_complete(unsigned* bar, unsigned x, unsigned& nloc, unsigned& nx) {
  const unsigned G = gridDim.x;
  unsigned sum, cnt, mine, sp = 0u;
  for (;;) {
    sum = 0u; cnt = 0u; mine = 0u;
#pragma unroll
    for (unsigned j = 0; j < 16; ++j) { const unsigned c = xb_ld(&bar[XB_XCNT(j)]); sum += c; cnt += (c > 0u) ? 1u : 0u; mine = (j == x) ? c : mine; }
    if (sum == G) break;
    __builtin_amdgcn_s_sleep(1);
    if ((++sp & 255u) == 0u) { if (xb_ld(&bar[XB_TMO])) break; if (sp > XB_SPIN_CAP) { atomicAdd(&bar[XB_TMO], 1u); break; } }
  }
  nloc = mine > 0u ? mine : 1u; nx = cnt > 0u ? cnt : 1u;
}
DI void xcd_barrier(const XcdBarrier& b) {
  asm volatile("s_waitcnt vmcnt(0)" ::: "memory");
  __syncthreads();
  if (TIDX() == 0) {
    unsigned* bar = b.bar;
    __builtin_amdgcn_s_waitcnt(0);
    unsigned nloc = b.st[0], nx = b.st[1];
    if (nloc == 0u) { xcd_barrier_complete(bar, b.x, nloc, nx); b.st[0] = nloc; b.st[1] = nx; }
    const unsigned old = xb_add(&bar[XB_XSUB(b.x)], 1u);
    const unsigned gen = old / nloc;
    if (old + 1u == (gen + 1u) * nloc) {
      __builtin_amdgcn_fence(__ATOMIC_RELEASE, "agent");
      asm volatile("s_waitcnt vmcnt(0)" ::: "memory");
      const unsigned og = xb_add(&bar[XB_TOP], 1u);
      const unsigned tg = og / nx;
      if (og + 1u == (tg + 1u) * nx) xb_add(&bar[XB_TOPGEN], 1u);
      else XB_SPIN(xb_ld(&bar[XB_TOPGEN]) == tg, bar);
      __builtin_amdgcn_fence(__ATOMIC_ACQUIRE, "agent");
      xb_add(&bar[XB_XGEN(b.x)], 1u);
      asm volatile("s_waitcnt vmcnt(0)" ::: "memory");
    } else {
      XB_SPIN(xb_ld(&bar[XB_XGEN(b.x)]) == gen, bar);
      __builtin_amdgcn_fence(__ATOMIC_ACQUIRE, "agent");
      asm volatile("s_waitcnt vmcnt(0)" ::: "memory");
    }
  }
  __syncthreads();
}

template <int MODE>
DI int rowmap(int n, int row0) {
  if (MODE == 0) return n + row0;
  return n < 2816 ? (n >> 7) * 256 + (n & 127) : ((n - 2816) >> 7) * 256 + 128 + ((n - 2816) & 127);
}
template <int MODE, int NJ = 4>
DI void convT(const float* __restrict__ src, u16* __restrict__ dst, int K, int N, int row0, char* smem, int& base) {
  u16* tl = (u16*)smem;
  const int tid = TIDX();
  const int nN = N / (64 * NJ), nunits = (K >> 6) * nN;
  for (int u = first_unit(base); u < nunits; u += gridDim.x) {
    const int k0 = (u / nN) << 6, n0 = (u % nN) * (64 * NJ);
    float4 v[2][NJ];
#pragma unroll
    for (int i = 0; i < 2; ++i)
#pragma unroll
      for (int j = 0; j < NJ; ++j)
        v[i][j] = *(const float4*)(src + (size_t)(k0 + (tid >> 4) + 32 * i) * N + n0 + (tid & 15) * 4 + 64 * j);
#pragma unroll
    for (int i = 0; i < 2; ++i)
#pragma unroll
      for (int j = 0; j < NJ; ++j) {
        const int r = (tid >> 4) + 32 * i, c4 = (tid & 15) * 4 + 64 * j;
        tl[(c4 + 0) * 72 + r] = f2bf(v[i][j].x); tl[(c4 + 1) * 72 + r] = f2bf(v[i][j].y);
        tl[(c4 + 2) * 72 + r] = f2bf(v[i][j].z); tl[(c4 + 3) * 72 + r] = f2bf(v[i][j].w);
      }
    __syncthreads();
#pragma unroll
    for (int j = 0; j < NJ; ++j) {
      const int n = (tid >> 3) + 64 * j, kc = (tid & 7) * 8;
      const uint4 o = *(const uint4*)(tl + n * 72 + kc);
      { const int rr = rowmap<MODE>(n0 + n, row0);
        *(uint4*)(dst + (size_t)(rr >> 8) * 256 * K + (size_t)(k0 >> 6) * (256 * 64) + (rr & 255) * 64 + kc) = o; }
    }
    __syncthreads();
  }
  base += nunits;
}

DI void convert_ffn_weights(const PV& p, int l, char* smem, int& base) {
  convT<1>(p.in(32) + (size_t)l * 1024 * 5632, (u16*)(p.ws() + OFF_WUP), 1024, 5632, 0, smem, base);
  convT<0>(p.in(35) + (size_t)l * 2816 * 1024, (u16*)(p.ws() + OFF_WDOWN), 2816, 1024, 0, smem, base);
}

DI void phase_prep(const PV& p, char* smem) {
  const int tid = TIDX();
  int base = 0;
  char* ws = p.ws();
  for (int i = 0; i < 2; ++i) {
    convT<0>(p.in(9) + (size_t)i * 1024 * 2560, (u16*)(ws + OFF_WMIXIN) + (size_t)i * 2560 * 1024, 1024, 2560, 0, smem, base);
    convT<0>(p.in(22) + (size_t)i * 1024 * 1024, (u16*)(ws + OFF_WMIXOUT) + (size_t)i * 1024 * 1024, 1024, 1024, 0, smem, base);
    convT<0>(p.in(23) + (size_t)i * 1024 * 512, (u16*)(ws + OFF_WDQKV) + (size_t)i * 1024 * 1024, 1024, 512, 0, smem, base);
    convT<0, 1>(p.in(26) + (size_t)i * 1024 * 320, (u16*)(ws + OFF_WDQKV) + (size_t)i * 1024 * 1024, 1024, 320, 512, smem, base);
    convT<0>(p.in(25) + (size_t)i * 512 * 1536, (u16*)(ws + OFF_WUQ) + (size_t)i * 1536 * 512, 512, 1536, 0, smem, base);
    convT<0>(p.in(28) + (size_t)i * 256 * 2048, (u16*)(ws + OFF_WUKV) + (size_t)i * 2048 * 256, 256, 2048, 0, smem, base);
    convT<0>(p.in(31) + (size_t)i * 1024 * 1024, (u16*)(ws + OFF_WO) + (size_t)i * 1024 * 1024, 1024, 1024, 0, smem, base);
  }
  convert_ffn_weights(p, 0, smem, base);
  {
    const long gtid = (long)blockIdx.x * blockDim.x + tid, gsz = (long)gridDim.x * blockDim.x;
    for (long i = gtid; i < 2 * 192 * 1024; i += gsz) {
      const int j = (int)(i / (192 * 1024)), rem = (int)(i % (192 * 1024)), rr = 832 + (rem >> 10), k = rem & 1023;
      ((u16*)(ws + OFF_WDQKV))[(size_t)j * 1024 * 1024 + (size_t)(rr >> 8) * 256 * 1024 + (size_t)(k >> 6) * (256 * 64) + (rr & 255) * 64 + (k & 63)] = 0;
    }
    for (long i = gtid; i < 2 * 4 * 128 * 128; i += gsz) ((u16*)(ws + OFF_WSGU))[i] = f2bf(p.in(10)[i]);
    for (long i = gtid; i < 64 * 16; i += gsz) {
      const int pos = (int)(i >> 4), f = (int)(i & 15);
      const float inv = exp2f(-(float)f * (13.287712379549449f / 16.f));
      float sn, cs;
      sincosf((float)pos * inv, &sn, &cs);
      ((float2*)(ws + OFF_ROPE))[i] = make_float2(cs, sn);
    }
  }
  {
    float* sc = (float*)smem;
    float* part = sc + 9 * 1024;
    __syncthreads();
    for (int i = tid; i < 9 * 1024; i += 512) {
      const int r = i >> 10, k = i & 1023;
      const float c = r == 0 ? p.in(5)[k] : p.in(4)[(r - 1) * 1024 + k];
      sc[i] = silu(c);
    }
    __syncthreads();
    float* MOD = (float*)(ws + OFF_MOD);
    const int nunits = 4 * 96;
    for (int u = first_unit(base); u < nunits; u += gridDim.x) {
      const int l = u / 96, n0 = (u % 96) * 64;
      const int col = n0 + (tid & 63), kg = tid >> 6;
      float acc[9];
#pragma unroll
      for (int r = 0; r < 9; ++r) acc[r] = 0.f;
      const float* w = p.in(6) + (size_t)l * 1024 * 6144 + col;
#pragma unroll 16
      for (int k = kg * 128; k < kg * 128 + 128; ++k) {
        const float wv = w[(size_t)k * 6144];
#pragma unroll
        for (int r = 0; r < 9; ++r) acc[r] += sc[r * 1024 + k] * wv;
      }
#pragma unroll
      for (int r = 0; r < 9; ++r) part[(kg * 9 + r) * 64 + (tid & 63)] = acc[r];
      __syncthreads();
      for (int i = tid; i < 576; i += 512) {
        const int r = i >> 6, cc = i & 63;
        float s = p.in(7)[l * 6144 + n0 + cc];
#pragma unroll
        for (int g = 0; g < 8; ++g) s += part[(g * 9 + r) * 64 + cc];
        MOD[(size_t)(l * 9 + r) * 6144 + n0 + cc] = s;
      }
      __syncthreads();
    }
    base += nunits;
  }
  {
    float* zf = (float*)smem;
    float* h1 = zf + 8 * 36;
    float* H2 = (float*)(ws + OFF_H2);
    const int nunits = 2 * 544;
    for (int u = first_unit(base); u < nunits; u += gridDim.x) {
      const int i = u / 544, tg0 = (u % 544) * 8;
      __syncthreads();
      if (tid < 8 * 33) {
        const int tt = tid / 33, e = tid % 33;
        const int tg = tg0 + tt;
        const float L = tg < 256 ? 256.f : 4096.f;
        const float t = tg < 256 ? (float)tg : (float)(tg - 256);
        const float tn = t / L;
        float v;
        if (e == 0) v = tn;
        else if (e <= 16) v = sinf((6.283185307179586f * tn) * (float)e);
        else v = cosf((6.283185307179586f * tn) * (float)(e - 16));
        zf[tt * 36 + e] = v;
      }
      __syncthreads();
      const int tt = tid >> 6, jj = tid & 63;
      const float fr = p.in(19)[i * 64 + jj];
      {
        float a = p.in(15)[i * 64 + jj];
        const float* w1 = p.in(14) + (size_t)i * 33 * 64 + jj;
        for (int e = 0; e < 33; ++e) a += zf[tt * 36 + e] * w1[e * 64];
        h1[tt * 64 + jj] = sinf(fr * a);
      }
      __syncthreads();
      {
        float a = p.in(17)[i * 64 + jj];
        const float* w2 = p.in(16) + (size_t)i * 64 * 64 + jj;
        for (int e = 0; e < 64; ++e) a += h1[tt * 64 + e] * w2[e * 64];
        H2[((size_t)i * 4352 + tg0 + tt) * 64 + jj] = sinf(fr * a);
      }
    }
    base += nunits;
    __syncthreads();
  }
}

DI void phase_filters(const PV& p, char* smem) {
  const int tid = TIDX();
  float* w3s = (float*)smem;
  float* red = w3s + 512;
  float* nrm = red + 512;
  float* hbuf = nrm + 8;
  const float* H2 = (const float*)(p.ws() + OFF_H2);
  u16* FILT = (u16*)(p.ws() + OFF_FILT);
  for (int u = blockIdx.x; u < 512; u += gridDim.x) {
    const int kind = (u >> 7) & 1, i = u >> 8, cg8 = (u & 127) * 8;
    const int L = kind ? 4096 : 256, tbase = kind ? 256 : 0;
    __syncthreads();
    { const int j = tid >> 3, cc = tid & 7; w3s[j * 8 + cc] = p.in(18)[((size_t)i * 64 + j) * 1024 + cg8 + cc]; }
    __syncthreads();
    const int cc = tid & 7, tq = tid >> 3;
    const int col = cg8 + cc, o = col >> 9, c = col & 511;
    const float dec = fabsf(p.in(20)[(i * 2 + o) * 512 + c]);
    float asum = 0.f;
    for (int t = tq; t < L; t += 64) {
      const float4* hr = (const float4*)(H2 + ((size_t)i * 4352 + tbase + t) * 64);
      float a = 0.f;
#pragma unroll
      for (int j4 = 0; j4 < 16; ++j4) {
        const float4 hv = hr[j4];
        a += hv.x * w3s[(j4 * 4 + 0) * 8 + cc]; a += hv.y * w3s[(j4 * 4 + 1) * 8 + cc];
        a += hv.z * w3s[(j4 * 4 + 2) * 8 + cc]; a += hv.w * w3s[(j4 * 4 + 3) * 8 + cc];
      }
      const float dist = fabsf((float)(t - L / 2)) / (float)L;
      a *= expf(-dec * dist);
      hbuf[cc * L + t] = a;
      asum += fabsf(a);
    }
    red[tid] = asum;
    __syncthreads();
    if (tid < 8) { float s = 0.f; for (int q = 0; q < 64; ++q) s += red[q * 8 + tid]; nrm[tid] = 1.f / (s + EPS); }
    __syncthreads();
    const int lgL = kind ? 12 : 8;
    for (int idx = tid; idx < 8 * L; idx += 512) {
      const int c2 = idx >> lgL, t = idx & (L - 1);
      const int col2 = cg8 + c2, o2 = col2 >> 9, cch = col2 & 511;
      FILT[((size_t)(i * 2 + o2) * 512 + cch) * 4352 + tbase + t] = f2bf(hbuf[c2 * L + t] * nrm[c2]);
    }
  }
  __syncthreads();
}

DI void phase_norm(const PV& p, int l, int part, int lx) {
  const int tid_ = TIDX(); const int lane = tid_ & 63, wid = tid_ >> 6;
  const float* MOD = (const float*)(p.ws() + OFF_MOD);
  const float* g = p.in(8) + (size_t)(l * 2 + part) * 1024;
  u16* H = (u16*)(p.ws() + OFF_A + A_H);
  const int stride = gridDim.x * 8;
  for (int row0 = blockIdx.x * 8 + wid; row0 < T; row0 += 2 * stride) {
    float4 v[2][4];
#pragma unroll
    for (int w = 0; w < 2; ++w) {
      const int row = row0 + w * stride;
      if (row < T) {
        const float* xr = xin_row(p, lx, row);
#pragma unroll
        for (int i = 0; i < 4; ++i) v[w][i] = *(const float4*)(xr + (i * 64 + lane) * 4);
      }
    }
#pragma unroll
    for (int w = 0; w < 2; ++w) {
      const int row = row0 + w * stride;
      if (row < T) {
        float ss = 0.f;
#pragma unroll
        for (int i = 0; i < 4; ++i) ss += v[w][i].x * v[w][i].x + v[w][i].y * v[w][i].y + v[w][i].z * v[w][i].z + v[w][i].w * v[w][i].w;
        ss = wave_sum(ss, lane);
        const float r = rsqrtf(ss * (1.f / 1024.f) + EPS);
        const float* mr = MOD + (size_t)(l * 9 + condrow(row)) * 6144 + part * 3072;
#pragma unroll
        for (int i = 0; i < 4; ++i) {
          const int k = (i * 64 + lane) * 4;
          const float4 gv = *(const float4*)(g + k), sh = *(const float4*)(mr + k), sc = *(const float4*)(mr + 1024 + k);
          const float a = v[w][i].x * r * gv.x * (1.f + sc.x) + sh.x;
          const float b = v[w][i].y * r * gv.y * (1.f + sc.y) + sh.y;
          const float c = v[w][i].z * r * gv.z * (1.f + sc.z) + sh.z;
          const float d = v[w][i].w * r * gv.w * (1.f + sc.w) + sh.w;
          *(uint2*)(H + (size_t)row * 1024 + k) = pack4(a, b, c, d);
        }
      }
    }
  }
}

template <bool SWAP, class Epi, class Pre>
DI void gemm_tile(const u16* A, int lda, const u16* Bt, int ldb, int K, int m0, int n0, char* smem, Epi epi, Pre pre) {
  const int tid = TIDX(), lane = tid & 63, wid = tid >> 6;
  const int wm = wid >> 1, wn = wid & 1, fr = lane & 15, fq = lane >> 4;
  const int lrow = tid >> 3, kc = tid & 7;
  const u16* ga = A + (size_t)(m0 + lrow) * lda + kc * 8;
  const u16* gb = Bt + (size_t)(n0 + lrow) * ldb + kc * 8;
  const int soff = lrow * 128 + ((kc ^ (lrow & 7)) << 4);
  uint4 ra[4], rb[2];
  f32x4 acc[4][4];
#pragma unroll
  for (int i = 0; i < 4; ++i)
#pragma unroll
    for (int j = 0; j < 4; ++j) acc[i][j] = f32x4{0.f, 0.f, 0.f, 0.f};
  const int nk = K >> 6;
#pragma unroll
  for (int i = 0; i < 4; ++i) ra[i] = *(const uint4*)(ga + (size_t)(64 * i) * lda);
#pragma unroll
  for (int i = 0; i < 2; ++i) rb[i] = *(const uint4*)(gb + (size_t)(64 * i) * ldb);
#pragma unroll
  for (int i = 0; i < 4; ++i) *(uint4*)(smem + soff + i * 8192) = ra[i];
#pragma unroll
  for (int i = 0; i < 2; ++i) *(uint4*)(smem + 32768 + soff + i * 8192) = rb[i];
  __syncthreads();
  for (int kt = 0; kt < nk; ++kt) {
    const bool more = kt + 1 < nk;
    if (more) {
      const int k0 = (kt + 1) << 6;
#pragma unroll
      for (int i = 0; i < 4; ++i) ra[i] = *(const uint4*)(ga + (size_t)(64 * i) * lda + k0);
#pragma unroll
      for (int i = 0; i < 2; ++i) rb[i] = *(const uint4*)(gb + (size_t)(64 * i) * ldb + k0);
    }
    const char* sa = smem + (kt & 1) * 49152;
    const char* sb = sa + 32768;
#pragma unroll
    for (int ks = 0; ks < 2; ++ks) {
      bf16x8 af[4], bfv[4];
      const int co = ((ks * 4 + fq) ^ (fr & 7)) << 4;
#pragma unroll
      for (int mi = 0; mi < 4; ++mi) af[mi] = *(const bf16x8*)(sa + (wm * 64 + mi * 16 + fr) * 128 + co);
#pragma unroll
      for (int ni = 0; ni < 4; ++ni) bfv[ni] = *(const bf16x8*)(sb + (wn * 64 + ni * 16 + fr) * 128 + co);
#pragma unroll
      for (int mi = 0; mi < 4; ++mi)
#pragma unroll
        for (int ni = 0; ni < 4; ++ni)
          acc[mi][ni] = SWAP ? __builtin_amdgcn_mfma_f32_16x16x32_bf16(bfv[ni], af[mi], acc[mi][ni], 0, 0, 0)
                             : __builtin_amdgcn_mfma_f32_16x16x32_bf16(af[mi], bfv[ni], acc[mi][ni], 0, 0, 0);
    }
    if (more) {
      char* da = smem + ((kt + 1) & 1) * 49152;
#pragma unroll
      for (int i = 0; i < 4; ++i) *(uint4*)(da + soff + i * 8192) = ra[i];
#pragma unroll
      for (int i = 0; i < 2; ++i) *(uint4*)(da + 32768 + soff + i * 8192) = rb[i];
    }
    __syncthreads();
  }
  uint2 pv[4][4];
#pragma unroll
  for (int mi = 0; mi < 4; ++mi)
#pragma unroll
    for (int ni = 0; ni < 4; ++ni) {
      if (SWAP) pv[mi][ni] = pre(m0 + wm * 64 + mi * 16 + fr, n0 + wn * 64 + ni * 16 + fq * 4);
      else pv[mi][ni] = pre(m0 + wm * 64 + mi * 16 + fq * 4, n0 + wn * 64 + ni * 16 + fr);
    }
#pragma unroll
  for (int mi = 0; mi < 4; ++mi)
#pragma unroll
    for (int ni = 0; ni < 4; ++ni) {
      if (SWAP) epi(m0 + wm * 64 + mi * 16 + fr, n0 + wn * 64 + ni * 16 + fq * 4, acc[mi][ni], pv[mi][ni]);
      else epi(m0 + wm * 64 + mi * 16 + fq * 4, n0 + wn * 64 + ni * 16 + fr, acc[mi][ni], pv[mi][ni]);
    }
}

template <class F>
DI void for_tiles(int nM, int nN, int sm, int sn, F f) {
  if (gridDim.x == 256) {
    const int xcd = blockIdx.x & 7, slot = blockIdx.x >> 3;
    const int am = slot % sm, bn = slot / sm;
    const int nSN = (nN + sn - 1) / sn, nS = (nM / sm) * nSN;
    for (int st = xcd; st < nS; st += 8) {
      const int tm = (st / nSN) * sm + am, tn = (st % nSN) * sn + bn;
      if (tn < nN) f(tm, tn);
    }
  } else {
    for (int t = blockIdx.x; t < nM * nN; t += gridDim.x) f(t / nN, t % nN);
  }
}


#define LAS __attribute__((address_space(3)))
constexpr int G8_HTB = 128 * 64 * 2;
DI int g8_lds_byte(int r, int c) { const int st = (r >> 4) * 2 + (c >> 5), rr = r & 15, cc = c & 31, ob = rr * 64 + cc * 2; return st * 1024 + (ob ^ (((ob >> 9) & 1) << 5)); }
DI void g8_stage_rc(int b, int& R, int& C) { const int st = b / 1024, sb = b % 1024, swz = sb ^ (((sb >> 9) & 1) << 5); R = (st >> 1) * 16 + swz / 64; C = (st & 1) * 32 + (swz % 64) / 2; }
template <int NM, int NN, int NN1, int SM1, int SN1, int SM2, int SN2>
struct TileSched {
  static constexpr int nSN1 = NN1 / SN1, nS1 = (NM / SM1) * nSN1, nSN2 = (NN - NN1) / SN2, nS2 = (NM / SM2) * nSN2, nT = NM * NN;
  int c;
  DI void init() { c = blockIdx.x; }
  DI bool next(int i, int& pm, int& pn) const {
    if (gridDim.x == 256) {
      const int xcd = c & 7, slot = c >> 3;
      int st = xcd + 8 * i;
      if (st < nS1) { pm = (st / nSN1) * SM1 + slot % SM1; pn = (st % nSN1) * SN1 + slot / SM1; return true; }
      st -= nS1;
      if (nS2 == 0 || st >= nS2) return false;
      pm = (st / (nSN2 > 0 ? nSN2 : 1)) * SM2 + slot % SM2; pn = NN1 + (st % (nSN2 > 0 ? nSN2 : 1)) * SN2 + slot / SM2; return true;
    }
    const int L = i * (int)gridDim.x + c; if (L >= nT) return false; pm = L / NN; pn = L % NN; return true;
  }
};
template <bool ABLK = false, int SWM = 0, class Sched, class Epi>
DI void gemm8(char* smem, const u16* A, const u16* Bt, int K, const Sched& S, const Epi& E) {
  LAS unsigned char* lds = (LAS unsigned char*)smem;
  const int tid = TIDX(), wid = __builtin_amdgcn_readfirstlane(tid >> 6), lane = tid & 63, wr = wid >> 2, wc = wid & 3, fr = lane & 15, fq = lane >> 4;
  const int nt = K / 64;
  unsigned voff[2], voffA[2];
#pragma unroll
  for (int i = 0; i < 2; ++i) { int R, C; g8_stage_rc(tid * 16 + i * 8192, R, C); voff[i] = (unsigned)(R * 64 + C) * 2u; voffA[i] = ABLK ? voff[i] : (unsigned)(R * K + C) * 2u; }
  const size_t kstep = 32768, hstep = 16384, tstep = (size_t)256 * K * 2;
  const size_t kstepA = ABLK ? 32768 : 128, hstepA = ABLK ? 16384 : (size_t)128 * K * 2;
  const unsigned ldsw = (unsigned)wid * 1024u;
  const int aoff = g8_lds_byte(wr * 64 + fr, fq * 8), boff = g8_lds_byte(wc * 32 + fr, fq * 8);
#define G8_SA(b, h) (((b) * 2 + (h)) * G8_HTB)
#define G8_SB(b, h) ((4 + (b) * 2 + (h)) * G8_HTB)
#define G8_STAGE(bufoff, gbase) do { _Pragma("unroll") for (int _i = 0; _i < 2; ++_i) \
    __builtin_amdgcn_global_load_lds((const unsigned*)((const char*)(gbase) + voff[_i]), (LAS unsigned*)(lds + (bufoff) + ldsw + _i * 8192), 16, 0, 0); } while (0)
#define G8_STAGEA(bufoff, gbase) do { _Pragma("unroll") for (int _i = 0; _i < 2; ++_i) \
    __builtin_amdgcn_global_load_lds((const unsigned*)((const char*)(gbase) + voffA[_i]), (LAS unsigned*)(lds + (bufoff) + ldsw + _i * 8192), 16, 0, 0); } while (0)
#define G8_LDA(dst, b, h) do { _Pragma("unroll") for (int m = 0; m < 4; ++m) _Pragma("unroll") for (int k = 0; k < 2; ++k) dst[m][k] = *(const LAS bf16x8*)(lds + G8_SA(b, h) + aoff + m * 2048 + k * 1024); } while (0)
#define G8_LDB(dst, b, h) do { _Pragma("unroll") for (int n = 0; n < 2; ++n) _Pragma("unroll") for (int k = 0; k < 2; ++k) dst[n][k] = *(const LAS bf16x8*)(lds + G8_SB(b, h) + boff + n * 2048 + k * 1024); } while (0)
#define G8_MMA(ai, bj, At_, Bt_) do { __builtin_amdgcn_s_setprio(1); _Pragma("unroll") for (int m = 0; m < 4; ++m) _Pragma("unroll") for (int n = 0; n < 2; ++n) _Pragma("unroll") for (int k = 0; k < 2; ++k) \
    acc[ai][bj][m][n] = SWM == 2 ? __builtin_amdgcn_mfma_f32_16x16x32_bf16(At_[m][k], Bt_[n][k], acc[ai][bj][m][n], 0, 0, 0) \
                                 : __builtin_amdgcn_mfma_f32_16x16x32_bf16(Bt_[n][k], At_[m][k], acc[ai][bj][m][n], 0, 0, 0); __builtin_amdgcn_s_setprio(0); } while (0)
#define G8_WAIT_V(n) asm volatile("s_waitcnt vmcnt(" #n ")" ::: "memory")
#define G8_WAIT_L(n) asm volatile("s_waitcnt lgkmcnt(" #n ")" ::: "memory")
#define G8_BAR __builtin_amdgcn_s_barrier()
#define G8_SCHED __builtin_amdgcn_sched_barrier(0)
  int cpm, cpn, npm = 0, npn = 0, ui = 0;
  if (!S.next(0, cpm, cpn)) return;
  f32x4 acc[2][2][4][2];
#pragma unroll
  for (int a = 0; a < 2; ++a)
#pragma unroll
    for (int b = 0; b < 2; ++b)
#pragma unroll
      for (int m = 0; m < 4; ++m)
#pragma unroll
        for (int n = 0; n < 2; ++n) acc[a][b][m][n] = f32x4{0.f, 0.f, 0.f, 0.f};
  bf16x8 At[4][2], B0[2][2], B1[2][2];
  const char* cA = (const char*)A + (size_t)cpm * tstep; const char* cB = (const char*)Bt + (size_t)cpn * tstep;
  G8_STAGE(G8_SB(0, 0), cB); G8_STAGEA(G8_SA(0, 0), cA); G8_STAGE(G8_SB(0, 1), cB + hstep); G8_STAGEA(G8_SA(0, 1), cA + hstepA);
  if (wr == 1) G8_BAR;
  G8_WAIT_V(4); G8_BAR;
  G8_STAGE(G8_SB(1, 0), cB + kstep); G8_STAGEA(G8_SA(1, 0), cA + kstepA); G8_STAGE(G8_SB(1, 1), cB + hstep + kstep);
  G8_WAIT_V(6); G8_BAR;
  for (;;) {
    const bool has_next = S.next(ui + 1, npm, npn);
    const char* nA = has_next ? (const char*)A + (size_t)npm * tstep : cA; const char* nB = has_next ? (const char*)Bt + (size_t)npn * tstep : cB;
#pragma unroll 1
    for (int t = 0; t < nt; t += 2) {
      const bool last = (t == nt - 2);
      const char* a1 = cA + (size_t)(t + 1) * kstepA;
      const char* a2 = last ? nA : cA + (size_t)(t + 2) * kstepA; const char* b2 = last ? nB : cB + (size_t)(t + 2) * kstep;
      const char* a3 = a2 + kstepA; const char* b3 = b2 + kstep;
      G8_LDB(B0, 0, 0); G8_SCHED; G8_LDA(At, 0, 0); G8_STAGEA(G8_SA(1, 1), a1 + hstepA);
      G8_WAIT_L(8); G8_BAR; G8_WAIT_L(0); G8_MMA(0, 0, At, B0); G8_BAR; G8_SCHED;
      G8_LDB(B1, 0, 1); G8_STAGE(G8_SB(0, 0), b2);
      G8_BAR; G8_WAIT_L(0); G8_MMA(0, 1, At, B1); G8_BAR;
      G8_LDA(At, 0, 1); G8_STAGEA(G8_SA(0, 0), a2);
      G8_BAR; G8_WAIT_L(0); G8_MMA(1, 0, At, B0); G8_BAR; G8_SCHED;
      G8_STAGE(G8_SB(0, 1), b2 + hstep);
      G8_WAIT_V(6); G8_BAR; G8_MMA(1, 1, At, B1); G8_BAR;
      G8_LDB(B0, 1, 0); G8_SCHED; G8_LDA(At, 1, 0); G8_STAGEA(G8_SA(0, 1), a2 + hstepA);
      G8_WAIT_L(8); G8_BAR; G8_WAIT_L(0); G8_MMA(0, 0, At, B0); G8_BAR; G8_SCHED;
      G8_LDB(B1, 1, 1); G8_STAGE(G8_SB(1, 0), b3);
      G8_BAR; G8_WAIT_L(0); G8_MMA(0, 1, At, B1); G8_BAR;
      G8_LDA(At, 1, 1); G8_STAGEA(G8_SA(1, 0), a3);
      G8_BAR; G8_WAIT_L(0); G8_MMA(1, 0, At, B0); G8_BAR; G8_SCHED;
      G8_STAGE(G8_SB(1, 1), b3 + hstep);
      G8_WAIT_V(6); G8_BAR; G8_MMA(1, 1, At, B1); G8_BAR;
    }
    { const int t2 = TIDX(), w2 = __builtin_amdgcn_readfirstlane(t2 >> 6), l2 = t2 & 63; E(acc, cpm, cpn, w2 >> 2, w2 & 3, l2 & 15, l2 >> 4); }
    if (!has_next) break;
#pragma unroll
    for (int a = 0; a < 2; ++a)
#pragma unroll
      for (int b = 0; b < 2; ++b)
#pragma unroll
        for (int m = 0; m < 4; ++m)
#pragma unroll
          for (int n = 0; n < 2; ++n) acc[a][b][m][n] = f32x4{0.f, 0.f, 0.f, 0.f};
    cpm = npm; cpn = npn; cA = nA; cB = nB; ++ui;
  }
  G8_WAIT_V(0);
  if (wr == 0) G8_BAR;
  G8_BAR;
#undef G8_SA
#undef G8_SB
#undef G8_STAGE
#undef G8_STAGEA
#undef G8_LDA
#undef G8_LDB
#undef G8_MMA
#undef G8_WAIT_V
#undef G8_WAIT_L
#undef G8_BAR
#undef G8_SCHED
}
template <bool ABLK, class Epi>
DI void gemm_half(char* smem, const u16* A, const u16* Bt, int K, int pm, int pn, int nh, const Epi& E) {
  LAS unsigned char* lds = (LAS unsigned char*)smem;
  const int tid = TIDX(), wid = __builtin_amdgcn_readfirstlane(tid >> 6), lane = tid & 63, wr = wid >> 2, wc = wid & 3, fr = lane & 15, fq = lane >> 4;
  const int nt = K / 64;
  unsigned voff[2], voffA[2];
#pragma unroll
  for (int i = 0; i < 2; ++i) { int R, C; g8_stage_rc(tid * 16 + i * 8192, R, C); voff[i] = (unsigned)(R * 64 + C) * 2u; voffA[i] = ABLK ? voff[i] : (unsigned)(R * K + C) * 2u; }
  const size_t kstep = 32768, hstep = 16384, tstep = (size_t)256 * K * 2;
  const size_t kstepA = ABLK ? 32768 : 128, hstepA = ABLK ? 16384 : (size_t)128 * K * 2;
  const unsigned ldsw = (unsigned)wid * 1024u;
  const int aoff = g8_lds_byte(wr * 64 + fr, fq * 8), boff = g8_lds_byte(wc * 32 + fr, fq * 8);
  const char* cA = (const char*)A + (size_t)pm * tstep;
  const char* cB = (const char*)Bt + (size_t)pn * tstep + (size_t)nh * hstep;
#define GH_STAGE(s_, kt_) do { _Pragma("unroll") for (int _i = 0; _i < 2; ++_i) { \
    __builtin_amdgcn_global_load_lds((const unsigned*)(cB + (size_t)(kt_) * kstep + voff[_i]), (LAS unsigned*)(lds + (s_) * 49152 + ldsw + _i * 8192), 16, 0, 0); \
    __builtin_amdgcn_global_load_lds((const unsigned*)(cA + (size_t)(kt_) * kstepA + voffA[_i]), (LAS unsigned*)(lds + (s_) * 49152 + 16384 + ldsw + _i * 8192), 16, 0, 0); \
    __builtin_amdgcn_global_load_lds((const unsigned*)(cA + hstepA + (size_t)(kt_) * kstepA + voffA[_i]), (LAS unsigned*)(lds + (s_) * 49152 + 32768 + ldsw + _i * 8192), 16, 0, 0); } } while (0)
  f32x4 acc[2][4][2];
#pragma unroll
  for (int a = 0; a < 2; ++a)
#pragma unroll
    for (int m = 0; m < 4; ++m)
#pragma unroll
      for (int n = 0; n < 2; ++n) acc[a][m][n] = f32x4{0.f, 0.f, 0.f, 0.f};
  __syncthreads();
  GH_STAGE(0, 0);
  asm volatile("s_waitcnt vmcnt(0)" ::: "memory");
  __syncthreads();
#pragma unroll 1
  for (int kt = 0; kt < nt; ++kt) {
    if (kt + 1 < nt) GH_STAGE((kt + 1) & 1, kt + 1);
    const LAS unsigned char* base = lds + (kt & 1) * 49152;
    bf16x8 B0[2][2];
#pragma unroll
    for (int n = 0; n < 2; ++n)
#pragma unroll
      for (int k = 0; k < 2; ++k) B0[n][k] = *(const LAS bf16x8*)(base + boff + n * 2048 + k * 1024);
#pragma unroll
    for (int ai = 0; ai < 2; ++ai) {
      bf16x8 At[4][2];
#pragma unroll
      for (int m = 0; m < 4; ++m)
#pragma unroll
        for (int k = 0; k < 2; ++k) At[m][k] = *(const LAS bf16x8*)(base + 16384 + ai * 16384 + aoff + m * 2048 + k * 1024);
#pragma unroll
      for (int m = 0; m < 4; ++m)
#pragma unroll
        for (int n = 0; n < 2; ++n)
#pragma unroll
          for (int k = 0; k < 2; ++k) acc[ai][m][n] = __builtin_amdgcn_mfma_f32_16x16x32_bf16(B0[n][k], At[m][k], acc[ai][m][n], 0, 0, 0);
    }
    asm volatile("s_waitcnt vmcnt(0)" ::: "memory");
    __syncthreads();
  }
#undef GH_STAGE
  E(acc, pm, pn, nh, wr, wc, fr, fq);
}

template <class F> struct ElemEpi {
  F f;
  DI void operator()(const f32x4 (&acc)[2][2][4][2], int pm, int pn, int wr, int wc, int fr, int fq) const {
    const int row0 = pm * 256 + wr * 64 + fr, col0 = pn * 256 + wc * 32 + 4 * fq;
#pragma unroll
    for (int ai = 0; ai < 2; ++ai)
#pragma unroll
      for (int m = 0; m < 4; ++m)
#pragma unroll
        for (int bj = 0; bj < 2; ++bj)
#pragma unroll
          for (int n = 0; n < 2; ++n) f(row0 + ai * 128 + m * 16, col0 + bj * 128 + n * 16, acc[ai][bj][m][n]);
  }
};
template <class F> DI ElemEpi<F> make_epi(F f) { return ElemEpi<F>{f}; }
template <int NM, int NN, int NN1, int SM1, int SN1, int SM2, int SN2, class F>
DI void gemm8_job(char* smem, const u16* A, const u16* Bt, int K, F f) {
  TileSched<NM, NN, NN1, SM1, SN1, SM2, SN2> S; S.init();
  gemm8(smem, A, Bt, K, S, make_epi(f));
}

struct EpiMixU {
  u16* MIX;
  DI void operator()(const f32x4 (&acc)[2][2][4][2], int pm, int pn, int wr, int wc, int fr, int fq) const {
    const int row0 = pm * 256 + wr * 64 + fr, col0 = pn * 256 + wc * 32 + 4 * fq;
#pragma unroll
    for (int ai = 0; ai < 2; ++ai)
#pragma unroll
      for (int m = 0; m < 4; ++m)
#pragma unroll
        for (int bj = 0; bj < 2; ++bj)
#pragma unroll
          for (int n = 0; n < 2; ++n) {
            const f32x4 v = acc[ai][bj][m][n];
            *(uint2*)(MIX + (unsigned)((row0 + ai * 128 + m * 16) * 1024 + col0 + bj * 128 + n * 16)) = pack4(gelu_tanh(v[0]), gelu_tanh(v[1]), gelu_tanh(v[2]), gelu_tanh(v[3]));
          }
  }
  DI void operator()(const f32x4 (&acc)[2][4][2], int pm, int pn, int nh, int wr, int wc, int fr, int fq) const {
    const int row0 = pm * 256 + wr * 64 + fr, col0 = pn * 256 + nh * 128 + wc * 32 + 4 * fq;
#pragma unroll
    for (int ai = 0; ai < 2; ++ai)
#pragma unroll
      for (int m = 0; m < 4; ++m)
#pragma unroll
        for (int n = 0; n < 2; ++n) {
          const f32x4 v = acc[ai][m][n];
          *(uint2*)(MIX + (unsigned)((row0 + ai * 128 + m * 16) * 1024 + col0 + n * 16)) = pack4(gelu_tanh(v[0]), gelu_tanh(v[1]), gelu_tanh(v[2]), gelu_tanh(v[3]));
        }
  }
};
struct EpiMixV {
  u16* VT; u16* PRT;
  DI void operator()(const f32x4 (&acc)[2][2][4][2], int pm, int pn, int wr, int wc, int fr, int fq) const {
    const int rowt = pm * 256;
    if (pn < 2) {
#pragma unroll
      for (int ai = 0; ai < 2; ++ai)
#pragma unroll
        for (int bj = 0; bj < 2; ++bj) {
          const unsigned g = (unsigned)(pn * 2 + bj), chunk = (unsigned)(pm * 2 + ai);
          const unsigned base = ((g * 320u + chunk) * 128u) * 128u;
#pragma unroll
          for (int m = 0; m < 4; ++m)
#pragma unroll
            for (int n = 0; n < 2; ++n) {
              const f32x4 v = acc[ai][bj][m][n];
              const unsigned c = (unsigned)(wc * 32 + n * 16 + fr), q = (unsigned)(wr * 64 + m * 16 + 4 * fq);
              *(uint2*)(VT + (base + c * 128u + q)) = pack4(gelu_tanh(v[0]), gelu_tanh(v[1]), gelu_tanh(v[2]), gelu_tanh(v[3]));
            }
        }
    } else {
      unsigned sbase, L;
      if (rowt < TP) { sbase = (unsigned)rowt * 1536u; L = 256u; }
      else { const int mm = rowt - TP; sbase = (unsigned)(TP + (mm & ~4095)) * 1536u + (unsigned)(mm & 4095); L = 4096u; }
#pragma unroll
      for (int ai = 0; ai < 2; ++ai)
#pragma unroll
        for (int bj = 0; bj < 2; ++bj)
#pragma unroll
          for (int m = 0; m < 4; ++m)
#pragma unroll
            for (int n = 0; n < 2; ++n) {
              const f32x4 v = acc[ai][bj][m][n];
              const unsigned cp = (unsigned)((pn - 2) * 256 + bj * 128 + wc * 32 + n * 16 + fr), tl = (unsigned)(ai * 128 + wr * 64 + m * 16 + 4 * fq);
              *(uint2*)(PRT + (sbase + cp * L + tl)) = pack4(v[0], v[1], v[2], v[3]);
            }
    }
  }
};
struct OneRoundSched {
  int c;
  DI void init() { c = blockIdx.x; }
  DI bool next(int i, int& pm, int& pn) const {
    if (gridDim.x == 256) { if (i > 0) return false; const int slot = c >> 3; pm = (c & 7) * 16 + (slot & 15); pn = slot >> 4; return true; }
    const int L = i * (int)gridDim.x + c; if (L >= 320) return false; pm = L >> 1; pn = L & 1; return true;
  }
};
DI void phase_mix_in(const PV& p, int i, char* smem) {
  const u16* H = (const u16*)(p.ws() + OFF_A + A_H);
  const u16* W = (const u16*)(p.ws() + OFF_WMIXIN) + (size_t)i * 2560 * 1024;
  EpiMixV EV; EV.VT = (u16*)(p.ws() + OFF_B + B_VT); EV.PRT = (u16*)(p.ws() + OFF_B + B_PRT);
  EpiMixU EU; EU.MIX = (u16*)(p.ws() + OFF_B + B_MIX);
  {
    TileSched<160, 8, 8, 8, 4, 32, 1> S; S.init();
    gemm8<false, 2>(smem, H, W + (size_t)512 * 1024, 1024, S, EV);
  }
  {
    OneRoundSched S; S.init();
    gemm8<false, 0>(smem, H, W, 1024, S, EU);
    if (gridDim.x == 256 && blockIdx.x < 128) {
      const int tile = blockIdx.x >> 1, nh = blockIdx.x & 1;
      gemm_half<false>(smem, H, W, 1024, 128 + (tile & 31), tile >> 5, nh, EU);
    }
  }
}

DI void phase_sgu(const PV& p, int i, char* smem) {
  const u16* VT = (const u16*)(p.ws() + OFF_B + B_VT);
  const u16* W = (const u16*)(p.ws() + OFF_WSGU) + (size_t)i * 4 * 16384;
  u16* MIX = (u16*)(p.ws() + OFF_B + B_MIX);
  const float* sb = p.in(11) + i * 512;
  for (int u = blockIdx.x; u < 640; u += gridDim.x) {
    const int g = u / 160, tm = u % 160;
    auto epi = [=](int m, int n, f32x4 v, uint2 uu) {
      const int chunk = m >> 7, c = m & 127;
      const int t = chunk * 128 + n;
      const float bias = sb[g * 128 + n];
      u16* dst = MIX + (size_t)t * 1024 + g * 128 + c;
      *(uint2*)dst = pack4(lo16(uu.x) * (v[0] + bias), hi16(uu.x) * (v[1] + bias), lo16(uu.y) * (v[2] + bias), hi16(uu.y) * (v[3] + bias));
    };
    auto pre = [=](int m, int n) { return *(const uint2*)(MIX + (size_t)((m >> 7) * 128 + n) * 1024 + g * 128 + (m & 127)); };
    gemm_tile<false>(VT + (size_t)g * 320 * 128 * 128, 128, W + (size_t)g * 16384, 128, 128, tm * 256, 0, smem, epi, pre);
  }
}

DI size_t prt_off(int kind, int b, int cp) {
  return kind ? (size_t)(TP + b * 4096) * 1536 + (size_t)cp * 4096 : (size_t)(b * 256) * 1536 + (size_t)cp * 256;
}
DI size_t zt_off(int kind, int b, int c) {
  return kind ? (size_t)(TP + b * 4096) * 512 + (size_t)c * 4096 : (size_t)(b * 256) * 512 + (size_t)c * 256;
}
DI void phase_conv(const PV& p, int i, int ord, char* smem) {
  const int tid = TIDX(), lane = tid & 63, wid = tid >> 6;
  const u16* PRT = (const u16*)(p.ws() + OFF_B + B_PRT);
  const u16* FILT = (const u16*)(p.ws() + OFF_FILT);
  const u16* Z1 = (const u16*)(p.ws() + OFF_A + A_Z1);
  u16* ZO = (u16*)(p.ws() + OFF_A + (ord ? A_Z2 : A_Z1));
  const float* cw = p.in(12) + (size_t)i * 3 * 1536;
  const float* cb = p.in(13) + (size_t)i * 1536;
  u16* hc = (u16*)smem;
  char* Ub = smem + 68096;
  for (int u = blockIdx.x; u < 1024; u += gridDim.x) {
    const int kind = u < 512 ? 1 : 0, c = u & 511;
    const int L = kind ? 4096 : 256, NB = kind ? 8 : 32, LB = L >> 6, DD = L >> 7;
    const int US = (L + 8) * 2;
    const size_t fbase = ((size_t)(i * 2 + ord) * 512 + c) * 4352 + (kind ? 256 : 0);
    __syncthreads();
    {
      u16* tmp = (u16*)Ub;
      for (int idx = tid; idx < (L >> 3); idx += 512) *(uint4*)(tmp + idx * 8) = *(const uint4*)(FILT + fbase + idx * 8);
      __syncthreads();
#pragma unroll 1
      for (int cpy = 0; cpy < 8; ++cpy)
        for (int m = tid; m < L + 136; m += 512) {
          const int x = L + 63 - m - cpy;
          hc[cpy * 4256 + m] = (x >= 0 && x < L) ? tmp[x] : (u16)0;
        }
      __syncthreads();
    }
    {
      const int lgn = kind ? 9 : 5, ncr = 1 << lgn, total = NB * ncr;
      const float w0 = cw[c], w1 = cw[1536 + c], w2 = cw[3072 + c], bb = cb[c];
      for (int id = tid; id < total; id += 512) {
        const int b = id >> lgn, t = (id & (ncr - 1)) * 8;
        uint4 o;
        if (ord == 0) {
          const u16* src = PRT + prt_off(kind, b, c) + t;
          const uint4 raw = *(const uint4*)src;
          float e[10];
          e[0] = t > 0 ? bf2f(src[-1]) : 0.f;
          e[9] = t + 8 < L ? bf2f(src[8]) : 0.f;
          e[1] = lo16(raw.x); e[2] = hi16(raw.x); e[3] = lo16(raw.y); e[4] = hi16(raw.y);
          e[5] = lo16(raw.z); e[6] = hi16(raw.z); e[7] = lo16(raw.w); e[8] = hi16(raw.w);
          float r[8];
#pragma unroll
          for (int k = 0; k < 8; ++k) r[k] = w0 * e[k] + w1 * e[k + 1] + w2 * e[k + 2] + bb;
          o.x = pack2(r[0], r[1]); o.y = pack2(r[2], r[3]); o.z = pack2(r[4], r[5]); o.w = pack2(r[6], r[7]);
        } else {
          o = *(const uint4*)(Z1 + zt_off(kind, b, c) + t);
        }
        *(uint4*)(Ub + b * US + t * 2) = o;
      }
    }
    __syncthreads();
    const int ncols = LB * NB;
#pragma unroll 1
    for (int hf = 0; hf < 2; ++hf) {
      const int jt = wid + 8 * hf;
      if (jt * 32 >= ncols) break;
      const int il = lane & 31, q = lane >> 5;
      const int lgb = kind ? 3 : 5;
      const int col = jt * 32 + il, t1c = col >> lgb, bc = col & (NB - 1);
      const int t1lo = (jt * 32) >> lgb, t1hi = (jt * 32 + 31) >> lgb;
      const int dlo = max(-DD, t1lo - (LB - 1)), dhi = min(DD, t1hi);
      const int cpy = 7 - (il & 7);
      const char* abase = (const char*)hc + cpy * 8512 + 2 * (L / 2 + 63 - il - cpy + 8 * q);
      f32x16 acc[2];
#pragma unroll
      for (int a = 0; a < 2; ++a)
#pragma unroll
        for (int r = 0; r < 16; ++r) acc[a][r] = 0.f;
      for (int d = dlo; d <= dhi; ++d) {
        bf16x8 bfr[4];
        {
          const int s1 = t1c - d;
          const bool valid = s1 >= 0 && s1 < LB;
          const char* bp = Ub + bc * US + ((valid ? s1 : 0) * 64 + 8 * q) * 2;
#pragma unroll
          for (int ks = 0; ks < 4; ++ks) {
            bf16x8 v = *(const bf16x8*)(bp + ks * 32);
            if (!valid) v = bf16x8{0, 0, 0, 0, 0, 0, 0, 0};
            bfr[ks] = v;
          }
        }
#pragma unroll
        for (int mt = 0; mt < 2; ++mt)
#pragma unroll
          for (int ks = 0; ks < 4; ++ks) {
            const bf16x8 af = *(const bf16x8*)(abase + 2 * (-64 * d - 32 * mt + 16 * ks));
            acc[mt] = __builtin_amdgcn_mfma_f32_32x32x16_bf16(af, bfr[ks], acc[mt], 0, 0, 0);
          }
      }
      const float dsk = p.in(21)[(i * 2 + ord) * 512 + c];
      const int gc = 512 * (ord + 1) + c;
      const float w0 = cw[gc], w1 = cw[1536 + gc], w2 = cw[3072 + gc], bb = cb[gc];
      {
        const int b = bc;
        const u16* xrow = PRT + prt_off(kind, b, gc);
        u16* orow = ZO + zt_off(kind, b, c);
#pragma unroll
        for (int mt = 0; mt < 2; ++mt)
#pragma unroll
          for (int g = 0; g < 4; ++g) {
            const int t = 64 * t1c + mt * 32 + 8 * g + 4 * q;
            const uint2 uu = *(const uint2*)(Ub + b * US + t * 2);
            const uint2 xx = *(const uint2*)(xrow + t);
            const float em = t > 0 ? bf2f(xrow[t - 1]) : 0.f;
            const float ep = t + 4 < L ? bf2f(xrow[t + 4]) : 0.f;
            const float e0 = lo16(xx.x), e1 = hi16(xx.x), e2 = lo16(xx.y), e3 = hi16(xx.y);
            const float x0 = w0 * em + w1 * e0 + w2 * e1 + bb;
            const float x1 = w0 * e0 + w1 * e1 + w2 * e2 + bb;
            const float x2 = w0 * e1 + w1 * e2 + w2 * e3 + bb;
            const float x3 = w0 * e2 + w1 * e3 + w2 * ep + bb;
            const float y0 = acc[mt][4 * g + 0] + lo16(uu.x) * dsk;
            const float y1 = acc[mt][4 * g + 1] + hi16(uu.x) * dsk;
            const float y2 = acc[mt][4 * g + 2] + lo16(uu.y) * dsk;
            const float y3 = acc[mt][4 * g + 3] + hi16(uu.y) * dsk;
            *(uint2*)(orow + t) = pack4(x0 * y0, x1 * y1, x2 * y2, x3 * y3);
          }
      }
    }
  }
  __syncthreads();
}

DI void phase_ztrans(const PV& p, char* smem) {
  const int tid = TIDX();
  const u16* Z2 = (const u16*)(p.ws() + OFF_A + A_Z2);
  u16* MIX = (u16*)(p.ws() + OFF_B + B_MIX);
  u16* tl = (u16*)smem;
  for (int u4 = blockIdx.x * 4; u4 < 640 * 8; u4 += gridDim.x * 4) {
    const int tt0 = (u4 >> 3) * 64;
    const int kind = tt0 >= TP ? 1 : 0;
    const int b = kind ? (tt0 - TP) >> 12 : tt0 >> 8;
    const int tl0 = kind ? (tt0 - TP) & 4095 : tt0 & 255;
    __syncthreads();
    { const int c = tid >> 3, ch = tid & 7;
      uint4 v[4];
#pragma unroll
      for (int w = 0; w < 4; ++w) v[w] = *(const uint4*)(Z2 + zt_off(kind, b, ((u4 + w) & 7) * 64 + c) + tl0 + ch * 8);
#pragma unroll
      for (int w = 0; w < 4; ++w) *(uint4*)(tl + w * 4608 + c * 72 + ch * 8) = v[w]; }
    __syncthreads();
    { const int tr = tid >> 3, cc = (tid & 7) * 8;
#pragma unroll
      for (int w = 0; w < 4; ++w) {
        const u16* tw = tl + w * 4608;
        uint4 o;
        o.x = (unsigned)tw[(cc + 0) * 72 + tr] | ((unsigned)tw[(cc + 1) * 72 + tr] << 16);
        o.y = (unsigned)tw[(cc + 2) * 72 + tr] | ((unsigned)tw[(cc + 3) * 72 + tr] << 16);
        o.z = (unsigned)tw[(cc + 4) * 72 + tr] | ((unsigned)tw[(cc + 5) * 72 + tr] << 16);
        o.w = (unsigned)tw[(cc + 6) * 72 + tr] | ((unsigned)tw[(cc + 7) * 72 + tr] << 16);
        *(uint4*)(MIX + (size_t)(tt0 + tr) * 1024 + 512 + ((u4 + w) & 7) * 64 + cc) = o;
      } }
  }
  __syncthreads();
}

struct EpiResid {
  float* X; const float* x0; const float* x1; const float* gate; int lx;
  DI void operator()(const f32x4 (&acc)[2][2][4][2], int pm, int pn, int wr, int wc, int fr, int fq) const {
    const int rowt = pm * 256, col0 = pn * 256 + wc * 32 + 4 * fq;
    const float* gr = gate + (size_t)condrow(rowt) * 6144 + col0;
    const float* xb = lx == 0 ? (rowt < TP ? x0 + (size_t)rowt * 1024 : x1 + (size_t)(rowt - TP) * 1024) : X + (size_t)rowt * 1024;
    float4 g[2][2];
#pragma unroll
    for (int bj = 0; bj < 2; ++bj)
#pragma unroll
      for (int n = 0; n < 2; ++n) g[bj][n] = *(const float4*)(gr + bj * 128 + n * 16);
#pragma unroll
    for (int ai = 0; ai < 2; ++ai)
#pragma unroll
      for (int mh = 0; mh < 2; ++mh) {
        float4 xo[2][2][2];
#pragma unroll
        for (int mm = 0; mm < 2; ++mm)
#pragma unroll
          for (int bj = 0; bj < 2; ++bj)
#pragma unroll
            for (int n = 0; n < 2; ++n)
              xo[mm][bj][n] = *(const float4*)(xb + (size_t)(wr * 64 + fr + ai * 128 + (2 * mh + mm) * 16) * 1024 + col0 + bj * 128 + n * 16);
#pragma unroll
        for (int mm = 0; mm < 2; ++mm)
#pragma unroll
          for (int bj = 0; bj < 2; ++bj)
#pragma unroll
            for (int n = 0; n < 2; ++n) {
              const f32x4 v = acc[ai][bj][2 * mh + mm][n];
              const float4 x = xo[mm][bj][n], gg = g[bj][n];
              float4 o; o.x = x.x + gg.x * v[0]; o.y = x.y + gg.y * v[1]; o.z = x.z + gg.z * v[2]; o.w = x.w + gg.w * v[3];
              *(float4*)(X + (size_t)(rowt + wr * 64 + fr + ai * 128 + (2 * mh + mm) * 16) * 1024 + col0 + bj * 128 + n * 16) = o;
            }
      }
  }
};
struct EpiResidHalf {
  float* X; const float* x0; const float* x1; const float* gate; int lx;
  DI void operator()(const f32x4 (&acc)[2][4][2], int pm, int pn, int nh, int wr, int wc, int fr, int fq) const {
    const int rowt = pm * 256, col0 = pn * 256 + nh * 128 + wc * 32 + 4 * fq;
    const float* gr = gate + (size_t)condrow(rowt) * 6144 + col0;
    const float* xb = lx == 0 ? (rowt < TP ? x0 + (size_t)rowt * 1024 : x1 + (size_t)(rowt - TP) * 1024) : X + (size_t)rowt * 1024;
    float4 g[2];
#pragma unroll
    for (int n = 0; n < 2; ++n) g[n] = *(const float4*)(gr + n * 16);
#pragma unroll
    for (int ai = 0; ai < 2; ++ai) {
      float4 xo[4][2];
#pragma unroll
      for (int m = 0; m < 4; ++m)
#pragma unroll
        for (int n = 0; n < 2; ++n) xo[m][n] = *(const float4*)(xb + (size_t)(wr * 64 + fr + ai * 128 + m * 16) * 1024 + col0 + n * 16);
#pragma unroll
      for (int m = 0; m < 4; ++m)
#pragma unroll
        for (int n = 0; n < 2; ++n) {
          const f32x4 v = acc[ai][m][n];
          const float4 x = xo[m][n], gg = g[n];
          float4 o; o.x = x.x + gg.x * v[0]; o.y = x.y + gg.y * v[1]; o.z = x.z + gg.z * v[2]; o.w = x.w + gg.w * v[3];
          *(float4*)(X + (size_t)(rowt + wr * 64 + fr + ai * 128 + m * 16) * 1024 + col0 + n * 16) = o;
        }
    }
  }
};
struct ResidSched2 {
  int c;
  DI void init() { c = blockIdx.x; }
  DI bool next(int i, int& pm, int& pn) const {
    if (gridDim.x == 256) {
      const int st = (c & 7) + 8 * i;
      if (st >= 16) return false;
      pm = st * 8 + ((c >> 3) & 7); pn = c >> 6; return true;
    }
    const int L = i * (int)gridDim.x + c; if (L >= 640) return false; pm = L >> 2; pn = L & 3; return true;
  }
};
DI void phase_resid_gemm(const PV& p, int l, int lx, const u16* A, int K, const u16* W, int goff, char* smem) {
  EpiResid E;
  E.X = p.out(); E.x0 = p.in(0); E.x1 = p.in(1); E.gate = (const float*)(p.ws() + OFF_MOD) + (size_t)l * 9 * 6144 + goff; E.lx = lx;
  ResidSched2 S; S.init();
  if (K == 2816) gemm8<true>(smem, A, W, K, S, E);
  else gemm8<false>(smem, A, W, K, S, E);
  if (gridDim.x == 256) {
    EpiResidHalf EH; EH.X = E.X; EH.x0 = E.x0; EH.x1 = E.x1; EH.gate = E.gate; EH.lx = lx;
    const int xcd = blockIdx.x & 7, slot = blockIdx.x >> 3;
    const int st = 16 + (xcd >> 1), ti = (xcd & 1) * 16 + (slot >> 1), nh = slot & 1;
    const int pm = st * 8 + (ti & 7), pn = ti >> 3;
    if (K == 2816) gemm_half<true>(smem, A, W, K, pm, pn, nh, EH);
    else gemm_half<false>(smem, A, W, K, pm, pn, nh, EH);
  }
}

DI void phase_dqkv(const PV& p, int j, char* smem) {
  const u16* H = (const u16*)(p.ws() + OFF_A + A_H);
  const u16* W = (const u16*)(p.ws() + OFF_WDQKV) + (size_t)j * 1024 * 1024;
  u16* DQKV = (u16*)(p.ws() + OFF_B + B_DQKV);
  u16* KR = (u16*)(p.ws() + OFF_KR);
  float* okr = p.out() + 46137344;
  auto epi = [=](int m, int n, f32x4 v) {
    if (n < 832) {
      const uint2 pk = pack4(v[0], v[1], v[2], v[3]);
      *(uint2*)(DQKV + (size_t)m * 896 + n) = pk;
      if (n >= 768) {
        const int e = n - 768;
        *(uint2*)(KR + (size_t)m * 64 + e) = pk;
        if (m < TP) {
          float4 o; o.x = v[0]; o.y = v[1]; o.z = v[2]; o.w = v[3];
          *(float4*)(okr + ((size_t)((m >> 8) * 2 + j) * 256 + (m & 255)) * 64 + e) = o;
        }
      }
    }
  };
  gemm8_job<160, 4, 4, 8, 4, 32, 1>(smem, H, W, 1024, epi);
}

DI void phase_mla_norms(const PV& p, int j) {
  const int tid_ = TIDX(); const int lane = tid_ & 63, wid = tid_ >> 6;
  const u16* DQKV = (const u16*)(p.ws() + OFF_B + B_DQKV);
  u16* QN = (u16*)(p.ws() + OFF_A + A_QN);
  u16* CKV = (u16*)(p.ws() + OFF_A + A_CKV);
  u16* KR = (u16*)(p.ws() + OFF_KR);
  float* ockv = p.out() + 41943040;
  const float* qn = p.in(24) + j * 512;
  const float* kvn = p.in(27) + j * 256;
  const int stride = gridDim.x * 8;
  for (int t0 = blockIdx.x * 8 + wid; t0 < TK; t0 += 2 * stride) {
    uint4 ra[2]; uint2 rb[2];
#pragma unroll
    for (int w = 0; w < 2; ++w) {
      const int t = t0 + w * stride;
      if (t < T) {
        const u16* row = DQKV + (size_t)t * 896;
        ra[w] = *(const uint4*)(row + lane * 8);
        rb[w] = *(const uint2*)(row + 512 + lane * 4);
      }
    }
#pragma unroll
    for (int w = 0; w < 2; ++w) {
      const int t = t0 + w * stride;
      if (t < T) {
        const uint4 a = ra[w];
        float q[8] = {lo16(a.x), hi16(a.x), lo16(a.y), hi16(a.y), lo16(a.z), hi16(a.z), lo16(a.w), hi16(a.w)};
        float ss = 0.f;
#pragma unroll
        for (int k = 0; k < 8; ++k) ss += q[k] * q[k];
        ss = wave_sum(ss, lane);
        const float r = rsqrtf(ss * (1.f / 512.f) + EPS);
        const float4 g0 = *(const float4*)(qn + lane * 8), g1 = *(const float4*)(qn + lane * 8 + 4);
        uint4 o;
        o.x = pack2(q[0] * r * g0.x, q[1] * r * g0.y); o.y = pack2(q[2] * r * g0.z, q[3] * r * g0.w);
        o.z = pack2(q[4] * r * g1.x, q[5] * r * g1.y); o.w = pack2(q[6] * r * g1.z, q[7] * r * g1.w);
        *(uint4*)(QN + (size_t)t * 512 + lane * 8) = o;
        const uint2 b = rb[w];
        float kv[4] = {lo16(b.x), hi16(b.x), lo16(b.y), hi16(b.y)};
        float s2 = kv[0] * kv[0] + kv[1] * kv[1] + kv[2] * kv[2] + kv[3] * kv[3];
        s2 = wave_sum(s2, lane);
        const float r2 = rsqrtf(s2 * (1.f / 256.f) + EPS);
        const float4 g2 = *(const float4*)(kvn + lane * 4);
        float4 o2; o2.x = kv[0] * r2 * g2.x; o2.y = kv[1] * r2 * g2.y; o2.z = kv[2] * r2 * g2.z; o2.w = kv[3] * r2 * g2.w;
        *(uint2*)(CKV + (size_t)t * 256 + lane * 4) = pack4(o2.x, o2.y, o2.z, o2.w);
        if (t < TP) *(float4*)(ockv + ((size_t)((t >> 8) * 2 + j) * 256 + (t & 255)) * 256 + lane * 4) = o2;
      } else if (t < TK) {
        const int pp = t - T, b = pp >> 8, sidx = pp & 255;
        const float4 v = *(const float4*)(p.in(2) + ((size_t)(b * 2 + j) * 256 + sidx) * 256 + lane * 4);
        *(uint2*)(CKV + (size_t)t * 256 + lane * 4) = pack4(v.x, v.y, v.z, v.w);
        if (lane < 16) {
          const float4 w4 = *(const float4*)(p.in(3) + ((size_t)(b * 2 + j) * 256 + sidx) * 64 + lane * 4);
          *(uint2*)(KR + (size_t)t * 64 + lane * 4) = pack4(w4.x, w4.y, w4.z, w4.w);
        }
      }
    }
  }
}

DI size_t vt_off(int m, int h, int d) {
  if (m < TP) return ((size_t)((m >> 8) * 8 + h) * 128 + d) * 256 + (m & 255);
  if (m < T) { const int mm = m - TP; return VT_SAMPLE_OFF + ((size_t)((mm >> 12) * 8 + h) * 128 + d) * 4352 + (mm & 4095); }
  const int mm = m - T;
  return VT_SAMPLE_OFF + ((size_t)((mm >> 8) * 8 + h) * 128 + d) * 4352 + 4096 + (mm & 255);
}
struct EpiKV {
  u16* Kb; u16* Vt;
  DI void operator()(const f32x4 (&acc)[2][2][4][2], int pm, int pn, int wr, int wc, int fr, int fq) const {
    const int h = pn;
    const int rowt = pm * 256;
    const unsigned ls = rowt < TP ? 256u : 4352u;
    unsigned vbase;
    if (rowt < TP) vbase = (unsigned)(((rowt >> 8) * 8 + h) * 128) * 256u;
    else if (rowt < T) { const int mm = rowt - TP; vbase = (unsigned)VT_SAMPLE_OFF + (unsigned)(((mm >> 12) * 8 + h) * 128) * 4352u + (unsigned)(mm & 4095); }
    else { const int mm = rowt - T; vbase = (unsigned)VT_SAMPLE_OFF + (unsigned)(((mm >> 8) * 8 + h) * 128) * 4352u + 4096u + (unsigned)(mm & 255); }
    const unsigned dcol = (unsigned)(wc * 32 + 4 * fq);
#pragma unroll
    for (int ai = 0; ai < 2; ++ai)
#pragma unroll
      for (int m = 0; m < 4; ++m) {
        const int rl = ai * 128 + wr * 64 + m * 16 + fr;
        const unsigned ko = (unsigned)((rowt + rl) * 8 + h) * 192u + dcol;
        const unsigned frp = (unsigned)((fr & 3) | ((fr & 4) << 1) | ((fr & 8) >> 1));
        const unsigned vo = vbase + (unsigned)(rl & ~15) + frp + dcol * ls;
#pragma unroll
        for (int n = 0; n < 2; ++n) {
          const f32x4 k = acc[ai][0][m][n], v = acc[ai][1][m][n];
          *(uint2*)(Kb + (ko + n * 16)) = pack4(k[0], k[1], k[2], k[3]);
          const unsigned p01 = pack2(v[0], v[1]), p23 = pack2(v[2], v[3]);
          const unsigned vq = vo + (unsigned)(n * 16) * ls;
          Vt[vq] = (u16)p01; Vt[vq + ls] = (u16)(p01 >> 16); Vt[vq + 2 * ls] = (u16)p23; Vt[vq + 3 * ls] = (u16)(p23 >> 16);
        }
      }
  }
};
DI void phase_uq_ukv(const PV& p, int j, char* smem) {
  const u16* QN = (const u16*)(p.ws() + OFF_A + A_QN);
  const u16* CKV = (const u16*)(p.ws() + OFF_A + A_CKV);
  const u16* WQ = (const u16*)(p.ws() + OFF_WUQ) + (size_t)j * 1536 * 512;
  const u16* WKV = (const u16*)(p.ws() + OFF_WUKV) + (size_t)j * 2048 * 256;
  u16* Q = (u16*)(p.ws() + OFF_B + B_Q);
  u16* Kb = (u16*)(p.ws() + OFF_B + B_K);
  u16* Vt = (u16*)(p.ws() + OFF_B + B_V);
  auto epiq = [=](int m, int n, f32x4 v) { *(uint2*)(Q + (size_t)m * 1536 + n) = pack4(v[0], v[1], v[2], v[3]); };
  gemm8_job<160, 6, 4, 8, 4, 16, 2>(smem, QN, WQ, 512, epiq);
  EpiKV E; E.Kb = Kb; E.Vt = Vt;
  TileSched<168, 8, 8, 8, 4, 32, 1> S; S.init();
  gemm8(smem, CKV, WKV, 256, S, E);
}

DI void phase_finalize(const PV& p, int j) {
  const int tid_ = TIDX(); const int lane = tid_ & 63, wid = tid_ >> 6;
  const int h = lane >> 3, l8 = lane & 7;
  u16* Q = (u16*)(p.ws() + OFF_B + B_Q);
  u16* Kb = (u16*)(p.ws() + OFF_B + B_K);
  const u16* KR = (const u16*)(p.ws() + OFF_KR);
  const float2* ROPE = (const float2*)(p.ws() + OFF_ROPE);
  const float* qhn = p.in(29) + j * 192;
  const float* khn = p.in(30) + j * 192;
  const float QSCALE = 1.4426950408889634f * 0.07216878364870322f;
  const int stride = gridDim.x * 8;
  for (int u0 = T + blockIdx.x * 8 + wid; u0 < T + TK; u0 += 2 * stride) {
    uint4 raw[2][3];
    u16* basep[2];
#pragma unroll
    for (int w = 0; w < 2; ++w) {
      const int u = u0 + w * stride;
      if (u < T + TK) {
        const bool isq = u < T;
        const int t = isq ? u : u - T;
        u16* base = isq ? Q + (size_t)t * 1536 + h * 192 : Kb + ((size_t)t * 8 + h) * 192;
        basep[w] = base;
#pragma unroll
        for (int k = 0; k < 3; ++k) {
          const u16* src = (!isq && k == 2) ? KR + (size_t)t * 64 + 8 * l8 : base + 8 * (l8 + 8 * k);
          raw[w][k] = *(const uint4*)src;
        }
      }
    }
#pragma unroll
    for (int w = 0; w < 2; ++w) {
      const int u = u0 + w * stride;
      if (u < T + TK) {
        const bool isq = u < T;
        const int t = isq ? u : u - T;
        const float* hn = isq ? qhn : khn;
        float v[3][8];
#pragma unroll
        for (int k = 0; k < 3; ++k) {
          const uint4 a = raw[w][k];
          v[k][0] = lo16(a.x); v[k][1] = hi16(a.x); v[k][2] = lo16(a.y); v[k][3] = hi16(a.y);
          v[k][4] = lo16(a.z); v[k][5] = hi16(a.z); v[k][6] = lo16(a.w); v[k][7] = hi16(a.w);
        }
        float ss = 0.f;
#pragma unroll
        for (int k = 0; k < 3; ++k)
#pragma unroll
          for (int e = 0; e < 8; ++e) ss += v[k][e] * v[k][e];
        ss += shx<1>(ss, lane); ss += shx<2>(ss, lane); ss += shx<4>(ss, lane);
        const float r = rsqrtf(ss * (1.f / 192.f) + EPS);
#pragma unroll
        for (int k = 0; k < 3; ++k) {
          const float4 g0 = *(const float4*)(hn + 8 * (l8 + 8 * k)), g1 = *(const float4*)(hn + 8 * (l8 + 8 * k) + 4);
          v[k][0] *= r * g0.x; v[k][1] *= r * g0.y; v[k][2] *= r * g0.z; v[k][3] *= r * g0.w;
          v[k][4] *= r * g1.x; v[k][5] *= r * g1.y; v[k][6] *= r * g1.z; v[k][7] *= r * g1.w;
        }
        if (t >= TP && t < T) {
          const int tl = (t - TP) & 4095;
          const int pos = l8 < 4 ? (tl >> 6) : (tl & 63);
          const float4* rp = (const float4*)(ROPE + pos * 16 + (l8 & 1) * 8);
          const float4 c01 = rp[0], c23 = rp[1], c45 = rp[2], c67 = rp[3];
          const float cs[8] = {c01.x, c01.z, c23.x, c23.z, c45.x, c45.z, c67.x, c67.z};
          const float sn[8] = {c01.y, c01.w, c23.y, c23.w, c45.y, c45.w, c67.y, c67.w};
#pragma unroll
          for (int e = 0; e < 8; ++e) {
            const float x = v[2][e];
            const float partner = shx<2>(x, lane);
            v[2][e] = (l8 & 2) ? x * cs[e] + partner * sn[e] : x * cs[e] - partner * sn[e];
          }
        }
        const float sc = isq ? QSCALE : 1.f;
#pragma unroll
        for (int k = 0; k < 3; ++k) {
          uint4 o;
          o.x = pack2(v[k][0] * sc, v[k][1] * sc); o.y = pack2(v[k][2] * sc, v[k][3] * sc);
          o.z = pack2(v[k][4] * sc, v[k][5] * sc); o.w = pack2(v[k][6] * sc, v[k][7] * sc);
          *(uint4*)(basep[w] + 8 * (l8 + 8 * k)) = o;
        }
      }
    }
  }
}

DI void attn_item(const PV& p, int j, int kind, int seq, int h, int q0, char* smem) {
  const int tid = TIDX(), lane = tid & 63, wid = tid >> 6;
  const int il = lane & 31, hh = lane >> 5;
  const u16* Q = (const u16*)(p.ws() + OFF_B + B_Q);
  const u16* Kb = (const u16*)(p.ws() + OFF_B + B_K);
  const u16* Vt = (const u16*)(p.ws() + OFF_B + B_V);
  u16* O = (u16*)(p.ws() + OFF_A + A_O);
  const float* qhn = p.in(29) + j * 192;
  const float2* ROPE = (const float2*)(p.ws() + OFF_ROPE);
  const int Lk = kind ? 4352 : 256, nkt = Lk >> 6;
  const u16* vbase = Vt + (kind ? VT_SAMPLE_OFF + (size_t)(seq * 8 + h) * 128 * 4352 : (size_t)(seq * 8 + h) * 128 * 256);
  const int tq = q0 + wid * 32 + il;
  bf16x8 qf[12];
  {
    float v[12][8];
    float ss = 0.f;
#pragma unroll
    for (int ks = 0; ks < 12; ++ks) {
      const uint4 a = *(const uint4*)(Q + ((size_t)tq * 8 + h) * 192 + 16 * ks + 8 * hh);
      v[ks][0] = lo16(a.x); v[ks][1] = hi16(a.x); v[ks][2] = lo16(a.y); v[ks][3] = hi16(a.y);
      v[ks][4] = lo16(a.z); v[ks][5] = hi16(a.z); v[ks][6] = lo16(a.w); v[ks][7] = hi16(a.w);
#pragma unroll
      for (int e = 0; e < 8; ++e) ss += v[ks][e] * v[ks][e];
    }
    { auto rr = __builtin_amdgcn_permlane32_swap(__float_as_uint(ss), __float_as_uint(ss), false, false); ss = __uint_as_float(rr[0]) + __uint_as_float(rr[1]); }
    const float rn = rsqrtf(ss * (1.f / 192.f) + EPS);
#pragma unroll
    for (int ks = 0; ks < 12; ++ks) {
      const float4 g0 = *(const float4*)(qhn + 16 * ks + 8 * hh), g1 = *(const float4*)(qhn + 16 * ks + 8 * hh + 4);
      v[ks][0] *= rn * g0.x; v[ks][1] *= rn * g0.y; v[ks][2] *= rn * g0.z; v[ks][3] *= rn * g0.w;
      v[ks][4] *= rn * g1.x; v[ks][5] *= rn * g1.y; v[ks][6] *= rn * g1.z; v[ks][7] *= rn * g1.w;
    }
    if (kind) {
      const int tl = (tq - TP) & 4095;
#pragma unroll
      for (int part = 0; part < 2; ++part) {
        const int pos = part == 0 ? (tl >> 6) : (tl & 63);
        const float4* rp = (const float4*)(ROPE + pos * 16 + 8 * hh);
        const float4 c01 = rp[0], c23 = rp[1], c45 = rp[2], c67 = rp[3];
        const float cs[8] = {c01.x, c01.z, c23.x, c23.z, c45.x, c45.z, c67.x, c67.z};
        const float sn[8] = {c01.y, c01.w, c23.y, c23.w, c45.y, c45.w, c67.y, c67.w};
#pragma unroll
        for (int e = 0; e < 8; ++e) {
          const float x1 = v[8 + 2 * part][e], x2 = v[9 + 2 * part][e];
          v[8 + 2 * part][e] = x1 * cs[e] - x2 * sn[e];
          v[9 + 2 * part][e] = x2 * cs[e] + x1 * sn[e];
        }
      }
    }
    const float QSCALE = 1.4426950408889634f * 0.07216878364870322f;
#pragma unroll
    for (int ks = 0; ks < 12; ++ks) {
      union { bf16x8 b; unsigned w[4]; } o;
#pragma unroll
      for (int w = 0; w < 4; ++w) o.w[w] = pack2(v[ks][2 * w] * QSCALE, v[ks][2 * w + 1] * QSCALE);
      qf[ks] = o.b;
    }
  }
  f32x16 oacc[4];
#pragma unroll
  for (int a = 0; a < 4; ++a)
#pragma unroll
    for (int r = 0; r < 16; ++r) oacc[a][r] = 0.f;
  float mrun = -INFINITY, lrun = 0.f;
  const int sw = (il >> 1) & 7;
  int ko[4], vob[4];
#pragma unroll
  for (int a = 0; a < 4; ++a) ko[a] = il * 384 + (((2 * a + hh) ^ sw) << 4);
#pragma unroll
  for (int c = 0; c < 4; ++c) vob[c] = il * 128 + (((2 * c + hh) ^ sw) << 4);
  LAS unsigned char* lds = (LAS unsigned char*)smem;
  unsigned kso[3], vso[2];
#pragma unroll
  for (int i = 0; i < 3; ++i) {
    const int id = tid + 512 * i, r = id / 24, pc = id - r * 24;
    const int ch = (pc & ~7) | ((pc & 7) ^ ((r >> 1) & 7));
    kso[i] = (unsigned)(r * 3072 + ch * 16);
  }
#pragma unroll
  for (int i = 0; i < 2; ++i) {
    const int id = tid + 512 * i, dd = id >> 3, pc = id & 7;
    const int ch = pc ^ ((dd >> 1) & 7);
    vso[i] = (unsigned)(dd * Lk * 2 + ch * 16);
  }
  const unsigned ldst = (unsigned)(tid >> 6) * 1024u;
#define ATT_STAGE(kt_, s_)                                                                                      \
  {                                                                                                            \
    const int k0_ = (kt_) * 64;                                                                                \
    const int rowbase_ = kind ? (k0_ < 4096 ? TP + seq * 4096 + k0_ : T + seq * 256 + (k0_ - 4096)) : seq * 256 + k0_; \
    const char* kg_ = (const char*)(Kb + ((size_t)rowbase_ * 8 + h) * 192);                                     \
    const char* vg_ = (const char*)(vbase + k0_);                                                              \
    _Pragma("unroll") for (int i_ = 0; i_ < 3; ++i_)                                                           \
      __builtin_amdgcn_global_load_lds((const unsigned*)(kg_ + kso[i_]), (LAS unsigned*)(lds + (s_) * 40960 + ldst + i_ * 8192), 16, 0, 0); \
    _Pragma("unroll") for (int i_ = 0; i_ < 2; ++i_)                                                           \
      __builtin_amdgcn_global_load_lds((const unsigned*)(vg_ + vso[i_]), (LAS unsigned*)(lds + (s_) * 40960 + 24576 + ldst + i_ * 8192), 16, 0, 0); \
  }
  __syncthreads();
  ATT_STAGE(0, 0)
  asm volatile("s_waitcnt vmcnt(0)" ::: "memory");
  __syncthreads();
  for (int kt = 0; kt < nkt; ++kt) {
    const bool more = kt + 1 < nkt;
    if (more) ATT_STAGE(kt + 1, (kt + 1) & 1)
    const char* Ks = smem + (kt & 1) * 40960;
    const char* Vs = Ks + 24576;
    f32x16 s2[2];
    __builtin_amdgcn_s_setprio(1);
#pragma unroll
    for (int st = 0; st < 2; ++st)
#pragma unroll
      for (int r = 0; r < 16; ++r) s2[st][r] = 0.f;
#pragma unroll
    for (int ks = 0; ks < 12; ++ks)
#pragma unroll
      for (int st = 0; st < 2; ++st) {
        const bf16x8 kf = *(const bf16x8*)(Ks + ko[ks & 3] + st * 12288 + (ks >> 2) * 128);
        s2[st] = __builtin_amdgcn_mfma_f32_32x32x16_bf16(kf, qf[ks], s2[st], 0, 0, 0);
      }
    __builtin_amdgcn_s_setprio(0);
    {
      float pmax = s2[0][0];
#pragma unroll
      for (int r = 1; r < 16; ++r) pmax = fmaxf(pmax, s2[0][r]);
#pragma unroll
      for (int r = 0; r < 16; ++r) pmax = fmaxf(pmax, s2[1][r]);
      { auto rr = __builtin_amdgcn_permlane32_swap(__float_as_uint(pmax), __float_as_uint(pmax), false, false);
        pmax = fmaxf(__uint_as_float(rr[0]), __uint_as_float(rr[1])); }
      if (!__all(pmax - mrun <= 11.541560327f)) {
        const float mn = fmaxf(mrun, pmax);
        const float alpha = __builtin_amdgcn_exp2f(mrun - mn);
        mrun = mn;
        lrun *= alpha;
#pragma unroll
        for (int a = 0; a < 4; ++a)
#pragma unroll
          for (int r = 0; r < 16; ++r) oacc[a][r] *= alpha;
      }
      float psum = 0.f;
#pragma unroll
      for (int st = 0; st < 2; ++st)
#pragma unroll
        for (int r = 0; r < 16; ++r) { const float pv = __builtin_amdgcn_exp2f(s2[st][r] - mrun); s2[st][r] = pv; psum += pv; }
      lrun += psum;
    }
    __builtin_amdgcn_s_setprio(1);
#pragma unroll
    for (int st = 0; st < 2; ++st)
#pragma unroll
      for (int sb = 0; sb < 2; ++sb) {
        union { bf16x8 v; unsigned w[4]; } pb;
#pragma unroll
        for (int w = 0; w < 4; ++w) pb.w[w] = pack2(s2[st][8 * sb + 2 * w], s2[st][8 * sb + 2 * w + 1]);
#pragma unroll
        for (int dt = 0; dt < 4; ++dt) {
          const bf16x8 vf = *(const bf16x8*)(Vs + vob[2 * st + sb] + dt * 4096);
          oacc[dt] = __builtin_amdgcn_mfma_f32_32x32x16_bf16(vf, pb.v, oacc[dt], 0, 0, 0);
        }
      }
    __builtin_amdgcn_s_setprio(0);
    asm volatile("s_waitcnt vmcnt(0)" ::: "memory");
    __syncthreads();
  }
#undef ATT_STAGE
  float ltot;
  { auto rr = __builtin_amdgcn_permlane32_swap(__float_as_uint(lrun), __float_as_uint(lrun), false, false); ltot = __uint_as_float(rr[0]) + __uint_as_float(rr[1]); }
  const float inv = 1.f / ltot;
#pragma unroll
  for (int dt = 0; dt < 4; ++dt)
#pragma unroll
    for (int g = 0; g < 4; ++g) {
      const int d = dt * 32 + 8 * g + 4 * hh;
      *(uint2*)(O + (size_t)tq * 1024 + h * 128 + d) =
          pack4(oacc[dt][4 * g] * inv, oacc[dt][4 * g + 1] * inv, oacc[dt][4 * g + 2] * inv, oacc[dt][4 * g + 3] * inv);
    }
}
DI void phase_attention(const PV& p, int j, char* smem) {
  const bool xmap = gridDim.x == 256;
  const int Gq = opaque_i((int)gridDim.x);
  const int nit = xmap ? 5 : (1280 + Gq - 1) / Gq;
#pragma unroll 1
  for (int r = 0; r < nit; ++r) {
    int kind, seq, h, q0;
    if (xmap) {
      if (r < 4) {
        const int xcd = blockIdx.x & 7, slot = blockIdx.x >> 3;
        const int pair = xcd + 8 * (2 * r + (slot >> 4)), qb = slot & 15;
        kind = 1; seq = pair >> 3; h = pair & 7; q0 = TP + seq * 4096 + qb * 256;
      } else {
        kind = 0; seq = blockIdx.x >> 3; h = blockIdx.x & 7; q0 = seq * 256;
      }
    } else {
      const int it = blockIdx.x + r * gridDim.x;
      if (it >= 1280) break;
      if (it < 1024) { const int pair = it >> 4, qb = it & 15; kind = 1; seq = pair >> 3; h = pair & 7; q0 = TP + seq * 4096 + qb * 256; }
      else { const int i2 = it - 1024; kind = 0; seq = i2 >> 3; h = i2 & 7; q0 = seq * 256; }
    }
    attn_item(p, j, kind, seq, h, q0, smem);
  }
  __syncthreads();
}

DI size_t act_blk(int t, int a) { return (size_t)(t >> 8) * (256 * 2816) + (size_t)(a >> 6) * (256 * 64) + (size_t)((t & 255) * 64 + (a & 63)); }
DI float dpp_ror1(float x) { return __int_as_float(__builtin_amdgcn_update_dpp(0, __float_as_int(x), 0x121, 0xf, 0xf, false)); }
DI float dpp_ror15(float x) { return __int_as_float(__builtin_amdgcn_update_dpp(0, __float_as_int(x), 0x12F, 0xf, 0xf, false)); }
struct EpiFFN {
  u16* ACT; u16* EDGE; const float* cw; const float* cb;
  DI void operator()(const f32x4 (&acc)[2][2][4][2], int pm, int pn, int wr, int wc, int fr, int fq) const {
#pragma unroll
    for (int n = 0; n < 2; ++n) {
      const int a = pn * 128 + wc * 32 + n * 16 + fq * 4;
      const float4 w0g = *(const float4*)(cw + a), w1g = *(const float4*)(cw + 5632 + a), w2g = *(const float4*)(cw + 11264 + a), bg = *(const float4*)(cb + a);
      const float4 w0u = *(const float4*)(cw + 2816 + a), w1u = *(const float4*)(cw + 5632 + 2816 + a), w2u = *(const float4*)(cw + 11264 + 2816 + a), bu = *(const float4*)(cb + 2816 + a);
#pragma unroll
      for (int ai = 0; ai < 2; ++ai) {
        const int rbase = pm * 256 + ai * 128 + wr * 64;
        const size_t erow = (size_t)(rbase >> 6) * 4;
#pragma unroll
        for (int m = 0; m < 4; ++m) {
          const int mp = m > 0 ? m - 1 : 0, mn = m < 3 ? m + 1 : 3;
          float o[4];
#define FFN_ONE(J, C)                                                                                         \
          {                                                                                                   \
            const float g = acc[ai][0][m][n][J], u = acc[ai][1][m][n][J];                                     \
            const float gpv = m > 0 ? acc[ai][0][mp][n][J] : 0.f, gnx = m < 3 ? acc[ai][0][mn][n][J] : 0.f;   \
            const float upv = m > 0 ? acc[ai][1][mp][n][J] : 0.f, unx = m < 3 ? acc[ai][1][mn][n][J] : 0.f;   \
            const float gp = dpp_ror1(fr == 15 ? gpv : g), gn = dpp_ror15(fr == 0 ? gnx : g);                \
            const float up = dpp_ror1(fr == 15 ? upv : u), un = dpp_ror15(fr == 0 ? unx : u);                \
            const float cg = w0g.C * gp + w1g.C * g + w2g.C * gn + bg.C;                                      \
            const float cu = w0u.C * up + w1u.C * u + w2u.C * un + bu.C;                                      \
            o[J] = silu(cg) * cu;                                                                             \
          }
          FFN_ONE(0, x) FFN_ONE(1, y) FFN_ONE(2, z) FFN_ONE(3, w)
#undef FFN_ONE
          *(uint2*)(ACT + act_blk(rbase + m * 16 + fr, a)) = pack4(o[0], o[1], o[2], o[3]);
          if ((m == 0 && fr < 2) || (m == 3 && fr >= 14)) {
            const int ri = m == 0 ? fr : fr - 12;
            u16* e = EDGE + (erow + ri) * 5632 + pn * 256 + wc * 32 + n * 16 + fq * 4;
            *(uint2*)e = pack4(acc[ai][0][m][n][0], acc[ai][0][m][n][1], acc[ai][0][m][n][2], acc[ai][0][m][n][3]);
            *(uint2*)(e + 128) = pack4(acc[ai][1][m][n][0], acc[ai][1][m][n][1], acc[ai][1][m][n][2], acc[ai][1][m][n][3]);
          }
        }
      }
    }
  }
};
DI void phase_ffn_up(const PV& p, int l, char* smem) {
  EpiFFN E;
  E.ACT = (u16*)(p.ws() + OFF_B + B_ACT); E.EDGE = (u16*)(p.ws() + OFF_EDGE);
  E.cw = p.in(33) + (size_t)l * 3 * 5632; E.cb = p.in(34) + (size_t)l * 5632;
  TileSched<160, 22, 16, 8, 4, 16, 2> S; S.init();
  gemm8(smem, (const u16*)(p.ws() + OFF_A + A_H), (const u16*)(p.ws() + OFF_WUP), 1024, S, E);
}
DI void phase_ffn_fix(const PV& p, int l) {
  const u16* EDGE = (const u16*)(p.ws() + OFF_EDGE);
  u16* ACT = (u16*)(p.ws() + OFF_B + B_ACT);
  const float* cw = p.in(33) + (size_t)l * 3 * 5632;
  const float* cb = p.in(34) + (size_t)l * 5632;
  const unsigned gtid = blockIdx.x * blockDim.x + (unsigned)TIDX(), gsz = gridDim.x * blockDim.x;
  for (unsigned idx = gtid; idx < 640u * 2u * 704u; idx += gsz) {
    const unsigned rq = idx / 704u;
    const int a = (int)(idx - rq * 704u) * 4, rr = (int)rq, which = rr & 1, sidx = rr >> 1;
    const int t = sidx * 64 + (which ? 63 : 0);
    const int tb = which ? t + 1 : t;
    const bool seqb = tb < TP ? (tb & 255) == 0 : ((tb - TP) & 4095) == 0;
    if (seqb) continue;
    const int pc = (a >> 7) * 256 + (a & 127);
    const u16 *pr, *cu, *nx;
    if (which == 0) { pr = EDGE + ((size_t)(sidx - 1) * 4 + 3) * 5632; cu = EDGE + ((size_t)sidx * 4 + 0) * 5632; nx = EDGE + ((size_t)sidx * 4 + 1) * 5632; }
    else { pr = EDGE + ((size_t)sidx * 4 + 2) * 5632; cu = EDGE + ((size_t)sidx * 4 + 3) * 5632; nx = EDGE + ((size_t)(sidx + 1) * 4 + 0) * 5632; }
    const uint2 gp = *(const uint2*)(pr + pc), gc = *(const uint2*)(cu + pc), gn = *(const uint2*)(nx + pc);
    const uint2 up = *(const uint2*)(pr + pc + 128), uc = *(const uint2*)(cu + pc + 128), un = *(const uint2*)(nx + pc + 128);
    const float4 w0g = *(const float4*)(cw + a), w1g = *(const float4*)(cw + 5632 + a), w2g = *(const float4*)(cw + 11264 + a), bg = *(const float4*)(cb + a);
    const float4 w0u = *(const float4*)(cw + 2816 + a), w1u = *(const float4*)(cw + 5632 + 2816 + a), w2u = *(const float4*)(cw + 11264 + 2816 + a), bu = *(const float4*)(cb + 2816 + a);
    const float g0 = w0g.x * lo16(gp.x) + w1g.x * lo16(gc.x) + w2g.x * lo16(gn.x) + bg.x, u0 = w0u.x * lo16(up.x) + w1u.x * lo16(uc.x) + w2u.x * lo16(un.x) + bu.x;
    const float g1 = w0g.y * hi16(gp.x) + w1g.y * hi16(gc.x) + w2g.y * hi16(gn.x) + bg.y, u1 = w0u.y * hi16(up.x) + w1u.y * hi16(uc.x) + w2u.y * hi16(un.x) + bu.y;
    const float g2 = w0g.z * lo16(gp.y) + w1g.z * lo16(gc.y) + w2g.z * lo16(gn.y) + bg.z, u2 = w0u.z * lo16(up.y) + w1u.z * lo16(uc.y) + w2u.z * lo16(un.y) + bu.z;
    const float g3 = w0g.w * hi16(gp.y) + w1g.w * hi16(gc.y) + w2g.w * hi16(gn.y) + bg.w, u3 = w0u.w * hi16(up.y) + w1u.w * hi16(uc.y) + w2u.w * hi16(un.y) + bu.w;
    *(uint2*)(ACT + act_blk(t, a)) = pack4(silu(g0) * u0, silu(g1) * u1, silu(g2) * u2, silu(g3) * u3);
  }
}

#ifndef PH
#define RUN(k, ...) __VA_ARGS__
#else
#define RUN(k, ...) if (PH == k) { __VA_ARGS__ }
#endif
extern "C" __global__ void __launch_bounds__(512) fwd_megakernel(Params kp) {
  extern __shared__ __attribute__((aligned(16))) char smem[];
  cg::grid_group grid = cg::this_grid();
  if (TIDX() == 0) {
    unsigned long long* t = (unsigned long long*)(smem + PARM_OFF);
#pragma unroll
    for (int k = 0; k < 36; ++k) t[k] = (unsigned long long)kp.in[k];
    t[36] = (unsigned long long)kp.out; t[37] = (unsigned long long)kp.ws;
  }
  __syncthreads();
  PV p; p.smem = smem;
  unsigned* bar = (unsigned*)(p.ws() + OFF_BAR);
  if (TIDX() == 0) { *(unsigned*)(smem + PARM_OFF + 512) = 0u; *(unsigned*)(smem + PARM_OFF + 516) = 0u; }
  __syncthreads();
  const XcdBarrier xb = xcd_barrier_post(bar, (volatile LASB unsigned*)(smem + PARM_OFF + 512));
  RUN(0, phase_prep(p, smem);)
  grid.sync();
  RUN(1, phase_filters(p, smem);)
  for (int l = 0; l < 4; ++l) {
    const int i = l >> 1;
    RUN(2, phase_norm(p, l, 0, l);)
    RUN(0, if (l > 0) { int base = 0; convert_ffn_weights(p, l, smem, base); })
    xcd_barrier(xb);
    if ((l & 1) == 0) {
      RUN(3, phase_mix_in(p, i, smem);)
      xcd_barrier(xb);
      RUN(4, phase_sgu(p, i, smem);)
      RUN(5, phase_conv(p, i, 0, smem);)
      xcd_barrier(xb);
      RUN(5, phase_conv(p, i, 1, smem);)
      xcd_barrier(xb);
      RUN(6, phase_ztrans(p, smem);)
      xcd_barrier(xb);
      RUN(7, phase_resid_gemm(p, l, l, (const u16*)(p.ws() + OFF_B + B_MIX), 1024, (const u16*)(p.ws() + OFF_WMIXOUT) + (size_t)i * 1024 * 1024, 2048, smem);)
      xcd_barrier(xb);
    } else {
      RUN(8, phase_dqkv(p, i, smem);)
      xcd_barrier(xb);
      RUN(9, phase_mla_norms(p, i);)
      xcd_barrier(xb);
      RUN(10, phase_uq_ukv(p, i, smem);)
      xcd_barrier(xb);
      RUN(11, phase_finalize(p, i);)
      xcd_barrier(xb);
      RUN(12, phase_attention(p, i, smem);)
      xcd_barrier(xb);
      RUN(7, phase_resid_gemm(p, l, l, (const u16*)(p.ws() + OFF_A + A_O), 1024, (const u16*)(p.ws() + OFF_WO) + (size_t)i * 1024 * 1024, 2048, smem);)
      xcd_barrier(xb);
    }
    RUN(2, phase_norm(p, l, 1, 1);)
    xcd_barrier(xb);
    RUN(13, phase_ffn_up(p, l, smem);)
    xcd_barrier(xb);
    RUN(14, phase_ffn_fix(p, l);)
    xcd_barrier(xb);
    RUN(7, phase_resid_gemm(p, l, 1, (const u16*)(p.ws() + OFF_B + B_ACT), 2816, (const u16*)(p.ws() + OFF_WDOWN), 5120, smem);)
    xcd_barrier(xb);
  }
}

extern "C" void kernel_launch(void* const* d_in, const int* in_sizes, int n_in,
                              void* d_out, int out_size, void* d_ws, size_t ws_size,
                              hipStream_t stream) {
  static int grid_blocks = 0;
  if (!grid_blocks) {
    int dev = 0, cus = 0, per_cu = 0;
    (void)hipGetDevice(&dev);
    (void)hipDeviceGetAttribute(&cus, hipDeviceAttributeMultiprocessorCount, dev);
    (void)hipFuncSetAttribute((const void*)fwd_megakernel, hipFuncAttributeMaxDynamicSharedMemorySize, (int)LDS_BYTES);
    (void)hipOccupancyMaxActiveBlocksPerMultiprocessor(&per_cu, fwd_megakernel, 512, LDS_BYTES);
    if (per_cu < 1) per_cu = 1;
    if (per_cu > 1) per_cu = 1;
    grid_blocks = cus * per_cu;
  }
  if (ws_size < WS_NEED) fprintf(stderr, "workspace too small: %zu < %zu\n", ws_size, (size_t)WS_NEED);
  Params p{};
  for (int i = 0; i < 36; ++i) p.in[i] = (const float*)d_in[i];
  p.out = (float*)d_out;
  p.ws = (char*)d_ws;
  (void)hipMemsetAsync((char*)d_ws + OFF_BAR, 0, 16384, stream);
  void* args[] = {&p};
  hipError_t e = hipLaunchCooperativeKernel((void*)fwd_megakernel, dim3(grid_blocks), dim3(512), args, LDS_BYTES, stream);
  if (e != hipSuccess) fprintf(stderr, "cooperative launch failed: %s (grid %d)\n", hipGetErrorString(e), grid_blocks);
}
```

```cpp
#include <hip/hip_runtime.h>
#include <hip/hip_cooperative_groups.h>
#include <cstdio>
namespace cg = cooperative_groups;

typedef unsigned short u16;
using bf16x8 = __attribute__((ext_vector_type(8))) short;
using f32x4 = __attribute__((ext_vector_type(4))) float;
using f32x16 = __attribute__((ext_vector_type(16))) float;
#define DI __device__ __forceinline__

constexpr int T = 40960;
constexpr int TP = 8192;
constexpr int TK = 43008;
constexpr float EPS = 1e-6f;
constexpr size_t LDS_BYTES = 139264;

constexpr size_t OFF_WMIXIN = 0;
constexpr size_t OFF_WMIXOUT = OFF_WMIXIN + (size_t)2 * 2560 * 1024 * 2;
constexpr size_t OFF_WDQKV = OFF_WMIXOUT + (size_t)2 * 1024 * 1024 * 2;
constexpr size_t OFF_WUQ = OFF_WDQKV + (size_t)2 * 1024 * 1024 * 2;
constexpr size_t OFF_WUKV = OFF_WUQ + (size_t)2 * 1536 * 512 * 2;
constexpr size_t OFF_WO = OFF_WUKV + (size_t)2 * 2048 * 256 * 2;
constexpr size_t OFF_WSGU = OFF_WO + (size_t)2 * 1024 * 1024 * 2;
constexpr size_t OFF_WUP = OFF_WSGU + (size_t)2 * 4 * 128 * 128 * 2;
constexpr size_t OFF_WDOWN = OFF_WUP + (size_t)5632 * 1024 * 2;
constexpr size_t OFF_MOD = OFF_WDOWN + (size_t)1024 * 2816 * 2;
constexpr size_t OFF_FILT = OFF_MOD + (size_t)4 * 9 * 6144 * 4;
constexpr size_t OFF_H2 = OFF_FILT + (size_t)2 * 2 * 512 * 4352 * 2;
constexpr size_t OFF_EDGE = OFF_H2 + (size_t)2 * 4352 * 64 * 4;
constexpr size_t OFF_KR = OFF_EDGE + (size_t)640 * 4 * 5632 * 2;
constexpr size_t OFF_A = OFF_KR + (size_t)TK * 64 * 2;
constexpr size_t OFF_B = OFF_A + (size_t)T * 1024 * 2;
constexpr size_t OFF_BAR = OFF_B + (size_t)346030080;
constexpr size_t OFF_ROPE = OFF_BAR + 16384;
constexpr size_t WS_NEED = OFF_ROPE + 64 * 16 * 8;
constexpr size_t A_H = 0, A_Z1 = 0, A_Z2 = (size_t)T * 512 * 2, A_QN = 0, A_CKV = (size_t)T * 512 * 2, A_O = 0;
constexpr size_t B_VT = 0, B_PRT = (size_t)T * 512 * 2, B_MIX = B_PRT + (size_t)T * 1536 * 2;
constexpr size_t B_DQKV = 0, B_Q = 0, B_K = (size_t)T * 1536 * 2, B_V = B_K + (size_t)TK * 1536 * 2;
constexpr size_t B_ACT = 0;
constexpr size_t VT_SAMPLE_OFF = (size_t)32 * 8 * 128 * 256;

struct Params {
  const float* in[36];
  float* out;
  char* ws;
};


constexpr int PARM_OFF = 138240;
struct PV {
  char* smem;
  DI unsigned long long ld(int k) const {
    int off = PARM_OFF + 8 * k;
    asm volatile("" : "+v"(off));
    const unsigned long long v = *(const unsigned long long*)(smem + off);
    const unsigned lo = __builtin_amdgcn_readfirstlane((unsigned)v), hi = __builtin_amdgcn_readfirstlane((unsigned)(v >> 32));
    return ((unsigned long long)hi << 32) | lo;
  }
  DI const float* in(int k) const { return (const float*)(const __attribute__((address_space(1))) float*)ld(k); }
  DI float* out() const { return (float*)(__attribute__((address_space(1))) float*)ld(36); }
  DI char* ws() const { return (char*)(__attribute__((address_space(1))) char*)ld(37); }
};

DI int TIDX() { int t = (int)__builtin_amdgcn_workitem_id_x(); asm volatile("" : "+v"(t)); return t; }
DI u16 f2bf(float x) { unsigned u = __float_as_uint(x); u += 0x7fffu + ((u >> 16) & 1u); return (u16)(u >> 16); }
DI float bf2f(u16 h) { return __uint_as_float(((unsigned)h) << 16); }
DI unsigned pack2(float a, float b) { unsigned r; asm("v_cvt_pk_bf16_f32 %0, %1, %2" : "=v"(r) : "v"(a), "v"(b)); return r; }
DI uint2 pack4(float a, float b, float c, float d) { uint2 r; r.x = pack2(a, b); r.y = pack2(c, d); return r; }
DI float lo16(unsigned w) { return __uint_as_float(w << 16); }
DI float hi16(unsigned w) { return __uint_as_float(w & 0xffff0000u); }
DI float gelu_tanh(float x) { const float y = x * (1.f + 0.044715f * x * x); return x * __builtin_amdgcn_rcpf(1.f + __builtin_amdgcn_exp2f(-2.302208198f * y)); }
DI float silu(float x) { return x * __builtin_amdgcn_rcpf(1.f + __builtin_amdgcn_exp2f(-1.4426950409f * x)); }
DI int condrow(int m) { return m < TP ? 0 : 1 + ((m - TP) >> 12); }
template <int MASK> DI float shx(float v, int lane) {
  if (MASK == 32) return __int_as_float(__builtin_amdgcn_ds_bpermute((lane ^ 32) << 2, __float_as_int(v)));
  return __int_as_float(__builtin_amdgcn_ds_swizzle(__float_as_int(v), (MASK << 10) | 0x1f));
}
DI float wave_sum(float v, int lane) {
  v += shx<32>(v, lane); v += shx<16>(v, lane); v += shx<8>(v, lane);
  v += shx<4>(v, lane); v += shx<2>(v, lane); v += shx<1>(v, lane); return v;
}
DI int opaque_i(int x) { asm volatile("" : "+s"(x)); return x; }
DI int first_unit(int base) { const int G = opaque_i((int)gridDim.x); int r = (int)blockIdx.x - (base % G); if (r < 0) r += G; return r; }
DI const float* xin_row(const PV& p, int l, int m) {
  if (l == 0) return m < TP ? p.in(0) + (size_t)m * 1024 : p.in(1) + (size_t)(m - TP) * 1024;
  return p.out() + (size_t)m * 1024;
}


#define XB_TMO      128
#define XB_XCNT(j)  (256  + 64 * (j))
#define XB_XSUB(j)  (1280 + 64 * (j))
#define XB_XGEN(j)  (2304 + 64 * (j))
#define XB_TOP      3328
#define XB_TOPGEN   3392
#define XB_SPIN_CAP (1u << 22)
#define LASB __attribute__((address_space(3)))
DI unsigned xb_ld(unsigned* p) { return __hip_atomic_load(p, __ATOMIC_RELAXED, __HIP_MEMORY_SCOPE_AGENT); }
DI unsigned xb_add(unsigned* p, unsigned v) { return __hip_atomic_fetch_add(p, v, __ATOMIC_RELAXED, __HIP_MEMORY_SCOPE_AGENT); }
DI unsigned xb_xcc_id() { return (unsigned)__builtin_amdgcn_s_getreg((3 << 11) | 20) & 0xFu; }
#define XB_SPIN(cond, bar) do { unsigned _sp = 0; while (cond) { __builtin_amdgcn_s_sleep(1); \
    if ((++_sp & 255u) == 0u) { if (xb_ld(&(bar)[XB_TMO])) break; if (_sp > XB_SPIN_CAP) { atomicAdd(&(bar)[XB_TMO], 1u); break; } } } } while (0)
struct XcdBarrier { unsigned* bar; unsigned x; volatile LASB unsigned* st; };
DI XcdBarrier xcd_barrier_post(unsigned* bar, volatile LASB unsigned* st) {
  XcdBarrier b; b.bar = bar; b.x = xb_xcc_id(); b.st = st;
  if (TIDX() == 0) (void)xb_add(&bar[XB_XCNT(b.x)], 1u);
  return b;
}
DI void xcd_barrier_complete(unsigned* bar, unsigned x, unsigned& nloc, unsigned& nx) {
  const unsigned G = gridDim.x;
  unsigned sum, cnt, mine, sp = 0u;
  for (;;) {
    sum = 0u; cnt = 0u; mine = 0u;
#pragma unroll
    for (unsigned j = 0; j < 16; ++j) { const unsigned c = xb_ld(&bar[XB_XCNT(j)]); sum += c; cnt += (c > 0u) ? 1u : 0u; mine = (j == x) ? c : mine; }
    if (sum == G) break;
    __builtin_amdgcn_s_sleep(1);
    if ((++sp & 255u) == 0u) { if (xb_ld(&bar[XB_TMO])) break; if (sp > XB_SPIN_CAP) { atomicAdd(&bar[XB_TMO], 1u); break; } }
  }
  nloc = mine > 0u ? mine : 1u; nx = cnt > 0u ? cnt : 1u;
}
DI void xcd_barrier(const XcdBarrier& b) {
  asm volatile("s_waitcnt vmcnt(0)" ::: "memory");
  __syncthreads();
  if (TIDX() == 0) {
    unsigned* bar = b.bar;
    __builtin_amdgcn_s_waitcnt(0);
    unsigned nloc = b.st[0], nx = b.st[1];
    if (nloc == 0u) { xcd_barrier_complete(bar, b.x, nloc, nx); b.st[0] = nloc; b.st[1] = nx; }
    const unsigned old = xb_add(&bar[XB_XSUB(b.x)], 1u);
    const unsigned gen = old / nloc;
    if (old + 1u == (gen + 1u) * nloc) {
      __builtin_amdgcn_fence(__ATOMIC_RELEASE, "agent");
      asm volatile("s_waitcnt vmcnt(0)" ::: "memory");
      const unsigned og = xb_add(&bar[XB_TOP], 1u);
      const unsigned tg = og / nx;
      if (og + 1u == (tg + 1u) * nx) xb_add(&bar[XB_TOPGEN], 1u);
      else XB_SPIN(xb_ld(&bar[XB_TOPGEN]) == tg, bar);
      __builtin_amdgcn_fence(__ATOMIC_ACQUIRE, "agent");
      xb_add(&bar[XB_XGEN(b.x)], 1u);
      asm volatile("s_waitcnt vmcnt(0)" ::: "memory");
    } else {
      XB_SPIN(xb_ld(&bar[XB_XGEN(b.x)]) == gen, bar);
      __builtin_amdgcn_fence(__ATOMIC_ACQUIRE, "agent");
      asm volatile("s_waitcnt vmcnt(0)" ::: "memory");
    }
  }
  __syncthreads();
}

template <int MODE>
DI int rowmap(int n, int row0) {
  if (MODE == 0) return n + row0;
  return n < 2816 ? (n >> 7) * 256 + (n & 127) : ((n - 2816) >> 7) * 256 + 128 + ((n - 2816) & 127);
}
template <int MODE, int NJ = 4>
DI void convT(const float* __restrict__ src, u16* __restrict__ dst, int K, int N, int row0, char* smem, int& base) {
  u16* tl = (u16*)smem;
  const int tid = TIDX();
  const int nN = N / (64 * NJ), nunits = (K >> 6) * nN;
  for (int u = first_unit(base); u < nunits; u += gridDim.x) {
    const int k0 = (u / nN) << 6, n0 = (u % nN) * (64 * NJ);
    float4 v[2][NJ];
#pragma unroll
    for (int i = 0; i < 2; ++i)
#pragma unroll
      for (int j = 0; j < NJ; ++j)
        v[i][j] = *(const float4*)(src + (size_t)(k0 + (tid >> 4) + 32 * i) * N + n0 + (tid & 15) * 4 + 64 * j);
#pragma unroll
    for (int i = 0; i < 2; ++i)
#pragma unroll
      for (int j = 0; j < NJ; ++j) {
        const int r = (tid >> 4) + 32 * i, c4 = (tid & 15) * 4 + 64 * j;
        tl[(c4 + 0) * 72 + r] = f2bf(v[i][j].x); tl[(c4 + 1) * 72 + r] = f2bf(v[i][j].y);
        tl[(c4 + 2) * 72 + r] = f2bf(v[i][j].z); tl[(c4 + 3) * 72 + r] = f2bf(v[i][j].w);
      }
    __syncthreads();
#pragma unroll
    for (int j = 0; j < NJ; ++j) {
      const int n = (tid >> 3) + 64 * j, kc = (tid & 7) * 8;
      const uint4 o = *(const uint4*)(tl + n * 72 + kc);
      { const int rr = rowmap<MODE>(n0 + n, row0);
        *(uint4*)(dst + (size_t)(rr >> 8) * 256 * K + (size_t)(k0 >> 6) * (256 * 64) + (rr & 255) * 64 + kc) = o; }
    }
    __syncthreads();
  }
  base += nunits;
}

DI void convert_ffn_weights(const PV& p, int l, char* smem, int& base) {
  convT<1>(p.in(32) + (size_t)l * 1024 * 5632, (u16*)(p.ws() + OFF_WUP), 1024, 5632, 0, smem, base);
  convT<0>(p.in(35) + (size_t)l * 2816 * 1024, (u16*)(p.ws() + OFF_WDOWN), 2816, 1024, 0, smem, base);
}

DI void phase_prep(const PV& p, char* smem) {
  const int tid = TIDX();
  int base = 0;
  char* ws = p.ws();
  for (int i = 0; i < 2; ++i) {
    convT<0>(p.in(9) + (size_t)i * 1024 * 2560, (u16*)(ws + OFF_WMIXIN) + (size_t)i * 2560 * 1024, 1024, 2560, 0, smem, base);
    convT<0>(p.in(22) + (size_t)i * 1024 * 1024, (u16*)(ws + OFF_WMIXOUT) + (size_t)i * 1024 * 1024, 1024, 1024, 0, smem, base);
    convT<0>(p.in(23) + (size_t)i * 1024 * 512, (u16*)(ws + OFF_WDQKV) + (size_t)i * 1024 * 1024, 1024, 512, 0, smem, base);
    convT<0, 1>(p.in(26) + (size_t)i * 1024 * 320, (u16*)(ws + OFF_WDQKV) + (size_t)i * 1024 * 1024, 1024, 320, 512, smem, base);
    convT<0>(p.in(25) + (size_t)i * 512 * 1536, (u16*)(ws + OFF_WUQ) + (size_t)i * 1536 * 512, 512, 1536, 0, smem, base);
    convT<0>(p.in(28) + (size_t)i * 256 * 2048, (u16*)(ws + OFF_WUKV) + (size_t)i * 2048 * 256, 256, 2048, 0, smem, base);
    convT<0>(p.in(31) + (size_t)i * 1024 * 1024, (u16*)(ws + OFF_WO) + (size_t)i * 1024 * 1024, 1024, 1024, 0, smem, base);
  }
  convert_ffn_weights(p, 0, smem, base);
  {
    const long gtid = (long)blockIdx.x * blockDim.x + tid, gsz = (long)gridDim.x * blockDim.x;
    for (long i = gtid; i < 2 * 192 * 1024; i += gsz) {
      const int j = (int)(i / (192 * 1024)), rem = (int)(i % (192 * 1024)), rr = 832 + (rem >> 10), k = rem & 1023;
      ((u16*)(ws + OFF_WDQKV))[(size_t)j * 1024 * 1024 + (size_t)(rr >> 8) * 256 * 1024 + (size_t)(k >> 6) * (256 * 64) + (rr & 255) * 64 + (k & 63)] = 0;
    }
    for (long i = gtid; i < 2 * 4 * 128 * 128; i += gsz) ((u16*)(ws + OFF_WSGU))[i] = f2bf(p.in(10)[i]);
    for (long i = gtid; i < 64 * 16; i += gsz) {
      const int pos = (int)(i >> 4), f = (int)(i & 15);
      const float inv = exp2f(-(float)f * (13.287712379549449f / 16.f));
      float sn, cs;
      sincosf((float)pos * inv, &sn, &cs);
      ((float2*)(ws + OFF_ROPE))[i] = make_float2(cs, sn);
    }
  }
  {
    float* sc = (float*)smem;
    float* part = sc + 9 * 1024;
    __syncthreads();
    for (int i = tid; i < 9 * 1024; i += 512) {
      const int r = i >> 10, k = i & 1023;
      const float c = r == 0 ? p.in(5)[k] : p.in(4)[(r - 1) * 1024 + k];
      sc[i] = silu(c);
    }
    __syncthreads();
    float* MOD = (float*)(ws + OFF_MOD);
    const int nunits = 4 * 96;
    for (int u = first_unit(base); u < nunits; u += gridDim.x) {
      const int l = u / 96, n0 = (u % 96) * 64;
      const int col = n0 + (tid & 63), kg = tid >> 6;
      float acc[9];
#pragma unroll
      for (int r = 0; r < 9; ++r) acc[r] = 0.f;
      const float* w = p.in(6) + (size_t)l * 1024 * 6144 + col;
#pragma unroll 16
      for (int k = kg * 128; k < kg * 128 + 128; ++k) {
        const float wv = w[(size_t)k * 6144];
#pragma unroll
        for (int r = 0; r < 9; ++r) acc[r] += sc[r * 1024 + k] * wv;
      }
#pragma unroll
      for (int r = 0; r < 9; ++r) part[(kg * 9 + r) * 64 + (tid & 63)] = acc[r];
      __syncthreads();
      for (int i = tid; i < 576; i += 512) {
        const int r = i >> 6, cc = i & 63;
        float s = p.in(7)[l * 6144 + n0 + cc];
#pragma unroll
        for (int g = 0; g < 8; ++g) s += part[(g * 9 + r) * 64 + cc];
        MOD[(size_t)(l * 9 + r) * 6144 + n0 + cc] = s;
      }
      __syncthreads();
    }
    base += nunits;
  }
  {
    float* zf = (float*)smem;
    float* h1 = zf + 8 * 36;
    float* H2 = (float*)(ws + OFF_H2);
    const int nunits = 2 * 544;
    for (int u = first_unit(base); u < nunits; u += gridDim.x) {
      const int i = u / 544, tg0 = (u % 544) * 8;
      __syncthreads();
      if (tid < 8 * 33) {
        const int tt = tid / 33, e = tid % 33;
        const int tg = tg0 + tt;
        const float L = tg < 256 ? 256.f : 4096.f;
        const float t = tg < 256 ? (float)tg : (float)(tg - 256);
        const float tn = t / L;
        float v;
        if (e == 0) v = tn;
        else if (e <= 16) v = sinf((6.283185307179586f * tn) * (float)e);
        else v = cosf((6.283185307179586f * tn) * (float)(e - 16));
        zf[tt * 36 + e] = v;
      }
      __syncthreads();
      const int tt = tid >> 6, jj = tid & 63;
      const float fr = p.in(19)[i * 64 + jj];
      {
        float a = p.in(15)[i * 64 + jj];
        const float* w1 = p.in(14) + (size_t)i * 33 * 64 + jj;
        for (int e = 0; e < 33; ++e) a += zf[tt * 36 + e] * w1[e * 64];
        h1[tt * 64 + jj] = sinf(fr * a);
      }
      __syncthreads();
      {
        float a = p.in(17)[i * 64 + jj];
        const float* w2 = p.in(16) + (size_t)i * 64 * 64 + jj;
        for (int e = 0; e < 64; ++e) a += h1[tt * 64 + e] * w2[e * 64];
        H2[((size_t)i * 4352 + tg0 + tt) * 64 + jj] = sinf(fr * a);
      }
    }
    base += nunits;
    __syncthreads();
  }
}

DI void phase_filters(const PV& p, char* smem) {
  const int tid = TIDX();
  float* w3s = (float*)smem;
  float* red = w3s + 512;
  float* nrm = red + 512;
  float* hbuf = nrm + 8;
  const float* H2 = (const float*)(p.ws() + OFF_H2);
  u16* FILT = (u16*)(p.ws() + OFF_FILT);
  for (int u = blockIdx.x; u < 512; u += gridDim.x) {
    const int kind = (u >> 7) & 1, i = u >> 8, cg8 = (u & 127) * 8;
    const int L = kind ? 4096 : 256, tbase = kind ? 256 : 0;
    __syncthreads();
    { const int j = tid >> 3, cc = tid & 7; w3s[j * 8 + cc] = p.in(18)[((size_t)i * 64 + j) * 1024 + cg8 + cc]; }
    __syncthreads();
    const int cc = tid & 7, tq = tid >> 3;
    const int col = cg8 + cc, o = col >> 9, c = col & 511;
    const float dec = fabsf(p.in(20)[(i * 2 + o) * 512 + c]);
    float asum = 0.f;
    for (int t = tq; t < L; t += 64) {
      const float4* hr = (const float4*)(H2 + ((size_t)i * 4352 + tbase + t) * 64);
      float a = 0.f;
#pragma unroll
      for (int j4 = 0; j4 < 16; ++j4) {
        const float4 hv = hr[j4];
        a += hv.x * w3s[(j4 * 4 + 0) * 8 + cc]; a += hv.y * w3s[(j4 * 4 + 1) * 8 + cc];
        a += hv.z * w3s[(j4 * 4 + 2) * 8 + cc]; a += hv.w * w3s[(j4 * 4 + 3) * 8 + cc];
      }
      const float dist = fabsf((float)(t - L / 2)) / (float)L;
      a *= expf(-dec * dist);
      hbuf[cc * L + t] = a;
      asum += fabsf(a);
    }
    red[tid] = asum;
    __syncthreads();
    if (tid < 8) { float s = 0.f; for (int q = 0; q < 64; ++q) s += red[q * 8 + tid]; nrm[tid] = 1.f / (s + EPS); }
    __syncthreads();
    const int lgL = kind ? 12 : 8;
    for (int idx = tid; idx < 8 * L; idx += 512) {
      const int c2 = idx >> lgL, t = idx & (L - 1);
      const int col2 = cg8 + c2, o2 = col2 >> 9, cch = col2 & 511;
      FILT[((size_t)(i * 2 + o2) * 512 + cch) * 4352 + tbase + t] = f2bf(hbuf[c2 * L + t] * nrm[c2]);
    }
  }
  __syncthreads();
}

DI void phase_norm(const PV& p, int l, int part, int lx) {
  const int tid_ = TIDX(); const int lane = tid_ & 63, wid = tid_ >> 6;
  const float* MOD = (const float*)(p.ws() + OFF_MOD);
  const float* g = p.in(8) + (size_t)(l * 2 + part) * 1024;
  u16* H = (u16*)(p.ws() + OFF_A + A_H);
  const int stride = gridDim.x * 8;
  for (int row0 = blockIdx.x * 8 + wid; row0 < T; row0 += 2 * stride) {
    float4 v[2][4];
#pragma unroll
    for (int w = 0; w < 2; ++w) {
      const int row = row0 + w * stride;
      if (row < T) {
        const float* xr = xin_row(p, lx, row);
#pragma unroll
        for (int i = 0; i < 4; ++i) v[w][i] = *(const float4*)(xr + (i * 64 + lane) * 4);
      }
    }
#pragma unroll
    for (int w = 0; w < 2; ++w) {
      const int row = row0 + w * stride;
      if (row < T) {
        float ss = 0.f;
#pragma unroll
        for (int i = 0; i < 4; ++i) ss += v[w][i].x * v[w][i].x + v[w][i].y * v[w][i].y + v[w][i].z * v[w][i].z + v[w][i].w * v[w][i].w;
        ss = wave_sum(ss, lane);
        const float r = rsqrtf(ss * (1.f / 1024.f) + EPS);
        const float* mr = MOD + (size_t)(l * 9 + condrow(row)) * 6144 + part * 3072;
#pragma unroll
        for (int i = 0; i < 4; ++i) {
          const int k = (i * 64 + lane) * 4;
          const float4 gv = *(const float4*)(g + k), sh = *(const float4*)(mr + k), sc = *(const float4*)(mr + 1024 + k);
          const float a = v[w][i].x * r * gv.x * (1.f + sc.x) + sh.x;
          const float b = v[w][i].y * r * gv.y * (1.f + sc.y) + sh.y;
          const float c = v[w][i].z * r * gv.z * (1.f + sc.z) + sh.z;
          const float d = v[w][i].w * r * gv.w * (1.f + sc.w) + sh.w;
          *(uint2*)(H + (size_t)row * 1024 + k) = pack4(a, b, c, d);
        }
      }
    }
  }
}

template <bool SWAP, class Epi, class Pre>
DI void gemm_tile(const u16* A, int lda, const u16* Bt, int ldb, int K, int m0, int n0, char* smem, Epi epi, Pre pre) {
  const int tid = TIDX(), lane = tid & 63, wid = tid >> 6;
  const int wm = wid >> 1, wn = wid & 1, fr = lane & 15, fq = lane >> 4;
  const int lrow = tid >> 3, kc = tid & 7;
  const u16* ga = A + (size_t)(m0 + lrow) * lda + kc * 8;
  const u16* gb = Bt + (size_t)(n0 + lrow) * ldb + kc * 8;
  const int soff = lrow * 128 + ((kc ^ (lrow & 7)) << 4);
  uint4 ra[4], rb[2];
  f32x4 acc[4][4];
#pragma unroll
  for (int i = 0; i < 4; ++i)
#pragma unroll
    for (int j = 0; j < 4; ++j) acc[i][j] = f32x4{0.f, 0.f, 0.f, 0.f};
  const int nk = K >> 6;
#pragma unroll
  for (int i = 0; i < 4; ++i) ra[i] = *(const uint4*)(ga + (size_t)(64 * i) * lda);
#pragma unroll
  for (int i = 0; i < 2; ++i) rb[i] = *(const uint4*)(gb + (size_t)(64 * i) * ldb);
#pragma unroll
  for (int i = 0; i < 4; ++i) *(uint4*)(smem + soff + i * 8192) = ra[i];
#pragma unroll
  for (int i = 0; i < 2; ++i) *(uint4*)(smem + 32768 + soff + i * 8192) = rb[i];
  __syncthreads();
  for (int kt = 0; kt < nk; ++kt) {
    const bool more = kt + 1 < nk;
    if (more) {
      const int k0 = (kt + 1) << 6;
#pragma unroll
      for (int i = 0; i < 4; ++i) ra[i] = *(const uint4*)(ga + (size_t)(64 * i) * lda + k0);
#pragma unroll
      for (int i = 0; i < 2; ++i) rb[i] = *(const uint4*)(gb + (size_t)(64 * i) * ldb + k0);
    }
    const char* sa = smem + (kt & 1) * 49152;
    const char* sb = sa + 32768;
#pragma unroll
    for (int ks = 0; ks < 2; ++ks) {
      bf16x8 af[4], bfv[4];
      const int co = ((ks * 4 + fq) ^ (fr & 7)) << 4;
#pragma unroll
      for (int mi = 0; mi < 4; ++mi) af[mi] = *(const bf16x8*)(sa + (wm * 64 + mi * 16 + fr) * 128 + co);
#pragma unroll
      for (int ni = 0; ni < 4; ++ni) bfv[ni] = *(const bf16x8*)(sb + (wn * 64 + ni * 16 + fr) * 128 + co);
#pragma unroll
      for (int mi = 0; mi < 4; ++mi)
#pragma unroll
        for (int ni = 0; ni < 4; ++ni)
          acc[mi][ni] = SWAP ? __builtin_amdgcn_mfma_f32_16x16x32_bf16(bfv[ni], af[mi], acc[mi][ni], 0, 0, 0)
                             : __builtin_amdgcn_mfma_f32_16x16x32_bf16(af[mi], bfv[ni], acc[mi][ni], 0, 0, 0);
    }
    if (more) {
      char* da = smem + ((kt + 1) & 1) * 49152;
#pragma unroll
      for (int i = 0; i < 4; ++i) *(uint4*)(da + soff + i * 8192) = ra[i];
#pragma unroll
      for (int i = 0; i < 2; ++i) *(uint4*)(da + 32768 + soff + i * 8192) = rb[i];
    }
    __syncthreads();
  }
  uint2 pv[4][4];
#pragma unroll
  for (int mi = 0; mi < 4; ++mi)
#pragma unroll
    for (int ni = 0; ni < 4; ++ni) {
      if (SWAP) pv[mi][ni] = pre(m0 + wm * 64 + mi * 16 + fr, n0 + wn * 64 + ni * 16 + fq * 4);
      else pv[mi][ni] = pre(m0 + wm * 64 + mi * 16 + fq * 4, n0 + wn * 64 + ni * 16 + fr);
    }
#pragma unroll
  for (int mi = 0; mi < 4; ++mi)
#pragma unroll
    for (int ni = 0; ni < 4; ++ni) {
      if (SWAP) epi(m0 + wm * 64 + mi * 16 + fr, n0 + wn * 64 + ni * 16 + fq * 4, acc[mi][ni], pv[mi][ni]);
      else epi(m0 + wm * 64 + mi * 16 + fq * 4, n0 + wn * 64 + ni * 16 + fr, acc[mi][ni], pv[mi][ni]);
    }
}

template <class F>
DI void for_tiles(int nM, int nN, int sm, int sn, F f) {
  if (gridDim.x == 256) {
    const int xcd = blockIdx.x & 7, slot = blockIdx.x >> 3;
    const int am = slot % sm, bn = slot / sm;
    const int nSN = (nN + sn - 1) / sn, nS = (nM / sm) * nSN;
    for (int st = xcd; st < nS; st += 8) {
      const int tm = (st / nSN) * sm + am, tn = (st % nSN) * sn + bn;
      if (tn < nN) f(tm, tn);
    }
  } else {
    for (int t = blockIdx.x; t < nM * nN; t += gridDim.x) f(t / nN, t % nN);
  }
}


#define LAS __attribute__((address_space(3)))
constexpr int G8_HTB = 128 * 64 * 2;
DI int g8_lds_byte(int r, int c) { const int st = (r >> 4) * 2 + (c >> 5), rr = r & 15, cc = c & 31, ob = rr * 64 + cc * 2; return st * 1024 + (ob ^ (((ob >> 9) & 1) << 5)); }
DI void g8_stage_rc(int b, int& R, int& C) { const int st = b / 1024, sb = b % 1024, swz = sb ^ (((sb >> 9) & 1) << 5); R = (st >> 1) * 16 + swz / 64; C = (st & 1) * 32 + (swz % 64) / 2; }
template <int NM, int NN, int NN1, int SM1, int SN1, int SM2, int SN2>
struct TileSched {
  static constexpr int nSN1 = NN1 / SN1, nS1 = (NM / SM1) * nSN1, nSN2 = (NN - NN1) / SN2, nS2 = (NM / SM2) * nSN2, nT = NM * NN;
  int c;
  DI void init() { c = blockIdx.x; }
  DI bool next(int i, int& pm, int& pn) const {
    if (gridDim.x == 256) {
      const int xcd = c & 7, slot = c >> 3;
      int st = xcd + 8 * i;
      if (st < nS1) { pm = (st / nSN1) * SM1 + slot % SM1; pn = (st % nSN1) * SN1 + slot / SM1; return true; }
      st -= nS1;
      if (nS2 == 0 || st >= nS2) return false;
      pm = (st / (nSN2 > 0 ? nSN2 : 1)) * SM2 + slot % SM2; pn = NN1 + (st % (nSN2 > 0 ? nSN2 : 1)) * SN2 + slot / SM2; return true;
    }
    const int L = i * (int)gridDim.x + c; if (L >= nT) return false; pm = L / NN; pn = L % NN; return true;
  }
};
template <bool ABLK = false, int SWM = 0, bool PERMB = false, class Sched, class Epi>
DI void gemm8(char* smem, const u16* A, const u16* Bt, int K, const Sched& S, const Epi& E) {
  LAS unsigned char* lds = (LAS unsigned char*)smem;
  const int tid = TIDX(), wid = __builtin_amdgcn_readfirstlane(tid >> 6), lane = tid & 63, wr = wid >> 2, wc = wid & 3, fr = lane & 15, fq = lane >> 4;
  const int nt = K / 64;
  unsigned voff[2], voffA[2];
#pragma unroll
  for (int i = 0; i < 2; ++i) { int R, C; g8_stage_rc(tid * 16 + i * 8192, R, C);
    const int rho = R & 31, Rb = PERMB ? (R & ~31) + 8 * ((rho & 15) >> 2) + 4 * (rho >> 4) + (rho & 3) : R;
    voff[i] = (unsigned)(Rb * 64 + C) * 2u; voffA[i] = ABLK ? (unsigned)(R * 64 + C) * 2u : (unsigned)(R * K + C) * 2u; }
  const size_t kstep = 32768, hstep = 16384, tstep = (size_t)256 * K * 2;
  const size_t kstepA = ABLK ? 32768 : 128, hstepA = ABLK ? 16384 : (size_t)128 * K * 2;
  const unsigned ldsw = (unsigned)wid * 1024u;
  const int aoff = g8_lds_byte(wr * 64 + fr, fq * 8), boff = g8_lds_byte(wc * 32 + fr, fq * 8);
#define G8_SA(b, h) (((b) * 2 + (h)) * G8_HTB)
#define G8_SB(b, h) ((4 + (b) * 2 + (h)) * G8_HTB)
#define G8_STAGE(bufoff, gbase) do { _Pragma("unroll") for (int _i = 0; _i < 2; ++_i) \
    __builtin_amdgcn_global_load_lds((const unsigned*)((const char*)(gbase) + voff[_i]), (LAS unsigned*)(lds + (bufoff) + ldsw + _i * 8192), 16, 0, 0); } while (0)
#define G8_STAGEA(bufoff, gbase) do { _Pragma("unroll") for (int _i = 0; _i < 2; ++_i) \
    __builtin_amdgcn_global_load_lds((const unsigned*)((const char*)(gbase) + voffA[_i]), (LAS unsigned*)(lds + (bufoff) + ldsw + _i * 8192), 16, 0, 0); } while (0)
#define G8_LDA(dst, b, h) do { _Pragma("unroll") for (int m = 0; m < 4; ++m) _Pragma("unroll") for (int k = 0; k < 2; ++k) dst[m][k] = *(const LAS bf16x8*)(lds + G8_SA(b, h) + aoff + m * 2048 + k * 1024); } while (0)
#define G8_LDB(dst, b, h) do { _Pragma("unroll") for (int n = 0; n < 2; ++n) _Pragma("unroll") for (int k = 0; k < 2; ++k) dst[n][k] = *(const LAS bf16x8*)(lds + G8_SB(b, h) + boff + n * 2048 + k * 1024); } while (0)
#define G8_MMA(ai, bj, At_, Bt_) do { __builtin_amdgcn_s_setprio(1); _Pragma("unroll") for (int m = 0; m < 4; ++m) _Pragma("unroll") for (int n = 0; n < 2; ++n) _Pragma("unroll") for (int k = 0; k < 2; ++k) \
    acc[ai][bj][m][n] = SWM == 2 ? __builtin_amdgcn_mfma_f32_16x16x32_bf16(At_[m][k], Bt_[n][k], acc[ai][bj][m][n], 0, 0, 0) \
                                 : __builtin_amdgcn_mfma_f32_16x16x32_bf16(Bt_[n][k], At_[m][k], acc[ai][bj][m][n], 0, 0, 0); __builtin_amdgcn_s_setprio(0); } while (0)
#define G8_WAIT_V(n) asm volatile("s_waitcnt vmcnt(" #n ")" ::: "memory")
#define G8_WAIT_L(n) asm volatile("s_waitcnt lgkmcnt(" #n ")" ::: "memory")
#define G8_BAR __builtin_amdgcn_s_barrier()
#define G8_SCHED __builtin_amdgcn_sched_barrier(0)
  int cpm, cpn, npm = 0, npn = 0, ui = 0;
  if (!S.next(0, cpm, cpn)) return;
  f32x4 acc[2][2][4][2];
#pragma unroll
  for (int a = 0; a < 2; ++a)
#pragma unroll
    for (int b = 0; b < 2; ++b)
#pragma unroll
      for (int m = 0; m < 4; ++m)
#pragma unroll
        for (int n = 0; n < 2; ++n) acc[a][b][m][n] = f32x4{0.f, 0.f, 0.f, 0.f};
  bf16x8 At[4][2], B0[2][2], B1[2][2];
  const char* cA = (const char*)A + (size_t)cpm * tstep; const char* cB = (const char*)Bt + (size_t)cpn * tstep;
  G8_STAGE(G8_SB(0, 0), cB); G8_STAGEA(G8_SA(0, 0), cA); G8_STAGE(G8_SB(0, 1), cB + hstep); G8_STAGEA(G8_SA(0, 1), cA + hstepA);
  if (wr == 1) G8_BAR;
  G8_WAIT_V(4); G8_BAR;
  G8_STAGE(G8_SB(1, 0), cB + kstep); G8_STAGEA(G8_SA(1, 0), cA + kstepA); G8_STAGE(G8_SB(1, 1), cB + hstep + kstep);
  G8_WAIT_V(6); G8_BAR;
  for (;;) {
    const bool has_next = S.next(ui + 1, npm, npn);
    const char* nA = has_next ? (const char*)A + (size_t)npm * tstep : cA; const char* nB = has_next ? (const char*)Bt + (size_t)npn * tstep : cB;
#pragma unroll 1
    for (int t = 0; t < nt; t += 2) {
      const bool last = (t == nt - 2);
      const char* a1 = cA + (size_t)(t + 1) * kstepA;
      const char* a2 = last ? nA : cA + (size_t)(t + 2) * kstepA; const char* b2 = last ? nB : cB + (size_t)(t + 2) * kstep;
      const char* a3 = a2 + kstepA; const char* b3 = b2 + kstep;
      G8_LDB(B0, 0, 0); G8_SCHED; G8_LDA(At, 0, 0); G8_STAGEA(G8_SA(1, 1), a1 + hstepA);
      G8_WAIT_L(8); G8_BAR; G8_WAIT_L(0); G8_MMA(0, 0, At, B0); G8_BAR; G8_SCHED;
      G8_LDB(B1, 0, 1); G8_STAGE(G8_SB(0, 0), b2);
      G8_BAR; G8_WAIT_L(0); G8_MMA(0, 1, At, B1); G8_BAR;
      G8_LDA(At, 0, 1); G8_STAGEA(G8_SA(0, 0), a2);
      G8_BAR; G8_WAIT_L(0); G8_MMA(1, 0, At, B0); G8_BAR; G8_SCHED;
      G8_STAGE(G8_SB(0, 1), b2 + hstep);
      G8_WAIT_V(6); G8_BAR; G8_MMA(1, 1, At, B1); G8_BAR;
      G8_LDB(B0, 1, 0); G8_SCHED; G8_LDA(At, 1, 0); G8_STAGEA(G8_SA(0, 1), a2 + hstepA);
      G8_WAIT_L(8); G8_BAR; G8_WAIT_L(0); G8_MMA(0, 0, At, B0); G8_BAR; G8_SCHED;
      G8_LDB(B1, 1, 1); G8_STAGE(G8_SB(1, 0), b3);
      G8_BAR; G8_WAIT_L(0); G8_MMA(0, 1, At, B1); G8_BAR;
      G8_LDA(At, 1, 1); G8_STAGEA(G8_SA(1, 0), a3);
      G8_BAR; G8_WAIT_L(0); G8_MMA(1, 0, At, B0); G8_BAR; G8_SCHED;
      G8_STAGE(G8_SB(1, 1), b3 + hstep);
      G8_WAIT_V(6); G8_BAR; G8_MMA(1, 1, At, B1); G8_BAR;
    }
    { const int t2 = TIDX(), w2 = __builtin_amdgcn_readfirstlane(t2 >> 6), l2 = t2 & 63; E(acc, cpm, cpn, w2 >> 2, w2 & 3, l2 & 15, l2 >> 4); }
    if (!has_next) break;
#pragma unroll
    for (int a = 0; a < 2; ++a)
#pragma unroll
      for (int b = 0; b < 2; ++b)
#pragma unroll
        for (int m = 0; m < 4; ++m)
#pragma unroll
          for (int n = 0; n < 2; ++n) acc[a][b][m][n] = f32x4{0.f, 0.f, 0.f, 0.f};
    cpm = npm; cpn = npn; cA = nA; cB = nB; ++ui;
  }
  G8_WAIT_V(0);
  if (wr == 0) G8_BAR;
  G8_BAR;
#undef G8_SA
#undef G8_SB
#undef G8_STAGE
#undef G8_STAGEA
#undef G8_LDA
#undef G8_LDB
#undef G8_MMA
#undef G8_WAIT_V
#undef G8_WAIT_L
#undef G8_BAR
#undef G8_SCHED
}
template <bool ABLK, class Epi>
DI void gemm_half(char* smem, const u16* A, const u16* Bt, int K, int pm, int pn, int nh, const Epi& E) {
  LAS unsigned char* lds = (LAS unsigned char*)smem;
  const int tid = TIDX(), wid = __builtin_amdgcn_readfirstlane(tid >> 6), lane = tid & 63, wr = wid >> 2, wc = wid & 3, fr = lane & 15, fq = lane >> 4;
  const int nt = K / 64;
  unsigned voff[2], voffA[2];
#pragma unroll
  for (int i = 0; i < 2; ++i) { int R, C; g8_stage_rc(tid * 16 + i * 8192, R, C); voff[i] = (unsigned)(R * 64 + C) * 2u; voffA[i] = ABLK ? voff[i] : (unsigned)(R * K + C) * 2u; }
  const size_t kstep = 32768, hstep = 16384, tstep = (size_t)256 * K * 2;
  const size_t kstepA = ABLK ? 32768 : 128, hstepA = ABLK ? 16384 : (size_t)128 * K * 2;
  const unsigned ldsw = (unsigned)wid * 1024u;
  const int aoff = g8_lds_byte(wr * 64 + fr, fq * 8), boff = g8_lds_byte(wc * 32 + fr, fq * 8);
  const char* cA = (const char*)A + (size_t)pm * tstep;
  const char* cB = (const char*)Bt + (size_t)pn * tstep + (size_t)nh * hstep;
#define GH_STAGE(s_, kt_) do { _Pragma("unroll") for (int _i = 0; _i < 2; ++_i) { \
    __builtin_amdgcn_global_load_lds((const unsigned*)(cB + (size_t)(kt_) * kstep + voff[_i]), (LAS unsigned*)(lds + (s_) * 49152 + ldsw + _i * 8192), 16, 0, 0); \
    __builtin_amdgcn_global_load_lds((const unsigned*)(cA + (size_t)(kt_) * kstepA + voffA[_i]), (LAS unsigned*)(lds + (s_) * 49152 + 16384 + ldsw + _i * 8192), 16, 0, 0); \
    __builtin_amdgcn_global_load_lds((const unsigned*)(cA + hstepA + (size_t)(kt_) * kstepA + voffA[_i]), (LAS unsigned*)(lds + (s_) * 49152 + 32768 + ldsw + _i * 8192), 16, 0, 0); } } while (0)
  f32x4 acc[2][4][2];
#pragma unroll
  for (int a = 0; a < 2; ++a)
#pragma unroll
    for (int m = 0; m < 4; ++m)
#pragma unroll
      for (int n = 0; n < 2; ++n) acc[a][m][n] = f32x4{0.f, 0.f, 0.f, 0.f};
  __syncthreads();
  GH_STAGE(0, 0);
  asm volatile("s_waitcnt vmcnt(0)" ::: "memory");
  __syncthreads();
#pragma unroll 1
  for (int kt = 0; kt < nt; ++kt) {
    if (kt + 1 < nt) GH_STAGE((kt + 1) & 1, kt + 1);
    const LAS unsigned char* base = lds + (kt & 1) * 49152;
    bf16x8 B0[2][2];
#pragma unroll
    for (int n = 0; n < 2; ++n)
#pragma unroll
      for (int k = 0; k < 2; ++k) B0[n][k] = *(const LAS bf16x8*)(base + boff + n * 2048 + k * 1024);
#pragma unroll
    for (int ai = 0; ai < 2; ++ai) {
      bf16x8 At[4][2];
#pragma unroll
      for (int m = 0; m < 4; ++m)
#pragma unroll
        for (int k = 0; k < 2; ++k) At[m][k] = *(const LAS bf16x8*)(base + 16384 + ai * 16384 + aoff + m * 2048 + k * 1024);
#pragma unroll
      for (int m = 0; m < 4; ++m)
#pragma unroll
        for (int n = 0; n < 2; ++n)
#pragma unroll
          for (int k = 0; k < 2; ++k) acc[ai][m][n] = __builtin_amdgcn_mfma_f32_16x16x32_bf16(B0[n][k], At[m][k], acc[ai][m][n], 0, 0, 0);
    }
    asm volatile("s_waitcnt vmcnt(0)" ::: "memory");
    __syncthreads();
  }
#undef GH_STAGE
  E(acc, pm, pn, nh, wr, wc, fr, fq);
}

template <class F> struct ElemEpi {
  F f;
  DI void operator()(const f32x4 (&acc)[2][2][4][2], int pm, int pn, int wr, int wc, int fr, int fq) const {
    const int row0 = pm * 256 + wr * 64 + fr, col0 = pn * 256 + wc * 32 + 4 * fq;
#pragma unroll
    for (int ai = 0; ai < 2; ++ai)
#pragma unroll
      for (int m = 0; m < 4; ++m)
#pragma unroll
        for (int bj = 0; bj < 2; ++bj)
#pragma unroll
          for (int n = 0; n < 2; ++n) f(row0 + ai * 128 + m * 16, col0 + bj * 128 + n * 16, acc[ai][bj][m][n]);
  }
};
template <class F> DI ElemEpi<F> make_epi(F f) { return ElemEpi<F>{f}; }
template <int NM, int NN, int NN1, int SM1, int SN1, int SM2, int SN2, class F>
DI void gemm8_job(char* smem, const u16* A, const u16* Bt, int K, F f) {
  TileSched<NM, NN, NN1, SM1, SN1, SM2, SN2> S; S.init();
  gemm8(smem, A, Bt, K, S, make_epi(f));
}

struct EpiMixU {
  u16* MIX;
  DI void operator()(const f32x4 (&acc)[2][2][4][2], int pm, int pn, int wr, int wc, int fr, int fq) const {
    const int row0 = pm * 256 + wr * 64 + fr, col0 = pn * 256 + wc * 32 + 4 * fq;
#pragma unroll
    for (int ai = 0; ai < 2; ++ai)
#pragma unroll
      for (int m = 0; m < 4; ++m)
#pragma unroll
        for (int bj = 0; bj < 2; ++bj)
#pragma unroll
          for (int n = 0; n < 2; ++n) {
            const f32x4 v = acc[ai][bj][m][n];
            *(uint2*)(MIX + (unsigned)((row0 + ai * 128 + m * 16) * 1024 + col0 + bj * 128 + n * 16)) = pack4(gelu_tanh(v[0]), gelu_tanh(v[1]), gelu_tanh(v[2]), gelu_tanh(v[3]));
          }
  }
  DI void operator()(const f32x4 (&acc)[2][4][2], int pm, int pn, int nh, int wr, int wc, int fr, int fq) const {
    const int row0 = pm * 256 + wr * 64 + fr, col0 = pn * 256 + nh * 128 + wc * 32 + 4 * fq;
#pragma unroll
    for (int ai = 0; ai < 2; ++ai)
#pragma unroll
      for (int m = 0; m < 4; ++m)
#pragma unroll
        for (int n = 0; n < 2; ++n) {
          const f32x4 v = acc[ai][m][n];
          *(uint2*)(MIX + (unsigned)((row0 + ai * 128 + m * 16) * 1024 + col0 + n * 16)) = pack4(gelu_tanh(v[0]), gelu_tanh(v[1]), gelu_tanh(v[2]), gelu_tanh(v[3]));
        }
  }
};
struct EpiMixV {
  u16* VT; u16* PRT;
  DI void operator()(const f32x4 (&acc)[2][2][4][2], int pm, int pn, int wr, int wc, int fr, int fq) const {
    const int rowt = pm * 256;
    if (pn < 2) {
#pragma unroll
      for (int ai = 0; ai < 2; ++ai)
#pragma unroll
        for (int bj = 0; bj < 2; ++bj) {
          const unsigned g = (unsigned)(pn * 2 + bj), chunk = (unsigned)(pm * 2 + ai);
          const unsigned base = ((g * 320u + chunk) * 128u) * 128u;
#pragma unroll
          for (int m = 0; m < 4; ++m)
#pragma unroll
            for (int n = 0; n < 2; ++n) {
              const f32x4 v = acc[ai][bj][m][n];
              const unsigned c = (unsigned)(wc * 32 + n * 16 + fr), q = (unsigned)(wr * 64 + m * 16 + 4 * fq);
              *(uint2*)(VT + (base + c * 128u + q)) = pack4(gelu_tanh(v[0]), gelu_tanh(v[1]), gelu_tanh(v[2]), gelu_tanh(v[3]));
            }
        }
    } else {
      unsigned sbase, L;
      if (rowt < TP) { sbase = (unsigned)rowt * 1536u; L = 256u; }
      else { const int mm = rowt - TP; sbase = (unsigned)(TP + (mm & ~4095)) * 1536u + (unsigned)(mm & 4095); L = 4096u; }
#pragma unroll
      for (int ai = 0; ai < 2; ++ai)
#pragma unroll
        for (int bj = 0; bj < 2; ++bj)
#pragma unroll
          for (int m = 0; m < 4; ++m)
#pragma unroll
            for (int n = 0; n < 2; ++n) {
              const f32x4 v = acc[ai][bj][m][n];
              const unsigned cp = (unsigned)((pn - 2) * 256 + bj * 128 + wc * 32 + n * 16 + fr), tl = (unsigned)(ai * 128 + wr * 64 + m * 16 + 4 * fq);
              *(uint2*)(PRT + (sbase + cp * L + tl)) = pack4(v[0], v[1], v[2], v[3]);
            }
    }
  }
};
struct OneRoundSched {
  int c;
  DI void init() { c = blockIdx.x; }
  DI bool next(int i, int& pm, int& pn) const {
    if (gridDim.x == 256) { if (i > 0) return false; const int slot = c >> 3; pm = (c & 7) * 16 + (slot & 15); pn = slot >> 4; return true; }
    const int L = i * (int)gridDim.x + c; if (L >= 320) return false; pm = L >> 1; pn = L & 1; return true;
  }
};
DI void phase_mix_in(const PV& p, int i, char* smem) {
  const u16* H = (const u16*)(p.ws() + OFF_A + A_H);
  const u16* W = (const u16*)(p.ws() + OFF_WMIXIN) + (size_t)i * 2560 * 1024;
  EpiMixV EV; EV.VT = (u16*)(p.ws() + OFF_B + B_VT); EV.PRT = (u16*)(p.ws() + OFF_B + B_PRT);
  EpiMixU EU; EU.MIX = (u16*)(p.ws() + OFF_B + B_MIX);
  {
    TileSched<160, 8, 8, 8, 4, 32, 1> S; S.init();
    gemm8<false, 2>(smem, H, W + (size_t)512 * 1024, 1024, S, EV);
  }
  {
    OneRoundSched S; S.init();
    gemm8<false, 0>(smem, H, W, 1024, S, EU);
    if (gridDim.x == 256 && blockIdx.x < 128) {
      const int tile = blockIdx.x >> 1, nh = blockIdx.x & 1;
      gemm_half<false>(smem, H, W, 1024, 128 + (tile & 31), tile >> 5, nh, EU);
    }
  }
}

DI void phase_sgu(const PV& p, int i, char* smem) {
  const u16* VT = (const u16*)(p.ws() + OFF_B + B_VT);
  const u16* W = (const u16*)(p.ws() + OFF_WSGU) + (size_t)i * 4 * 16384;
  u16* MIX = (u16*)(p.ws() + OFF_B + B_MIX);
  const float* sb = p.in(11) + i * 512;
  for (int u = blockIdx.x; u < 640; u += gridDim.x) {
    const int g = u / 160, tm = u % 160;
    auto epi = [=](int m, int n, f32x4 v, uint2 uu) {
      const int chunk = m >> 7, c = m & 127;
      const int t = chunk * 128 + n;
      const float bias = sb[g * 128 + n];
      u16* dst = MIX + (size_t)t * 1024 + g * 128 + c;
      *(uint2*)dst = pack4(lo16(uu.x) * (v[0] + bias), hi16(uu.x) * (v[1] + bias), lo16(uu.y) * (v[2] + bias), hi16(uu.y) * (v[3] + bias));
    };
    auto pre = [=](int m, int n) { return *(const uint2*)(MIX + (size_t)((m >> 7) * 128 + n) * 1024 + g * 128 + (m & 127)); };
    gemm_tile<false>(VT + (size_t)g * 320 * 128 * 128, 128, W + (size_t)g * 16384, 128, 128, tm * 256, 0, smem, epi, pre);
  }
}

DI size_t prt_off(int kind, int b, int cp) {
  return kind ? (size_t)(TP + b * 4096) * 1536 + (size_t)cp * 4096 : (size_t)(b * 256) * 1536 + (size_t)cp * 256;
}
DI size_t zt_off(int kind, int b, int c) {
  return kind ? (size_t)(TP + b * 4096) * 512 + (size_t)c * 4096 : (size_t)(b * 256) * 512 + (size_t)c * 256;
}
DI void phase_conv(const PV& p, int i, int ord, char* smem) {
  const int tid = TIDX(), lane = tid & 63, wid = tid >> 6;
  const u16* PRT = (const u16*)(p.ws() + OFF_B + B_PRT);
  const u16* FILT = (const u16*)(p.ws() + OFF_FILT);
  const u16* Z1 = (const u16*)(p.ws() + OFF_A + A_Z1);
  u16* ZO = (u16*)(p.ws() + OFF_A + (ord ? A_Z2 : A_Z1));
  const float* cw = p.in(12) + (size_t)i * 3 * 1536;
  const float* cb = p.in(13) + (size_t)i * 1536;
  u16* hc = (u16*)smem;
  char* Ub = smem + 68096;
  for (int u = blockIdx.x; u < 1024; u += gridDim.x) {
    const int kind = u < 512 ? 1 : 0, c = u & 511;
    const int L = kind ? 4096 : 256, NB = kind ? 8 : 32, LB = L >> 6, DD = L >> 7;
    const int US = (L + 8) * 2;
    const size_t fbase = ((size_t)(i * 2 + ord) * 512 + c) * 4352 + (kind ? 256 : 0);
    __syncthreads();
    {
      u16* tmp = (u16*)Ub;
      for (int idx = tid; idx < (L >> 3); idx += 512) *(uint4*)(tmp + idx * 8) = *(const uint4*)(FILT + fbase + idx * 8);
      __syncthreads();
#pragma unroll 1
      for (int cpy = 0; cpy < 8; ++cpy)
        for (int m = tid; m < L + 136; m += 512) {
          const int x = L + 63 - m - cpy;
          hc[cpy * 4256 + m] = (x >= 0 && x < L) ? tmp[x] : (u16)0;
        }
      __syncthreads();
    }
    {
      const int lgn = kind ? 9 : 5, ncr = 1 << lgn, total = NB * ncr;
      const float w0 = cw[c], w1 = cw[1536 + c], w2 = cw[3072 + c], bb = cb[c];
      for (int id = tid; id < total; id += 512) {
        const int b = id >> lgn, t = (id & (ncr - 1)) * 8;
        uint4 o;
        if (ord == 0) {
          const u16* src = PRT + prt_off(kind, b, c) + t;
          const uint4 raw = *(const uint4*)src;
          float e[10];
          e[0] = t > 0 ? bf2f(src[-1]) : 0.f;
          e[9] = t + 8 < L ? bf2f(src[8]) : 0.f;
          e[1] = lo16(raw.x); e[2] = hi16(raw.x); e[3] = lo16(raw.y); e[4] = hi16(raw.y);
          e[5] = lo16(raw.z); e[6] = hi16(raw.z); e[7] = lo16(raw.w); e[8] = hi16(raw.w);
          float r[8];
#pragma unroll
          for (int k = 0; k < 8; ++k) r[k] = w0 * e[k] + w1 * e[k + 1] + w2 * e[k + 2] + bb;
          o.x = pack2(r[0], r[1]); o.y = pack2(r[2], r[3]); o.z = pack2(r[4], r[5]); o.w = pack2(r[6], r[7]);
        } else {
          o = *(const uint4*)(Z1 + zt_off(kind, b, c) + t);
        }
        *(uint4*)(Ub + b * US + t * 2) = o;
      }
    }
    __syncthreads();
    const int ncols = LB * NB;
#pragma unroll 1
    for (int hf = 0; hf < 2; ++hf) {
      const int jt = wid + 8 * hf;
      if (jt * 32 >= ncols) break;
      const int il = lane & 31, q = lane >> 5;
      const int lgb = kind ? 3 : 5;
      const int col = jt * 32 + il, t1c = col >> lgb, bc = col & (NB - 1);
      const int t1lo = (jt * 32) >> lgb, t1hi = (jt * 32 + 31) >> lgb;
      const int dlo = max(-DD, t1lo - (LB - 1)), dhi = min(DD, t1hi);
      const int cpy = 7 - (il & 7);
      const char* abase = (const char*)hc + cpy * 8512 + 2 * (L / 2 + 63 - il - cpy + 8 * q);
      f32x16 acc[2];
#pragma unroll
      for (int a = 0; a < 2; ++a)
#pragma unroll
        for (int r = 0; r < 16; ++r) acc[a][r] = 0.f;
      for (int d = dlo; d <= dhi; ++d) {
        bf16x8 bfr[4];
        {
          const int s1 = t1c - d;
          const bool valid = s1 >= 0 && s1 < LB;
          const char* bp = Ub + bc * US + ((valid ? s1 : 0) * 64 + 8 * q) * 2;
#pragma unroll
          for (int ks = 0; ks < 4; ++ks) {
            bf16x8 v = *(const bf16x8*)(bp + ks * 32);
            if (!valid) v = bf16x8{0, 0, 0, 0, 0, 0, 0, 0};
            bfr[ks] = v;
          }
        }
#pragma unroll
        for (int mt = 0; mt < 2; ++mt)
#pragma unroll
          for (int ks = 0; ks < 4; ++ks) {
            const bf16x8 af = *(const bf16x8*)(abase + 2 * (-64 * d - 32 * mt + 16 * ks));
            acc[mt] = __builtin_amdgcn_mfma_f32_32x32x16_bf16(af, bfr[ks], acc[mt], 0, 0, 0);
          }
      }
      const float dsk = p.in(21)[(i * 2 + ord) * 512 + c];
      const int gc = 512 * (ord + 1) + c;
      const float w0 = cw[gc], w1 = cw[1536 + gc], w2 = cw[3072 + gc], bb = cb[gc];
      {
        const int b = bc;
        const u16* xrow = PRT + prt_off(kind, b, gc);
        u16* orow = ZO + zt_off(kind, b, c);
#pragma unroll
        for (int mt = 0; mt < 2; ++mt)
#pragma unroll
          for (int g = 0; g < 4; ++g) {
            const int t = 64 * t1c + mt * 32 + 8 * g + 4 * q;
            const uint2 uu = *(const uint2*)(Ub + b * US + t * 2);
            const uint2 xx = *(const uint2*)(xrow + t);
            const float em = t > 0 ? bf2f(xrow[t - 1]) : 0.f;
            const float ep = t + 4 < L ? bf2f(xrow[t + 4]) : 0.f;
            const float e0 = lo16(xx.x), e1 = hi16(xx.x), e2 = lo16(xx.y), e3 = hi16(xx.y);
            const float x0 = w0 * em + w1 * e0 + w2 * e1 + bb;
            const float x1 = w0 * e0 + w1 * e1 + w2 * e2 + bb;
            const float x2 = w0 * e1 + w1 * e2 + w2 * e3 + bb;
            const float x3 = w0 * e2 + w1 * e3 + w2 * ep + bb;
            const float y0 = acc[mt][4 * g + 0] + lo16(uu.x) * dsk;
            const float y1 = acc[mt][4 * g + 1] + hi16(uu.x) * dsk;
            const float y2 = acc[mt][4 * g + 2] + lo16(uu.y) * dsk;
            const float y3 = acc[mt][4 * g + 3] + hi16(uu.y) * dsk;
            *(uint2*)(orow + t) = pack4(x0 * y0, x1 * y1, x2 * y2, x3 * y3);
          }
      }
    }
  }
  __syncthreads();
}

DI void phase_ztrans(const PV& p, char* smem) {
  const int tid = TIDX();
  const u16* Z2 = (const u16*)(p.ws() + OFF_A + A_Z2);
  u16* MIX = (u16*)(p.ws() + OFF_B + B_MIX);
  u16* tl = (u16*)smem;
  for (int u4 = blockIdx.x * 4; u4 < 640 * 8; u4 += gridDim.x * 4) {
    const int tt0 = (u4 >> 3) * 64;
    const int kind = tt0 >= TP ? 1 : 0;
    const int b = kind ? (tt0 - TP) >> 12 : tt0 >> 8;
    const int tl0 = kind ? (tt0 - TP) & 4095 : tt0 & 255;
    __syncthreads();
    { const int c = tid >> 3, ch = tid & 7;
      uint4 v[4];
#pragma unroll
      for (int w = 0; w < 4; ++w) v[w] = *(const uint4*)(Z2 + zt_off(kind, b, ((u4 + w) & 7) * 64 + c) + tl0 + ch * 8);
#pragma unroll
      for (int w = 0; w < 4; ++w) *(uint4*)(tl + w * 4608 + c * 72 + ch * 8) = v[w]; }
    __syncthreads();
    { const int tr = tid >> 3, cc = (tid & 7) * 8;
#pragma unroll
      for (int w = 0; w < 4; ++w) {
        const u16* tw = tl + w * 4608;
        uint4 o;
        o.x = (unsigned)tw[(cc + 0) * 72 + tr] | ((unsigned)tw[(cc + 1) * 72 + tr] << 16);
        o.y = (unsigned)tw[(cc + 2) * 72 + tr] | ((unsigned)tw[(cc + 3) * 72 + tr] << 16);
        o.z = (unsigned)tw[(cc + 4) * 72 + tr] | ((unsigned)tw[(cc + 5) * 72 + tr] << 16);
        o.w = (unsigned)tw[(cc + 6) * 72 + tr] | ((unsigned)tw[(cc + 7) * 72 + tr] << 16);
        *(uint4*)(MIX + (size_t)(tt0 + tr) * 1024 + 512 + ((u4 + w) & 7) * 64 + cc) = o;
      } }
  }
  __syncthreads();
}

struct EpiResid {
  float* X; const float* x0; const float* x1; const float* gate; int lx;
  DI void operator()(const f32x4 (&acc)[2][2][4][2], int pm, int pn, int wr, int wc, int fr, int fq) const {
    const int rowt = pm * 256, col0 = pn * 256 + wc * 32 + 4 * fq;
    const float* gr = gate + (size_t)condrow(rowt) * 6144 + col0;
    const float* xb = lx == 0 ? (rowt < TP ? x0 + (size_t)rowt * 1024 : x1 + (size_t)(rowt - TP) * 1024) : X + (size_t)rowt * 1024;
    float4 g[2][2];
#pragma unroll
    for (int bj = 0; bj < 2; ++bj)
#pragma unroll
      for (int n = 0; n < 2; ++n) g[bj][n] = *(const float4*)(gr + bj * 128 + n * 16);
#pragma unroll
    for (int ai = 0; ai < 2; ++ai)
#pragma unroll
      for (int mh = 0; mh < 2; ++mh) {
        float4 xo[2][2][2];
#pragma unroll
        for (int mm = 0; mm < 2; ++mm)
#pragma unroll
          for (int bj = 0; bj < 2; ++bj)
#pragma unroll
            for (int n = 0; n < 2; ++n)
              xo[mm][bj][n] = *(const float4*)(xb + (size_t)(wr * 64 + fr + ai * 128 + (2 * mh + mm) * 16) * 1024 + col0 + bj * 128 + n * 16);
#pragma unroll
        for (int mm = 0; mm < 2; ++mm)
#pragma unroll
          for (int bj = 0; bj < 2; ++bj)
#pragma unroll
            for (int n = 0; n < 2; ++n) {
              const f32x4 v = acc[ai][bj][2 * mh + mm][n];
              const float4 x = xo[mm][bj][n], gg = g[bj][n];
              float4 o; o.x = x.x + gg.x * v[0]; o.y = x.y + gg.y * v[1]; o.z = x.z + gg.z * v[2]; o.w = x.w + gg.w * v[3];
              *(float4*)(X + (size_t)(rowt + wr * 64 + fr + ai * 128 + (2 * mh + mm) * 16) * 1024 + col0 + bj * 128 + n * 16) = o;
            }
      }
  }
};
struct EpiResidHalf {
  float* X; const float* x0; const float* x1; const float* gate; int lx;
  DI void operator()(const f32x4 (&acc)[2][4][2], int pm, int pn, int nh, int wr, int wc, int fr, int fq) const {
    const int rowt = pm * 256, col0 = pn * 256 + nh * 128 + wc * 32 + 4 * fq;
    const float* gr = gate + (size_t)condrow(rowt) * 6144 + col0;
    const float* xb = lx == 0 ? (rowt < TP ? x0 + (size_t)rowt * 1024 : x1 + (size_t)(rowt - TP) * 1024) : X + (size_t)rowt * 1024;
    float4 g[2];
#pragma unroll
    for (int n = 0; n < 2; ++n) g[n] = *(const float4*)(gr + n * 16);
#pragma unroll
    for (int ai = 0; ai < 2; ++ai) {
      float4 xo[4][2];
#pragma unroll
      for (int m = 0; m < 4; ++m)
#pragma unroll
        for (int n = 0; n < 2; ++n) xo[m][n] = *(const float4*)(xb + (size_t)(wr * 64 + fr + ai * 128 + m * 16) * 1024 + col0 + n * 16);
#pragma unroll
      for (int m = 0; m < 4; ++m)
#pragma unroll
        for (int n = 0; n < 2; ++n) {
          const f32x4 v = acc[ai][m][n];
          const float4 x = xo[m][n], gg = g[n];
          float4 o; o.x = x.x + gg.x * v[0]; o.y = x.y + gg.y * v[1]; o.z = x.z + gg.z * v[2]; o.w = x.w + gg.w * v[3];
          *(float4*)(X + (size_t)(rowt + wr * 64 + fr + ai * 128 + m * 16) * 1024 + col0 + n * 16) = o;
        }
    }
  }
};
struct ResidSched2 {
  int c;
  DI void init() { c = blockIdx.x; }
  DI bool next(int i, int& pm, int& pn) const {
    if (gridDim.x == 256) {
      const int st = (c & 7) + 8 * i;
      if (st >= 16) return false;
      pm = st * 8 + ((c >> 3) & 7); pn = c >> 6; return true;
    }
    const int L = i * (int)gridDim.x + c; if (L >= 640) return false; pm = L >> 2; pn = L & 3; return true;
  }
};
DI void phase_resid_gemm(const PV& p, int l, int lx, const u16* A, int K, const u16* W, int goff, char* smem) {
  EpiResid E;
  E.X = p.out(); E.x0 = p.in(0); E.x1 = p.in(1); E.gate = (const float*)(p.ws() + OFF_MOD) + (size_t)l * 9 * 6144 + goff; E.lx = lx;
  ResidSched2 S; S.init();
  if (K == 2816) gemm8<true>(smem, A, W, K, S, E);
  else gemm8<false>(smem, A, W, K, S, E);
  if (gridDim.x == 256) {
    EpiResidHalf EH; EH.X = E.X; EH.x0 = E.x0; EH.x1 = E.x1; EH.gate = E.gate; EH.lx = lx;
    const int xcd = blockIdx.x & 7, slot = blockIdx.x >> 3;
    const int st = 16 + (xcd >> 1), ti = (xcd & 1) * 16 + (slot >> 1), nh = slot & 1;
    const int pm = st * 8 + (ti & 7), pn = ti >> 3;
    if (K == 2816) gemm_half<true>(smem, A, W, K, pm, pn, nh, EH);
    else gemm_half<false>(smem, A, W, K, pm, pn, nh, EH);
  }
}

DI void phase_dqkv(const PV& p, int j, char* smem) {
  const u16* H = (const u16*)(p.ws() + OFF_A + A_H);
  const u16* W = (const u16*)(p.ws() + OFF_WDQKV) + (size_t)j * 1024 * 1024;
  u16* DQKV = (u16*)(p.ws() + OFF_B + B_DQKV);
  u16* KR = (u16*)(p.ws() + OFF_KR);
  float* okr = p.out() + 46137344;
  auto epi = [=](int m, int n, f32x4 v) {
    if (n < 832) {
      const uint2 pk = pack4(v[0], v[1], v[2], v[3]);
      *(uint2*)(DQKV + (size_t)m * 896 + n) = pk;
      if (n >= 768) {
        const int e = n - 768;
        *(uint2*)(KR + (size_t)m * 64 + e) = pk;
        if (m < TP) {
          float4 o; o.x = v[0]; o.y = v[1]; o.z = v[2]; o.w = v[3];
          *(float4*)(okr + ((size_t)((m >> 8) * 2 + j) * 256 + (m & 255)) * 64 + e) = o;
        }
      }
    }
  };
  gemm8_job<160, 4, 4, 8, 4, 32, 1>(smem, H, W, 1024, epi);
}

DI void phase_mla_norms(const PV& p, int j) {
  const int tid_ = TIDX(); const int lane = tid_ & 63, wid = tid_ >> 6;
  const u16* DQKV = (const u16*)(p.ws() + OFF_B + B_DQKV);
  u16* QN = (u16*)(p.ws() + OFF_A + A_QN);
  u16* CKV = (u16*)(p.ws() + OFF_A + A_CKV);
  u16* KR = (u16*)(p.ws() + OFF_KR);
  float* ockv = p.out() + 41943040;
  const float* qn = p.in(24) + j * 512;
  const float* kvn = p.in(27) + j * 256;
  const int stride = gridDim.x * 8;
  for (int t0 = blockIdx.x * 8 + wid; t0 < TK; t0 += 2 * stride) {
    uint4 ra[2]; uint2 rb[2];
#pragma unroll
    for (int w = 0; w < 2; ++w) {
      const int t = t0 + w * stride;
      if (t < T) {
        const u16* row = DQKV + (size_t)t * 896;
        ra[w] = *(const uint4*)(row + lane * 8);
        rb[w] = *(const uint2*)(row + 512 + lane * 4);
      }
    }
#pragma unroll
    for (int w = 0; w < 2; ++w) {
      const int t = t0 + w * stride;
      if (t < T) {
        const uint4 a = ra[w];
        float q[8] = {lo16(a.x), hi16(a.x), lo16(a.y), hi16(a.y), lo16(a.z), hi16(a.z), lo16(a.w), hi16(a.w)};
        float ss = 0.f;
#pragma unroll
        for (int k = 0; k < 8; ++k) ss += q[k] * q[k];
        ss = wave_sum(ss, lane);
        const float r = rsqrtf(ss * (1.f / 512.f) + EPS);
        const float4 g0 = *(const float4*)(qn + lane * 8), g1 = *(const float4*)(qn + lane * 8 + 4);
        uint4 o;
        o.x = pack2(q[0] * r * g0.x, q[1] * r * g0.y); o.y = pack2(q[2] * r * g0.z, q[3] * r * g0.w);
        o.z = pack2(q[4] * r * g1.x, q[5] * r * g1.y); o.w = pack2(q[6] * r * g1.z, q[7] * r * g1.w);
        *(uint4*)(QN + (size_t)t * 512 + lane * 8) = o;
        const uint2 b = rb[w];
        float kv[4] = {lo16(b.x), hi16(b.x), lo16(b.y), hi16(b.y)};
        float s2 = kv[0] * kv[0] + kv[1] * kv[1] + kv[2] * kv[2] + kv[3] * kv[3];
        s2 = wave_sum(s2, lane);
        const float r2 = rsqrtf(s2 * (1.f / 256.f) + EPS);
        const float4 g2 = *(const float4*)(kvn + lane * 4);
        float4 o2; o2.x = kv[0] * r2 * g2.x; o2.y = kv[1] * r2 * g2.y; o2.z = kv[2] * r2 * g2.z; o2.w = kv[3] * r2 * g2.w;
        *(uint2*)(CKV + (size_t)t * 256 + lane * 4) = pack4(o2.x, o2.y, o2.z, o2.w);
        if (t < TP) *(float4*)(ockv + ((size_t)((t >> 8) * 2 + j) * 256 + (t & 255)) * 256 + lane * 4) = o2;
      } else if (t < TK) {
        const int pp = t - T, b = pp >> 8, sidx = pp & 255;
        const float4 v = *(const float4*)(p.in(2) + ((size_t)(b * 2 + j) * 256 + sidx) * 256 + lane * 4);
        *(uint2*)(CKV + (size_t)t * 256 + lane * 4) = pack4(v.x, v.y, v.z, v.w);
        if (lane < 16) {
          const float4 w4 = *(const float4*)(p.in(3) + ((size_t)(b * 2 + j) * 256 + sidx) * 64 + lane * 4);
          *(uint2*)(KR + (size_t)t * 64 + lane * 4) = pack4(w4.x, w4.y, w4.z, w4.w);
        }
      }
    }
  }
}

DI size_t vt_off(int m, int h, int d) {
  if (m < TP) return ((size_t)((m >> 8) * 8 + h) * 128 + d) * 256 + (m & 255);
  if (m < T) { const int mm = m - TP; return VT_SAMPLE_OFF + ((size_t)((mm >> 12) * 8 + h) * 128 + d) * 4352 + (mm & 4095); }
  const int mm = m - T;
  return VT_SAMPLE_OFF + ((size_t)((mm >> 8) * 8 + h) * 128 + d) * 4352 + 4096 + (mm & 255);
}
struct EpiKV {
  u16* Kb; u16* Vt;
  DI void operator()(const f32x4 (&acc)[2][2][4][2], int pm, int pn, int wr, int wc, int fr, int fq) const {
    const int h = pn;
    const int rowt = pm * 256;
    const unsigned ls = rowt < TP ? 256u : 4352u;
    unsigned vbase;
    if (rowt < TP) vbase = (unsigned)(((rowt >> 8) * 8 + h) * 128) * 256u;
    else if (rowt < T) { const int mm = rowt - TP; vbase = (unsigned)VT_SAMPLE_OFF + (unsigned)(((mm >> 12) * 8 + h) * 128) * 4352u + (unsigned)(mm & 4095); }
    else { const int mm = rowt - T; vbase = (unsigned)VT_SAMPLE_OFF + (unsigned)(((mm >> 8) * 8 + h) * 128) * 4352u + 4096u + (unsigned)(mm & 255); }
    const unsigned dcol = (unsigned)(wc * 32 + 4 * fq);
#pragma unroll
    for (int ai = 0; ai < 2; ++ai)
#pragma unroll
      for (int m = 0; m < 4; ++m) {
        const int rl = ai * 128 + wr * 64 + m * 16 + fr;
        const unsigned ko = (unsigned)((rowt + rl) * 8 + h) * 192u + dcol;
        const unsigned frp = (unsigned)((fr & 3) | ((fr & 4) << 1) | ((fr & 8) >> 1));
        const unsigned vo = vbase + (unsigned)(rl & ~15) + frp + dcol * ls;
#pragma unroll
        for (int n = 0; n < 2; ++n) {
          const f32x4 k = acc[ai][0][m][n], v = acc[ai][1][m][n];
          *(uint2*)(Kb + (ko + n * 16)) = pack4(k[0], k[1], k[2], k[3]);
          const unsigned p01 = pack2(v[0], v[1]), p23 = pack2(v[2], v[3]);
          const unsigned vq = vo + (unsigned)(n * 16) * ls;
          Vt[vq] = (u16)p01; Vt[vq + ls] = (u16)(p01 >> 16); Vt[vq + 2 * ls] = (u16)p23; Vt[vq + 3 * ls] = (u16)(p23 >> 16);
        }
      }
  }
};
DI void phase_uq_ukv(const PV& p, int j, char* smem) {
  const u16* QN = (const u16*)(p.ws() + OFF_A + A_QN);
  const u16* CKV = (const u16*)(p.ws() + OFF_A + A_CKV);
  const u16* WQ = (const u16*)(p.ws() + OFF_WUQ) + (size_t)j * 1536 * 512;
  const u16* WKV = (const u16*)(p.ws() + OFF_WUKV) + (size_t)j * 2048 * 256;
  u16* Q = (u16*)(p.ws() + OFF_B + B_Q);
  u16* Kb = (u16*)(p.ws() + OFF_B + B_K);
  u16* Vt = (u16*)(p.ws() + OFF_B + B_V);
  auto epiq = [=](int m, int n, f32x4 v) { *(uint2*)(Q + (size_t)m * 1536 + n) = pack4(v[0], v[1], v[2], v[3]); };
  gemm8_job<160, 6, 4, 8, 4, 16, 2>(smem, QN, WQ, 512, epiq);
  EpiKV E; E.Kb = Kb; E.Vt = Vt;
  TileSched<168, 8, 8, 8, 4, 32, 1> S; S.init();
  gemm8(smem, CKV, WKV, 256, S, E);
}

DI void phase_finalize(const PV& p, int j) {
  const int tid_ = TIDX(); const int lane = tid_ & 63, wid = tid_ >> 6;
  const int h = lane >> 3, l8 = lane & 7;
  u16* Q = (u16*)(p.ws() + OFF_B + B_Q);
  u16* Kb = (u16*)(p.ws() + OFF_B + B_K);
  const u16* KR = (const u16*)(p.ws() + OFF_KR);
  const float2* ROPE = (const float2*)(p.ws() + OFF_ROPE);
  const float* qhn = p.in(29) + j * 192;
  const float* khn = p.in(30) + j * 192;
  const float QSCALE = 1.4426950408889634f * 0.07216878364870322f;
  const int stride = gridDim.x * 8;
  for (int u0 = T + blockIdx.x * 8 + wid; u0 < T + TK; u0 += 2 * stride) {
    uint4 raw[2][3];
    u16* basep[2];
#pragma unroll
    for (int w = 0; w < 2; ++w) {
      const int u = u0 + w * stride;
      if (u < T + TK) {
        const bool isq = u < T;
        const int t = isq ? u : u - T;
        u16* base = isq ? Q + (size_t)t * 1536 + h * 192 : Kb + ((size_t)t * 8 + h) * 192;
        basep[w] = base;
#pragma unroll
        for (int k = 0; k < 3; ++k) {
          const u16* src = (!isq && k == 2) ? KR + (size_t)t * 64 + 8 * l8 : base + 8 * (l8 + 8 * k);
          raw[w][k] = *(const uint4*)src;
        }
      }
    }
#pragma unroll
    for (int w = 0; w < 2; ++w) {
      const int u = u0 + w * stride;
      if (u < T + TK) {
        const bool isq = u < T;
        const int t = isq ? u : u - T;
        const float* hn = isq ? qhn : khn;
        float v[3][8];
#pragma unroll
        for (int k = 0; k < 3; ++k) {
          const uint4 a = raw[w][k];
          v[k][0] = lo16(a.x); v[k][1] = hi16(a.x); v[k][2] = lo16(a.y); v[k][3] = hi16(a.y);
          v[k][4] = lo16(a.z); v[k][5] = hi16(a.z); v[k][6] = lo16(a.w); v[k][7] = hi16(a.w);
        }
        float ss = 0.f;
#pragma unroll
        for (int k = 0; k < 3; ++k)
#pragma unroll
          for (int e = 0; e < 8; ++e) ss += v[k][e] * v[k][e];
        ss += shx<1>(ss, lane); ss += shx<2>(ss, lane); ss += shx<4>(ss, lane);
        const float r = rsqrtf(ss * (1.f / 192.f) + EPS);
#pragma unroll
        for (int k = 0; k < 3; ++k) {
          const float4 g0 = *(const float4*)(hn + 8 * (l8 + 8 * k)), g1 = *(const float4*)(hn + 8 * (l8 + 8 * k) + 4);
          v[k][0] *= r * g0.x; v[k][1] *= r * g0.y; v[k][2] *= r * g0.z; v[k][3] *= r * g0.w;
          v[k][4] *= r * g1.x; v[k][5] *= r * g1.y; v[k][6] *= r * g1.z; v[k][7] *= r * g1.w;
        }
        if (t >= TP && t < T) {
          const int tl = (t - TP) & 4095;
          const int pos = l8 < 4 ? (tl >> 6) : (tl & 63);
          const float4* rp = (const float4*)(ROPE + pos * 16 + (l8 & 1) * 8);
          const float4 c01 = rp[0], c23 = rp[1], c45 = rp[2], c67 = rp[3];
          const float cs[8] = {c01.x, c01.z, c23.x, c23.z, c45.x, c45.z, c67.x, c67.z};
          const float sn[8] = {c01.y, c01.w, c23.y, c23.w, c45.y, c45.w, c67.y, c67.w};
#pragma unroll
          for (int e = 0; e < 8; ++e) {
            const float x = v[2][e];
            const float partner = shx<2>(x, lane);
            v[2][e] = (l8 & 2) ? x * cs[e] + partner * sn[e] : x * cs[e] - partner * sn[e];
          }
        }
        const float sc = isq ? QSCALE : 1.f;
#pragma unroll
        for (int k = 0; k < 3; ++k) {
          uint4 o;
          o.x = pack2(v[k][0] * sc, v[k][1] * sc); o.y = pack2(v[k][2] * sc, v[k][3] * sc);
          o.z = pack2(v[k][4] * sc, v[k][5] * sc); o.w = pack2(v[k][6] * sc, v[k][7] * sc);
          *(uint4*)(basep[w] + 8 * (l8 + 8 * k)) = o;
        }
      }
    }
  }
}

DI void attn_item(const PV& p, int j, int kind, int seq, int h, int q0, char* smem) {
  const int tid = TIDX(), lane = tid & 63, wid = tid >> 6;
  const int il = lane & 31, hh = lane >> 5;
  const u16* Q = (const u16*)(p.ws() + OFF_B + B_Q);
  const u16* Kb = (const u16*)(p.ws() + OFF_B + B_K);
  const u16* Vt = (const u16*)(p.ws() + OFF_B + B_V);
  u16* O = (u16*)(p.ws() + OFF_A + A_O);
  const float* qhn = p.in(29) + j * 192;
  const float2* ROPE = (const float2*)(p.ws() + OFF_ROPE);
  const int Lk = kind ? 4352 : 256, nkt = Lk >> 6;
  const u16* vbase = Vt + (kind ? VT_SAMPLE_OFF + (size_t)(seq * 8 + h) * 128 * 4352 : (size_t)(seq * 8 + h) * 128 * 256);
  const int tq = q0 + wid * 32 + il;
  bf16x8 qf[12];
  {
    float v[12][8];
    float ss = 0.f;
#pragma unroll
    for (int ks = 0; ks < 12; ++ks) {
      const uint4 a = *(const uint4*)(Q + ((size_t)tq * 8 + h) * 192 + 16 * ks + 8 * hh);
      v[ks][0] = lo16(a.x); v[ks][1] = hi16(a.x); v[ks][2] = lo16(a.y); v[ks][3] = hi16(a.y);
      v[ks][4] = lo16(a.z); v[ks][5] = hi16(a.z); v[ks][6] = lo16(a.w); v[ks][7] = hi16(a.w);
#pragma unroll
      for (int e = 0; e < 8; ++e) ss += v[ks][e] * v[ks][e];
    }
    { auto rr = __builtin_amdgcn_permlane32_swap(__float_as_uint(ss), __float_as_uint(ss), false, false); ss = __uint_as_float(rr[0]) + __uint_as_float(rr[1]); }
    const float rn = rsqrtf(ss * (1.f / 192.f) + EPS);
#pragma unroll
    for (int ks = 0; ks < 12; ++ks) {
      const float4 g0 = *(const float4*)(qhn + 16 * ks + 8 * hh), g1 = *(const float4*)(qhn + 16 * ks + 8 * hh + 4);
      v[ks][0] *= rn * g0.x; v[ks][1] *= rn * g0.y; v[ks][2] *= rn * g0.z; v[ks][3] *= rn * g0.w;
      v[ks][4] *= rn * g1.x; v[ks][5] *= rn * g1.y; v[ks][6] *= rn * g1.z; v[ks][7] *= rn * g1.w;
    }
    if (kind) {
      const int tl = (tq - TP) & 4095;
#pragma unroll
      for (int part = 0; part < 2; ++part) {
        const int pos = part == 0 ? (tl >> 6) : (tl & 63);
        const float4* rp = (const float4*)(ROPE + pos * 16 + 8 * hh);
        const float4 c01 = rp[0], c23 = rp[1], c45 = rp[2], c67 = rp[3];
        const float cs[8] = {c01.x, c01.z, c23.x, c23.z, c45.x, c45.z, c67.x, c67.z};
        const float sn[8] = {c01.y, c01.w, c23.y, c23.w, c45.y, c45.w, c67.y, c67.w};
#pragma unroll
        for (int e = 0; e < 8; ++e) {
          const float x1 = v[8 + 2 * part][e], x2 = v[9 + 2 * part][e];
          v[8 + 2 * part][e] = x1 * cs[e] - x2 * sn[e];
          v[9 + 2 * part][e] = x2 * cs[e] + x1 * sn[e];
        }
      }
    }
    const float QSCALE = 1.4426950408889634f * 0.07216878364870322f;
#pragma unroll
    for (int ks = 0; ks < 12; ++ks) {
      union { bf16x8 b; unsigned w[4]; } o;
#pragma unroll
      for (int w = 0; w < 4; ++w) o.w[w] = pack2(v[ks][2 * w] * QSCALE, v[ks][2 * w + 1] * QSCALE);
      qf[ks] = o.b;
    }
  }
  f32x16 oacc[4];
#pragma unroll
  for (int a = 0; a < 4; ++a)
#pragma unroll
    for (int r = 0; r < 16; ++r) oacc[a][r] = 0.f;
  float mrun = -INFINITY, lrun = 0.f;
  const int sw = (il >> 1) & 7;
  int ko[4], vob[4];
#pragma unroll
  for (int a = 0; a < 4; ++a) ko[a] = il * 384 + (((2 * a + hh) ^ sw) << 4);
#pragma unroll
  for (int c = 0; c < 4; ++c) vob[c] = il * 128 + (((2 * c + hh) ^ sw) << 4);
  LAS unsigned char* lds = (LAS unsigned char*)smem;
  unsigned kso[3], vso[2];
#pragma unroll
  for (int i = 0; i < 3; ++i) {
    const int id = tid + 512 * i, r = id / 24, pc = id - r * 24;
    const int ch = (pc & ~7) | ((pc & 7) ^ ((r >> 1) & 7));
    kso[i] = (unsigned)(r * 3072 + ch * 16);
  }
#pragma unroll
  for (int i = 0; i < 2; ++i) {
    const int id = tid + 512 * i, dd = id >> 3, pc = id & 7;
    const int ch = pc ^ ((dd >> 1) & 7);
    vso[i] = (unsigned)(dd * Lk * 2 + ch * 16);
  }
  const unsigned ldst = (unsigned)(tid >> 6) * 1024u;
#define ATT_STAGE(kt_, s_)                                                                                      \
  {                                                                                                            \
    const int k0_ = (kt_) * 64;                                                                                \
    const int rowbase_ = kind ? (k0_ < 4096 ? TP + seq * 4096 + k0_ : T + seq * 256 + (k0_ - 4096)) : seq * 256 + k0_; \
    const char* kg_ = (const char*)(Kb + ((size_t)rowbase_ * 8 + h) * 192);                                     \
    const char* vg_ = (const char*)(vbase + k0_);                                                              \
    _Pragma("unroll") for (int i_ = 0; i_ < 3; ++i_)                                                           \
      __builtin_amdgcn_global_load_lds((const unsigned*)(kg_ + kso[i_]), (LAS unsigned*)(lds + (s_) * 40960 + ldst + i_ * 8192), 16, 0, 0); \
    _Pragma("unroll") for (int i_ = 0; i_ < 2; ++i_)                                                           \
      __builtin_amdgcn_global_load_lds((const unsigned*)(vg_ + vso[i_]), (LAS unsigned*)(lds + (s_) * 40960 + 24576 + ldst + i_ * 8192), 16, 0, 0); \
  }
  __syncthreads();
  ATT_STAGE(0, 0)
  asm volatile("s_waitcnt vmcnt(0)" ::: "memory");
  __syncthreads();
  for (int kt = 0; kt < nkt; ++kt) {
    const bool more = kt + 1 < nkt;
    if (more) ATT_STAGE(kt + 1, (kt + 1) & 1)
    const char* Ks = smem + (kt & 1) * 40960;
    const char* Vs = Ks + 24576;
    f32x16 s2[2];
    __builtin_amdgcn_s_setprio(1);
#pragma unroll
    for (int st = 0; st < 2; ++st)
#pragma unroll
      for (int r = 0; r < 16; ++r) s2[st][r] = 0.f;
#pragma unroll
    for (int ks = 0; ks < 12; ++ks)
#pragma unroll
      for (int st = 0; st < 2; ++st) {
        const bf16x8 kf = *(const bf16x8*)(Ks + ko[ks & 3] + st * 12288 + (ks >> 2) * 128);
        s2[st] = __builtin_amdgcn_mfma_f32_32x32x16_bf16(kf, qf[ks], s2[st], 0, 0, 0);
      }
    __builtin_amdgcn_s_setprio(0);
    {
      float pmax = s2[0][0];
#pragma unroll
      for (int r = 1; r < 16; ++r) pmax = fmaxf(pmax, s2[0][r]);
#pragma unroll
      for (int r = 0; r < 16; ++r) pmax = fmaxf(pmax, s2[1][r]);
      { auto rr = __builtin_amdgcn_permlane32_swap(__float_as_uint(pmax), __float_as_uint(pmax), false, false);
        pmax = fmaxf(__uint_as_float(rr[0]), __uint_as_float(rr[1])); }
      if (!__all(pmax - mrun <= 11.541560327f)) {
        const float mn = fmaxf(mrun, pmax);
        const float alpha = __builtin_amdgcn_exp2f(mrun - mn);
        mrun = mn;
        lrun *= alpha;
#pragma unroll
        for (int a = 0; a < 4; ++a)
#pragma unroll
          for (int r = 0; r < 16; ++r) oacc[a][r] *= alpha;
      }
      float psum = 0.f;
#pragma unroll
      for (int st = 0; st < 2; ++st)
#pragma unroll
        for (int r = 0; r < 16; ++r) { const float pv = __builtin_amdgcn_exp2f(s2[st][r] - mrun); s2[st][r] = pv; psum += pv; }
      lrun += psum;
    }
    __builtin_amdgcn_s_setprio(1);
#pragma unroll
    for (int st = 0; st < 2; ++st)
#pragma unroll
      for (int sb = 0; sb < 2; ++sb) {
        union { bf16x8 v; unsigned w[4]; } pb;
#pragma unroll
        for (int w = 0; w < 4; ++w) pb.w[w] = pack2(s2[st][8 * sb + 2 * w], s2[st][8 * sb + 2 * w + 1]);
#pragma unroll
        for (int dt = 0; dt < 4; ++dt) {
          const bf16x8 vf = *(const bf16x8*)(Vs + vob[2 * st + sb] + dt * 4096);
          oacc[dt] = __builtin_amdgcn_mfma_f32_32x32x16_bf16(vf, pb.v, oacc[dt], 0, 0, 0);
        }
      }
    __builtin_amdgcn_s_setprio(0);
    asm volatile("s_waitcnt vmcnt(0)" ::: "memory");
    __syncthreads();
  }
#undef ATT_STAGE
  float ltot;
  { auto rr = __builtin_amdgcn_permlane32_swap(__float_as_uint(lrun), __float_as_uint(lrun), false, false); ltot = __uint_as_float(rr[0]) + __uint_as_float(rr[1]); }
  const float inv = 1.f / ltot;
#pragma unroll
  for (int dt = 0; dt < 4; ++dt)
#pragma unroll
    for (int g = 0; g < 4; ++g) {
      const int d = dt * 32 + 8 * g + 4 * hh;
      *(uint2*)(O + (size_t)tq * 1024 + h * 128 + d) =
          pack4(oacc[dt][4 * g] * inv, oacc[dt][4 * g + 1] * inv, oacc[dt][4 * g + 2] * inv, oacc[dt][4 * g + 3] * inv);
    }
}
DI void phase_attention(const PV& p, int j, char* smem) {
  const bool xmap = gridDim.x == 256;
  const int Gq = opaque_i((int)gridDim.x);
  const int nit = xmap ? 5 : (1280 + Gq - 1) / Gq;
#pragma unroll 1
  for (int r = 0; r < nit; ++r) {
    int kind, seq, h, q0;
    if (xmap) {
      if (r < 4) {
        const int xcd = blockIdx.x & 7, slot = blockIdx.x >> 3;
        const int pair = xcd + 8 * (2 * r + (slot >> 4)), qb = slot & 15;
        kind = 1; seq = pair >> 3; h = pair & 7; q0 = TP + seq * 4096 + qb * 256;
      } else {
        kind = 0; seq = blockIdx.x >> 3; h = blockIdx.x & 7; q0 = seq * 256;
      }
    } else {
      const int it = blockIdx.x + r * gridDim.x;
      if (it >= 1280) break;
      if (it < 1024) { const int pair = it >> 4, qb = it & 15; kind = 1; seq = pair >> 3; h = pair & 7; q0 = TP + seq * 4096 + qb * 256; }
      else { const int i2 = it - 1024; kind = 0; seq = i2 >> 3; h = i2 & 7; q0 = seq * 256; }
    }
    attn_item(p, j, kind, seq, h, q0, smem);
  }
  __syncthreads();
}

DI size_t act_blk(int t, int a) { return (size_t)(t >> 8) * (256 * 2816) + (size_t)(a >> 6) * (256 * 64) + (size_t)((t & 255) * 64 + (a & 63)); }
DI float dpp_ror1(float x) { return __int_as_float(__builtin_amdgcn_update_dpp(0, __float_as_int(x), 0x121, 0xf, 0xf, false)); }
DI float dpp_ror15(float x) { return __int_as_float(__builtin_amdgcn_update_dpp(0, __float_as_int(x), 0x12F, 0xf, 0xf, false)); }
struct EpiFFN {
  u16* ACT; u16* EDGE; const float* cw; const float* cb;
  DI void operator()(const f32x4 (&acc)[2][2][4][2], int pm, int pn, int wr, int wc, int fr, int fq) const {
    uint2 keep[2][4];
#pragma unroll
    for (int n = 0; n < 2; ++n) {
      const int a = pn * 128 + wc * 32 + fq * 8 + n * 4;
      const float4 w0g = *(const float4*)(cw + a), w1g = *(const float4*)(cw + 5632 + a), w2g = *(const float4*)(cw + 11264 + a), bg = *(const float4*)(cb + a);
      const float4 w0u = *(const float4*)(cw + 2816 + a), w1u = *(const float4*)(cw + 5632 + 2816 + a), w2u = *(const float4*)(cw + 11264 + 2816 + a), bu = *(const float4*)(cb + 2816 + a);
#pragma unroll
      for (int ai = 0; ai < 2; ++ai) {
        const int rbase = pm * 256 + ai * 128 + wr * 64;
        const size_t erow = (size_t)(rbase >> 6) * 4;
#pragma unroll
        for (int m = 0; m < 4; ++m) {
          const int mp = m > 0 ? m - 1 : 0, mn = m < 3 ? m + 1 : 3;
          float o[4];
#define FFN_ONE(J, C)                                                                                         \
          {                                                                                                   \
            const float g = acc[ai][0][m][n][J], u = acc[ai][1][m][n][J];                                     \
            const float gpv = m > 0 ? acc[ai][0][mp][n][J] : 0.f, gnx = m < 3 ? acc[ai][0][mn][n][J] : 0.f;   \
            const float upv = m > 0 ? acc[ai][1][mp][n][J] : 0.f, unx = m < 3 ? acc[ai][1][mn][n][J] : 0.f;   \
            const float gp = dpp_ror1(fr == 15 ? gpv : g), gn = dpp_ror15(fr == 0 ? gnx : g);                \
            const float up = dpp_ror1(fr == 15 ? upv : u), un = dpp_ror15(fr == 0 ? unx : u);                \
            const float cg = w0g.C * gp + w1g.C * g + w2g.C * gn + bg.C;                                      \
            const float cu = w0u.C * up + w1u.C * u + w2u.C * un + bu.C;                                      \
            o[J] = silu(cg) * cu;                                                                             \
          }
          FFN_ONE(0, x) FFN_ONE(1, y) FFN_ONE(2, z) FFN_ONE(3, w)
#undef FFN_ONE
          {
            const uint2 cur = pack4(o[0], o[1], o[2], o[3]);
            if (n == 0) keep[ai][m] = cur;
            else { uint4 w; w.x = keep[ai][m].x; w.y = keep[ai][m].y; w.z = cur.x; w.w = cur.y; *(uint4*)(ACT + act_blk(rbase + m * 16 + fr, a - 4)) = w; }
          }
          if ((m == 0 && fr < 2) || (m == 3 && fr >= 14)) {
            const int ri = m == 0 ? fr : fr - 12;
            u16* e = EDGE + (erow + ri) * 5632 + pn * 256 + wc * 32 + fq * 8 + n * 4;
            *(uint2*)e = pack4(acc[ai][0][m][n][0], acc[ai][0][m][n][1], acc[ai][0][m][n][2], acc[ai][0][m][n][3]);
            *(uint2*)(e + 128) = pack4(acc[ai][1][m][n][0], acc[ai][1][m][n][1], acc[ai][1][m][n][2], acc[ai][1][m][n][3]);
          }
        }
      }
    }
  }
};
DI void phase_ffn_up(const PV& p, int l, char* smem) {
  EpiFFN E;
  E.ACT = (u16*)(p.ws() + OFF_B + B_ACT); E.EDGE = (u16*)(p.ws() + OFF_EDGE);
  E.cw = p.in(33) + (size_t)l * 3 * 5632; E.cb = p.in(34) + (size_t)l * 5632;
  TileSched<160, 22, 16, 8, 4, 16, 2> S; S.init();
  gemm8<false, 0, true>(smem, (const u16*)(p.ws() + OFF_A + A_H), (const u16*)(p.ws() + OFF_WUP), 1024, S, E);
}
DI void phase_ffn_fix(const PV& p, int l) {
  const u16* EDGE = (const u16*)(p.ws() + OFF_EDGE);
  u16* ACT = (u16*)(p.ws() + OFF_B + B_ACT);
  const float* cw = p.in(33) + (size_t)l * 3 * 5632;
  const float* cb = p.in(34) + (size_t)l * 5632;
  const unsigned gtid = blockIdx.x * blockDim.x + (unsigned)TIDX(), gsz = gridDim.x * blockDim.x;
  for (unsigned idx = gtid; idx < 640u * 2u * 704u; idx += gsz) {
    const unsigned rq = idx / 704u;
    const int a = (int)(idx - rq * 704u) * 4, rr = (int)rq, which = rr & 1, sidx = rr >> 1;
    const int t = sidx * 64 + (which ? 63 : 0);
    const int tb = which ? t + 1 : t;
    const bool seqb = tb < TP ? (tb & 255) == 0 : ((tb - TP) & 4095) == 0;
    if (seqb) continue;
    const int pc = (a >> 7) * 256 + (a & 127);
    const u16 *pr, *cu, *nx;
    if (which == 0) { pr = EDGE + ((size_t)(sidx - 1) * 4 + 3) * 5632; cu = EDGE + ((size_t)sidx * 4 + 0) * 5632; nx = EDGE + ((size_t)sidx * 4 + 1) * 5632; }
    else { pr = EDGE + ((size_t)sidx * 4 + 2) * 5632; cu = EDGE + ((size_t)sidx * 4 + 3) * 5632; nx = EDGE + ((size_t)(sidx + 1) * 4 + 0) * 5632; }
    const uint2 gp = *(const uint2*)(pr + pc), gc = *(const uint2*)(cu + pc), gn = *(const uint2*)(nx + pc);
    const uint2 up = *(const uint2*)(pr + pc + 128), uc = *(const uint2*)(cu + pc + 128), un = *(const uint2*)(nx + pc + 128);
    const float4 w0g = *(const float4*)(cw + a), w1g = *(const float4*)(cw + 5632 + a), w2g = *(const float4*)(cw + 11264 + a), bg = *(const float4*)(cb + a);
    const float4 w0u = *(const float4*)(cw + 2816 + a), w1u = *(const float4*)(cw + 5632 + 2816 + a), w2u = *(const float4*)(cw + 11264 + 2816 + a), bu = *(const float4*)(cb + 2816 + a);
    const float g0 = w0g.x * lo16(gp.x) + w1g.x * lo16(gc.x) + w2g.x * lo16(gn.x) + bg.x, u0 = w0u.x * lo16(up.x) + w1u.x * lo16(uc.x) + w2u.x * lo16(un.x) + bu.x;
    const float g1 = w0g.y * hi16(gp.x) + w1g.y * hi16(gc.x) + w2g.y * hi16(gn.x) + bg.y, u1 = w0u.y * hi16(up.x) + w1u.y * hi16(uc.x) + w2u.y * hi16(un.x) + bu.y;
    const float g2 = w0g.z * lo16(gp.y) + w1g.z * lo16(gc.y) + w2g.z * lo16(gn.y) + bg.z, u2 = w0u.z * lo16(up.y) + w1u.z * lo16(uc.y) + w2u.z * lo16(un.y) + bu.z;
    const float g3 = w0g.w * hi16(gp.y) + w1g.w * hi16(gc.y) + w2g.w * hi16(gn.y) + bg.w, u3 = w0u.w * hi16(up.y) + w1u.w * hi16(uc.y) + w2u.w * hi16(un.y) + bu.w;
    *(uint2*)(ACT + act_blk(t, a)) = pack4(silu(g0) * u0, silu(g1) * u1, silu(g2) * u2, silu(g3) * u3);
  }
}

#ifndef PH
#define RUN(k, ...) __VA_ARGS__
#else
#define RUN(k, ...) if (PH == k) { __VA_ARGS__ }
#endif
extern "C" __global__ void __launch_bounds__(512) fwd_megakernel(Params kp) {
  extern __shared__ __attribute__((aligned(16))) char smem[];
  cg::grid_group grid = cg::this_grid();
  if (TIDX() == 0) {
    unsigned long long* t = (unsigned long long*)(smem + PARM_OFF);
#pragma unroll
    for (int k = 0; k < 36; ++k) t[k] = (unsigned long long)kp.in[k];
    t[36] = (unsigned long long)kp.out; t[37] = (unsigned long long)kp.ws;
  }
  __syncthreads();
  PV p; p.smem = smem;
  unsigned* bar = (unsigned*)(p.ws() + OFF_BAR);
  if (TIDX() == 0) { *(unsigned*)(smem + PARM_OFF + 512) = 0u; *(unsigned*)(smem + PARM_OFF + 516) = 0u; }
  __syncthreads();
  const XcdBarrier xb = xcd_barrier_post(bar, (volatile LASB unsigned*)(smem + PARM_OFF + 512));
  RUN(0, phase_prep(p, smem);)
  grid.sync();
  RUN(1, phase_filters(p, smem);)
  for (int l = 0; l < 4; ++l) {
    const int i = l >> 1;
    RUN(2, phase_norm(p, l, 0, l);)
    RUN(0, if (l > 0) { int base = 0; convert_ffn_weights(p, l, smem, base); })
    xcd_barrier(xb);
    if ((l & 1) == 0) {
      RUN(3, phase_mix_in(p, i, smem);)
      xcd_barrier(xb);
      RUN(4, phase_sgu(p, i, smem);)
      RUN(5, phase_conv(p, i, 0, smem);)
      xcd_barrier(xb);
      RUN(5, phase_conv(p, i, 1, smem);)
      xcd_barrier(xb);
      RUN(6, phase_ztrans(p, smem);)
      xcd_barrier(xb);
      RUN(7, phase_resid_gemm(p, l, l, (const u16*)(p.ws() + OFF_B + B_MIX), 1024, (const u16*)(p.ws() + OFF_WMIXOUT) + (size_t)i * 1024 * 1024, 2048, smem);)
      xcd_barrier(xb);
    } else {
      RUN(8, phase_dqkv(p, i, smem);)
      xcd_barrier(xb);
      RUN(9, phase_mla_norms(p, i);)
      xcd_barrier(xb);
      RUN(10, phase_uq_ukv(p, i, smem);)
      xcd_barrier(xb);
      RUN(11, phase_finalize(p, i);)
      xcd_barrier(xb);
      RUN(12, phase_attention(p, i, smem);)
      xcd_barrier(xb);
      RUN(7, phase_resid_gemm(p, l, l, (const u16*)(p.ws() + OFF_A + A_O), 1024, (const u16*)(p.ws() + OFF_WO) + (size_t)i * 1024 * 1024, 2048, smem);)
      xcd_barrier(xb);
    }
    RUN(2, phase_norm(p, l, 1, 1);)
    xcd_barrier(xb);
    RUN(13, phase_ffn_up(p, l, smem);)
    xcd_barrier(xb);
    RUN(14, phase_ffn_fix(p, l);)
    xcd_barrier(xb);
    RUN(7, phase_resid_gemm(p, l, 1, (const u16*)(p.ws() + OFF_B + B_ACT), 2816, (const u16*)(p.ws() + OFF_WDOWN), 5120, smem);)
    xcd_barrier(xb);
  }
}

extern "C" void kernel_launch(void* const* d_in, const int* in_sizes, int n_in,
                              void* d_out, int out_size, void* d_ws, size_t ws_size,
                              hipStream_t stream) {
  static int grid_blocks = 0;
  if (!grid_blocks) {
    int dev = 0, cus = 0, per_cu = 0;
    (void)hipGetDevice(&dev);
    (void)hipDeviceGetAttribute(&cus, hipDeviceAttributeMultiprocessorCount, dev);
    (void)hipFuncSetAttribute((const void*)fwd_megakernel, hipFuncAttributeMaxDynamicSharedMemorySize, (int)LDS_BYTES);
    (void)hipOccupancyMaxActiveBlocksPerMultiprocessor(&per_cu, fwd_megakernel, 512, LDS_BYTES);
    if (per_cu < 1) per_cu = 1;
    if (per_cu > 1) per_cu = 1;
    grid_blocks = cus * per_cu;
  }
  if (ws_size < WS_NEED) fprintf(stderr, "workspace too small: %zu < %zu\n", ws_size, (size_t)WS_NEED);
  Params p{};
  for (int i = 0; i < 36; ++i) p.in[i] = (const float*)d_in[i];
  p.out = (float*)d_out;
  p.ws = (char*)d_ws;
  (void)hipMemsetAsync((char*)d_ws + OFF_BAR, 0, 16384, stream);
  void* args[] = {&p};
  hipError_t e = hipLaunchCooperativeKernel((void*)fwd_megakernel, dim3(grid_blocks), dim3(512), args, LDS_BYTES, stream);
  if (e != hipSuccess) fprintf(stderr, "cooperative launch failed: %s (grid %d)\n", hipGetErrorString(e), grid_blocks);
}
```

```cpp
#include <hip/hip_runtime.h>
#include <hip/hip_cooperative_groups.h>
#include <cstdio>
namespace cg = cooperative_groups;

typedef unsigned short u16;
using bf16x8 = __attribute__((ext_vector_type(8))) short;
using f32x4 = __attribute__((ext_vector_type(4))) float;
using f32x16 = __attribute__((ext_vector_type(16))) float;
#define DI __device__ __forceinline__

constexpr int T = 40960;
constexpr int TP = 8192;
constexpr int TK = 43008;
constexpr float EPS = 1e-6f;
constexpr size_t LDS_BYTES = 139264;

constexpr size_t OFF_WMIXIN = 0;
constexpr size_t OFF_WMIXOUT = OFF_WMIXIN + (size_t)2 * 2560 * 1024 * 2;
constexpr size_t OFF_WDQKV = OFF_WMIXOUT + (size_t)2 * 1024 * 1024 * 2;
constexpr size_t OFF_WUQ = OFF_WDQKV + (size_t)2 * 1024 * 1024 * 2;
constexpr size_t OFF_WUKV = OFF_WUQ + (size_t)2 * 1536 * 512 * 2;
constexpr size_t OFF_WO = OFF_WUKV + (size_t)2 * 2048 * 256 * 2;
constexpr size_t OFF_WSGU = OFF_WO + (size_t)2 * 1024 * 1024 * 2;
constexpr size_t OFF_WUP = OFF_WSGU + (size_t)2 * 4 * 128 * 128 * 2;
constexpr size_t OFF_WDOWN = OFF_WUP + (size_t)5632 * 1024 * 2;
constexpr size_t OFF_MOD = OFF_WDOWN + (size_t)1024 * 2816 * 2;
constexpr size_t OFF_FILT = OFF_MOD + (size_t)4 * 9 * 6144 * 4;
constexpr size_t OFF_H2 = OFF_FILT + (size_t)2 * 2 * 512 * 4352 * 2;
constexpr size_t OFF_EDGE = OFF_H2 + (size_t)2 * 4352 * 64 * 4;
constexpr size_t OFF_KR = OFF_EDGE + (size_t)640 * 4 * 5632 * 2;
constexpr size_t OFF_A = OFF_KR + (size_t)TK * 64 * 2;
constexpr size_t OFF_B = OFF_A + (size_t)T * 1024 * 2;
constexpr size_t OFF_BAR = OFF_B + (size_t)346030080;
constexpr size_t OFF_ROPE = OFF_BAR + 16384;
constexpr size_t WS_NEED = OFF_ROPE + 64 * 16 * 8;
constexpr size_t A_H = 0, A_Z1 = 0, A_Z2 = (size_t)T * 512 * 2, A_QN = 0, A_CKV = (size_t)T * 512 * 2, A_O = 0;
constexpr size_t B_VT = 0, B_PRT = (size_t)T * 512 * 2, B_MIX = B_PRT + (size_t)T * 1536 * 2;
constexpr size_t B_DQKV = 0, B_Q = 0, B_K = (size_t)T * 1536 * 2, B_V = B_K + (size_t)TK * 1536 * 2;
constexpr size_t B_ACT = 0;
constexpr size_t VT_SAMPLE_OFF = (size_t)32 * 8 * 128 * 256;

struct Params {
  const float* in[36];
  float* out;
  char* ws;
};


constexpr int PARM_OFF = 138240;
struct PV {
  char* smem;
  DI unsigned long long ld(int k) const {
    int off = PARM_OFF + 8 * k;
    asm volatile("" : "+v"(off));
    const unsigned long long v = *(const unsigned long long*)(smem + off);
    const unsigned lo = __builtin_amdgcn_readfirstlane((unsigned)v), hi = __builtin_amdgcn_readfirstlane((unsigned)(v >> 32));
    return ((unsigned long long)hi << 32) | lo;
  }
  DI const float* in(int k) const { return (const float*)(const __attribute__((address_space(1))) float*)ld(k); }
  DI float* out() const { return (float*)(__attribute__((address_space(1))) float*)ld(36); }
  DI char* ws() const { return (char*)(__attribute__((address_space(1))) char*)ld(37); }
};

DI int TIDX() { int t = (int)__builtin_amdgcn_workitem_id_x(); asm volatile("" : "+v"(t)); return t; }
DI u16 f2bf(float x) { unsigned u = __float_as_uint(x); u += 0x7fffu + ((u >> 16) & 1u); return (u16)(u >> 16); }
DI float bf2f(u16 h) { return __uint_as_float(((unsigned)h) << 16); }
DI unsigned pack2(float a, float b) { unsigned r; asm("v_cvt_pk_bf16_f32 %0, %1, %2" : "=v"(r) : "v"(a), "v"(b)); return r; }
DI uint2 pack4(float a, float b, float c, float d) { uint2 r; r.x = pack2(a, b); r.y = pack2(c, d); return r; }
DI float lo16(unsigned w) { return __uint_as_float(w << 16); }
DI float hi16(unsigned w) { return __uint_as_float(w & 0xffff0000u); }
DI float gelu_tanh(float x) { const float y = x * (1.f + 0.044715f * x * x); return x * __builtin_amdgcn_rcpf(1.f + __builtin_amdgcn_exp2f(-2.302208198f * y)); }
DI float silu(float x) { return x * __builtin_amdgcn_rcpf(1.f + __builtin_amdgcn_exp2f(-1.4426950409f * x)); }
DI float4 ld16_nt(const float* ptr) { const f32x4 t = __builtin_nontemporal_load((const f32x4*)ptr); float4 r; r.x = t[0]; r.y = t[1]; r.z = t[2]; r.w = t[3]; return r; }
DI void st16_nt(float* ptr, float4 v) { const f32x4 t = {v.x, v.y, v.z, v.w}; __builtin_nontemporal_store(t, (f32x4*)ptr); }
DI int condrow(int m) { return m < TP ? 0 : 1 + ((m - TP) >> 12); }
template <int MASK> DI float shx(float v, int lane) {
  if (MASK == 32) return __int_as_float(__builtin_amdgcn_ds_bpermute((lane ^ 32) << 2, __float_as_int(v)));
  return __int_as_float(__builtin_amdgcn_ds_swizzle(__float_as_int(v), (MASK << 10) | 0x1f));
}
DI float wave_sum(float v, int lane) {
  v += shx<32>(v, lane); v += shx<16>(v, lane); v += shx<8>(v, lane);
  v += shx<4>(v, lane); v += shx<2>(v, lane); v += shx<1>(v, lane); return v;
}
DI int opaque_i(int x) { asm volatile("" : "+s"(x)); return x; }
DI int first_unit(int base) { const int G = opaque_i((int)gridDim.x); int r = (int)blockIdx.x - (base % G); if (r < 0) r += G; return r; }
DI const float* xin_row(const PV& p, int l, int m) {
  if (l == 0) return m < TP ? p.in(0) + (size_t)m * 1024 : p.in(1) + (size_t)(m - TP) * 1024;
  return p.out() + (size_t)m * 1024;
}


#define XB_TMO      128
#define XB_XCNT(j)  (256  + 64 * (j))
#define XB_XSUB(j)  (1280 + 64 * (j))
#define XB_XGEN(j)  (2304 + 64 * (j))
#define XB_TOP      3328
#define XB_TOPGEN   3392
#define XB_SPIN_CAP (1u << 22)
#define LASB __attribute__((address_space(3)))
DI unsigned xb_ld(unsigned* p) { return __hip_atomic_load(p, __ATOMIC_RELAXED, __HIP_MEMORY_SCOPE_AGENT); }
DI unsigned xb_add(unsigned* p, unsigned v) { return __hip_atomic_fetch_add(p, v, __ATOMIC_RELAXED, __HIP_MEMORY_SCOPE_AGENT); }
DI unsigned xb_xcc_id() { return (unsigned)__builtin_amdgcn_s_getreg((3 << 11) | 20) & 0xFu; }
#define XB_SPIN(cond, bar) do { unsigned _sp = 0; while (cond) { __builtin_amdgcn_s_sleep(1); \
    if ((++_sp & 255u) == 0u) { if (xb_ld(&(bar)[XB_TMO])) break; if (_sp > XB_SPIN_CAP) { atomicAdd(&(bar)[XB_TMO], 1u); break; } } } } while (0)
struct XcdBarrier { unsigned* bar; unsigned x; volatile LASB unsigned* st; };
DI XcdBarrier xcd_barrier_post(unsigned* bar, volatile LASB unsigned* st) {
  XcdBarrier b; b.bar = bar; b.x = xb_xcc_id(); b.st = st;
  if (TIDX() == 0) (void)xb_add(&bar[XB_XCNT(b.x)], 1u);
  return b;
}
DI void xcd_barrier_complete(unsigned* bar, unsigned x, unsigned& nloc, unsigned& nx) {
  const unsigned G = gridDim.x;
  unsigned sum, cnt, mine, sp = 0u;
  for (;;) {
    sum = 0u; cnt = 0u; mine = 0u;
#pragma unroll
    for (unsigned j = 0; j < 16; ++j) { const unsigned c = xb_ld(&bar[XB_XCNT(j)]); sum += c; cnt += (c > 0u) ? 1u : 0u; mine = (j == x) ? c : mine; }
    if (sum == G) break;
    __builtin_amdgcn_s_sleep(1);
    if ((++sp & 255u) == 0u) { if (xb_ld(&bar[XB_TMO])) break; if (sp > XB_SPIN_CAP) { atomicAdd(&bar[XB_TMO], 1u); break; } }
  }
  nloc = mine > 0u ? mine : 1u; nx = cnt > 0u ? cnt : 1u;
}
DI void xcd_barrier(const XcdBarrier& b) {
  asm volatile("s_waitcnt vmcnt(0)" ::: "memory");
  __syncthreads();
  if (TIDX() == 0) {
    unsigned* bar = b.bar;
    __builtin_amdgcn_s_waitcnt(0);
    unsigned nloc = b.st[0], nx = b.st[1];
    if (nloc == 0u) { xcd_barrier_complete(bar, b.x, nloc, nx); b.st[0] = nloc; b.st[1] = nx; }
    const unsigned old = xb_add(&bar[XB_XSUB(b.x)], 1u);
    const unsigned gen = old / nloc;
    if (old + 1u == (gen + 1u) * nloc) {
      __builtin_amdgcn_fence(__ATOMIC_RELEASE, "agent");
      asm volatile("s_waitcnt vmcnt(0)" ::: "memory");
      const unsigned og = xb_add(&bar[XB_TOP], 1u);
      const unsigned tg = og / nx;
      if (og + 1u == (tg + 1u) * nx) xb_add(&bar[XB_TOPGEN], 1u);
      else XB_SPIN(xb_ld(&bar[XB_TOPGEN]) == tg, bar);
      __builtin_amdgcn_fence(__ATOMIC_ACQUIRE, "agent");
      xb_add(&bar[XB_XGEN(b.x)], 1u);
      asm volatile("s_waitcnt vmcnt(0)" ::: "memory");
    } else {
      XB_SPIN(xb_ld(&bar[XB_XGEN(b.x)]) == gen, bar);
      __builtin_amdgcn_fence(__ATOMIC_ACQUIRE, "agent");
      asm volatile("s_waitcnt vmcnt(0)" ::: "memory");
    }
  }
  __syncthreads();
}

template <int MODE>
DI int rowmap(int n, int row0) {
  if (MODE == 0) return n + row0;
  return n < 2816 ? (n >> 7) * 256 + (n & 127) : ((n - 2816) >> 7) * 256 + 128 + ((n - 2816) & 127);
}
template <int MODE, int NJ = 4>
DI void convT(const float* __restrict__ src, u16* __restrict__ dst, int K, int N, int row0, char* smem, int& base) {
  u16* tl = (u16*)smem;
  const int tid = TIDX();
  const int nN = N / (64 * NJ), nunits = (K >> 6) * nN;
  for (int u = first_unit(base); u < nunits; u += gridDim.x) {
    const int k0 = (u / nN) << 6, n0 = (u % nN) * (64 * NJ);
    float4 v[2][NJ];
#pragma unroll
    for (int i = 0; i < 2; ++i)
#pragma unroll
      for (int j = 0; j < NJ; ++j)
        v[i][j] = *(const float4*)(src + (size_t)(k0 + (tid >> 4) + 32 * i) * N + n0 + (tid & 15) * 4 + 64 * j);
#pragma unroll
    for (int i = 0; i < 2; ++i)
#pragma unroll
      for (int j = 0; j < NJ; ++j) {
        const int r = (tid >> 4) + 32 * i, c4 = (tid & 15) * 4 + 64 * j;
        tl[(c4 + 0) * 72 + r] = f2bf(v[i][j].x); tl[(c4 + 1) * 72 + r] = f2bf(v[i][j].y);
        tl[(c4 + 2) * 72 + r] = f2bf(v[i][j].z); tl[(c4 + 3) * 72 + r] = f2bf(v[i][j].w);
      }
    __syncthreads();
#pragma unroll
    for (int j = 0; j < NJ; ++j) {
      const int n = (tid >> 3) + 64 * j, kc = (tid & 7) * 8;
      const uint4 o = *(const uint4*)(tl + n * 72 + kc);
      { const int rr = rowmap<MODE>(n0 + n, row0);
        *(uint4*)(dst + (size_t)(rr >> 8) * 256 * K + (size_t)(k0 >> 6) * (256 * 64) + (rr & 255) * 64 + kc) = o; }
    }
    __syncthreads();
  }
  base += nunits;
}

DI void convert_ffn_weights(const PV& p, int l, char* smem, int& base) {
  convT<1>(p.in(32) + (size_t)l * 1024 * 5632, (u16*)(p.ws() + OFF_WUP), 1024, 5632, 0, smem, base);
  convT<0>(p.in(35) + (size_t)l * 2816 * 1024, (u16*)(p.ws() + OFF_WDOWN), 2816, 1024, 0, smem, base);
}

DI void phase_prep(const PV& p, char* smem) {
  const int tid = TIDX();
  int base = 0;
  char* ws = p.ws();
  for (int i = 0; i < 2; ++i) {
    convT<0>(p.in(9) + (size_t)i * 1024 * 2560, (u16*)(ws + OFF_WMIXIN) + (size_t)i * 2560 * 1024, 1024, 2560, 0, smem, base);
    convT<0>(p.in(22) + (size_t)i * 1024 * 1024, (u16*)(ws + OFF_WMIXOUT) + (size_t)i * 1024 * 1024, 1024, 1024, 0, smem, base);
    convT<0>(p.in(23) + (size_t)i * 1024 * 512, (u16*)(ws + OFF_WDQKV) + (size_t)i * 1024 * 1024, 1024, 512, 0, smem, base);
    convT<0, 1>(p.in(26) + (size_t)i * 1024 * 320, (u16*)(ws + OFF_WDQKV) + (size_t)i * 1024 * 1024, 1024, 320, 512, smem, base);
    convT<0>(p.in(25) + (size_t)i * 512 * 1536, (u16*)(ws + OFF_WUQ) + (size_t)i * 1536 * 512, 512, 1536, 0, smem, base);
    convT<0>(p.in(28) + (size_t)i * 256 * 2048, (u16*)(ws + OFF_WUKV) + (size_t)i * 2048 * 256, 256, 2048, 0, smem, base);
    convT<0>(p.in(31) + (size_t)i * 1024 * 1024, (u16*)(ws + OFF_WO) + (size_t)i * 1024 * 1024, 1024, 1024, 0, smem, base);
  }
  convert_ffn_weights(p, 0, smem, base);
  {
    const long gtid = (long)blockIdx.x * blockDim.x + tid, gsz = (long)gridDim.x * blockDim.x;
    for (long i = gtid; i < 2 * 192 * 1024; i += gsz) {
      const int j = (int)(i / (192 * 1024)), rem = (int)(i % (192 * 1024)), rr = 832 + (rem >> 10), k = rem & 1023;
      ((u16*)(ws + OFF_WDQKV))[(size_t)j * 1024 * 1024 + (size_t)(rr >> 8) * 256 * 1024 + (size_t)(k >> 6) * (256 * 64) + (rr & 255) * 64 + (k & 63)] = 0;
    }
    for (long i = gtid; i < 2 * 4 * 128 * 128; i += gsz) ((u16*)(ws + OFF_WSGU))[i] = f2bf(p.in(10)[i]);
    for (long i = gtid; i < 64 * 16; i += gsz) {
      const int pos = (int)(i >> 4), f = (int)(i & 15);
      const float inv = exp2f(-(float)f * (13.287712379549449f / 16.f));
      float sn, cs;
      sincosf((float)pos * inv, &sn, &cs);
      ((float2*)(ws + OFF_ROPE))[i] = make_float2(cs, sn);
    }
  }
  {
    float* sc = (float*)smem;
    float* part = sc + 9 * 1024;
    __syncthreads();
    for (int i = tid; i < 9 * 1024; i += 512) {
      const int r = i >> 10, k = i & 1023;
      const float c = r == 0 ? p.in(5)[k] : p.in(4)[(r - 1) * 1024 + k];
      sc[i] = silu(c);
    }
    __syncthreads();
    float* MOD = (float*)(ws + OFF_MOD);
    const int nunits = 4 * 96;
    for (int u = first_unit(base); u < nunits; u += gridDim.x) {
      const int l = u / 96, n0 = (u % 96) * 64;
      const int col = n0 + (tid & 63), kg = tid >> 6;
      float acc[9];
#pragma unroll
      for (int r = 0; r < 9; ++r) acc[r] = 0.f;
      const float* w = p.in(6) + (size_t)l * 1024 * 6144 + col;
#pragma unroll 16
      for (int k = kg * 128; k < kg * 128 + 128; ++k) {
        const float wv = w[(size_t)k * 6144];
#pragma unroll
        for (int r = 0; r < 9; ++r) acc[r] += sc[r * 1024 + k] * wv;
      }
#pragma unroll
      for (int r = 0; r < 9; ++r) part[(kg * 9 + r) * 64 + (tid & 63)] = acc[r];
      __syncthreads();
      for (int i = tid; i < 576; i += 512) {
        const int r = i >> 6, cc = i & 63;
        float s = p.in(7)[l * 6144 + n0 + cc];
#pragma unroll
        for (int g = 0; g < 8; ++g) s += part[(g * 9 + r) * 64 + cc];
        MOD[(size_t)(l * 9 + r) * 6144 + n0 + cc] = s;
      }
      __syncthreads();
    }
    base += nunits;
  }
  {
    float* zf = (float*)smem;
    float* h1 = zf + 8 * 36;
    float* H2 = (float*)(ws + OFF_H2);
    const int nunits = 2 * 544;
    for (int u = first_unit(base); u < nunits; u += gridDim.x) {
      const int i = u / 544, tg0 = (u % 544) * 8;
      __syncthreads();
      if (tid < 8 * 33) {
        const int tt = tid / 33, e = tid % 33;
        const int tg = tg0 + tt;
        const float L = tg < 256 ? 256.f : 4096.f;
        const float t = tg < 256 ? (float)tg : (float)(tg - 256);
        const float tn = t / L;
        float v;
        if (e == 0) v = tn;
        else if (e <= 16) v = sinf((6.283185307179586f * tn) * (float)e);
        else v = cosf((6.283185307179586f * tn) * (float)(e - 16));
        zf[tt * 36 + e] = v;
      }
      __syncthreads();
      const int tt = tid >> 6, jj = tid & 63;
      const float fr = p.in(19)[i * 64 + jj];
      {
        float a = p.in(15)[i * 64 + jj];
        const float* w1 = p.in(14) + (size_t)i * 33 * 64 + jj;
        for (int e = 0; e < 33; ++e) a += zf[tt * 36 + e] * w1[e * 64];
        h1[tt * 64 + jj] = sinf(fr * a);
      }
      __syncthreads();
      {
        float a = p.in(17)[i * 64 + jj];
        const float* w2 = p.in(16) + (size_t)i * 64 * 64 + jj;
        for (int e = 0; e < 64; ++e) a += h1[tt * 64 + e] * w2[e * 64];
        H2[((size_t)i * 4352 + tg0 + tt) * 64 + jj] = sinf(fr * a);
      }
    }
    base += nunits;
    __syncthreads();
  }
}

DI void phase_filters(const PV& p, char* smem) {
  const int tid = TIDX();
  float* w3s = (float*)smem;
  float* red = w3s + 512;
  float* nrm = red + 512;
  float* hbuf = nrm + 8;
  const float* H2 = (const float*)(p.ws() + OFF_H2);
  u16* FILT = (u16*)(p.ws() + OFF_FILT);
  for (int u = blockIdx.x; u < 512; u += gridDim.x) {
    const int kind = (u >> 7) & 1, i = u >> 8, cg8 = (u & 127) * 8;
    const int L = kind ? 4096 : 256, tbase = kind ? 256 : 0;
    __syncthreads();
    { const int j = tid >> 3, cc = tid & 7; w3s[j * 8 + cc] = p.in(18)[((size_t)i * 64 + j) * 1024 + cg8 + cc]; }
    __syncthreads();
    const int cc = tid & 7, tq = tid >> 3;
    const int col = cg8 + cc, o = col >> 9, c = col & 511;
    const float dec = fabsf(p.in(20)[(i * 2 + o) * 512 + c]);
    float asum = 0.f;
    for (int t = tq; t < L; t += 64) {
      const float4* hr = (const float4*)(H2 + ((size_t)i * 4352 + tbase + t) * 64);
      float a = 0.f;
#pragma unroll
      for (int j4 = 0; j4 < 16; ++j4) {
        const float4 hv = hr[j4];
        a += hv.x * w3s[(j4 * 4 + 0) * 8 + cc]; a += hv.y * w3s[(j4 * 4 + 1) * 8 + cc];
        a += hv.z * w3s[(j4 * 4 + 2) * 8 + cc]; a += hv.w * w3s[(j4 * 4 + 3) * 8 + cc];
      }
      const float dist = fabsf((float)(t - L / 2)) / (float)L;
      a *= expf(-dec * dist);
      hbuf[cc * L + t] = a;
      asum += fabsf(a);
    }
    red[tid] = asum;
    __syncthreads();
    if (tid < 8) { float s = 0.f; for (int q = 0; q < 64; ++q) s += red[q * 8 + tid]; nrm[tid] = 1.f / (s + EPS); }
    __syncthreads();
    const int lgL = kind ? 12 : 8;
    for (int idx = tid; idx < 8 * L; idx += 512) {
      const int c2 = idx >> lgL, t = idx & (L - 1);
      const int col2 = cg8 + c2, o2 = col2 >> 9, cch = col2 & 511;
      FILT[((size_t)(i * 2 + o2) * 512 + cch) * 4352 + tbase + t] = f2bf(hbuf[c2 * L + t] * nrm[c2]);
    }
  }
  __syncthreads();
}

DI void phase_norm(const PV& p, int l, int part, int lx) {
  const int tid_ = TIDX(); const int lane = tid_ & 63, wid = tid_ >> 6;
  const float* MOD = (const float*)(p.ws() + OFF_MOD);
  const float* g = p.in(8) + (size_t)(l * 2 + part) * 1024;
  u16* H = (u16*)(p.ws() + OFF_A + A_H);
  const int stride = gridDim.x * 8;
  for (int row0 = blockIdx.x * 8 + wid; row0 < T; row0 += 2 * stride) {
    float4 v[2][4];
#pragma unroll
    for (int w = 0; w < 2; ++w) {
      const int row = row0 + w * stride;
      if (row < T) {
        const float* xr = xin_row(p, lx, row);
#pragma unroll
        for (int i = 0; i < 4; ++i) v[w][i] = *(const float4*)(xr + (i * 64 + lane) * 4);
      }
    }
#pragma unroll
    for (int w = 0; w < 2; ++w) {
      const int row = row0 + w * stride;
      if (row < T) {
        float ss = 0.f;
#pragma unroll
        for (int i = 0; i < 4; ++i) ss += v[w][i].x * v[w][i].x + v[w][i].y * v[w][i].y + v[w][i].z * v[w][i].z + v[w][i].w * v[w][i].w;
        ss = wave_sum(ss, lane);
        const float r = rsqrtf(ss * (1.f / 1024.f) + EPS);
        const float* mr = MOD + (size_t)(l * 9 + condrow(row)) * 6144 + part * 3072;
#pragma unroll
        for (int i = 0; i < 4; ++i) {
          const int k = (i * 64 + lane) * 4;
          const float4 gv = *(const float4*)(g + k), sh = *(const float4*)(mr + k), sc = *(const float4*)(mr + 1024 + k);
          const float a = v[w][i].x * r * gv.x * (1.f + sc.x) + sh.x;
          const float b = v[w][i].y * r * gv.y * (1.f + sc.y) + sh.y;
          const float c = v[w][i].z * r * gv.z * (1.f + sc.z) + sh.z;
          const float d = v[w][i].w * r * gv.w * (1.f + sc.w) + sh.w;
          *(uint2*)(H + (size_t)row * 1024 + k) = pack4(a, b, c, d);
        }
      }
    }
  }
}

template <bool SWAP, class Epi, class Pre>
DI void gemm_tile(const u16* A, int lda, const u16* Bt, int ldb, int K, int m0, int n0, char* smem, Epi epi, Pre pre) {
  const int tid = TIDX(), lane = tid & 63, wid = tid >> 6;
  const int wm = wid >> 1, wn = wid & 1, fr = lane & 15, fq = lane >> 4;
  const int lrow = tid >> 3, kc = tid & 7;
  const u16* ga = A + (size_t)(m0 + lrow) * lda + kc * 8;
  const u16* gb = Bt + (size_t)(n0 + lrow) * ldb + kc * 8;
  const int soff = lrow * 128 + ((kc ^ (lrow & 7)) << 4);
  uint4 ra[4], rb[2];
  f32x4 acc[4][4];
#pragma unroll
  for (int i = 0; i < 4; ++i)
#pragma unroll
    for (int j = 0; j < 4; ++j) acc[i][j] = f32x4{0.f, 0.f, 0.f, 0.f};
  const int nk = K >> 6;
#pragma unroll
  for (int i = 0; i < 4; ++i) ra[i] = *(const uint4*)(ga + (size_t)(64 * i) * lda);
#pragma unroll
  for (int i = 0; i < 2; ++i) rb[i] = *(const uint4*)(gb + (size_t)(64 * i) * ldb);
#pragma unroll
  for (int i = 0; i < 4; ++i) *(uint4*)(smem + soff + i * 8192) = ra[i];
#pragma unroll
  for (int i = 0; i < 2; ++i) *(uint4*)(smem + 32768 + soff + i * 8192) = rb[i];
  __syncthreads();
  for (int kt = 0; kt < nk; ++kt) {
    const bool more = kt + 1 < nk;
    if (more) {
      const int k0 = (kt + 1) << 6;
#pragma unroll
      for (int i = 0; i < 4; ++i) ra[i] = *(const uint4*)(ga + (size_t)(64 * i) * lda + k0);
#pragma unroll
      for (int i = 0; i < 2; ++i) rb[i] = *(const uint4*)(gb + (size_t)(64 * i) * ldb + k0);
    }
    const char* sa = smem + (kt & 1) * 49152;
    const char* sb = sa + 32768;
#pragma unroll
    for (int ks = 0; ks < 2; ++ks) {
      bf16x8 af[4], bfv[4];
      const int co = ((ks * 4 + fq) ^ (fr & 7)) << 4;
#pragma unroll
      for (int mi = 0; mi < 4; ++mi) af[mi] = *(const bf16x8*)(sa + (wm * 64 + mi * 16 + fr) * 128 + co);
#pragma unroll
      for (int ni = 0; ni < 4; ++ni) bfv[ni] = *(const bf16x8*)(sb + (wn * 64 + ni * 16 + fr) * 128 + co);
#pragma unroll
      for (int mi = 0; mi < 4; ++mi)
#pragma unroll
        for (int ni = 0; ni < 4; ++ni)
          acc[mi][ni] = SWAP ? __builtin_amdgcn_mfma_f32_16x16x32_bf16(bfv[ni], af[mi], acc[mi][ni], 0, 0, 0)
                             : __builtin_amdgcn_mfma_f32_16x16x32_bf16(af[mi], bfv[ni], acc[mi][ni], 0, 0, 0);
    }
    if (more) {
      char* da = smem + ((kt + 1) & 1) * 49152;
#pragma unroll
      for (int i = 0; i < 4; ++i) *(uint4*)(da + soff + i * 8192) = ra[i];
#pragma unroll
      for (int i = 0; i < 2; ++i) *(uint4*)(da + 32768 + soff + i * 8192) = rb[i];
    }
    __syncthreads();
  }
  uint2 pv[4][4];
#pragma unroll
  for (int mi = 0; mi < 4; ++mi)
#pragma unroll
    for (int ni = 0; ni < 4; ++ni) {
      if (SWAP) pv[mi][ni] = pre(m0 + wm * 64 + mi * 16 + fr, n0 + wn * 64 + ni * 16 + fq * 4);
      else pv[mi][ni] = pre(m0 + wm * 64 + mi * 16 + fq * 4, n0 + wn * 64 + ni * 16 + fr);
    }
#pragma unroll
  for (int mi = 0; mi < 4; ++mi)
#pragma unroll
    for (int ni = 0; ni < 4; ++ni) {
      if (SWAP) epi(m0 + wm * 64 + mi * 16 + fr, n0 + wn * 64 + ni * 16 + fq * 4, acc[mi][ni], pv[mi][ni]);
      else epi(m0 + wm * 64 + mi * 16 + fq * 4, n0 + wn * 64 + ni * 16 + fr, acc[mi][ni], pv[mi][ni]);
    }
}

template <class F>
DI void for_tiles(int nM, int nN, int sm, int sn, F f) {
  if (gridDim.x == 256) {
    const int xcd = blockIdx.x & 7, slot = blockIdx.x >> 3;
    const int am = slot % sm, bn = slot / sm;
    const int nSN = (nN + sn - 1) / sn, nS = (nM / sm) * nSN;
    for (int st = xcd; st < nS; st += 8) {
      const int tm = (st / nSN) * sm + am, tn = (st % nSN) * sn + bn;
      if (tn < nN) f(tm, tn);
    }
  } else {
    for (int t = blockIdx.x; t < nM * nN; t += gridDim.x) f(t / nN, t % nN);
  }
}


#define LAS __attribute__((address_space(3)))
constexpr int G8_HTB = 128 * 64 * 2;
DI int g8_lds_byte(int r, int c) { const int st = (r >> 4) * 2 + (c >> 5), rr = r & 15, cc = c & 31, ob = rr * 64 + cc * 2; return st * 1024 + (ob ^ (((ob >> 9) & 1) << 5)); }
DI void g8_stage_rc(int b, int& R, int& C) { const int st = b / 1024, sb = b % 1024, swz = sb ^ (((sb >> 9) & 1) << 5); R = (st >> 1) * 16 + swz / 64; C = (st & 1) * 32 + (swz % 64) / 2; }
template <int NM, int NN, int NN1, int SM1, int SN1, int SM2, int SN2>
struct TileSched {
  static constexpr int nSN1 = NN1 / SN1, nS1 = (NM / SM1) * nSN1, nSN2 = (NN - NN1) / SN2, nS2 = (NM / SM2) * nSN2, nT = NM * NN;
  int c;
  DI void init() { c = blockIdx.x; }
  DI bool next(int i, int& pm, int& pn) const {
    if (gridDim.x == 256) {
      const int xcd = c & 7, slot = c >> 3;
      int st = xcd + 8 * i;
      if (st < nS1) { pm = (st / nSN1) * SM1 + slot % SM1; pn = (st % nSN1) * SN1 + slot / SM1; return true; }
      st -= nS1;
      if (nS2 == 0 || st >= nS2) return false;
      pm = (st / (nSN2 > 0 ? nSN2 : 1)) * SM2 + slot % SM2; pn = NN1 + (st % (nSN2 > 0 ? nSN2 : 1)) * SN2 + slot / SM2; return true;
    }
    const int L = i * (int)gridDim.x + c; if (L >= nT) return false; pm = L / NN; pn = L % NN; return true;
  }
};
template <bool ABLK = false, int SWM = 0, bool PERMB = false, class Sched, class Epi>
DI void gemm8(char* smem, const u16* A, const u16* Bt, int K, const Sched& S, const Epi& E) {
  LAS unsigned char* lds = (LAS unsigned char*)smem;
  const int tid = TIDX(), wid = __builtin_amdgcn_readfirstlane(tid >> 6), lane = tid & 63, wr = wid >> 2, wc = wid & 3, fr = lane & 15, fq = lane >> 4;
  const int nt = K / 64;
  unsigned voff[2], voffA[2];
#pragma unroll
  for (int i = 0; i < 2; ++i) { int R, C; g8_stage_rc(tid * 16 + i * 8192, R, C);
    const int rho = R & 31, Rb = PERMB ? (R & ~31) + 8 * ((rho & 15) >> 2) + 4 * (rho >> 4) + (rho & 3) : R;
    voff[i] = (unsigned)(Rb * 64 + C) * 2u; voffA[i] = ABLK ? (unsigned)(R * 64 + C) * 2u : (unsigned)(R * K + C) * 2u; }
  const size_t kstep = 32768, hstep = 16384, tstep = (size_t)256 * K * 2;
  const size_t kstepA = ABLK ? 32768 : 128, hstepA = ABLK ? 16384 : (size_t)128 * K * 2;
  const unsigned ldsw = (unsigned)wid * 1024u;
  const int aoff = g8_lds_byte(wr * 64 + fr, fq * 8), boff = g8_lds_byte(wc * 32 + fr, fq * 8);
#define G8_SA(b, h) (((b) * 2 + (h)) * G8_HTB)
#define G8_SB(b, h) ((4 + (b) * 2 + (h)) * G8_HTB)
#define G8_STAGE(bufoff, gbase) do { _Pragma("unroll") for (int _i = 0; _i < 2; ++_i) \
    __builtin_amdgcn_global_load_lds((const unsigned*)((const char*)(gbase) + voff[_i]), (LAS unsigned*)(lds + (bufoff) + ldsw + _i * 8192), 16, 0, 0); } while (0)
#define G8_STAGEA(bufoff, gbase) do { _Pragma("unroll") for (int _i = 0; _i < 2; ++_i) \
    __builtin_amdgcn_global_load_lds((const unsigned*)((const char*)(gbase) + voffA[_i]), (LAS unsigned*)(lds + (bufoff) + ldsw + _i * 8192), 16, 0, 0); } while (0)
#define G8_LDA(dst, b, h) do { _Pragma("unroll") for (int m = 0; m < 4; ++m) _Pragma("unroll") for (int k = 0; k < 2; ++k) dst[m][k] = *(const LAS bf16x8*)(lds + G8_SA(b, h) + aoff + m * 2048 + k * 1024); } while (0)
#define G8_LDB(dst, b, h) do { _Pragma("unroll") for (int n = 0; n < 2; ++n) _Pragma("unroll") for (int k = 0; k < 2; ++k) dst[n][k] = *(const LAS bf16x8*)(lds + G8_SB(b, h) + boff + n * 2048 + k * 1024); } while (0)
#define G8_MMA(ai, bj, At_, Bt_) do { __builtin_amdgcn_s_setprio(1); _Pragma("unroll") for (int m = 0; m < 4; ++m) _Pragma("unroll") for (int n = 0; n < 2; ++n) _Pragma("unroll") for (int k = 0; k < 2; ++k) \
    acc[ai][bj][m][n] = SWM == 2 ? __builtin_amdgcn_mfma_f32_16x16x32_bf16(At_[m][k], Bt_[n][k], acc[ai][bj][m][n], 0, 0, 0) \
                                 : __builtin_amdgcn_mfma_f32_16x16x32_bf16(Bt_[n][k], At_[m][k], acc[ai][bj][m][n], 0, 0, 0); __builtin_amdgcn_s_setprio(0); } while (0)
#define G8_WAIT_V(n) asm volatile("s_waitcnt vmcnt(" #n ")" ::: "memory")
#define G8_WAIT_L(n) asm volatile("s_waitcnt lgkmcnt(" #n ")" ::: "memory")
#define G8_BAR __builtin_amdgcn_s_barrier()
#define G8_SCHED __builtin_amdgcn_sched_barrier(0)
  int cpm, cpn, npm = 0, npn = 0, ui = 0;
  if (!S.next(0, cpm, cpn)) return;
  f32x4 acc[2][2][4][2];
#pragma unroll
  for (int a = 0; a < 2; ++a)
#pragma unroll
    for (int b = 0; b < 2; ++b)
#pragma unroll
      for (int m = 0; m < 4; ++m)
#pragma unroll
        for (int n = 0; n < 2; ++n) acc[a][b][m][n] = f32x4{0.f, 0.f, 0.f, 0.f};
  bf16x8 At[4][2], B0[2][2], B1[2][2];
  const char* cA = (const char*)A + (size_t)cpm * tstep; const char* cB = (const char*)Bt + (size_t)cpn * tstep;
  G8_STAGE(G8_SB(0, 0), cB); G8_STAGEA(G8_SA(0, 0), cA); G8_STAGE(G8_SB(0, 1), cB + hstep); G8_STAGEA(G8_SA(0, 1), cA + hstepA);
  if (wr == 1) G8_BAR;
  G8_WAIT_V(4); G8_BAR;
  G8_STAGE(G8_SB(1, 0), cB + kstep); G8_STAGEA(G8_SA(1, 0), cA + kstepA); G8_STAGE(G8_SB(1, 1), cB + hstep + kstep);
  G8_WAIT_V(6); G8_BAR;
  for (;;) {
    const bool has_next = S.next(ui + 1, npm, npn);
    const char* nA = has_next ? (const char*)A + (size_t)npm * tstep : cA; const char* nB = has_next ? (const char*)Bt + (size_t)npn * tstep : cB;
#pragma unroll 1
    for (int t = 0; t < nt; t += 2) {
      const bool last = (t == nt - 2);
      const char* a1 = cA + (size_t)(t + 1) * kstepA;
      const char* a2 = last ? nA : cA + (size_t)(t + 2) * kstepA; const char* b2 = last ? nB : cB + (size_t)(t + 2) * kstep;
      const char* a3 = a2 + kstepA; const char* b3 = b2 + kstep;
      G8_LDB(B0, 0, 0); G8_SCHED; G8_LDA(At, 0, 0); G8_STAGEA(G8_SA(1, 1), a1 + hstepA);
      G8_WAIT_L(8); G8_BAR; G8_WAIT_L(0); G8_MMA(0, 0, At, B0); G8_BAR; G8_SCHED;
      G8_LDB(B1, 0, 1); G8_STAGE(G8_SB(0, 0), b2);
      G8_BAR; G8_WAIT_L(0); G8_MMA(0, 1, At, B1); G8_BAR;
      G8_LDA(At, 0, 1); G8_STAGEA(G8_SA(0, 0), a2);
      G8_BAR; G8_WAIT_L(0); G8_MMA(1, 0, At, B0); G8_BAR; G8_SCHED;
      G8_STAGE(G8_SB(0, 1), b2 + hstep);
      G8_WAIT_V(6); G8_BAR; G8_MMA(1, 1, At, B1); G8_BAR;
      G8_LDB(B0, 1, 0); G8_SCHED; G8_LDA(At, 1, 0); G8_STAGEA(G8_SA(0, 1), a2 + hstepA);
      G8_WAIT_L(8); G8_BAR; G8_WAIT_L(0); G8_MMA(0, 0, At, B0); G8_BAR; G8_SCHED;
      G8_LDB(B1, 1, 1); G8_STAGE(G8_SB(1, 0), b3);
      G8_BAR; G8_WAIT_L(0); G8_MMA(0, 1, At, B1); G8_BAR;
      G8_LDA(At, 1, 1); G8_STAGEA(G8_SA(1, 0), a3);
      G8_BAR; G8_WAIT_L(0); G8_MMA(1, 0, At, B0); G8_BAR; G8_SCHED;
      G8_STAGE(G8_SB(1, 1), b3 + hstep);
      G8_WAIT_V(6); G8_BAR; G8_MMA(1, 1, At, B1); G8_BAR;
    }
    { const int t2 = TIDX(), w2 = __builtin_amdgcn_readfirstlane(t2 >> 6), l2 = t2 & 63; E(acc, cpm, cpn, w2 >> 2, w2 & 3, l2 & 15, l2 >> 4); }
    if (!has_next) break;
#pragma unroll
    for (int a = 0; a < 2; ++a)
#pragma unroll
      for (int b = 0; b < 2; ++b)
#pragma unroll
        for (int m = 0; m < 4; ++m)
#pragma unroll
          for (int n = 0; n < 2; ++n) acc[a][b][m][n] = f32x4{0.f, 0.f, 0.f, 0.f};
    cpm = npm; cpn = npn; cA = nA; cB = nB; ++ui;
  }
  G8_WAIT_V(0);
  if (wr == 0) G8_BAR;
  G8_BAR;
#undef G8_SA
#undef G8_SB
#undef G8_STAGE
#undef G8_STAGEA
#undef G8_LDA
#undef G8_LDB
#undef G8_MMA
#undef G8_WAIT_V
#undef G8_WAIT_L
#undef G8_BAR
#undef G8_SCHED
}
template <bool ABLK, class Epi>
DI void gemm_half(char* smem, const u16* A, const u16* Bt, int K, int pm, int pn, int nh, const Epi& E) {
  LAS unsigned char* lds = (LAS unsigned char*)smem;
  const int tid = TIDX(), wid = __builtin_amdgcn_readfirstlane(tid >> 6), lane = tid & 63, wr = wid >> 2, wc = wid & 3, fr = lane & 15, fq = lane >> 4;
  const int nt = K / 64;
  unsigned voff[2], voffA[2];
#pragma unroll
  for (int i = 0; i < 2; ++i) { int R, C; g8_stage_rc(tid * 16 + i * 8192, R, C); voff[i] = (unsigned)(R * 64 + C) * 2u; voffA[i] = ABLK ? voff[i] : (unsigned)(R * K + C) * 2u; }
  const size_t kstep = 32768, hstep = 16384, tstep = (size_t)256 * K * 2;
  const size_t kstepA = ABLK ? 32768 : 128, hstepA = ABLK ? 16384 : (size_t)128 * K * 2;
  const unsigned ldsw = (unsigned)wid * 1024u;
  const int aoff = g8_lds_byte(wr * 64 + fr, fq * 8), boff = g8_lds_byte(wc * 32 + fr, fq * 8);
  const char* cA = (const char*)A + (size_t)pm * tstep;
  const char* cB = (const char*)Bt + (size_t)pn * tstep + (size_t)nh * hstep;
#define GH_STAGE(s_, kt_) do { _Pragma("unroll") for (int _i = 0; _i < 2; ++_i) { \
    __builtin_amdgcn_global_load_lds((const unsigned*)(cB + (size_t)(kt_) * kstep + voff[_i]), (LAS unsigned*)(lds + (s_) * 49152 + ldsw + _i * 8192), 16, 0, 0); \
    __builtin_amdgcn_global_load_lds((const unsigned*)(cA + (size_t)(kt_) * kstepA + voffA[_i]), (LAS unsigned*)(lds + (s_) * 49152 + 16384 + ldsw + _i * 8192), 16, 0, 0); \
    __builtin_amdgcn_global_load_lds((const unsigned*)(cA + hstepA + (size_t)(kt_) * kstepA + voffA[_i]), (LAS unsigned*)(lds + (s_) * 49152 + 32768 + ldsw + _i * 8192), 16, 0, 0); } } while (0)
  f32x4 acc[2][4][2];
#pragma unroll
  for (int a = 0; a < 2; ++a)
#pragma unroll
    for (int m = 0; m < 4; ++m)
#pragma unroll
      for (int n = 0; n < 2; ++n) acc[a][m][n] = f32x4{0.f, 0.f, 0.f, 0.f};
  __syncthreads();
  GH_STAGE(0, 0);
  asm volatile("s_waitcnt vmcnt(0)" ::: "memory");
  __syncthreads();
#pragma unroll 1
  for (int kt = 0; kt < nt; ++kt) {
    if (kt + 1 < nt) GH_STAGE((kt + 1) & 1, kt + 1);
    const LAS unsigned char* base = lds + (kt & 1) * 49152;
    bf16x8 B0[2][2];
#pragma unroll
    for (int n = 0; n < 2; ++n)
#pragma unroll
      for (int k = 0; k < 2; ++k) B0[n][k] = *(const LAS bf16x8*)(base + boff + n * 2048 + k * 1024);
#pragma unroll
    for (int ai = 0; ai < 2; ++ai) {
      bf16x8 At[4][2];
#pragma unroll
      for (int m = 0; m < 4; ++m)
#pragma unroll
        for (int k = 0; k < 2; ++k) At[m][k] = *(const LAS bf16x8*)(base + 16384 + ai * 16384 + aoff + m * 2048 + k * 1024);
#pragma unroll
      for (int m = 0; m < 4; ++m)
#pragma unroll
        for (int n = 0; n < 2; ++n)
#pragma unroll
          for (int k = 0; k < 2; ++k) acc[ai][m][n] = __builtin_amdgcn_mfma_f32_16x16x32_bf16(B0[n][k], At[m][k], acc[ai][m][n], 0, 0, 0);
    }
    asm volatile("s_waitcnt vmcnt(0)" ::: "memory");
    __syncthreads();
  }
#undef GH_STAGE
  E(acc, pm, pn, nh, wr, wc, fr, fq);
}

template <class F> struct ElemEpi {
  F f;
  DI void operator()(const f32x4 (&acc)[2][2][4][2], int pm, int pn, int wr, int wc, int fr, int fq) const {
    const int row0 = pm * 256 + wr * 64 + fr, col0 = pn * 256 + wc * 32 + 4 * fq;
#pragma unroll
    for (int ai = 0; ai < 2; ++ai)
#pragma unroll
      for (int m = 0; m < 4; ++m)
#pragma unroll
        for (int bj = 0; bj < 2; ++bj)
#pragma unroll
          for (int n = 0; n < 2; ++n) f(row0 + ai * 128 + m * 16, col0 + bj * 128 + n * 16, acc[ai][bj][m][n]);
  }
};
template <class F> DI ElemEpi<F> make_epi(F f) { return ElemEpi<F>{f}; }
template <int NM, int NN, int NN1, int SM1, int SN1, int SM2, int SN2, class F>
DI void gemm8_job(char* smem, const u16* A, const u16* Bt, int K, F f) {
  TileSched<NM, NN, NN1, SM1, SN1, SM2, SN2> S; S.init();
  gemm8(smem, A, Bt, K, S, make_epi(f));
}

struct EpiMixU {
  u16* MIX;
  DI void operator()(const f32x4 (&acc)[2][2][4][2], int pm, int pn, int wr, int wc, int fr, int fq) const {
    const int row0 = pm * 256 + wr * 64 + fr, col0 = pn * 256 + wc * 32 + 4 * fq;
#pragma unroll
    for (int ai = 0; ai < 2; ++ai)
#pragma unroll
      for (int m = 0; m < 4; ++m)
#pragma unroll
        for (int bj = 0; bj < 2; ++bj)
#pragma unroll
          for (int n = 0; n < 2; ++n) {
            const f32x4 v = acc[ai][bj][m][n];
            *(uint2*)(MIX + (unsigned)((row0 + ai * 128 + m * 16) * 1024 + col0 + bj * 128 + n * 16)) = pack4(gelu_tanh(v[0]), gelu_tanh(v[1]), gelu_tanh(v[2]), gelu_tanh(v[3]));
          }
  }
  DI void operator()(const f32x4 (&acc)[2][4][2], int pm, int pn, int nh, int wr, int wc, int fr, int fq) const {
    const int row0 = pm * 256 + wr * 64 + fr, col0 = pn * 256 + nh * 128 + wc * 32 + 4 * fq;
#pragma unroll
    for (int ai = 0; ai < 2; ++ai)
#pragma unroll
      for (int m = 0; m < 4; ++m)
#pragma unroll
        for (int n = 0; n < 2; ++n) {
          const f32x4 v = acc[ai][m][n];
          *(uint2*)(MIX + (unsigned)((row0 + ai * 128 + m * 16) * 1024 + col0 + n * 16)) = pack4(gelu_tanh(v[0]), gelu_tanh(v[1]), gelu_tanh(v[2]), gelu_tanh(v[3]));
        }
  }
};
struct EpiMixV {
  u16* VT; u16* PRT;
  DI void operator()(const f32x4 (&acc)[2][2][4][2], int pm, int pn, int wr, int wc, int fr, int fq) const {
    const int rowt = pm * 256;
    if (pn < 2) {
#pragma unroll
      for (int ai = 0; ai < 2; ++ai)
#pragma unroll
        for (int bj = 0; bj < 2; ++bj) {
          const unsigned g = (unsigned)(pn * 2 + bj), chunk = (unsigned)(pm * 2 + ai);
          const unsigned base = ((g * 320u + chunk) * 128u) * 128u;
#pragma unroll
          for (int m = 0; m < 4; ++m)
#pragma unroll
            for (int n = 0; n < 2; ++n) {
              const f32x4 v = acc[ai][bj][m][n];
              const unsigned c = (unsigned)(wc * 32 + n * 16 + fr), q = (unsigned)(wr * 64 + m * 16 + 4 * fq);
              *(uint2*)(VT + (base + c * 128u + q)) = pack4(gelu_tanh(v[0]), gelu_tanh(v[1]), gelu_tanh(v[2]), gelu_tanh(v[3]));
            }
        }
    } else {
      unsigned sbase, L;
      if (rowt < TP) { sbase = (unsigned)rowt * 1536u; L = 256u; }
      else { const int mm = rowt - TP; sbase = (unsigned)(TP + (mm & ~4095)) * 1536u + (unsigned)(mm & 4095); L = 4096u; }
#pragma unroll
      for (int ai = 0; ai < 2; ++ai)
#pragma unroll
        for (int bj = 0; bj < 2; ++bj)
#pragma unroll
          for (int m = 0; m < 4; ++m)
#pragma unroll
            for (int n = 0; n < 2; ++n) {
              const f32x4 v = acc[ai][bj][m][n];
              const unsigned cp = (unsigned)((pn - 2) * 256 + bj * 128 + wc * 32 + n * 16 + fr), tl = (unsigned)(ai * 128 + wr * 64 + m * 16 + 4 * fq);
              *(uint2*)(PRT + (sbase + cp * L + tl)) = pack4(v[0], v[1], v[2], v[3]);
            }
    }
  }
};
struct OneRoundSched {
  int c;
  DI void init() { c = blockIdx.x; }
  DI bool next(int i, int& pm, int& pn) const {
    if (gridDim.x == 256) { if (i > 0) return false; const int slot = c >> 3; pm = (c & 7) * 16 + (slot & 15); pn = slot >> 4; return true; }
    const int L = i * (int)gridDim.x + c; if (L >= 320) return false; pm = L >> 1; pn = L & 1; return true;
  }
};
DI void phase_mix_in(const PV& p, int i, char* smem) {
  const u16* H = (const u16*)(p.ws() + OFF_A + A_H);
  const u16* W = (const u16*)(p.ws() + OFF_WMIXIN) + (size_t)i * 2560 * 1024;
  EpiMixV EV; EV.VT = (u16*)(p.ws() + OFF_B + B_VT); EV.PRT = (u16*)(p.ws() + OFF_B + B_PRT);
  EpiMixU EU; EU.MIX = (u16*)(p.ws() + OFF_B + B_MIX);
  {
    TileSched<160, 8, 8, 8, 4, 32, 1> S; S.init();
    gemm8<false, 2>(smem, H, W + (size_t)512 * 1024, 1024, S, EV);
  }
  {
    OneRoundSched S; S.init();
    gemm8<false, 0>(smem, H, W, 1024, S, EU);
    if (gridDim.x == 256 && blockIdx.x < 128) {
      const int tile = blockIdx.x >> 1, nh = blockIdx.x & 1;
      gemm_half<false>(smem, H, W, 1024, 128 + (tile & 31), tile >> 5, nh, EU);
    }
  }
}

DI void phase_sgu(const PV& p, int i, char* smem) {
  const u16* VT = (const u16*)(p.ws() + OFF_B + B_VT);
  const u16* W = (const u16*)(p.ws() + OFF_WSGU) + (size_t)i * 4 * 16384;
  u16* MIX = (u16*)(p.ws() + OFF_B + B_MIX);
  const float* sb = p.in(11) + i * 512;
  for (int u = blockIdx.x; u < 640; u += gridDim.x) {
    const int g = u / 160, tm = u % 160;
    auto epi = [=](int m, int n, f32x4 v, uint2 uu) {
      const int chunk = m >> 7, c = m & 127;
      const int t = chunk * 128 + n;
      const float bias = sb[g * 128 + n];
      u16* dst = MIX + (size_t)t * 1024 + g * 128 + c;
      *(uint2*)dst = pack4(lo16(uu.x) * (v[0] + bias), hi16(uu.x) * (v[1] + bias), lo16(uu.y) * (v[2] + bias), hi16(uu.y) * (v[3] + bias));
    };
    auto pre = [=](int m, int n) { return *(const uint2*)(MIX + (size_t)((m >> 7) * 128 + n) * 1024 + g * 128 + (m & 127)); };
    gemm_tile<false>(VT + (size_t)g * 320 * 128 * 128, 128, W + (size_t)g * 16384, 128, 128, tm * 256, 0, smem, epi, pre);
  }
}

DI size_t prt_off(int kind, int b, int cp) {
  return kind ? (size_t)(TP + b * 4096) * 1536 + (size_t)cp * 4096 : (size_t)(b * 256) * 1536 + (size_t)cp * 256;
}
DI size_t zt_off(int kind, int b, int c) {
  return kind ? (size_t)(TP + b * 4096) * 512 + (size_t)c * 4096 : (size_t)(b * 256) * 512 + (size_t)c * 256;
}
DI void phase_conv(const PV& p, int i, int ord, char* smem) {
  const int tid = TIDX(), lane = tid & 63, wid = tid >> 6;
  const u16* PRT = (const u16*)(p.ws() + OFF_B + B_PRT);
  const u16* FILT = (const u16*)(p.ws() + OFF_FILT);
  const u16* Z1 = (const u16*)(p.ws() + OFF_A + A_Z1);
  u16* ZO = (u16*)(p.ws() + OFF_A + (ord ? A_Z2 : A_Z1));
  const float* cw = p.in(12) + (size_t)i * 3 * 1536;
  const float* cb = p.in(13) + (size_t)i * 1536;
  u16* hc = (u16*)smem;
  char* Ub = smem + 68096;
  for (int u = blockIdx.x; u < 1024; u += gridDim.x) {
    const int kind = u < 512 ? 1 : 0, c = u & 511;
    const int L = kind ? 4096 : 256, NB = kind ? 8 : 32, LB = L >> 6, DD = L >> 7;
    const int US = (L + 8) * 2;
    const size_t fbase = ((size_t)(i * 2 + ord) * 512 + c) * 4352 + (kind ? 256 : 0);
    __syncthreads();
    {
      u16* tmp = (u16*)Ub;
      for (int idx = tid; idx < (L >> 3); idx += 512) *(uint4*)(tmp + idx * 8) = *(const uint4*)(FILT + fbase + idx * 8);
      __syncthreads();
#pragma unroll 1
      for (int cpy = 0; cpy < 8; ++cpy)
        for (int m = tid; m < L + 136; m += 512) {
          const int x = L + 63 - m - cpy;
          hc[cpy * 4256 + m] = (x >= 0 && x < L) ? tmp[x] : (u16)0;
        }
      __syncthreads();
    }
    {
      const int lgn = kind ? 9 : 5, ncr = 1 << lgn, total = NB * ncr;
      const float w0 = cw[c], w1 = cw[1536 + c], w2 = cw[3072 + c], bb = cb[c];
      for (int id = tid; id < total; id += 512) {
        const int b = id >> lgn, t = (id & (ncr - 1)) * 8;
        uint4 o;
        if (ord == 0) {
          const u16* src = PRT + prt_off(kind, b, c) + t;
          const uint4 raw = *(const uint4*)src;
          float e[10];
          e[0] = t > 0 ? bf2f(src[-1]) : 0.f;
          e[9] = t + 8 < L ? bf2f(src[8]) : 0.f;
          e[1] = lo16(raw.x); e[2] = hi16(raw.x); e[3] = lo16(raw.y); e[4] = hi16(raw.y);
          e[5] = lo16(raw.z); e[6] = hi16(raw.z); e[7] = lo16(raw.w); e[8] = hi16(raw.w);
          float r[8];
#pragma unroll
          for (int k = 0; k < 8; ++k) r[k] = w0 * e[k] + w1 * e[k + 1] + w2 * e[k + 2] + bb;
          o.x = pack2(r[0], r[1]); o.y = pack2(r[2], r[3]); o.z = pack2(r[4], r[5]); o.w = pack2(r[6], r[7]);
        } else {
          o = *(const uint4*)(Z1 + zt_off(kind, b, c) + t);
        }
        *(uint4*)(Ub + b * US + t * 2) = o;
      }
    }
    __syncthreads();
    const int ncols = LB * NB;
#pragma unroll 1
    for (int hf = 0; hf < 2; ++hf) {
      const int jt = wid + 8 * hf;
      if (jt * 32 >= ncols) break;
      const int il = lane & 31, q = lane >> 5;
      const int lgb = kind ? 3 : 5;
      const int col = jt * 32 + il, t1c = col >> lgb, bc = col & (NB - 1);
      const int t1lo = (jt * 32) >> lgb, t1hi = (jt * 32 + 31) >> lgb;
      const int dlo = max(-DD, t1lo - (LB - 1)), dhi = min(DD, t1hi);
      const int cpy = 7 - (il & 7);
      const char* abase = (const char*)hc + cpy * 8512 + 2 * (L / 2 + 63 - il - cpy + 8 * q);
      f32x16 acc[2];
#pragma unroll
      for (int a = 0; a < 2; ++a)
#pragma unroll
        for (int r = 0; r < 16; ++r) acc[a][r] = 0.f;
      for (int d = dlo; d <= dhi; ++d) {
        bf16x8 bfr[4];
        {
          const int s1 = t1c - d;
          const bool valid = s1 >= 0 && s1 < LB;
          const char* bp = Ub + bc * US + ((valid ? s1 : 0) * 64 + 8 * q) * 2;
#pragma unroll
          for (int ks = 0; ks < 4; ++ks) {
            bf16x8 v = *(const bf16x8*)(bp + ks * 32);
            if (!valid) v = bf16x8{0, 0, 0, 0, 0, 0, 0, 0};
            bfr[ks] = v;
          }
        }
#pragma unroll
        for (int mt = 0; mt < 2; ++mt)
#pragma unroll
          for (int ks = 0; ks < 4; ++ks) {
            const bf16x8 af = *(const bf16x8*)(abase + 2 * (-64 * d - 32 * mt + 16 * ks));
            acc[mt] = __builtin_amdgcn_mfma_f32_32x32x16_bf16(af, bfr[ks], acc[mt], 0, 0, 0);
          }
      }
      const float dsk = p.in(21)[(i * 2 + ord) * 512 + c];
      const int gc = 512 * (ord + 1) + c;
      const float w0 = cw[gc], w1 = cw[1536 + gc], w2 = cw[3072 + gc], bb = cb[gc];
      {
        const int b = bc;
        const u16* xrow = PRT + prt_off(kind, b, gc);
        u16* orow = ZO + zt_off(kind, b, c);
#pragma unroll
        for (int mt = 0; mt < 2; ++mt)
#pragma unroll
          for (int g = 0; g < 4; ++g) {
            const int t = 64 * t1c + mt * 32 + 8 * g + 4 * q;
            const uint2 uu = *(const uint2*)(Ub + b * US + t * 2);
            const uint2 xx = *(const uint2*)(xrow + t);
            const float em = t > 0 ? bf2f(xrow[t - 1]) : 0.f;
            const float ep = t + 4 < L ? bf2f(xrow[t + 4]) : 0.f;
            const float e0 = lo16(xx.x), e1 = hi16(xx.x), e2 = lo16(xx.y), e3 = hi16(xx.y);
            const float x0 = w0 * em + w1 * e0 + w2 * e1 + bb;
            const float x1 = w0 * e0 + w1 * e1 + w2 * e2 + bb;
            const float x2 = w0 * e1 + w1 * e2 + w2 * e3 + bb;
            const float x3 = w0 * e2 + w1 * e3 + w2 * ep + bb;
            const float y0 = acc[mt][4 * g + 0] + lo16(uu.x) * dsk;
            const float y1 = acc[mt][4 * g + 1] + hi16(uu.x) * dsk;
            const float y2 = acc[mt][4 * g + 2] + lo16(uu.y) * dsk;
            const float y3 = acc[mt][4 * g + 3] + hi16(uu.y) * dsk;
            *(uint2*)(orow + t) = pack4(x0 * y0, x1 * y1, x2 * y2, x3 * y3);
          }
      }
    }
  }
  __syncthreads();
}

DI void phase_ztrans(const PV& p, char* smem) {
  const int tid = TIDX();
  const u16* Z2 = (const u16*)(p.ws() + OFF_A + A_Z2);
  u16* MIX = (u16*)(p.ws() + OFF_B + B_MIX);
  u16* tl = (u16*)smem;
  for (int u4 = blockIdx.x * 4; u4 < 640 * 8; u4 += gridDim.x * 4) {
    const int tt0 = (u4 >> 3) * 64;
    const int kind = tt0 >= TP ? 1 : 0;
    const int b = kind ? (tt0 - TP) >> 12 : tt0 >> 8;
    const int tl0 = kind ? (tt0 - TP) & 4095 : tt0 & 255;
    __syncthreads();
    { const int c = tid >> 3, ch = tid & 7;
      uint4 v[4];
#pragma unroll
      for (int w = 0; w < 4; ++w) v[w] = *(const uint4*)(Z2 + zt_off(kind, b, ((u4 + w) & 7) * 64 + c) + tl0 + ch * 8);
#pragma unroll
      for (int w = 0; w < 4; ++w) *(uint4*)(tl + w * 4608 + c * 72 + ch * 8) = v[w]; }
    __syncthreads();
    { const int tr = tid >> 3, cc = (tid & 7) * 8;
#pragma unroll
      for (int w = 0; w < 4; ++w) {
        const u16* tw = tl + w * 4608;
        uint4 o;
        o.x = (unsigned)tw[(cc + 0) * 72 + tr] | ((unsigned)tw[(cc + 1) * 72 + tr] << 16);
        o.y = (unsigned)tw[(cc + 2) * 72 + tr] | ((unsigned)tw[(cc + 3) * 72 + tr] << 16);
        o.z = (unsigned)tw[(cc + 4) * 72 + tr] | ((unsigned)tw[(cc + 5) * 72 + tr] << 16);
        o.w = (unsigned)tw[(cc + 6) * 72 + tr] | ((unsigned)tw[(cc + 7) * 72 + tr] << 16);
        *(uint4*)(MIX + (size_t)(tt0 + tr) * 1024 + 512 + ((u4 + w) & 7) * 64 + cc) = o;
      } }
  }
  __syncthreads();
}

struct EpiResid {
  float* X; const float* x0; const float* x1; const float* gate; int lx;
  DI void operator()(const f32x4 (&acc)[2][2][4][2], int pm, int pn, int wr, int wc, int fr, int fq) const {
    const int rowt = pm * 256, col0 = pn * 256 + wc * 32 + 4 * fq;
    const float* gr = gate + (size_t)condrow(rowt) * 6144 + col0;
    const float* xb = lx == 0 ? (rowt < TP ? x0 + (size_t)rowt * 1024 : x1 + (size_t)(rowt - TP) * 1024) : X + (size_t)rowt * 1024;
    float4 g[2][2];
#pragma unroll
    for (int bj = 0; bj < 2; ++bj)
#pragma unroll
      for (int n = 0; n < 2; ++n) g[bj][n] = *(const float4*)(gr + bj * 128 + n * 16);
#pragma unroll
    for (int ai = 0; ai < 2; ++ai)
#pragma unroll
      for (int mh = 0; mh < 2; ++mh) {
        float4 xo[2][2][2];
#pragma unroll
        for (int mm = 0; mm < 2; ++mm)
#pragma unroll
          for (int bj = 0; bj < 2; ++bj)
#pragma unroll
            for (int n = 0; n < 2; ++n)
              xo[mm][bj][n] = ld16_nt(xb + (size_t)(wr * 64 + fr + ai * 128 + (2 * mh + mm) * 16) * 1024 + col0 + bj * 128 + n * 16);
#pragma unroll
        for (int mm = 0; mm < 2; ++mm)
#pragma unroll
          for (int bj = 0; bj < 2; ++bj)
#pragma unroll
            for (int n = 0; n < 2; ++n) {
              const f32x4 v = acc[ai][bj][2 * mh + mm][n];
              const float4 x = xo[mm][bj][n], gg = g[bj][n];
              float4 o; o.x = x.x + gg.x * v[0]; o.y = x.y + gg.y * v[1]; o.z = x.z + gg.z * v[2]; o.w = x.w + gg.w * v[3];
              st16_nt(X + (size_t)(rowt + wr * 64 + fr + ai * 128 + (2 * mh + mm) * 16) * 1024 + col0 + bj * 128 + n * 16, o);
            }
      }
  }
};
struct EpiResidHalf {
  float* X; const float* x0; const float* x1; const float* gate; int lx;
  DI void operator()(const f32x4 (&acc)[2][4][2], int pm, int pn, int nh, int wr, int wc, int fr, int fq) const {
    const int rowt = pm * 256, col0 = pn * 256 + nh * 128 + wc * 32 + 4 * fq;
    const float* gr = gate + (size_t)condrow(rowt) * 6144 + col0;
    const float* xb = lx == 0 ? (rowt < TP ? x0 + (size_t)rowt * 1024 : x1 + (size_t)(rowt - TP) * 1024) : X + (size_t)rowt * 1024;
    float4 g[2];
#pragma unroll
    for (int n = 0; n < 2; ++n) g[n] = *(const float4*)(gr + n * 16);
#pragma unroll
    for (int ai = 0; ai < 2; ++ai) {
      float4 xo[4][2];
#pragma unroll
      for (int m = 0; m < 4; ++m)
#pragma unroll
        for (int n = 0; n < 2; ++n) xo[m][n] = ld16_nt(xb + (size_t)(wr * 64 + fr + ai * 128 + m * 16) * 1024 + col0 + n * 16);
#pragma unroll
      for (int m = 0; m < 4; ++m)
#pragma unroll
        for (int n = 0; n < 2; ++n) {
          const f32x4 v = acc[ai][m][n];
          const float4 x = xo[m][n], gg = g[n];
          float4 o; o.x = x.x + gg.x * v[0]; o.y = x.y + gg.y * v[1]; o.z = x.z + gg.z * v[2]; o.w = x.w + gg.w * v[3];
          st16_nt(X + (size_t)(rowt + wr * 64 + fr + ai * 128 + m * 16) * 1024 + col0 + n * 16, o);
        }
    }
  }
};
struct ResidSched2 {
  int c;
  DI void init() { c = blockIdx.x; }
  DI bool next(int i, int& pm, int& pn) const {
    if (gridDim.x == 256) {
      const int st = (c & 7) + 8 * i;
      if (st >= 16) return false;
      pm = st * 8 + ((c >> 3) & 7); pn = c >> 6; return true;
    }
    const int L = i * (int)gridDim.x + c; if (L >= 640) return false; pm = L >> 2; pn = L & 3; return true;
  }
};
DI void phase_resid_gemm(const PV& p, int l, int lx, const u16* A, int K, const u16* W, int goff, char* smem) {
  EpiResid E;
  E.X = p.out(); E.x0 = p.in(0); E.x1 = p.in(1); E.gate = (const float*)(p.ws() + OFF_MOD) + (size_t)l * 9 * 6144 + goff; E.lx = lx;
  ResidSched2 S; S.init();
  if (K == 2816) gemm8<true>(smem, A, W, K, S, E);
  else gemm8<false>(smem, A, W, K, S, E);
  if (gridDim.x == 256) {
    EpiResidHalf EH; EH.X = E.X; EH.x0 = E.x0; EH.x1 = E.x1; EH.gate = E.gate; EH.lx = lx;
    const int xcd = blockIdx.x & 7, slot = blockIdx.x >> 3;
    const int st = 16 + (xcd >> 1), ti = (xcd & 1) * 16 + (slot >> 1), nh = slot & 1;
    const int pm = st * 8 + (ti & 7), pn = ti >> 3;
    if (K == 2816) gemm_half<true>(smem, A, W, K, pm, pn, nh, EH);
    else gemm_half<false>(smem, A, W, K, pm, pn, nh, EH);
  }
}

DI void phase_dqkv(const PV& p, int j, char* smem) {
  const u16* H = (const u16*)(p.ws() + OFF_A + A_H);
  const u16* W = (const u16*)(p.ws() + OFF_WDQKV) + (size_t)j * 1024 * 1024;
  u16* DQKV = (u16*)(p.ws() + OFF_B + B_DQKV);
  u16* KR = (u16*)(p.ws() + OFF_KR);
  float* okr = p.out() + 46137344;
  auto epi = [=](int m, int n, f32x4 v) {
    if (n < 832) {
      const uint2 pk = pack4(v[0], v[1], v[2], v[3]);
      *(uint2*)(DQKV + (size_t)m * 896 + n) = pk;
      if (n >= 768) {
        const int e = n - 768;
        *(uint2*)(KR + (size_t)m * 64 + e) = pk;
        if (m < TP) {
          float4 o; o.x = v[0]; o.y = v[1]; o.z = v[2]; o.w = v[3];
          *(float4*)(okr + ((size_t)((m >> 8) * 2 + j) * 256 + (m & 255)) * 64 + e) = o;
        }
      }
    }
  };
  gemm8_job<160, 4, 4, 8, 4, 32, 1>(smem, H, W, 1024, epi);
}

DI void phase_mla_norms(const PV& p, int j) {
  const int tid_ = TIDX(); const int lane = tid_ & 63, wid = tid_ >> 6;
  const u16* DQKV = (const u16*)(p.ws() + OFF_B + B_DQKV);
  u16* QN = (u16*)(p.ws() + OFF_A + A_QN);
  u16* CKV = (u16*)(p.ws() + OFF_A + A_CKV);
  u16* KR = (u16*)(p.ws() + OFF_KR);
  float* ockv = p.out() + 41943040;
  const float* qn = p.in(24) + j * 512;
  const float* kvn = p.in(27) + j * 256;
  const int stride = gridDim.x * 8;
  for (int t0 = blockIdx.x * 8 + wid; t0 < TK; t0 += 2 * stride) {
    uint4 ra[2]; uint2 rb[2];
#pragma unroll
    for (int w = 0; w < 2; ++w) {
      const int t = t0 + w * stride;
      if (t < T) {
        const u16* row = DQKV + (size_t)t * 896;
        ra[w] = *(const uint4*)(row + lane * 8);
        rb[w] = *(const uint2*)(row + 512 + lane * 4);
      }
    }
#pragma unroll
    for (int w = 0; w < 2; ++w) {
      const int t = t0 + w * stride;
      if (t < T) {
        const uint4 a = ra[w];
        float q[8] = {lo16(a.x), hi16(a.x), lo16(a.y), hi16(a.y), lo16(a.z), hi16(a.z), lo16(a.w), hi16(a.w)};
        float ss = 0.f;
#pragma unroll
        for (int k = 0; k < 8; ++k) ss += q[k] * q[k];
        ss = wave_sum(ss, lane);
        const float r = rsqrtf(ss * (1.f / 512.f) + EPS);
        const float4 g0 = *(const float4*)(qn + lane * 8), g1 = *(const float4*)(qn + lane * 8 + 4);
        uint4 o;
        o.x = pack2(q[0] * r * g0.x, q[1] * r * g0.y); o.y = pack2(q[2] * r * g0.z, q[3] * r * g0.w);
        o.z = pack2(q[4] * r * g1.x, q[5] * r * g1.y); o.w = pack2(q[6] * r * g1.z, q[7] * r * g1.w);
        *(uint4*)(QN + (size_t)t * 512 + lane * 8) = o;
        const uint2 b = rb[w];
        float kv[4] = {lo16(b.x), hi16(b.x), lo16(b.y), hi16(b.y)};
        float s2 = kv[0] * kv[0] + kv[1] * kv[1] + kv[2] * kv[2] + kv[3] * kv[3];
        s2 = wave_sum(s2, lane);
        const float r2 = rsqrtf(s2 * (1.f / 256.f) + EPS);
        const float4 g2 = *(const float4*)(kvn + lane * 4);
        float4 o2; o2.x = kv[0] * r2 * g2.x; o2.y = kv[1] * r2 * g2.y; o2.z = kv[2] * r2 * g2.z; o2.w = kv[3] * r2 * g2.w;
        *(uint2*)(CKV + (size_t)t * 256 + lane * 4) = pack4(o2.x, o2.y, o2.z, o2.w);
        if (t < TP) *(float4*)(ockv + ((size_t)((t >> 8) * 2 + j) * 256 + (t & 255)) * 256 + lane * 4) = o2;
      } else if (t < TK) {
        const int pp = t - T, b = pp >> 8, sidx = pp & 255;
        const float4 v = *(const float4*)(p.in(2) + ((size_t)(b * 2 + j) * 256 + sidx) * 256 + lane * 4);
        *(uint2*)(CKV + (size_t)t * 256 + lane * 4) = pack4(v.x, v.y, v.z, v.w);
        if (lane < 16) {
          const float4 w4 = *(const float4*)(p.in(3) + ((size_t)(b * 2 + j) * 256 + sidx) * 64 + lane * 4);
          *(uint2*)(KR + (size_t)t * 64 + lane * 4) = pack4(w4.x, w4.y, w4.z, w4.w);
        }
      }
    }
  }
}

DI size_t vt_off(int m, int h, int d) {
  if (m < TP) return ((size_t)((m >> 8) * 8 + h) * 128 + d) * 256 + (m & 255);
  if (m < T) { const int mm = m - TP; return VT_SAMPLE_OFF + ((size_t)((mm >> 12) * 8 + h) * 128 + d) * 4352 + (mm & 4095); }
  const int mm = m - T;
  return VT_SAMPLE_OFF + ((size_t)((mm >> 8) * 8 + h) * 128 + d) * 4352 + 4096 + (mm & 255);
}
struct EpiKV {
  u16* Kb; u16* Vt;
  DI void operator()(const f32x4 (&acc)[2][2][4][2], int pm, int pn, int wr, int wc, int fr, int fq) const {
    const int h = pn;
    const int rowt = pm * 256;
    const unsigned ls = rowt < TP ? 256u : 4352u;
    unsigned vbase;
    if (rowt < TP) vbase = (unsigned)(((rowt >> 8) * 8 + h) * 128) * 256u;
    else if (rowt < T) { const int mm = rowt - TP; vbase = (unsigned)VT_SAMPLE_OFF + (unsigned)(((mm >> 12) * 8 + h) * 128) * 4352u + (unsigned)(mm & 4095); }
    else { const int mm = rowt - T; vbase = (unsigned)VT_SAMPLE_OFF + (unsigned)(((mm >> 8) * 8 + h) * 128) * 4352u + 4096u + (unsigned)(mm & 255); }
    const unsigned dcol = (unsigned)(wc * 32 + 4 * fq);
#pragma unroll
    for (int ai = 0; ai < 2; ++ai)
#pragma unroll
      for (int m = 0; m < 4; ++m) {
        const int rl = ai * 128 + wr * 64 + m * 16 + fr;
        const unsigned ko = (unsigned)((rowt + rl) * 8 + h) * 192u + dcol;
        const unsigned frp = (unsigned)((fr & 3) | ((fr & 4) << 1) | ((fr & 8) >> 1));
        const unsigned vo = vbase + (unsigned)(rl & ~15) + frp + dcol * ls;
#pragma unroll
        for (int n = 0; n < 2; ++n) {
          const f32x4 k = acc[ai][0][m][n], v = acc[ai][1][m][n];
          *(uint2*)(Kb + (ko + n * 16)) = pack4(k[0], k[1], k[2], k[3]);
          const unsigned p01 = pack2(v[0], v[1]), p23 = pack2(v[2], v[3]);
          const unsigned vq = vo + (unsigned)(n * 16) * ls;
          Vt[vq] = (u16)p01; Vt[vq + ls] = (u16)(p01 >> 16); Vt[vq + 2 * ls] = (u16)p23; Vt[vq + 3 * ls] = (u16)(p23 >> 16);
        }
      }
  }
};
DI void phase_uq_ukv(const PV& p, int j, char* smem) {
  const u16* QN = (const u16*)(p.ws() + OFF_A + A_QN);
  const u16* CKV = (const u16*)(p.ws() + OFF_A + A_CKV);
  const u16* WQ = (const u16*)(p.ws() + OFF_WUQ) + (size_t)j * 1536 * 512;
  const u16* WKV = (const u16*)(p.ws() + OFF_WUKV) + (size_t)j * 2048 * 256;
  u16* Q = (u16*)(p.ws() + OFF_B + B_Q);
  u16* Kb = (u16*)(p.ws() + OFF_B + B_K);
  u16* Vt = (u16*)(p.ws() + OFF_B + B_V);
  auto epiq = [=](int m, int n, f32x4 v) { *(uint2*)(Q + (size_t)m * 1536 + n) = pack4(v[0], v[1], v[2], v[3]); };
  gemm8_job<160, 6, 4, 8, 4, 16, 2>(smem, QN, WQ, 512, epiq);
  EpiKV E; E.Kb = Kb; E.Vt = Vt;
  TileSched<168, 8, 8, 8, 4, 32, 1> S; S.init();
  gemm8(smem, CKV, WKV, 256, S, E);
}

DI void phase_finalize(const PV& p, int j) {
  const int tid_ = TIDX(); const int lane = tid_ & 63, wid = tid_ >> 6;
  const int h = lane >> 3, l8 = lane & 7;
  u16* Q = (u16*)(p.ws() + OFF_B + B_Q);
  u16* Kb = (u16*)(p.ws() + OFF_B + B_K);
  const u16* KR = (const u16*)(p.ws() + OFF_KR);
  const float2* ROPE = (const float2*)(p.ws() + OFF_ROPE);
  const float* qhn = p.in(29) + j * 192;
  const float* khn = p.in(30) + j * 192;
  const float QSCALE = 1.4426950408889634f * 0.07216878364870322f;
  const int stride = gridDim.x * 8;
  for (int u0 = T + blockIdx.x * 8 + wid; u0 < T + TK; u0 += 2 * stride) {
    uint4 raw[2][3];
    u16* basep[2];
#pragma unroll
    for (int w = 0; w < 2; ++w) {
      const int u = u0 + w * stride;
      if (u < T + TK) {
        const bool isq = u < T;
        const int t = isq ? u : u - T;
        u16* base = isq ? Q + (size_t)t * 1536 + h * 192 : Kb + ((size_t)t * 8 + h) * 192;
        basep[w] = base;
#pragma unroll
        for (int k = 0; k < 3; ++k) {
          const u16* src = (!isq && k == 2) ? KR + (size_t)t * 64 + 8 * l8 : base + 8 * (l8 + 8 * k);
          raw[w][k] = *(const uint4*)src;
        }
      }
    }
#pragma unroll
    for (int w = 0; w < 2; ++w) {
      const int u = u0 + w * stride;
      if (u < T + TK) {
        const bool isq = u < T;
        const int t = isq ? u : u - T;
        const float* hn = isq ? qhn : khn;
        float v[3][8];
#pragma unroll
        for (int k = 0; k < 3; ++k) {
          const uint4 a = raw[w][k];
          v[k][0] = lo16(a.x); v[k][1] = hi16(a.x); v[k][2] = lo16(a.y); v[k][3] = hi16(a.y);
          v[k][4] = lo16(a.z); v[k][5] = hi16(a.z); v[k][6] = lo16(a.w); v[k][7] = hi16(a.w);
        }
        float ss = 0.f;
#pragma unroll
        for (int k = 0; k < 3; ++k)
#pragma unroll
          for (int e = 0; e < 8; ++e) ss += v[k][e] * v[k][e];
        ss += shx<1>(ss, lane); ss += shx<2>(ss, lane); ss += shx<4>(ss, lane);
        const float r = rsqrtf(ss * (1.f / 192.f) + EPS);
#pragma unroll
        for (int k = 0; k < 3; ++k) {
          const float4 g0 = *(const float4*)(hn + 8 * (l8 + 8 * k)), g1 = *(const float4*)(hn + 8 * (l8 + 8 * k) + 4);
          v[k][0] *= r * g0.x; v[k][1] *= r * g0.y; v[k][2] *= r * g0.z; v[k][3] *= r * g0.w;
          v[k][4] *= r * g1.x; v[k][5] *= r * g1.y; v[k][6] *= r * g1.z; v[k][7] *= r * g1.w;
        }
        if (t >= TP && t < T) {
          const int tl = (t - TP) & 4095;
          const int pos = l8 < 4 ? (tl >> 6) : (tl & 63);
          const float4* rp = (const float4*)(ROPE + pos * 16 + (l8 & 1) * 8);
          const float4 c01 = rp[0], c23 = rp[1], c45 = rp[2], c67 = rp[3];
          const float cs[8] = {c01.x, c01.z, c23.x, c23.z, c45.x, c45.z, c67.x, c67.z};
          const float sn[8] = {c01.y, c01.w, c23.y, c23.w, c45.y, c45.w, c67.y, c67.w};
#pragma unroll
          for (int e = 0; e < 8; ++e) {
            const float x = v[2][e];
            const float partner = shx<2>(x, lane);
            v[2][e] = (l8 & 2) ? x * cs[e] + partner * sn[e] : x * cs[e] - partner * sn[e];
          }
        }
        const float sc = isq ? QSCALE : 1.f;
#pragma unroll
        for (int k = 0; k < 3; ++k) {
          uint4 o;
          o.x = pack2(v[k][0] * sc, v[k][1] * sc); o.y = pack2(v[k][2] * sc, v[k][3] * sc);
          o.z = pack2(v[k][4] * sc, v[k][5] * sc); o.w = pack2(v[k][6] * sc, v[k][7] * sc);
          *(uint4*)(basep[w] + 8 * (l8 + 8 * k)) = o;
        }
      }
    }
  }
}

DI void attn_item(const PV& p, int j, int kind, int seq, int h, int q0, char* smem) {
  const int tid = TIDX(), lane = tid & 63, wid = tid >> 6;
  const int il = lane & 31, hh = lane >> 5;
  const u16* Q = (const u16*)(p.ws() + OFF_B + B_Q);
  const u16* Kb = (const u16*)(p.ws() + OFF_B + B_K);
  const u16* Vt = (const u16*)(p.ws() + OFF_B + B_V);
  u16* O = (u16*)(p.ws() + OFF_A + A_O);
  const float* qhn = p.in(29) + j * 192;
  const float2* ROPE = (const float2*)(p.ws() + OFF_ROPE);
  const int Lk = kind ? 4352 : 256, nkt = Lk >> 6;
  const u16* vbase = Vt + (kind ? VT_SAMPLE_OFF + (size_t)(seq * 8 + h) * 128 * 4352 : (size_t)(seq * 8 + h) * 128 * 256);
  const int tq = q0 + wid * 32 + il;
  bf16x8 qf[12];
  {
    float v[12][8];
    float ss = 0.f;
#pragma unroll
    for (int ks = 0; ks < 12; ++ks) {
      const uint4 a = *(const uint4*)(Q + ((size_t)tq * 8 + h) * 192 + 16 * ks + 8 * hh);
      v[ks][0] = lo16(a.x); v[ks][1] = hi16(a.x); v[ks][2] = lo16(a.y); v[ks][3] = hi16(a.y);
      v[ks][4] = lo16(a.z); v[ks][5] = hi16(a.z); v[ks][6] = lo16(a.w); v[ks][7] = hi16(a.w);
#pragma unroll
      for (int e = 0; e < 8; ++e) ss += v[ks][e] * v[ks][e];
    }
    { auto rr = __builtin_amdgcn_permlane32_swap(__float_as_uint(ss), __float_as_uint(ss), false, false); ss = __uint_as_float(rr[0]) + __uint_as_float(rr[1]); }
    const float rn = rsqrtf(ss * (1.f / 192.f) + EPS);
#pragma unroll
    for (int ks = 0; ks < 12; ++ks) {
      const float4 g0 = *(const float4*)(qhn + 16 * ks + 8 * hh), g1 = *(const float4*)(qhn + 16 * ks + 8 * hh + 4);
      v[ks][0] *= rn * g0.x; v[ks][1] *= rn * g0.y; v[ks][2] *= rn * g0.z; v[ks][3] *= rn * g0.w;
      v[ks][4] *= rn * g1.x; v[ks][5] *= rn * g1.y; v[ks][6] *= rn * g1.z; v[ks][7] *= rn * g1.w;
    }
    if (kind) {
      const int tl = (tq - TP) & 4095;
#pragma unroll
      for (int part = 0; part < 2; ++part) {
        const int pos = part == 0 ? (tl >> 6) : (tl & 63);
        const float4* rp = (const float4*)(ROPE + pos * 16 + 8 * hh);
        const float4 c01 = rp[0], c23 = rp[1], c45 = rp[2], c67 = rp[3];
        const float cs[8] = {c01.x, c01.z, c23.x, c23.z, c45.x, c45.z, c67.x, c67.z};
        const float sn[8] = {c01.y, c01.w, c23.y, c23.w, c45.y, c45.w, c67.y, c67.w};
#pragma unroll
        for (int e = 0; e < 8; ++e) {
          const float x1 = v[8 + 2 * part][e], x2 = v[9 + 2 * part][e];
          v[8 + 2 * part][e] = x1 * cs[e] - x2 * sn[e];
          v[9 + 2 * part][e] = x2 * cs[e] + x1 * sn[e];
        }
      }
    }
    const float QSCALE = 1.4426950408889634f * 0.07216878364870322f;
#pragma unroll
    for (int ks = 0; ks < 12; ++ks) {
      union { bf16x8 b; unsigned w[4]; } o;
#pragma unroll
      for (int w = 0; w < 4; ++w) o.w[w] = pack2(v[ks][2 * w] * QSCALE, v[ks][2 * w + 1] * QSCALE);
      qf[ks] = o.b;
    }
  }
  f32x16 oacc[4];
#pragma unroll
  for (int a = 0; a < 4; ++a)
#pragma unroll
    for (int r = 0; r < 16; ++r) oacc[a][r] = 0.f;
  float mrun = -INFINITY, lrun = 0.f;
  const int sw = (il >> 1) & 7;
  int ko[4], vob[4];
#pragma unroll
  for (int a = 0; a < 4; ++a) ko[a] = il * 384 + (((2 * a + hh) ^ sw) << 4);
#pragma unroll
  for (int c = 0; c < 4; ++c) vob[c] = il * 128 + (((2 * c + hh) ^ sw) << 4);
  LAS unsigned char* lds = (LAS unsigned char*)smem;
  unsigned kso[3], vso[2];
#pragma unroll
  for (int i = 0; i < 3; ++i) {
    const int id = tid + 512 * i, r = id / 24, pc = id - r * 24;
    const int ch = (pc & ~7) | ((pc & 7) ^ ((r >> 1) & 7));
    kso[i] = (unsigned)(r * 3072 + ch * 16);
  }
#pragma unroll
  for (int i = 0; i < 2; ++i) {
    const int id = tid + 512 * i, dd = id >> 3, pc = id & 7;
    const int ch = pc ^ ((dd >> 1) & 7);
    vso[i] = (unsigned)(dd * Lk * 2 + ch * 16);
  }
  const unsigned ldst = (unsigned)(tid >> 6) * 1024u;
#define ATT_STAGE(kt_, s_)                                                                                      \
  {                                                                                                            \
    const int k0_ = (kt_) * 64;                                                                                \
    const int rowbase_ = kind ? (k0_ < 4096 ? TP + seq * 4096 + k0_ : T + seq * 256 + (k0_ - 4096)) : seq * 256 + k0_; \
    const char* kg_ = (const char*)(Kb + ((size_t)rowbase_ * 8 + h) * 192);                                     \
    const char* vg_ = (const char*)(vbase + k0_);                                                              \
    _Pragma("unroll") for (int i_ = 0; i_ < 3; ++i_)                                                           \
      __builtin_amdgcn_global_load_lds((const unsigned*)(kg_ + kso[i_]), (LAS unsigned*)(lds + (s_) * 40960 + ldst + i_ * 8192), 16, 0, 0); \
    _Pragma("unroll") for (int i_ = 0; i_ < 2; ++i_)                                                           \
      __builtin_amdgcn_global_load_lds((const unsigned*)(vg_ + vso[i_]), (LAS unsigned*)(lds + (s_) * 40960 + 24576 + ldst + i_ * 8192), 16, 0, 0); \
  }
  __syncthreads();
  ATT_STAGE(0, 0)
  asm volatile("s_waitcnt vmcnt(0)" ::: "memory");
  __syncthreads();
  for (int kt = 0; kt < nkt; ++kt) {
    const bool more = kt + 1 < nkt;
    if (more) ATT_STAGE(kt + 1, (kt + 1) & 1)
    const char* Ks = smem + (kt & 1) * 40960;
    const char* Vs = Ks + 24576;
    f32x16 s2[2];
    __builtin_amdgcn_s_setprio(1);
#pragma unroll
    for (int st = 0; st < 2; ++st)
#pragma unroll
      for (int r = 0; r < 16; ++r) s2[st][r] = 0.f;
#pragma unroll
    for (int ks = 0; ks < 12; ++ks)
#pragma unroll
      for (int st = 0; st < 2; ++st) {
        const bf16x8 kf = *(const bf16x8*)(Ks + ko[ks & 3] + st * 12288 + (ks >> 2) * 128);
        s2[st] = __builtin_amdgcn_mfma_f32_32x32x16_bf16(kf, qf[ks], s2[st], 0, 0, 0);
      }
    __builtin_amdgcn_s_setprio(0);
    {
      float pmax = s2[0][0];
#pragma unroll
      for (int r = 1; r < 16; ++r) pmax = fmaxf(pmax, s2[0][r]);
#pragma unroll
      for (int r = 0; r < 16; ++r) pmax = fmaxf(pmax, s2[1][r]);
      { auto rr = __builtin_amdgcn_permlane32_swap(__float_as_uint(pmax), __float_as_uint(pmax), false, false);
        pmax = fmaxf(__uint_as_float(rr[0]), __uint_as_float(rr[1])); }
      if (!__all(pmax - mrun <= 11.541560327f)) {
        const float mn = fmaxf(mrun, pmax);
        const float alpha = __builtin_amdgcn_exp2f(mrun - mn);
        mrun = mn;
        lrun *= alpha;
#pragma unroll
        for (int a = 0; a < 4; ++a)
#pragma unroll
          for (int r = 0; r < 16; ++r) oacc[a][r] *= alpha;
      }
      float psum = 0.f;
#pragma unroll
      for (int st = 0; st < 2; ++st)
#pragma unroll
        for (int r = 0; r < 16; ++r) { const float pv = __builtin_amdgcn_exp2f(s2[st][r] - mrun); s2[st][r] = pv; psum += pv; }
      lrun += psum;
    }
    __builtin_amdgcn_s_setprio(1);
#pragma unroll
    for (int st = 0; st < 2; ++st)
#pragma unroll
      for (int sb = 0; sb < 2; ++sb) {
        union { bf16x8 v; unsigned w[4]; } pb;
#pragma unroll
        for (int w = 0; w < 4; ++w) pb.w[w] = pack2(s2[st][8 * sb + 2 * w], s2[st][8 * sb + 2 * w + 1]);
#pragma unroll
        for (int dt = 0; dt < 4; ++dt) {
          const bf16x8 vf = *(const bf16x8*)(Vs + vob[2 * st + sb] + dt * 4096);
          oacc[dt] = __builtin_amdgcn_mfma_f32_32x32x16_bf16(vf, pb.v, oacc[dt], 0, 0, 0);
        }
      }
    __builtin_amdgcn_s_setprio(0);
    asm volatile("s_waitcnt vmcnt(0)" ::: "memory");
    __syncthreads();
  }
#undef ATT_STAGE
  float ltot;
  { auto rr = __builtin_amdgcn_permlane32_swap(__float_as_uint(lrun), __float_as_uint(lrun), false, false); ltot = __uint_as_float(rr[0]) + __uint_as_float(rr[1]); }
  const float inv = 1.f / ltot;
#pragma unroll
  for (int dt = 0; dt < 4; ++dt)
#pragma unroll
    for (int g = 0; g < 4; ++g) {
      const int d = dt * 32 + 8 * g + 4 * hh;
      *(uint2*)(O + (size_t)tq * 1024 + h * 128 + d) =
          pack4(oacc[dt][4 * g] * inv, oacc[dt][4 * g + 1] * inv, oacc[dt][4 * g + 2] * inv, oacc[dt][4 * g + 3] * inv);
    }
}
DI void phase_attention(const PV& p, int j, char* smem) {
  const bool xmap = gridDim.x == 256;
  const int Gq = opaque_i((int)gridDim.x);
  const int nit = xmap ? 5 : (1280 + Gq - 1) / Gq;
#pragma unroll 1
  for (int r = 0; r < nit; ++r) {
    int kind, seq, h, q0;
    if (xmap) {
      if (r < 4) {
        const int xcd = blockIdx.x & 7, slot = blockIdx.x >> 3;
        const int pair = xcd + 8 * (2 * r + (slot >> 4)), qb = slot & 15;
        kind = 1; seq = pair >> 3; h = pair & 7; q0 = TP + seq * 4096 + qb * 256;
      } else {
        kind = 0; seq = blockIdx.x >> 3; h = blockIdx.x & 7; q0 = seq * 256;
      }
    } else {
      const int it = blockIdx.x + r * gridDim.x;
      if (it >= 1280) break;
      if (it < 1024) { const int pair = it >> 4, qb = it & 15; kind = 1; seq = pair >> 3; h = pair & 7; q0 = TP + seq * 4096 + qb * 256; }
      else { const int i2 = it - 1024; kind = 0; seq = i2 >> 3; h = i2 & 7; q0 = seq * 256; }
    }
    attn_item(p, j, kind, seq, h, q0, smem);
  }
  __syncthreads();
}

DI size_t act_blk(int t, int a) { return (size_t)(t >> 8) * (256 * 2816) + (size_t)(a >> 6) * (256 * 64) + (size_t)((t & 255) * 64 + (a & 63)); }
DI float dpp_ror1(float x) { return __int_as_float(__builtin_amdgcn_update_dpp(0, __float_as_int(x), 0x121, 0xf, 0xf, false)); }
DI float dpp_ror15(float x) { return __int_as_float(__builtin_amdgcn_update_dpp(0, __float_as_int(x), 0x12F, 0xf, 0xf, false)); }
struct EpiFFN {
  u16* ACT; u16* EDGE; const float* cw; const float* cb;
  DI void operator()(const f32x4 (&acc)[2][2][4][2], int pm, int pn, int wr, int wc, int fr, int fq) const {
    uint2 keep[2][4];
#pragma unroll
    for (int n = 0; n < 2; ++n) {
      const int a = pn * 128 + wc * 32 + fq * 8 + n * 4;
      const float4 w0g = *(const float4*)(cw + a), w1g = *(const float4*)(cw + 5632 + a), w2g = *(const float4*)(cw + 11264 + a), bg = *(const float4*)(cb + a);
      const float4 w0u = *(const float4*)(cw + 2816 + a), w1u = *(const float4*)(cw + 5632 + 2816 + a), w2u = *(const float4*)(cw + 11264 + 2816 + a), bu = *(const float4*)(cb + 2816 + a);
#pragma unroll
      for (int ai = 0; ai < 2; ++ai) {
        const int rbase = pm * 256 + ai * 128 + wr * 64;
        const size_t erow = (size_t)(rbase >> 6) * 4;
#pragma unroll
        for (int m = 0; m < 4; ++m) {
          const int mp = m > 0 ? m - 1 : 0, mn = m < 3 ? m + 1 : 3;
          float o[4];
#define FFN_ONE(J, C)                                                                                         \
          {                                                                                                   \
            const float g = acc[ai][0][m][n][J], u = acc[ai][1][m][n][J];                                     \
            const float gpv = m > 0 ? acc[ai][0][mp][n][J] : 0.f, gnx = m < 3 ? acc[ai][0][mn][n][J] : 0.f;   \
            const float upv = m > 0 ? acc[ai][1][mp][n][J] : 0.f, unx = m < 3 ? acc[ai][1][mn][n][J] : 0.f;   \
            const float gp = dpp_ror1(fr == 15 ? gpv : g), gn = dpp_ror15(fr == 0 ? gnx : g);                \
            const float up = dpp_ror1(fr == 15 ? upv : u), un = dpp_ror15(fr == 0 ? unx : u);                \
            const float cg = w0g.C * gp + w1g.C * g + w2g.C * gn + bg.C;                                      \
            const float cu = w0u.C * up + w1u.C * u + w2u.C * un + bu.C;                                      \
            o[J] = silu(cg) * cu;                                                                             \
          }
          FFN_ONE(0, x) FFN_ONE(1, y) FFN_ONE(2, z) FFN_ONE(3, w)
#undef FFN_ONE
          {
            const uint2 cur = pack4(o[0], o[1], o[2], o[3]);
            if (n == 0) keep[ai][m] = cur;
            else { uint4 w; w.x = keep[ai][m].x; w.y = keep[ai][m].y; w.z = cur.x; w.w = cur.y; *(uint4*)(ACT + act_blk(rbase + m * 16 + fr, a - 4)) = w; }
          }
          if ((m == 0 && fr < 2) || (m == 3 && fr >= 14)) {
            const int ri = m == 0 ? fr : fr - 12;
            u16* e = EDGE + (erow + ri) * 5632 + pn * 256 + wc * 32 + fq * 8 + n * 4;
            *(uint2*)e = pack4(acc[ai][0][m][n][0], acc[ai][0][m][n][1], acc[ai][0][m][n][2], acc[ai][0][m][n][3]);
            *(uint2*)(e + 128) = pack4(acc[ai][1][m][n][0], acc[ai][1][m][n][1], acc[ai][1][m][n][2], acc[ai][1][m][n][3]);
          }
        }
      }
    }
  }
};
DI void phase_ffn_up(const PV& p, int l, char* smem) {
  EpiFFN E;
  E.ACT = (u16*)(p.ws() + OFF_B + B_ACT); E.EDGE = (u16*)(p.ws() + OFF_EDGE);
  E.cw = p.in(33) + (size_t)l * 3 * 5632; E.cb = p.in(34) + (size_t)l * 5632;
  TileSched<160, 22, 16, 8, 4, 16, 2> S; S.init();
  gemm8<false, 0, true>(smem, (const u16*)(p.ws() + OFF_A + A_H), (const u16*)(p.ws() + OFF_WUP), 1024, S, E);
}
DI void phase_ffn_fix(const PV& p, int l) {
  const u16* EDGE = (const u16*)(p.ws() + OFF_EDGE);
  u16* ACT = (u16*)(p.ws() + OFF_B + B_ACT);
  const float* cw = p.in(33) + (size_t)l * 3 * 5632;
  const float* cb = p.in(34) + (size_t)l * 5632;
  const unsigned gtid = blockIdx.x * blockDim.x + (unsigned)TIDX(), gsz = gridDim.x * blockDim.x;
  for (unsigned idx = gtid; idx < 640u * 2u * 704u; idx += gsz) {
    const unsigned rq = idx / 704u;
    const int a = (int)(idx - rq * 704u) * 4, rr = (int)rq, which = rr & 1, sidx = rr >> 1;
    const int t = sidx * 64 + (which ? 63 : 0);
    const int tb = which ? t + 1 : t;
    const bool seqb = tb < TP ? (tb & 255) == 0 : ((tb - TP) & 4095) == 0;
    if (seqb) continue;
    const int pc = (a >> 7) * 256 + (a & 127);
    const u16 *pr, *cu, *nx;
    if (which == 0) { pr = EDGE + ((size_t)(sidx - 1) * 4 + 3) * 5632; cu = EDGE + ((size_t)sidx * 4 + 0) * 5632; nx = EDGE + ((size_t)sidx * 4 + 1) * 5632; }
    else { pr = EDGE + ((size_t)sidx * 4 + 2) * 5632; cu = EDGE + ((size_t)sidx * 4 + 3) * 5632; nx = EDGE + ((size_t)(sidx + 1) * 4 + 0) * 5632; }
    const uint2 gp = *(const uint2*)(pr + pc), gc = *(const uint2*)(cu + pc), gn = *(const uint2*)(nx + pc);
    const uint2 up = *(const uint2*)(pr + pc + 128), uc = *(const uint2*)(cu + pc + 128), un = *(const uint2*)(nx + pc + 128);
    const float4 w0g = *(const float4*)(cw + a), w1g = *(const float4*)(cw + 5632 + a), w2g = *(const float4*)(cw + 11264 + a), bg = *(const float4*)(cb + a);
    const float4 w0u = *(const float4*)(cw + 2816 + a), w1u = *(const float4*)(cw + 5632 + 2816 + a), w2u = *(const float4*)(cw + 11264 + 2816 + a), bu = *(const float4*)(cb + 2816 + a);
    const float g0 = w0g.x * lo16(gp.x) + w1g.x * lo16(gc.x) + w2g.x * lo16(gn.x) + bg.x, u0 = w0u.x * lo16(up.x) + w1u.x * lo16(uc.x) + w2u.x * lo16(un.x) + bu.x;
    const float g1 = w0g.y * hi16(gp.x) + w1g.y * hi16(gc.x) + w2g.y * hi16(gn.x) + bg.y, u1 = w0u.y * hi16(up.x) + w1u.y * hi16(uc.x) + w2u.y * hi16(un.x) + bu.y;
    const float g2 = w0g.z * lo16(gp.y) + w1g.z * lo16(gc.y) + w2g.z * lo16(gn.y) + bg.z, u2 = w0u.z * lo16(up.y) + w1u.z * lo16(uc.y) + w2u.z * lo16(un.y) + bu.z;
    const float g3 = w0g.w * hi16(gp.y) + w1g.w * hi16(gc.y) + w2g.w * hi16(gn.y) + bg.w, u3 = w0u.w * hi16(up.y) + w1u.w * hi16(uc.y) + w2u.w * hi16(un.y) + bu.w;
    *(uint2*)(ACT + act_blk(t, a)) = pack4(silu(g0) * u0, silu(g1) * u1, silu(g2) * u2, silu(g3) * u3);
  }
}

#ifndef PH
#define RUN(k, ...) __VA_ARGS__
#else
#define RUN(k, ...) if (PH == k) { __VA_ARGS__ }
#endif
extern "C" __global__ void __launch_bounds__(512) fwd_megakernel(Params kp) {
  extern __shared__ __attribute__((aligned(16))) char smem[];
  cg::grid_group grid = cg::this_grid();
  if (TIDX() == 0) {
    unsigned long long* t = (unsigned long long*)(smem + PARM_OFF);
#pragma unroll
    for (int k = 0; k < 36; ++k) t[k] = (unsigned long long)kp.in[k];
    t[36] = (unsigned long long)kp.out; t[37] = (unsigned long long)kp.ws;
  }
  __syncthreads();
  PV p; p.smem = smem;
  unsigned* bar = (unsigned*)(p.ws() + OFF_BAR);
  if (TIDX() == 0) { *(unsigned*)(smem + PARM_OFF + 512) = 0u; *(unsigned*)(smem + PARM_OFF + 516) = 0u; }
  __syncthreads();
  const XcdBarrier xb = xcd_barrier_post(bar, (volatile LASB unsigned*)(smem + PARM_OFF + 512));
  RUN(0, phase_prep(p, smem);)
  grid.sync();
  RUN(1, phase_filters(p, smem);)
  for (int l = 0; l < 4; ++l) {
    const int i = l >> 1;
    RUN(2, phase_norm(p, l, 0, l);)
    RUN(0, if (l > 0) { int base = 0; convert_ffn_weights(p, l, smem, base); })
    xcd_barrier(xb);
    if ((l & 1) == 0) {
      RUN(3, phase_mix_in(p, i, smem);)
      xcd_barrier(xb);
      RUN(4, phase_sgu(p, i, smem);)
      RUN(5, phase_conv(p, i, 0, smem);)
      xcd_barrier(xb);
      RUN(5, phase_conv(p, i, 1, smem);)
      xcd_barrier(xb);
      RUN(6, phase_ztrans(p, smem);)
      xcd_barrier(xb);
      RUN(7, phase_resid_gemm(p, l, l, (const u16*)(p.ws() + OFF_B + B_MIX), 1024, (const u16*)(p.ws() + OFF_WMIXOUT) + (size_t)i * 1024 * 1024, 2048, smem);)
      xcd_barrier(xb);
    } else {
      RUN(8, phase_dqkv(p, i, smem);)
      xcd_barrier(xb);
      RUN(9, phase_mla_norms(p, i);)
      xcd_barrier(xb);
      RUN(10, phase_uq_ukv(p, i, smem);)
      xcd_barrier(xb);
      RUN(11, phase_finalize(p, i);)
      xcd_barrier(xb);
      RUN(12, phase_attention(p, i, smem);)
      xcd_barrier(xb);
      RUN(7, phase_resid_gemm(p, l, l, (const u16*)(p.ws() + OFF_A + A_O), 1024, (const u16*)(p.ws() + OFF_WO) + (size_t)i * 1024 * 1024, 2048, smem);)
      xcd_barrier(xb);
    }
    RUN(2, phase_norm(p, l, 1, 1);)
    xcd_barrier(xb);
    RUN(13, phase_ffn_up(p, l, smem);)
    xcd_barrier(xb);
    RUN(14, phase_ffn_fix(p, l);)
    xcd_barrier(xb);
    RUN(7, phase_resid_gemm(p, l, 1, (const u16*)(p.ws() + OFF_B + B_ACT), 2816, (const u16*)(p.ws() + OFF_WDOWN), 5120, smem);)
    xcd_barrier(xb);
  }
}

extern "C" void kernel_launch(void* const* d_in, const int* in_sizes, int n_in,
                              void* d_out, int out_size, void* d_ws, size_t ws_size,
                              hipStream_t stream) {
  static int grid_blocks = 0;
  if (!grid_blocks) {
    int dev = 0, cus = 0, per_cu = 0;
    (void)hipGetDevice(&dev);
    (void)hipDeviceGetAttribute(&cus, hipDeviceAttributeMultiprocessorCount, dev);
    (void)hipFuncSetAttribute((const void*)fwd_megakernel, hipFuncAttributeMaxDynamicSharedMemorySize, (int)LDS_BYTES);
    (void)hipOccupancyMaxActiveBlocksPerMultiprocessor(&per_cu, fwd_megakernel, 512, LDS_BYTES);
    if (per_cu < 1) per_cu = 1;
    if (per_cu > 1) per_cu = 1;
    grid_blocks = cus * per_cu;
  }
  if (ws_size < WS_NEED) fprintf(stderr, "workspace too small: %zu < %zu\n", ws_size, (size_t)WS_NEED);
  Params p{};
  for (int i = 0; i < 36; ++i) p.in[i] = (const float*)d_in[i];
  p.out = (float*)d_out;
  p.ws = (char*)d_ws;
  (void)hipMemsetAsync((char*)d_ws + OFF_BAR, 0, 16384, stream);
  void* args[] = {&p};
  hipError_t e = hipLaunchCooperativeKernel((void*)fwd_megakernel, dim3(grid_blocks), dim3(512), args, LDS_BYTES, stream);
  if (e != hipSuccess) fprintf(stderr, "cooperative launch failed: %s (grid %d)\n", hipGetErrorString(e), grid_blocks);
}
```

```cpp
#include <hip/hip_runtime.h>
#include <hip/hip_cooperative_groups.h>
#include <cstdio>
namespace cg = cooperative_groups;

typedef unsigned short u16;
using bf16x8 = __attribute__((ext_vector_type(8))) short;
using f32x4 = __attribute__((ext_vector_type(4))) float;
using f32x16 = __attribute__((ext_vector_type(16))) float;
#define DI __device__ __forceinline__

constexpr int T = 40960;
constexpr int TP = 8192;
constexpr int TK = 43008;
constexpr float EPS = 1e-6f;
constexpr size_t LDS_BYTES = 139264;

constexpr size_t OFF_WMIXIN = 0;
constexpr size_t OFF_WMIXOUT = OFF_WMIXIN + (size_t)2 * 2560 * 1024 * 2;
constexpr size_t OFF_WDQKV = OFF_WMIXOUT + (size_t)2 * 1024 * 1024 * 2;
constexpr size_t OFF_WUQ = OFF_WDQKV + (size_t)2 * 1024 * 1024 * 2;
constexpr size_t OFF_WUKV = OFF_WUQ + (size_t)2 * 1536 * 512 * 2;
constexpr size_t OFF_WO = OFF_WUKV + (size_t)2 * 2048 * 256 * 2;
constexpr size_t OFF_WSGU = OFF_WO + (size_t)2 * 1024 * 1024 * 2;
constexpr size_t OFF_WUP = OFF_WSGU + (size_t)2 * 4 * 128 * 128 * 2;
constexpr size_t OFF_WDOWN = OFF_WUP + (size_t)5632 * 1024 * 2;
constexpr size_t OFF_MOD = OFF_WDOWN + (size_t)1024 * 2816 * 2;
constexpr size_t OFF_FILT = OFF_MOD + (size_t)4 * 9 * 6144 * 4;
constexpr size_t OFF_H2 = OFF_FILT + (size_t)2 * 2 * 512 * 4352 * 2;
constexpr size_t OFF_EDGE = OFF_H2 + (size_t)2 * 4352 * 64 * 4;
constexpr size_t OFF_KR = OFF_EDGE + (size_t)640 * 4 * 5632 * 2;
constexpr size_t OFF_A = OFF_KR + (size_t)TK * 64 * 2;
constexpr size_t OFF_B = OFF_A + (size_t)T * 1024 * 2;
constexpr size_t OFF_BAR = OFF_B + (size_t)346030080;
constexpr size_t OFF_ROPE = OFF_BAR + 16384;
constexpr size_t WS_NEED = OFF_ROPE + 64 * 16 * 8;
constexpr size_t A_H = 0, A_Z1 = 0, A_Z2 = (size_t)T * 512 * 2, A_QN = 0, A_CKV = (size_t)T * 512 * 2, A_O = 0;
constexpr size_t B_VT = 0, B_PRT = (size_t)T * 512 * 2, B_MIX = B_PRT + (size_t)T * 1536 * 2;
constexpr size_t B_DQKV = 0, B_Q = 0, B_K = (size_t)T * 1536 * 2, B_V = B_K + (size_t)TK * 1536 * 2;
constexpr size_t B_ACT = 0;
constexpr size_t VT_SAMPLE_OFF = (size_t)32 * 8 * 128 * 256;

struct Params {
  const float* in[36];
  float* out;
  char* ws;
};


constexpr int PARM_OFF = 138240;
struct PV {
  char* smem;
  DI unsigned long long ld(int k) const {
    int off = PARM_OFF + 8 * k;
    asm volatile("" : "+v"(off));
    const unsigned long long v = *(const unsigned long long*)(smem + off);
    const unsigned lo = __builtin_amdgcn_readfirstlane((unsigned)v), hi = __builtin_amdgcn_readfirstlane((unsigned)(v >> 32));
    return ((unsigned long long)hi << 32) | lo;
  }
  DI const float* in(int k) const { return (const float*)(const __attribute__((address_space(1))) float*)ld(k); }
  DI float* out() const { return (float*)(__attribute__((address_space(1))) float*)ld(36); }
  DI char* ws() const { return (char*)(__attribute__((address_space(1))) char*)ld(37); }
};

DI int TIDX() { int t = (int)__builtin_amdgcn_workitem_id_x(); asm volatile("" : "+v"(t)); return t; }
DI u16 f2bf(float x) { unsigned u = __float_as_uint(x); u += 0x7fffu + ((u >> 16) & 1u); return (u16)(u >> 16); }
DI float bf2f(u16 h) { return __uint_as_float(((unsigned)h) << 16); }
DI unsigned pack2(float a, float b) { unsigned r; asm("v_cvt_pk_bf16_f32 %0, %1, %2" : "=v"(r) : "v"(a), "v"(b)); return r; }
DI uint2 pack4(float a, float b, float c, float d) { uint2 r; r.x = pack2(a, b); r.y = pack2(c, d); return r; }
DI float lo16(unsigned w) { return __uint_as_float(w << 16); }
DI float hi16(unsigned w) { return __uint_as_float(w & 0xffff0000u); }
DI float gelu_tanh(float x) { const float y = x * (1.f + 0.044715f * x * x); return x * __builtin_amdgcn_rcpf(1.f + __builtin_amdgcn_exp2f(-2.302208198f * y)); }
DI float silu(float x) { return x * __builtin_amdgcn_rcpf(1.f + __builtin_amdgcn_exp2f(-1.4426950409f * x)); }
DI float4 ld16_nt(const float* ptr) { const f32x4 t = __builtin_nontemporal_load((const f32x4*)ptr); float4 r; r.x = t[0]; r.y = t[1]; r.z = t[2]; r.w = t[3]; return r; }
DI void st16_nt(float* ptr, float4 v) { const f32x4 t = {v.x, v.y, v.z, v.w}; __builtin_nontemporal_store(t, (f32x4*)ptr); }
DI int condrow(int m) { return m < TP ? 0 : 1 + ((m - TP) >> 12); }
template <int MASK> DI float shx(float v, int lane) {
  if (MASK == 32) return __int_as_float(__builtin_amdgcn_ds_bpermute((lane ^ 32) << 2, __float_as_int(v)));
  return __int_as_float(__builtin_amdgcn_ds_swizzle(__float_as_int(v), (MASK << 10) | 0x1f));
}
DI float wave_sum(float v, int lane) {
  v += shx<32>(v, lane); v += shx<16>(v, lane); v += shx<8>(v, lane);
  v += shx<4>(v, lane); v += shx<2>(v, lane); v += shx<1>(v, lane); return v;
}
DI int opaque_i(int x) { asm volatile("" : "+s"(x)); return x; }
DI int first_unit(int base) { const int G = opaque_i((int)gridDim.x); int r = (int)blockIdx.x - (base % G); if (r < 0) r += G; return r; }
DI const float* xin_row(const PV& p, int l, int m) {
  if (l == 0) return m < TP ? p.in(0) + (size_t)m * 1024 : p.in(1) + (size_t)(m - TP) * 1024;
  return p.out() + (size_t)m * 1024;
}


#define XB_TMO      128
#define XB_XCNT(j)  (256  + 64 * (j))
#define XB_XSUB(j)  (1280 + 64 * (j))
#define XB_XGEN(j)  (2304 + 64 * (j))
#define XB_TOP      3328
#define XB_TOPGEN   3392
#define XB_SPIN_CAP (1u << 22)
#define LASB __attribute__((address_space(3)))
DI unsigned xb_ld(unsigned* p) { return __hip_atomic_load(p, __ATOMIC_RELAXED, __HIP_MEMORY_SCOPE_AGENT); }
DI unsigned xb_add(unsigned* p, unsigned v) { return __hip_atomic_fetch_add(p, v, __ATOMIC_RELAXED, __HIP_MEMORY_SCOPE_AGENT); }
DI unsigned xb_xcc_id() { return (unsigned)__builtin_amdgcn_s_getreg((3 << 11) | 20) & 0xFu; }
#define XB_SPIN(cond, bar) do { unsigned _sp = 0; while (cond) { __builtin_amdgcn_s_sleep(1); \
    if ((++_sp & 255u) == 0u) { if (xb_ld(&(bar)[XB_TMO])) break; if (_sp > XB_SPIN_CAP) { atomicAdd(&(bar)[XB_TMO], 1u); break; } } } } while (0)
struct XcdBarrier { unsigned* bar; unsigned x; volatile LASB unsigned* st; };
DI XcdBarrier xcd_barrier_post(unsigned* bar, volatile LASB unsigned* st) {
  XcdBarrier b; b.bar = bar; b.x = xb_xcc_id(); b.st = st;
  if (TIDX() == 0) (void)xb_add(&bar[XB_XCNT(b.x)], 1u);
  return b;
}
DI void xcd_barrier_complete(unsigned* bar, unsigned x, unsigned& nloc, unsigned& nx) {
  const unsigned G = gridDim.x;
  unsigned sum, cnt, mine, sp = 0u;
  for (;;) {
    sum = 0u; cnt = 0u; mine = 0u;
#pragma unroll
    for (unsigned j = 0; j < 16; ++j) { const unsigned c = xb_ld(&bar[XB_XCNT(j)]); sum += c; cnt += (c > 0u) ? 1u : 0u; mine = (j == x) ? c : mine; }
    if (sum == G) break;
    __builtin_amdgcn_s_sleep(1);
    if ((++sp & 255u) == 0u) { if (xb_ld(&bar[XB_TMO])) break; if (sp > XB_SPIN_CAP) { atomicAdd(&bar[XB_TMO], 1u); break; } }
  }
  nloc = mine > 0u ? mine : 1u; nx = cnt > 0u ? cnt : 1u;
}
DI void xcd_barrier(const XcdBarrier& b) {
  asm volatile("s_waitcnt vmcnt(0)" ::: "memory");
  __syncthreads();
  if (TIDX() == 0) {
    unsigned* bar = b.bar;
    __builtin_amdgcn_s_waitcnt(0);
    unsigned nloc = b.st[0], nx = b.st[1];
    if (nloc == 0u) { xcd_barrier_complete(bar, b.x, nloc, nx); b.st[0] = nloc; b.st[1] = nx; }
    const unsigned old = xb_add(&bar[XB_XSUB(b.x)], 1u);
    const unsigned gen = old / nloc;
    if (old + 1u == (gen + 1u) * nloc) {
      __builtin_amdgcn_fence(__ATOMIC_RELEASE, "agent");
      asm volatile("s_waitcnt vmcnt(0)" ::: "memory");
      const unsigned og = xb_add(&bar[XB_TOP], 1u);
      const unsigned tg = og / nx;
      if (og + 1u == (tg + 1u) * nx) xb_add(&bar[XB_TOPGEN], 1u);
      else XB_SPIN(xb_ld(&bar[XB_TOPGEN]) == tg, bar);
      __builtin_amdgcn_fence(__ATOMIC_ACQUIRE, "agent");
      xb_add(&bar[XB_XGEN(b.x)], 1u);
      asm volatile("s_waitcnt vmcnt(0)" ::: "memory");
    } else {
      XB_SPIN(xb_ld(&bar[XB_XGEN(b.x)]) == gen, bar);
      __builtin_amdgcn_fence(__ATOMIC_ACQUIRE, "agent");
      asm volatile("s_waitcnt vmcnt(0)" ::: "memory");
    }
  }
  __syncthreads();
}

template <int MODE>
DI int rowmap(int n, int row0) {
  if (MODE == 0) return n + row0;
  return n < 2816 ? (n >> 7) * 256 + (n & 127) : ((n - 2816) >> 7) * 256 + 128 + ((n - 2816) & 127);
}
template <int MODE, int NJ = 4>
DI void convT(const float* __restrict__ src, u16* __restrict__ dst, int K, int N, int row0, char* smem, int& base) {
  u16* tl = (u16*)smem;
  const int tid = TIDX();
  const int nN = N / (64 * NJ), nunits = (K >> 6) * nN;
  for (int u = first_unit(base); u < nunits; u += gridDim.x) {
    const int k0 = (u / nN) << 6, n0 = (u % nN) * (64 * NJ);
    float4 v[2][NJ];
#pragma unroll
    for (int i = 0; i < 2; ++i)
#pragma unroll
      for (int j = 0; j < NJ; ++j)
        v[i][j] = *(const float4*)(src + (size_t)(k0 + (tid >> 4) + 32 * i) * N + n0 + (tid & 15) * 4 + 64 * j);
#pragma unroll
    for (int i = 0; i < 2; ++i)
#pragma unroll
      for (int j = 0; j < NJ; ++j) {
        const int r = (tid >> 4) + 32 * i, c4 = (tid & 15) * 4 + 64 * j;
        tl[(c4 + 0) * 72 + r] = f2bf(v[i][j].x); tl[(c4 + 1) * 72 + r] = f2bf(v[i][j].y);
        tl[(c4 + 2) * 72 + r] = f2bf(v[i][j].z); tl[(c4 + 3) * 72 + r] = f2bf(v[i][j].w);
      }
    __syncthreads();
#pragma unroll
    for (int j = 0; j < NJ; ++j) {
      const int n = (tid >> 3) + 64 * j, kc = (tid & 7) * 8;
      const uint4 o = *(const uint4*)(tl + n * 72 + kc);
      { const int rr = rowmap<MODE>(n0 + n, row0);
        *(uint4*)(dst + (size_t)(rr >> 8) * 256 * K + (size_t)(k0 >> 6) * (256 * 64) + (rr & 255) * 64 + kc) = o; }
    }
    __syncthreads();
  }
  base += nunits;
}

DI void convert_ffn_weights(const PV& p, int l, char* smem, int& base) {
  convT<1>(p.in(32) + (size_t)l * 1024 * 5632, (u16*)(p.ws() + OFF_WUP), 1024, 5632, 0, smem, base);
  convT<0>(p.in(35) + (size_t)l * 2816 * 1024, (u16*)(p.ws() + OFF_WDOWN), 2816, 1024, 0, smem, base);
}

DI void phase_prep(const PV& p, char* smem) {
  const int tid = TIDX();
  int base = 0;
  char* ws = p.ws();
  for (int i = 0; i < 2; ++i) {
    convT<0>(p.in(9) + (size_t)i * 1024 * 2560, (u16*)(ws + OFF_WMIXIN) + (size_t)i * 2560 * 1024, 1024, 2560, 0, smem, base);
    convT<0>(p.in(22) + (size_t)i * 1024 * 1024, (u16*)(ws + OFF_WMIXOUT) + (size_t)i * 1024 * 1024, 1024, 1024, 0, smem, base);
    convT<0>(p.in(23) + (size_t)i * 1024 * 512, (u16*)(ws + OFF_WDQKV) + (size_t)i * 1024 * 1024, 1024, 512, 0, smem, base);
    convT<0, 1>(p.in(26) + (size_t)i * 1024 * 320, (u16*)(ws + OFF_WDQKV) + (size_t)i * 1024 * 1024, 1024, 320, 512, smem, base);
    convT<0>(p.in(25) + (size_t)i * 512 * 1536, (u16*)(ws + OFF_WUQ) + (size_t)i * 1536 * 512, 512, 1536, 0, smem, base);
    convT<0>(p.in(28) + (size_t)i * 256 * 2048, (u16*)(ws + OFF_WUKV) + (size_t)i * 2048 * 256, 256, 2048, 0, smem, base);
    convT<0>(p.in(31) + (size_t)i * 1024 * 1024, (u16*)(ws + OFF_WO) + (size_t)i * 1024 * 1024, 1024, 1024, 0, smem, base);
  }
  convert_ffn_weights(p, 0, smem, base);
  {
    const long gtid = (long)blockIdx.x * blockDim.x + tid, gsz = (long)gridDim.x * blockDim.x;
    for (long i = gtid; i < 2 * 192 * 1024; i += gsz) {
      const int j = (int)(i / (192 * 1024)), rem = (int)(i % (192 * 1024)), rr = 832 + (rem >> 10), k = rem & 1023;
      ((u16*)(ws + OFF_WDQKV))[(size_t)j * 1024 * 1024 + (size_t)(rr >> 8) * 256 * 1024 + (size_t)(k >> 6) * (256 * 64) + (rr & 255) * 64 + (k & 63)] = 0;
    }
    for (long i = gtid; i < 2 * 4 * 128 * 128; i += gsz) ((u16*)(ws + OFF_WSGU))[i] = f2bf(p.in(10)[i]);
    for (long i = gtid; i < 64 * 16; i += gsz) {
      const int pos = (int)(i >> 4), f = (int)(i & 15);
      const float inv = exp2f(-(float)f * (13.287712379549449f / 16.f));
      float sn, cs;
      sincosf((float)pos * inv, &sn, &cs);
      ((float2*)(ws + OFF_ROPE))[i] = make_float2(cs, sn);
    }
  }
  {
    float* sc = (float*)smem;
    float* part = sc + 9 * 1024;
    __syncthreads();
    for (int i = tid; i < 9 * 1024; i += 512) {
      const int r = i >> 10, k = i & 1023;
      const float c = r == 0 ? p.in(5)[k] : p.in(4)[(r - 1) * 1024 + k];
      sc[i] = silu(c);
    }
    __syncthreads();
    float* MOD = (float*)(ws + OFF_MOD);
    const int nunits = 4 * 96;
    for (int u = first_unit(base); u < nunits; u += gridDim.x) {
      const int l = u / 96, n0 = (u % 96) * 64;
      const int col = n0 + (tid & 63), kg = tid >> 6;
      float acc[9];
#pragma unroll
      for (int r = 0; r < 9; ++r) acc[r] = 0.f;
      const float* w = p.in(6) + (size_t)l * 1024 * 6144 + col;
#pragma unroll 16
      for (int k = kg * 128; k < kg * 128 + 128; ++k) {
        const float wv = w[(size_t)k * 6144];
#pragma unroll
        for (int r = 0; r < 9; ++r) acc[r] += sc[r * 1024 + k] * wv;
      }
#pragma unroll
      for (int r = 0; r < 9; ++r) part[(kg * 9 + r) * 64 + (tid & 63)] = acc[r];
      __syncthreads();
      for (int i = tid; i < 576; i += 512) {
        const int r = i >> 6, cc = i & 63;
        float s = p.in(7)[l * 6144 + n0 + cc];
#pragma unroll
        for (int g = 0; g < 8; ++g) s += part[(g * 9 + r) * 64 + cc];
        MOD[(size_t)(l * 9 + r) * 6144 + n0 + cc] = s;
      }
      __syncthreads();
    }
    base += nunits;
  }
  {
    float* zf = (float*)smem;
    float* h1 = zf + 8 * 36;
    float* H2 = (float*)(ws + OFF_H2);
    const int nunits = 2 * 544;
    for (int u = first_unit(base); u < nunits; u += gridDim.x) {
      const int i = u / 544, tg0 = (u % 544) * 8;
      __syncthreads();
      if (tid < 8 * 33) {
        const int tt = tid / 33, e = tid % 33;
        const int tg = tg0 + tt;
        const float L = tg < 256 ? 256.f : 4096.f;
        const float t = tg < 256 ? (float)tg : (float)(tg - 256);
        const float tn = t / L;
        float v;
        if (e == 0) v = tn;
        else if (e <= 16) v = sinf((6.283185307179586f * tn) * (float)e);
        else v = cosf((6.283185307179586f * tn) * (float)(e - 16));
        zf[tt * 36 + e] = v;
      }
      __syncthreads();
      const int tt = tid >> 6, jj = tid & 63;
      const float fr = p.in(19)[i * 64 + jj];
      {
        float a = p.in(15)[i * 64 + jj];
        const float* w1 = p.in(14) + (size_t)i * 33 * 64 + jj;
        for (int e = 0; e < 33; ++e) a += zf[tt * 36 + e] * w1[e * 64];
        h1[tt * 64 + jj] = sinf(fr * a);
      }
      __syncthreads();
      {
        float a = p.in(17)[i * 64 + jj];
        const float* w2 = p.in(16) + (size_t)i * 64 * 64 + jj;
        for (int e = 0; e < 64; ++e) a += h1[tt * 64 + e] * w2[e * 64];
        H2[((size_t)i * 4352 + tg0 + tt) * 64 + jj] = sinf(fr * a);
      }
    }
    base += nunits;
    __syncthreads();
  }
}

DI void phase_filters(const PV& p, char* smem) {
  const int tid = TIDX();
  float* w3s = (float*)smem;
  float* red = w3s + 512;
  float* nrm = red + 512;
  float* hbuf = nrm + 8;
  const float* H2 = (const float*)(p.ws() + OFF_H2);
  u16* FILT = (u16*)(p.ws() + OFF_FILT);
  for (int u = blockIdx.x; u < 512; u += gridDim.x) {
    const int kind = (u >> 7) & 1, i = u >> 8, cg8 = (u & 127) * 8;
    const int L = kind ? 4096 : 256, tbase = kind ? 256 : 0;
    __syncthreads();
    { const int j = tid >> 3, cc = tid & 7; w3s[j * 8 + cc] = p.in(18)[((size_t)i * 64 + j) * 1024 + cg8 + cc]; }
    __syncthreads();
    const int cc = tid & 7, tq = tid >> 3;
    const int col = cg8 + cc, o = col >> 9, c = col & 511;
    const float dec = fabsf(p.in(20)[(i * 2 + o) * 512 + c]);
    float asum = 0.f;
    for (int t = tq; t < L; t += 64) {
      const float4* hr = (const float4*)(H2 + ((size_t)i * 4352 + tbase + t) * 64);
      float a = 0.f;
#pragma unroll
      for (int j4 = 0; j4 < 16; ++j4) {
        const float4 hv = hr[j4];
        a += hv.x * w3s[(j4 * 4 + 0) * 8 + cc]; a += hv.y * w3s[(j4 * 4 + 1) * 8 + cc];
        a += hv.z * w3s[(j4 * 4 + 2) * 8 + cc]; a += hv.w * w3s[(j4 * 4 + 3) * 8 + cc];
      }
      const float dist = fabsf((float)(t - L / 2)) / (float)L;
      a *= expf(-dec * dist);
      hbuf[cc * L + t] = a;
      asum += fabsf(a);
    }
    red[tid] = asum;
    __syncthreads();
    if (tid < 8) { float s = 0.f; for (int q = 0; q < 64; ++q) s += red[q * 8 + tid]; nrm[tid] = 1.f / (s + EPS); }
    __syncthreads();
    const int lgL = kind ? 12 : 8;
    for (int idx = tid; idx < 8 * L; idx += 512) {
      const int c2 = idx >> lgL, t = idx & (L - 1);
      const int col2 = cg8 + c2, o2 = col2 >> 9, cch = col2 & 511;
      FILT[((size_t)(i * 2 + o2) * 512 + cch) * 4352 + tbase + t] = f2bf(hbuf[c2 * L + t] * nrm[c2]);
    }
  }
  __syncthreads();
}

DI void phase_norm(const PV& p, int l, int part, int lx) {
  const int tid_ = TIDX(); const int lane = tid_ & 63, wid = tid_ >> 6;
  const float* MOD = (const float*)(p.ws() + OFF_MOD);
  const float* g = p.in(8) + (size_t)(l * 2 + part) * 1024;
  u16* H = (u16*)(p.ws() + OFF_A + A_H);
  const int stride = gridDim.x * 8;
  for (int row0 = blockIdx.x * 8 + wid; row0 < T; row0 += 2 * stride) {
    float4 v[2][4];
#pragma unroll
    for (int w = 0; w < 2; ++w) {
      const int row = row0 + w * stride;
      if (row < T) {
        const float* xr = xin_row(p, lx, row);
#pragma unroll
        for (int i = 0; i < 4; ++i) v[w][i] = ld16_nt(xr + (i * 64 + lane) * 4);
      }
    }
#pragma unroll
    for (int w = 0; w < 2; ++w) {
      const int row = row0 + w * stride;
      if (row < T) {
        float ss = 0.f;
#pragma unroll
        for (int i = 0; i < 4; ++i) ss += v[w][i].x * v[w][i].x + v[w][i].y * v[w][i].y + v[w][i].z * v[w][i].z + v[w][i].w * v[w][i].w;
        ss = wave_sum(ss, lane);
        const float r = rsqrtf(ss * (1.f / 1024.f) + EPS);
        const float* mr = MOD + (size_t)(l * 9 + condrow(row)) * 6144 + part * 3072;
#pragma unroll
        for (int i = 0; i < 4; ++i) {
          const int k = (i * 64 + lane) * 4;
          const float4 gv = *(const float4*)(g + k), sh = *(const float4*)(mr + k), sc = *(const float4*)(mr + 1024 + k);
          const float a = v[w][i].x * r * gv.x * (1.f + sc.x) + sh.x;
          const float b = v[w][i].y * r * gv.y * (1.f + sc.y) + sh.y;
          const float c = v[w][i].z * r * gv.z * (1.f + sc.z) + sh.z;
          const float d = v[w][i].w * r * gv.w * (1.f + sc.w) + sh.w;
          *(uint2*)(H + (size_t)row * 1024 + k) = pack4(a, b, c, d);
        }
      }
    }
  }
}

template <bool SWAP, class Epi, class Pre>
DI void gemm_tile(const u16* A, int lda, const u16* Bt, int ldb, int K, int m0, int n0, char* smem, Epi epi, Pre pre) {
  const int tid = TIDX(), lane = tid & 63, wid = tid >> 6;
  const int wm = wid >> 1, wn = wid & 1, fr = lane & 15, fq = lane >> 4;
  const int lrow = tid >> 3, kc = tid & 7;
  const u16* ga = A + (size_t)(m0 + lrow) * lda + kc * 8;
  const u16* gb = Bt + (size_t)(n0 + lrow) * ldb + kc * 8;
  const int soff = lrow * 128 + ((kc ^ (lrow & 7)) << 4);
  uint4 ra[4], rb[2];
  f32x4 acc[4][4];
#pragma unroll
  for (int i = 0; i < 4; ++i)
#pragma unroll
    for (int j = 0; j < 4; ++j) acc[i][j] = f32x4{0.f, 0.f, 0.f, 0.f};
  const int nk = K >> 6;
#pragma unroll
  for (int i = 0; i < 4; ++i) ra[i] = *(const uint4*)(ga + (size_t)(64 * i) * lda);
#pragma unroll
  for (int i = 0; i < 2; ++i) rb[i] = *(const uint4*)(gb + (size_t)(64 * i) * ldb);
#pragma unroll
  for (int i = 0; i < 4; ++i) *(uint4*)(smem + soff + i * 8192) = ra[i];
#pragma unroll
  for (int i = 0; i < 2; ++i) *(uint4*)(smem + 32768 + soff + i * 8192) = rb[i];
  __syncthreads();
  for (int kt = 0; kt < nk; ++kt) {
    const bool more = kt + 1 < nk;
    if (more) {
      const int k0 = (kt + 1) << 6;
#pragma unroll
      for (int i = 0; i < 4; ++i) ra[i] = *(const uint4*)(ga + (size_t)(64 * i) * lda + k0);
#pragma unroll
      for (int i = 0; i < 2; ++i) rb[i] = *(const uint4*)(gb + (size_t)(64 * i) * ldb + k0);
    }
    const char* sa = smem + (kt & 1) * 49152;
    const char* sb = sa + 32768;
#pragma unroll
    for (int ks = 0; ks < 2; ++ks) {
      bf16x8 af[4], bfv[4];
      const int co = ((ks * 4 + fq) ^ (fr & 7)) << 4;
#pragma unroll
      for (int mi = 0; mi < 4; ++mi) af[mi] = *(const bf16x8*)(sa + (wm * 64 + mi * 16 + fr) * 128 + co);
#pragma unroll
      for (int ni = 0; ni < 4; ++ni) bfv[ni] = *(const bf16x8*)(sb + (wn * 64 + ni * 16 + fr) * 128 + co);
#pragma unroll
      for (int mi = 0; mi < 4; ++mi)
#pragma unroll
        for (int ni = 0; ni < 4; ++ni)
          acc[mi][ni] = SWAP ? __builtin_amdgcn_mfma_f32_16x16x32_bf16(bfv[ni], af[mi], acc[mi][ni], 0, 0, 0)
                             : __builtin_amdgcn_mfma_f32_16x16x32_bf16(af[mi], bfv[ni], acc[mi][ni], 0, 0, 0);
    }
    if (more) {
      char* da = smem + ((kt + 1) & 1) * 49152;
#pragma unroll
      for (int i = 0; i < 4; ++i) *(uint4*)(da + soff + i * 8192) = ra[i];
#pragma unroll
      for (int i = 0; i < 2; ++i) *(uint4*)(da + 32768 + soff + i * 8192) = rb[i];
    }
    __syncthreads();
  }
  uint2 pv[4][4];
#pragma unroll
  for (int mi = 0; mi < 4; ++mi)
#pragma unroll
    for (int ni = 0; ni < 4; ++ni) {
      if (SWAP) pv[mi][ni] = pre(m0 + wm * 64 + mi * 16 + fr, n0 + wn * 64 + ni * 16 + fq * 4);
      else pv[mi][ni] = pre(m0 + wm * 64 + mi * 16 + fq * 4, n0 + wn * 64 + ni * 16 + fr);
    }
#pragma unroll
  for (int mi = 0; mi < 4; ++mi)
#pragma unroll
    for (int ni = 0; ni < 4; ++ni) {
      if (SWAP) epi(m0 + wm * 64 + mi * 16 + fr, n0 + wn * 64 + ni * 16 + fq * 4, acc[mi][ni], pv[mi][ni]);
      else epi(m0 + wm * 64 + mi * 16 + fq * 4, n0 + wn * 64 + ni * 16 + fr, acc[mi][ni], pv[mi][ni]);
    }
}

template <class F>
DI void for_tiles(int nM, int nN, int sm, int sn, F f) {
  if (gridDim.x == 256) {
    const int xcd = blockIdx.x & 7, slot = blockIdx.x >> 3;
    const int am = slot % sm, bn = slot / sm;
    const int nSN = (nN + sn - 1) / sn, nS = (nM / sm) * nSN;
    for (int st = xcd; st < nS; st += 8) {
      const int tm = (st / nSN) * sm + am, tn = (st % nSN) * sn + bn;
      if (tn < nN) f(tm, tn);
    }
  } else {
    for (int t = blockIdx.x; t < nM * nN; t += gridDim.x) f(t / nN, t % nN);
  }
}


#define LAS __attribute__((address_space(3)))
constexpr int G8_HTB = 128 * 64 * 2;
DI int g8_lds_byte(int r, int c) { const int st = (r >> 4) * 2 + (c >> 5), rr = r & 15, cc = c & 31, ob = rr * 64 + cc * 2; return st * 1024 + (ob ^ (((ob >> 9) & 1) << 5)); }
DI void g8_stage_rc(int b, int& R, int& C) { const int st = b / 1024, sb = b % 1024, swz = sb ^ (((sb >> 9) & 1) << 5); R = (st >> 1) * 16 + swz / 64; C = (st & 1) * 32 + (swz % 64) / 2; }
template <int NM, int NN, int NN1, int SM1, int SN1, int SM2, int SN2>
struct TileSched {
  static constexpr int nSN1 = NN1 / SN1, nS1 = (NM / SM1) * nSN1, nSN2 = (NN - NN1) / SN2, nS2 = (NM / SM2) * nSN2, nT = NM * NN;
  int c;
  DI void init() { c = blockIdx.x; }
  DI bool next(int i, int& pm, int& pn) const {
    if (gridDim.x == 256) {
      const int xcd = c & 7, slot = c >> 3;
      int st = xcd + 8 * i;
      if (st < nS1) { pm = (st / nSN1) * SM1 + slot % SM1; pn = (st % nSN1) * SN1 + slot / SM1; return true; }
      st -= nS1;
      if (nS2 == 0 || st >= nS2) return false;
      pm = (st / (nSN2 > 0 ? nSN2 : 1)) * SM2 + slot % SM2; pn = NN1 + (st % (nSN2 > 0 ? nSN2 : 1)) * SN2 + slot / SM2; return true;
    }
    const int L = i * (int)gridDim.x + c; if (L >= nT) return false; pm = L / NN; pn = L % NN; return true;
  }
};
template <bool ABLK = false, int SWM = 0, bool PERMB = false, class Sched, class Epi>
DI void gemm8(char* smem, const u16* A, const u16* Bt, int K, const Sched& S, const Epi& E) {
  LAS unsigned char* lds = (LAS unsigned char*)smem;
  const int tid = TIDX(), wid = __builtin_amdgcn_readfirstlane(tid >> 6), lane = tid & 63, wr = wid >> 2, wc = wid & 3, fr = lane & 15, fq = lane >> 4;
  const int nt = K / 64;
  unsigned voff[2], voffA[2];
#pragma unroll
  for (int i = 0; i < 2; ++i) { int R, C; g8_stage_rc(tid * 16 + i * 8192, R, C);
    const int rho = R & 31, Rb = PERMB ? (R & ~31) + 8 * ((rho & 15) >> 2) + 4 * (rho >> 4) + (rho & 3) : R;
    voff[i] = (unsigned)(Rb * 64 + C) * 2u; voffA[i] = ABLK ? (unsigned)(R * 64 + C) * 2u : (unsigned)(R * K + C) * 2u; }
  const size_t kstep = 32768, hstep = 16384, tstep = (size_t)256 * K * 2;
  const size_t kstepA = ABLK ? 32768 : 128, hstepA = ABLK ? 16384 : (size_t)128 * K * 2;
  const unsigned ldsw = (unsigned)wid * 1024u;
  const int aoff = g8_lds_byte(wr * 64 + fr, fq * 8), boff = g8_lds_byte(wc * 32 + fr, fq * 8);
#define G8_SA(b, h) (((b) * 2 + (h)) * G8_HTB)
#define G8_SB(b, h) ((4 + (b) * 2 + (h)) * G8_HTB)
#define G8_STAGE(bufoff, gbase) do { _Pragma("unroll") for (int _i = 0; _i < 2; ++_i) \
    __builtin_amdgcn_global_load_lds((const unsigned*)((const char*)(gbase) + voff[_i]), (LAS unsigned*)(lds + (bufoff) + ldsw + _i * 8192), 16, 0, 0); } while (0)
#define G8_STAGEA(bufoff, gbase) do { _Pragma("unroll") for (int _i = 0; _i < 2; ++_i) \
    __builtin_amdgcn_global_load_lds((const unsigned*)((const char*)(gbase) + voffA[_i]), (LAS unsigned*)(lds + (bufoff) + ldsw + _i * 8192), 16, 0, 0); } while (0)
#define G8_LDA(dst, b, h) do { _Pragma("unroll") for (int m = 0; m < 4; ++m) _Pragma("unroll") for (int k = 0; k < 2; ++k) dst[m][k] = *(const LAS bf16x8*)(lds + G8_SA(b, h) + aoff + m * 2048 + k * 1024); } while (0)
#define G8_LDB(dst, b, h) do { _Pragma("unroll") for (int n = 0; n < 2; ++n) _Pragma("unroll") for (int k = 0; k < 2; ++k) dst[n][k] = *(const LAS bf16x8*)(lds + G8_SB(b, h) + boff + n * 2048 + k * 1024); } while (0)
#define G8_MMA(ai, bj, At_, Bt_) do { __builtin_amdgcn_s_setprio(1); _Pragma("unroll") for (int m = 0; m < 4; ++m) _Pragma("unroll") for (int n = 0; n < 2; ++n) _Pragma("unroll") for (int k = 0; k < 2; ++k) \
    acc[ai][bj][m][n] = SWM == 2 ? __builtin_amdgcn_mfma_f32_16x16x32_bf16(At_[m][k], Bt_[n][k], acc[ai][bj][m][n], 0, 0, 0) \
                                 : __builtin_amdgcn_mfma_f32_16x16x32_bf16(Bt_[n][k], At_[m][k], acc[ai][bj][m][n], 0, 0, 0); __builtin_amdgcn_s_setprio(0); } while (0)
#define G8_WAIT_V(n) asm volatile("s_waitcnt vmcnt(" #n ")" ::: "memory")
#define G8_WAIT_L(n) asm volatile("s_waitcnt lgkmcnt(" #n ")" ::: "memory")
#define G8_BAR __builtin_amdgcn_s_barrier()
#define G8_SCHED __builtin_amdgcn_sched_barrier(0)
  int cpm, cpn, npm = 0, npn = 0, ui = 0;
  if (!S.next(0, cpm, cpn)) return;
  f32x4 acc[2][2][4][2];
#pragma unroll
  for (int a = 0; a < 2; ++a)
#pragma unroll
    for (int b = 0; b < 2; ++b)
#pragma unroll
      for (int m = 0; m < 4; ++m)
#pragma unroll
        for (int n = 0; n < 2; ++n) acc[a][b][m][n] = f32x4{0.f, 0.f, 0.f, 0.f};
  bf16x8 At[4][2], B0[2][2], B1[2][2];
  const char* cA = (const char*)A + (size_t)cpm * tstep; const char* cB = (const char*)Bt + (size_t)cpn * tstep;
  G8_STAGE(G8_SB(0, 0), cB); G8_STAGEA(G8_SA(0, 0), cA); G8_STAGE(G8_SB(0, 1), cB + hstep); G8_STAGEA(G8_SA(0, 1), cA + hstepA);
  if (wr == 1) G8_BAR;
  G8_WAIT_V(4); G8_BAR;
  G8_STAGE(G8_SB(1, 0), cB + kstep); G8_STAGEA(G8_SA(1, 0), cA + kstepA); G8_STAGE(G8_SB(1, 1), cB + hstep + kstep);
  G8_WAIT_V(6); G8_BAR;
  for (;;) {
    const bool has_next = S.next(ui + 1, npm, npn);
    const char* nA = has_next ? (const char*)A + (size_t)npm * tstep : cA; const char* nB = has_next ? (const char*)Bt + (size_t)npn * tstep : cB;
#pragma unroll 1
    for (int t = 0; t < nt; t += 2) {
      const bool last = (t == nt - 2);
      const char* a1 = cA + (size_t)(t + 1) * kstepA;
      const char* a2 = last ? nA : cA + (size_t)(t + 2) * kstepA; const char* b2 = last ? nB : cB + (size_t)(t + 2) * kstep;
      const char* a3 = a2 + kstepA; const char* b3 = b2 + kstep;
      G8_LDB(B0, 0, 0); G8_SCHED; G8_LDA(At, 0, 0); G8_STAGEA(G8_SA(1, 1), a1 + hstepA);
      G8_WAIT_L(8); G8_BAR; G8_WAIT_L(0); G8_MMA(0, 0, At, B0); G8_BAR; G8_SCHED;
      G8_LDB(B1, 0, 1); G8_STAGE(G8_SB(0, 0), b2);
      G8_BAR; G8_WAIT_L(0); G8_MMA(0, 1, At, B1); G8_BAR;
      G8_LDA(At, 0, 1); G8_STAGEA(G8_SA(0, 0), a2);
      G8_BAR; G8_WAIT_L(0); G8_MMA(1, 0, At, B0); G8_BAR; G8_SCHED;
      G8_STAGE(G8_SB(0, 1), b2 + hstep);
      G8_WAIT_V(6); G8_BAR; G8_MMA(1, 1, At, B1); G8_BAR;
      G8_LDB(B0, 1, 0); G8_SCHED; G8_LDA(At, 1, 0); G8_STAGEA(G8_SA(0, 1), a2 + hstepA);
      G8_WAIT_L(8); G8_BAR; G8_WAIT_L(0); G8_MMA(0, 0, At, B0); G8_BAR; G8_SCHED;
      G8_LDB(B1, 1, 1); G8_STAGE(G8_SB(1, 0), b3);
      G8_BAR; G8_WAIT_L(0); G8_MMA(0, 1, At, B1); G8_BAR;
      G8_LDA(At, 1, 1); G8_STAGEA(G8_SA(1, 0), a3);
      G8_BAR; G8_WAIT_L(0); G8_MMA(1, 0, At, B0); G8_BAR; G8_SCHED;
      G8_STAGE(G8_SB(1, 1), b3 + hstep);
      G8_WAIT_V(6); G8_BAR; G8_MMA(1, 1, At, B1); G8_BAR;
    }
    { const int t2 = TIDX(), w2 = __builtin_amdgcn_readfirstlane(t2 >> 6), l2 = t2 & 63; E(acc, cpm, cpn, w2 >> 2, w2 & 3, l2 & 15, l2 >> 4); }
    if (!has_next) break;
#pragma unroll
    for (int a = 0; a < 2; ++a)
#pragma unroll
      for (int b = 0; b < 2; ++b)
#pragma unroll
        for (int m = 0; m < 4; ++m)
#pragma unroll
          for (int n = 0; n < 2; ++n) acc[a][b][m][n] = f32x4{0.f, 0.f, 0.f, 0.f};
    cpm = npm; cpn = npn; cA = nA; cB = nB; ++ui;
  }
  G8_WAIT_V(0);
  if (wr == 0) G8_BAR;
  G8_BAR;
#undef G8_SA
#undef G8_SB
#undef G8_STAGE
#undef G8_STAGEA
#undef G8_LDA
#undef G8_LDB
#undef G8_MMA
#undef G8_WAIT_V
#undef G8_WAIT_L
#undef G8_BAR
#undef G8_SCHED
}
template <bool ABLK, class Epi>
DI void gemm_half(char* smem, const u16* A, const u16* Bt, int K, int pm, int pn, int nh, const Epi& E) {
  LAS unsigned char* lds = (LAS unsigned char*)smem;
  const int tid = TIDX(), wid = __builtin_amdgcn_readfirstlane(tid >> 6), lane = tid & 63, wr = wid >> 2, wc = wid & 3, fr = lane & 15, fq = lane >> 4;
  const int nt = K / 64;
  unsigned voff[2], voffA[2];
#pragma unroll
  for (int i = 0; i < 2; ++i) { int R, C; g8_stage_rc(tid * 16 + i * 8192, R, C); voff[i] = (unsigned)(R * 64 + C) * 2u; voffA[i] = ABLK ? voff[i] : (unsigned)(R * K + C) * 2u; }
  const size_t kstep = 32768, hstep = 16384, tstep = (size_t)256 * K * 2;
  const size_t kstepA = ABLK ? 32768 : 128, hstepA = ABLK ? 16384 : (size_t)128 * K * 2;
  const unsigned ldsw = (unsigned)wid * 1024u;
  const int aoff = g8_lds_byte(wr * 64 + fr, fq * 8), boff = g8_lds_byte(wc * 32 + fr, fq * 8);
  const char* cA = (const char*)A + (size_t)pm * tstep;
  const char* cB = (const char*)Bt + (size_t)pn * tstep + (size_t)nh * hstep;
#define GH_STAGE(s_, kt_) do { _Pragma("unroll") for (int _i = 0; _i < 2; ++_i) { \
    __builtin_amdgcn_global_load_lds((const unsigned*)(cB + (size_t)(kt_) * kstep + voff[_i]), (LAS unsigned*)(lds + (s_) * 49152 + ldsw + _i * 8192), 16, 0, 0); \
    __builtin_amdgcn_global_load_lds((const unsigned*)(cA + (size_t)(kt_) * kstepA + voffA[_i]), (LAS unsigned*)(lds + (s_) * 49152 + 16384 + ldsw + _i * 8192), 16, 0, 0); \
    __builtin_amdgcn_global_load_lds((const unsigned*)(cA + hstepA + (size_t)(kt_) * kstepA + voffA[_i]), (LAS unsigned*)(lds + (s_) * 49152 + 32768 + ldsw + _i * 8192), 16, 0, 0); } } while (0)
  f32x4 acc[2][4][2];
#pragma unroll
  for (int a = 0; a < 2; ++a)
#pragma unroll
    for (int m = 0; m < 4; ++m)
#pragma unroll
      for (int n = 0; n < 2; ++n) acc[a][m][n] = f32x4{0.f, 0.f, 0.f, 0.f};
  __syncthreads();
  GH_STAGE(0, 0);
  asm volatile("s_waitcnt vmcnt(0)" ::: "memory");
  __syncthreads();
#pragma unroll 1
  for (int kt = 0; kt < nt; ++kt) {
    if (kt + 1 < nt) GH_STAGE((kt + 1) & 1, kt + 1);
    const LAS unsigned char* base = lds + (kt & 1) * 49152;
    bf16x8 B0[2][2];
#pragma unroll
    for (int n = 0; n < 2; ++n)
#pragma unroll
      for (int k = 0; k < 2; ++k) B0[n][k] = *(const LAS bf16x8*)(base + boff + n * 2048 + k * 1024);
#pragma unroll
    for (int ai = 0; ai < 2; ++ai) {
      bf16x8 At[4][2];
#pragma unroll
      for (int m = 0; m < 4; ++m)
#pragma unroll
        for (int k = 0; k < 2; ++k) At[m][k] = *(const LAS bf16x8*)(base + 16384 + ai * 16384 + aoff + m * 2048 + k * 1024);
#pragma unroll
      for (int m = 0; m < 4; ++m)
#pragma unroll
        for (int n = 0; n < 2; ++n)
#pragma unroll
          for (int k = 0; k < 2; ++k) acc[ai][m][n] = __builtin_amdgcn_mfma_f32_16x16x32_bf16(B0[n][k], At[m][k], acc[ai][m][n], 0, 0, 0);
    }
    asm volatile("s_waitcnt vmcnt(0)" ::: "memory");
    __syncthreads();
  }
#undef GH_STAGE
  E(acc, pm, pn, nh, wr, wc, fr, fq);
}

template <class F> struct ElemEpi {
  F f;
  DI void operator()(const f32x4 (&acc)[2][2][4][2], int pm, int pn, int wr, int wc, int fr, int fq) const {
    const int row0 = pm * 256 + wr * 64 + fr, col0 = pn * 256 + wc * 32 + 4 * fq;
#pragma unroll
    for (int ai = 0; ai < 2; ++ai)
#pragma unroll
      for (int m = 0; m < 4; ++m)
#pragma unroll
        for (int bj = 0; bj < 2; ++bj)
#pragma unroll
          for (int n = 0; n < 2; ++n) f(row0 + ai * 128 + m * 16, col0 + bj * 128 + n * 16, acc[ai][bj][m][n]);
  }
};
template <class F> DI ElemEpi<F> make_epi(F f) { return ElemEpi<F>{f}; }
template <int NM, int NN, int NN1, int SM1, int SN1, int SM2, int SN2, class F>
DI void gemm8_job(char* smem, const u16* A, const u16* Bt, int K, F f) {
  TileSched<NM, NN, NN1, SM1, SN1, SM2, SN2> S; S.init();
  gemm8(smem, A, Bt, K, S, make_epi(f));
}

struct EpiMixU {
  u16* MIX;
  DI void operator()(const f32x4 (&acc)[2][2][4][2], int pm, int pn, int wr, int wc, int fr, int fq) const {
    const int row0 = pm * 256 + wr * 64 + fr, col0 = pn * 256 + wc * 32 + 4 * fq;
#pragma unroll
    for (int ai = 0; ai < 2; ++ai)
#pragma unroll
      for (int m = 0; m < 4; ++m)
#pragma unroll
        for (int bj = 0; bj < 2; ++bj)
#pragma unroll
          for (int n = 0; n < 2; ++n) {
            const f32x4 v = acc[ai][bj][m][n];
            *(uint2*)(MIX + (unsigned)((row0 + ai * 128 + m * 16) * 1024 + col0 + bj * 128 + n * 16)) = pack4(gelu_tanh(v[0]), gelu_tanh(v[1]), gelu_tanh(v[2]), gelu_tanh(v[3]));
          }
  }
  DI void operator()(const f32x4 (&acc)[2][4][2], int pm, int pn, int nh, int wr, int wc, int fr, int fq) const {
    const int row0 = pm * 256 + wr * 64 + fr, col0 = pn * 256 + nh * 128 + wc * 32 + 4 * fq;
#pragma unroll
    for (int ai = 0; ai < 2; ++ai)
#pragma unroll
      for (int m = 0; m < 4; ++m)
#pragma unroll
        for (int n = 0; n < 2; ++n) {
          const f32x4 v = acc[ai][m][n];
          *(uint2*)(MIX + (unsigned)((row0 + ai * 128 + m * 16) * 1024 + col0 + n * 16)) = pack4(gelu_tanh(v[0]), gelu_tanh(v[1]), gelu_tanh(v[2]), gelu_tanh(v[3]));
        }
  }
};
struct EpiMixV {
  u16* VT; u16* PRT;
  DI void operator()(const f32x4 (&acc)[2][2][4][2], int pm, int pn, int wr, int wc, int fr, int fq) const {
    const int rowt = pm * 256;
    if (pn < 2) {
#pragma unroll
      for (int ai = 0; ai < 2; ++ai)
#pragma unroll
        for (int bj = 0; bj < 2; ++bj) {
          const unsigned g = (unsigned)(pn * 2 + bj), chunk = (unsigned)(pm * 2 + ai);
          const unsigned base = ((g * 320u + chunk) * 128u) * 128u;
#pragma unroll
          for (int m = 0; m < 4; ++m)
#pragma unroll
            for (int n = 0; n < 2; ++n) {
              const f32x4 v = acc[ai][bj][m][n];
              const unsigned c = (unsigned)(wc * 32 + n * 16 + fr), q = (unsigned)(wr * 64 + m * 16 + 4 * fq);
              *(uint2*)(VT + (base + c * 128u + q)) = pack4(gelu_tanh(v[0]), gelu_tanh(v[1]), gelu_tanh(v[2]), gelu_tanh(v[3]));
            }
        }
    } else {
      unsigned sbase, L;
      if (rowt < TP) { sbase = (unsigned)rowt * 1536u; L = 256u; }
      else { const int mm = rowt - TP; sbase = (unsigned)(TP + (mm & ~4095)) * 1536u + (unsigned)(mm & 4095); L = 4096u; }
#pragma unroll
      for (int ai = 0; ai < 2; ++ai)
#pragma unroll
        for (int bj = 0; bj < 2; ++bj)
#pragma unroll
          for (int m = 0; m < 4; ++m)
#pragma unroll
            for (int n = 0; n < 2; ++n) {
              const f32x4 v = acc[ai][bj][m][n];
              const unsigned cp = (unsigned)((pn - 2) * 256 + bj * 128 + wc * 32 + n * 16 + fr), tl = (unsigned)(ai * 128 + wr * 64 + m * 16 + 4 * fq);
              *(uint2*)(PRT + (sbase + cp * L + tl)) = pack4(v[0], v[1], v[2], v[3]);
            }
    }
  }
};
struct OneRoundSched {
  int c;
  DI void init() { c = blockIdx.x; }
  DI bool next(int i, int& pm, int& pn) const {
    if (gridDim.x == 256) { if (i > 0) return false; const int slot = c >> 3; pm = (c & 7) * 16 + (slot & 15); pn = slot >> 4; return true; }
    const int L = i * (int)gridDim.x + c; if (L >= 320) return false; pm = L >> 1; pn = L & 1; return true;
  }
};
DI void phase_mix_in(const PV& p, int i, char* smem) {
  const u16* H = (const u16*)(p.ws() + OFF_A + A_H);
  const u16* W = (const u16*)(p.ws() + OFF_WMIXIN) + (size_t)i * 2560 * 1024;
  EpiMixV EV; EV.VT = (u16*)(p.ws() + OFF_B + B_VT); EV.PRT = (u16*)(p.ws() + OFF_B + B_PRT);
  EpiMixU EU; EU.MIX = (u16*)(p.ws() + OFF_B + B_MIX);
  {
    TileSched<160, 8, 8, 8, 4, 32, 1> S; S.init();
    gemm8<false, 2>(smem, H, W + (size_t)512 * 1024, 1024, S, EV);
  }
  {
    OneRoundSched S; S.init();
    gemm8<false, 0>(smem, H, W, 1024, S, EU);
    if (gridDim.x == 256 && blockIdx.x < 128) {
      const int tile = blockIdx.x >> 1, nh = blockIdx.x & 1;
      gemm_half<false>(smem, H, W, 1024, 128 + (tile & 31), tile >> 5, nh, EU);
    }
  }
}

DI void phase_sgu(const PV& p, int i, char* smem) {
  const u16* VT = (const u16*)(p.ws() + OFF_B + B_VT);
  const u16* W = (const u16*)(p.ws() + OFF_WSGU) + (size_t)i * 4 * 16384;
  u16* MIX = (u16*)(p.ws() + OFF_B + B_MIX);
  const float* sb = p.in(11) + i * 512;
  for (int u = blockIdx.x; u < 640; u += gridDim.x) {
    const int g = u / 160, tm = u % 160;
    auto epi = [=](int m, int n, f32x4 v, uint2 uu) {
      const int chunk = m >> 7, c = m & 127;
      const int t = chunk * 128 + n;
      const float bias = sb[g * 128 + n];
      u16* dst = MIX + (size_t)t * 1024 + g * 128 + c;
      *(uint2*)dst = pack4(lo16(uu.x) * (v[0] + bias), hi16(uu.x) * (v[1] + bias), lo16(uu.y) * (v[2] + bias), hi16(uu.y) * (v[3] + bias));
    };
    auto pre = [=](int m, int n) { return *(const uint2*)(MIX + (size_t)((m >> 7) * 128 + n) * 1024 + g * 128 + (m & 127)); };
    gemm_tile<false>(VT + (size_t)g * 320 * 128 * 128, 128, W + (size_t)g * 16384, 128, 128, tm * 256, 0, smem, epi, pre);
  }
}

DI size_t prt_off(int kind, int b, int cp) {
  return kind ? (size_t)(TP + b * 4096) * 1536 + (size_t)cp * 4096 : (size_t)(b * 256) * 1536 + (size_t)cp * 256;
}
DI size_t zt_off(int kind, int b, int c) {
  return kind ? (size_t)(TP + b * 4096) * 512 + (size_t)c * 4096 : (size_t)(b * 256) * 512 + (size_t)c * 256;
}
DI void phase_conv(const PV& p, int i, int ord, char* smem) {
  const int tid = TIDX(), lane = tid & 63, wid = tid >> 6;
  const u16* PRT = (const u16*)(p.ws() + OFF_B + B_PRT);
  const u16* FILT = (const u16*)(p.ws() + OFF_FILT);
  const u16* Z1 = (const u16*)(p.ws() + OFF_A + A_Z1);
  u16* ZO = (u16*)(p.ws() + OFF_A + (ord ? A_Z2 : A_Z1));
  const float* cw = p.in(12) + (size_t)i * 3 * 1536;
  const float* cb = p.in(13) + (size_t)i * 1536;
  u16* hc = (u16*)smem;
  char* Ub = smem + 68096;
  for (int u = blockIdx.x; u < 1024; u += gridDim.x) {
    const int kind = u < 512 ? 1 : 0, c = u & 511;
    const int L = kind ? 4096 : 256, NB = kind ? 8 : 32, LB = L >> 6, DD = L >> 7;
    const int US = (L + 8) * 2;
    const size_t fbase = ((size_t)(i * 2 + ord) * 512 + c) * 4352 + (kind ? 256 : 0);
    __syncthreads();
    {
      u16* tmp = (u16*)Ub;
      for (int idx = tid; idx < (L >> 3); idx += 512) *(uint4*)(tmp + idx * 8) = *(const uint4*)(FILT + fbase + idx * 8);
      __syncthreads();
#pragma unroll 1
      for (int cpy = 0; cpy < 8; ++cpy)
        for (int m = tid; m < L + 136; m += 512) {
          const int x = L + 63 - m - cpy;
          hc[cpy * 4256 + m] = (x >= 0 && x < L) ? tmp[x] : (u16)0;
        }
      __syncthreads();
    }
    {
      const int lgn = kind ? 9 : 5, ncr = 1 << lgn, total = NB * ncr;
      const float w0 = cw[c], w1 = cw[1536 + c], w2 = cw[3072 + c], bb = cb[c];
      for (int id = tid; id < total; id += 512) {
        const int b = id >> lgn, t = (id & (ncr - 1)) * 8;
        uint4 o;
        if (ord == 0) {
          const u16* src = PRT + prt_off(kind, b, c) + t;
          const uint4 raw = *(const uint4*)src;
          float e[10];
          e[0] = t > 0 ? bf2f(src[-1]) : 0.f;
          e[9] = t + 8 < L ? bf2f(src[8]) : 0.f;
          e[1] = lo16(raw.x); e[2] = hi16(raw.x); e[3] = lo16(raw.y); e[4] = hi16(raw.y);
          e[5] = lo16(raw.z); e[6] = hi16(raw.z); e[7] = lo16(raw.w); e[8] = hi16(raw.w);
          float r[8];
#pragma unroll
          for (int k = 0; k < 8; ++k) r[k] = w0 * e[k] + w1 * e[k + 1] + w2 * e[k + 2] + bb;
          o.x = pack2(r[0], r[1]); o.y = pack2(r[2], r[3]); o.z = pack2(r[4], r[5]); o.w = pack2(r[6], r[7]);
        } else {
          o = *(const uint4*)(Z1 + zt_off(kind, b, c) + t);
        }
        *(uint4*)(Ub + b * US + t * 2) = o;
      }
    }
    __syncthreads();
    const int ncols = LB * NB;
#pragma unroll 1
    for (int hf = 0; hf < 2; ++hf) {
      const int jt = wid + 8 * hf;
      if (jt * 32 >= ncols) break;
      const int il = lane & 31, q = lane >> 5;
      const int lgb = kind ? 3 : 5;
      const int col = jt * 32 + il, t1c = col >> lgb, bc = col & (NB - 1);
      const int t1lo = (jt * 32) >> lgb, t1hi = (jt * 32 + 31) >> lgb;
      const int dlo = max(-DD, t1lo - (LB - 1)), dhi = min(DD, t1hi);
      const int cpy = 7 - (il & 7);
      const char* abase = (const char*)hc + cpy * 8512 + 2 * (L / 2 + 63 - il - cpy + 8 * q);
      f32x16 acc[2];
#pragma unroll
      for (int a = 0; a < 2; ++a)
#pragma unroll
        for (int r = 0; r < 16; ++r) acc[a][r] = 0.f;
      for (int d = dlo; d <= dhi; ++d) {
        bf16x8 bfr[4];
        {
          const int s1 = t1c - d;
          const bool valid = s1 >= 0 && s1 < LB;
          const char* bp = Ub + bc * US + ((valid ? s1 : 0) * 64 + 8 * q) * 2;
#pragma unroll
          for (int ks = 0; ks < 4; ++ks) {
            bf16x8 v = *(const bf16x8*)(bp + ks * 32);
            if (!valid) v = bf16x8{0, 0, 0, 0, 0, 0, 0, 0};
            bfr[ks] = v;
          }
        }
#pragma unroll
        for (int mt = 0; mt < 2; ++mt)
#pragma unroll
          for (int ks = 0; ks < 4; ++ks) {
            const bf16x8 af = *(const bf16x8*)(abase + 2 * (-64 * d - 32 * mt + 16 * ks));
            acc[mt] = __builtin_amdgcn_mfma_f32_32x32x16_bf16(af, bfr[ks], acc[mt], 0, 0, 0);
          }
      }
      const float dsk = p.in(21)[(i * 2 + ord) * 512 + c];
      const int gc = 512 * (ord + 1) + c;
      const float w0 = cw[gc], w1 = cw[1536 + gc], w2 = cw[3072 + gc], bb = cb[gc];
      {
        const int b = bc;
        const u16* xrow = PRT + prt_off(kind, b, gc);
        u16* orow = ZO + zt_off(kind, b, c);
#pragma unroll
        for (int mt = 0; mt < 2; ++mt)
#pragma unroll
          for (int g = 0; g < 4; ++g) {
            const int t = 64 * t1c + mt * 32 + 8 * g + 4 * q;
            const uint2 uu = *(const uint2*)(Ub + b * US + t * 2);
            const uint2 xx = *(const uint2*)(xrow + t);
            const float em = t > 0 ? bf2f(xrow[t - 1]) : 0.f;
            const float ep = t + 4 < L ? bf2f(xrow[t + 4]) : 0.f;
            const float e0 = lo16(xx.x), e1 = hi16(xx.x), e2 = lo16(xx.y), e3 = hi16(xx.y);
            const float x0 = w0 * em + w1 * e0 + w2 * e1 + bb;
            const float x1 = w0 * e0 + w1 * e1 + w2 * e2 + bb;
            const float x2 = w0 * e1 + w1 * e2 + w2 * e3 + bb;
            const float x3 = w0 * e2 + w1 * e3 + w2 * ep + bb;
            const float y0 = acc[mt][4 * g + 0] + lo16(uu.x) * dsk;
            const float y1 = acc[mt][4 * g + 1] + hi16(uu.x) * dsk;
            const float y2 = acc[mt][4 * g + 2] + lo16(uu.y) * dsk;
            const float y3 = acc[mt][4 * g + 3] + hi16(uu.y) * dsk;
            *(uint2*)(orow + t) = pack4(x0 * y0, x1 * y1, x2 * y2, x3 * y3);
          }
      }
    }
  }
  __syncthreads();
}

DI void phase_ztrans(const PV& p, char* smem) {
  const int tid = TIDX();
  const u16* Z2 = (const u16*)(p.ws() + OFF_A + A_Z2);
  u16* MIX = (u16*)(p.ws() + OFF_B + B_MIX);
  u16* tl = (u16*)smem;
  for (int u4 = blockIdx.x * 4; u4 < 640 * 8; u4 += gridDim.x * 4) {
    const int tt0 = (u4 >> 3) * 64;
    const int kind = tt0 >= TP ? 1 : 0;
    const int b = kind ? (tt0 - TP) >> 12 : tt0 >> 8;
    const int tl0 = kind ? (tt0 - TP) & 4095 : tt0 & 255;
    __syncthreads();
    { const int c = tid >> 3, ch = tid & 7;
      uint4 v[4];
#pragma unroll
      for (int w = 0; w < 4; ++w) v[w] = *(const uint4*)(Z2 + zt_off(kind, b, ((u4 + w) & 7) * 64 + c) + tl0 + ch * 8);
#pragma unroll
      for (int w = 0; w < 4; ++w) *(uint4*)(tl + w * 4608 + c * 72 + ch * 8) = v[w]; }
    __syncthreads();
    { const int tr = tid >> 3, cc = (tid & 7) * 8;
#pragma unroll
      for (int w = 0; w < 4; ++w) {
        const u16* tw = tl + w * 4608;
        uint4 o;
        o.x = (unsigned)tw[(cc + 0) * 72 + tr] | ((unsigned)tw[(cc + 1) * 72 + tr] << 16);
        o.y = (unsigned)tw[(cc + 2) * 72 + tr] | ((unsigned)tw[(cc + 3) * 72 + tr] << 16);
        o.z = (unsigned)tw[(cc + 4) * 72 + tr] | ((unsigned)tw[(cc + 5) * 72 + tr] << 16);
        o.w = (unsigned)tw[(cc + 6) * 72 + tr] | ((unsigned)tw[(cc + 7) * 72 + tr] << 16);
        *(uint4*)(MIX + (size_t)(tt0 + tr) * 1024 + 512 + ((u4 + w) & 7) * 64 + cc) = o;
      } }
  }
  __syncthreads();
}

struct EpiResid {
  float* X; const float* x0; const float* x1; const float* gate; int lx;
  DI void operator()(const f32x4 (&acc)[2][2][4][2], int pm, int pn, int wr, int wc, int fr, int fq) const {
    const int rowt = pm * 256, col0 = pn * 256 + wc * 32 + 4 * fq;
    const float* gr = gate + (size_t)condrow(rowt) * 6144 + col0;
    const float* xb = lx == 0 ? (rowt < TP ? x0 + (size_t)rowt * 1024 : x1 + (size_t)(rowt - TP) * 1024) : X + (size_t)rowt * 1024;
    float4 g[2][2];
#pragma unroll
    for (int bj = 0; bj < 2; ++bj)
#pragma unroll
      for (int n = 0; n < 2; ++n) g[bj][n] = *(const float4*)(gr + bj * 128 + n * 16);
#pragma unroll
    for (int ai = 0; ai < 2; ++ai)
#pragma unroll
      for (int mh = 0; mh < 2; ++mh) {
        float4 xo[2][2][2];
#pragma unroll
        for (int mm = 0; mm < 2; ++mm)
#pragma unroll
          for (int bj = 0; bj < 2; ++bj)
#pragma unroll
            for (int n = 0; n < 2; ++n)
              xo[mm][bj][n] = ld16_nt(xb + (size_t)(wr * 64 + fr + ai * 128 + (2 * mh + mm) * 16) * 1024 + col0 + bj * 128 + n * 16);
#pragma unroll
        for (int mm = 0; mm < 2; ++mm)
#pragma unroll
          for (int bj = 0; bj < 2; ++bj)
#pragma unroll
            for (int n = 0; n < 2; ++n) {
              const f32x4 v = acc[ai][bj][2 * mh + mm][n];
              const float4 x = xo[mm][bj][n], gg = g[bj][n];
              float4 o; o.x = x.x + gg.x * v[0]; o.y = x.y + gg.y * v[1]; o.z = x.z + gg.z * v[2]; o.w = x.w + gg.w * v[3];
              st16_nt(X + (size_t)(rowt + wr * 64 + fr + ai * 128 + (2 * mh + mm) * 16) * 1024 + col0 + bj * 128 + n * 16, o);
            }
      }
  }
};
struct EpiResidHalf {
  float* X; const float* x0; const float* x1; const float* gate; int lx;
  DI void operator()(const f32x4 (&acc)[2][4][2], int pm, int pn, int nh, int wr, int wc, int fr, int fq) const {
    const int rowt = pm * 256, col0 = pn * 256 + nh * 128 + wc * 32 + 4 * fq;
    const float* gr = gate + (size_t)condrow(rowt) * 6144 + col0;
    const float* xb = lx == 0 ? (rowt < TP ? x0 + (size_t)rowt * 1024 : x1 + (size_t)(rowt - TP) * 1024) : X + (size_t)rowt * 1024;
    float4 g[2];
#pragma unroll
    for (int n = 0; n < 2; ++n) g[n] = *(const float4*)(gr + n * 16);
#pragma unroll
    for (int ai = 0; ai < 2; ++ai) {
      float4 xo[4][2];
#pragma unroll
      for (int m = 0; m < 4; ++m)
#pragma unroll
        for (int n = 0; n < 2; ++n) xo[m][n] = ld16_nt(xb + (size_t)(wr * 64 + fr + ai * 128 + m * 16) * 1024 + col0 + n * 16);
#pragma unroll
      for (int m = 0; m < 4; ++m)
#pragma unroll
        for (int n = 0; n < 2; ++n) {
          const f32x4 v = acc[ai][m][n];
          const float4 x = xo[m][n], gg = g[n];
          float4 o; o.x = x.x + gg.x * v[0]; o.y = x.y + gg.y * v[1]; o.z = x.z + gg.z * v[2]; o.w = x.w + gg.w * v[3];
          st16_nt(X + (size_t)(rowt + wr * 64 + fr + ai * 128 + m * 16) * 1024 + col0 + n * 16, o);
        }
    }
  }
};
struct ResidSched2 {
  int c;
  DI void init() { c = blockIdx.x; }
  DI bool next(int i, int& pm, int& pn) const {
    if (gridDim.x == 256) {
      const int st = (c & 7) + 8 * i;
      if (st >= 16) return false;
      pm = st * 8 + ((c >> 3) & 7); pn = c >> 6; return true;
    }
    const int L = i * (int)gridDim.x + c; if (L >= 640) return false; pm = L >> 2; pn = L & 3; return true;
  }
};
DI void phase_resid_gemm(const PV& p, int l, int lx, const u16* A, int K, const u16* W, int goff, char* smem) {
  EpiResid E;
  E.X = p.out(); E.x0 = p.in(0); E.x1 = p.in(1); E.gate = (const float*)(p.ws() + OFF_MOD) + (size_t)l * 9 * 6144 + goff; E.lx = lx;
  ResidSched2 S; S.init();
  if (K == 2816) gemm8<true>(smem, A, W, K, S, E);
  else gemm8<false>(smem, A, W, K, S, E);
  if (gridDim.x == 256) {
    EpiResidHalf EH; EH.X = E.X; EH.x0 = E.x0; EH.x1 = E.x1; EH.gate = E.gate; EH.lx = lx;
    const int xcd = blockIdx.x & 7, slot = blockIdx.x >> 3;
    const int st = 16 + (xcd >> 1), ti = (xcd & 1) * 16 + (slot >> 1), nh = slot & 1;
    const int pm = st * 8 + (ti & 7), pn = ti >> 3;
    if (K == 2816) gemm_half<true>(smem, A, W, K, pm, pn, nh, EH);
    else gemm_half<false>(smem, A, W, K, pm, pn, nh, EH);
  }
}

DI void phase_dqkv(const PV& p, int j, char* smem) {
  const u16* H = (const u16*)(p.ws() + OFF_A + A_H);
  const u16* W = (const u16*)(p.ws() + OFF_WDQKV) + (size_t)j * 1024 * 1024;
  u16* DQKV = (u16*)(p.ws() + OFF_B + B_DQKV);
  u16* KR = (u16*)(p.ws() + OFF_KR);
  float* okr = p.out() + 46137344;
  auto epi = [=](int m, int n, f32x4 v) {
    if (n < 832) {
      const uint2 pk = pack4(v[0], v[1], v[2], v[3]);
      *(uint2*)(DQKV + (size_t)m * 896 + n) = pk;
      if (n >= 768) {
        const int e = n - 768;
        *(uint2*)(KR + (size_t)m * 64 + e) = pk;
        if (m < TP) {
          float4 o; o.x = v[0]; o.y = v[1]; o.z = v[2]; o.w = v[3];
          *(float4*)(okr + ((size_t)((m >> 8) * 2 + j) * 256 + (m & 255)) * 64 + e) = o;
        }
      }
    }
  };
  gemm8_job<160, 4, 4, 8, 4, 32, 1>(smem, H, W, 1024, epi);
}

DI void phase_mla_norms(const PV& p, int j) {
  const int tid_ = TIDX(); const int lane = tid_ & 63, wid = tid_ >> 6;
  const u16* DQKV = (const u16*)(p.ws() + OFF_B + B_DQKV);
  u16* QN = (u16*)(p.ws() + OFF_A + A_QN);
  u16* CKV = (u16*)(p.ws() + OFF_A + A_CKV);
  u16* KR = (u16*)(p.ws() + OFF_KR);
  float* ockv = p.out() + 41943040;
  const float* qn = p.in(24) + j * 512;
  const float* kvn = p.in(27) + j * 256;
  const int stride = gridDim.x * 8;
  for (int t0 = blockIdx.x * 8 + wid; t0 < TK; t0 += 2 * stride) {
    uint4 ra[2]; uint2 rb[2];
#pragma unroll
    for (int w = 0; w < 2; ++w) {
      const int t = t0 + w * stride;
      if (t < T) {
        const u16* row = DQKV + (size_t)t * 896;
        ra[w] = *(const uint4*)(row + lane * 8);
        rb[w] = *(const uint2*)(row + 512 + lane * 4);
      }
    }
#pragma unroll
    for (int w = 0; w < 2; ++w) {
      const int t = t0 + w * stride;
      if (t < T) {
        const uint4 a = ra[w];
        float q[8] = {lo16(a.x), hi16(a.x), lo16(a.y), hi16(a.y), lo16(a.z), hi16(a.z), lo16(a.w), hi16(a.w)};
        float ss = 0.f;
#pragma unroll
        for (int k = 0; k < 8; ++k) ss += q[k] * q[k];
        ss = wave_sum(ss, lane);
        const float r = rsqrtf(ss * (1.f / 512.f) + EPS);
        const float4 g0 = *(const float4*)(qn + lane * 8), g1 = *(const float4*)(qn + lane * 8 + 4);
        uint4 o;
        o.x = pack2(q[0] * r * g0.x, q[1] * r * g0.y); o.y = pack2(q[2] * r * g0.z, q[3] * r * g0.w);
        o.z = pack2(q[4] * r * g1.x, q[5] * r * g1.y); o.w = pack2(q[6] * r * g1.z, q[7] * r * g1.w);
        *(uint4*)(QN + (size_t)t * 512 + lane * 8) = o;
        const uint2 b = rb[w];
        float kv[4] = {lo16(b.x), hi16(b.x), lo16(b.y), hi16(b.y)};
        float s2 = kv[0] * kv[0] + kv[1] * kv[1] + kv[2] * kv[2] + kv[3] * kv[3];
        s2 = wave_sum(s2, lane);
        const float r2 = rsqrtf(s2 * (1.f / 256.f) + EPS);
        const float4 g2 = *(const float4*)(kvn + lane * 4);
        float4 o2; o2.x = kv[0] * r2 * g2.x; o2.y = kv[1] * r2 * g2.y; o2.z = kv[2] * r2 * g2.z; o2.w = kv[3] * r2 * g2.w;
        *(uint2*)(CKV + (size_t)t * 256 + lane * 4) = pack4(o2.x, o2.y, o2.z, o2.w);
        if (t < TP) *(float4*)(ockv + ((size_t)((t >> 8) * 2 + j) * 256 + (t & 255)) * 256 + lane * 4) = o2;
      } else if (t < TK) {
        const int pp = t - T, b = pp >> 8, sidx = pp & 255;
        const float4 v = *(const float4*)(p.in(2) + ((size_t)(b * 2 + j) * 256 + sidx) * 256 + lane * 4);
        *(uint2*)(CKV + (size_t)t * 256 + lane * 4) = pack4(v.x, v.y, v.z, v.w);
        if (lane < 16) {
          const float4 w4 = *(const float4*)(p.in(3) + ((size_t)(b * 2 + j) * 256 + sidx) * 64 + lane * 4);
          *(uint2*)(KR + (size_t)t * 64 + lane * 4) = pack4(w4.x, w4.y, w4.z, w4.w);
        }
      }
    }
  }
}

DI size_t vt_off(int m, int h, int d) {
  if (m < TP) return ((size_t)((m >> 8) * 8 + h) * 128 + d) * 256 + (m & 255);
  if (m < T) { const int mm = m - TP; return VT_SAMPLE_OFF + ((size_t)((mm >> 12) * 8 + h) * 128 + d) * 4352 + (mm & 4095); }
  const int mm = m - T;
  return VT_SAMPLE_OFF + ((size_t)((mm >> 8) * 8 + h) * 128 + d) * 4352 + 4096 + (mm & 255);
}
struct EpiKV {
  u16* Kb; u16* Vt;
  DI void operator()(const f32x4 (&acc)[2][2][4][2], int pm, int pn, int wr, int wc, int fr, int fq) const {
    const int h = pn;
    const int rowt = pm * 256;
    const unsigned ls = rowt < TP ? 256u : 4352u;
    unsigned vbase;
    if (rowt < TP) vbase = (unsigned)(((rowt >> 8) * 8 + h) * 128) * 256u;
    else if (rowt < T) { const int mm = rowt - TP; vbase = (unsigned)VT_SAMPLE_OFF + (unsigned)(((mm >> 12) * 8 + h) * 128) * 4352u + (unsigned)(mm & 4095); }
    else { const int mm = rowt - T; vbase = (unsigned)VT_SAMPLE_OFF + (unsigned)(((mm >> 8) * 8 + h) * 128) * 4352u + 4096u + (unsigned)(mm & 255); }
    const unsigned dcol = (unsigned)(wc * 32 + 4 * fq);
#pragma unroll
    for (int ai = 0; ai < 2; ++ai)
#pragma unroll
      for (int m = 0; m < 4; ++m) {
        const int rl = ai * 128 + wr * 64 + m * 16 + fr;
        const unsigned ko = (unsigned)((rowt + rl) * 8 + h) * 192u + dcol;
        const unsigned frp = (unsigned)((fr & 3) | ((fr & 4) << 1) | ((fr & 8) >> 1));
        const unsigned vo = vbase + (unsigned)(rl & ~15) + frp + dcol * ls;
#pragma unroll
        for (int n = 0; n < 2; ++n) {
          const f32x4 k = acc[ai][0][m][n], v = acc[ai][1][m][n];
          *(uint2*)(Kb + (ko + n * 16)) = pack4(k[0], k[1], k[2], k[3]);
          const unsigned p01 = pack2(v[0], v[1]), p23 = pack2(v[2], v[3]);
          const unsigned vq = vo + (unsigned)(n * 16) * ls;
          Vt[vq] = (u16)p01; Vt[vq + ls] = (u16)(p01 >> 16); Vt[vq + 2 * ls] = (u16)p23; Vt[vq + 3 * ls] = (u16)(p23 >> 16);
        }
      }
  }
};
DI void phase_uq_ukv(const PV& p, int j, char* smem) {
  const u16* QN = (const u16*)(p.ws() + OFF_A + A_QN);
  const u16* CKV = (const u16*)(p.ws() + OFF_A + A_CKV);
  const u16* WQ = (const u16*)(p.ws() + OFF_WUQ) + (size_t)j * 1536 * 512;
  const u16* WKV = (const u16*)(p.ws() + OFF_WUKV) + (size_t)j * 2048 * 256;
  u16* Q = (u16*)(p.ws() + OFF_B + B_Q);
  u16* Kb = (u16*)(p.ws() + OFF_B + B_K);
  u16* Vt = (u16*)(p.ws() + OFF_B + B_V);
  auto epiq = [=](int m, int n, f32x4 v) { *(uint2*)(Q + (size_t)m * 1536 + n) = pack4(v[0], v[1], v[2], v[3]); };
  gemm8_job<160, 6, 4, 8, 4, 16, 2>(smem, QN, WQ, 512, epiq);
  EpiKV E; E.Kb = Kb; E.Vt = Vt;
  TileSched<168, 8, 8, 8, 4, 32, 1> S; S.init();
  gemm8(smem, CKV, WKV, 256, S, E);
}

DI void phase_finalize(const PV& p, int j) {
  const int tid_ = TIDX(); const int lane = tid_ & 63, wid = tid_ >> 6;
  const int h = lane >> 3, l8 = lane & 7;
  u16* Q = (u16*)(p.ws() + OFF_B + B_Q);
  u16* Kb = (u16*)(p.ws() + OFF_B + B_K);
  const u16* KR = (const u16*)(p.ws() + OFF_KR);
  const float2* ROPE = (const float2*)(p.ws() + OFF_ROPE);
  const float* qhn = p.in(29) + j * 192;
  const float* khn = p.in(30) + j * 192;
  const float QSCALE = 1.4426950408889634f * 0.07216878364870322f;
  const int stride = gridDim.x * 8;
  for (int u0 = T + blockIdx.x * 8 + wid; u0 < T + TK; u0 += 2 * stride) {
    uint4 raw[2][3];
    u16* basep[2];
#pragma unroll
    for (int w = 0; w < 2; ++w) {
      const int u = u0 + w * stride;
      if (u < T + TK) {
        const bool isq = u < T;
        const int t = isq ? u : u - T;
        u16* base = isq ? Q + (size_t)t * 1536 + h * 192 : Kb + ((size_t)t * 8 + h) * 192;
        basep[w] = base;
#pragma unroll
        for (int k = 0; k < 3; ++k) {
          const u16* src = (!isq && k == 2) ? KR + (size_t)t * 64 + 8 * l8 : base + 8 * (l8 + 8 * k);
          raw[w][k] = *(const uint4*)src;
        }
      }
    }
#pragma unroll
    for (int w = 0; w < 2; ++w) {
      const int u = u0 + w * stride;
      if (u < T + TK) {
        const bool isq = u < T;
        const int t = isq ? u : u - T;
        const float* hn = isq ? qhn : khn;
        float v[3][8];
#pragma unroll
        for (int k = 0; k < 3; ++k) {
          const uint4 a = raw[w][k];
          v[k][0] = lo16(a.x); v[k][1] = hi16(a.x); v[k][2] = lo16(a.y); v[k][3] = hi16(a.y);
          v[k][4] = lo16(a.z); v[k][5] = hi16(a.z); v[k][6] = lo16(a.w); v[k][7] = hi16(a.w);
        }
        float ss = 0.f;
#pragma unroll
        for (int k = 0; k < 3; ++k)
#pragma unroll
          for (int e = 0; e < 8; ++e) ss += v[k][e] * v[k][e];
        ss += shx<1>(ss, lane); ss += shx<2>(ss, lane); ss += shx<4>(ss, lane);
        const float r = rsqrtf(ss * (1.f / 192.f) + EPS);
#pragma unroll
        for (int k = 0; k < 3; ++k) {
          const float4 g0 = *(const float4*)(hn + 8 * (l8 + 8 * k)), g1 = *(const float4*)(hn + 8 * (l8 + 8 * k) + 4);
          v[k][0] *= r * g0.x; v[k][1] *= r * g0.y; v[k][2] *= r * g0.z; v[k][3] *= r * g0.w;
          v[k][4] *= r * g1.x; v[k][5] *= r * g1.y; v[k][6] *= r * g1.z; v[k][7] *= r * g1.w;
        }
        if (t >= TP && t < T) {
          const int tl = (t - TP) & 4095;
          const int pos = l8 < 4 ? (tl >> 6) : (tl & 63);
          const float4* rp = (const float4*)(ROPE + pos * 16 + (l8 & 1) * 8);
          const float4 c01 = rp[0], c23 = rp[1], c45 = rp[2], c67 = rp[3];
          const float cs[8] = {c01.x, c01.z, c23.x, c23.z, c45.x, c45.z, c67.x, c67.z};
          const float sn[8] = {c01.y, c01.w, c23.y, c23.w, c45.y, c45.w, c67.y, c67.w};
#pragma unroll
          for (int e = 0; e < 8; ++e) {
            const float x = v[2][e];
            const float partner = shx<2>(x, lane);
            v[2][e] = (l8 & 2) ? x * cs[e] + partner * sn[e] : x * cs[e] - partner * sn[e];
          }
        }
        const float sc = isq ? QSCALE : 1.f;
#pragma unroll
        for (int k = 0; k < 3; ++k) {
          uint4 o;
          o.x = pack2(v[k][0] * sc, v[k][1] * sc); o.y = pack2(v[k][2] * sc, v[k][3] * sc);
          o.z = pack2(v[k][4] * sc, v[k][5] * sc); o.w = pack2(v[k][6] * sc, v[k][7] * sc);
          *(uint4*)(basep[w] + 8 * (l8 + 8 * k)) = o;
        }
      }
    }
  }
}

DI void attn_item(const PV& p, int j, int kind, int seq, int h, int q0, char* smem) {
  const int tid = TIDX(), lane = tid & 63, wid = tid >> 6;
  const int il = lane & 31, hh = lane >> 5;
  const u16* Q = (const u16*)(p.ws() + OFF_B + B_Q);
  const u16* Kb = (const u16*)(p.ws() + OFF_B + B_K);
  const u16* Vt = (const u16*)(p.ws() + OFF_B + B_V);
  u16* O = (u16*)(p.ws() + OFF_A + A_O);
  const float* qhn = p.in(29) + j * 192;
  const float2* ROPE = (const float2*)(p.ws() + OFF_ROPE);
  const int Lk = kind ? 4352 : 256, nkt = Lk >> 6;
  const u16* vbase = Vt + (kind ? VT_SAMPLE_OFF + (size_t)(seq * 8 + h) * 128 * 4352 : (size_t)(seq * 8 + h) * 128 * 256);
  const int tq = q0 + wid * 32 + il;
  bf16x8 qf[12];
  {
    float v[12][8];
    float ss = 0.f;
#pragma unroll
    for (int ks = 0; ks < 12; ++ks) {
      const uint4 a = *(const uint4*)(Q + ((size_t)tq * 8 + h) * 192 + 16 * ks + 8 * hh);
      v[ks][0] = lo16(a.x); v[ks][1] = hi16(a.x); v[ks][2] = lo16(a.y); v[ks][3] = hi16(a.y);
      v[ks][4] = lo16(a.z); v[ks][5] = hi16(a.z); v[ks][6] = lo16(a.w); v[ks][7] = hi16(a.w);
#pragma unroll
      for (int e = 0; e < 8; ++e) ss += v[ks][e] * v[ks][e];
    }
    { auto rr = __builtin_amdgcn_permlane32_swap(__float_as_uint(ss), __float_as_uint(ss), false, false); ss = __uint_as_float(rr[0]) + __uint_as_float(rr[1]); }
    const float rn = rsqrtf(ss * (1.f / 192.f) + EPS);
#pragma unroll
    for (int ks = 0; ks < 12; ++ks) {
      const float4 g0 = *(const float4*)(qhn + 16 * ks + 8 * hh), g1 = *(const float4*)(qhn + 16 * ks + 8 * hh + 4);
      v[ks][0] *= rn * g0.x; v[ks][1] *= rn * g0.y; v[ks][2] *= rn * g0.z; v[ks][3] *= rn * g0.w;
      v[ks][4] *= rn * g1.x; v[ks][5] *= rn * g1.y; v[ks][6] *= rn * g1.z; v[ks][7] *= rn * g1.w;
    }
    if (kind) {
      const int tl = (tq - TP) & 4095;
#pragma unroll
      for (int part = 0; part < 2; ++part) {
        const int pos = part == 0 ? (tl >> 6) : (tl & 63);
        const float4* rp = (const float4*)(ROPE + pos * 16 + 8 * hh);
        const float4 c01 = rp[0], c23 = rp[1], c45 = rp[2], c67 = rp[3];
        const float cs[8] = {c01.x, c01.z, c23.x, c23.z, c45.x, c45.z, c67.x, c67.z};
        const float sn[8] = {c01.y, c01.w, c23.y, c23.w, c45.y, c45.w, c67.y, c67.w};
#pragma unroll
        for (int e = 0; e < 8; ++e) {
          const float x1 = v[8 + 2 * part][e], x2 = v[9 + 2 * part][e];
          v[8 + 2 * part][e] = x1 * cs[e] - x2 * sn[e];
          v[9 + 2 * part][e] = x2 * cs[e] + x1 * sn[e];
        }
      }
    }
    const float QSCALE = 1.4426950408889634f * 0.07216878364870322f;
#pragma unroll
    for (int ks = 0; ks < 12; ++ks) {
      union { bf16x8 b; unsigned w[4]; } o;
#pragma unroll
      for (int w = 0; w < 4; ++w) o.w[w] = pack2(v[ks][2 * w] * QSCALE, v[ks][2 * w + 1] * QSCALE);
      qf[ks] = o.b;
    }
  }
  f32x16 oacc[4];
#pragma unroll
  for (int a = 0; a < 4; ++a)
#pragma unroll
    for (int r = 0; r < 16; ++r) oacc[a][r] = 0.f;
  float mrun = -INFINITY, lrun = 0.f;
  const int sw = (il >> 1) & 7;
  int ko[4], vob[4];
#pragma unroll
  for (int a = 0; a < 4; ++a) ko[a] = il * 384 + (((2 * a + hh) ^ sw) << 4);
#pragma unroll
  for (int c = 0; c < 4; ++c) vob[c] = il * 128 + (((2 * c + hh) ^ sw) << 4);
  LAS unsigned char* lds = (LAS unsigned char*)smem;
  unsigned kso[3], vso[2];
#pragma unroll
  for (int i = 0; i < 3; ++i) {
    const int id = tid + 512 * i, r = id / 24, pc = id - r * 24;
    const int ch = (pc & ~7) | ((pc & 7) ^ ((r >> 1) & 7));
    kso[i] = (unsigned)(r * 3072 + ch * 16);
  }
#pragma unroll
  for (int i = 0; i < 2; ++i) {
    const int id = tid + 512 * i, dd = id >> 3, pc = id & 7;
    const int ch = pc ^ ((dd >> 1) & 7);
    vso[i] = (unsigned)(dd * Lk * 2 + ch * 16);
  }
  const unsigned ldst = (unsigned)(tid >> 6) * 1024u;
#define ATT_STAGE(kt_, s_)                                                                                      \
  {                                                                                                            \
    const int k0_ = (kt_) * 64;                                                                                \
    const int rowbase_ = kind ? (k0_ < 4096 ? TP + seq * 4096 + k0_ : T + seq * 256 + (k0_ - 4096)) : seq * 256 + k0_; \
    const char* kg_ = (const char*)(Kb + ((size_t)rowbase_ * 8 + h) * 192);                                     \
    const char* vg_ = (const char*)(vbase + k0_);                                                              \
    _Pragma("unroll") for (int i_ = 0; i_ < 3; ++i_)                                                           \
      __builtin_amdgcn_global_load_lds((const unsigned*)(kg_ + kso[i_]), (LAS unsigned*)(lds + (s_) * 40960 + ldst + i_ * 8192), 16, 0, 0); \
    _Pragma("unroll") for (int i_ = 0; i_ < 2; ++i_)                                                           \
      __builtin_amdgcn_global_load_lds((const unsigned*)(vg_ + vso[i_]), (LAS unsigned*)(lds + (s_) * 40960 + 24576 + ldst + i_ * 8192), 16, 0, 0); \
  }
  __syncthreads();
  ATT_STAGE(0, 0)
  asm volatile("s_waitcnt vmcnt(0)" ::: "memory");
  __syncthreads();
  for (int kt = 0; kt < nkt; ++kt) {
    const bool more = kt + 1 < nkt;
    if (more) ATT_STAGE(kt + 1, (kt + 1) & 1)
    const char* Ks = smem + (kt & 1) * 40960;
    const char* Vs = Ks + 24576;
    f32x16 s2[2];
    __builtin_amdgcn_s_setprio(1);
#pragma unroll
    for (int st = 0; st < 2; ++st)
#pragma unroll
      for (int r = 0; r < 16; ++r) s2[st][r] = 0.f;
#pragma unroll
    for (int ks = 0; ks < 12; ++ks)
#pragma unroll
      for (int st = 0; st < 2; ++st) {
        const bf16x8 kf = *(const bf16x8*)(Ks + ko[ks & 3] + st * 12288 + (ks >> 2) * 128);
        s2[st] = __builtin_amdgcn_mfma_f32_32x32x16_bf16(kf, qf[ks], s2[st], 0, 0, 0);
      }
    __builtin_amdgcn_s_setprio(0);
    {
      float pmax = s2[0][0];
#pragma unroll
      for (int r = 1; r < 16; ++r) pmax = fmaxf(pmax, s2[0][r]);
#pragma unroll
      for (int r = 0; r < 16; ++r) pmax = fmaxf(pmax, s2[1][r]);
      { auto rr = __builtin_amdgcn_permlane32_swap(__float_as_uint(pmax), __float_as_uint(pmax), false, false);
        pmax = fmaxf(__uint_as_float(rr[0]), __uint_as_float(rr[1])); }
      if (!__all(pmax - mrun <= 11.541560327f)) {
        const float mn = fmaxf(mrun, pmax);
        const float alpha = __builtin_amdgcn_exp2f(mrun - mn);
        mrun = mn;
        lrun *= alpha;
#pragma unroll
        for (int a = 0; a < 4; ++a)
#pragma unroll
          for (int r = 0; r < 16; ++r) oacc[a][r] *= alpha;
      }
      float psum = 0.f;
#pragma unroll
      for (int st = 0; st < 2; ++st)
#pragma unroll
        for (int r = 0; r < 16; ++r) { const float pv = __builtin_amdgcn_exp2f(s2[st][r] - mrun); s2[st][r] = pv; psum += pv; }
      lrun += psum;
    }
    __builtin_amdgcn_s_setprio(1);
#pragma unroll
    for (int st = 0; st < 2; ++st)
#pragma unroll
      for (int sb = 0; sb < 2; ++sb) {
        union { bf16x8 v; unsigned w[4]; } pb;
#pragma unroll
        for (int w = 0; w < 4; ++w) pb.w[w] = pack2(s2[st][8 * sb + 2 * w], s2[st][8 * sb + 2 * w + 1]);
#pragma unroll
        for (int dt = 0; dt < 4; ++dt) {
          const bf16x8 vf = *(const bf16x8*)(Vs + vob[2 * st + sb] + dt * 4096);
          oacc[dt] = __builtin_amdgcn_mfma_f32_32x32x16_bf16(vf, pb.v, oacc[dt], 0, 0, 0);
        }
      }
    __builtin_amdgcn_s_setprio(0);
    asm volatile("s_waitcnt vmcnt(0)" ::: "memory");
    __syncthreads();
  }
#undef ATT_STAGE
  float ltot;
  { auto rr = __builtin_amdgcn_permlane32_swap(__float_as_uint(lrun), __float_as_uint(lrun), false, false); ltot = __uint_as_float(rr[0]) + __uint_as_float(rr[1]); }
  const float inv = 1.f / ltot;
#pragma unroll
  for (int dt = 0; dt < 4; ++dt)
#pragma unroll
    for (int g = 0; g < 4; ++g) {
      const int d = dt * 32 + 8 * g + 4 * hh;
      *(uint2*)(O + (size_t)tq * 1024 + h * 128 + d) =
          pack4(oacc[dt][4 * g] * inv, oacc[dt][4 * g + 1] * inv, oacc[dt][4 * g + 2] * inv, oacc[dt][4 * g + 3] * inv);
    }
}
DI void phase_attention(const PV& p, int j, char* smem) {
  const bool xmap = gridDim.x == 256;
  const int Gq = opaque_i((int)gridDim.x);
  const int nit = xmap ? 5 : (1280 + Gq - 1) / Gq;
#pragma unroll 1
  for (int r = 0; r < nit; ++r) {
    int kind, seq, h, q0;
    if (xmap) {
      if (r < 4) {
        const int xcd = blockIdx.x & 7, slot = blockIdx.x >> 3;
        const int pair = xcd + 8 * (2 * r + (slot >> 4)), qb = slot & 15;
        kind = 1; seq = pair >> 3; h = pair & 7; q0 = TP + seq * 4096 + qb * 256;
      } else {
        kind = 0; seq = blockIdx.x >> 3; h = blockIdx.x & 7; q0 = seq * 256;
      }
    } else {
      const int it = blockIdx.x + r * gridDim.x;
      if (it >= 1280) break;
      if (it < 1024) { const int pair = it >> 4, qb = it & 15; kind = 1; seq = pair >> 3; h = pair & 7; q0 = TP + seq * 4096 + qb * 256; }
      else { const int i2 = it - 1024; kind = 0; seq = i2 >> 3; h = i2 & 7; q0 = seq * 256; }
    }
    attn_item(p, j, kind, seq, h, q0, smem);
  }
  __syncthreads();
}

DI size_t act_blk(int t, int a) { return (size_t)(t >> 8) * (256 * 2816) + (size_t)(a >> 6) * (256 * 64) + (size_t)((t & 255) * 64 + (a & 63)); }
DI float dpp_ror1(float x) { return __int_as_float(__builtin_amdgcn_update_dpp(0, __float_as_int(x), 0x121, 0xf, 0xf, false)); }
DI float dpp_ror15(float x) { return __int_as_float(__builtin_amdgcn_update_dpp(0, __float_as_int(x), 0x12F, 0xf, 0xf, false)); }
struct EpiFFN {
  u16* ACT; u16* EDGE; const float* cw; const float* cb;
  DI void operator()(const f32x4 (&acc)[2][2][4][2], int pm, int pn, int wr, int wc, int fr, int fq) const {
    uint2 keep[2][4];
#pragma unroll
    for (int n = 0; n < 2; ++n) {
      const int a = pn * 128 + wc * 32 + fq * 8 + n * 4;
      const float4 w0g = *(const float4*)(cw + a), w1g = *(const float4*)(cw + 5632 + a), w2g = *(const float4*)(cw + 11264 + a), bg = *(const float4*)(cb + a);
      const float4 w0u = *(const float4*)(cw + 2816 + a), w1u = *(const float4*)(cw + 5632 + 2816 + a), w2u = *(const float4*)(cw + 11264 + 2816 + a), bu = *(const float4*)(cb + 2816 + a);
#pragma unroll
      for (int ai = 0; ai < 2; ++ai) {
        const int rbase = pm * 256 + ai * 128 + wr * 64;
        const size_t erow = (size_t)(rbase >> 6) * 4;
#pragma unroll
        for (int m = 0; m < 4; ++m) {
          const int mp = m > 0 ? m - 1 : 0, mn = m < 3 ? m + 1 : 3;
          float o[4];
#define FFN_ONE(J, C)                                                                                         \
          {                                                                                                   \
            const float g = acc[ai][0][m][n][J], u = acc[ai][1][m][n][J];                                     \
            const float gpv = m > 0 ? acc[ai][0][mp][n][J] : 0.f, gnx = m < 3 ? acc[ai][0][mn][n][J] : 0.f;   \
            const float upv = m > 0 ? acc[ai][1][mp][n][J] : 0.f, unx = m < 3 ? acc[ai][1][mn][n][J] : 0.f;   \
            const float gp = dpp_ror1(fr == 15 ? gpv : g), gn = dpp_ror15(fr == 0 ? gnx : g);                \
            const float up = dpp_ror1(fr == 15 ? upv : u), un = dpp_ror15(fr == 0 ? unx : u);                \
            const float cg = w0g.C * gp + w1g.C * g + w2g.C * gn + bg.C;                                      \
            const float cu = w0u.C * up + w1u.C * u + w2u.C * un + bu.C;                                      \
            o[J] = silu(cg) * cu;                                                                             \
          }
          FFN_ONE(0, x) FFN_ONE(1, y) FFN_ONE(2, z) FFN_ONE(3, w)
#undef FFN_ONE
          {
            const uint2 cur = pack4(o[0], o[1], o[2], o[3]);
            if (n == 0) keep[ai][m] = cur;
            else { uint4 w; w.x = keep[ai][m].x; w.y = keep[ai][m].y; w.z = cur.x; w.w = cur.y; *(uint4*)(ACT + act_blk(rbase + m * 16 + fr, a - 4)) = w; }
          }
          if ((m == 0 && fr < 2) || (m == 3 && fr >= 14)) {
            const int ri = m == 0 ? fr : fr - 12;
            u16* e = EDGE + (erow + ri) * 5632 + pn * 256 + wc * 32 + fq * 8 + n * 4;
            *(uint2*)e = pack4(acc[ai][0][m][n][0], acc[ai][0][m][n][1], acc[ai][0][m][n][2], acc[ai][0][m][n][3]);
            *(uint2*)(e + 128) = pack4(acc[ai][1][m][n][0], acc[ai][1][m][n][1], acc[ai][1][m][n][2], acc[ai][1][m][n][3]);
          }
        }
      }
    }
  }
};
DI void phase_ffn_up(const PV& p, int l, char* smem) {
  EpiFFN E;
  E.ACT = (u16*)(p.ws() + OFF_B + B_ACT); E.EDGE = (u16*)(p.ws() + OFF_EDGE);
  E.cw = p.in(33) + (size_t)l * 3 * 5632; E.cb = p.in(34) + (size_t)l * 5632;
  TileSched<160, 22, 16, 8, 4, 16, 2> S; S.init();
  gemm8<false, 0, true>(smem, (const u16*)(p.ws() + OFF_A + A_H), (const u16*)(p.ws() + OFF_WUP), 1024, S, E);
}
DI void phase_ffn_fix(const PV& p, int l) {
  const u16* EDGE = (const u16*)(p.ws() + OFF_EDGE);
  u16* ACT = (u16*)(p.ws() + OFF_B + B_ACT);
  const float* cw = p.in(33) + (size_t)l * 3 * 5632;
  const float* cb = p.in(34) + (size_t)l * 5632;
  const unsigned gtid = blockIdx.x * blockDim.x + (unsigned)TIDX(), gsz = gridDim.x * blockDim.x;
  for (unsigned idx = gtid; idx < 640u * 2u * 704u; idx += gsz) {
    const unsigned rq = idx / 704u;
    const int a = (int)(idx - rq * 704u) * 4, rr = (int)rq, which = rr & 1, sidx = rr >> 1;
    const int t = sidx * 64 + (which ? 63 : 0);
    const int tb = which ? t + 1 : t;
    const bool seqb = tb < TP ? (tb & 255) == 0 : ((tb - TP) & 4095) == 0;
    if (seqb) continue;
    const int pc = (a >> 7) * 256 + (a & 127);
    const u16 *pr, *cu, *nx;
    if (which == 0) { pr = EDGE + ((size_t)(sidx - 1) * 4 + 3) * 5632; cu = EDGE + ((size_t)sidx * 4 + 0) * 5632; nx = EDGE + ((size_t)sidx * 4 + 1) * 5632; }
    else { pr = EDGE + ((size_t)sidx * 4 + 2) * 5632; cu = EDGE + ((size_t)sidx * 4 + 3) * 5632; nx = EDGE + ((size_t)(sidx + 1) * 4 + 0) * 5632; }
    const uint2 gp = *(const uint2*)(pr + pc), gc = *(const uint2*)(cu + pc), gn = *(const uint2*)(nx + pc);
    const uint2 up = *(const uint2*)(pr + pc + 128), uc = *(const uint2*)(cu + pc + 128), un = *(const uint2*)(nx + pc + 128);
    const float4 w0g = *(const float4*)(cw + a), w1g = *(const float4*)(cw + 5632 + a), w2g = *(const float4*)(cw + 11264 + a), bg = *(const float4*)(cb + a);
    const float4 w0u = *(const float4*)(cw + 2816 + a), w1u = *(const float4*)(cw + 5632 + 2816 + a), w2u = *(const float4*)(cw + 11264 + 2816 + a), bu = *(const float4*)(cb + 2816 + a);
    const float g0 = w0g.x * lo16(gp.x) + w1g.x * lo16(gc.x) + w2g.x * lo16(gn.x) + bg.x, u0 = w0u.x * lo16(up.x) + w1u.x * lo16(uc.x) + w2u.x * lo16(un.x) + bu.x;
    const float g1 = w0g.y * hi16(gp.x) + w1g.y * hi16(gc.x) + w2g.y * hi16(gn.x) + bg.y, u1 = w0u.y * hi16(up.x) + w1u.y * hi16(uc.x) + w2u.y * hi16(un.x) + bu.y;
    const float g2 = w0g.z * lo16(gp.y) + w1g.z * lo16(gc.y) + w2g.z * lo16(gn.y) + bg.z, u2 = w0u.z * lo16(up.y) + w1u.z * lo16(uc.y) + w2u.z * lo16(un.y) + bu.z;
    const float g3 = w0g.w * hi16(gp.y) + w1g.w * hi16(gc.y) + w2g.w * hi16(gn.y) + bg.w, u3 = w0u.w * hi16(up.y) + w1u.w * hi16(uc.y) + w2u.w * hi16(un.y) + bu.w;
    *(uint2*)(ACT + act_blk(t, a)) = pack4(silu(g0) * u0, silu(g1) * u1, silu(g2) * u2, silu(g3) * u3);
  }
}

#ifndef PH
#define RUN(k, ...) __VA_ARGS__
#else
#define RUN(k, ...) if (PH == k) { __VA_ARGS__ }
#endif
extern "C" __global__ void __launch_bounds__(512) fwd_megakernel(Params kp) {
  extern __shared__ __attribute__((aligned(16))) char smem[];
  cg::grid_group grid = cg::this_grid();
  if (TIDX() == 0) {
    unsigned long long* t = (unsigned long long*)(smem + PARM_OFF);
#pragma unroll
    for (int k = 0; k < 36; ++k) t[k] = (unsigned long long)kp.in[k];
    t[36] = (unsigned long long)kp.out; t[37] = (unsigned long long)kp.ws;
  }
  __syncthreads();
  PV p; p.smem = smem;
  unsigned* bar = (unsigned*)(p.ws() + OFF_BAR);
  if (TIDX() == 0) { *(unsigned*)(smem + PARM_OFF + 512) = 0u; *(unsigned*)(smem + PARM_OFF + 516) = 0u; }
  __syncthreads();
  const XcdBarrier xb = xcd_barrier_post(bar, (volatile LASB unsigned*)(smem + PARM_OFF + 512));
  RUN(0, phase_prep(p, smem);)
  grid.sync();
  RUN(1, phase_filters(p, smem);)
  for (int l = 0; l < 4; ++l) {
    const int i = l >> 1;
    RUN(2, phase_norm(p, l, 0, l);)
    RUN(0, if (l > 0) { int base = 0; convert_ffn_weights(p, l, smem, base); })
    xcd_barrier(xb);
    if ((l & 1) == 0) {
      RUN(3, phase_mix_in(p, i, smem);)
      xcd_barrier(xb);
      RUN(4, phase_sgu(p, i, smem);)
      RUN(5, phase_conv(p, i, 0, smem);)
      xcd_barrier(xb);
      RUN(5, phase_conv(p, i, 1, smem);)
      xcd_barrier(xb);
      RUN(6, phase_ztrans(p, smem);)
      xcd_barrier(xb);
      RUN(7, phase_resid_gemm(p, l, l, (const u16*)(p.ws() + OFF_B + B_MIX), 1024, (const u16*)(p.ws() + OFF_WMIXOUT) + (size_t)i * 1024 * 1024, 2048, smem);)
      xcd_barrier(xb);
    } else {
      RUN(8, phase_dqkv(p, i, smem);)
      xcd_barrier(xb);
      RUN(9, phase_mla_norms(p, i);)
      xcd_barrier(xb);
      RUN(10, phase_uq_ukv(p, i, smem);)
      xcd_barrier(xb);
      RUN(11, phase_finalize(p, i);)
      xcd_barrier(xb);
      RUN(12, phase_attention(p, i, smem);)
      xcd_barrier(xb);
      RUN(7, phase_resid_gemm(p, l, l, (const u16*)(p.ws() + OFF_A + A_O), 1024, (const u16*)(p.ws() + OFF_WO) + (size_t)i * 1024 * 1024, 2048, smem);)
      xcd_barrier(xb);
    }
    RUN(2, phase_norm(p, l, 1, 1);)
    xcd_barrier(xb);
    RUN(13, phase_ffn_up(p, l, smem);)
    xcd_barrier(xb);
    RUN(14, phase_ffn_fix(p, l);)
    xcd_barrier(xb);
    RUN(7, phase_resid_gemm(p, l, 1, (const u16*)(p.ws() + OFF_B + B_ACT), 2816, (const u16*)(p.ws() + OFF_WDOWN), 5120, smem);)
    xcd_barrier(xb);
  }
}

extern "C" void kernel_launch(void* const* d_in, const int* in_sizes, int n_in,
                              void* d_out, int out_size, void* d_ws, size_t ws_size,
                              hipStream_t stream) {
  static int grid_blocks = 0;
  if (!grid_blocks) {
    int dev = 0, cus = 0, per_cu = 0;
    (void)hipGetDevice(&dev);
    (void)hipDeviceGetAttribute(&cus, hipDeviceAttributeMultiprocessorCount, dev);
    (void)hipFuncSetAttribute((const void*)fwd_megakernel, hipFuncAttributeMaxDynamicSharedMemorySize, (int)LDS_BYTES);
    (void)hipOccupancyMaxActiveBlocksPerMultiprocessor(&per_cu, fwd_megakernel, 512, LDS_BYTES);
    if (per_cu < 1) per_cu = 1;
    if (per_cu > 1) per_cu = 1;
    grid_blocks = cus * per_cu;
  }
  if (ws_size < WS_NEED) fprintf(stderr, "workspace too small: %zu < %zu\n", ws_size, (size_t)WS_NEED);
  Params p{};
  for (int i = 0; i < 36; ++i) p.in[i] = (const float*)d_in[i];
  p.out = (float*)d_out;
  p.ws = (char*)d_ws;
  (void)hipMemsetAsync((char*)d_ws + OFF_BAR, 0, 16384, stream);
  void* args[] = {&p};
  hipError_t e = hipLaunchCooperativeKernel((void*)fwd_megakernel, dim3(grid_blocks), dim3(512), args, LDS_BYTES, stream);
  if (e != hipSuccess) fprintf(stderr, "cooperative launch failed: %s (grid %d)\n", hipGetErrorString(e), grid_blocks);
}
```

```cpp
#include <hip/hip_runtime.h>
#include <hip/hip_cooperative_groups.h>
#include <cstdio>
namespace cg = cooperative_groups;

typedef unsigned short u16;
using bf16x8 = __attribute__((ext_vector_type(8))) short;
using f32x4 = __attribute__((ext_vector_type(4))) float;
using f32x16 = __attribute__((ext_vector_type(16))) float;
#define DI __device__ __forceinline__

constexpr int T = 40960;
constexpr int TP = 8192;
constexpr int TK = 43008;
constexpr float EPS = 1e-6f;
constexpr size_t LDS_BYTES = 139264;

constexpr size_t OFF_WMIXIN = 0;
constexpr size_t OFF_WMIXOUT = OFF_WMIXIN + (size_t)2 * 2560 * 1024 * 2;
constexpr size_t OFF_WDQKV = OFF_WMIXOUT + (size_t)2 * 1024 * 1024 * 2;
constexpr size_t OFF_WUQ = OFF_WDQKV + (size_t)2 * 1024 * 1024 * 2;
constexpr size_t OFF_WUKV = OFF_WUQ + (size_t)2 * 1536 * 512 * 2;
constexpr size_t OFF_WO = OFF_WUKV + (size_t)2 * 2048 * 256 * 2;
constexpr size_t OFF_WSGU = OFF_WO + (size_t)2 * 1024 * 1024 * 2;
constexpr size_t OFF_WUP = OFF_WSGU + (size_t)2 * 4 * 128 * 128 * 2;
constexpr size_t OFF_WDOWN = OFF_WUP + (size_t)5632 * 1024 * 2;
constexpr size_t OFF_MOD = OFF_WDOWN + (size_t)1024 * 2816 * 2;
constexpr size_t OFF_FILT = OFF_MOD + (size_t)4 * 9 * 6144 * 4;
constexpr size_t OFF_H2 = OFF_FILT + (size_t)2 * 2 * 512 * 4352 * 2;
constexpr size_t OFF_EDGE = OFF_H2 + (size_t)2 * 4352 * 64 * 4;
constexpr size_t OFF_KR = OFF_EDGE + (size_t)640 * 4 * 5632 * 2;
constexpr size_t OFF_A = OFF_KR + (size_t)TK * 64 * 2;
constexpr size_t OFF_B = OFF_A + (size_t)T * 1024 * 2;
constexpr size_t OFF_BAR = OFF_B + (size_t)346030080;
constexpr size_t OFF_ROPE = OFF_BAR + 16384;
constexpr size_t WS_NEED = OFF_ROPE + 64 * 16 * 8;
constexpr size_t A_H = 0, A_Z1 = 0, A_Z2 = (size_t)T * 512 * 2, A_QN = 0, A_CKV = (size_t)T * 512 * 2, A_O = 0;
constexpr size_t B_VT = 0, B_PRT = (size_t)T * 512 * 2, B_MIX = B_PRT + (size_t)T * 1536 * 2;
constexpr size_t B_DQKV = 0, B_Q = 0, B_K = (size_t)T * 1536 * 2, B_V = B_K + (size_t)TK * 1536 * 2;
constexpr size_t B_ACT = 0;
constexpr size_t VT_SAMPLE_OFF = (size_t)32 * 8 * 128 * 256;

struct Params {
  const float* in[36];
  float* out;
  char* ws;
};


constexpr int PARM_OFF = 138240;
struct PV {
  char* smem;
  DI unsigned long long ld(int k) const {
    int off = PARM_OFF + 8 * k;
    asm volatile("" : "+v"(off));
    const unsigned long long v = *(const unsigned long long*)(smem + off);
    const unsigned lo = __builtin_amdgcn_readfirstlane((unsigned)v), hi = __builtin_amdgcn_readfirstlane((unsigned)(v >> 32));
    return ((unsigned long long)hi << 32) | lo;
  }
  DI const float* in(int k) const { return (const float*)(const __attribute__((address_space(1))) float*)ld(k); }
  DI float* out() const { return (float*)(__attribute__((address_space(1))) float*)ld(36); }
  DI char* ws() const { return (char*)(__attribute__((address_space(1))) char*)ld(37); }
};

DI int TIDX() { int t = (int)__builtin_amdgcn_workitem_id_x(); asm volatile("" : "+v"(t)); return t; }
DI u16 f2bf(float x) { unsigned u = __float_as_uint(x); u += 0x7fffu + ((u >> 16) & 1u); return (u16)(u >> 16); }
DI float bf2f(u16 h) { return __uint_as_float(((unsigned)h) << 16); }
DI unsigned pack2(float a, float b) { unsigned r; asm("v_cvt_pk_bf16_f32 %0, %1, %2" : "=v"(r) : "v"(a), "v"(b)); return r; }
DI uint2 pack4(float a, float b, float c, float d) { uint2 r; r.x = pack2(a, b); r.y = pack2(c, d); return r; }
DI float lo16(unsigned w) { return __uint_as_float(w << 16); }
DI float hi16(unsigned w) { return __uint_as_float(w & 0xffff0000u); }
DI float gelu_tanh(float x) { const float y = x * (1.f + 0.044715f * x * x); return x * __builtin_amdgcn_rcpf(1.f + __builtin_amdgcn_exp2f(-2.302208198f * y)); }
DI float silu(float x) { return x * __builtin_amdgcn_rcpf(1.f + __builtin_amdgcn_exp2f(-1.4426950409f * x)); }
DI float4 ld16_nt(const float* ptr) { const f32x4 t = __builtin_nontemporal_load((const f32x4*)ptr); float4 r; r.x = t[0]; r.y = t[1]; r.z = t[2]; r.w = t[3]; return r; }
DI void st16_nt(float* ptr, float4 v) { const f32x4 t = {v.x, v.y, v.z, v.w}; __builtin_nontemporal_store(t, (f32x4*)ptr); }
DI uint4 ld16u_nt(const u16* ptr) { typedef unsigned u32x4w __attribute__((ext_vector_type(4))); const u32x4w t = __builtin_nontemporal_load((const u32x4w*)ptr); uint4 r; r.x = t[0]; r.y = t[1]; r.z = t[2]; r.w = t[3]; return r; }
DI int condrow(int m) { return m < TP ? 0 : 1 + ((m - TP) >> 12); }
template <int MASK> DI float shx(float v, int lane) {
  if (MASK == 32) return __int_as_float(__builtin_amdgcn_ds_bpermute((lane ^ 32) << 2, __float_as_int(v)));
  return __int_as_float(__builtin_amdgcn_ds_swizzle(__float_as_int(v), (MASK << 10) | 0x1f));
}
DI float wave_sum(float v, int lane) {
  v += shx<32>(v, lane); v += shx<16>(v, lane); v += shx<8>(v, lane);
  v += shx<4>(v, lane); v += shx<2>(v, lane); v += shx<1>(v, lane); return v;
}
DI int opaque_i(int x) { asm volatile("" : "+s"(x)); return x; }
DI int first_unit(int base) { const int G = opaque_i((int)gridDim.x); int r = (int)blockIdx.x - (base % G); if (r < 0) r += G; return r; }
DI const float* xin_row(const PV& p, int l, int m) {
  if (l == 0) return m < TP ? p.in(0) + (size_t)m * 1024 : p.in(1) + (size_t)(m - TP) * 1024;
  return p.out() + (size_t)m * 1024;
}


#define XB_TMO      128
#define XB_XCNT(j)  (256  + 64 * (j))
#define XB_XSUB(j)  (1280 + 64 * (j))
#define XB_XGEN(j)  (2304 + 64 * (j))
#define XB_TOP      3328
#define XB_TOPGEN   3392
#define XB_SPIN_CAP (1u << 22)
#define LASB __attribute__((address_space(3)))
DI unsigned xb_ld(unsigned* p) { return __hip_atomic_load(p, __ATOMIC_RELAXED, __HIP_MEMORY_SCOPE_AGENT); }
DI unsigned xb_add(unsigned* p, unsigned v) { return __hip_atomic_fetch_add(p, v, __ATOMIC_RELAXED, __HIP_MEMORY_SCOPE_AGENT); }
DI unsigned xb_xcc_id() { return (unsigned)__builtin_amdgcn_s_getreg((3 << 11) | 20) & 0xFu; }
#define XB_SPIN(cond, bar) do { unsigned _sp = 0; while (cond) { __builtin_amdgcn_s_sleep(1); \
    if ((++_sp & 255u) == 0u) { if (xb_ld(&(bar)[XB_TMO])) break; if (_sp > XB_SPIN_CAP) { atomicAdd(&(bar)[XB_TMO], 1u); break; } } } } while (0)
struct XcdBarrier { unsigned* bar; unsigned x; volatile LASB unsigned* st; };
DI XcdBarrier xcd_barrier_post(unsigned* bar, volatile LASB unsigned* st) {
  XcdBarrier b; b.bar = bar; b.x = xb_xcc_id(); b.st = st;
  if (TIDX() == 0) (void)xb_add(&bar[XB_XCNT(b.x)], 1u);
  return b;
}
DI void xcd_barrier_complete(unsigned* bar, unsigned x, unsigned& nloc, unsigned& nx) {
  const unsigned G = gridDim.x;
  unsigned sum, cnt, mine, sp = 0u;
  for (;;) {
    sum = 0u; cnt = 0u; mine = 0u;
#pragma unroll
    for (unsigned j = 0; j < 16; ++j) { const unsigned c = xb_ld(&bar[XB_XCNT(j)]); sum += c; cnt += (c > 0u) ? 1u : 0u; mine = (j == x) ? c : mine; }
    if (sum == G) break;
    __builtin_amdgcn_s_sleep(1);
    if ((++sp & 255u) == 0u) { if (xb_ld(&bar[XB_TMO])) break; if (sp > XB_SPIN_CAP) { atomicAdd(&bar[XB_TMO], 1u); break; } }
  }
  nloc = mine > 0u ? mine : 1u; nx = cnt > 0u ? cnt : 1u;
}
DI void xcd_barrier(const XcdBarrier& b) {
  asm volatile("s_waitcnt vmcnt(0)" ::: "memory");
  __syncthreads();
  if (TIDX() == 0) {
    unsigned* bar = b.bar;
    __builtin_amdgcn_s_waitcnt(0);
    unsigned nloc = b.st[0], nx = b.st[1];
    if (nloc == 0u) { xcd_barrier_complete(bar, b.x, nloc, nx); b.st[0] = nloc; b.st[1] = nx; }
    const unsigned old = xb_add(&bar[XB_XSUB(b.x)], 1u);
    const unsigned gen = old / nloc;
    if (old + 1u == (gen + 1u) * nloc) {
      __builtin_amdgcn_fence(__ATOMIC_RELEASE, "agent");
      asm volatile("s_waitcnt vmcnt(0)" ::: "memory");
      const unsigned og = xb_add(&bar[XB_TOP], 1u);
      const unsigned tg = og / nx;
      if (og + 1u == (tg + 1u) * nx) xb_add(&bar[XB_TOPGEN], 1u);
      else XB_SPIN(xb_ld(&bar[XB_TOPGEN]) == tg, bar);
      __builtin_amdgcn_fence(__ATOMIC_ACQUIRE, "agent");
      xb_add(&bar[XB_XGEN(b.x)], 1u);
      asm volatile("s_waitcnt vmcnt(0)" ::: "memory");
    } else {
      XB_SPIN(xb_ld(&bar[XB_XGEN(b.x)]) == gen, bar);
      __builtin_amdgcn_fence(__ATOMIC_ACQUIRE, "agent");
      asm volatile("s_waitcnt vmcnt(0)" ::: "memory");
    }
  }
  __syncthreads();
}

template <int MODE>
DI int rowmap(int n, int row0) {
  if (MODE == 0) return n + row0;
  return n < 2816 ? (n >> 7) * 256 + (n & 127) : ((n - 2816) >> 7) * 256 + 128 + ((n - 2816) & 127);
}
template <int MODE, int NJ = 4>
DI void convT(const float* __restrict__ src, u16* __restrict__ dst, int K, int N, int row0, char* smem, int& base) {
  u16* tl = (u16*)smem;
  const int tid = TIDX();
  const int nN = N / (64 * NJ), nunits = (K >> 6) * nN;
  for (int u = first_unit(base); u < nunits; u += gridDim.x) {
    const int k0 = (u / nN) << 6, n0 = (u % nN) * (64 * NJ);
    float4 v[2][NJ];
#pragma unroll
    for (int i = 0; i < 2; ++i)
#pragma unroll
      for (int j = 0; j < NJ; ++j)
        v[i][j] = *(const float4*)(src + (size_t)(k0 + (tid >> 4) + 32 * i) * N + n0 + (tid & 15) * 4 + 64 * j);
#pragma unroll
    for (int i = 0; i < 2; ++i)
#pragma unroll
      for (int j = 0; j < NJ; ++j) {
        const int r = (tid >> 4) + 32 * i, c4 = (tid & 15) * 4 + 64 * j;
        tl[(c4 + 0) * 72 + r] = f2bf(v[i][j].x); tl[(c4 + 1) * 72 + r] = f2bf(v[i][j].y);
        tl[(c4 + 2) * 72 + r] = f2bf(v[i][j].z); tl[(c4 + 3) * 72 + r] = f2bf(v[i][j].w);
      }
    __syncthreads();
#pragma unroll
    for (int j = 0; j < NJ; ++j) {
      const int n = (tid >> 3) + 64 * j, kc = (tid & 7) * 8;
      const uint4 o = *(const uint4*)(tl + n * 72 + kc);
      { const int rr = rowmap<MODE>(n0 + n, row0);
        *(uint4*)(dst + (size_t)(rr >> 8) * 256 * K + (size_t)(k0 >> 6) * (256 * 64) + (rr & 255) * 64 + kc) = o; }
    }
    __syncthreads();
  }
  base += nunits;
}

DI void convert_ffn_weights(const PV& p, int l, char* smem, int& base) {
  convT<1>(p.in(32) + (size_t)l * 1024 * 5632, (u16*)(p.ws() + OFF_WUP), 1024, 5632, 0, smem, base);
  convT<0>(p.in(35) + (size_t)l * 2816 * 1024, (u16*)(p.ws() + OFF_WDOWN), 2816, 1024, 0, smem, base);
}

DI void phase_prep(const PV& p, char* smem) {
  const int tid = TIDX();
  int base = 0;
  char* ws = p.ws();
  for (int i = 0; i < 2; ++i) {
    convT<0>(p.in(9) + (size_t)i * 1024 * 2560, (u16*)(ws + OFF_WMIXIN) + (size_t)i * 2560 * 1024, 1024, 2560, 0, smem, base);
    convT<0>(p.in(22) + (size_t)i * 1024 * 1024, (u16*)(ws + OFF_WMIXOUT) + (size_t)i * 1024 * 1024, 1024, 1024, 0, smem, base);
    convT<0>(p.in(23) + (size_t)i * 1024 * 512, (u16*)(ws + OFF_WDQKV) + (size_t)i * 1024 * 1024, 1024, 512, 0, smem, base);
    convT<0, 1>(p.in(26) + (size_t)i * 1024 * 320, (u16*)(ws + OFF_WDQKV) + (size_t)i * 1024 * 1024, 1024, 320, 512, smem, base);
    convT<0>(p.in(25) + (size_t)i * 512 * 1536, (u16*)(ws + OFF_WUQ) + (size_t)i * 1536 * 512, 512, 1536, 0, smem, base);
    convT<0>(p.in(28) + (size_t)i * 256 * 2048, (u16*)(ws + OFF_WUKV) + (size_t)i * 2048 * 256, 256, 2048, 0, smem, base);
    convT<0>(p.in(31) + (size_t)i * 1024 * 1024, (u16*)(ws + OFF_WO) + (size_t)i * 1024 * 1024, 1024, 1024, 0, smem, base);
  }
  convert_ffn_weights(p, 0, smem, base);
  {
    const long gtid = (long)blockIdx.x * blockDim.x + tid, gsz = (long)gridDim.x * blockDim.x;
    for (long i = gtid; i < 2 * 192 * 1024; i += gsz) {
      const int j = (int)(i / (192 * 1024)), rem = (int)(i % (192 * 1024)), rr = 832 + (rem >> 10), k = rem & 1023;
      ((u16*)(ws + OFF_WDQKV))[(size_t)j * 1024 * 1024 + (size_t)(rr >> 8) * 256 * 1024 + (size_t)(k >> 6) * (256 * 64) + (rr & 255) * 64 + (k & 63)] = 0;
    }
    for (long i = gtid; i < 2 * 4 * 128 * 128; i += gsz) ((u16*)(ws + OFF_WSGU))[i] = f2bf(p.in(10)[i]);
    for (long i = gtid; i < 64 * 16; i += gsz) {
      const int pos = (int)(i >> 4), f = (int)(i & 15);
      const float inv = exp2f(-(float)f * (13.287712379549449f / 16.f));
      float sn, cs;
      sincosf((float)pos * inv, &sn, &cs);
      ((float2*)(ws + OFF_ROPE))[i] = make_float2(cs, sn);
    }
  }
  {
    float* sc = (float*)smem;
    float* part = sc + 9 * 1024;
    __syncthreads();
    for (int i = tid; i < 9 * 1024; i += 512) {
      const int r = i >> 10, k = i & 1023;
      const float c = r == 0 ? p.in(5)[k] : p.in(4)[(r - 1) * 1024 + k];
      sc[i] = silu(c);
    }
    __syncthreads();
    float* MOD = (float*)(ws + OFF_MOD);
    const int nunits = 4 * 96;
    for (int u = first_unit(base); u < nunits; u += gridDim.x) {
      const int l = u / 96, n0 = (u % 96) * 64;
      const int col = n0 + (tid & 63), kg = tid >> 6;
      float acc[9];
#pragma unroll
      for (int r = 0; r < 9; ++r) acc[r] = 0.f;
      const float* w = p.in(6) + (size_t)l * 1024 * 6144 + col;
#pragma unroll 16
      for (int k = kg * 128; k < kg * 128 + 128; ++k) {
        const float wv = w[(size_t)k * 6144];
#pragma unroll
        for (int r = 0; r < 9; ++r) acc[r] += sc[r * 1024 + k] * wv;
      }
#pragma unroll
      for (int r = 0; r < 9; ++r) part[(kg * 9 + r) * 64 + (tid & 63)] = acc[r];
      __syncthreads();
      for (int i = tid; i < 576; i += 512) {
        const int r = i >> 6, cc = i & 63;
        float s = p.in(7)[l * 6144 + n0 + cc];
#pragma unroll
        for (int g = 0; g < 8; ++g) s += part[(g * 9 + r) * 64 + cc];
        MOD[(size_t)(l * 9 + r) * 6144 + n0 + cc] = s;
      }
      __syncthreads();
    }
    base += nunits;
  }
  {
    float* zf = (float*)smem;
    float* h1 = zf + 8 * 36;
    float* H2 = (float*)(ws + OFF_H2);
    const int nunits = 2 * 544;
    for (int u = first_unit(base); u < nunits; u += gridDim.x) {
      const int i = u / 544, tg0 = (u % 544) * 8;
      __syncthreads();
      if (tid < 8 * 33) {
        const int tt = tid / 33, e = tid % 33;
        const int tg = tg0 + tt;
        const float L = tg < 256 ? 256.f : 4096.f;
        const float t = tg < 256 ? (float)tg : (float)(tg - 256);
        const float tn = t / L;
        float v;
        if (e == 0) v = tn;
        else if (e <= 16) v = sinf((6.283185307179586f * tn) * (float)e);
        else v = cosf((6.283185307179586f * tn) * (float)(e - 16));
        zf[tt * 36 + e] = v;
      }
      __syncthreads();
      const int tt = tid >> 6, jj = tid & 63;
      const float fr = p.in(19)[i * 64 + jj];
      {
        float a = p.in(15)[i * 64 + jj];
        const float* w1 = p.in(14) + (size_t)i * 33 * 64 + jj;
        for (int e = 0; e < 33; ++e) a += zf[tt * 36 + e] * w1[e * 64];
        h1[tt * 64 + jj] = sinf(fr * a);
      }
      __syncthreads();
      {
        float a = p.in(17)[i * 64 + jj];
        const float* w2 = p.in(16) + (size_t)i * 64 * 64 + jj;
        for (int e = 0; e < 64; ++e) a += h1[tt * 64 + e] * w2[e * 64];
        H2[((size_t)i * 4352 + tg0 + tt) * 64 + jj] = sinf(fr * a);
      }
    }
    base += nunits;
    __syncthreads();
  }
}

DI void phase_filters(const PV& p, char* smem) {
  const int tid = TIDX();
  float* w3s = (float*)smem;
  float* red = w3s + 512;
  float* nrm = red + 512;
  float* hbuf = nrm + 8;
  const float* H2 = (const float*)(p.ws() + OFF_H2);
  u16* FILT = (u16*)(p.ws() + OFF_FILT);
  for (int u = blockIdx.x; u < 512; u += gridDim.x) {
    const int kind = (u >> 7) & 1, i = u >> 8, cg8 = (u & 127) * 8;
    const int L = kind ? 4096 : 256, tbase = kind ? 256 : 0;
    __syncthreads();
    { const int j = tid >> 3, cc = tid & 7; w3s[j * 8 + cc] = p.in(18)[((size_t)i * 64 + j) * 1024 + cg8 + cc]; }
    __syncthreads();
    const int cc = tid & 7, tq = tid >> 3;
    const int col = cg8 + cc, o = col >> 9, c = col & 511;
    const float dec = fabsf(p.in(20)[(i * 2 + o) * 512 + c]);
    float asum = 0.f;
    for (int t = tq; t < L; t += 64) {
      const float4* hr = (const float4*)(H2 + ((size_t)i * 4352 + tbase + t) * 64);
      float a = 0.f;
#pragma unroll
      for (int j4 = 0; j4 < 16; ++j4) {
        const float4 hv = hr[j4];
        a += hv.x * w3s[(j4 * 4 + 0) * 8 + cc]; a += hv.y * w3s[(j4 * 4 + 1) * 8 + cc];
        a += hv.z * w3s[(j4 * 4 + 2) * 8 + cc]; a += hv.w * w3s[(j4 * 4 + 3) * 8 + cc];
      }
      const float dist = fabsf((float)(t - L / 2)) / (float)L;
      a *= expf(-dec * dist);
      hbuf[cc * L + t] = a;
      asum += fabsf(a);
    }
    red[tid] = asum;
    __syncthreads();
    if (tid < 8) { float s = 0.f; for (int q = 0; q < 64; ++q) s += red[q * 8 + tid]; nrm[tid] = 1.f / (s + EPS); }
    __syncthreads();
    const int lgL = kind ? 12 : 8;
    for (int idx = tid; idx < 8 * L; idx += 512) {
      const int c2 = idx >> lgL, t = idx & (L - 1);
      const int col2 = cg8 + c2, o2 = col2 >> 9, cch = col2 & 511;
      FILT[((size_t)(i * 2 + o2) * 512 + cch) * 4352 + tbase + t] = f2bf(hbuf[c2 * L + t] * nrm[c2]);
    }
  }
  __syncthreads();
}

DI void phase_norm(const PV& p, int l, int part, int lx) {
  const int tid_ = TIDX(); const int lane = tid_ & 63, wid = tid_ >> 6;
  const float* MOD = (const float*)(p.ws() + OFF_MOD);
  const float* g = p.in(8) + (size_t)(l * 2 + part) * 1024;
  u16* H = (u16*)(p.ws() + OFF_A + A_H);
  const int stride = gridDim.x * 8;
  for (int row0 = blockIdx.x * 8 + wid; row0 < T; row0 += 2 * stride) {
    float4 v[2][4];
#pragma unroll
    for (int w = 0; w < 2; ++w) {
      const int row = row0 + w * stride;
      if (row < T) {
        const float* xr = xin_row(p, lx, row);
#pragma unroll
        for (int i = 0; i < 4; ++i) v[w][i] = ld16_nt(xr + (i * 64 + lane) * 4);
      }
    }
#pragma unroll
    for (int w = 0; w < 2; ++w) {
      const int row = row0 + w * stride;
      if (row < T) {
        float ss = 0.f;
#pragma unroll
        for (int i = 0; i < 4; ++i) ss += v[w][i].x * v[w][i].x + v[w][i].y * v[w][i].y + v[w][i].z * v[w][i].z + v[w][i].w * v[w][i].w;
        ss = wave_sum(ss, lane);
        const float r = rsqrtf(ss * (1.f / 1024.f) + EPS);
        const float* mr = MOD + (size_t)(l * 9 + condrow(row)) * 6144 + part * 3072;
#pragma unroll
        for (int i = 0; i < 4; ++i) {
          const int k = (i * 64 + lane) * 4;
          const float4 gv = *(const float4*)(g + k), sh = *(const float4*)(mr + k), sc = *(const float4*)(mr + 1024 + k);
          const float a = v[w][i].x * r * gv.x * (1.f + sc.x) + sh.x;
          const float b = v[w][i].y * r * gv.y * (1.f + sc.y) + sh.y;
          const float c = v[w][i].z * r * gv.z * (1.f + sc.z) + sh.z;
          const float d = v[w][i].w * r * gv.w * (1.f + sc.w) + sh.w;
          *(uint2*)(H + (size_t)row * 1024 + k) = pack4(a, b, c, d);
        }
      }
    }
  }
}

template <bool SWAP, class Epi, class Pre>
DI void gemm_tile(const u16* A, int lda, const u16* Bt, int ldb, int K, int m0, int n0, char* smem, Epi epi, Pre pre) {
  const int tid = TIDX(), lane = tid & 63, wid = tid >> 6;
  const int wm = wid >> 1, wn = wid & 1, fr = lane & 15, fq = lane >> 4;
  const int lrow = tid >> 3, kc = tid & 7;
  const u16* ga = A + (size_t)(m0 + lrow) * lda + kc * 8;
  const u16* gb = Bt + (size_t)(n0 + lrow) * ldb + kc * 8;
  const int soff = lrow * 128 + ((kc ^ (lrow & 7)) << 4);
  uint4 ra[4], rb[2];
  f32x4 acc[4][4];
#pragma unroll
  for (int i = 0; i < 4; ++i)
#pragma unroll
    for (int j = 0; j < 4; ++j) acc[i][j] = f32x4{0.f, 0.f, 0.f, 0.f};
  const int nk = K >> 6;
#pragma unroll
  for (int i = 0; i < 4; ++i) ra[i] = *(const uint4*)(ga + (size_t)(64 * i) * lda);
#pragma unroll
  for (int i = 0; i < 2; ++i) rb[i] = *(const uint4*)(gb + (size_t)(64 * i) * ldb);
#pragma unroll
  for (int i = 0; i < 4; ++i) *(uint4*)(smem + soff + i * 8192) = ra[i];
#pragma unroll
  for (int i = 0; i < 2; ++i) *(uint4*)(smem + 32768 + soff + i * 8192) = rb[i];
  __syncthreads();
  for (int kt = 0; kt < nk; ++kt) {
    const bool more = kt + 1 < nk;
    if (more) {
      const int k0 = (kt + 1) << 6;
#pragma unroll
      for (int i = 0; i < 4; ++i) ra[i] = *(const uint4*)(ga + (size_t)(64 * i) * lda + k0);
#pragma unroll
      for (int i = 0; i < 2; ++i) rb[i] = *(const uint4*)(gb + (size_t)(64 * i) * ldb + k0);
    }
    const char* sa = smem + (kt & 1) * 49152;
    const char* sb = sa + 32768;
#pragma unroll
    for (int ks = 0; ks < 2; ++ks) {
      bf16x8 af[4], bfv[4];
      const int co = ((ks * 4 + fq) ^ (fr & 7)) << 4;
#pragma unroll
      for (int mi = 0; mi < 4; ++mi) af[mi] = *(const bf16x8*)(sa + (wm * 64 + mi * 16 + fr) * 128 + co);
#pragma unroll
      for (int ni = 0; ni < 4; ++ni) bfv[ni] = *(const bf16x8*)(sb + (wn * 64 + ni * 16 + fr) * 128 + co);
#pragma unroll
      for (int mi = 0; mi < 4; ++mi)
#pragma unroll
        for (int ni = 0; ni < 4; ++ni)
          acc[mi][ni] = SWAP ? __builtin_amdgcn_mfma_f32_16x16x32_bf16(bfv[ni], af[mi], acc[mi][ni], 0, 0, 0)
                             : __builtin_amdgcn_mfma_f32_16x16x32_bf16(af[mi], bfv[ni], acc[mi][ni], 0, 0, 0);
    }
    if (more) {
      char* da = smem + ((kt + 1) & 1) * 49152;
#pragma unroll
      for (int i = 0; i < 4; ++i) *(uint4*)(da + soff + i * 8192) = ra[i];
#pragma unroll
      for (int i = 0; i < 2; ++i) *(uint4*)(da + 32768 + soff + i * 8192) = rb[i];
    }
    __syncthreads();
  }
  uint2 pv[4][4];
#pragma unroll
  for (int mi = 0; mi < 4; ++mi)
#pragma unroll
    for (int ni = 0; ni < 4; ++ni) {
      if (SWAP) pv[mi][ni] = pre(m0 + wm * 64 + mi * 16 + fr, n0 + wn * 64 + ni * 16 + fq * 4);
      else pv[mi][ni] = pre(m0 + wm * 64 + mi * 16 + fq * 4, n0 + wn * 64 + ni * 16 + fr);
    }
#pragma unroll
  for (int mi = 0; mi < 4; ++mi)
#pragma unroll
    for (int ni = 0; ni < 4; ++ni) {
      if (SWAP) epi(m0 + wm * 64 + mi * 16 + fr, n0 + wn * 64 + ni * 16 + fq * 4, acc[mi][ni], pv[mi][ni]);
      else epi(m0 + wm * 64 + mi * 16 + fq * 4, n0 + wn * 64 + ni * 16 + fr, acc[mi][ni], pv[mi][ni]);
    }
}

template <class F>
DI void for_tiles(int nM, int nN, int sm, int sn, F f) {
  if (gridDim.x == 256) {
    const int xcd = blockIdx.x & 7, slot = blockIdx.x >> 3;
    const int am = slot % sm, bn = slot / sm;
    const int nSN = (nN + sn - 1) / sn, nS = (nM / sm) * nSN;
    for (int st = xcd; st < nS; st += 8) {
      const int tm = (st / nSN) * sm + am, tn = (st % nSN) * sn + bn;
      if (tn < nN) f(tm, tn);
    }
  } else {
    for (int t = blockIdx.x; t < nM * nN; t += gridDim.x) f(t / nN, t % nN);
  }
}


#define LAS __attribute__((address_space(3)))
constexpr int G8_HTB = 128 * 64 * 2;
DI int g8_lds_byte(int r, int c) { const int st = (r >> 4) * 2 + (c >> 5), rr = r & 15, cc = c & 31, ob = rr * 64 + cc * 2; return st * 1024 + (ob ^ (((ob >> 9) & 1) << 5)); }
DI void g8_stage_rc(int b, int& R, int& C) { const int st = b / 1024, sb = b % 1024, swz = sb ^ (((sb >> 9) & 1) << 5); R = (st >> 1) * 16 + swz / 64; C = (st & 1) * 32 + (swz % 64) / 2; }
template <int NM, int NN, int NN1, int SM1, int SN1, int SM2, int SN2>
struct TileSched {
  static constexpr int nSN1 = NN1 / SN1, nS1 = (NM / SM1) * nSN1, nSN2 = (NN - NN1) / SN2, nS2 = (NM / SM2) * nSN2, nT = NM * NN;
  int c;
  DI void init() { c = blockIdx.x; }
  DI bool next(int i, int& pm, int& pn) const {
    if (gridDim.x == 256) {
      const int xcd = c & 7, slot = c >> 3;
      int st = xcd + 8 * i;
      if (st < nS1) { pm = (st / nSN1) * SM1 + slot % SM1; pn = (st % nSN1) * SN1 + slot / SM1; return true; }
      st -= nS1;
      if (nS2 == 0 || st >= nS2) return false;
      pm = (st / (nSN2 > 0 ? nSN2 : 1)) * SM2 + slot % SM2; pn = NN1 + (st % (nSN2 > 0 ? nSN2 : 1)) * SN2 + slot / SM2; return true;
    }
    const int L = i * (int)gridDim.x + c; if (L >= nT) return false; pm = L / NN; pn = L % NN; return true;
  }
};
template <bool ABLK = false, int SWM = 0, bool PERMB = false, class Sched, class Epi>
DI void gemm8(char* smem, const u16* A, const u16* Bt, int K, const Sched& S, const Epi& E) {
  LAS unsigned char* lds = (LAS unsigned char*)smem;
  const int tid = TIDX(), wid = __builtin_amdgcn_readfirstlane(tid >> 6), lane = tid & 63, wr = wid >> 2, wc = wid & 3, fr = lane & 15, fq = lane >> 4;
  const int nt = K / 64;
  unsigned voff[2], voffA[2];
#pragma unroll
  for (int i = 0; i < 2; ++i) { int R, C; g8_stage_rc(tid * 16 + i * 8192, R, C);
    const int rho = R & 31, Rb = PERMB ? (R & ~31) + 8 * ((rho & 15) >> 2) + 4 * (rho >> 4) + (rho & 3) : R;
    voff[i] = (unsigned)(Rb * 64 + C) * 2u; voffA[i] = ABLK ? (unsigned)(R * 64 + C) * 2u : (unsigned)(R * K + C) * 2u; }
  const size_t kstep = 32768, hstep = 16384, tstep = (size_t)256 * K * 2;
  const size_t kstepA = ABLK ? 32768 : 128, hstepA = ABLK ? 16384 : (size_t)128 * K * 2;
  const unsigned ldsw = (unsigned)wid * 1024u;
  const int aoff = g8_lds_byte(wr * 64 + fr, fq * 8), boff = g8_lds_byte(wc * 32 + fr, fq * 8);
#define G8_SA(b, h) (((b) * 2 + (h)) * G8_HTB)
#define G8_SB(b, h) ((4 + (b) * 2 + (h)) * G8_HTB)
#define G8_STAGE(bufoff, gbase) do { _Pragma("unroll") for (int _i = 0; _i < 2; ++_i) \
    __builtin_amdgcn_global_load_lds((const unsigned*)((const char*)(gbase) + voff[_i]), (LAS unsigned*)(lds + (bufoff) + ldsw + _i * 8192), 16, 0, 0); } while (0)
#define G8_STAGEA(bufoff, gbase) do { _Pragma("unroll") for (int _i = 0; _i < 2; ++_i) \
    __builtin_amdgcn_global_load_lds((const unsigned*)((const char*)(gbase) + voffA[_i]), (LAS unsigned*)(lds + (bufoff) + ldsw + _i * 8192), 16, 0, 0); } while (0)
#define G8_LDA(dst, b, h) do { _Pragma("unroll") for (int m = 0; m < 4; ++m) _Pragma("unroll") for (int k = 0; k < 2; ++k) dst[m][k] = *(const LAS bf16x8*)(lds + G8_SA(b, h) + aoff + m * 2048 + k * 1024); } while (0)
#define G8_LDB(dst, b, h) do { _Pragma("unroll") for (int n = 0; n < 2; ++n) _Pragma("unroll") for (int k = 0; k < 2; ++k) dst[n][k] = *(const LAS bf16x8*)(lds + G8_SB(b, h) + boff + n * 2048 + k * 1024); } while (0)
#define G8_MMA(ai, bj, At_, Bt_) do { __builtin_amdgcn_s_setprio(1); _Pragma("unroll") for (int m = 0; m < 4; ++m) _Pragma("unroll") for (int n = 0; n < 2; ++n) _Pragma("unroll") for (int k = 0; k < 2; ++k) \
    acc[ai][bj][m][n] = SWM == 2 ? __builtin_amdgcn_mfma_f32_16x16x32_bf16(At_[m][k], Bt_[n][k], acc[ai][bj][m][n], 0, 0, 0) \
                                 : __builtin_amdgcn_mfma_f32_16x16x32_bf16(Bt_[n][k], At_[m][k], acc[ai][bj][m][n], 0, 0, 0); __builtin_amdgcn_s_setprio(0); } while (0)
#define G8_WAIT_V(n) asm volatile("s_waitcnt vmcnt(" #n ")" ::: "memory")
#define G8_WAIT_L(n) asm volatile("s_waitcnt lgkmcnt(" #n ")" ::: "memory")
#define G8_BAR __builtin_amdgcn_s_barrier()
#define G8_SCHED __builtin_amdgcn_sched_barrier(0)
  int cpm, cpn, npm = 0, npn = 0, ui = 0;
  if (!S.next(0, cpm, cpn)) return;
  f32x4 acc[2][2][4][2];
#pragma unroll
  for (int a = 0; a < 2; ++a)
#pragma unroll
    for (int b = 0; b < 2; ++b)
#pragma unroll
      for (int m = 0; m < 4; ++m)
#pragma unroll
        for (int n = 0; n < 2; ++n) acc[a][b][m][n] = f32x4{0.f, 0.f, 0.f, 0.f};
  bf16x8 At[4][2], B0[2][2], B1[2][2];
  const char* cA = (const char*)A + (size_t)cpm * tstep; const char* cB = (const char*)Bt + (size_t)cpn * tstep;
  G8_STAGE(G8_SB(0, 0), cB); G8_STAGEA(G8_SA(0, 0), cA); G8_STAGE(G8_SB(0, 1), cB + hstep); G8_STAGEA(G8_SA(0, 1), cA + hstepA);
  if (wr == 1) G8_BAR;
  G8_WAIT_V(4); G8_BAR;
  G8_STAGE(G8_SB(1, 0), cB + kstep); G8_STAGEA(G8_SA(1, 0), cA + kstepA); G8_STAGE(G8_SB(1, 1), cB + hstep + kstep);
  G8_WAIT_V(6); G8_BAR;
  for (;;) {
    const bool has_next = S.next(ui + 1, npm, npn);
    const char* nA = has_next ? (const char*)A + (size_t)npm * tstep : cA; const char* nB = has_next ? (const char*)Bt + (size_t)npn * tstep : cB;
#pragma unroll 1
    for (int t = 0; t < nt; t += 2) {
      const bool last = (t == nt - 2);
      const char* a1 = cA + (size_t)(t + 1) * kstepA;
      const char* a2 = last ? nA : cA + (size_t)(t + 2) * kstepA; const char* b2 = last ? nB : cB + (size_t)(t + 2) * kstep;
      const char* a3 = a2 + kstepA; const char* b3 = b2 + kstep;
      G8_LDB(B0, 0, 0); G8_SCHED; G8_LDA(At, 0, 0); G8_STAGEA(G8_SA(1, 1), a1 + hstepA);
      G8_WAIT_L(8); G8_BAR; G8_WAIT_L(0); G8_MMA(0, 0, At, B0); G8_BAR; G8_SCHED;
      G8_LDB(B1, 0, 1); G8_STAGE(G8_SB(0, 0), b2);
      G8_BAR; G8_WAIT_L(0); G8_MMA(0, 1, At, B1); G8_BAR;
      G8_LDA(At, 0, 1); G8_STAGEA(G8_SA(0, 0), a2);
      G8_BAR; G8_WAIT_L(0); G8_MMA(1, 0, At, B0); G8_BAR; G8_SCHED;
      G8_STAGE(G8_SB(0, 1), b2 + hstep);
      G8_WAIT_V(6); G8_BAR; G8_MMA(1, 1, At, B1); G8_BAR;
      G8_LDB(B0, 1, 0); G8_SCHED; G8_LDA(At, 1, 0); G8_STAGEA(G8_SA(0, 1), a2 + hstepA);
      G8_WAIT_L(8); G8_BAR; G8_WAIT_L(0); G8_MMA(0, 0, At, B0); G8_BAR; G8_SCHED;
      G8_LDB(B1, 1, 1); G8_STAGE(G8_SB(1, 0), b3);
      G8_BAR; G8_WAIT_L(0); G8_MMA(0, 1, At, B1); G8_BAR;
      G8_LDA(At, 1, 1); G8_STAGEA(G8_SA(1, 0), a3);
      G8_BAR; G8_WAIT_L(0); G8_MMA(1, 0, At, B0); G8_BAR; G8_SCHED;
      G8_STAGE(G8_SB(1, 1), b3 + hstep);
      G8_WAIT_V(6); G8_BAR; G8_MMA(1, 1, At, B1); G8_BAR;
    }
    { const int t2 = TIDX(), w2 = __builtin_amdgcn_readfirstlane(t2 >> 6), l2 = t2 & 63; E(acc, cpm, cpn, w2 >> 2, w2 & 3, l2 & 15, l2 >> 4); }
    if (!has_next) break;
#pragma unroll
    for (int a = 0; a < 2; ++a)
#pragma unroll
      for (int b = 0; b < 2; ++b)
#pragma unroll
        for (int m = 0; m < 4; ++m)
#pragma unroll
          for (int n = 0; n < 2; ++n) acc[a][b][m][n] = f32x4{0.f, 0.f, 0.f, 0.f};
    cpm = npm; cpn = npn; cA = nA; cB = nB; ++ui;
  }
  G8_WAIT_V(0);
  if (wr == 0) G8_BAR;
  G8_BAR;
#undef G8_SA
#undef G8_SB
#undef G8_STAGE
#undef G8_STAGEA
#undef G8_LDA
#undef G8_LDB
#undef G8_MMA
#undef G8_WAIT_V
#undef G8_WAIT_L
#undef G8_BAR
#undef G8_SCHED
}
template <bool ABLK, class Epi>
DI void gemm_half(char* smem, const u16* A, const u16* Bt, int K, int pm, int pn, int nh, const Epi& E) {
  LAS unsigned char* lds = (LAS unsigned char*)smem;
  const int tid = TIDX(), wid = __builtin_amdgcn_readfirstlane(tid >> 6), lane = tid & 63, wr = wid >> 2, wc = wid & 3, fr = lane & 15, fq = lane >> 4;
  const int nt = K / 64;
  unsigned voff[2], voffA[2];
#pragma unroll
  for (int i = 0; i < 2; ++i) { int R, C; g8_stage_rc(tid * 16 + i * 8192, R, C); voff[i] = (unsigned)(R * 64 + C) * 2u; voffA[i] = ABLK ? voff[i] : (unsigned)(R * K + C) * 2u; }
  const size_t kstep = 32768, hstep = 16384, tstep = (size_t)256 * K * 2;
  const size_t kstepA = ABLK ? 32768 : 128, hstepA = ABLK ? 16384 : (size_t)128 * K * 2;
  const unsigned ldsw = (unsigned)wid * 1024u;
  const int aoff = g8_lds_byte(wr * 64 + fr, fq * 8), boff = g8_lds_byte(wc * 32 + fr, fq * 8);
  const char* cA = (const char*)A + (size_t)pm * tstep;
  const char* cB = (const char*)Bt + (size_t)pn * tstep + (size_t)nh * hstep;
#define GH_STAGE(s_, kt_) do { _Pragma("unroll") for (int _i = 0; _i < 2; ++_i) { \
    __builtin_amdgcn_global_load_lds((const unsigned*)(cB + (size_t)(kt_) * kstep + voff[_i]), (LAS unsigned*)(lds + (s_) * 49152 + ldsw + _i * 8192), 16, 0, 0); \
    __builtin_amdgcn_global_load_lds((const unsigned*)(cA + (size_t)(kt_) * kstepA + voffA[_i]), (LAS unsigned*)(lds + (s_) * 49152 + 16384 + ldsw + _i * 8192), 16, 0, 0); \
    __builtin_amdgcn_global_load_lds((const unsigned*)(cA + hstepA + (size_t)(kt_) * kstepA + voffA[_i]), (LAS unsigned*)(lds + (s_) * 49152 + 32768 + ldsw + _i * 8192), 16, 0, 0); } } while (0)
  f32x4 acc[2][4][2];
#pragma unroll
  for (int a = 0; a < 2; ++a)
#pragma unroll
    for (int m = 0; m < 4; ++m)
#pragma unroll
      for (int n = 0; n < 2; ++n) acc[a][m][n] = f32x4{0.f, 0.f, 0.f, 0.f};
  __syncthreads();
  GH_STAGE(0, 0);
  asm volatile("s_waitcnt vmcnt(0)" ::: "memory");
  __syncthreads();
#pragma unroll 1
  for (int kt = 0; kt < nt; ++kt) {
    if (kt + 1 < nt) GH_STAGE((kt + 1) & 1, kt + 1);
    const LAS unsigned char* base = lds + (kt & 1) * 49152;
    bf16x8 B0[2][2];
#pragma unroll
    for (int n = 0; n < 2; ++n)
#pragma unroll
      for (int k = 0; k < 2; ++k) B0[n][k] = *(const LAS bf16x8*)(base + boff + n * 2048 + k * 1024);
#pragma unroll
    for (int ai = 0; ai < 2; ++ai) {
      bf16x8 At[4][2];
#pragma unroll
      for (int m = 0; m < 4; ++m)
#pragma unroll
        for (int k = 0; k < 2; ++k) At[m][k] = *(const LAS bf16x8*)(base + 16384 + ai * 16384 + aoff + m * 2048 + k * 1024);
#pragma unroll
      for (int m = 0; m < 4; ++m)
#pragma unroll
        for (int n = 0; n < 2; ++n)
#pragma unroll
          for (int k = 0; k < 2; ++k) acc[ai][m][n] = __builtin_amdgcn_mfma_f32_16x16x32_bf16(B0[n][k], At[m][k], acc[ai][m][n], 0, 0, 0);
    }
    asm volatile("s_waitcnt vmcnt(0)" ::: "memory");
    __syncthreads();
  }
#undef GH_STAGE
  E(acc, pm, pn, nh, wr, wc, fr, fq);
}

template <class F> struct ElemEpi {
  F f;
  DI void operator()(const f32x4 (&acc)[2][2][4][2], int pm, int pn, int wr, int wc, int fr, int fq) const {
    const int row0 = pm * 256 + wr * 64 + fr, col0 = pn * 256 + wc * 32 + 4 * fq;
#pragma unroll
    for (int ai = 0; ai < 2; ++ai)
#pragma unroll
      for (int m = 0; m < 4; ++m)
#pragma unroll
        for (int bj = 0; bj < 2; ++bj)
#pragma unroll
          for (int n = 0; n < 2; ++n) f(row0 + ai * 128 + m * 16, col0 + bj * 128 + n * 16, acc[ai][bj][m][n]);
  }
};
template <class F> DI ElemEpi<F> make_epi(F f) { return ElemEpi<F>{f}; }
template <int NM, int NN, int NN1, int SM1, int SN1, int SM2, int SN2, class F>
DI void gemm8_job(char* smem, const u16* A, const u16* Bt, int K, F f) {
  TileSched<NM, NN, NN1, SM1, SN1, SM2, SN2> S; S.init();
  gemm8(smem, A, Bt, K, S, make_epi(f));
}

struct EpiMixU {
  u16* MIX;
  DI void operator()(const f32x4 (&acc)[2][2][4][2], int pm, int pn, int wr, int wc, int fr, int fq) const {
    const int row0 = pm * 256 + wr * 64 + fr, col0 = pn * 256 + wc * 32 + 4 * fq;
#pragma unroll
    for (int ai = 0; ai < 2; ++ai)
#pragma unroll
      for (int m = 0; m < 4; ++m)
#pragma unroll
        for (int bj = 0; bj < 2; ++bj)
#pragma unroll
          for (int n = 0; n < 2; ++n) {
            const f32x4 v = acc[ai][bj][m][n];
            *(uint2*)(MIX + (unsigned)((row0 + ai * 128 + m * 16) * 1024 + col0 + bj * 128 + n * 16)) = pack4(gelu_tanh(v[0]), gelu_tanh(v[1]), gelu_tanh(v[2]), gelu_tanh(v[3]));
          }
  }
  DI void operator()(const f32x4 (&acc)[2][4][2], int pm, int pn, int nh, int wr, int wc, int fr, int fq) const {
    const int row0 = pm * 256 + wr * 64 + fr, col0 = pn * 256 + nh * 128 + wc * 32 + 4 * fq;
#pragma unroll
    for (int ai = 0; ai < 2; ++ai)
#pragma unroll
      for (int m = 0; m < 4; ++m)
#pragma unroll
        for (int n = 0; n < 2; ++n) {
          const f32x4 v = acc[ai][m][n];
          *(uint2*)(MIX + (unsigned)((row0 + ai * 128 + m * 16) * 1024 + col0 + n * 16)) = pack4(gelu_tanh(v[0]), gelu_tanh(v[1]), gelu_tanh(v[2]), gelu_tanh(v[3]));
        }
  }
};
struct EpiMixV {
  u16* VT; u16* PRT;
  DI void operator()(const f32x4 (&acc)[2][2][4][2], int pm, int pn, int wr, int wc, int fr, int fq) const {
    const int rowt = pm * 256;
    if (pn < 2) {
#pragma unroll
      for (int ai = 0; ai < 2; ++ai)
#pragma unroll
        for (int bj = 0; bj < 2; ++bj) {
          const unsigned g = (unsigned)(pn * 2 + bj), chunk = (unsigned)(pm * 2 + ai);
          const unsigned base = ((g * 320u + chunk) * 128u) * 128u;
#pragma unroll
          for (int m = 0; m < 4; ++m)
#pragma unroll
            for (int n = 0; n < 2; ++n) {
              const f32x4 v = acc[ai][bj][m][n];
              const unsigned c = (unsigned)(wc * 32 + n * 16 + fr), q = (unsigned)(wr * 64 + m * 16 + 4 * fq);
              *(uint2*)(VT + (base + c * 128u + q)) = pack4(gelu_tanh(v[0]), gelu_tanh(v[1]), gelu_tanh(v[2]), gelu_tanh(v[3]));
            }
        }
    } else {
      unsigned sbase, L;
      if (rowt < TP) { sbase = (unsigned)rowt * 1536u; L = 256u; }
      else { const int mm = rowt - TP; sbase = (unsigned)(TP + (mm & ~4095)) * 1536u + (unsigned)(mm & 4095); L = 4096u; }
#pragma unroll
      for (int ai = 0; ai < 2; ++ai)
#pragma unroll
        for (int bj = 0; bj < 2; ++bj)
#pragma unroll
          for (int m = 0; m < 4; ++m)
#pragma unroll
            for (int n = 0; n < 2; ++n) {
              const f32x4 v = acc[ai][bj][m][n];
              const unsigned cp = (unsigned)((pn - 2) * 256 + bj * 128 + wc * 32 + n * 16 + fr), tl = (unsigned)(ai * 128 + wr * 64 + m * 16 + 4 * fq);
              *(uint2*)(PRT + (sbase + cp * L + tl)) = pack4(v[0], v[1], v[2], v[3]);
            }
    }
  }
};
struct OneRoundSched {
  int c;
  DI void init() { c = blockIdx.x; }
  DI bool next(int i, int& pm, int& pn) const {
    if (gridDim.x == 256) { if (i > 0) return false; const int slot = c >> 3; pm = (c & 7) * 16 + (slot & 15); pn = slot >> 4; return true; }
    const int L = i * (int)gridDim.x + c; if (L >= 320) return false; pm = L >> 1; pn = L & 1; return true;
  }
};
DI void phase_mix_in(const PV& p, int i, char* smem) {
  const u16* H = (const u16*)(p.ws() + OFF_A + A_H);
  const u16* W = (const u16*)(p.ws() + OFF_WMIXIN) + (size_t)i * 2560 * 1024;
  EpiMixV EV; EV.VT = (u16*)(p.ws() + OFF_B + B_VT); EV.PRT = (u16*)(p.ws() + OFF_B + B_PRT);
  EpiMixU EU; EU.MIX = (u16*)(p.ws() + OFF_B + B_MIX);
  {
    TileSched<160, 8, 8, 8, 4, 32, 1> S; S.init();
    gemm8<false, 2>(smem, H, W + (size_t)512 * 1024, 1024, S, EV);
  }
  {
    OneRoundSched S; S.init();
    gemm8<false, 0>(smem, H, W, 1024, S, EU);
    if (gridDim.x == 256 && blockIdx.x < 128) {
      const int tile = blockIdx.x >> 1, nh = blockIdx.x & 1;
      gemm_half<false>(smem, H, W, 1024, 128 + (tile & 31), tile >> 5, nh, EU);
    }
  }
}

DI void phase_sgu(const PV& p, int i, char* smem) {
  const u16* VT = (const u16*)(p.ws() + OFF_B + B_VT);
  const u16* W = (const u16*)(p.ws() + OFF_WSGU) + (size_t)i * 4 * 16384;
  u16* MIX = (u16*)(p.ws() + OFF_B + B_MIX);
  const float* sb = p.in(11) + i * 512;
  for (int u = blockIdx.x; u < 640; u += gridDim.x) {
    const int g = u / 160, tm = u % 160;
    auto epi = [=](int m, int n, f32x4 v, uint2 uu) {
      const int chunk = m >> 7, c = m & 127;
      const int t = chunk * 128 + n;
      const float bias = sb[g * 128 + n];
      u16* dst = MIX + (size_t)t * 1024 + g * 128 + c;
      *(uint2*)dst = pack4(lo16(uu.x) * (v[0] + bias), hi16(uu.x) * (v[1] + bias), lo16(uu.y) * (v[2] + bias), hi16(uu.y) * (v[3] + bias));
    };
    auto pre = [=](int m, int n) { return *(const uint2*)(MIX + (size_t)((m >> 7) * 128 + n) * 1024 + g * 128 + (m & 127)); };
    gemm_tile<false>(VT + (size_t)g * 320 * 128 * 128, 128, W + (size_t)g * 16384, 128, 128, tm * 256, 0, smem, epi, pre);
  }
}

DI size_t prt_off(int kind, int b, int cp) {
  return kind ? (size_t)(TP + b * 4096) * 1536 + (size_t)cp * 4096 : (size_t)(b * 256) * 1536 + (size_t)cp * 256;
}
DI size_t zt_off(int kind, int b, int c) {
  return kind ? (size_t)(TP + b * 4096) * 512 + (size_t)c * 4096 : (size_t)(b * 256) * 512 + (size_t)c * 256;
}
DI void phase_conv(const PV& p, int i, int ord, char* smem) {
  const int tid = TIDX(), lane = tid & 63, wid = tid >> 6;
  const u16* PRT = (const u16*)(p.ws() + OFF_B + B_PRT);
  const u16* FILT = (const u16*)(p.ws() + OFF_FILT);
  const u16* Z1 = (const u16*)(p.ws() + OFF_A + A_Z1);
  u16* ZO = (u16*)(p.ws() + OFF_A + (ord ? A_Z2 : A_Z1));
  const float* cw = p.in(12) + (size_t)i * 3 * 1536;
  const float* cb = p.in(13) + (size_t)i * 1536;
  u16* hc = (u16*)smem;
  char* Ub = smem + 68096;
  for (int u = blockIdx.x; u < 1024; u += gridDim.x) {
    const int kind = u < 512 ? 1 : 0, c = u & 511;
    const int L = kind ? 4096 : 256, NB = kind ? 8 : 32, LB = L >> 6, DD = L >> 7;
    const int US = (L + 8) * 2;
    const size_t fbase = ((size_t)(i * 2 + ord) * 512 + c) * 4352 + (kind ? 256 : 0);
    __syncthreads();
    {
      u16* tmp = (u16*)Ub;
      for (int idx = tid; idx < (L >> 3); idx += 512) *(uint4*)(tmp + idx * 8) = *(const uint4*)(FILT + fbase + idx * 8);
      __syncthreads();
#pragma unroll 1
      for (int cpy = 0; cpy < 8; ++cpy)
        for (int m = tid; m < L + 136; m += 512) {
          const int x = L + 63 - m - cpy;
          hc[cpy * 4256 + m] = (x >= 0 && x < L) ? tmp[x] : (u16)0;
        }
      __syncthreads();
    }
    {
      const int lgn = kind ? 9 : 5, ncr = 1 << lgn, total = NB * ncr;
      const float w0 = cw[c], w1 = cw[1536 + c], w2 = cw[3072 + c], bb = cb[c];
      for (int id = tid; id < total; id += 512) {
        const int b = id >> lgn, t = (id & (ncr - 1)) * 8;
        uint4 o;
        if (ord == 0) {
          const u16* src = PRT + prt_off(kind, b, c) + t;
          const uint4 raw = ld16u_nt(src);
          float e[10];
          e[0] = t > 0 ? bf2f(src[-1]) : 0.f;
          e[9] = t + 8 < L ? bf2f(src[8]) : 0.f;
          e[1] = lo16(raw.x); e[2] = hi16(raw.x); e[3] = lo16(raw.y); e[4] = hi16(raw.y);
          e[5] = lo16(raw.z); e[6] = hi16(raw.z); e[7] = lo16(raw.w); e[8] = hi16(raw.w);
          float r[8];
#pragma unroll
          for (int k = 0; k < 8; ++k) r[k] = w0 * e[k] + w1 * e[k + 1] + w2 * e[k + 2] + bb;
          o.x = pack2(r[0], r[1]); o.y = pack2(r[2], r[3]); o.z = pack2(r[4], r[5]); o.w = pack2(r[6], r[7]);
        } else {
          o = ld16u_nt(Z1 + zt_off(kind, b, c) + t);
        }
        *(uint4*)(Ub + b * US + t * 2) = o;
      }
    }
    __syncthreads();
    const int ncols = LB * NB;
#pragma unroll 1
    for (int hf = 0; hf < 2; ++hf) {
      const int jt = wid + 8 * hf;
      if (jt * 32 >= ncols) break;
      const int il = lane & 31, q = lane >> 5;
      const int lgb = kind ? 3 : 5;
      const int col = jt * 32 + il, t1c = col >> lgb, bc = col & (NB - 1);
      const int t1lo = (jt * 32) >> lgb, t1hi = (jt * 32 + 31) >> lgb;
      const int dlo = max(-DD, t1lo - (LB - 1)), dhi = min(DD, t1hi);
      const int cpy = 7 - (il & 7);
      const char* abase = (const char*)hc + cpy * 8512 + 2 * (L / 2 + 63 - il - cpy + 8 * q);
      f32x16 acc[2];
#pragma unroll
      for (int a = 0; a < 2; ++a)
#pragma unroll
        for (int r = 0; r < 16; ++r) acc[a][r] = 0.f;
      for (int d = dlo; d <= dhi; ++d) {
        bf16x8 bfr[4];
        {
          const int s1 = t1c - d;
          const bool valid = s1 >= 0 && s1 < LB;
          const char* bp = Ub + bc * US + ((valid ? s1 : 0) * 64 + 8 * q) * 2;
#pragma unroll
          for (int ks = 0; ks < 4; ++ks) {
            bf16x8 v = *(const bf16x8*)(bp + ks * 32);
            if (!valid) v = bf16x8{0, 0, 0, 0, 0, 0, 0, 0};
            bfr[ks] = v;
          }
        }
#pragma unroll
        for (int mt = 0; mt < 2; ++mt)
#pragma unroll
          for (int ks = 0; ks < 4; ++ks) {
            const bf16x8 af = *(const bf16x8*)(abase + 2 * (-64 * d - 32 * mt + 16 * ks));
            acc[mt] = __builtin_amdgcn_mfma_f32_32x32x16_bf16(af, bfr[ks], acc[mt], 0, 0, 0);
          }
      }
      const float dsk = p.in(21)[(i * 2 + ord) * 512 + c];
      const int gc = 512 * (ord + 1) + c;
      const float w0 = cw[gc], w1 = cw[1536 + gc], w2 = cw[3072 + gc], bb = cb[gc];
      {
        const int b = bc;
        const u16* xrow = PRT + prt_off(kind, b, gc);
        u16* orow = ZO + zt_off(kind, b, c);
#pragma unroll
        for (int mt = 0; mt < 2; ++mt)
#pragma unroll
          for (int g = 0; g < 4; ++g) {
            const int t = 64 * t1c + mt * 32 + 8 * g + 4 * q;
            const uint2 uu = *(const uint2*)(Ub + b * US + t * 2);
            const uint2 xx = *(const uint2*)(xrow + t);
            const float em = t > 0 ? bf2f(xrow[t - 1]) : 0.f;
            const float ep = t + 4 < L ? bf2f(xrow[t + 4]) : 0.f;
            const float e0 = lo16(xx.x), e1 = hi16(xx.x), e2 = lo16(xx.y), e3 = hi16(xx.y);
            const float x0 = w0 * em + w1 * e0 + w2 * e1 + bb;
            const float x1 = w0 * e0 + w1 * e1 + w2 * e2 + bb;
            const float x2 = w0 * e1 + w1 * e2 + w2 * e3 + bb;
            const float x3 = w0 * e2 + w1 * e3 + w2 * ep + bb;
            const float y0 = acc[mt][4 * g + 0] + lo16(uu.x) * dsk;
            const float y1 = acc[mt][4 * g + 1] + hi16(uu.x) * dsk;
            const float y2 = acc[mt][4 * g + 2] + lo16(uu.y) * dsk;
            const float y3 = acc[mt][4 * g + 3] + hi16(uu.y) * dsk;
            *(uint2*)(orow + t) = pack4(x0 * y0, x1 * y1, x2 * y2, x3 * y3);
          }
      }
    }
  }
  __syncthreads();
}

DI void phase_ztrans(const PV& p, char* smem) {
  const int tid = TIDX();
  const u16* Z2 = (const u16*)(p.ws() + OFF_A + A_Z2);
  u16* MIX = (u16*)(p.ws() + OFF_B + B_MIX);
  u16* tl = (u16*)smem;
  for (int u4 = blockIdx.x * 4; u4 < 640 * 8; u4 += gridDim.x * 4) {
    const int tt0 = (u4 >> 3) * 64;
    const int kind = tt0 >= TP ? 1 : 0;
    const int b = kind ? (tt0 - TP) >> 12 : tt0 >> 8;
    const int tl0 = kind ? (tt0 - TP) & 4095 : tt0 & 255;
    __syncthreads();
    { const int c = tid >> 3, ch = tid & 7;
      uint4 v[4];
#pragma unroll
      for (int w = 0; w < 4; ++w) v[w] = *(const uint4*)(Z2 + zt_off(kind, b, ((u4 + w) & 7) * 64 + c) + tl0 + ch * 8);
#pragma unroll
      for (int w = 0; w < 4; ++w) *(uint4*)(tl + w * 4608 + c * 72 + ch * 8) = v[w]; }
    __syncthreads();
    { const int tr = tid >> 3, cc = (tid & 7) * 8;
#pragma unroll
      for (int w = 0; w < 4; ++w) {
        const u16* tw = tl + w * 4608;
        uint4 o;
        o.x = (unsigned)tw[(cc + 0) * 72 + tr] | ((unsigned)tw[(cc + 1) * 72 + tr] << 16);
        o.y = (unsigned)tw[(cc + 2) * 72 + tr] | ((unsigned)tw[(cc + 3) * 72 + tr] << 16);
        o.z = (unsigned)tw[(cc + 4) * 72 + tr] | ((unsigned)tw[(cc + 5) * 72 + tr] << 16);
        o.w = (unsigned)tw[(cc + 6) * 72 + tr] | ((unsigned)tw[(cc + 7) * 72 + tr] << 16);
        *(uint4*)(MIX + (size_t)(tt0 + tr) * 1024 + 512 + ((u4 + w) & 7) * 64 + cc) = o;
      } }
  }
  __syncthreads();
}

struct EpiResid {
  float* X; const float* x0; const float* x1; const float* gate; int lx;
  DI void operator()(const f32x4 (&acc)[2][2][4][2], int pm, int pn, int wr, int wc, int fr, int fq) const {
    const int rowt = pm * 256, col0 = pn * 256 + wc * 32 + 4 * fq;
    const float* gr = gate + (size_t)condrow(rowt) * 6144 + col0;
    const float* xb = lx == 0 ? (rowt < TP ? x0 + (size_t)rowt * 1024 : x1 + (size_t)(rowt - TP) * 1024) : X + (size_t)rowt * 1024;
    float4 g[2][2];
#pragma unroll
    for (int bj = 0; bj < 2; ++bj)
#pragma unroll
      for (int n = 0; n < 2; ++n) g[bj][n] = *(const float4*)(gr + bj * 128 + n * 16);
#pragma unroll
    for (int ai = 0; ai < 2; ++ai)
#pragma unroll
      for (int mh = 0; mh < 2; ++mh) {
        float4 xo[2][2][2];
#pragma unroll
        for (int mm = 0; mm < 2; ++mm)
#pragma unroll
          for (int bj = 0; bj < 2; ++bj)
#pragma unroll
            for (int n = 0; n < 2; ++n)
              xo[mm][bj][n] = ld16_nt(xb + (size_t)(wr * 64 + fr + ai * 128 + (2 * mh + mm) * 16) * 1024 + col0 + bj * 128 + n * 16);
#pragma unroll
        for (int mm = 0; mm < 2; ++mm)
#pragma unroll
          for (int bj = 0; bj < 2; ++bj)
#pragma unroll
            for (int n = 0; n < 2; ++n) {
              const f32x4 v = acc[ai][bj][2 * mh + mm][n];
              const float4 x = xo[mm][bj][n], gg = g[bj][n];
              float4 o; o.x = x.x + gg.x * v[0]; o.y = x.y + gg.y * v[1]; o.z = x.z + gg.z * v[2]; o.w = x.w + gg.w * v[3];
              st16_nt(X + (size_t)(rowt + wr * 64 + fr + ai * 128 + (2 * mh + mm) * 16) * 1024 + col0 + bj * 128 + n * 16, o);
            }
      }
  }
};
struct EpiResidHalf {
  float* X; const float* x0; const float* x1; const float* gate; int lx;
  DI void operator()(const f32x4 (&acc)[2][4][2], int pm, int pn, int nh, int wr, int wc, int fr, int fq) const {
    const int rowt = pm * 256, col0 = pn * 256 + nh * 128 + wc * 32 + 4 * fq;
    const float* gr = gate + (size_t)condrow(rowt) * 6144 + col0;
    const float* xb = lx == 0 ? (rowt < TP ? x0 + (size_t)rowt * 1024 : x1 + (size_t)(rowt - TP) * 1024) : X + (size_t)rowt * 1024;
    float4 g[2];
#pragma unroll
    for (int n = 0; n < 2; ++n) g[n] = *(const float4*)(gr + n * 16);
#pragma unroll
    for (int ai = 0; ai < 2; ++ai) {
      float4 xo[4][2];
#pragma unroll
      for (int m = 0; m < 4; ++m)
#pragma unroll
        for (int n = 0; n < 2; ++n) xo[m][n] = ld16_nt(xb + (size_t)(wr * 64 + fr + ai * 128 + m * 16) * 1024 + col0 + n * 16);
#pragma unroll
      for (int m = 0; m < 4; ++m)
#pragma unroll
        for (int n = 0; n < 2; ++n) {
          const f32x4 v = acc[ai][m][n];
          const float4 x = xo[m][n], gg = g[n];
          float4 o; o.x = x.x + gg.x * v[0]; o.y = x.y + gg.y * v[1]; o.z = x.z + gg.z * v[2]; o.w = x.w + gg.w * v[3];
          st16_nt(X + (size_t)(rowt + wr * 64 + fr + ai * 128 + m * 16) * 1024 + col0 + n * 16, o);
        }
    }
  }
};
struct ResidSched2 {
  int c;
  DI void init() { c = blockIdx.x; }
  DI bool next(int i, int& pm, int& pn) const {
    if (gridDim.x == 256) {
      const int st = (c & 7) + 8 * i;
      if (st >= 16) return false;
      pm = st * 8 + ((c >> 3) & 7); pn = c >> 6; return true;
    }
    const int L = i * (int)gridDim.x + c; if (L >= 640) return false; pm = L >> 2; pn = L & 3; return true;
  }
};
DI void phase_resid_gemm(const PV& p, int l, int lx, const u16* A, int K, const u16* W, int goff, char* smem) {
  EpiResid E;
  E.X = p.out(); E.x0 = p.in(0); E.x1 = p.in(1); E.gate = (const float*)(p.ws() + OFF_MOD) + (size_t)l * 9 * 6144 + goff; E.lx = lx;
  ResidSched2 S; S.init();
  if (K == 2816) gemm8<true>(smem, A, W, K, S, E);
  else gemm8<false>(smem, A, W, K, S, E);
  if (gridDim.x == 256) {
    EpiResidHalf EH; EH.X = E.X; EH.x0 = E.x0; EH.x1 = E.x1; EH.gate = E.gate; EH.lx = lx;
    const int xcd = blockIdx.x & 7, slot = blockIdx.x >> 3;
    const int st = 16 + (xcd >> 1), ti = (xcd & 1) * 16 + (slot >> 1), nh = slot & 1;
    const int pm = st * 8 + (ti & 7), pn = ti >> 3;
    if (K == 2816) gemm_half<true>(smem, A, W, K, pm, pn, nh, EH);
    else gemm_half<false>(smem, A, W, K, pm, pn, nh, EH);
  }
}

DI void phase_dqkv(const PV& p, int j, char* smem) {
  const u16* H = (const u16*)(p.ws() + OFF_A + A_H);
  const u16* W = (const u16*)(p.ws() + OFF_WDQKV) + (size_t)j * 1024 * 1024;
  u16* DQKV = (u16*)(p.ws() + OFF_B + B_DQKV);
  u16* KR = (u16*)(p.ws() + OFF_KR);
  float* okr = p.out() + 46137344;
  auto epi = [=](int m, int n, f32x4 v) {
    if (n < 832) {
      const uint2 pk = pack4(v[0], v[1], v[2], v[3]);
      *(uint2*)(DQKV + (size_t)m * 896 + n) = pk;
      if (n >= 768) {
        const int e = n - 768;
        *(uint2*)(KR + (size_t)m * 64 + e) = pk;
        if (m < TP) {
          float4 o; o.x = v[0]; o.y = v[1]; o.z = v[2]; o.w = v[3];
          *(float4*)(okr + ((size_t)((m >> 8) * 2 + j) * 256 + (m & 255)) * 64 + e) = o;
        }
      }
    }
  };
  gemm8_job<160, 4, 4, 8, 4, 32, 1>(smem, H, W, 1024, epi);
}

DI void phase_mla_norms(const PV& p, int j) {
  const int tid_ = TIDX(); const int lane = tid_ & 63, wid = tid_ >> 6;
  const u16* DQKV = (const u16*)(p.ws() + OFF_B + B_DQKV);
  u16* QN = (u16*)(p.ws() + OFF_A + A_QN);
  u16* CKV = (u16*)(p.ws() + OFF_A + A_CKV);
  u16* KR = (u16*)(p.ws() + OFF_KR);
  float* ockv = p.out() + 41943040;
  const float* qn = p.in(24) + j * 512;
  const float* kvn = p.in(27) + j * 256;
  const int stride = gridDim.x * 8;
  for (int t0 = blockIdx.x * 8 + wid; t0 < TK; t0 += 2 * stride) {
    uint4 ra[2]; uint2 rb[2];
#pragma unroll
    for (int w = 0; w < 2; ++w) {
      const int t = t0 + w * stride;
      if (t < T) {
        const u16* row = DQKV + (size_t)t * 896;
        ra[w] = *(const uint4*)(row + lane * 8);
        rb[w] = *(const uint2*)(row + 512 + lane * 4);
      }
    }
#pragma unroll
    for (int w = 0; w < 2; ++w) {
      const int t = t0 + w * stride;
      if (t < T) {
        const uint4 a = ra[w];
        float q[8] = {lo16(a.x), hi16(a.x), lo16(a.y), hi16(a.y), lo16(a.z), hi16(a.z), lo16(a.w), hi16(a.w)};
        float ss = 0.f;
#pragma unroll
        for (int k = 0; k < 8; ++k) ss += q[k] * q[k];
        ss = wave_sum(ss, lane);
        const float r = rsqrtf(ss * (1.f / 512.f) + EPS);
        const float4 g0 = *(const float4*)(qn + lane * 8), g1 = *(const float4*)(qn + lane * 8 + 4);
        uint4 o;
        o.x = pack2(q[0] * r * g0.x, q[1] * r * g0.y); o.y = pack2(q[2] * r * g0.z, q[3] * r * g0.w);
        o.z = pack2(q[4] * r * g1.x, q[5] * r * g1.y); o.w = pack2(q[6] * r * g1.z, q[7] * r * g1.w);
        *(uint4*)(QN + (size_t)t * 512 + lane * 8) = o;
        const uint2 b = rb[w];
        float kv[4] = {lo16(b.x), hi16(b.x), lo16(b.y), hi16(b.y)};
        float s2 = kv[0] * kv[0] + kv[1] * kv[1] + kv[2] * kv[2] + kv[3] * kv[3];
        s2 = wave_sum(s2, lane);
        const float r2 = rsqrtf(s2 * (1.f / 256.f) + EPS);
        const float4 g2 = *(const float4*)(kvn + lane * 4);
        float4 o2; o2.x = kv[0] * r2 * g2.x; o2.y = kv[1] * r2 * g2.y; o2.z = kv[2] * r2 * g2.z; o2.w = kv[3] * r2 * g2.w;
        *(uint2*)(CKV + (size_t)t * 256 + lane * 4) = pack4(o2.x, o2.y, o2.z, o2.w);
        if (t < TP) *(float4*)(ockv + ((size_t)((t >> 8) * 2 + j) * 256 + (t & 255)) * 256 + lane * 4) = o2;
      } else if (t < TK) {
        const int pp = t - T, b = pp >> 8, sidx = pp & 255;
        const float4 v = *(const float4*)(p.in(2) + ((size_t)(b * 2 + j) * 256 + sidx) * 256 + lane * 4);
        *(uint2*)(CKV + (size_t)t * 256 + lane * 4) = pack4(v.x, v.y, v.z, v.w);
        if (lane < 16) {
          const float4 w4 = *(const float4*)(p.in(3) + ((size_t)(b * 2 + j) * 256 + sidx) * 64 + lane * 4);
          *(uint2*)(KR + (size_t)t * 64 + lane * 4) = pack4(w4.x, w4.y, w4.z, w4.w);
        }
      }
    }
  }
}

DI size_t vt_off(int m, int h, int d) {
  if (m < TP) return ((size_t)((m >> 8) * 8 + h) * 128 + d) * 256 + (m & 255);
  if (m < T) { const int mm = m - TP; return VT_SAMPLE_OFF + ((size_t)((mm >> 12) * 8 + h) * 128 + d) * 4352 + (mm & 4095); }
  const int mm = m - T;
  return VT_SAMPLE_OFF + ((size_t)((mm >> 8) * 8 + h) * 128 + d) * 4352 + 4096 + (mm & 255);
}
struct EpiKV {
  u16* Kb; u16* Vt;
  DI void operator()(const f32x4 (&acc)[2][2][4][2], int pm, int pn, int wr, int wc, int fr, int fq) const {
    const int h = pn;
    const int rowt = pm * 256;
    const unsigned ls = rowt < TP ? 256u : 4352u;
    unsigned vbase;
    if (rowt < TP) vbase = (unsigned)(((rowt >> 8) * 8 + h) * 128) * 256u;
    else if (rowt < T) { const int mm = rowt - TP; vbase = (unsigned)VT_SAMPLE_OFF + (unsigned)(((mm >> 12) * 8 + h) * 128) * 4352u + (unsigned)(mm & 4095); }
    else { const int mm = rowt - T; vbase = (unsigned)VT_SAMPLE_OFF + (unsigned)(((mm >> 8) * 8 + h) * 128) * 4352u + 4096u + (unsigned)(mm & 255); }
    const unsigned dcol = (unsigned)(wc * 32 + 4 * fq);
#pragma unroll
    for (int ai = 0; ai < 2; ++ai)
#pragma unroll
      for (int m = 0; m < 4; ++m) {
        const int rl = ai * 128 + wr * 64 + m * 16 + fr;
        const unsigned ko = (unsigned)((rowt + rl) * 8 + h) * 192u + dcol;
        const unsigned frp = (unsigned)((fr & 3) | ((fr & 4) << 1) | ((fr & 8) >> 1));
        const unsigned vo = vbase + (unsigned)(rl & ~15) + frp + dcol * ls;
#pragma unroll
        for (int n = 0; n < 2; ++n) {
          const f32x4 k = acc[ai][0][m][n], v = acc[ai][1][m][n];
          *(uint2*)(Kb + (ko + n * 16)) = pack4(k[0], k[1], k[2], k[3]);
          const unsigned p01 = pack2(v[0], v[1]), p23 = pack2(v[2], v[3]);
          const unsigned vq = vo + (unsigned)(n * 16) * ls;
          Vt[vq] = (u16)p01; Vt[vq + ls] = (u16)(p01 >> 16); Vt[vq + 2 * ls] = (u16)p23; Vt[vq + 3 * ls] = (u16)(p23 >> 16);
        }
      }
  }
};
DI void phase_uq_ukv(const PV& p, int j, char* smem) {
  const u16* QN = (const u16*)(p.ws() + OFF_A + A_QN);
  const u16* CKV = (const u16*)(p.ws() + OFF_A + A_CKV);
  const u16* WQ = (const u16*)(p.ws() + OFF_WUQ) + (size_t)j * 1536 * 512;
  const u16* WKV = (const u16*)(p.ws() + OFF_WUKV) + (size_t)j * 2048 * 256;
  u16* Q = (u16*)(p.ws() + OFF_B + B_Q);
  u16* Kb = (u16*)(p.ws() + OFF_B + B_K);
  u16* Vt = (u16*)(p.ws() + OFF_B + B_V);
  auto epiq = [=](int m, int n, f32x4 v) { *(uint2*)(Q + (size_t)m * 1536 + n) = pack4(v[0], v[1], v[2], v[3]); };
  gemm8_job<160, 6, 4, 8, 4, 16, 2>(smem, QN, WQ, 512, epiq);
  EpiKV E; E.Kb = Kb; E.Vt = Vt;
  TileSched<168, 8, 8, 8, 4, 32, 1> S; S.init();
  gemm8(smem, CKV, WKV, 256, S, E);
}

DI void phase_finalize(const PV& p, int j) {
  const int tid_ = TIDX(); const int lane = tid_ & 63, wid = tid_ >> 6;
  const int h = lane >> 3, l8 = lane & 7;
  u16* Q = (u16*)(p.ws() + OFF_B + B_Q);
  u16* Kb = (u16*)(p.ws() + OFF_B + B_K);
  const u16* KR = (const u16*)(p.ws() + OFF_KR);
  const float2* ROPE = (const float2*)(p.ws() + OFF_ROPE);
  const float* qhn = p.in(29) + j * 192;
  const float* khn = p.in(30) + j * 192;
  const float QSCALE = 1.4426950408889634f * 0.07216878364870322f;
  const int stride = gridDim.x * 8;
  for (int u0 = T + blockIdx.x * 8 + wid; u0 < T + TK; u0 += 2 * stride) {
    uint4 raw[2][3];
    u16* basep[2];
#pragma unroll
    for (int w = 0; w < 2; ++w) {
      const int u = u0 + w * stride;
      if (u < T + TK) {
        const bool isq = u < T;
        const int t = isq ? u : u - T;
        u16* base = isq ? Q + (size_t)t * 1536 + h * 192 : Kb + ((size_t)t * 8 + h) * 192;
        basep[w] = base;
#pragma unroll
        for (int k = 0; k < 3; ++k) {
          const u16* src = (!isq && k == 2) ? KR + (size_t)t * 64 + 8 * l8 : base + 8 * (l8 + 8 * k);
          raw[w][k] = *(const uint4*)src;
        }
      }
    }
#pragma unroll
    for (int w = 0; w < 2; ++w) {
      const int u = u0 + w * stride;
      if (u < T + TK) {
        const bool isq = u < T;
        const int t = isq ? u : u - T;
        const float* hn = isq ? qhn : khn;
        float v[3][8];
#pragma unroll
        for (int k = 0; k < 3; ++k) {
          const uint4 a = raw[w][k];
          v[k][0] = lo16(a.x); v[k][1] = hi16(a.x); v[k][2] = lo16(a.y); v[k][3] = hi16(a.y);
          v[k][4] = lo16(a.z); v[k][5] = hi16(a.z); v[k][6] = lo16(a.w); v[k][7] = hi16(a.w);
        }
        float ss = 0.f;
#pragma unroll
        for (int k = 0; k < 3; ++k)
#pragma unroll
          for (int e = 0; e < 8; ++e) ss += v[k][e] * v[k][e];
        ss += shx<1>(ss, lane); ss += shx<2>(ss, lane); ss += shx<4>(ss, lane);
        const float r = rsqrtf(ss * (1.f / 192.f) + EPS);
#pragma unroll
        for (int k = 0; k < 3; ++k) {
          const float4 g0 = *(const float4*)(hn + 8 * (l8 + 8 * k)), g1 = *(const float4*)(hn + 8 * (l8 + 8 * k) + 4);
          v[k][0] *= r * g0.x; v[k][1] *= r * g0.y; v[k][2] *= r * g0.z; v[k][3] *= r * g0.w;
          v[k][4] *= r * g1.x; v[k][5] *= r * g1.y; v[k][6] *= r * g1.z; v[k][7] *= r * g1.w;
        }
        if (t >= TP && t < T) {
          const int tl = (t - TP) & 4095;
          const int pos = l8 < 4 ? (tl >> 6) : (tl & 63);
          const float4* rp = (const float4*)(ROPE + pos * 16 + (l8 & 1) * 8);
          const float4 c01 = rp[0], c23 = rp[1], c45 = rp[2], c67 = rp[3];
          const float cs[8] = {c01.x, c01.z, c23.x, c23.z, c45.x, c45.z, c67.x, c67.z};
          const float sn[8] = {c01.y, c01.w, c23.y, c23.w, c45.y, c45.w, c67.y, c67.w};
#pragma unroll
          for (int e = 0; e < 8; ++e) {
            const float x = v[2][e];
            const float partner = shx<2>(x, lane);
            v[2][e] = (l8 & 2) ? x * cs[e] + partner * sn[e] : x * cs[e] - partner * sn[e];
          }
        }
        const float sc = isq ? QSCALE : 1.f;
#pragma unroll
        for (int k = 0; k < 3; ++k) {
          uint4 o;
          o.x = pack2(v[k][0] * sc, v[k][1] * sc); o.y = pack2(v[k][2] * sc, v[k][3] * sc);
          o.z = pack2(v[k][4] * sc, v[k][5] * sc); o.w = pack2(v[k][6] * sc, v[k][7] * sc);
          *(uint4*)(basep[w] + 8 * (l8 + 8 * k)) = o;
        }
      }
    }
  }
}

DI void attn_item(const PV& p, int j, int kind, int seq, int h, int q0, char* smem) {
  const int tid = TIDX(), lane = tid & 63, wid = tid >> 6;
  const int il = lane & 31, hh = lane >> 5;
  const u16* Q = (const u16*)(p.ws() + OFF_B + B_Q);
  const u16* Kb = (const u16*)(p.ws() + OFF_B + B_K);
  const u16* Vt = (const u16*)(p.ws() + OFF_B + B_V);
  u16* O = (u16*)(p.ws() + OFF_A + A_O);
  const float* qhn = p.in(29) + j * 192;
  const float2* ROPE = (const float2*)(p.ws() + OFF_ROPE);
  const int Lk = kind ? 4352 : 256, nkt = Lk >> 6;
  const u16* vbase = Vt + (kind ? VT_SAMPLE_OFF + (size_t)(seq * 8 + h) * 128 * 4352 : (size_t)(seq * 8 + h) * 128 * 256);
  const int tq = q0 + wid * 32 + il;
  bf16x8 qf[12];
  {
    float v[12][8];
    float ss = 0.f;
#pragma unroll
    for (int ks = 0; ks < 12; ++ks) {
      const uint4 a = *(const uint4*)(Q + ((size_t)tq * 8 + h) * 192 + 16 * ks + 8 * hh);
      v[ks][0] = lo16(a.x); v[ks][1] = hi16(a.x); v[ks][2] = lo16(a.y); v[ks][3] = hi16(a.y);
      v[ks][4] = lo16(a.z); v[ks][5] = hi16(a.z); v[ks][6] = lo16(a.w); v[ks][7] = hi16(a.w);
#pragma unroll
      for (int e = 0; e < 8; ++e) ss += v[ks][e] * v[ks][e];
    }
    { auto rr = __builtin_amdgcn_permlane32_swap(__float_as_uint(ss), __float_as_uint(ss), false, false); ss = __uint_as_float(rr[0]) + __uint_as_float(rr[1]); }
    const float rn = rsqrtf(ss * (1.f / 192.f) + EPS);
#pragma unroll
    for (int ks = 0; ks < 12; ++ks) {
      const float4 g0 = *(const float4*)(qhn + 16 * ks + 8 * hh), g1 = *(const float4*)(qhn + 16 * ks + 8 * hh + 4);
      v[ks][0] *= rn * g0.x; v[ks][1] *= rn * g0.y; v[ks][2] *= rn * g0.z; v[ks][3] *= rn * g0.w;
      v[ks][4] *= rn * g1.x; v[ks][5] *= rn * g1.y; v[ks][6] *= rn * g1.z; v[ks][7] *= rn * g1.w;
    }
    if (kind) {
      const int tl = (tq - TP) & 4095;
#pragma unroll
      for (int part = 0; part < 2; ++part) {
        const int pos = part == 0 ? (tl >> 6) : (tl & 63);
        const float4* rp = (const float4*)(ROPE + pos * 16 + 8 * hh);
        const float4 c01 = rp[0], c23 = rp[1], c45 = rp[2], c67 = rp[3];
        const float cs[8] = {c01.x, c01.z, c23.x, c23.z, c45.x, c45.z, c67.x, c67.z};
        const float sn[8] = {c01.y, c01.w, c23.y, c23.w, c45.y, c45.w, c67.y, c67.w};
#pragma unroll
        for (int e = 0; e < 8; ++e) {
          const float x1 = v[8 + 2 * part][e], x2 = v[9 + 2 * part][e];
          v[8 + 2 * part][e] = x1 * cs[e] - x2 * sn[e];
          v[9 + 2 * part][e] = x2 * cs[e] + x1 * sn[e];
        }
      }
    }
    const float QSCALE = 1.4426950408889634f * 0.07216878364870322f;
#pragma unroll
    for (int ks = 0; ks < 12; ++ks) {
      union { bf16x8 b; unsigned w[4]; } o;
#pragma unroll
      for (int w = 0; w < 4; ++w) o.w[w] = pack2(v[ks][2 * w] * QSCALE, v[ks][2 * w + 1] * QSCALE);
      qf[ks] = o.b;
    }
  }
  f32x16 oacc[4];
#pragma unroll
  for (int a = 0; a < 4; ++a)
#pragma unroll
    for (int r = 0; r < 16; ++r) oacc[a][r] = 0.f;
  float mrun = -INFINITY, lrun = 0.f;
  const int sw = (il >> 1) & 7;
  int ko[4], vob[4];
#pragma unroll
  for (int a = 0; a < 4; ++a) ko[a] = il * 384 + (((2 * a + hh) ^ sw) << 4);
#pragma unroll
  for (int c = 0; c < 4; ++c) vob[c] = il * 128 + (((2 * c + hh) ^ sw) << 4);
  LAS unsigned char* lds = (LAS unsigned char*)smem;
  unsigned kso[3], vso[2];
#pragma unroll
  for (int i = 0; i < 3; ++i) {
    const int id = tid + 512 * i, r = id / 24, pc = id - r * 24;
    const int ch = (pc & ~7) | ((pc & 7) ^ ((r >> 1) & 7));
    kso[i] = (unsigned)(r * 3072 + ch * 16);
  }
#pragma unroll
  for (int i = 0; i < 2; ++i) {
    const int id = tid + 512 * i, dd = id >> 3, pc = id & 7;
    const int ch = pc ^ ((dd >> 1) & 7);
    vso[i] = (unsigned)(dd * Lk * 2 + ch * 16);
  }
  const unsigned ldst = (unsigned)(tid >> 6) * 1024u;
#define ATT_STAGE(kt_, s_)                                                                                      \
  {                                                                                                            \
    const int k0_ = (kt_) * 64;                                                                                \
    const int rowbase_ = kind ? (k0_ < 4096 ? TP + seq * 4096 + k0_ : T + seq * 256 + (k0_ - 4096)) : seq * 256 + k0_; \
    const char* kg_ = (const char*)(Kb + ((size_t)rowbase_ * 8 + h) * 192);                                     \
    const char* vg_ = (const char*)(vbase + k0_);                                                              \
    _Pragma("unroll") for (int i_ = 0; i_ < 3; ++i_)                                                           \
      __builtin_amdgcn_global_load_lds((const unsigned*)(kg_ + kso[i_]), (LAS unsigned*)(lds + (s_) * 40960 + ldst + i_ * 8192), 16, 0, 0); \
    _Pragma("unroll") for (int i_ = 0; i_ < 2; ++i_)                                                           \
      __builtin_amdgcn_global_load_lds((const unsigned*)(vg_ + vso[i_]), (LAS unsigned*)(lds + (s_) * 40960 + 24576 + ldst + i_ * 8192), 16, 0, 0); \
  }
  __syncthreads();
  ATT_STAGE(0, 0)
  asm volatile("s_waitcnt vmcnt(0)" ::: "memory");
  __syncthreads();
  for (int kt = 0; kt < nkt; ++kt) {
    const bool more = kt + 1 < nkt;
    if (more) ATT_STAGE(kt + 1, (kt + 1) & 1)
    const char* Ks = smem + (kt & 1) * 40960;
    const char* Vs = Ks + 24576;
    f32x16 s2[2];
    __builtin_amdgcn_s_setprio(1);
#pragma unroll
    for (int st = 0; st < 2; ++st)
#pragma unroll
      for (int r = 0; r < 16; ++r) s2[st][r] = 0.f;
#pragma unroll
    for (int ks = 0; ks < 12; ++ks)
#pragma unroll
      for (int st = 0; st < 2; ++st) {
        const bf16x8 kf = *(const bf16x8*)(Ks + ko[ks & 3] + st * 12288 + (ks >> 2) * 128);
        s2[st] = __builtin_amdgcn_mfma_f32_32x32x16_bf16(kf, qf[ks], s2[st], 0, 0, 0);
      }
    __builtin_amdgcn_s_setprio(0);
    {
      float pmax = s2[0][0];
#pragma unroll
      for (int r = 1; r < 16; ++r) pmax = fmaxf(pmax, s2[0][r]);
#pragma unroll
      for (int r = 0; r < 16; ++r) pmax = fmaxf(pmax, s2[1][r]);
      { auto rr = __builtin_amdgcn_permlane32_swap(__float_as_uint(pmax), __float_as_uint(pmax), false, false);
        pmax = fmaxf(__uint_as_float(rr[0]), __uint_as_float(rr[1])); }
      if (!__all(pmax - mrun <= 11.541560327f)) {
        const float mn = fmaxf(mrun, pmax);
        const float alpha = __builtin_amdgcn_exp2f(mrun - mn);
        mrun = mn;
        lrun *= alpha;
#pragma unroll
        for (int a = 0; a < 4; ++a)
#pragma unroll
          for (int r = 0; r < 16; ++r) oacc[a][r] *= alpha;
      }
      float psum = 0.f;
#pragma unroll
      for (int st = 0; st < 2; ++st)
#pragma unroll
        for (int r = 0; r < 16; ++r) { const float pv = __builtin_amdgcn_exp2f(s2[st][r] - mrun); s2[st][r] = pv; psum += pv; }
      lrun += psum;
    }
    __builtin_amdgcn_s_setprio(1);
#pragma unroll
    for (int st = 0; st < 2; ++st)
#pragma unroll
      for (int sb = 0; sb < 2; ++sb) {
        union { bf16x8 v; unsigned w[4]; } pb;
#pragma unroll
        for (int w = 0; w < 4; ++w) pb.w[w] = pack2(s2[st][8 * sb + 2 * w], s2[st][8 * sb + 2 * w + 1]);
#pragma unroll
        for (int dt = 0; dt < 4; ++dt) {
          const bf16x8 vf = *(const bf16x8*)(Vs + vob[2 * st + sb] + dt * 4096);
          oacc[dt] = __builtin_amdgcn_mfma_f32_32x32x16_bf16(vf, pb.v, oacc[dt], 0, 0, 0);
        }
      }
    __builtin_amdgcn_s_setprio(0);
    asm volatile("s_waitcnt vmcnt(0)" ::: "memory");
    __syncthreads();
  }
#undef ATT_STAGE
  float ltot;
  { auto rr = __builtin_amdgcn_permlane32_swap(__float_as_uint(lrun), __float_as_uint(lrun), false, false); ltot = __uint_as_float(rr[0]) + __uint_as_float(rr[1]); }
  const float inv = 1.f / ltot;
#pragma unroll
  for (int dt = 0; dt < 4; ++dt)
#pragma unroll
    for (int g = 0; g < 4; ++g) {
      const int d = dt * 32 + 8 * g + 4 * hh;
      *(uint2*)(O + (size_t)tq * 1024 + h * 128 + d) =
          pack4(oacc[dt][4 * g] * inv, oacc[dt][4 * g + 1] * inv, oacc[dt][4 * g + 2] * inv, oacc[dt][4 * g + 3] * inv);
    }
}
DI void phase_attention(const PV& p, int j, char* smem) {
  const bool xmap = gridDim.x == 256;
  const int Gq = opaque_i((int)gridDim.x);
  const int nit = xmap ? 5 : (1280 + Gq - 1) / Gq;
#pragma unroll 1
  for (int r = 0; r < nit; ++r) {
    int kind, seq, h, q0;
    if (xmap) {
      if (r < 4) {
        const int xcd = blockIdx.x & 7, slot = blockIdx.x >> 3;
        const int pair = xcd + 8 * (2 * r + (slot >> 4)), qb = slot & 15;
        kind = 1; seq = pair >> 3; h = pair & 7; q0 = TP + seq * 4096 + qb * 256;
      } else {
        kind = 0; seq = blockIdx.x >> 3; h = blockIdx.x & 7; q0 = seq * 256;
      }
    } else {
      const int it = blockIdx.x + r * gridDim.x;
      if (it >= 1280) break;
      if (it < 1024) { const int pair = it >> 4, qb = it & 15; kind = 1; seq = pair >> 3; h = pair & 7; q0 = TP + seq * 4096 + qb * 256; }
      else { const int i2 = it - 1024; kind = 0; seq = i2 >> 3; h = i2 & 7; q0 = seq * 256; }
    }
    attn_item(p, j, kind, seq, h, q0, smem);
  }
  __syncthreads();
}

DI size_t act_blk(int t, int a) { return (size_t)(t >> 8) * (256 * 2816) + (size_t)(a >> 6) * (256 * 64) + (size_t)((t & 255) * 64 + (a & 63)); }
DI float dpp_ror1(float x) { return __int_as_float(__builtin_amdgcn_update_dpp(0, __float_as_int(x), 0x121, 0xf, 0xf, false)); }
DI float dpp_ror15(float x) { return __int_as_float(__builtin_amdgcn_update_dpp(0, __float_as_int(x), 0x12F, 0xf, 0xf, false)); }
struct EpiFFN {
  u16* ACT; u16* EDGE; const float* cw; const float* cb;
  DI void operator()(const f32x4 (&acc)[2][2][4][2], int pm, int pn, int wr, int wc, int fr, int fq) const {
    uint2 keep[2][4];
#pragma unroll
    for (int n = 0; n < 2; ++n) {
      const int a = pn * 128 + wc * 32 + fq * 8 + n * 4;
      const float4 w0g = *(const float4*)(cw + a), w1g = *(const float4*)(cw + 5632 + a), w2g = *(const float4*)(cw + 11264 + a), bg = *(const float4*)(cb + a);
      const float4 w0u = *(const float4*)(cw + 2816 + a), w1u = *(const float4*)(cw + 5632 + 2816 + a), w2u = *(const float4*)(cw + 11264 + 2816 + a), bu = *(const float4*)(cb + 2816 + a);
#pragma unroll
      for (int ai = 0; ai < 2; ++ai) {
        const int rbase = pm * 256 + ai * 128 + wr * 64;
        const size_t erow = (size_t)(rbase >> 6) * 4;
#pragma unroll
        for (int m = 0; m < 4; ++m) {
          const int mp = m > 0 ? m - 1 : 0, mn = m < 3 ? m + 1 : 3;
          float o[4];
#define FFN_ONE(J, C)                                                                                         \
          {                                                                                                   \
            const float g = acc[ai][0][m][n][J], u = acc[ai][1][m][n][J];                                     \
            const float gpv = m > 0 ? acc[ai][0][mp][n][J] : 0.f, gnx = m < 3 ? acc[ai][0][mn][n][J] : 0.f;   \
            const float upv = m > 0 ? acc[ai][1][mp][n][J] : 0.f, unx = m < 3 ? acc[ai][1][mn][n][J] : 0.f;   \
            const float gp = dpp_ror1(fr == 15 ? gpv : g), gn = dpp_ror15(fr == 0 ? gnx : g);                \
            const float up = dpp_ror1(fr == 15 ? upv : u), un = dpp_ror15(fr == 0 ? unx : u);                \
            const float cg = w0g.C * gp + w1g.C * g + w2g.C * gn + bg.C;                                      \
            const float cu = w0u.C * up + w1u.C * u + w2u.C * un + bu.C;                                      \
            o[J] = silu(cg) * cu;                                                                             \
          }
          FFN_ONE(0, x) FFN_ONE(1, y) FFN_ONE(2, z) FFN_ONE(3, w)
#undef FFN_ONE
          {
            const uint2 cur = pack4(o[0], o[1], o[2], o[3]);
            if (n == 0) keep[ai][m] = cur;
            else { uint4 w; w.x = keep[ai][m].x; w.y = keep[ai][m].y; w.z = cur.x; w.w = cur.y; *(uint4*)(ACT + act_blk(rbase + m * 16 + fr, a - 4)) = w; }
          }
          if ((m == 0 && fr < 2) || (m == 3 && fr >= 14)) {
            const int ri = m == 0 ? fr : fr - 12;
            u16* e = EDGE + (erow + ri) * 5632 + pn * 256 + wc * 32 + fq * 8 + n * 4;
            *(uint2*)e = pack4(acc[ai][0][m][n][0], acc[ai][0][m][n][1], acc[ai][0][m][n][2], acc[ai][0][m][n][3]);
            *(uint2*)(e + 128) = pack4(acc[ai][1][m][n][0], acc[ai][1][m][n][1], acc[ai][1][m][n][2], acc[ai][1][m][n][3]);
          }
        }
      }
    }
  }
};
DI void phase_ffn_up(const PV& p, int l, char* smem) {
  EpiFFN E;
  E.ACT = (u16*)(p.ws() + OFF_B + B_ACT); E.EDGE = (u16*)(p.ws() + OFF_EDGE);
  E.cw = p.in(33) + (size_t)l * 3 * 5632; E.cb = p.in(34) + (size_t)l * 5632;
  TileSched<160, 22, 16, 8, 4, 16, 2> S; S.init();
  gemm8<false, 0, true>(smem, (const u16*)(p.ws() + OFF_A + A_H), (const u16*)(p.ws() + OFF_WUP), 1024, S, E);
}
DI void phase_ffn_fix(const PV& p, int l) {
  const u16* EDGE = (const u16*)(p.ws() + OFF_EDGE);
  u16* ACT = (u16*)(p.ws() + OFF_B + B_ACT);
  const float* cw = p.in(33) + (size_t)l * 3 * 5632;
  const float* cb = p.in(34) + (size_t)l * 5632;
  const unsigned gtid = blockIdx.x * blockDim.x + (unsigned)TIDX(), gsz = gridDim.x * blockDim.x;
  for (unsigned idx = gtid; idx < 640u * 2u * 704u; idx += gsz) {
    const unsigned rq = idx / 704u;
    const int a = (int)(idx - rq * 704u) * 4, rr = (int)rq, which = rr & 1, sidx = rr >> 1;
    const int t = sidx * 64 + (which ? 63 : 0);
    const int tb = which ? t + 1 : t;
    const bool seqb = tb < TP ? (tb & 255) == 0 : ((tb - TP) & 4095) == 0;
    if (seqb) continue;
    const int pc = (a >> 7) * 256 + (a & 127);
    const u16 *pr, *cu, *nx;
    if (which == 0) { pr = EDGE + ((size_t)(sidx - 1) * 4 + 3) * 5632; cu = EDGE + ((size_t)sidx * 4 + 0) * 5632; nx = EDGE + ((size_t)sidx * 4 + 1) * 5632; }
    else { pr = EDGE + ((size_t)sidx * 4 + 2) * 5632; cu = EDGE + ((size_t)sidx * 4 + 3) * 5632; nx = EDGE + ((size_t)(sidx + 1) * 4 + 0) * 5632; }
    const uint2 gp = *(const uint2*)(pr + pc), gc = *(const uint2*)(cu + pc), gn = *(const uint2*)(nx + pc);
    const uint2 up = *(const uint2*)(pr + pc + 128), uc = *(const uint2*)(cu + pc + 128), un = *(const uint2*)(nx + pc + 128);
    const float4 w0g = *(const float4*)(cw + a), w1g = *(const float4*)(cw + 5632 + a), w2g = *(const float4*)(cw + 11264 + a), bg = *(const float4*)(cb + a);
    const float4 w0u = *(const float4*)(cw + 2816 + a), w1u = *(const float4*)(cw + 5632 + 2816 + a), w2u = *(const float4*)(cw + 11264 + 2816 + a), bu = *(const float4*)(cb + 2816 + a);
    const float g0 = w0g.x * lo16(gp.x) + w1g.x * lo16(gc.x) + w2g.x * lo16(gn.x) + bg.x, u0 = w0u.x * lo16(up.x) + w1u.x * lo16(uc.x) + w2u.x * lo16(un.x) + bu.x;
    const float g1 = w0g.y * hi16(gp.x) + w1g.y * hi16(gc.x) + w2g.y * hi16(gn.x) + bg.y, u1 = w0u.y * hi16(up.x) + w1u.y * hi16(uc.x) + w2u.y * hi16(un.x) + bu.y;
    const float g2 = w0g.z * lo16(gp.y) + w1g.z * lo16(gc.y) + w2g.z * lo16(gn.y) + bg.z, u2 = w0u.z * lo16(up.y) + w1u.z * lo16(uc.y) + w2u.z * lo16(un.y) + bu.z;
    const float g3 = w0g.w * hi16(gp.y) + w1g.w * hi16(gc.y) + w2g.w * hi16(gn.y) + bg.w, u3 = w0u.w * hi16(up.y) + w1u.w * hi16(uc.y) + w2u.w * hi16(un.y) + bu.w;
    *(uint2*)(ACT + act_blk(t, a)) = pack4(silu(g0) * u0, silu(g1) * u1, silu(g2) * u2, silu(g3) * u3);
  }
}

#ifndef PH
#define RUN(k, ...) __VA_ARGS__
#else
#define RUN(k, ...) if (PH == k) { __VA_ARGS__ }
#endif
extern "C" __global__ void __launch_bounds__(512) fwd_megakernel(Params kp) {
  extern __shared__ __attribute__((aligned(16))) char smem[];
  cg::grid_group grid = cg::this_grid();
  if (TIDX() == 0) {
    unsigned long long* t = (unsigned long long*)(smem + PARM_OFF);
#pragma unroll
    for (int k = 0; k < 36; ++k) t[k] = (unsigned long long)kp.in[k];
    t[36] = (unsigned long long)kp.out; t[37] = (unsigned long long)kp.ws;
  }
  __syncthreads();
  PV p; p.smem = smem;
  unsigned* bar = (unsigned*)(p.ws() + OFF_BAR);
  if (TIDX() == 0) { *(unsigned*)(smem + PARM_OFF + 512) = 0u; *(unsigned*)(smem + PARM_OFF + 516) = 0u; }
  __syncthreads();
  const XcdBarrier xb = xcd_barrier_post(bar, (volatile LASB unsigned*)(smem + PARM_OFF + 512));
  RUN(0, phase_prep(p, smem);)
  grid.sync();
  RUN(1, phase_filters(p, smem);)
  for (int l = 0; l < 4; ++l) {
    const int i = l >> 1;
    RUN(2, phase_norm(p, l, 0, l);)
    RUN(0, if (l > 0) { int base = 0; convert_ffn_weights(p, l, smem, base); })
    xcd_barrier(xb);
    if ((l & 1) == 0) {
      RUN(3, phase_mix_in(p, i, smem);)
      xcd_barrier(xb);
      RUN(4, phase_sgu(p, i, smem);)
      RUN(5, phase_conv(p, i, 0, smem);)
      xcd_barrier(xb);
      RUN(5, phase_conv(p, i, 1, smem);)
      xcd_barrier(xb);
      RUN(6, phase_ztrans(p, smem);)
      xcd_barrier(xb);
      RUN(7, phase_resid_gemm(p, l, l, (const u16*)(p.ws() + OFF_B + B_MIX), 1024, (const u16*)(p.ws() + OFF_WMIXOUT) + (size_t)i * 1024 * 1024, 2048, smem);)
      xcd_barrier(xb);
    } else {
      RUN(8, phase_dqkv(p, i, smem);)
      xcd_barrier(xb);
      RUN(9, phase_mla_norms(p, i);)
      xcd_barrier(xb);
      RUN(10, phase_uq_ukv(p, i, smem);)
      xcd_barrier(xb);
      RUN(11, phase_finalize(p, i);)
      xcd_barrier(xb);
      RUN(12, phase_attention(p, i, smem);)
      xcd_barrier(xb);
      RUN(7, phase_resid_gemm(p, l, l, (const u16*)(p.ws() + OFF_A + A_O), 1024, (const u16*)(p.ws() + OFF_WO) + (size_t)i * 1024 * 1024, 2048, smem);)
      xcd_barrier(xb);
    }
    RUN(2, phase_norm(p, l, 1, 1);)
    xcd_barrier(xb);
    RUN(13, phase_ffn_up(p, l, smem);)
    xcd_barrier(xb);
    RUN(14, phase_ffn_fix(p, l);)
    xcd_barrier(xb);
    RUN(7, phase_resid_gemm(p, l, 1, (const u16*)(p.ws() + OFF_B + B_ACT), 2816, (const u16*)(p.ws() + OFF_WDOWN), 5120, smem);)
    xcd_barrier(xb);
  }
}

extern "C" void kernel_launch(void* const* d_in, const int* in_sizes, int n_in,
                              void* d_out, int out_size, void* d_ws, size_t ws_size,
                              hipStream_t stream) {
  static int grid_blocks = 0;
  if (!grid_blocks) {
    int dev = 0, cus = 0, per_cu = 0;
    (void)hipGetDevice(&dev);
    (void)hipDeviceGetAttribute(&cus, hipDeviceAttributeMultiprocessorCount, dev);
    (void)hipFuncSetAttribute((const void*)fwd_megakernel, hipFuncAttributeMaxDynamicSharedMemorySize, (int)LDS_BYTES);
    (void)hipOccupancyMaxActiveBlocksPerMultiprocessor(&per_cu, fwd_megakernel, 512, LDS_BYTES);
    if (per_cu < 1) per_cu = 1;
    if (per_cu > 1) per_cu = 1;
    grid_blocks = cus * per_cu;
  }
  if (ws_size < WS_NEED) fprintf(stderr, "workspace too small: %zu < %zu\n", ws_size, (size_t)WS_NEED);
  Params p{};
  for (int i = 0; i < 36; ++i) p.in[i] = (const float*)d_in[i];
  p.out = (float*)d_out;
  p.ws = (char*)d_ws;
  (void)hipMemsetAsync((char*)d_ws + OFF_BAR, 0, 16384, stream);
  void* args[] = {&p};
  hipError_t e = hipLaunchCooperativeKernel((void*)fwd_megakernel, dim3(grid_blocks), dim3(512), args, LDS_BYTES, stream);
  if (e != hipSuccess) fprintf(stderr, "cooperative launch failed: %s (grid %d)\n", hipGetErrorString(e), grid_blocks);
}
```
